# Optimizing an MI355X kernel written in HIP

```python
import jax, jax.numpy as jnp
from jax import lax
import numpy as np

D_MODEL = 1024
BATCH = 16
SEQ = 256
DEPTH = 2
DEC_BATCH = 4
DEC_SEQ = 2048
PAST_LEN = 256

GRID_W = 64
EPS = 1e-6
BRANCH_W = D_MODEL
N_BRANCH = 3
RET_HEADS = 4
RET_DV = BRANCH_W // RET_HEADS
RET_DK = RET_DV // 2
RET_QK_W = RET_HEADS * RET_DK
RET_CHUNK = 128
LRU_W = BRANCH_W
LRU_BLOCKS = 8
LRU_BS = LRU_W // LRU_BLOCKS
LRU_C = 8.0
CONV_W = 4
ATT_HD = 64
ATT_Q_HEADS = BRANCH_W // ATT_HD
ATT_KV_HEADS = 4
ATT_GROUP = ATT_Q_HEADS // ATT_KV_HEADS
ATT_KV_W = ATT_KV_HEADS * ATT_HD
WINDOW = 128
Q_BLOCK = 128
ROPE_BASE = 10000.0
IN_SPLITS = (RET_QK_W, RET_QK_W, BRANCH_W, BRANCH_W,
             LRU_W, LRU_W,
             BRANCH_W, ATT_KV_W, ATT_KV_W, BRANCH_W)
IN_W = sum(IN_SPLITS)

kernel_name = "hybrid_retention_rglru_swa_diffusion_step"

F32 = jnp.float32


def rms_norm(x, g):
    xf = x.astype(F32)
    y = xf * lax.rsqrt(jnp.mean(xf * xf, axis=-1, keepdims=True) + EPS)
    return (y * g.astype(F32)).astype(x.dtype)


def head_norm(x):
    mu = jnp.mean(x, axis=-1, keepdims=True)
    xc = x - mu
    return xc * lax.rsqrt(jnp.mean(xc * xc, axis=-1, keepdims=True) + EPS)


def axial_rope(n_tokens, dim):
    rows = n_tokens // GRID_W
    r = jnp.repeat(jnp.arange(rows, dtype=F32), GRID_W)
    col = jnp.tile(jnp.arange(GRID_W, dtype=F32), rows)
    nq = dim // 4
    inv = ROPE_BASE ** (-jnp.arange(nq, dtype=F32) / nq)
    ang = jnp.stack([r[:, None] * inv, col[:, None] * inv], axis=1)
    return jnp.cos(ang), jnp.sin(ang)


def apply_rope(x, cos, sin):
    B, n, H, dim = x.shape
    xr = x.astype(F32).reshape(B, n, H, 2, 2, dim // 4)
    x1, x2 = xr[..., 0, :], xr[..., 1, :]
    c = cos[None, :, None]
    s = sin[None, :, None]
    out = jnp.stack([x1 * c - x2 * s, x2 * c + x1 * s], axis=-2)
    return out.reshape(B, n, H, dim).astype(x.dtype)


def retention_dir(q, k, v, log_g, s0):
    B, L, H, DK = q.shape
    DV = v.shape[-1]
    n = L // RET_CHUNK

    def chunks(t):
        return t.reshape(B, n, RET_CHUNK, H, t.shape[-1]).transpose(1, 0, 3, 2, 4)

    idx = jnp.arange(RET_CHUNK, dtype=F32)
    diff = idx[:, None] - idx[None, :]
    lg = log_g.astype(F32)
    decay_in = jnp.where(diff >= 0, jnp.exp(lg[:, None, None] * jnp.maximum(diff, 0.0)), 0.0)
    decay_q = jnp.exp(lg[:, None] * (idx + 1.0))[:, :, None]
    decay_k = jnp.exp(lg[:, None] * (RET_CHUNK - 1.0 - idx))[:, :, None]
    decay_c = jnp.exp(lg * RET_CHUNK)[:, None, None]

    def step(s, blk):
        qb, kb, vb = blk
        a = jnp.einsum('bhqd,bhkd->bhqk', qb, kb) * decay_in
        o = (jnp.einsum('bhqk,bhkv->bhqv', a, vb)
             + jnp.einsum('bhqd,bhdv->bhqv', qb * decay_q, s))
        s = s * decay_c + jnp.einsum('bhkd,bhkv->bhdv', kb * decay_k, vb)
        return s, o

    s_fin, o = lax.scan(step, s0.astype(F32), (chunks(q), chunks(k), chunks(v)))
    o = o.transpose(1, 0, 3, 2, 4).reshape(B, L, H, DV)
    return o, s_fin


def bi_retention(q, k, v, log_g, s0):
    of, sf = retention_dir(q, k, v, log_g[0], s0[:, 0])
    ob, sb = retention_dir(q[:, ::-1], k[:, ::-1], v[:, ::-1], log_g[1], s0[:, 1])
    return of + ob[:, ::-1], jnp.stack([sf, sb], axis=1)


def depthwise_conv(x, w, b):
    y = lax.conv_general_dilated(x, w.astype(x.dtype)[:, None, :], window_strides=(1,),
                                 padding=[(1, 2)], dimension_numbers=('NWC', 'WIO', 'NWC'),
                                 feature_group_count=x.shape[-1])
    return y + b.astype(x.dtype)


def _lin_combine(e1, e2):
    a1, b1 = e1
    a2, b2 = e2
    return a1 * a2, a2 * b1 + b2


def rglru_dir(x, w_a, b_a, w_x, b_x, lam, h0):
    B, L, W = x.shape
    xb = x.reshape(B, L, LRU_BLOCKS, LRU_BS)
    r = jax.nn.sigmoid(jnp.einsum('blnc,ncd->blnd', xb, w_a.astype(F32)).reshape(B, L, W) + b_a.astype(F32))
    i = jax.nn.sigmoid(jnp.einsum('blnc,ncd->blnd', xb, w_x.astype(F32)).reshape(B, L, W) + b_x.astype(F32))
    log_a = -LRU_C * r * jax.nn.softplus(-lam.astype(F32))
    a = jnp.exp(log_a)
    u = jnp.sqrt(-jnp.expm1(2.0 * log_a)) * (i * x)
    a_cum, h = lax.associative_scan(_lin_combine, (a, u), axis=1)
    h = h + a_cum * h0.astype(F32)[:, None, :]
    return h, h[:, -1]


def sink_attend(qb, kb, vb, sink, mask):
    s = jnp.einsum('bqhgd,bkhd->bhgqk', qb.astype(F32), kb.astype(F32)) * (ATT_HD ** -0.5)
    if mask is not None:
        s = jnp.where(mask, s, -jnp.inf)
    sk = sink.astype(F32)[None, :, :, None]
    m = jnp.maximum(jnp.max(s, axis=-1), sk)
    p = jnp.exp(s - m[..., None])
    denom = jnp.sum(p, axis=-1) + jnp.exp(sk - m)
    return jnp.einsum('bhgqk,bkhd->bqhgd', p / denom[..., None], vb.astype(F32))


def context_attention(q, k, v, sink):
    B, P = q.shape[:2]
    qg = q.reshape(B, P, ATT_KV_HEADS, ATT_GROUP, ATT_HD)
    sk = sink.reshape(ATT_KV_HEADS, ATT_GROUP)

    def blk(i):
        qb = lax.dynamic_slice_in_dim(qg, i * Q_BLOCK, Q_BLOCK, axis=1)
        return sink_attend(qb, k, v, sk, None)

    o = lax.map(blk, jnp.arange(P // Q_BLOCK))
    return o.transpose(1, 0, 2, 3, 4, 5).reshape(B, P, ATT_Q_HEADS * ATT_HD)


def latent_attention(q, k, v, ck, cv, sink):
    B, L = q.shape[:2]
    qg = q.reshape(B, L, ATT_KV_HEADS, ATT_GROUP, ATT_HD)
    sk = sink.reshape(ATT_KV_HEADS, ATT_GROUP)
    pad = ((0, 0), (WINDOW, WINDOW), (0, 0), (0, 0))
    kp = jnp.pad(k, pad)
    vp = jnp.pad(v, pad)
    span = Q_BLOCK + 2 * WINDOW
    ctx_mask = jnp.ones((Q_BLOCK, ck.shape[1]), dtype=bool)
    ckf = ck.astype(F32)
    cvf = cv.astype(F32)

    def blk(i):
        start = i * Q_BLOCK
        qb = lax.dynamic_slice_in_dim(qg, start, Q_BLOCK, axis=1)
        kb = lax.dynamic_slice_in_dim(kp, start, span, axis=1).astype(F32)
        vb = lax.dynamic_slice_in_dim(vp, start, span, axis=1).astype(F32)
        qpos = start + jnp.arange(Q_BLOCK)
        kpos = start - WINDOW + jnp.arange(span)
        band = ((jnp.abs(qpos[:, None] - kpos[None, :]) <= WINDOW)
                & (kpos >= 0)[None, :] & (kpos < L)[None, :])
        mask = jnp.concatenate([band, ctx_mask], axis=1)
        return sink_attend(qb, jnp.concatenate([kb, ckf], axis=1),
                           jnp.concatenate([vb, cvf], axis=1), sk, mask)

    o = lax.map(blk, jnp.arange(L // Q_BLOCK))
    return o.transpose(1, 0, 2, 3, 4, 5).reshape(B, L, ATT_Q_HEADS * ATT_HD)


def trunk_layer(x, cond, lp, ctx):
    B, L, _ = x.shape
    dt = x.dtype
    mod = jnp.dot(jax.nn.silu(cond), lp['w_ada']) + lp['b_ada']
    shift, scale, gate = jnp.split(mod[:, None, :], 3, axis=-1)
    h = rms_norm(x, lp['norm_pre']) * (1.0 + scale) + shift
    offs = np.cumsum(IN_SPLITS)[:-1].tolist()
    rq, rk, rv, rg, lx, lgt, aq, ak, av, ag = jnp.split(jnp.dot(h, lp['w_in']), offs, axis=-1)
    rq = rq.reshape(B, L, RET_HEADS, RET_DK).astype(F32) * (RET_DK ** -0.5)
    rk = rk.reshape(B, L, RET_HEADS, RET_DK).astype(F32)
    rv = rv.reshape(B, L, RET_HEADS, RET_DV).astype(F32)
    aq = aq.reshape(B, L, ATT_Q_HEADS, ATT_HD)
    ak = ak.reshape(B, L, ATT_KV_HEADS, ATT_HD)
    av = av.reshape(B, L, ATT_KV_HEADS, ATT_HD)
    if ctx is None:
        ret_s0 = jnp.zeros((B, 2, RET_HEADS, RET_DK, RET_DV), F32)
        lru_h0 = jnp.zeros((B, 2, LRU_W), F32)
    else:
        ret_s0, lru_h0, ck, cv = ctx
        cos_r, sin_r = axial_rope(L, RET_DK)
        rq = apply_rope(rq, cos_r, sin_r)
        rk = apply_rope(rk, cos_r, sin_r)
        cos_a, sin_a = axial_rope(L, ATT_HD)
        aq = apply_rope(aq, cos_a, sin_a)
        ak = apply_rope(ak, cos_a, sin_a)
    log_g = -jax.nn.softplus(-lp['ret_decay'].astype(F32))
    ro, ret_s = bi_retention(rq, rk, rv, log_g, ret_s0)
    ro = head_norm(ro).reshape(B, L, BRANCH_W) * jax.nn.silu(rg.astype(F32))
    lxc = depthwise_conv(lx, lp['conv_w'], lp['conv_b']).astype(F32)
    hf, lf = rglru_dir(lxc, lp['lru_wa'][0], lp['lru_ba'][0], lp['lru_wx'][0], lp['lru_bx'][0],
                       lp['lru_lambda'][0], lru_h0[:, 0])
    hb, lb = rglru_dir(lxc[:, ::-1], lp['lru_wa'][1], lp['lru_ba'][1], lp['lru_wx'][1], lp['lru_bx'][1],
                       lp['lru_lambda'][1], lru_h0[:, 1])
    lo = (hf + hb[:, ::-1]) * jax.nn.silu(lgt.astype(F32))
    lru_s = jnp.stack([lf, lb], axis=1)
    if ctx is None:
        ao = context_attention(aq, ak, av, lp['att_sink'])
    else:
        ao = latent_attention(aq, ak, av, ck, cv, lp['att_sink'])
    ao = ao * jax.nn.silu(ag.astype(F32))
    branches = jnp.stack([ro, lo, ao], axis=2).astype(dt)
    z = jnp.einsum('blnc,ncd->blnd', branches, lp['w_branch'])
    g = jax.nn.sigmoid(jnp.dot(h, lp['w_merge']) + lp['b_merge']).reshape(B, L, N_BRANCH, D_MODEL)
    merged = jnp.sum(g * z, axis=2)
    out = jnp.dot(merged, lp['w_out'])
    x = x + gate * rms_norm(out, lp['norm_post'])
    if ctx is None:
        return x, (ret_s, lru_s, ak, av)
    return x


def setup_inputs(seed: int = 0) -> dict:
    key = jax.random.key(seed)
    ks = jax.random.split(key, 32)
    D = D_MODEL

    def nrm(k, shape, s):
        return jax.random.normal(k, shape, F32) * s

    gamma0 = 1.0 - 2.0 ** (-5.0 - jnp.arange(RET_HEADS, dtype=F32))
    a0 = jax.random.uniform(ks[20], (DEPTH, 2, LRU_W), F32, 0.9, 0.999)
    root = a0 ** (1.0 / LRU_C)
    return {
        "x_prompt": nrm(ks[0], (BATCH, SEQ, D), 1.0),
        "x_sample": nrm(ks[1], (DEC_BATCH, DEC_SEQ, D), 1.0),
        "cache_k": nrm(ks[2], (DEC_BATCH, DEPTH, PAST_LEN, ATT_KV_HEADS, ATT_HD), 1.0),
        "cache_v": nrm(ks[3], (DEC_BATCH, DEPTH, PAST_LEN, ATT_KV_HEADS, ATT_HD), 1.0),
        "state_ret": nrm(ks[4], (DEC_BATCH, DEPTH, 2, RET_HEADS, RET_DK, RET_DV), 1.0),
        "state_lru": nrm(ks[5], (DEC_BATCH, DEPTH, 2, LRU_W), 1.0),
        "c": nrm(ks[6], (DEC_BATCH, D), 1.0),
        "c_ctx": nrm(ks[7], (D,), 1.0),
        "w_ada": nrm(ks[8], (DEPTH, D, 3 * D), D ** -0.5),
        "b_ada": nrm(ks[9], (DEPTH, 3 * D), 0.02),
        "norm_pre": 1.0 + nrm(ks[10], (DEPTH, D), 0.05),
        "norm_post": 1.0 + nrm(ks[11], (DEPTH, D), 0.05),
        "w_in": nrm(ks[12], (DEPTH, D, IN_W), D ** -0.5),
        "ret_decay": jnp.log(gamma0 / (1.0 - gamma0)) + nrm(ks[13], (DEPTH, 2, RET_HEADS), 0.1),
        "conv_w": nrm(ks[14], (DEPTH, CONV_W, LRU_W), CONV_W ** -0.5),
        "conv_b": nrm(ks[15], (DEPTH, LRU_W), 0.02),
        "lru_wa": nrm(ks[16], (DEPTH, 2, LRU_BLOCKS, LRU_BS, LRU_BS), LRU_BS ** -0.5),
        "lru_ba": nrm(ks[17], (DEPTH, 2, LRU_W), 0.02),
        "lru_wx": nrm(ks[18], (DEPTH, 2, LRU_BLOCKS, LRU_BS, LRU_BS), LRU_BS ** -0.5),
        "lru_bx": nrm(ks[19], (DEPTH, 2, LRU_W), 0.02),
        "lru_lambda": jnp.log(root) - jnp.log1p(-root),
        "att_sink": nrm(ks[21], (DEPTH, ATT_Q_HEADS), 0.5),
        "w_branch": nrm(ks[22], (DEPTH, N_BRANCH, BRANCH_W, D), BRANCH_W ** -0.5),
        "w_merge": nrm(ks[23], (DEPTH, D, N_BRANCH * D), D ** -0.5),
        "b_merge": nrm(ks[24], (DEPTH, N_BRANCH * D), 0.02),
        "w_out": nrm(ks[25], (DEPTH, D, D), D ** -0.5),
    }


def reference(x_prompt, x_sample, cache_k, cache_v, state_ret, state_lru, c, c_ctx,
              w_ada, b_ada, norm_pre, norm_post, w_in, ret_decay, conv_w, conv_b,
              lru_wa, lru_ba, lru_wx, lru_bx, lru_lambda, att_sink, w_branch, w_merge,
              b_merge, w_out):
    yp = x_prompt
    ys = x_sample
    cond_ctx = c_ctx[None, :]
    new_k, new_v, new_ret, new_lru = [], [], [], []
    for l in range(DEPTH):
        lp = {
            'w_ada': w_ada[l], 'b_ada': b_ada[l], 'norm_pre': norm_pre[l], 'norm_post': norm_post[l],
            'w_in': w_in[l], 'ret_decay': ret_decay[l], 'conv_w': conv_w[l], 'conv_b': conv_b[l],
            'lru_wa': lru_wa[l], 'lru_ba': lru_ba[l], 'lru_wx': lru_wx[l], 'lru_bx': lru_bx[l],
            'lru_lambda': lru_lambda[l], 'att_sink': att_sink[l], 'w_branch': w_branch[l],
            'w_merge': w_merge[l], 'b_merge': b_merge[l], 'w_out': w_out[l],
        }
        yp, (r_s, l_s, k_l, v_l) = trunk_layer(yp, cond_ctx, lp, None)
        new_ret.append(r_s.astype(x_prompt.dtype))
        new_lru.append(l_s.astype(x_prompt.dtype))
        new_k.append(k_l)
        new_v.append(v_l)
        ys = trunk_layer(ys, c, lp, (state_ret[:, l], state_lru[:, l], cache_k[:, l], cache_v[:, l]))
    new_cache_k = jnp.stack(new_k, axis=1)
    new_cache_v = jnp.stack(new_v, axis=1)
    new_state_ret = jnp.stack(new_ret, axis=1)
    new_state_lru = jnp.stack(new_lru, axis=1)
    return (yp, ys, new_cache_k, new_cache_v, new_state_ret, new_state_lru)
```

```cpp
#include <hip/hip_runtime.h>
#include <hip/hip_cooperative_groups.h>
#include <cstdio>
#include <cstdint>
namespace cg = cooperative_groups;

#ifndef ONE_LAUNCH
#define ONE_LAUNCH 0
#endif

typedef unsigned short bf16_t;
#define DEV __device__ __forceinline__

constexpr int D = 1024;
constexpr int NCTX = 4096;
constexpr int NLAT = 8192;
constexpr int M = NCTX + NLAT;
constexpr int PW = 7680;
constexpr int C_RQ = 0, C_RK = 512, C_RV = 1024, C_RG = 2048, C_LX = 3072, C_LG = 4096,
              C_AQ = 5120, C_AK = 6144, C_AV = 6400, C_AG = 6656;
constexpr float EPS = 1e-6f;

constexpr size_t O_YP = 0, O_YS = 4194304, O_NK = 12582912, O_NV = 14680064, O_NRET = 16777216, O_NLRU = 25165824;

constexpr size_t OFF_MOD  = 0;
constexpr size_t OFF_LRUW = 122880;
constexpr size_t OFF_WBR  = OFF_LRUW + 1048576;
constexpr size_t OFF_WOUT = OFF_WBR + 6291456;
constexpr size_t OFF_WMG  = OFF_WOUT + 2097152;
constexpr size_t OFF_H    = OFF_WMG + 6291456;
constexpr size_t OFF_P    = OFF_H + (size_t)M * 1024 * 2;
constexpr size_t OFF_W1T  = OFF_P + (size_t)M * PW * 2;
constexpr size_t OFF_OFTMP = OFF_W1T;
constexpr size_t OFF_LRUC = 262266880;
constexpr size_t WS_NEED  = OFF_LRUC + (size_t)2 * 192 * 2 * 1024 * 4;
static_assert(OFF_OFTMP + (size_t)M * 1024 * 2 <= OFF_LRUC, "overlap");
static_assert(WS_NEED <= 268435456, "ws budget");

struct Params {
    const float *x_prompt, *x_sample, *cache_k, *cache_v, *state_ret, *state_lru, *c, *c_ctx,
                *w_ada, *b_ada, *norm_pre, *norm_post, *w_in, *ret_decay, *conv_w, *conv_b,
                *lru_wa, *lru_ba, *lru_wx, *lru_bx, *lru_lambda, *att_sink, *w_branch, *w_merge, *b_merge, *w_out;
    float* out;
    unsigned char* ws;
};

DEV float bf2f(bf16_t v) { return __uint_as_float(((unsigned)v) << 16); }
DEV bf16_t f2bf(float f) { unsigned u = __float_as_uint(f); u += 0x7fffu + ((u >> 16) & 1u); return (bf16_t)(u >> 16); }
DEV float siluf(float x) { return x / (1.f + __expf(-x)); }
DEV float sigmf(float x) { return 1.f / (1.f + __expf(-x)); }
DEV float softplusf(float x) { return fmaxf(x, 0.f) + log1pf(__expf(-fabsf(x))); }

DEV float* ws_mod(const Params& p) { return (float*)(p.ws + OFF_MOD); }
DEV bf16_t* ws_bf(const Params& p, size_t off) { return (bf16_t*)(p.ws + off); }

DEV const float* x_row(const Params& p, int l, int m) {
    const float* xp = p.x_prompt; const float* xs = p.x_sample; const float* po = p.out;
    if (l == 0) return m < NCTX ? xp + (size_t)m * D : xs + (size_t)(m - NCTX) * D;
    return po + (size_t)m * D;
}
DEV int cond_row(int m) { return m < NCTX ? 0 : 1 + ((m - NCTX) >> 11); }

DEV float wave_sum(float v) {
#pragma unroll
    for (int o = 1; o < 64; o <<= 1) v += __shfl_xor(v, o);
    return v;
}
DEV float block_sum(float v, float* red) {
    v = wave_sum(v);
    __syncthreads();
    if ((threadIdx.x & 63) == 0) red[threadIdx.x >> 6] = v;
    __syncthreads();
    return (red[0] + red[1]) + (red[2] + red[3]);
}

DEV float dot_bf16(const bf16_t* a, const bf16_t* b, int K) {
    float acc = 0.f;
    const uint4* a4 = (const uint4*)a; const uint4* b4 = (const uint4*)b;
    for (int i = 0; i < K / 8; ++i) {
        uint4 x = a4[i], y = b4[i];
        unsigned xs[4] = {x.x, x.y, x.z, x.w}, ys[4] = {y.x, y.y, y.z, y.w};
#pragma unroll
        for (int j = 0; j < 4; ++j) {
            acc += __uint_as_float(xs[j] << 16) * __uint_as_float(ys[j] << 16);
            acc += __uint_as_float(xs[j] & 0xffff0000u) * __uint_as_float(ys[j] & 0xffff0000u);
        }
    }
    return acc;
}

DEV void phase_mod(const Params& p) {
    float* mod = ws_mod(p);
    const int gt = blockIdx.x * blockDim.x + threadIdx.x, gs = gridDim.x * blockDim.x;
    for (int idx = gt; idx < 2 * 5 * 3072; idx += gs) {
        const int j = idx % 3072, r = (idx / 3072) % 5, l = idx / 15360;
        const float* cctx = p.c_ctx; const float* cb = p.c;
        const float* cond = r == 0 ? cctx : cb + (r - 1) * D;
        const float* w = p.w_ada + (size_t)l * D * 3072 + j;
        float acc = p.b_ada[l * 3072 + j];
        for (int k = 0; k < D; ++k) acc += siluf(cond[k]) * w[(size_t)k * 3072];
        mod[idx] = acc;
    }
}

DEV void transpose_tile(const float* src, int K, int N, bf16_t* dst, int k0, int n0, float* tile) {
    const int tid = threadIdx.x;
#pragma unroll 4
    for (int i = 0; i < 16; ++i) {
        const int r = i * 4 + (tid >> 6), c = tid & 63;
        tile[r * 65 + c] = src[(size_t)(k0 + r) * N + n0 + c];
    }
    __syncthreads();
#pragma unroll 4
    for (int i = 0; i < 16; ++i) {
        const int n = i * 4 + (tid >> 6), k = tid & 63;
        dst[(size_t)(n0 + n) * K + k0 + k] = f2bf(tile[k * 65 + n]);
    }
    __syncthreads();
}
DEV void phase_convert(const Params& p, int l, float* tile) {
    constexpr int T_IN = 16 * 120, T_MG = 16 * 48, T_BR = 3 * 256, T_OUT = 256, T_LRU = 32 * 4;
    constexpr int TOT = T_IN + T_MG + T_BR + T_OUT + T_LRU;
    for (int it = blockIdx.x; it < TOT; it += gridDim.x) {
        int r = it;
        if (r < T_IN) { transpose_tile(p.w_in + (size_t)l * D * PW, D, PW, ws_bf(p, OFF_W1T), (r / 120) * 64, (r % 120) * 64, tile); continue; }
        r -= T_IN;
        if (r < T_MG) { transpose_tile(p.w_merge + (size_t)l * D * 3072, D, 3072, ws_bf(p, OFF_WMG), (r / 48) * 64, (r % 48) * 64, tile); continue; }
        r -= T_MG;
        if (r < T_BR) { const int nb = r / 256, q = r % 256;
            transpose_tile(p.w_branch + ((size_t)l * 3 + nb) * D * D, D, D, ws_bf(p, OFF_WBR) + (size_t)nb * D * D, (q / 16) * 64, (q % 16) * 64, tile); continue; }
        r -= T_BR;
        if (r < T_OUT) { transpose_tile(p.w_out + (size_t)l * D * D, D, D, ws_bf(p, OFF_WOUT), (r / 16) * 64, (r % 16) * 64, tile); continue; }
        r -= T_OUT;
        {
            const int mat = r / 4, q = r % 4;
            const int dir = mat >> 4, gate = (mat >> 3) & 1, blk = mat & 7;
            const float* wa_ = p.lru_wa; const float* wx_ = p.lru_wx;
            const float* src = (gate ? wx_ : wa_) + (((size_t)l * 2 + dir) * 8 + blk) * 128 * 128;
            transpose_tile(src, 128, 128, ws_bf(p, OFF_LRUW) + (size_t)mat * 128 * 128, (q >> 1) * 64, (q & 1) * 64, tile);
        }
    }
}

DEV void prenorm_row(const Params& p, int l, int m, float4 v, float* red) {
    const int tid = threadIdx.x;
    const float ss = block_sum(v.x * v.x + v.y * v.y + v.z * v.z + v.w * v.w, red);
    const float rstd = rsqrtf(ss * (1.f / D) + EPS);
    const float* mod = ws_mod(p) + (size_t)(l * 5 + cond_row(m)) * 3072;
    const float4 g = ((const float4*)(p.norm_pre + l * D))[tid];
    const float4 sh = ((const float4*)mod)[tid];
    const float4 sc = ((const float4*)(mod + 1024))[tid];
    bf16_t* h = ws_bf(p, OFF_H) + (size_t)m * D + tid * 4;
    ushort4 o;
    o.x = f2bf(v.x * rstd * g.x * (1.f + sc.x) + sh.x);
    o.y = f2bf(v.y * rstd * g.y * (1.f + sc.y) + sh.y);
    o.z = f2bf(v.z * rstd * g.z * (1.f + sc.z) + sh.z);
    o.w = f2bf(v.w * rstd * g.w * (1.f + sc.w) + sh.w);
    *(ushort4*)h = o;
}
DEV void phase_prenorm(const Params& p, int l, float* red) {
    for (int m = blockIdx.x; m < M; m += gridDim.x) {
        const float4 v = ((const float4*)x_row(p, l, m))[threadIdx.x];
        prenorm_row(p, l, m, v, red);
    }
}

DEV int rope_partner(int n) {
    if (n < 1024) return ((n >> 5) & 1) ? n - 32 : n + 32;
    return (((n - C_AQ) >> 4) & 1) ? n - 16 : n + 16;
}
DEV bool rope_col(int n) { return n < 1024 || (n >= C_AQ && n < C_AV); }
DEV void p2_store(const Params& p, int l, int m, int n, float v, float partner) {
    const bool lat = m >= NCTX;
    const int t = lat ? ((m - NCTX) & 2047) : (m & 255);
    bf16_t* P = ws_bf(p, OFF_P) + (size_t)m * PW;
    float o = v;
    if (n < 1024) {
        if (lat) {
            const int d = n & 127, c = d & 31, a = d >> 6, b = (d >> 5) & 1;
            const float pos = (float)(a ? (t & 63) : (t >> 6));
            const float inv = powf(10000.f, -(float)c / 32.f);
            float sn, cs; sincosf(pos * inv, &sn, &cs);
            o = b ? v * cs + partner * sn : v * cs - partner * sn;
        }
        if (n < 512) o *= 0.08838834764831845f;
    } else if (n < C_RG) {
    } else if (n < C_LX) { o = siluf(v);
    } else if (n < C_LG) {
    } else if (n < C_AQ) { o = siluf(v);
    } else if (n < C_AV) {
        if (lat) {
            const int d = (n - C_AQ) & 63, c = d & 15, a = d >> 5, b = (d >> 4) & 1;
            const float pos = (float)(a ? (t & 63) : (t >> 6));
            const float inv = powf(10000.f, -(float)c / 16.f);
            float sn, cs; sincosf(pos * inv, &sn, &cs);
            o = b ? v * cs + partner * sn : v * cs - partner * sn;
        } else if (n >= C_AK) {
            p.out[O_NK + ((size_t)((m >> 8) * 2 + l) * 256 + t) * 256 + (n - C_AK)] = v;
        }
        if (n < C_AK) o *= 0.125f;
    } else if (n < C_AG) {
        if (!lat) p.out[O_NV + ((size_t)((m >> 8) * 2 + l) * 256 + t) * 256 + (n - C_AV)] = v;
    } else { o = siluf(v); }
    P[n] = f2bf(o);
}

DEV void phase_gemm1_naive(const Params& p, int l) {
    const bf16_t* H = ws_bf(p, OFF_H); const bf16_t* W = ws_bf(p, OFF_W1T);
    const size_t gt = (size_t)blockIdx.x * blockDim.x + threadIdx.x, gs = (size_t)gridDim.x * blockDim.x;
    for (size_t idx = gt; idx < (size_t)M * PW; idx += gs) {
        const int n = (int)(idx % PW), m = (int)(idx / PW);
        const float v = dot_bf16(H + (size_t)m * D, W + (size_t)n * D, D);
        float pr = 0.f;
        if (m >= NCTX && rope_col(n)) pr = dot_bf16(H + (size_t)m * D, W + (size_t)rope_partner(n) * D, D);
        p2_store(p, l, m, n, v, pr);
    }
}

DEV void phase_attn_naive(const Params& p, int l) {
    bf16_t* Pb = ws_bf(p, OFF_P);
    const int gt = blockIdx.x * blockDim.x + threadIdx.x, gs = gridDim.x * blockDim.x;
    for (int idx = gt; idx < M * 16; idx += gs) {
        const int m = idx >> 4, hq = idx & 15, hk = hq >> 2;
        const bool lat = m >= NCTX;
        float q[64], acc[64];
        bf16_t* qp = Pb + (size_t)m * PW + C_AQ + hq * 64;
#pragma unroll
        for (int d = 0; d < 64; ++d) { q[d] = bf2f(qp[d]); acc[d] = 0.f; }
        float mx = p.att_sink[l * 16 + hq], den = 1.f;
        int k_lo, k_hi;
        if (!lat) { k_lo = m & ~255; k_hi = k_lo + 255; }
        else { const int mm = m - NCTX, s0 = NCTX + (mm & ~2047), t = mm & 2047;
               k_lo = s0 + max(t - 128, 0); k_hi = s0 + min(t + 128, 2047); }
        for (int kr = k_lo; kr <= k_hi; ++kr) {
            const bf16_t* kp = Pb + (size_t)kr * PW + C_AK + hk * 64;
            const bf16_t* vp = Pb + (size_t)kr * PW + C_AV + hk * 64;
            float s = 0.f;
#pragma unroll
            for (int d = 0; d < 64; ++d) s += q[d] * bf2f(kp[d]);
            if (s > mx) { const float sc = __expf(mx - s); den *= sc;
#pragma unroll
                for (int d = 0; d < 64; ++d) acc[d] *= sc;
                mx = s; }
            const float pe = __expf(s - mx); den += pe;
#pragma unroll
            for (int d = 0; d < 64; ++d) acc[d] += pe * bf2f(vp[d]);
        }
        if (lat) {
            const int b = (m - NCTX) >> 11;
            for (int j = 0; j < 256; ++j) {
                const float* kp = p.cache_k + ((size_t)((b * 2 + l) * 256 + j) * 4 + hk) * 64;
                const float* vp = p.cache_v + ((size_t)((b * 2 + l) * 256 + j) * 4 + hk) * 64;
                float s = 0.f;
#pragma unroll
                for (int d = 0; d < 64; ++d) s += q[d] * kp[d];
                if (s > mx) { const float sc = __expf(mx - s); den *= sc;
#pragma unroll
                    for (int d = 0; d < 64; ++d) acc[d] *= sc;
                    mx = s; }
                const float pe = __expf(s - mx); den += pe;
#pragma unroll
                for (int d = 0; d < 64; ++d) acc[d] += pe * vp[d];
            }
        }
        const float rd = 1.f / den;
        const bf16_t* gp = Pb + (size_t)m * PW + C_AG + hq * 64;
#pragma unroll
        for (int d = 0; d < 64; ++d) qp[d] = f2bf(acc[d] * rd * bf2f(gp[d]));
    }
}

DEV void phase_ret_naive(const Params& p, int l, float* red) {
    bf16_t* Pb = ws_bf(p, OFF_P);
    bf16_t* tmp = ws_bf(p, OFF_OFTMP);
    const int dv = threadIdx.x;
    for (int item = blockIdx.x; item < 80; item += gridDim.x) {
        const int seq = item >> 2, h = item & 3;
        const bool lat = seq >= 16;
        const int b = lat ? seq - 16 : seq;
        const int row0 = lat ? NCTX + b * 2048 : b * 256;
        const int L = lat ? 2048 : 256;
        for (int dir = 0; dir < 2; ++dir) {
            const float g = 1.f / (1.f + __expf(-p.ret_decay[(l * 2 + dir) * 4 + h]));
            float S[128];
            if (lat) {
                const float* s0 = p.state_ret + ((((size_t)b * 2 + l) * 2 + dir) * 4 + h) * 128 * 256 + dv;
#pragma unroll
                for (int j = 0; j < 128; ++j) S[j] = s0[(size_t)j * 256];
            } else {
#pragma unroll
                for (int j = 0; j < 128; ++j) S[j] = 0.f;
            }
            for (int s = 0; s < L; ++s) {
                const int t = dir == 0 ? s : L - 1 - s;
                const int m = row0 + t;
                const bf16_t* row = Pb + (size_t)m * PW;
                const float v = bf2f(row[C_RV + h * 256 + dv]);
                const uint4* k4 = (const uint4*)(row + C_RK + h * 128);
                const uint4* q4 = (const uint4*)(row + C_RQ + h * 128);
                float o = 0.f;
#pragma unroll
                for (int jj = 0; jj < 16; ++jj) {
                    const uint4 kk = k4[jj], qq = q4[jj];
                    const unsigned ks[4] = {kk.x, kk.y, kk.z, kk.w}, qs[4] = {qq.x, qq.y, qq.z, qq.w};
#pragma unroll
                    for (int e = 0; e < 4; ++e) {
                        const int j = jj * 8 + e * 2;
                        S[j] = g * S[j] + __uint_as_float(ks[e] << 16) * v;
                        o += __uint_as_float(qs[e] << 16) * S[j];
                        S[j + 1] = g * S[j + 1] + __uint_as_float(ks[e] & 0xffff0000u) * v;
                        o += __uint_as_float(qs[e] & 0xffff0000u) * S[j + 1];
                    }
                }
                if (dir == 0) {
                    tmp[(size_t)m * D + h * 256 + dv] = f2bf(o);
                } else {
                    o += bf2f(tmp[(size_t)m * D + h * 256 + dv]);
                    const float mu = block_sum(o, red) * (1.f / 256.f);
                    const float xc = o - mu;
                    const float var = block_sum(xc * xc, red) * (1.f / 256.f);
                    const float y = xc * rsqrtf(var + EPS);
                    bf16_t* gp = Pb + (size_t)m * PW + C_RG + h * 256 + dv;
                    *gp = f2bf(y * bf2f(*gp));
                }
            }
            if (!lat) {
                float* so = p.out + O_NRET + ((((size_t)b * 2 + l) * 2 + dir) * 4 + h) * 128 * 256 + dv;
#pragma unroll
                for (int j = 0; j < 128; ++j) so[(size_t)j * 256] = S[j];
            }
        }
    }
}

DEV void lru_tile_naive(const Params& p, int l, int gc, int blk, int mode, float* lds) {
    float* lxc = lds; float* hs = lds + 64 * 128;
    bf16_t* Pb = ws_bf(p, OFF_P);
    const int tid = threadIdx.x;
    const int m0 = gc * 64;
    const bool lat = m0 >= NCTX;
    const int L = lat ? 2048 : 256;
    const int t0 = lat ? ((m0 - NCTX) & 2047) : (m0 & 255);
    for (int e = tid; e < 64 * 128; e += 256) {
        const int tt = e >> 7, c = e & 127, ch = blk * 128 + c;
        float acc = p.conv_b[l * D + ch];
#pragma unroll
        for (int j = 0; j < 4; ++j) {
            const int tp = t0 + tt + j - 1;
            if (tp >= 0 && tp < L) acc += p.conv_w[(l * 4 + j) * D + ch] * bf2f(Pb[(size_t)(m0 + tt + j - 1) * PW + C_LX + ch]);
        }
        lxc[e] = acc; hs[e] = 0.f;
    }
    __syncthreads();
    const int c = tid & 127, dir = tid >> 7, ch = blk * 128 + c;
    const bf16_t* Wa = ws_bf(p, OFF_LRUW) + ((size_t)((dir * 2 + 0) * 8 + blk) * 128 + c) * 128;
    const bf16_t* Wx = ws_bf(p, OFF_LRUW) + ((size_t)((dir * 2 + 1) * 8 + blk) * 128 + c) * 128;
    const float ba = p.lru_ba[(l * 2 + dir) * D + ch], bx = p.lru_bx[(l * 2 + dir) * D + ch];
    const float sp = softplusf(-p.lru_lambda[(l * 2 + dir) * D + ch]);
    float* LA = (float*)(p.ws + OFF_LRUC);
    float* LH = LA + 192 * 2 * 1024;
    const size_t ci = ((size_t)gc * 2 + dir) * 1024 + ch;
    float h = mode ? LH[ci] : 0.f, A = 1.f;
    for (int s = 0; s < 64; ++s) {
        const int tt = dir == 0 ? s : 63 - s;
        float r = ba, ig = bx;
        for (int j = 0; j < 128; ++j) { const float x = lxc[tt * 128 + j]; r += x * bf2f(Wa[j]); ig += x * bf2f(Wx[j]); }
        r = sigmf(r); ig = sigmf(ig);
        const float log_a = -8.f * r * sp;
        const float a = __expf(log_a);
        const float u = sqrtf(-expm1f(2.f * log_a)) * (ig * lxc[tt * 128 + c]);
        h = a * h + u; A *= a;
        if (mode) atomicAdd(&hs[tt * 128 + c], h);
    }
    if (!mode) { LA[ci] = A; LH[ci] = h; }
    else if (!lat) {
        const int b = m0 >> 8;
        if (dir == 0 && t0 == 192) p.out[O_NLRU + ((size_t)(b * 2 + l) * 2 + 0) * 1024 + ch] = h;
        if (dir == 1 && t0 == 0)   p.out[O_NLRU + ((size_t)(b * 2 + l) * 2 + 1) * 1024 + ch] = h;
    }
    __syncthreads();
    if (mode) {
        for (int e = tid; e < 64 * 128; e += 256) {
            const int tt = e >> 7, cc = e & 127;
            bf16_t* gp = Pb + (size_t)(m0 + tt) * PW + C_LG + blk * 128 + cc;
            *gp = f2bf(hs[e] * bf2f(*gp));
        }
    }
    __syncthreads();
}
DEV void phase_lru_tiles_naive(const Params& p, int l, int mode, float* lds) {
    for (int it = blockIdx.x; it < 192 * 8; it += gridDim.x) lru_tile_naive(p, l, it >> 3, it & 7, mode, lds);
}
DEV void phase_lru_carry(const Params& p, int l) {
    float* LA = (float*)(p.ws + OFF_LRUC);
    float* LH = LA + 192 * 2 * 1024;
    const int gt = blockIdx.x * blockDim.x + threadIdx.x, gs = gridDim.x * blockDim.x;
    for (int idx = gt; idx < 20 * 2 * 1024; idx += gs) {
        const int ch = idx & 1023, dir = (idx >> 10) & 1, seq = idx >> 11;
        const bool lat = seq >= 16;
        const int nch = lat ? 32 : 4;
        const int gc0 = lat ? 64 + (seq - 16) * 32 : seq * 4;
        float carry = lat ? p.state_lru[((size_t)((seq - 16) * 2 + l) * 2 + dir) * 1024 + ch] : 0.f;
        for (int s = 0; s < nch; ++s) {
            const int cidx = dir == 0 ? s : nch - 1 - s;
            const size_t ci = ((size_t)(gc0 + cidx) * 2 + dir) * 1024 + ch;
            const float A = LA[ci], Hh = LH[ci];
            LH[ci] = carry;
            carry = A * carry + Hh;
        }
    }
}

DEV void phase_merge_naive(const Params& p, int l) {
    bf16_t* Pb = ws_bf(p, OFF_P);
    const bf16_t* H = ws_bf(p, OFF_H);
    const int gt = blockIdx.x * blockDim.x + threadIdx.x, gs = gridDim.x * blockDim.x;
    for (int idx = gt; idx < M * D; idx += gs) {
        const int m = idx >> 10, d = idx & 1023;
        float tot = 0.f;
        for (int nb = 0; nb < 3; ++nb) {
            const float gl = dot_bf16(H + (size_t)m * D, ws_bf(p, OFF_WMG) + (size_t)(nb * D + d) * D, D) + p.b_merge[l * 3072 + nb * D + d];
            const float z = dot_bf16(Pb + (size_t)m * PW + (nb == 0 ? C_RG : nb == 1 ? C_LG : C_AQ), ws_bf(p, OFF_WBR) + ((size_t)nb * D + d) * D, D);
            tot += sigmf(gl) * z;
        }
        Pb[(size_t)m * PW + d] = f2bf(tot);
    }
}
DEV void phase_out_naive(const Params& p, int l) {
    bf16_t* Pb = ws_bf(p, OFF_P);
    const int gt = blockIdx.x * blockDim.x + threadIdx.x, gs = gridDim.x * blockDim.x;
    for (int idx = gt; idx < M * D; idx += gs) {
        const int m = idx >> 10, d = idx & 1023;
        const float v = dot_bf16(Pb + (size_t)m * PW, ws_bf(p, OFF_WOUT) + (size_t)d * D, D);
        ((float*)(Pb + (size_t)m * PW + 1024))[d] = v;
    }
}
DEV void phase_post(const Params& p, int l, float* red) {
    const int tid = threadIdx.x;
    for (int m = blockIdx.x; m < M; m += gridDim.x) {
        const float4 o = ((const float4*)(ws_bf(p, OFF_P) + (size_t)m * PW + 1024))[tid];
        const float ss = block_sum(o.x * o.x + o.y * o.y + o.z * o.z + o.w * o.w, red);
        const float rstd = rsqrtf(ss * (1.f / D) + EPS);
        const float4 x = ((const float4*)x_row(p, l, m))[tid];
        const float4 g = ((const float4*)(p.norm_post + l * D))[tid];
        const float4 gate = ((const float4*)(ws_mod(p) + (size_t)(l * 5 + cond_row(m)) * 3072 + 2048))[tid];
        float4 y;
        y.x = x.x + gate.x * (o.x * rstd * g.x);
        y.y = x.y + gate.y * (o.y * rstd * g.y);
        y.z = x.z + gate.z * (o.z * rstd * g.z);
        y.w = x.w + gate.w * (o.w * rstd * g.w);
        ((float4*)(p.out + (size_t)m * D))[tid] = y;
        if (l == 0) prenorm_row(p, 1, m, y, red);
    }
}

enum { PH_INIT = 0, PH_PRENORM, PH_GEMM1, PH_MIX1, PH_MIX2, PH_MIX3, PH_MERGE, PH_OUT, PH_POST, PH_COUNT };

DEV void run_phase(const Params& p, int ph, int l, float* lds) {
    switch (ph) {
    case PH_INIT:    phase_mod(p); phase_convert(p, 0, lds); break;
    case PH_PRENORM: phase_prenorm(p, l, lds); break;
    case PH_GEMM1:   phase_gemm1_naive(p, l); break;
    case PH_MIX1:    phase_attn_naive(p, l); phase_lru_tiles_naive(p, l, 0, lds); break;
    case PH_MIX2:    phase_lru_carry(p, l); phase_ret_naive(p, l, lds); break;
    case PH_MIX3:    phase_lru_tiles_naive(p, l, 1, lds); break;
    case PH_MERGE:   phase_merge_naive(p, l); break;
    case PH_OUT:     phase_out_naive(p, l); break;
    case PH_POST:    phase_post(p, l, lds); if (l == 0) phase_convert(p, 1, lds); break;
    }
}

__global__ void __launch_bounds__(256, 2) phase_kernel(Params p, int ph, int l) {
    __shared__ __attribute__((aligned(16))) float lds[16384];
    run_phase(p, ph, l, lds);
}

#if ONE_LAUNCH
__global__ void __launch_bounds__(256, 2) mega_kernel(Params p) {
    __shared__ __attribute__((aligned(16))) float lds[16384];
    cg::grid_group grid = cg::this_grid();
    run_phase(p, PH_INIT, 0, lds); grid.sync();
    run_phase(p, PH_PRENORM, 0, lds); grid.sync();
    for (int l = 0; l < 2; ++l) {
        for (int ph = PH_GEMM1; ph <= PH_POST; ++ph) {
            run_phase(p, ph, l, lds);
            if (!(l == 1 && ph == PH_POST)) grid.sync();
        }
    }
}
#endif

extern "C" void kernel_launch(void* const* d_in, const int* in_sizes, int n_in,
                              void* d_out, int out_size, void* d_ws, size_t ws_size,
                              hipStream_t stream) {
    static int grid_blocks = 0;
    if (grid_blocks == 0) {
        if (n_in != 26 || ws_size < WS_NEED || out_size != 25231360) {
            fprintf(stderr, "kernel_launch: unexpected n_in %d / ws_size %zu (need %zu) / out_size %d\n", n_in, ws_size, (size_t)WS_NEED, out_size);
            grid_blocks = -1; return;
        }
        int dev = 0, cus = 0, per_cu = 0;
        hipGetDevice(&dev);
        hipDeviceGetAttribute(&cus, hipDeviceAttributeMultiprocessorCount, dev);
#if ONE_LAUNCH
        hipOccupancyMaxActiveBlocksPerMultiprocessor(&per_cu, (const void*)mega_kernel, 256, 0);
#else
        hipOccupancyMaxActiveBlocksPerMultiprocessor(&per_cu, (const void*)phase_kernel, 256, 0);
#endif
        if (per_cu < 1) per_cu = 1;
        if (per_cu > 2) per_cu = 2;
        grid_blocks = cus * per_cu;
    }
    if (grid_blocks < 0) return;
    Params p{};
    const float** pp = (const float**)&p;
    for (int i = 0; i < 26; ++i) pp[i] = (const float*)d_in[i];
    p.out = (float*)d_out;
    p.ws = (unsigned char*)d_ws;
#if ONE_LAUNCH
    void* args[] = {&p};
    hipError_t e = hipLaunchCooperativeKernel((const void*)mega_kernel, dim3(grid_blocks), dim3(256), args, 0, stream);
    if (e != hipSuccess) fprintf(stderr, "cooperative launch failed: %s (grid %d)\n", hipGetErrorString(e), grid_blocks);
#else
    phase_kernel<<<grid_blocks, 256, 0, stream>>>(p, PH_INIT, 0);
    phase_kernel<<<grid_blocks, 256, 0, stream>>>(p, PH_PRENORM, 0);
    for (int l = 0; l < 2; ++l)
        for (int ph = PH_GEMM1; ph <= PH_POST; ++ph)
            phase_kernel<<<grid_blocks, 256, 0, stream>>>(p, ph, l);
#endif
}
```

```cpp
#include <hip/hip_runtime.h>
#include <hip/hip_cooperative_groups.h>
#include <cstdio>
#include <cstdint>
namespace cg = cooperative_groups;

#ifndef ONE_LAUNCH
#define ONE_LAUNCH 1
#endif

typedef unsigned short bf16_t;
#define DEV __device__ __forceinline__

constexpr int D = 1024;
constexpr int NCTX = 4096;
constexpr int NLAT = 8192;
constexpr int M = NCTX + NLAT;
constexpr int PW = 7680;
constexpr int C_RQ = 0, C_RK = 512, C_RV = 1024, C_RG = 2048, C_LX = 3072, C_LG = 4096,
              C_AQ = 5120, C_AK = 6144, C_AV = 6400, C_AG = 6656;
constexpr float EPS = 1e-6f;

constexpr size_t O_YP = 0, O_YS = 4194304, O_NK = 12582912, O_NV = 14680064, O_NRET = 16777216, O_NLRU = 25165824;

constexpr size_t OFF_MOD  = 0;
constexpr size_t OFF_LRUW = 122880;
constexpr size_t OFF_WBR  = OFF_LRUW + 1048576;
constexpr size_t OFF_WOUT = OFF_WBR + 6291456;
constexpr size_t OFF_WMG  = OFF_WOUT + 2097152;
constexpr size_t OFF_H    = OFF_WMG + 6291456;
constexpr size_t OFF_P    = OFF_H + (size_t)M * 1024 * 2;
constexpr size_t OFF_W1T  = OFF_P + (size_t)M * PW * 2;
constexpr size_t OFF_OFTMP = OFF_W1T;
constexpr size_t OFF_LRUC = 262266880;
constexpr size_t WS_NEED  = OFF_LRUC + (size_t)2 * 192 * 2 * 1024 * 4;
static_assert(OFF_OFTMP + (size_t)M * 1024 * 2 <= OFF_LRUC, "overlap");
static_assert(WS_NEED <= 268435456, "ws budget");

struct Params {
    const float *x_prompt, *x_sample, *cache_k, *cache_v, *state_ret, *state_lru, *c, *c_ctx,
                *w_ada, *b_ada, *norm_pre, *norm_post, *w_in, *ret_decay, *conv_w, *conv_b,
                *lru_wa, *lru_ba, *lru_wx, *lru_bx, *lru_lambda, *att_sink, *w_branch, *w_merge, *b_merge, *w_out;
    float* out;
    unsigned char* ws;
};

DEV float bf2f(bf16_t v) { return __uint_as_float(((unsigned)v) << 16); }
DEV bf16_t f2bf(float f) { unsigned u = __float_as_uint(f); u += 0x7fffu + ((u >> 16) & 1u); return (bf16_t)(u >> 16); }
DEV float siluf(float x) { return x / (1.f + __expf(-x)); }
DEV float sigmf(float x) { return 1.f / (1.f + __expf(-x)); }
DEV float softplusf(float x) { return fmaxf(x, 0.f) + log1pf(__expf(-fabsf(x))); }

DEV float* ws_mod(const Params& p) { return (float*)(p.ws + OFF_MOD); }
DEV bf16_t* ws_bf(const Params& p, size_t off) { return (bf16_t*)(p.ws + off); }

DEV const float* x_row(const Params& p, int l, int m) {
    const float* xp = p.x_prompt; const float* xs = p.x_sample; const float* po = p.out;
    if (l == 0) return m < NCTX ? xp + (size_t)m * D : xs + (size_t)(m - NCTX) * D;
    return po + (size_t)m * D;
}
DEV int cond_row(int m) { return m < NCTX ? 0 : 1 + ((m - NCTX) >> 11); }

DEV float wave_sum(float v) {
#pragma unroll
    for (int o = 1; o < 64; o <<= 1) v += __shfl_xor(v, o);
    return v;
}
DEV float block_sum(float v, float* red) {
    v = wave_sum(v);
    __syncthreads();
    if ((threadIdx.x & 63) == 0) red[threadIdx.x >> 6] = v;
    __syncthreads();
    return (red[0] + red[1]) + (red[2] + red[3]);
}

DEV float dot_bf16(const bf16_t* a, const bf16_t* b, int K) {
    float acc = 0.f;
    const uint4* a4 = (const uint4*)a; const uint4* b4 = (const uint4*)b;
    for (int i = 0; i < K / 8; ++i) {
        uint4 x = a4[i], y = b4[i];
        unsigned xs[4] = {x.x, x.y, x.z, x.w}, ys[4] = {y.x, y.y, y.z, y.w};
#pragma unroll
        for (int j = 0; j < 4; ++j) {
            acc += __uint_as_float(xs[j] << 16) * __uint_as_float(ys[j] << 16);
            acc += __uint_as_float(xs[j] & 0xffff0000u) * __uint_as_float(ys[j] & 0xffff0000u);
        }
    }
    return acc;
}

DEV void phase_mod(const Params& p) {
    float* mod = ws_mod(p);
    const int gt = blockIdx.x * blockDim.x + threadIdx.x, gs = gridDim.x * blockDim.x;
    for (int idx = gt; idx < 2 * 5 * 3072; idx += gs) {
        const int j = idx % 3072, r = (idx / 3072) % 5, l = idx / 15360;
        const float* cctx = p.c_ctx; const float* cb = p.c;
        const float* cond = r == 0 ? cctx : cb + (r - 1) * D;
        const float* w = p.w_ada + (size_t)l * D * 3072 + j;
        float acc = p.b_ada[l * 3072 + j];
        for (int k = 0; k < D; ++k) acc += siluf(cond[k]) * w[(size_t)k * 3072];
        mod[idx] = acc;
    }
}

DEV void transpose_tile(const float* src, int K, int N, bf16_t* dst, int k0, int n0, float* tile) {
    const int tid = threadIdx.x;
#pragma unroll 4
    for (int i = 0; i < 16; ++i) {
        const int r = i * 4 + (tid >> 6), c = tid & 63;
        tile[r * 65 + c] = src[(size_t)(k0 + r) * N + n0 + c];
    }
    __syncthreads();
#pragma unroll 4
    for (int i = 0; i < 16; ++i) {
        const int n = i * 4 + (tid >> 6), k = tid & 63;
        dst[(size_t)(n0 + n) * K + k0 + k] = f2bf(tile[k * 65 + n]);
    }
    __syncthreads();
}
DEV void phase_convert(const Params& p, int l, float* tile) {
    constexpr int T_IN = 16 * 120, T_MG = 16 * 48, T_BR = 3 * 256, T_OUT = 256, T_LRU = 32 * 4;
    constexpr int TOT = T_IN + T_MG + T_BR + T_OUT + T_LRU;
    for (int it = blockIdx.x; it < TOT; it += gridDim.x) {
        int r = it;
        if (r < T_IN) { transpose_tile(p.w_in + (size_t)l * D * PW, D, PW, ws_bf(p, OFF_W1T), (r / 120) * 64, (r % 120) * 64, tile); continue; }
        r -= T_IN;
        if (r < T_MG) { transpose_tile(p.w_merge + (size_t)l * D * 3072, D, 3072, ws_bf(p, OFF_WMG), (r / 48) * 64, (r % 48) * 64, tile); continue; }
        r -= T_MG;
        if (r < T_BR) { const int nb = r / 256, q = r % 256;
            transpose_tile(p.w_branch + ((size_t)l * 3 + nb) * D * D, D, D, ws_bf(p, OFF_WBR) + (size_t)nb * D * D, (q / 16) * 64, (q % 16) * 64, tile); continue; }
        r -= T_BR;
        if (r < T_OUT) { transpose_tile(p.w_out + (size_t)l * D * D, D, D, ws_bf(p, OFF_WOUT), (r / 16) * 64, (r % 16) * 64, tile); continue; }
        r -= T_OUT;
        {
            const int mat = r / 4, q = r % 4;
            const int dir = mat >> 4, gate = (mat >> 3) & 1, blk = mat & 7;
            const float* wa_ = p.lru_wa; const float* wx_ = p.lru_wx;
            const float* src = (gate ? wx_ : wa_) + (((size_t)l * 2 + dir) * 8 + blk) * 128 * 128;
            transpose_tile(src, 128, 128, ws_bf(p, OFF_LRUW) + (size_t)mat * 128 * 128, (q >> 1) * 64, (q & 1) * 64, tile);
        }
    }
}

DEV void prenorm_row(const Params& p, int l, int m, float4 v, float* red) {
    const int tid = threadIdx.x;
    const float ss = block_sum(v.x * v.x + v.y * v.y + v.z * v.z + v.w * v.w, red);
    const float rstd = rsqrtf(ss * (1.f / D) + EPS);
    const float* mod = ws_mod(p) + (size_t)(l * 5 + cond_row(m)) * 3072;
    const float4 g = ((const float4*)(p.norm_pre + l * D))[tid];
    const float4 sh = ((const float4*)mod)[tid];
    const float4 sc = ((const float4*)(mod + 1024))[tid];
    bf16_t* h = ws_bf(p, OFF_H) + (size_t)m * D + tid * 4;
    ushort4 o;
    o.x = f2bf(v.x * rstd * g.x * (1.f + sc.x) + sh.x);
    o.y = f2bf(v.y * rstd * g.y * (1.f + sc.y) + sh.y);
    o.z = f2bf(v.z * rstd * g.z * (1.f + sc.z) + sh.z);
    o.w = f2bf(v.w * rstd * g.w * (1.f + sc.w) + sh.w);
    *(ushort4*)h = o;
}
DEV void phase_prenorm(const Params& p, int l, float* red) {
    for (int m = blockIdx.x; m < M; m += gridDim.x) {
        const float4 v = ((const float4*)x_row(p, l, m))[threadIdx.x];
        prenorm_row(p, l, m, v, red);
    }
}

DEV int rope_partner(int n) {
    if (n < 1024) return ((n >> 5) & 1) ? n - 32 : n + 32;
    return (((n - C_AQ) >> 4) & 1) ? n - 16 : n + 16;
}
DEV bool rope_col(int n) { return n < 1024 || (n >= C_AQ && n < C_AV); }
DEV void p2_store(const Params& p, int l, int m, int n, float v, float partner) {
    const bool lat = m >= NCTX;
    const int t = lat ? ((m - NCTX) & 2047) : (m & 255);
    bf16_t* P = ws_bf(p, OFF_P) + (size_t)m * PW;
    float o = v;
    if (n < 1024) {
        if (lat) {
            const int d = n & 127, c = d & 31, a = d >> 6, b = (d >> 5) & 1;
            const float pos = (float)(a ? (t & 63) : (t >> 6));
            const float inv = powf(10000.f, -(float)c / 32.f);
            float sn, cs; sincosf(pos * inv, &sn, &cs);
            o = b ? v * cs + partner * sn : v * cs - partner * sn;
        }
        if (n < 512) o *= 0.08838834764831845f;
    } else if (n < C_RG) {
    } else if (n < C_LX) { o = siluf(v);
    } else if (n < C_LG) {
    } else if (n < C_AQ) { o = siluf(v);
    } else if (n < C_AV) {
        if (lat) {
            const int d = (n - C_AQ) & 63, c = d & 15, a = d >> 5, b = (d >> 4) & 1;
            const float pos = (float)(a ? (t & 63) : (t >> 6));
            const float inv = powf(10000.f, -(float)c / 16.f);
            float sn, cs; sincosf(pos * inv, &sn, &cs);
            o = b ? v * cs + partner * sn : v * cs - partner * sn;
        } else if (n >= C_AK) {
            p.out[O_NK + ((size_t)((m >> 8) * 2 + l) * 256 + t) * 256 + (n - C_AK)] = v;
        }
        if (n < C_AK) o *= 0.125f;
    } else if (n < C_AG) {
        if (!lat) p.out[O_NV + ((size_t)((m >> 8) * 2 + l) * 256 + t) * 256 + (n - C_AV)] = v;
    } else { o = siluf(v); }
    P[n] = f2bf(o);
}

DEV void phase_gemm1_naive(const Params& p, int l) {
    const bf16_t* H = ws_bf(p, OFF_H); const bf16_t* W = ws_bf(p, OFF_W1T);
    const size_t gt = (size_t)blockIdx.x * blockDim.x + threadIdx.x, gs = (size_t)gridDim.x * blockDim.x;
    for (size_t idx = gt; idx < (size_t)M * PW; idx += gs) {
        const int n = (int)(idx % PW), m = (int)(idx / PW);
        const float v = dot_bf16(H + (size_t)m * D, W + (size_t)n * D, D);
        float pr = 0.f;
        if (m >= NCTX && rope_col(n)) pr = dot_bf16(H + (size_t)m * D, W + (size_t)rope_partner(n) * D, D);
        p2_store(p, l, m, n, v, pr);
    }
}

DEV void phase_attn_naive(const Params& p, int l) {
    bf16_t* Pb = ws_bf(p, OFF_P);
    const int gt = blockIdx.x * blockDim.x + threadIdx.x, gs = gridDim.x * blockDim.x;
    for (int idx = gt; idx < M * 16; idx += gs) {
        const int m = idx >> 4, hq = idx & 15, hk = hq >> 2;
        const bool lat = m >= NCTX;
        float q[64], acc[64];
        bf16_t* qp = Pb + (size_t)m * PW + C_AQ + hq * 64;
#pragma unroll
        for (int d = 0; d < 64; ++d) { q[d] = bf2f(qp[d]); acc[d] = 0.f; }
        float mx = p.att_sink[l * 16 + hq], den = 1.f;
        int k_lo, k_hi;
        if (!lat) { k_lo = m & ~255; k_hi = k_lo + 255; }
        else { const int mm = m - NCTX, s0 = NCTX + (mm & ~2047), t = mm & 2047;
               k_lo = s0 + max(t - 128, 0); k_hi = s0 + min(t + 128, 2047); }
        for (int kr = k_lo; kr <= k_hi; ++kr) {
            const bf16_t* kp = Pb + (size_t)kr * PW + C_AK + hk * 64;
            const bf16_t* vp = Pb + (size_t)kr * PW + C_AV + hk * 64;
            float s = 0.f;
#pragma unroll
            for (int d = 0; d < 64; ++d) s += q[d] * bf2f(kp[d]);
            if (s > mx) { const float sc = __expf(mx - s); den *= sc;
#pragma unroll
                for (int d = 0; d < 64; ++d) acc[d] *= sc;
                mx = s; }
            const float pe = __expf(s - mx); den += pe;
#pragma unroll
            for (int d = 0; d < 64; ++d) acc[d] += pe * bf2f(vp[d]);
        }
        if (lat) {
            const int b = (m - NCTX) >> 11;
            for (int j = 0; j < 256; ++j) {
                const float* kp = p.cache_k + ((size_t)((b * 2 + l) * 256 + j) * 4 + hk) * 64;
                const float* vp = p.cache_v + ((size_t)((b * 2 + l) * 256 + j) * 4 + hk) * 64;
                float s = 0.f;
#pragma unroll
                for (int d = 0; d < 64; ++d) s += q[d] * kp[d];
                if (s > mx) { const float sc = __expf(mx - s); den *= sc;
#pragma unroll
                    for (int d = 0; d < 64; ++d) acc[d] *= sc;
                    mx = s; }
                const float pe = __expf(s - mx); den += pe;
#pragma unroll
                for (int d = 0; d < 64; ++d) acc[d] += pe * vp[d];
            }
        }
        const float rd = 1.f / den;
        const bf16_t* gp = Pb + (size_t)m * PW + C_AG + hq * 64;
#pragma unroll
        for (int d = 0; d < 64; ++d) qp[d] = f2bf(acc[d] * rd * bf2f(gp[d]));
    }
}

DEV void phase_ret_naive(const Params& p, int l, float* red) {
    bf16_t* Pb = ws_bf(p, OFF_P);
    bf16_t* tmp = ws_bf(p, OFF_OFTMP);
    const int dv = threadIdx.x;
    for (int item = blockIdx.x; item < 80; item += gridDim.x) {
        const int seq = item >> 2, h = item & 3;
        const bool lat = seq >= 16;
        const int b = lat ? seq - 16 : seq;
        const int row0 = lat ? NCTX + b * 2048 : b * 256;
        const int L = lat ? 2048 : 256;
        for (int dir = 0; dir < 2; ++dir) {
            const float g = 1.f / (1.f + __expf(-p.ret_decay[(l * 2 + dir) * 4 + h]));
            float S[128];
            if (lat) {
                const float* s0 = p.state_ret + ((((size_t)b * 2 + l) * 2 + dir) * 4 + h) * 128 * 256 + dv;
#pragma unroll
                for (int j = 0; j < 128; ++j) S[j] = s0[(size_t)j * 256];
            } else {
#pragma unroll
                for (int j = 0; j < 128; ++j) S[j] = 0.f;
            }
            for (int s = 0; s < L; ++s) {
                const int t = dir == 0 ? s : L - 1 - s;
                const int m = row0 + t;
                const bf16_t* row = Pb + (size_t)m * PW;
                const float v = bf2f(row[C_RV + h * 256 + dv]);
                const uint4* k4 = (const uint4*)(row + C_RK + h * 128);
                const uint4* q4 = (const uint4*)(row + C_RQ + h * 128);
                float o = 0.f;
#pragma unroll
                for (int jj = 0; jj < 16; ++jj) {
                    const uint4 kk = k4[jj], qq = q4[jj];
                    const unsigned ks[4] = {kk.x, kk.y, kk.z, kk.w}, qs[4] = {qq.x, qq.y, qq.z, qq.w};
#pragma unroll
                    for (int e = 0; e < 4; ++e) {
                        const int j = jj * 8 + e * 2;
                        S[j] = g * S[j] + __uint_as_float(ks[e] << 16) * v;
                        o += __uint_as_float(qs[e] << 16) * S[j];
                        S[j + 1] = g * S[j + 1] + __uint_as_float(ks[e] & 0xffff0000u) * v;
                        o += __uint_as_float(qs[e] & 0xffff0000u) * S[j + 1];
                    }
                }
                if (dir == 0) {
                    tmp[(size_t)m * D + h * 256 + dv] = f2bf(o);
                } else {
                    o += bf2f(tmp[(size_t)m * D + h * 256 + dv]);
                    const float mu = block_sum(o, red) * (1.f / 256.f);
                    const float xc = o - mu;
                    const float var = block_sum(xc * xc, red) * (1.f / 256.f);
                    const float y = xc * rsqrtf(var + EPS);
                    bf16_t* gp = Pb + (size_t)m * PW + C_RG + h * 256 + dv;
                    *gp = f2bf(y * bf2f(*gp));
                }
            }
            if (!lat) {
                float* so = p.out + O_NRET + ((((size_t)b * 2 + l) * 2 + dir) * 4 + h) * 128 * 256 + dv;
#pragma unroll
                for (int j = 0; j < 128; ++j) so[(size_t)j * 256] = S[j];
            }
        }
    }
}

DEV void lru_tile_naive(const Params& p, int l, int gc, int blk, int mode, float* lds) {
    float* lxc = lds; float* hs = lds + 64 * 128;
    bf16_t* Pb = ws_bf(p, OFF_P);
    const int tid = threadIdx.x;
    const int m0 = gc * 64;
    const bool lat = m0 >= NCTX;
    const int L = lat ? 2048 : 256;
    const int t0 = lat ? ((m0 - NCTX) & 2047) : (m0 & 255);
    for (int e = tid; e < 64 * 128; e += 256) {
        const int tt = e >> 7, c = e & 127, ch = blk * 128 + c;
        float acc = p.conv_b[l * D + ch];
#pragma unroll
        for (int j = 0; j < 4; ++j) {
            const int tp = t0 + tt + j - 1;
            if (tp >= 0 && tp < L) acc += p.conv_w[(l * 4 + j) * D + ch] * bf2f(Pb[(size_t)(m0 + tt + j - 1) * PW + C_LX + ch]);
        }
        lxc[e] = acc; hs[e] = 0.f;
    }
    __syncthreads();
    const int c = tid & 127, dir = tid >> 7, ch = blk * 128 + c;
    const bf16_t* Wa = ws_bf(p, OFF_LRUW) + ((size_t)((dir * 2 + 0) * 8 + blk) * 128 + c) * 128;
    const bf16_t* Wx = ws_bf(p, OFF_LRUW) + ((size_t)((dir * 2 + 1) * 8 + blk) * 128 + c) * 128;
    const float ba = p.lru_ba[(l * 2 + dir) * D + ch], bx = p.lru_bx[(l * 2 + dir) * D + ch];
    const float sp = softplusf(-p.lru_lambda[(l * 2 + dir) * D + ch]);
    float* LA = (float*)(p.ws + OFF_LRUC);
    float* LH = LA + 192 * 2 * 1024;
    const size_t ci = ((size_t)gc * 2 + dir) * 1024 + ch;
    float h = mode ? LH[ci] : 0.f, A = 1.f;
    for (int s = 0; s < 64; ++s) {
        const int tt = dir == 0 ? s : 63 - s;
        float r = ba, ig = bx;
        for (int j = 0; j < 128; ++j) { const float x = lxc[tt * 128 + j]; r += x * bf2f(Wa[j]); ig += x * bf2f(Wx[j]); }
        r = sigmf(r); ig = sigmf(ig);
        const float log_a = -8.f * r * sp;
        const float a = __expf(log_a);
        const float u = sqrtf(-expm1f(2.f * log_a)) * (ig * lxc[tt * 128 + c]);
        h = a * h + u; A *= a;
        if (mode) atomicAdd(&hs[tt * 128 + c], h);
    }
    if (!mode) { LA[ci] = A; LH[ci] = h; }
    else if (!lat) {
        const int b = m0 >> 8;
        if (dir == 0 && t0 == 192) p.out[O_NLRU + ((size_t)(b * 2 + l) * 2 + 0) * 1024 + ch] = h;
        if (dir == 1 && t0 == 0)   p.out[O_NLRU + ((size_t)(b * 2 + l) * 2 + 1) * 1024 + ch] = h;
    }
    __syncthreads();
    if (mode) {
        for (int e = tid; e < 64 * 128; e += 256) {
            const int tt = e >> 7, cc = e & 127;
            bf16_t* gp = Pb + (size_t)(m0 + tt) * PW + C_LG + blk * 128 + cc;
            *gp = f2bf(hs[e] * bf2f(*gp));
        }
    }
    __syncthreads();
}
DEV void phase_lru_tiles_naive(const Params& p, int l, int mode, float* lds) {
    for (int it = blockIdx.x; it < 192 * 8; it += gridDim.x) lru_tile_naive(p, l, it >> 3, it & 7, mode, lds);
}
DEV void phase_lru_carry(const Params& p, int l) {
    float* LA = (float*)(p.ws + OFF_LRUC);
    float* LH = LA + 192 * 2 * 1024;
    const int gt = blockIdx.x * blockDim.x + threadIdx.x, gs = gridDim.x * blockDim.x;
    for (int idx = gt; idx < 20 * 2 * 1024; idx += gs) {
        const int ch = idx & 1023, dir = (idx >> 10) & 1, seq = idx >> 11;
        const bool lat = seq >= 16;
        const int nch = lat ? 32 : 4;
        const int gc0 = lat ? 64 + (seq - 16) * 32 : seq * 4;
        float carry = lat ? p.state_lru[((size_t)((seq - 16) * 2 + l) * 2 + dir) * 1024 + ch] : 0.f;
        for (int s = 0; s < nch; ++s) {
            const int cidx = dir == 0 ? s : nch - 1 - s;
            const size_t ci = ((size_t)(gc0 + cidx) * 2 + dir) * 1024 + ch;
            const float A = LA[ci], Hh = LH[ci];
            LH[ci] = carry;
            carry = A * carry + Hh;
        }
    }
}

DEV void phase_merge_naive(const Params& p, int l) {
    bf16_t* Pb = ws_bf(p, OFF_P);
    const bf16_t* H = ws_bf(p, OFF_H);
    const int gt = blockIdx.x * blockDim.x + threadIdx.x, gs = gridDim.x * blockDim.x;
    for (int idx = gt; idx < M * D; idx += gs) {
        const int m = idx >> 10, d = idx & 1023;
        float tot = 0.f;
        for (int nb = 0; nb < 3; ++nb) {
            const float gl = dot_bf16(H + (size_t)m * D, ws_bf(p, OFF_WMG) + (size_t)(nb * D + d) * D, D) + p.b_merge[l * 3072 + nb * D + d];
            const float z = dot_bf16(Pb + (size_t)m * PW + (nb == 0 ? C_RG : nb == 1 ? C_LG : C_AQ), ws_bf(p, OFF_WBR) + ((size_t)nb * D + d) * D, D);
            tot += sigmf(gl) * z;
        }
        Pb[(size_t)m * PW + d] = f2bf(tot);
    }
}
DEV void phase_out_naive(const Params& p, int l) {
    bf16_t* Pb = ws_bf(p, OFF_P);
    const int gt = blockIdx.x * blockDim.x + threadIdx.x, gs = gridDim.x * blockDim.x;
    for (int idx = gt; idx < M * D; idx += gs) {
        const int m = idx >> 10, d = idx & 1023;
        const float v = dot_bf16(Pb + (size_t)m * PW, ws_bf(p, OFF_WOUT) + (size_t)d * D, D);
        ((float*)(Pb + (size_t)m * PW + 1024))[d] = v;
    }
}
DEV void phase_post(const Params& p, int l, float* red) {
    const int tid = threadIdx.x;
    for (int m = blockIdx.x; m < M; m += gridDim.x) {
        const float4 o = ((const float4*)(ws_bf(p, OFF_P) + (size_t)m * PW + 1024))[tid];
        const float ss = block_sum(o.x * o.x + o.y * o.y + o.z * o.z + o.w * o.w, red);
        const float rstd = rsqrtf(ss * (1.f / D) + EPS);
        const float4 x = ((const float4*)x_row(p, l, m))[tid];
        const float4 g = ((const float4*)(p.norm_post + l * D))[tid];
        const float4 gate = ((const float4*)(ws_mod(p) + (size_t)(l * 5 + cond_row(m)) * 3072 + 2048))[tid];
        float4 y;
        y.x = x.x + gate.x * (o.x * rstd * g.x);
        y.y = x.y + gate.y * (o.y * rstd * g.y);
        y.z = x.z + gate.z * (o.z * rstd * g.z);
        y.w = x.w + gate.w * (o.w * rstd * g.w);
        ((float4*)(p.out + (size_t)m * D))[tid] = y;
        if (l == 0) prenorm_row(p, 1, m, y, red);
    }
}

enum { PH_INIT = 0, PH_PRENORM, PH_GEMM1, PH_MIX1, PH_MIX2, PH_MIX3, PH_MERGE, PH_OUT, PH_POST, PH_COUNT };

DEV void run_phase(const Params& p, int ph, int l, float* lds) {
    switch (ph) {
    case PH_INIT:    phase_mod(p); phase_convert(p, 0, lds); break;
    case PH_PRENORM: phase_prenorm(p, l, lds); break;
    case PH_GEMM1:   phase_gemm1_naive(p, l); break;
    case PH_MIX1:    phase_attn_naive(p, l); phase_lru_tiles_naive(p, l, 0, lds); break;
    case PH_MIX2:    phase_lru_carry(p, l); phase_ret_naive(p, l, lds); break;
    case PH_MIX3:    phase_lru_tiles_naive(p, l, 1, lds); break;
    case PH_MERGE:   phase_merge_naive(p, l); break;
    case PH_OUT:     phase_out_naive(p, l); break;
    case PH_POST:    phase_post(p, l, lds); if (l == 0) phase_convert(p, 1, lds); break;
    }
}

#if !ONE_LAUNCH
__global__ void __launch_bounds__(256, 2) phase_kernel(Params p, int ph, int l) {
    __shared__ __attribute__((aligned(16))) float lds[16384];
    run_phase(p, ph, l, lds);
}
#endif

#if ONE_LAUNCH
__global__ void __launch_bounds__(256, 1) mega_kernel(Params p) {
    __shared__ __attribute__((aligned(16))) float lds[16384];
    cg::grid_group grid = cg::this_grid();
    run_phase(p, PH_INIT, 0, lds); grid.sync();
    run_phase(p, PH_PRENORM, 0, lds); grid.sync();
    for (int l = 0; l < 2; ++l) {
        for (int ph = PH_GEMM1; ph <= PH_POST; ++ph) {
            run_phase(p, ph, l, lds);
            if (!(l == 1 && ph == PH_POST)) grid.sync();
        }
    }
}
#endif

extern "C" void kernel_launch(void* const* d_in, const int* in_sizes, int n_in,
                              void* d_out, int out_size, void* d_ws, size_t ws_size,
                              hipStream_t stream) {
    static int grid_blocks = 0;
    if (grid_blocks == 0) {
        if (n_in != 26 || ws_size < WS_NEED || out_size != 25231360) {
            fprintf(stderr, "kernel_launch: unexpected n_in %d / ws_size %zu (need %zu) / out_size %d\n", n_in, ws_size, (size_t)WS_NEED, out_size);
            grid_blocks = -1; return;
        }
        int dev = 0, cus = 0, per_cu = 0;
        hipGetDevice(&dev);
        hipDeviceGetAttribute(&cus, hipDeviceAttributeMultiprocessorCount, dev);
#if ONE_LAUNCH
        hipOccupancyMaxActiveBlocksPerMultiprocessor(&per_cu, (const void*)mega_kernel, 256, 0);
#else
        hipOccupancyMaxActiveBlocksPerMultiprocessor(&per_cu, (const void*)phase_kernel, 256, 0);
#endif
        if (per_cu < 1) per_cu = 1;
#if ONE_LAUNCH
        if (per_cu > 1) per_cu = 1;
#else
        if (per_cu > 2) per_cu = 2;
#endif
        grid_blocks = cus * per_cu;
    }
    if (grid_blocks < 0) return;
    Params p{};
    const float** pp = (const float**)&p;
    for (int i = 0; i < 26; ++i) pp[i] = (const float*)d_in[i];
    p.out = (float*)d_out;
    p.ws = (unsigned char*)d_ws;
#if ONE_LAUNCH
    void* args[] = {&p};
    hipError_t e = hipLaunchCooperativeKernel((const void*)mega_kernel, dim3(grid_blocks), dim3(256), args, 0, stream);
    if (e != hipSuccess) fprintf(stderr, "cooperative launch failed: %s (grid %d)\n", hipGetErrorString(e), grid_blocks);
#else
    phase_kernel<<<grid_blocks, 256, 0, stream>>>(p, PH_INIT, 0);
    phase_kernel<<<grid_blocks, 256, 0, stream>>>(p, PH_PRENORM, 0);
    for (int l = 0; l < 2; ++l)
        for (int ph = PH_GEMM1; ph <= PH_POST; ++ph)
            phase_kernel<<<grid_blocks, 256, 0, stream>>>(p, ph, l);
#endif
}
```

```cpp
#include <hip/hip_runtime.h>
#include <hip/hip_cooperative_groups.h>
#include <cstdio>
#include <cstdint>
namespace cg = cooperative_groups;

#ifndef ONE_LAUNCH
#define ONE_LAUNCH 1
#endif

typedef unsigned short bf16_t;
#define DEV __device__ __forceinline__

constexpr int D = 1024;
constexpr int NCTX = 4096;
constexpr int NLAT = 8192;
constexpr int M = NCTX + NLAT;
constexpr int PW = 7680;
constexpr int C_RQ = 0, C_RK = 512, C_RV = 1024, C_RG = 2048, C_LX = 3072, C_LG = 4096,
              C_AQ = 5120, C_AK = 6144, C_AV = 6400, C_AG = 6656;
constexpr float EPS = 1e-6f;

constexpr size_t O_YP = 0, O_YS = 4194304, O_NK = 12582912, O_NV = 14680064, O_NRET = 16777216, O_NLRU = 25165824;

constexpr size_t OFF_MOD  = 0;
constexpr size_t OFF_LRUW = 122880;
constexpr size_t OFF_WBR  = OFF_LRUW + 1048576;
constexpr size_t OFF_WOUT = OFF_WBR + 6291456;
constexpr size_t OFF_WMG  = OFF_WOUT + 2097152;
constexpr size_t OFF_H    = OFF_WMG + 6291456;
constexpr size_t OFF_P    = OFF_H + (size_t)M * 1024 * 2;
constexpr size_t OFF_W1T  = OFF_P + (size_t)M * PW * 2;
constexpr size_t OFF_OFTMP = OFF_W1T;
constexpr size_t OFF_LRUC = 262266880;
constexpr size_t OFF_ROPE = OFF_LRUC + (size_t)2 * 192 * 2 * 1024 * 4;
constexpr size_t WS_NEED  = OFF_ROPE + (size_t)2048 * 96 * 8;
static_assert(OFF_OFTMP + (size_t)M * 1024 * 2 <= OFF_LRUC, "overlap");
static_assert(WS_NEED <= 268435456, "ws budget");

struct Params {
    const float *x_prompt, *x_sample, *cache_k, *cache_v, *state_ret, *state_lru, *c, *c_ctx,
                *w_ada, *b_ada, *norm_pre, *norm_post, *w_in, *ret_decay, *conv_w, *conv_b,
                *lru_wa, *lru_ba, *lru_wx, *lru_bx, *lru_lambda, *att_sink, *w_branch, *w_merge, *b_merge, *w_out;
    float* out;
    unsigned char* ws;
};

DEV float bf2f(bf16_t v) { return __uint_as_float(((unsigned)v) << 16); }
DEV bf16_t f2bf(float f) { unsigned u = __float_as_uint(f); u += 0x7fffu + ((u >> 16) & 1u); return (bf16_t)(u >> 16); }
DEV float siluf(float x) { return x / (1.f + __expf(-x)); }
DEV float sigmf(float x) { return 1.f / (1.f + __expf(-x)); }
DEV float softplusf(float x) { return fmaxf(x, 0.f) + log1pf(__expf(-fabsf(x))); }

DEV float* ws_mod(const Params& p) { return (float*)(p.ws + OFF_MOD); }
DEV bf16_t* ws_bf(const Params& p, size_t off) { return (bf16_t*)(p.ws + off); }

DEV const float* x_row(const Params& p, int l, int m) {
    const float* xp = p.x_prompt; const float* xs = p.x_sample; const float* po = p.out;
    if (l == 0) return m < NCTX ? xp + (size_t)m * D : xs + (size_t)(m - NCTX) * D;
    return po + (size_t)m * D;
}
DEV int cond_row(int m) { return m < NCTX ? 0 : 1 + ((m - NCTX) >> 11); }

DEV float wave_sum(float v) {
#pragma unroll
    for (int o = 1; o < 64; o <<= 1) v += __shfl_xor(v, o);
    return v;
}
DEV float block_sum(float v, float* red) {
    v = wave_sum(v);
    __syncthreads();
    if ((threadIdx.x & 63) == 0) red[threadIdx.x >> 6] = v;
    __syncthreads();
    return (red[0] + red[1]) + (red[2] + red[3]);
}

DEV float dot_bf16(const bf16_t* a, const bf16_t* b, int K) {
    float acc = 0.f;
    const uint4* a4 = (const uint4*)a; const uint4* b4 = (const uint4*)b;
    for (int i = 0; i < K / 8; ++i) {
        uint4 x = a4[i], y = b4[i];
        unsigned xs[4] = {x.x, x.y, x.z, x.w}, ys[4] = {y.x, y.y, y.z, y.w};
#pragma unroll
        for (int j = 0; j < 4; ++j) {
            acc += __uint_as_float(xs[j] << 16) * __uint_as_float(ys[j] << 16);
            acc += __uint_as_float(xs[j] & 0xffff0000u) * __uint_as_float(ys[j] & 0xffff0000u);
        }
    }
    return acc;
}

DEV void phase_mod(const Params& p) {
    float* mod = ws_mod(p);
    const int gt = blockIdx.x * blockDim.x + threadIdx.x, gs = gridDim.x * blockDim.x;
    for (int idx = gt; idx < 2 * 5 * 3072; idx += gs) {
        const int j = idx % 3072, r = (idx / 3072) % 5, l = idx / 15360;
        const float* cctx = p.c_ctx; const float* cb = p.c;
        const float* cond = r == 0 ? cctx : cb + (r - 1) * D;
        const float* w = p.w_ada + (size_t)l * D * 3072 + j;
        float acc = p.b_ada[l * 3072 + j];
        for (int k = 0; k < D; ++k) acc += siluf(cond[k]) * w[(size_t)k * 3072];
        mod[idx] = acc;
    }
}

DEV void phase_rope_table(const Params& p) {
    float2* tab = (float2*)(p.ws + OFF_ROPE);
    const int gt = blockIdx.x * blockDim.x + threadIdx.x, gs = gridDim.x * blockDim.x;
    for (int idx = gt; idx < 2048 * 96; idx += gs) {
        const int t = idx / 96, e = idx % 96;
        int a, c; float nq;
        if (e < 64) { a = e >> 5; c = e & 31; nq = 32.f; } else { a = (e - 64) >> 4; c = (e - 64) & 15; nq = 16.f; }
        const float pos = (float)(a ? (t & 63) : (t >> 6));
        const float inv = powf(10000.f, -(float)c / nq);
        float sn, cs; sincosf(pos * inv, &sn, &cs);
        tab[idx] = make_float2(cs, sn);
    }
}

DEV void transpose_tile(const float* src, int K, int N, bf16_t* dst, int k0, int n0, float* tile) {
    const int tid = threadIdx.x;
#pragma unroll 4
    for (int i = 0; i < 16; ++i) {
        const int r = i * 4 + (tid >> 6), c = tid & 63;
        tile[r * 65 + c] = src[(size_t)(k0 + r) * N + n0 + c];
    }
    __syncthreads();
#pragma unroll 4
    for (int i = 0; i < 16; ++i) {
        const int n = i * 4 + (tid >> 6), k = tid & 63;
        dst[(size_t)(n0 + n) * K + k0 + k] = f2bf(tile[k * 65 + n]);
    }
    __syncthreads();
}
DEV void phase_convert(const Params& p, int l, float* tile) {
    constexpr int T_IN = 16 * 120, T_MG = 16 * 48, T_BR = 3 * 256, T_OUT = 256, T_LRU = 32 * 4;
    constexpr int TOT = T_IN + T_MG + T_BR + T_OUT + T_LRU;
    for (int it = blockIdx.x; it < TOT; it += gridDim.x) {
        int r = it;
        if (r < T_IN) { transpose_tile(p.w_in + (size_t)l * D * PW, D, PW, ws_bf(p, OFF_W1T), (r / 120) * 64, (r % 120) * 64, tile); continue; }
        r -= T_IN;
        if (r < T_MG) { transpose_tile(p.w_merge + (size_t)l * D * 3072, D, 3072, ws_bf(p, OFF_WMG), (r / 48) * 64, (r % 48) * 64, tile); continue; }
        r -= T_MG;
        if (r < T_BR) { const int nb = r / 256, q = r % 256;
            transpose_tile(p.w_branch + ((size_t)l * 3 + nb) * D * D, D, D, ws_bf(p, OFF_WBR) + (size_t)nb * D * D, (q / 16) * 64, (q % 16) * 64, tile); continue; }
        r -= T_BR;
        if (r < T_OUT) { transpose_tile(p.w_out + (size_t)l * D * D, D, D, ws_bf(p, OFF_WOUT), (r / 16) * 64, (r % 16) * 64, tile); continue; }
        r -= T_OUT;
        {
            const int mat = r / 4, q = r % 4;
            const int dir = mat >> 4, gate = (mat >> 3) & 1, blk = mat & 7;
            const float* wa_ = p.lru_wa; const float* wx_ = p.lru_wx;
            const float* src = (gate ? wx_ : wa_) + (((size_t)l * 2 + dir) * 8 + blk) * 128 * 128;
            transpose_tile(src, 128, 128, ws_bf(p, OFF_LRUW) + (size_t)mat * 128 * 128, (q >> 1) * 64, (q & 1) * 64, tile);
        }
    }
}

DEV void prenorm_row(const Params& p, int l, int m, float4 v, float* red) {
    const int tid = threadIdx.x;
    const float ss = block_sum(v.x * v.x + v.y * v.y + v.z * v.z + v.w * v.w, red);
    const float rstd = rsqrtf(ss * (1.f / D) + EPS);
    const float* mod = ws_mod(p) + (size_t)(l * 5 + cond_row(m)) * 3072;
    const float4 g = ((const float4*)(p.norm_pre + l * D))[tid];
    const float4 sh = ((const float4*)mod)[tid];
    const float4 sc = ((const float4*)(mod + 1024))[tid];
    bf16_t* h = ws_bf(p, OFF_H) + (size_t)m * D + tid * 4;
    ushort4 o;
    o.x = f2bf(v.x * rstd * g.x * (1.f + sc.x) + sh.x);
    o.y = f2bf(v.y * rstd * g.y * (1.f + sc.y) + sh.y);
    o.z = f2bf(v.z * rstd * g.z * (1.f + sc.z) + sh.z);
    o.w = f2bf(v.w * rstd * g.w * (1.f + sc.w) + sh.w);
    *(ushort4*)h = o;
}
DEV void phase_prenorm(const Params& p, int l, float* red) {
    for (int m = blockIdx.x; m < M; m += gridDim.x) {
        const float4 v = ((const float4*)x_row(p, l, m))[threadIdx.x];
        prenorm_row(p, l, m, v, red);
    }
}

DEV int rope_partner(int n) {
    if (n < 1024) return ((n >> 5) & 1) ? n - 32 : n + 32;
    return (((n - C_AQ) >> 4) & 1) ? n - 16 : n + 16;
}
DEV bool rope_col(int n) { return n < 1024 || (n >= C_AQ && n < C_AV); }
DEV void p2_store(const Params& p, int l, int m, int n, float v, float partner) {
    const bool lat = m >= NCTX;
    const int t = lat ? ((m - NCTX) & 2047) : (m & 255);
    bf16_t* P = ws_bf(p, OFF_P) + (size_t)m * PW;
    float o = v;
    if (n < 1024) {
        if (lat) {
            const int d = n & 127, c = d & 31, a = d >> 6, b = (d >> 5) & 1;
            const float2 cssn = ((const float2*)(p.ws + OFF_ROPE))[t * 96 + a * 32 + c];
            o = b ? v * cssn.x + partner * cssn.y : v * cssn.x - partner * cssn.y;
        }
        if (n < 512) o *= 0.08838834764831845f;
    } else if (n < C_RG) {
    } else if (n < C_LX) { o = siluf(v);
    } else if (n < C_LG) {
    } else if (n < C_AQ) { o = siluf(v);
    } else if (n < C_AV) {
        if (lat) {
            const int d = (n - C_AQ) & 63, c = d & 15, a = d >> 5, b = (d >> 4) & 1;
            const float2 cssn = ((const float2*)(p.ws + OFF_ROPE))[t * 96 + 64 + a * 16 + c];
            o = b ? v * cssn.x + partner * cssn.y : v * cssn.x - partner * cssn.y;
        } else if (n >= C_AK) {
            p.out[O_NK + ((size_t)((m >> 8) * 2 + l) * 256 + t) * 256 + (n - C_AK)] = v;
        }
        if (n < C_AK) o *= 0.125f;
    } else if (n < C_AG) {
        if (!lat) p.out[O_NV + ((size_t)((m >> 8) * 2 + l) * 256 + t) * 256 + (n - C_AV)] = v;
    } else { o = siluf(v); }
    P[n] = f2bf(o);
}

DEV void phase_gemm1_naive(const Params& p, int l) {
    const bf16_t* H = ws_bf(p, OFF_H); const bf16_t* W = ws_bf(p, OFF_W1T);
    const size_t gt = (size_t)blockIdx.x * blockDim.x + threadIdx.x, gs = (size_t)gridDim.x * blockDim.x;
    for (size_t idx = gt; idx < (size_t)M * PW; idx += gs) {
        const int n = (int)(idx % PW), m = (int)(idx / PW);
        const float v = dot_bf16(H + (size_t)m * D, W + (size_t)n * D, D);
        float pr = 0.f;
        if (m >= NCTX && rope_col(n)) pr = dot_bf16(H + (size_t)m * D, W + (size_t)rope_partner(n) * D, D);
        p2_store(p, l, m, n, v, pr);
    }
}

typedef short bf16x8 __attribute__((ext_vector_type(8)));
typedef float f32x4 __attribute__((ext_vector_type(4)));

template <int FM, int FN>
DEV void gemm_mainloop(const bf16_t* __restrict__ A, int lda, const bf16_t* __restrict__ Bt, int ldb, int K,
                       f32x4 (&acc)[FM][FN], unsigned char* lds) {
    const int tid = threadIdx.x, lane = tid & 63, w = tid >> 6, wm = w >> 1, wn = w & 1;
    unsigned char* As = lds;
    unsigned char* Bs = lds + 2 * FM * 4096;
    const int srow = tid >> 3, sc = tid & 7;
    const bf16_t* ga = A + (size_t)srow * lda + sc * 8;
    const bf16_t* gb = Bt + (size_t)srow * ldb + sc * 8;
    const int woff = srow * 128 + ((sc ^ ((srow >> 1) & 7)) << 4);
    const int fsw = (lane >> 1) & 7;
    const int a_roff = (wm * 16 * FM + (lane & 15)) * 128;
    const int b_roff = (wn * 16 * FN + (lane & 15)) * 128;
    uint4 ra[FM], rb[FN];
#pragma unroll
    for (int i = 0; i < FM; ++i) ra[i] = *(const uint4*)(ga + (size_t)i * 32 * lda);
#pragma unroll
    for (int i = 0; i < FN; ++i) rb[i] = *(const uint4*)(gb + (size_t)i * 32 * ldb);
#pragma unroll
    for (int i = 0; i < FM; ++i) *(uint4*)(As + woff + i * 4096) = ra[i];
#pragma unroll
    for (int i = 0; i < FN; ++i) *(uint4*)(Bs + woff + i * 4096) = rb[i];
    __syncthreads();
    const int nk = K >> 6;
    for (int kt = 0; kt < nk; ++kt) {
        const int cur = kt & 1;
        if (kt + 1 < nk) {
            const int k0 = (kt + 1) << 6;
#pragma unroll
            for (int i = 0; i < FM; ++i) ra[i] = *(const uint4*)(ga + (size_t)i * 32 * lda + k0);
#pragma unroll
            for (int i = 0; i < FN; ++i) rb[i] = *(const uint4*)(gb + (size_t)i * 32 * ldb + k0);
        }
        const unsigned char* Ac = As + cur * (FM * 4096);
        const unsigned char* Bc = Bs + cur * (FN * 4096);
#pragma unroll
        for (int kk = 0; kk < 2; ++kk) {
            const int coff = ((kk * 4 + (lane >> 4)) ^ fsw) << 4;
            bf16x8 af[FM], bfr[FN];
#pragma unroll
            for (int i = 0; i < FM; ++i) af[i] = *(const bf16x8*)(Ac + a_roff + i * 2048 + coff);
#pragma unroll
            for (int j = 0; j < FN; ++j) bfr[j] = *(const bf16x8*)(Bc + b_roff + j * 2048 + coff);
#pragma unroll
            for (int i = 0; i < FM; ++i)
#pragma unroll
                for (int j = 0; j < FN; ++j)
                    acc[i][j] = __builtin_amdgcn_mfma_f32_16x16x32_bf16(af[i], bfr[j], acc[i][j], 0, 0, 0);
        }
        if (kt + 1 < nk) {
            unsigned char* An = As + (cur ^ 1) * (FM * 4096);
            unsigned char* Bn = Bs + (cur ^ 1) * (FN * 4096);
#pragma unroll
            for (int i = 0; i < FM; ++i) *(uint4*)(An + woff + i * 4096) = ra[i];
#pragma unroll
            for (int i = 0; i < FN; ++i) *(uint4*)(Bn + woff + i * 4096) = rb[i];
        }
        __syncthreads();
    }
}

DEV void phase_gemm1(const Params& p, int l, unsigned char* lds) {
    const bf16_t* H = ws_bf(p, OFF_H); const bf16_t* W = ws_bf(p, OFF_W1T);
    const int lane = threadIdx.x & 63, w = threadIdx.x >> 6, wm = w >> 1, wn = w & 1;
    constexpr int NT_N = PW / 128, NT = (M / 128) * NT_N;
    for (int tile = blockIdx.x; tile < NT; tile += gridDim.x) {
        const int m0 = (tile / NT_N) * 128, n0 = (tile % NT_N) * 128;
        f32x4 acc[4][4];
#pragma unroll
        for (int i = 0; i < 4; ++i)
#pragma unroll
            for (int j = 0; j < 4; ++j) acc[i][j] = (f32x4){0.f, 0.f, 0.f, 0.f};
        gemm_mainloop<4, 4>(H + (size_t)m0 * D, D, W + (size_t)n0 * D, D, D, acc, lds);
        const bool ret_rope = n0 < 1024, att_rope = n0 >= C_AQ && n0 < C_AV;
#pragma unroll
        for (int i = 0; i < 4; ++i)
#pragma unroll
            for (int j = 0; j < 4; ++j) {
#pragma unroll
                for (int r = 0; r < 4; ++r) {
                    const int m = m0 + wm * 64 + i * 16 + (lane >> 4) * 4 + r;
                    const int n = n0 + wn * 64 + j * 16 + (lane & 15);
                    const float partner = ret_rope ? acc[i][j ^ 2][r] : att_rope ? acc[i][j ^ 1][r] : 0.f;
                    p2_store(p, l, m, n, acc[i][j][r], partner);
                }
            }
    }
}

DEV void phase_merge(const Params& p, int l, unsigned char* lds) {
    bf16_t* Pb = ws_bf(p, OFF_P);
    const bf16_t* H = ws_bf(p, OFF_H);
    const int lane = threadIdx.x & 63, w = threadIdx.x >> 6, wm = w >> 1, wn = w & 1;
    constexpr int NT_N = D / 128, NT = (M / 64) * NT_N;
    for (int tile = blockIdx.x; tile < NT; tile += gridDim.x) {
        const int m0 = (tile / NT_N) * 64, n0 = (tile % NT_N) * 128;
        f32x4 tot[2][4];
#pragma unroll
        for (int i = 0; i < 2; ++i)
#pragma unroll
            for (int j = 0; j < 4; ++j) tot[i][j] = (f32x4){0.f, 0.f, 0.f, 0.f};
#pragma unroll 1
        for (int nb = 0; nb < 3; ++nb) {
            f32x4 g[2][4], z[2][4];
#pragma unroll
            for (int i = 0; i < 2; ++i)
#pragma unroll
                for (int j = 0; j < 4; ++j) { g[i][j] = (f32x4){0.f, 0.f, 0.f, 0.f}; z[i][j] = (f32x4){0.f, 0.f, 0.f, 0.f}; }
            gemm_mainloop<2, 4>(H + (size_t)m0 * D, D, ws_bf(p, OFF_WMG) + (size_t)(nb * D + n0) * D, D, D, g, lds);
            const int bcol = nb == 0 ? C_RG : nb == 1 ? C_LG : C_AQ;
            gemm_mainloop<2, 4>(Pb + (size_t)m0 * PW + bcol, PW, ws_bf(p, OFF_WBR) + ((size_t)nb * D + n0) * D, D, D, z, lds);
#pragma unroll
            for (int j = 0; j < 4; ++j) {
                const float bias = p.b_merge[l * 3072 + nb * D + n0 + wn * 64 + j * 16 + (lane & 15)];
#pragma unroll
                for (int i = 0; i < 2; ++i)
#pragma unroll
                    for (int r = 0; r < 4; ++r) tot[i][j][r] += sigmf(g[i][j][r] + bias) * z[i][j][r];
            }
        }
#pragma unroll
        for (int i = 0; i < 2; ++i)
#pragma unroll
            for (int j = 0; j < 4; ++j)
#pragma unroll
                for (int r = 0; r < 4; ++r) {
                    const int m = m0 + wm * 32 + i * 16 + (lane >> 4) * 4 + r;
                    const int n = n0 + wn * 64 + j * 16 + (lane & 15);
                    Pb[(size_t)m * PW + n] = f2bf(tot[i][j][r]);
                }
    }
}

DEV void phase_out(const Params& p, int l, unsigned char* lds) {
    bf16_t* Pb = ws_bf(p, OFF_P);
    const int lane = threadIdx.x & 63, w = threadIdx.x >> 6, wm = w >> 1, wn = w & 1;
    constexpr int NT_N = D / 128, NT = (M / 64) * NT_N;
    for (int tile = blockIdx.x; tile < NT; tile += gridDim.x) {
        const int m0 = (tile / NT_N) * 64, n0 = (tile % NT_N) * 128;
        f32x4 acc[2][4];
#pragma unroll
        for (int i = 0; i < 2; ++i)
#pragma unroll
            for (int j = 0; j < 4; ++j) acc[i][j] = (f32x4){0.f, 0.f, 0.f, 0.f};
        gemm_mainloop<2, 4>(Pb + (size_t)m0 * PW, PW, ws_bf(p, OFF_WOUT) + (size_t)n0 * D, D, D, acc, lds);
#pragma unroll
        for (int i = 0; i < 2; ++i)
#pragma unroll
            for (int j = 0; j < 4; ++j)
#pragma unroll
                for (int r = 0; r < 4; ++r) {
                    const int m = m0 + wm * 32 + i * 16 + (lane >> 4) * 4 + r;
                    const int n = n0 + wn * 64 + j * 16 + (lane & 15);
                    ((float*)(Pb + (size_t)m * PW + 1024))[n] = acc[i][j][r];
                }
    }
}

DEV void phase_attn_naive(const Params& p, int l) {
    bf16_t* Pb = ws_bf(p, OFF_P);
    const int gt = blockIdx.x * blockDim.x + threadIdx.x, gs = gridDim.x * blockDim.x;
    for (int idx = gt; idx < M * 16; idx += gs) {
        const int m = idx >> 4, hq = idx & 15, hk = hq >> 2;
        const bool lat = m >= NCTX;
        float q[64], acc[64];
        bf16_t* qp = Pb + (size_t)m * PW + C_AQ + hq * 64;
#pragma unroll
        for (int d = 0; d < 64; ++d) { q[d] = bf2f(qp[d]); acc[d] = 0.f; }
        float mx = p.att_sink[l * 16 + hq], den = 1.f;
        int k_lo, k_hi;
        if (!lat) { k_lo = m & ~255; k_hi = k_lo + 255; }
        else { const int mm = m - NCTX, s0 = NCTX + (mm & ~2047), t = mm & 2047;
               k_lo = s0 + max(t - 128, 0); k_hi = s0 + min(t + 128, 2047); }
        for (int kr = k_lo; kr <= k_hi; ++kr) {
            const bf16_t* kp = Pb + (size_t)kr * PW + C_AK + hk * 64;
            const bf16_t* vp = Pb + (size_t)kr * PW + C_AV + hk * 64;
            float s = 0.f;
#pragma unroll
            for (int d = 0; d < 64; ++d) s += q[d] * bf2f(kp[d]);
            if (s > mx) { const float sc = __expf(mx - s); den *= sc;
#pragma unroll
                for (int d = 0; d < 64; ++d) acc[d] *= sc;
                mx = s; }
            const float pe = __expf(s - mx); den += pe;
#pragma unroll
            for (int d = 0; d < 64; ++d) acc[d] += pe * bf2f(vp[d]);
        }
        if (lat) {
            const int b = (m - NCTX) >> 11;
            for (int j = 0; j < 256; ++j) {
                const float* kp = p.cache_k + ((size_t)((b * 2 + l) * 256 + j) * 4 + hk) * 64;
                const float* vp = p.cache_v + ((size_t)((b * 2 + l) * 256 + j) * 4 + hk) * 64;
                float s = 0.f;
#pragma unroll
                for (int d = 0; d < 64; ++d) s += q[d] * kp[d];
                if (s > mx) { const float sc = __expf(mx - s); den *= sc;
#pragma unroll
                    for (int d = 0; d < 64; ++d) acc[d] *= sc;
                    mx = s; }
                const float pe = __expf(s - mx); den += pe;
#pragma unroll
                for (int d = 0; d < 64; ++d) acc[d] += pe * vp[d];
            }
        }
        const float rd = 1.f / den;
        const bf16_t* gp = Pb + (size_t)m * PW + C_AG + hq * 64;
#pragma unroll
        for (int d = 0; d < 64; ++d) qp[d] = f2bf(acc[d] * rd * bf2f(gp[d]));
    }
}

DEV void phase_ret_naive(const Params& p, int l, float* red) {
    bf16_t* Pb = ws_bf(p, OFF_P);
    bf16_t* tmp = ws_bf(p, OFF_OFTMP);
    const int dv = threadIdx.x;
    for (int item = blockIdx.x; item < 80; item += gridDim.x) {
        const int seq = item >> 2, h = item & 3;
        const bool lat = seq >= 16;
        const int b = lat ? seq - 16 : seq;
        const int row0 = lat ? NCTX + b * 2048 : b * 256;
        const int L = lat ? 2048 : 256;
        for (int dir = 0; dir < 2; ++dir) {
            const float g = 1.f / (1.f + __expf(-p.ret_decay[(l * 2 + dir) * 4 + h]));
            float S[128];
            if (lat) {
                const float* s0 = p.state_ret + ((((size_t)b * 2 + l) * 2 + dir) * 4 + h) * 128 * 256 + dv;
#pragma unroll
                for (int j = 0; j < 128; ++j) S[j] = s0[(size_t)j * 256];
            } else {
#pragma unroll
                for (int j = 0; j < 128; ++j) S[j] = 0.f;
            }
            for (int s = 0; s < L; ++s) {
                const int t = dir == 0 ? s : L - 1 - s;
                const int m = row0 + t;
                const bf16_t* row = Pb + (size_t)m * PW;
                const float v = bf2f(row[C_RV + h * 256 + dv]);
                const uint4* k4 = (const uint4*)(row + C_RK + h * 128);
                const uint4* q4 = (const uint4*)(row + C_RQ + h * 128);
                float o = 0.f;
#pragma unroll
                for (int jj = 0; jj < 16; ++jj) {
                    const uint4 kk = k4[jj], qq = q4[jj];
                    const unsigned ks[4] = {kk.x, kk.y, kk.z, kk.w}, qs[4] = {qq.x, qq.y, qq.z, qq.w};
#pragma unroll
                    for (int e = 0; e < 4; ++e) {
                        const int j = jj * 8 + e * 2;
                        S[j] = g * S[j] + __uint_as_float(ks[e] << 16) * v;
                        o += __uint_as_float(qs[e] << 16) * S[j];
                        S[j + 1] = g * S[j + 1] + __uint_as_float(ks[e] & 0xffff0000u) * v;
                        o += __uint_as_float(qs[e] & 0xffff0000u) * S[j + 1];
                    }
                }
                if (dir == 0) {
                    tmp[(size_t)m * D + h * 256 + dv] = f2bf(o);
                } else {
                    o += bf2f(tmp[(size_t)m * D + h * 256 + dv]);
                    const float mu = block_sum(o, red) * (1.f / 256.f);
                    const float xc = o - mu;
                    const float var = block_sum(xc * xc, red) * (1.f / 256.f);
                    const float y = xc * rsqrtf(var + EPS);
                    bf16_t* gp = Pb + (size_t)m * PW + C_RG + h * 256 + dv;
                    *gp = f2bf(y * bf2f(*gp));
                }
            }
            if (!lat) {
                float* so = p.out + O_NRET + ((((size_t)b * 2 + l) * 2 + dir) * 4 + h) * 128 * 256 + dv;
#pragma unroll
                for (int j = 0; j < 128; ++j) so[(size_t)j * 256] = S[j];
            }
        }
    }
}

DEV void lru_tile_naive(const Params& p, int l, int gc, int blk, int mode, float* lds) {
    float* lxc = lds; float* hs = lds + 64 * 128;
    bf16_t* Pb = ws_bf(p, OFF_P);
    const int tid = threadIdx.x;
    const int m0 = gc * 64;
    const bool lat = m0 >= NCTX;
    const int L = lat ? 2048 : 256;
    const int t0 = lat ? ((m0 - NCTX) & 2047) : (m0 & 255);
    for (int e = tid; e < 64 * 128; e += 256) {
        const int tt = e >> 7, c = e & 127, ch = blk * 128 + c;
        float acc = p.conv_b[l * D + ch];
#pragma unroll
        for (int j = 0; j < 4; ++j) {
            const int tp = t0 + tt + j - 1;
            if (tp >= 0 && tp < L) acc += p.conv_w[(l * 4 + j) * D + ch] * bf2f(Pb[(size_t)(m0 + tt + j - 1) * PW + C_LX + ch]);
        }
        lxc[e] = acc; hs[e] = 0.f;
    }
    __syncthreads();
    const int c = tid & 127, dir = tid >> 7, ch = blk * 128 + c;
    const bf16_t* Wa = ws_bf(p, OFF_LRUW) + ((size_t)((dir * 2 + 0) * 8 + blk) * 128 + c) * 128;
    const bf16_t* Wx = ws_bf(p, OFF_LRUW) + ((size_t)((dir * 2 + 1) * 8 + blk) * 128 + c) * 128;
    const float ba = p.lru_ba[(l * 2 + dir) * D + ch], bx = p.lru_bx[(l * 2 + dir) * D + ch];
    const float sp = softplusf(-p.lru_lambda[(l * 2 + dir) * D + ch]);
    float* LA = (float*)(p.ws + OFF_LRUC);
    float* LH = LA + 192 * 2 * 1024;
    const size_t ci = ((size_t)gc * 2 + dir) * 1024 + ch;
    float h = mode ? LH[ci] : 0.f, A = 1.f;
    for (int s = 0; s < 64; ++s) {
        const int tt = dir == 0 ? s : 63 - s;
        float r = ba, ig = bx;
        for (int j = 0; j < 128; ++j) { const float x = lxc[tt * 128 + j]; r += x * bf2f(Wa[j]); ig += x * bf2f(Wx[j]); }
        r = sigmf(r); ig = sigmf(ig);
        const float log_a = -8.f * r * sp;
        const float a = __expf(log_a);
        const float u = sqrtf(-expm1f(2.f * log_a)) * (ig * lxc[tt * 128 + c]);
        h = a * h + u; A *= a;
        if (mode) atomicAdd(&hs[tt * 128 + c], h);
    }
    if (!mode) { LA[ci] = A; LH[ci] = h; }
    else if (!lat) {
        const int b = m0 >> 8;
        if (dir == 0 && t0 == 192) p.out[O_NLRU + ((size_t)(b * 2 + l) * 2 + 0) * 1024 + ch] = h;
        if (dir == 1 && t0 == 0)   p.out[O_NLRU + ((size_t)(b * 2 + l) * 2 + 1) * 1024 + ch] = h;
    }
    __syncthreads();
    if (mode) {
        for (int e = tid; e < 64 * 128; e += 256) {
            const int tt = e >> 7, cc = e & 127;
            bf16_t* gp = Pb + (size_t)(m0 + tt) * PW + C_LG + blk * 128 + cc;
            *gp = f2bf(hs[e] * bf2f(*gp));
        }
    }
    __syncthreads();
}
DEV void phase_lru_tiles_naive(const Params& p, int l, int mode, float* lds) {
    for (int it = blockIdx.x; it < 192 * 8; it += gridDim.x) lru_tile_naive(p, l, it >> 3, it & 7, mode, lds);
}
DEV void phase_lru_carry(const Params& p, int l) {
    float* LA = (float*)(p.ws + OFF_LRUC);
    float* LH = LA + 192 * 2 * 1024;
    const int gt = blockIdx.x * blockDim.x + threadIdx.x, gs = gridDim.x * blockDim.x;
    for (int idx = gt; idx < 20 * 2 * 1024; idx += gs) {
        const int ch = idx & 1023, dir = (idx >> 10) & 1, seq = idx >> 11;
        const bool lat = seq >= 16;
        const int nch = lat ? 32 : 4;
        const int gc0 = lat ? 64 + (seq - 16) * 32 : seq * 4;
        float carry = lat ? p.state_lru[((size_t)((seq - 16) * 2 + l) * 2 + dir) * 1024 + ch] : 0.f;
        for (int s = 0; s < nch; ++s) {
            const int cidx = dir == 0 ? s : nch - 1 - s;
            const size_t ci = ((size_t)(gc0 + cidx) * 2 + dir) * 1024 + ch;
            const float A = LA[ci], Hh = LH[ci];
            LH[ci] = carry;
            carry = A * carry + Hh;
        }
    }
}

DEV void phase_merge_naive(const Params& p, int l) {
    bf16_t* Pb = ws_bf(p, OFF_P);
    const bf16_t* H = ws_bf(p, OFF_H);
    const int gt = blockIdx.x * blockDim.x + threadIdx.x, gs = gridDim.x * blockDim.x;
    for (int idx = gt; idx < M * D; idx += gs) {
        const int m = idx >> 10, d = idx & 1023;
        float tot = 0.f;
        for (int nb = 0; nb < 3; ++nb) {
            const float gl = dot_bf16(H + (size_t)m * D, ws_bf(p, OFF_WMG) + (size_t)(nb * D + d) * D, D) + p.b_merge[l * 3072 + nb * D + d];
            const float z = dot_bf16(Pb + (size_t)m * PW + (nb == 0 ? C_RG : nb == 1 ? C_LG : C_AQ), ws_bf(p, OFF_WBR) + ((size_t)nb * D + d) * D, D);
            tot += sigmf(gl) * z;
        }
        Pb[(size_t)m * PW + d] = f2bf(tot);
    }
}
DEV void phase_out_naive(const Params& p, int l) {
    bf16_t* Pb = ws_bf(p, OFF_P);
    const int gt = blockIdx.x * blockDim.x + threadIdx.x, gs = gridDim.x * blockDim.x;
    for (int idx = gt; idx < M * D; idx += gs) {
        const int m = idx >> 10, d = idx & 1023;
        const float v = dot_bf16(Pb + (size_t)m * PW, ws_bf(p, OFF_WOUT) + (size_t)d * D, D);
        ((float*)(Pb + (size_t)m * PW + 1024))[d] = v;
    }
}
DEV void phase_post(const Params& p, int l, float* red) {
    const int tid = threadIdx.x;
    for (int m = blockIdx.x; m < M; m += gridDim.x) {
        const float4 o = ((const float4*)(ws_bf(p, OFF_P) + (size_t)m * PW + 1024))[tid];
        const float ss = block_sum(o.x * o.x + o.y * o.y + o.z * o.z + o.w * o.w, red);
        const float rstd = rsqrtf(ss * (1.f / D) + EPS);
        const float4 x = ((const float4*)x_row(p, l, m))[tid];
        const float4 g = ((const float4*)(p.norm_post + l * D))[tid];
        const float4 gate = ((const float4*)(ws_mod(p) + (size_t)(l * 5 + cond_row(m)) * 3072 + 2048))[tid];
        float4 y;
        y.x = x.x + gate.x * (o.x * rstd * g.x);
        y.y = x.y + gate.y * (o.y * rstd * g.y);
        y.z = x.z + gate.z * (o.z * rstd * g.z);
        y.w = x.w + gate.w * (o.w * rstd * g.w);
        ((float4*)(p.out + (size_t)m * D))[tid] = y;
        if (l == 0) prenorm_row(p, 1, m, y, red);
    }
}

enum { PH_INIT = 0, PH_PRENORM, PH_GEMM1, PH_MIX1, PH_MIX2, PH_MIX3, PH_MERGE, PH_OUT, PH_POST, PH_COUNT };

DEV void run_phase(const Params& p, int ph, int l, float* lds) {
    switch (ph) {
    case PH_INIT:    phase_mod(p); phase_rope_table(p); phase_convert(p, 0, lds); break;
    case PH_PRENORM: phase_prenorm(p, l, lds); break;
    case PH_GEMM1:   phase_gemm1(p, l, (unsigned char*)lds); break;
    case PH_MIX1:    phase_attn_naive(p, l); phase_lru_tiles_naive(p, l, 0, lds); break;
    case PH_MIX2:    phase_lru_carry(p, l); phase_ret_naive(p, l, lds); break;
    case PH_MIX3:    phase_lru_tiles_naive(p, l, 1, lds); break;
    case PH_MERGE:   phase_merge(p, l, (unsigned char*)lds); break;
    case PH_OUT:     phase_out(p, l, (unsigned char*)lds); break;
    case PH_POST:    phase_post(p, l, lds); if (l == 0) phase_convert(p, 1, lds); break;
    }
}

#if !ONE_LAUNCH
__global__ void __launch_bounds__(256, 2) phase_kernel(Params p, int ph, int l) {
    __shared__ __attribute__((aligned(16))) float lds[16384];
    run_phase(p, ph, l, lds);
}
#endif

#if ONE_LAUNCH
__global__ void __launch_bounds__(256, 1) mega_kernel(Params p) {
    __shared__ __attribute__((aligned(16))) float lds[16384];
    cg::grid_group grid = cg::this_grid();
    run_phase(p, PH_INIT, 0, lds); grid.sync();
    run_phase(p, PH_PRENORM, 0, lds); grid.sync();
    for (int l = 0; l < 2; ++l) {
        for (int ph = PH_GEMM1; ph <= PH_POST; ++ph) {
            run_phase(p, ph, l, lds);
            if (!(l == 1 && ph == PH_POST)) grid.sync();
        }
    }
}
#endif

extern "C" void kernel_launch(void* const* d_in, const int* in_sizes, int n_in,
                              void* d_out, int out_size, void* d_ws, size_t ws_size,
                              hipStream_t stream) {
    static int grid_blocks = 0;
    if (grid_blocks == 0) {
        if (n_in != 26 || ws_size < WS_NEED || out_size != 25231360) {
            fprintf(stderr, "kernel_launch: unexpected n_in %d / ws_size %zu (need %zu) / out_size %d\n", n_in, ws_size, (size_t)WS_NEED, out_size);
            grid_blocks = -1; return;
        }
        int dev = 0, cus = 0, per_cu = 0;
        hipGetDevice(&dev);
        hipDeviceGetAttribute(&cus, hipDeviceAttributeMultiprocessorCount, dev);
#if ONE_LAUNCH
        hipOccupancyMaxActiveBlocksPerMultiprocessor(&per_cu, (const void*)mega_kernel, 256, 0);
#else
        hipOccupancyMaxActiveBlocksPerMultiprocessor(&per_cu, (const void*)phase_kernel, 256, 0);
#endif
        if (per_cu < 1) per_cu = 1;
#if ONE_LAUNCH
        if (per_cu > 1) per_cu = 1;
#else
        if (per_cu > 2) per_cu = 2;
#endif
        grid_blocks = cus * per_cu;
    }
    if (grid_blocks < 0) return;
    Params p{};
    const float** pp = (const float**)&p;
    for (int i = 0; i < 26; ++i) pp[i] = (const float*)d_in[i];
    p.out = (float*)d_out;
    p.ws = (unsigned char*)d_ws;
#if ONE_LAUNCH
    void* args[] = {&p};
    hipError_t e = hipLaunchCooperativeKernel((const void*)mega_kernel, dim3(grid_blocks), dim3(256), args, 0, stream);
    if (e != hipSuccess) fprintf(stderr, "cooperative launch failed: %s (grid %d)\n", hipGetErrorString(e), grid_blocks);
#else
    phase_kernel<<<grid_blocks, 256, 0, stream>>>(p, PH_INIT, 0);
    phase_kernel<<<grid_blocks, 256, 0, stream>>>(p, PH_PRENORM, 0);
    for (int l = 0; l < 2; ++l)
        for (int ph = PH_GEMM1; ph <= PH_POST; ++ph)
            phase_kernel<<<grid_blocks, 256, 0, stream>>>(p, ph, l);
#endif
}
```

```cpp
#include <hip/hip_runtime.h>
#include <hip/hip_cooperative_groups.h>
#include <cstdio>
#include <cstdint>
namespace cg = cooperative_groups;

#ifndef ONE_LAUNCH
#define ONE_LAUNCH 1
#endif

typedef unsigned short bf16_t;
#define DEV __device__ __forceinline__

constexpr int D = 1024;
constexpr int NCTX = 4096;
constexpr int NLAT = 8192;
constexpr int M = NCTX + NLAT;
constexpr int PW = 7680;
constexpr int C_RQ = 0, C_RK = 512, C_RV = 1024, C_RG = 2048, C_LX = 3072, C_LG = 4096,
              C_AQ = 5120, C_AK = 6144, C_AV = 6400, C_AG = 6656;
constexpr float EPS = 1e-6f;

constexpr size_t O_YP = 0, O_YS = 4194304, O_NK = 12582912, O_NV = 14680064, O_NRET = 16777216, O_NLRU = 25165824;

constexpr size_t OFF_MOD  = 0;
constexpr size_t OFF_LRUW = 122880;
constexpr size_t OFF_WBR  = OFF_LRUW + 1048576;
constexpr size_t OFF_WOUT = OFF_WBR + 6291456;
constexpr size_t OFF_WMG  = OFF_WOUT + 2097152;
constexpr size_t OFF_H    = OFF_WMG + 6291456;
constexpr size_t OFF_P    = OFF_H + (size_t)M * 1024 * 2;
constexpr size_t OFF_W1T  = OFF_P + (size_t)M * PW * 2;
constexpr size_t OFF_OFTMP = OFF_W1T;
constexpr size_t OFF_LRUC = 262266880;
constexpr size_t OFF_ROPE = OFF_LRUC + (size_t)2 * 192 * 2 * 1024 * 4;
constexpr size_t WS_NEED  = OFF_ROPE + (size_t)2048 * 96 * 8;
static_assert(OFF_OFTMP + (size_t)M * 1024 * 2 <= OFF_LRUC, "overlap");
static_assert(WS_NEED <= 268435456, "ws budget");

struct Params {
    const float *x_prompt, *x_sample, *cache_k, *cache_v, *state_ret, *state_lru, *c, *c_ctx,
                *w_ada, *b_ada, *norm_pre, *norm_post, *w_in, *ret_decay, *conv_w, *conv_b,
                *lru_wa, *lru_ba, *lru_wx, *lru_bx, *lru_lambda, *att_sink, *w_branch, *w_merge, *b_merge, *w_out;
    float* out;
    unsigned char* ws;
};

DEV float bf2f(bf16_t v) { return __uint_as_float(((unsigned)v) << 16); }
DEV bf16_t f2bf(float f) { unsigned u = __float_as_uint(f); u += 0x7fffu + ((u >> 16) & 1u); return (bf16_t)(u >> 16); }
DEV float siluf(float x) { return x / (1.f + __expf(-x)); }
DEV float sigmf(float x) { return 1.f / (1.f + __expf(-x)); }
DEV float softplusf(float x) { return fmaxf(x, 0.f) + log1pf(__expf(-fabsf(x))); }

DEV float* ws_mod(const Params& p) { return (float*)(p.ws + OFF_MOD); }
DEV bf16_t* ws_bf(const Params& p, size_t off) { return (bf16_t*)(p.ws + off); }

DEV const float* x_row(const Params& p, int l, int m) {
    const float* xp = p.x_prompt; const float* xs = p.x_sample; const float* po = p.out;
    if (l == 0) return m < NCTX ? xp + (size_t)m * D : xs + (size_t)(m - NCTX) * D;
    return po + (size_t)m * D;
}
DEV int cond_row(int m) { return m < NCTX ? 0 : 1 + ((m - NCTX) >> 11); }

DEV float wave_sum(float v) {
#pragma unroll
    for (int o = 1; o < 64; o <<= 1) v += __shfl_xor(v, o);
    return v;
}
DEV float block_sum(float v, float* red) {
    v = wave_sum(v);
    __syncthreads();
    if ((threadIdx.x & 63) == 0) red[threadIdx.x >> 6] = v;
    __syncthreads();
    return (red[0] + red[1]) + (red[2] + red[3]);
}

DEV float dot_bf16(const bf16_t* a, const bf16_t* b, int K) {
    float acc = 0.f;
    const uint4* a4 = (const uint4*)a; const uint4* b4 = (const uint4*)b;
    for (int i = 0; i < K / 8; ++i) {
        uint4 x = a4[i], y = b4[i];
        unsigned xs[4] = {x.x, x.y, x.z, x.w}, ys[4] = {y.x, y.y, y.z, y.w};
#pragma unroll
        for (int j = 0; j < 4; ++j) {
            acc += __uint_as_float(xs[j] << 16) * __uint_as_float(ys[j] << 16);
            acc += __uint_as_float(xs[j] & 0xffff0000u) * __uint_as_float(ys[j] & 0xffff0000u);
        }
    }
    return acc;
}

DEV void phase_mod(const Params& p) {
    float* mod = ws_mod(p);
    const int gt = blockIdx.x * blockDim.x + threadIdx.x, gs = gridDim.x * blockDim.x;
    for (int idx = gt; idx < 2 * 5 * 3072; idx += gs) {
        const int j = idx % 3072, r = (idx / 3072) % 5, l = idx / 15360;
        const float* cctx = p.c_ctx; const float* cb = p.c;
        const float* cond = r == 0 ? cctx : cb + (r - 1) * D;
        const float* w = p.w_ada + (size_t)l * D * 3072 + j;
        float acc = p.b_ada[l * 3072 + j];
        for (int k = 0; k < D; ++k) acc += siluf(cond[k]) * w[(size_t)k * 3072];
        mod[idx] = acc;
    }
}

DEV void phase_rope_table(const Params& p) {
    float2* tab = (float2*)(p.ws + OFF_ROPE);
    const int gt = blockIdx.x * blockDim.x + threadIdx.x, gs = gridDim.x * blockDim.x;
    for (int idx = gt; idx < 2048 * 96; idx += gs) {
        const int t = idx / 96, e = idx % 96;
        int a, c; float nq;
        if (e < 64) { a = e >> 5; c = e & 31; nq = 32.f; } else { a = (e - 64) >> 4; c = (e - 64) & 15; nq = 16.f; }
        const float pos = (float)(a ? (t & 63) : (t >> 6));
        const float inv = powf(10000.f, -(float)c / nq);
        float sn, cs; sincosf(pos * inv, &sn, &cs);
        tab[idx] = make_float2(cs, sn);
    }
}

DEV void transpose_tile(const float* src, int K, int N, bf16_t* dst, int k0, int n0, float* tile) {
    const int tid = threadIdx.x;
#pragma unroll 4
    for (int i = 0; i < 16; ++i) {
        const int r = i * 4 + (tid >> 6), c = tid & 63;
        tile[r * 65 + c] = src[(size_t)(k0 + r) * N + n0 + c];
    }
    __syncthreads();
#pragma unroll 4
    for (int i = 0; i < 16; ++i) {
        const int n = i * 4 + (tid >> 6), k = tid & 63;
        dst[(size_t)(n0 + n) * K + k0 + k] = f2bf(tile[k * 65 + n]);
    }
    __syncthreads();
}
DEV void phase_convert(const Params& p, int l, float* tile) {
    constexpr int T_IN = 16 * 120, T_MG = 16 * 48, T_BR = 3 * 256, T_OUT = 256, T_LRU = 32 * 4;
    constexpr int TOT = T_IN + T_MG + T_BR + T_OUT + T_LRU;
    for (int it = blockIdx.x; it < TOT; it += gridDim.x) {
        int r = it;
        if (r < T_IN) { transpose_tile(p.w_in + (size_t)l * D * PW, D, PW, ws_bf(p, OFF_W1T), (r / 120) * 64, (r % 120) * 64, tile); continue; }
        r -= T_IN;
        if (r < T_MG) { transpose_tile(p.w_merge + (size_t)l * D * 3072, D, 3072, ws_bf(p, OFF_WMG), (r / 48) * 64, (r % 48) * 64, tile); continue; }
        r -= T_MG;
        if (r < T_BR) { const int nb = r / 256, q = r % 256;
            transpose_tile(p.w_branch + ((size_t)l * 3 + nb) * D * D, D, D, ws_bf(p, OFF_WBR) + (size_t)nb * D * D, (q / 16) * 64, (q % 16) * 64, tile); continue; }
        r -= T_BR;
        if (r < T_OUT) { transpose_tile(p.w_out + (size_t)l * D * D, D, D, ws_bf(p, OFF_WOUT), (r / 16) * 64, (r % 16) * 64, tile); continue; }
        r -= T_OUT;
        {
            const int mat = r / 4, q = r % 4;
            const int dir = mat >> 4, gate = (mat >> 3) & 1, blk = mat & 7;
            const float* wa_ = p.lru_wa; const float* wx_ = p.lru_wx;
            const float* src = (gate ? wx_ : wa_) + (((size_t)l * 2 + dir) * 8 + blk) * 128 * 128;
            transpose_tile(src, 128, 128, ws_bf(p, OFF_LRUW) + (size_t)mat * 128 * 128, (q >> 1) * 64, (q & 1) * 64, tile);
        }
    }
}

DEV void prenorm_row(const Params& p, int l, int m, float4 v, float* red) {
    const int tid = threadIdx.x;
    const float ss = block_sum(v.x * v.x + v.y * v.y + v.z * v.z + v.w * v.w, red);
    const float rstd = rsqrtf(ss * (1.f / D) + EPS);
    const float* mod = ws_mod(p) + (size_t)(l * 5 + cond_row(m)) * 3072;
    const float4 g = ((const float4*)(p.norm_pre + l * D))[tid];
    const float4 sh = ((const float4*)mod)[tid];
    const float4 sc = ((const float4*)(mod + 1024))[tid];
    bf16_t* h = ws_bf(p, OFF_H) + (size_t)m * D + tid * 4;
    ushort4 o;
    o.x = f2bf(v.x * rstd * g.x * (1.f + sc.x) + sh.x);
    o.y = f2bf(v.y * rstd * g.y * (1.f + sc.y) + sh.y);
    o.z = f2bf(v.z * rstd * g.z * (1.f + sc.z) + sh.z);
    o.w = f2bf(v.w * rstd * g.w * (1.f + sc.w) + sh.w);
    *(ushort4*)h = o;
}
DEV void phase_prenorm(const Params& p, int l, float* red) {
    for (int m = blockIdx.x; m < M; m += gridDim.x) {
        const float4 v = ((const float4*)x_row(p, l, m))[threadIdx.x];
        prenorm_row(p, l, m, v, red);
    }
}

DEV int rope_partner(int n) {
    if (n < 1024) return ((n >> 5) & 1) ? n - 32 : n + 32;
    return (((n - C_AQ) >> 4) & 1) ? n - 16 : n + 16;
}
DEV bool rope_col(int n) { return n < 1024 || (n >= C_AQ && n < C_AV); }
DEV void p2_store(const Params& p, int l, int m, int n, float v, float partner) {
    const bool lat = m >= NCTX;
    const int t = lat ? ((m - NCTX) & 2047) : (m & 255);
    bf16_t* P = ws_bf(p, OFF_P) + (size_t)m * PW;
    float o = v;
    if (n < 1024) {
        if (lat) {
            const int d = n & 127, c = d & 31, a = d >> 6, b = (d >> 5) & 1;
            const float2 cssn = ((const float2*)(p.ws + OFF_ROPE))[t * 96 + a * 32 + c];
            o = b ? v * cssn.x + partner * cssn.y : v * cssn.x - partner * cssn.y;
        }
        if (n < 512) o *= 0.08838834764831845f;
    } else if (n < C_RG) {
    } else if (n < C_LX) { o = siluf(v);
    } else if (n < C_LG) {
    } else if (n < C_AQ) { o = siluf(v);
    } else if (n < C_AV) {
        if (lat) {
            const int d = (n - C_AQ) & 63, c = d & 15, a = d >> 5, b = (d >> 4) & 1;
            const float2 cssn = ((const float2*)(p.ws + OFF_ROPE))[t * 96 + 64 + a * 16 + c];
            o = b ? v * cssn.x + partner * cssn.y : v * cssn.x - partner * cssn.y;
        } else if (n >= C_AK) {
            p.out[O_NK + ((size_t)((m >> 8) * 2 + l) * 256 + t) * 256 + (n - C_AK)] = v;
        }
        if (n < C_AK) o *= 0.125f;
    } else if (n < C_AG) {
        if (!lat) p.out[O_NV + ((size_t)((m >> 8) * 2 + l) * 256 + t) * 256 + (n - C_AV)] = v;
    } else { o = siluf(v); }
    P[n] = f2bf(o);
}

DEV void phase_gemm1_naive(const Params& p, int l) {
    const bf16_t* H = ws_bf(p, OFF_H); const bf16_t* W = ws_bf(p, OFF_W1T);
    const size_t gt = (size_t)blockIdx.x * blockDim.x + threadIdx.x, gs = (size_t)gridDim.x * blockDim.x;
    for (size_t idx = gt; idx < (size_t)M * PW; idx += gs) {
        const int n = (int)(idx % PW), m = (int)(idx / PW);
        const float v = dot_bf16(H + (size_t)m * D, W + (size_t)n * D, D);
        float pr = 0.f;
        if (m >= NCTX && rope_col(n)) pr = dot_bf16(H + (size_t)m * D, W + (size_t)rope_partner(n) * D, D);
        p2_store(p, l, m, n, v, pr);
    }
}

typedef short bf16x8 __attribute__((ext_vector_type(8)));
typedef float f32x4 __attribute__((ext_vector_type(4)));

template <int FM, int FN>
DEV void gemm_mainloop(const bf16_t* __restrict__ A, int lda, const bf16_t* __restrict__ Bt, int ldb, int K,
                       f32x4 (&acc)[FM][FN], unsigned char* lds) {
    const int tid = threadIdx.x, lane = tid & 63, w = tid >> 6, wm = w >> 1, wn = w & 1;
    unsigned char* As = lds;
    unsigned char* Bs = lds + 2 * FM * 4096;
    const int srow = tid >> 3, sc = tid & 7;
    const bf16_t* ga = A + (size_t)srow * lda + sc * 8;
    const bf16_t* gb = Bt + (size_t)srow * ldb + sc * 8;
    const int woff = srow * 128 + ((sc ^ ((srow >> 1) & 7)) << 4);
    const int fsw = (lane >> 1) & 7;
    const int a_roff = (wm * 16 * FM + (lane & 15)) * 128;
    const int b_roff = (wn * 16 * FN + (lane & 15)) * 128;
    uint4 ra[FM], rb[FN];
#pragma unroll
    for (int i = 0; i < FM; ++i) ra[i] = *(const uint4*)(ga + (size_t)i * 32 * lda);
#pragma unroll
    for (int i = 0; i < FN; ++i) rb[i] = *(const uint4*)(gb + (size_t)i * 32 * ldb);
#pragma unroll
    for (int i = 0; i < FM; ++i) *(uint4*)(As + woff + i * 4096) = ra[i];
#pragma unroll
    for (int i = 0; i < FN; ++i) *(uint4*)(Bs + woff + i * 4096) = rb[i];
    __syncthreads();
    const int nk = K >> 6;
    for (int kt = 0; kt < nk; ++kt) {
        const int cur = kt & 1;
        if (kt + 1 < nk) {
            const int k0 = (kt + 1) << 6;
#pragma unroll
            for (int i = 0; i < FM; ++i) ra[i] = *(const uint4*)(ga + (size_t)i * 32 * lda + k0);
#pragma unroll
            for (int i = 0; i < FN; ++i) rb[i] = *(const uint4*)(gb + (size_t)i * 32 * ldb + k0);
        }
        const unsigned char* Ac = As + cur * (FM * 4096);
        const unsigned char* Bc = Bs + cur * (FN * 4096);
#pragma unroll
        for (int kk = 0; kk < 2; ++kk) {
            const int coff = ((kk * 4 + (lane >> 4)) ^ fsw) << 4;
            bf16x8 af[FM], bfr[FN];
#pragma unroll
            for (int i = 0; i < FM; ++i) af[i] = *(const bf16x8*)(Ac + a_roff + i * 2048 + coff);
#pragma unroll
            for (int j = 0; j < FN; ++j) bfr[j] = *(const bf16x8*)(Bc + b_roff + j * 2048 + coff);
#pragma unroll
            for (int i = 0; i < FM; ++i)
#pragma unroll
                for (int j = 0; j < FN; ++j)
                    acc[i][j] = __builtin_amdgcn_mfma_f32_16x16x32_bf16(af[i], bfr[j], acc[i][j], 0, 0, 0);
        }
        if (kt + 1 < nk) {
            unsigned char* An = As + (cur ^ 1) * (FM * 4096);
            unsigned char* Bn = Bs + (cur ^ 1) * (FN * 4096);
#pragma unroll
            for (int i = 0; i < FM; ++i) *(uint4*)(An + woff + i * 4096) = ra[i];
#pragma unroll
            for (int i = 0; i < FN; ++i) *(uint4*)(Bn + woff + i * 4096) = rb[i];
        }
        __syncthreads();
    }
}

DEV void phase_gemm1(const Params& p, int l, unsigned char* lds) {
    const bf16_t* H = ws_bf(p, OFF_H); const bf16_t* W = ws_bf(p, OFF_W1T);
    const int lane = threadIdx.x & 63, w = threadIdx.x >> 6, wm = w >> 1, wn = w & 1;
    constexpr int NT_N = PW / 128, NT = (M / 128) * NT_N;
    for (int tile = blockIdx.x; tile < NT; tile += gridDim.x) {
        const int m0 = (tile / NT_N) * 128, n0 = (tile % NT_N) * 128;
        f32x4 acc[4][4];
#pragma unroll
        for (int i = 0; i < 4; ++i)
#pragma unroll
            for (int j = 0; j < 4; ++j) acc[i][j] = (f32x4){0.f, 0.f, 0.f, 0.f};
        gemm_mainloop<4, 4>(H + (size_t)m0 * D, D, W + (size_t)n0 * D, D, D, acc, lds);
        const bool ret_rope = n0 < 1024, att_rope = n0 >= C_AQ && n0 < C_AV;
#pragma unroll
        for (int i = 0; i < 4; ++i)
#pragma unroll
            for (int j = 0; j < 4; ++j) {
#pragma unroll
                for (int r = 0; r < 4; ++r) {
                    const int m = m0 + wm * 64 + i * 16 + (lane >> 4) * 4 + r;
                    const int n = n0 + wn * 64 + j * 16 + (lane & 15);
                    const float partner = ret_rope ? acc[i][j ^ 2][r] : att_rope ? acc[i][j ^ 1][r] : 0.f;
                    p2_store(p, l, m, n, acc[i][j][r], partner);
                }
            }
    }
}

DEV void phase_merge(const Params& p, int l, unsigned char* lds) {
    bf16_t* Pb = ws_bf(p, OFF_P);
    const bf16_t* H = ws_bf(p, OFF_H);
    const int lane = threadIdx.x & 63, w = threadIdx.x >> 6, wm = w >> 1, wn = w & 1;
    constexpr int NT_N = D / 128, NT = (M / 64) * NT_N;
    for (int tile = blockIdx.x; tile < NT; tile += gridDim.x) {
        const int m0 = (tile / NT_N) * 64, n0 = (tile % NT_N) * 128;
        f32x4 tot[2][4];
#pragma unroll
        for (int i = 0; i < 2; ++i)
#pragma unroll
            for (int j = 0; j < 4; ++j) tot[i][j] = (f32x4){0.f, 0.f, 0.f, 0.f};
#pragma unroll 1
        for (int nb = 0; nb < 3; ++nb) {
            f32x4 g[2][4], z[2][4];
#pragma unroll
            for (int i = 0; i < 2; ++i)
#pragma unroll
                for (int j = 0; j < 4; ++j) { g[i][j] = (f32x4){0.f, 0.f, 0.f, 0.f}; z[i][j] = (f32x4){0.f, 0.f, 0.f, 0.f}; }
            gemm_mainloop<2, 4>(H + (size_t)m0 * D, D, ws_bf(p, OFF_WMG) + (size_t)(nb * D + n0) * D, D, D, g, lds);
            const int bcol = nb == 0 ? C_RG : nb == 1 ? C_LG : C_AQ;
            gemm_mainloop<2, 4>(Pb + (size_t)m0 * PW + bcol, PW, ws_bf(p, OFF_WBR) + ((size_t)nb * D + n0) * D, D, D, z, lds);
#pragma unroll
            for (int j = 0; j < 4; ++j) {
                const float bias = p.b_merge[l * 3072 + nb * D + n0 + wn * 64 + j * 16 + (lane & 15)];
#pragma unroll
                for (int i = 0; i < 2; ++i)
#pragma unroll
                    for (int r = 0; r < 4; ++r) tot[i][j][r] += sigmf(g[i][j][r] + bias) * z[i][j][r];
            }
        }
#pragma unroll
        for (int i = 0; i < 2; ++i)
#pragma unroll
            for (int j = 0; j < 4; ++j)
#pragma unroll
                for (int r = 0; r < 4; ++r) {
                    const int m = m0 + wm * 32 + i * 16 + (lane >> 4) * 4 + r;
                    const int n = n0 + wn * 64 + j * 16 + (lane & 15);
                    Pb[(size_t)m * PW + n] = f2bf(tot[i][j][r]);
                }
    }
}

DEV void phase_out(const Params& p, int l, unsigned char* lds) {
    bf16_t* Pb = ws_bf(p, OFF_P);
    const int lane = threadIdx.x & 63, w = threadIdx.x >> 6, wm = w >> 1, wn = w & 1;
    constexpr int NT_N = D / 128, NT = (M / 64) * NT_N;
    for (int tile = blockIdx.x; tile < NT; tile += gridDim.x) {
        const int m0 = (tile / NT_N) * 64, n0 = (tile % NT_N) * 128;
        f32x4 acc[2][4];
#pragma unroll
        for (int i = 0; i < 2; ++i)
#pragma unroll
            for (int j = 0; j < 4; ++j) acc[i][j] = (f32x4){0.f, 0.f, 0.f, 0.f};
        gemm_mainloop<2, 4>(Pb + (size_t)m0 * PW, PW, ws_bf(p, OFF_WOUT) + (size_t)n0 * D, D, D, acc, lds);
#pragma unroll
        for (int i = 0; i < 2; ++i)
#pragma unroll
            for (int j = 0; j < 4; ++j)
#pragma unroll
                for (int r = 0; r < 4; ++r) {
                    const int m = m0 + wm * 32 + i * 16 + (lane >> 4) * 4 + r;
                    const int n = n0 + wn * 64 + j * 16 + (lane & 15);
                    ((float*)(Pb + (size_t)m * PW + 1024))[n] = acc[i][j][r];
                }
    }
}

DEV uint4 pack8(const float4 a, const float4 b) {
    uint4 r;
    r.x = (unsigned)f2bf(a.x) | ((unsigned)f2bf(a.y) << 16); r.y = (unsigned)f2bf(a.z) | ((unsigned)f2bf(a.w) << 16);
    r.z = (unsigned)f2bf(b.x) | ((unsigned)f2bf(b.y) << 16); r.w = (unsigned)f2bf(b.z) | ((unsigned)f2bf(b.w) << 16);
    return r;
}
DEV void attn_item(const Params& p, int l, int item, unsigned char* lds) {
    bf16_t* Pb = ws_bf(p, OFF_P);
    unsigned char* Ks = lds; unsigned char* Vt = lds + 8192;
    const int tid = threadIdx.x, lane = tid & 63, w = tid >> 6, g = lane >> 4, lc = lane & 15;
    const bool lat = item < 512;
    int b, hk, qb, row0, L;
    if (lat) { b = item >> 7; hk = (item >> 5) & 3; qb = item & 31; row0 = NCTX + b * 2048; L = 2048; }
    else { const int it = item - 512; b = it >> 4; hk = (it >> 2) & 3; qb = it & 3; row0 = b * 256; L = 256; }
    const int q0 = qb * 64;
    const int hq = hk * 4 + w;
    bf16x8 qfr[4][2];
#pragma unroll
    for (int qf = 0; qf < 4; ++qf)
#pragma unroll
        for (int ks = 0; ks < 2; ++ks)
            qfr[qf][ks] = *(const bf16x8*)(Pb + (size_t)(row0 + q0 + qf * 16 + lc) * PW + C_AQ + hq * 64 + ks * 32 + g * 8);
    f32x4 O[4][4];
    float mrun[4], lrun[4];
    const float sink = p.att_sink[l * 16 + hq];
#pragma unroll
    for (int qf = 0; qf < 4; ++qf) { mrun[qf] = sink; lrun[qf] = g == 0 ? 1.f : 0.f;
#pragma unroll
        for (int df = 0; df < 4; ++df) O[df][qf] = (f32x4){0.f, 0.f, 0.f, 0.f}; }
    const int nband = lat ? 5 : 4;
    const int ntile = lat ? 9 : 4;
    const int fsw = (lane >> 1) & 7;
    for (int t = 0; t < ntile; ++t) {
        const bool cache = t >= nband;
        int kp0 = 0;
        if (!cache) { kp0 = lat ? q0 + 64 * (t - 2) : 64 * t; if (kp0 < 0 || kp0 >= L) continue; }
        __syncthreads();
        if (!cache) {
#pragma unroll
            for (int i = 0; i < 2; ++i) {
                const int id = i * 256 + tid, row = id >> 3, c = id & 7;
                const uint4 v = *(const uint4*)(Pb + (size_t)(row0 + kp0 + row) * PW + C_AK + hk * 64 + c * 8);
                *(uint4*)(Ks + row * 128 + ((c ^ ((row >> 1) & 7)) << 4)) = v;
            }
#pragma unroll
            for (int i = 0; i < 2; ++i) {
                const int key = lane, c = w + 4 * i;
                const uint4 v = *(const uint4*)(Pb + (size_t)(row0 + kp0 + key) * PW + C_AV + hk * 64 + c * 8);
                bf16_t* dst = (bf16_t*)(Vt + (c * 8) * 136 + key * 2);
                dst[0 * 68] = (bf16_t)(v.x & 0xffff); dst[1 * 68] = (bf16_t)(v.x >> 16);
                dst[2 * 68] = (bf16_t)(v.y & 0xffff); dst[3 * 68] = (bf16_t)(v.y >> 16);
                dst[4 * 68] = (bf16_t)(v.z & 0xffff); dst[5 * 68] = (bf16_t)(v.z >> 16);
                dst[6 * 68] = (bf16_t)(v.w & 0xffff); dst[7 * 68] = (bf16_t)(v.w >> 16);
            }
        } else {
            const int j0 = (t - nband) * 64;
            const float* ck = p.cache_k + (size_t)((b * 2 + l) * 256 + j0) * 256 + hk * 64;
            const float* cv = p.cache_v + (size_t)((b * 2 + l) * 256 + j0) * 256 + hk * 64;
#pragma unroll
            for (int i = 0; i < 2; ++i) {
                const int id = i * 256 + tid, row = id >> 3, c = id & 7;
                const float4 x0 = *(const float4*)(ck + (size_t)row * 256 + c * 8), x1 = *(const float4*)(ck + (size_t)row * 256 + c * 8 + 4);
                *(uint4*)(Ks + row * 128 + ((c ^ ((row >> 1) & 7)) << 4)) = pack8(x0, x1);
            }
#pragma unroll
            for (int i = 0; i < 2; ++i) {
                const int key = lane, c = w + 4 * i;
                const float4 x0 = *(const float4*)(cv + (size_t)key * 256 + c * 8), x1 = *(const float4*)(cv + (size_t)key * 256 + c * 8 + 4);
                bf16_t* dst = (bf16_t*)(Vt + (c * 8) * 136 + key * 2);
                dst[0 * 68] = f2bf(x0.x); dst[1 * 68] = f2bf(x0.y); dst[2 * 68] = f2bf(x0.z); dst[3 * 68] = f2bf(x0.w);
                dst[4 * 68] = f2bf(x1.x); dst[5 * 68] = f2bf(x1.y); dst[6 * 68] = f2bf(x1.z); dst[7 * 68] = f2bf(x1.w);
            }
        }
        __syncthreads();
        f32x4 sc[4][4];
#pragma unroll
        for (int kf = 0; kf < 4; ++kf)
#pragma unroll
            for (int qf = 0; qf < 4; ++qf) sc[kf][qf] = (f32x4){0.f, 0.f, 0.f, 0.f};
#pragma unroll
        for (int ks = 0; ks < 2; ++ks) {
            bf16x8 ak[4];
#pragma unroll
            for (int kf = 0; kf < 4; ++kf) ak[kf] = *(const bf16x8*)(Ks + (kf * 16 + lc) * 128 + (((ks * 4 + g) ^ fsw) << 4));
#pragma unroll
            for (int kf = 0; kf < 4; ++kf)
#pragma unroll
                for (int qf = 0; qf < 4; ++qf)
                    sc[kf][qf] = __builtin_amdgcn_mfma_f32_16x16x32_bf16(ak[kf], qfr[qf][ks], sc[kf][qf], 0, 0, 0);
        }
        if (lat && !cache && (t == 0 || t == 4)) {
#pragma unroll
            for (int kf = 0; kf < 4; ++kf)
#pragma unroll
                for (int qf = 0; qf < 4; ++qf)
#pragma unroll
                    for (int r = 0; r < 4; ++r) {
                        const int kpos = kp0 + kf * 16 + g * 4 + r, qpos = q0 + qf * 16 + lc;
                        const int dd = qpos - kpos;
                        if (dd > 128 || dd < -128) sc[kf][qf][r] = -INFINITY;
                    }
        }
        bf16x8 pb[2][4];
#pragma unroll
        for (int qf = 0; qf < 4; ++qf) {
            float mx = -INFINITY;
#pragma unroll
            for (int kf = 0; kf < 4; ++kf)
#pragma unroll
                for (int r = 0; r < 4; ++r) mx = fmaxf(mx, sc[kf][qf][r]);
            mx = fmaxf(mx, __shfl_xor(mx, 16));
            mx = fmaxf(mx, __shfl_xor(mx, 32));
            const float mnew = fmaxf(mrun[qf], mx);
            const float alpha = __expf(mrun[qf] - mnew);
            mrun[qf] = mnew;
            float ps = 0.f;
#pragma unroll
            for (int kf = 0; kf < 4; ++kf)
#pragma unroll
                for (int r = 0; r < 4; ++r) { const float e = __expf(sc[kf][qf][r] - mnew); sc[kf][qf][r] = e; ps += e; }
            lrun[qf] = lrun[qf] * alpha + ps;
#pragma unroll
            for (int df = 0; df < 4; ++df) O[df][qf] *= alpha;
#pragma unroll
            for (int s2 = 0; s2 < 2; ++s2) {
                bf16x8 v;
#pragma unroll
                for (int r = 0; r < 4; ++r) { v[r] = (short)f2bf(sc[2 * s2][qf][r]); v[4 + r] = (short)f2bf(sc[2 * s2 + 1][qf][r]); }
                pb[s2][qf] = v;
            }
        }
#pragma unroll
        for (int s2 = 0; s2 < 2; ++s2)
#pragma unroll
            for (int df = 0; df < 4; ++df) {
                const unsigned char* vr = Vt + (df * 16 + lc) * 136 + (32 * s2 + 4 * g) * 2;
                const uint2 lo = *(const uint2*)vr, hi = *(const uint2*)(vr + 32);
                union { uint4 u; bf16x8 v; } av; av.u = make_uint4(lo.x, lo.y, hi.x, hi.y);
#pragma unroll
                for (int qf = 0; qf < 4; ++qf)
                    O[df][qf] = __builtin_amdgcn_mfma_f32_16x16x32_bf16(av.v, pb[s2][qf], O[df][qf], 0, 0, 0);
            }
    }
#pragma unroll
    for (int qf = 0; qf < 4; ++qf) {
        float lt = lrun[qf];
        lt += __shfl_xor(lt, 16); lt += __shfl_xor(lt, 32);
        const float inv = 1.f / lt;
        const size_t m = (size_t)(row0 + q0 + qf * 16 + lc);
#pragma unroll
        for (int df = 0; df < 4; ++df) {
            const int col = hq * 64 + df * 16 + g * 4;
            const uint2 gt = *(const uint2*)(Pb + m * PW + C_AG + col);
            uint2 o;
            o.x = (unsigned)f2bf(O[df][qf][0] * inv * __uint_as_float(gt.x << 16)) | ((unsigned)f2bf(O[df][qf][1] * inv * __uint_as_float(gt.x & 0xffff0000u)) << 16);
            o.y = (unsigned)f2bf(O[df][qf][2] * inv * __uint_as_float(gt.y << 16)) | ((unsigned)f2bf(O[df][qf][3] * inv * __uint_as_float(gt.y & 0xffff0000u)) << 16);
            *(uint2*)(Pb + m * PW + C_AQ + col) = o;
        }
    }
}
DEV void phase_attn(const Params& p, int l, unsigned char* lds) {
    for (int item = blockIdx.x; item < 768; item += gridDim.x) attn_item(p, l, item, lds);
}

DEV void phase_attn_naive(const Params& p, int l) {
    bf16_t* Pb = ws_bf(p, OFF_P);
    const int gt = blockIdx.x * blockDim.x + threadIdx.x, gs = gridDim.x * blockDim.x;
    for (int idx = gt; idx < M * 16; idx += gs) {
        const int m = idx >> 4, hq = idx & 15, hk = hq >> 2;
        const bool lat = m >= NCTX;
        float q[64], acc[64];
        bf16_t* qp = Pb + (size_t)m * PW + C_AQ + hq * 64;
#pragma unroll
        for (int d = 0; d < 64; ++d) { q[d] = bf2f(qp[d]); acc[d] = 0.f; }
        float mx = p.att_sink[l * 16 + hq], den = 1.f;
        int k_lo, k_hi;
        if (!lat) { k_lo = m & ~255; k_hi = k_lo + 255; }
        else { const int mm = m - NCTX, s0 = NCTX + (mm & ~2047), t = mm & 2047;
               k_lo = s0 + max(t - 128, 0); k_hi = s0 + min(t + 128, 2047); }
        for (int kr = k_lo; kr <= k_hi; ++kr) {
            const bf16_t* kp = Pb + (size_t)kr * PW + C_AK + hk * 64;
            const bf16_t* vp = Pb + (size_t)kr * PW + C_AV + hk * 64;
            float s = 0.f;
#pragma unroll
            for (int d = 0; d < 64; ++d) s += q[d] * bf2f(kp[d]);
            if (s > mx) { const float sc = __expf(mx - s); den *= sc;
#pragma unroll
                for (int d = 0; d < 64; ++d) acc[d] *= sc;
                mx = s; }
            const float pe = __expf(s - mx); den += pe;
#pragma unroll
            for (int d = 0; d < 64; ++d) acc[d] += pe * bf2f(vp[d]);
        }
        if (lat) {
            const int b = (m - NCTX) >> 11;
            for (int j = 0; j < 256; ++j) {
                const float* kp = p.cache_k + ((size_t)((b * 2 + l) * 256 + j) * 4 + hk) * 64;
                const float* vp = p.cache_v + ((size_t)((b * 2 + l) * 256 + j) * 4 + hk) * 64;
                float s = 0.f;
#pragma unroll
                for (int d = 0; d < 64; ++d) s += q[d] * kp[d];
                if (s > mx) { const float sc = __expf(mx - s); den *= sc;
#pragma unroll
                    for (int d = 0; d < 64; ++d) acc[d] *= sc;
                    mx = s; }
                const float pe = __expf(s - mx); den += pe;
#pragma unroll
                for (int d = 0; d < 64; ++d) acc[d] += pe * vp[d];
            }
        }
        const float rd = 1.f / den;
        const bf16_t* gp = Pb + (size_t)m * PW + C_AG + hq * 64;
#pragma unroll
        for (int d = 0; d < 64; ++d) qp[d] = f2bf(acc[d] * rd * bf2f(gp[d]));
    }
}

DEV void phase_ret_naive(const Params& p, int l, float* red) {
    bf16_t* Pb = ws_bf(p, OFF_P);
    bf16_t* tmp = ws_bf(p, OFF_OFTMP);
    const int dv = threadIdx.x;
    for (int item = blockIdx.x; item < 80; item += gridDim.x) {
        const int seq = item >> 2, h = item & 3;
        const bool lat = seq >= 16;
        const int b = lat ? seq - 16 : seq;
        const int row0 = lat ? NCTX + b * 2048 : b * 256;
        const int L = lat ? 2048 : 256;
        for (int dir = 0; dir < 2; ++dir) {
            const float g = 1.f / (1.f + __expf(-p.ret_decay[(l * 2 + dir) * 4 + h]));
            float S[128];
            if (lat) {
                const float* s0 = p.state_ret + ((((size_t)b * 2 + l) * 2 + dir) * 4 + h) * 128 * 256 + dv;
#pragma unroll
                for (int j = 0; j < 128; ++j) S[j] = s0[(size_t)j * 256];
            } else {
#pragma unroll
                for (int j = 0; j < 128; ++j) S[j] = 0.f;
            }
            for (int s = 0; s < L; ++s) {
                const int t = dir == 0 ? s : L - 1 - s;
                const int m = row0 + t;
                const bf16_t* row = Pb + (size_t)m * PW;
                const float v = bf2f(row[C_RV + h * 256 + dv]);
                const uint4* k4 = (const uint4*)(row + C_RK + h * 128);
                const uint4* q4 = (const uint4*)(row + C_RQ + h * 128);
                float o = 0.f;
#pragma unroll
                for (int jj = 0; jj < 16; ++jj) {
                    const uint4 kk = k4[jj], qq = q4[jj];
                    const unsigned ks[4] = {kk.x, kk.y, kk.z, kk.w}, qs[4] = {qq.x, qq.y, qq.z, qq.w};
#pragma unroll
                    for (int e = 0; e < 4; ++e) {
                        const int j = jj * 8 + e * 2;
                        S[j] = g * S[j] + __uint_as_float(ks[e] << 16) * v;
                        o += __uint_as_float(qs[e] << 16) * S[j];
                        S[j + 1] = g * S[j + 1] + __uint_as_float(ks[e] & 0xffff0000u) * v;
                        o += __uint_as_float(qs[e] & 0xffff0000u) * S[j + 1];
                    }
                }
                if (dir == 0) {
                    tmp[(size_t)m * D + h * 256 + dv] = f2bf(o);
                } else {
                    o += bf2f(tmp[(size_t)m * D + h * 256 + dv]);
                    const float mu = block_sum(o, red) * (1.f / 256.f);
                    const float xc = o - mu;
                    const float var = block_sum(xc * xc, red) * (1.f / 256.f);
                    const float y = xc * rsqrtf(var + EPS);
                    bf16_t* gp = Pb + (size_t)m * PW + C_RG + h * 256 + dv;
                    *gp = f2bf(y * bf2f(*gp));
                }
            }
            if (!lat) {
                float* so = p.out + O_NRET + ((((size_t)b * 2 + l) * 2 + dir) * 4 + h) * 128 * 256 + dv;
#pragma unroll
                for (int j = 0; j < 128; ++j) so[(size_t)j * 256] = S[j];
            }
        }
    }
}

DEV void lru_tile_naive(const Params& p, int l, int gc, int blk, int mode, float* lds) {
    float* lxc = lds; float* hs = lds + 64 * 128;
    bf16_t* Pb = ws_bf(p, OFF_P);
    const int tid = threadIdx.x;
    const int m0 = gc * 64;
    const bool lat = m0 >= NCTX;
    const int L = lat ? 2048 : 256;
    const int t0 = lat ? ((m0 - NCTX) & 2047) : (m0 & 255);
    for (int e = tid; e < 64 * 128; e += 256) {
        const int tt = e >> 7, c = e & 127, ch = blk * 128 + c;
        float acc = p.conv_b[l * D + ch];
#pragma unroll
        for (int j = 0; j < 4; ++j) {
            const int tp = t0 + tt + j - 1;
            if (tp >= 0 && tp < L) acc += p.conv_w[(l * 4 + j) * D + ch] * bf2f(Pb[(size_t)(m0 + tt + j - 1) * PW + C_LX + ch]);
        }
        lxc[e] = acc; hs[e] = 0.f;
    }
    __syncthreads();
    const int c = tid & 127, dir = tid >> 7, ch = blk * 128 + c;
    const bf16_t* Wa = ws_bf(p, OFF_LRUW) + ((size_t)((dir * 2 + 0) * 8 + blk) * 128 + c) * 128;
    const bf16_t* Wx = ws_bf(p, OFF_LRUW) + ((size_t)((dir * 2 + 1) * 8 + blk) * 128 + c) * 128;
    const float ba = p.lru_ba[(l * 2 + dir) * D + ch], bx = p.lru_bx[(l * 2 + dir) * D + ch];
    const float sp = softplusf(-p.lru_lambda[(l * 2 + dir) * D + ch]);
    float* LA = (float*)(p.ws + OFF_LRUC);
    float* LH = LA + 192 * 2 * 1024;
    const size_t ci = ((size_t)gc * 2 + dir) * 1024 + ch;
    float h = mode ? LH[ci] : 0.f, A = 1.f;
    for (int s = 0; s < 64; ++s) {
        const int tt = dir == 0 ? s : 63 - s;
        float r = ba, ig = bx;
        for (int j = 0; j < 128; ++j) { const float x = lxc[tt * 128 + j]; r += x * bf2f(Wa[j]); ig += x * bf2f(Wx[j]); }
        r = sigmf(r); ig = sigmf(ig);
        const float log_a = -8.f * r * sp;
        const float a = __expf(log_a);
        const float u = sqrtf(-expm1f(2.f * log_a)) * (ig * lxc[tt * 128 + c]);
        h = a * h + u; A *= a;
        if (mode) atomicAdd(&hs[tt * 128 + c], h);
    }
    if (!mode) { LA[ci] = A; LH[ci] = h; }
    else if (!lat) {
        const int b = m0 >> 8;
        if (dir == 0 && t0 == 192) p.out[O_NLRU + ((size_t)(b * 2 + l) * 2 + 0) * 1024 + ch] = h;
        if (dir == 1 && t0 == 0)   p.out[O_NLRU + ((size_t)(b * 2 + l) * 2 + 1) * 1024 + ch] = h;
    }
    __syncthreads();
    if (mode) {
        for (int e = tid; e < 64 * 128; e += 256) {
            const int tt = e >> 7, cc = e & 127;
            bf16_t* gp = Pb + (size_t)(m0 + tt) * PW + C_LG + blk * 128 + cc;
            *gp = f2bf(hs[e] * bf2f(*gp));
        }
    }
    __syncthreads();
}
DEV void phase_lru_tiles_naive(const Params& p, int l, int mode, float* lds) {
    for (int it = blockIdx.x; it < 192 * 8; it += gridDim.x) lru_tile_naive(p, l, it >> 3, it & 7, mode, lds);
}
template <bool REV>
DEV void lru_scan16(const float (&a)[4][4], const float (&u)[4][4], float cin, int g, int lc, float (&h)[4][4], float& cout, float& Aprod) {
    float carry = cin, Ap = 1.f;
#pragma unroll
    for (int ii = 0; ii < 4; ++ii) {
        const int i = REV ? 3 - ii : ii;
        float hl[4], cp[4];
        {
            float hh = 0.f, cc = 1.f;
#pragma unroll
            for (int rr = 0; rr < 4; ++rr) { const int r = REV ? 3 - rr : rr; hh = a[i][r] * hh + u[i][r]; cc *= a[i][r]; hl[r] = hh; cp[r] = cc; }
        }
        const float As = REV ? cp[0] : cp[3], Hs = REV ? hl[0] : hl[3];
        float Ag[4], Hg[4];
#pragma unroll
        for (int gg = 0; gg < 4; ++gg) { Ag[gg] = __shfl(As, lc + 16 * gg); Hg[gg] = __shfl(Hs, lc + 16 * gg); }
        float cur = carry, mine = carry;
#pragma unroll
        for (int sI = 0; sI < 4; ++sI) {
            const int gg = REV ? 3 - sI : sI;
            mine = (g == gg) ? cur : mine;
            cur = Ag[gg] * cur + Hg[gg];
            Ap *= Ag[gg];
        }
        carry = cur;
#pragma unroll
        for (int r = 0; r < 4; ++r) h[i][r] = hl[r] + cp[r] * mine;
    }
    cout = carry; Aprod = Ap;
}

DEV void lru_tile(const Params& p, int l, int gc, int blk, int mode, unsigned char* lds) {
    unsigned char* xa = lds; float* hs = (float*)(lds + 16384);
    bf16_t* Pb = ws_bf(p, OFF_P);
    const int tid = threadIdx.x, lane = tid & 63, w = tid >> 6, g = lane >> 4, lc = lane & 15;
    const int dir = w >> 1, chh = w & 1;
    const int m0 = gc * 64;
    const bool lat = m0 >= NCTX;
    const int L = lat ? 2048 : 256;
    const int t0 = lat ? ((m0 - NCTX) & 2047) : (m0 & 255);
    {
        const int chunk = tid & 15, chb = blk * 128 + chunk * 8;
        float cw[4][8], cb[8];
#pragma unroll
        for (int j = 0; j < 4; ++j) {
            const float4 a0 = *(const float4*)(p.conv_w + (size_t)(l * 4 + j) * D + chb), a1 = *(const float4*)(p.conv_w + (size_t)(l * 4 + j) * D + chb + 4);
            cw[j][0] = a0.x; cw[j][1] = a0.y; cw[j][2] = a0.z; cw[j][3] = a0.w; cw[j][4] = a1.x; cw[j][5] = a1.y; cw[j][6] = a1.z; cw[j][7] = a1.w;
        }
        {
            const float4 a0 = *(const float4*)(p.conv_b + (size_t)l * D + chb), a1 = *(const float4*)(p.conv_b + (size_t)l * D + chb + 4);
            cb[0] = a0.x; cb[1] = a0.y; cb[2] = a0.z; cb[3] = a0.w; cb[4] = a1.x; cb[5] = a1.y; cb[6] = a1.z; cb[7] = a1.w;
        }
#pragma unroll
        for (int i = 0; i < 4; ++i) {
            const int tt = (tid >> 4) + 16 * i;
            float acc[8];
#pragma unroll
            for (int e = 0; e < 8; ++e) acc[e] = cb[e];
#pragma unroll
            for (int j = 0; j < 4; ++j) {
                const int tp = t0 + tt + j - 1;
                if (tp >= 0 && tp < L) {
                    const uint4 v = *(const uint4*)(Pb + (size_t)(m0 + tt + j - 1) * PW + C_LX + chb);
                    acc[0] += cw[j][0] * __uint_as_float(v.x << 16); acc[1] += cw[j][1] * __uint_as_float(v.x & 0xffff0000u);
                    acc[2] += cw[j][2] * __uint_as_float(v.y << 16); acc[3] += cw[j][3] * __uint_as_float(v.y & 0xffff0000u);
                    acc[4] += cw[j][4] * __uint_as_float(v.z << 16); acc[5] += cw[j][5] * __uint_as_float(v.z & 0xffff0000u);
                    acc[6] += cw[j][6] * __uint_as_float(v.w << 16); acc[7] += cw[j][7] * __uint_as_float(v.w & 0xffff0000u);
                }
            }
            uint4 o;
            o.x = (unsigned)f2bf(acc[0]) | ((unsigned)f2bf(acc[1]) << 16); o.y = (unsigned)f2bf(acc[2]) | ((unsigned)f2bf(acc[3]) << 16);
            o.z = (unsigned)f2bf(acc[4]) | ((unsigned)f2bf(acc[5]) << 16); o.w = (unsigned)f2bf(acc[6]) | ((unsigned)f2bf(acc[7]) << 16);
            *(uint4*)(xa + tt * 256 + ((chunk ^ (tt & 15)) << 4)) = o;
        }
        if (mode) for (int e = tid; e < 64 * 128; e += 256) hs[e] = 0.f;
    }
    __syncthreads();
    float* LA = (float*)(p.ws + OFF_LRUC);
    float* LH = LA + 192 * 2 * 1024;
    const bf16_t* Wa = ws_bf(p, OFF_LRUW) + (size_t)((dir * 2 + 0) * 8 + blk) * 128 * 128;
    const bf16_t* Wx = ws_bf(p, OFF_LRUW) + (size_t)((dir * 2 + 1) * 8 + blk) * 128 * 128;
#pragma unroll 1
    for (int nh = 0; nh < 2; ++nh) {
        f32x4 accA[2][4], accX[2][4];
#pragma unroll
        for (int nf = 0; nf < 2; ++nf)
#pragma unroll
            for (int i = 0; i < 4; ++i) { accA[nf][i] = (f32x4){0.f, 0.f, 0.f, 0.f}; accX[nf][i] = (f32x4){0.f, 0.f, 0.f, 0.f}; }
#pragma unroll
        for (int ks = 0; ks < 4; ++ks) {
            bf16x8 af[4];
#pragma unroll
            for (int i = 0; i < 4; ++i) af[i] = *(const bf16x8*)(xa + (i * 16 + lc) * 256 + (((ks * 4 + g) ^ lc) << 4));
#pragma unroll
            for (int nf = 0; nf < 2; ++nf) {
                const int co = chh * 64 + (nh * 2 + nf) * 16 + lc;
                const bf16x8 bA = *(const bf16x8*)(Wa + (size_t)co * 128 + ks * 32 + g * 8);
                const bf16x8 bX = *(const bf16x8*)(Wx + (size_t)co * 128 + ks * 32 + g * 8);
#pragma unroll
                for (int i = 0; i < 4; ++i) {
                    accA[nf][i] = __builtin_amdgcn_mfma_f32_16x16x32_bf16(af[i], bA, accA[nf][i], 0, 0, 0);
                    accX[nf][i] = __builtin_amdgcn_mfma_f32_16x16x32_bf16(af[i], bX, accX[nf][i], 0, 0, 0);
                }
            }
        }
#pragma unroll
        for (int nf = 0; nf < 2; ++nf) {
            const int cl = chh * 64 + (nh * 2 + nf) * 16 + lc;
            const int ch = blk * 128 + cl;
            const float ba = p.lru_ba[(l * 2 + dir) * D + ch], bx = p.lru_bx[(l * 2 + dir) * D + ch];
            const float sp = softplusf(-p.lru_lambda[(l * 2 + dir) * D + ch]);
            const size_t ci = ((size_t)gc * 2 + dir) * 1024 + ch;
            const float cin = mode ? LH[ci] : 0.f;
            float a[4][4], u[4][4], h[4][4];
#pragma unroll
            for (int i = 0; i < 4; ++i)
#pragma unroll
                for (int r = 0; r < 4; ++r) {
                    const int tok = i * 16 + g * 4 + r;
                    const float x = bf2f(*(const bf16_t*)(xa + tok * 256 + (((cl >> 3) ^ (tok & 15)) << 4) + (cl & 7) * 2));
                    const float rg = sigmf(accA[nf][i][r] + ba), ig = sigmf(accX[nf][i][r] + bx);
                    const float la = -8.f * rg * sp;
                    a[i][r] = __expf(la);
                    u[i][r] = sqrtf(-expm1f(2.f * la)) * (ig * x);
                }
            float cout, Ap;
            if (dir == 0) lru_scan16<false>(a, u, cin, g, lc, h, cout, Ap);
            else          lru_scan16<true>(a, u, cin, g, lc, h, cout, Ap);
            if (!mode) { if (g == 0) { LA[ci] = Ap; LH[ci] = cout; } }
            else {
#pragma unroll
                for (int i = 0; i < 4; ++i)
#pragma unroll
                    for (int r = 0; r < 4; ++r) atomicAdd(&hs[(i * 16 + g * 4 + r) * 128 + cl], h[i][r]);
                if (!lat && g == 0) {
                    const int b = m0 >> 8;
                    if (dir == 0 && t0 == 192) p.out[O_NLRU + ((size_t)(b * 2 + l) * 2 + 0) * 1024 + ch] = cout;
                    if (dir == 1 && t0 == 0)   p.out[O_NLRU + ((size_t)(b * 2 + l) * 2 + 1) * 1024 + ch] = cout;
                }
            }
        }
    }
    __syncthreads();
    if (mode) {
#pragma unroll
        for (int i = 0; i < 4; ++i) {
            const int tt = (tid >> 4) + 16 * i, c8 = (tid & 15) * 8;
            bf16_t* gp = Pb + (size_t)(m0 + tt) * PW + C_LG + blk * 128 + c8;
            const uint4 gv = *(const uint4*)gp;
            const float4 h0 = *(const float4*)(hs + tt * 128 + c8), h1 = *(const float4*)(hs + tt * 128 + c8 + 4);
            uint4 o;
            o.x = (unsigned)f2bf(h0.x * __uint_as_float(gv.x << 16)) | ((unsigned)f2bf(h0.y * __uint_as_float(gv.x & 0xffff0000u)) << 16);
            o.y = (unsigned)f2bf(h0.z * __uint_as_float(gv.y << 16)) | ((unsigned)f2bf(h0.w * __uint_as_float(gv.y & 0xffff0000u)) << 16);
            o.z = (unsigned)f2bf(h1.x * __uint_as_float(gv.z << 16)) | ((unsigned)f2bf(h1.y * __uint_as_float(gv.z & 0xffff0000u)) << 16);
            o.w = (unsigned)f2bf(h1.z * __uint_as_float(gv.w << 16)) | ((unsigned)f2bf(h1.w * __uint_as_float(gv.w & 0xffff0000u)) << 16);
            *(uint4*)gp = o;
        }
    }
    __syncthreads();
}
DEV void phase_lru_tiles(const Params& p, int l, int mode, unsigned char* lds) {
    for (int it = blockIdx.x; it < 192 * 8; it += gridDim.x) lru_tile(p, l, it >> 3, it & 7, mode, lds);
}

DEV void phase_lru_carry(const Params& p, int l) {
    float* LA = (float*)(p.ws + OFF_LRUC);
    float* LH = LA + 192 * 2 * 1024;
    const int gt = blockIdx.x * blockDim.x + threadIdx.x, gs = gridDim.x * blockDim.x;
    for (int idx = gt; idx < 20 * 2 * 1024; idx += gs) {
        const int ch = idx & 1023, dir = (idx >> 10) & 1, seq = idx >> 11;
        const bool lat = seq >= 16;
        const int nch = lat ? 32 : 4;
        const int gc0 = lat ? 64 + (seq - 16) * 32 : seq * 4;
        float carry = lat ? p.state_lru[((size_t)((seq - 16) * 2 + l) * 2 + dir) * 1024 + ch] : 0.f;
        for (int s = 0; s < nch; ++s) {
            const int cidx = dir == 0 ? s : nch - 1 - s;
            const size_t ci = ((size_t)(gc0 + cidx) * 2 + dir) * 1024 + ch;
            const float A = LA[ci], Hh = LH[ci];
            LH[ci] = carry;
            carry = A * carry + Hh;
        }
    }
}

DEV void phase_merge_naive(const Params& p, int l) {
    bf16_t* Pb = ws_bf(p, OFF_P);
    const bf16_t* H = ws_bf(p, OFF_H);
    const int gt = blockIdx.x * blockDim.x + threadIdx.x, gs = gridDim.x * blockDim.x;
    for (int idx = gt; idx < M * D; idx += gs) {
        const int m = idx >> 10, d = idx & 1023;
        float tot = 0.f;
        for (int nb = 0; nb < 3; ++nb) {
            const float gl = dot_bf16(H + (size_t)m * D, ws_bf(p, OFF_WMG) + (size_t)(nb * D + d) * D, D) + p.b_merge[l * 3072 + nb * D + d];
            const float z = dot_bf16(Pb + (size_t)m * PW + (nb == 0 ? C_RG : nb == 1 ? C_LG : C_AQ), ws_bf(p, OFF_WBR) + ((size_t)nb * D + d) * D, D);
            tot += sigmf(gl) * z;
        }
        Pb[(size_t)m * PW + d] = f2bf(tot);
    }
}
DEV void phase_out_naive(const Params& p, int l) {
    bf16_t* Pb = ws_bf(p, OFF_P);
    const int gt = blockIdx.x * blockDim.x + threadIdx.x, gs = gridDim.x * blockDim.x;
    for (int idx = gt; idx < M * D; idx += gs) {
        const int m = idx >> 10, d = idx & 1023;
        const float v = dot_bf16(Pb + (size_t)m * PW, ws_bf(p, OFF_WOUT) + (size_t)d * D, D);
        ((float*)(Pb + (size_t)m * PW + 1024))[d] = v;
    }
}
DEV void phase_post(const Params& p, int l, float* red) {
    const int tid = threadIdx.x;
    for (int m = blockIdx.x; m < M; m += gridDim.x) {
        const float4 o = ((const float4*)(ws_bf(p, OFF_P) + (size_t)m * PW + 1024))[tid];
        const float ss = block_sum(o.x * o.x + o.y * o.y + o.z * o.z + o.w * o.w, red);
        const float rstd = rsqrtf(ss * (1.f / D) + EPS);
        const float4 x = ((const float4*)x_row(p, l, m))[tid];
        const float4 g = ((const float4*)(p.norm_post + l * D))[tid];
        const float4 gate = ((const float4*)(ws_mod(p) + (size_t)(l * 5 + cond_row(m)) * 3072 + 2048))[tid];
        float4 y;
        y.x = x.x + gate.x * (o.x * rstd * g.x);
        y.y = x.y + gate.y * (o.y * rstd * g.y);
        y.z = x.z + gate.z * (o.z * rstd * g.z);
        y.w = x.w + gate.w * (o.w * rstd * g.w);
        ((float4*)(p.out + (size_t)m * D))[tid] = y;
        if (l == 0) prenorm_row(p, 1, m, y, red);
    }
}

enum { PH_INIT = 0, PH_PRENORM, PH_GEMM1, PH_MIX1, PH_MIX2, PH_MIX3, PH_MERGE, PH_OUT, PH_POST, PH_COUNT };

DEV void run_phase(const Params& p, int ph, int l, float* lds) {
    switch (ph) {
    case PH_INIT:    phase_mod(p); phase_rope_table(p); __syncthreads(); phase_convert(p, 0, lds); break;
    case PH_PRENORM: phase_prenorm(p, l, lds); break;
    case PH_GEMM1:   phase_gemm1(p, l, (unsigned char*)lds); break;
    case PH_MIX1:    phase_attn(p, l, (unsigned char*)lds); __syncthreads(); phase_lru_tiles(p, l, 0, (unsigned char*)lds); break;
    case PH_MIX2:    phase_lru_carry(p, l); __syncthreads(); phase_ret_naive(p, l, lds); break;
    case PH_MIX3:    phase_lru_tiles(p, l, 1, (unsigned char*)lds); break;
    case PH_MERGE:   phase_merge(p, l, (unsigned char*)lds); break;
    case PH_OUT:     phase_out(p, l, (unsigned char*)lds); break;
    case PH_POST:    phase_post(p, l, lds); __syncthreads(); if (l == 0) phase_convert(p, 1, lds); break;
    }
}

#if !ONE_LAUNCH
__global__ void __launch_bounds__(256, 2) phase_kernel(Params p, int ph, int l) {
    __shared__ __attribute__((aligned(16))) float lds[16384];
    run_phase(p, ph, l, lds);
}
#endif

#if ONE_LAUNCH
__global__ void __launch_bounds__(256, 1) mega_kernel(Params p) {
    __shared__ __attribute__((aligned(16))) float lds[16384];
    cg::grid_group grid = cg::this_grid();
    run_phase(p, PH_INIT, 0, lds); grid.sync();
    run_phase(p, PH_PRENORM, 0, lds); grid.sync();
    for (int l = 0; l < 2; ++l) {
        for (int ph = PH_GEMM1; ph <= PH_POST; ++ph) {
            run_phase(p, ph, l, lds);
            if (!(l == 1 && ph == PH_POST)) grid.sync();
        }
    }
}
#endif

extern "C" void kernel_launch(void* const* d_in, const int* in_sizes, int n_in,
                              void* d_out, int out_size, void* d_ws, size_t ws_size,
                              hipStream_t stream) {
    static int grid_blocks = 0;
    if (grid_blocks == 0) {
        if (n_in != 26 || ws_size < WS_NEED || out_size != 25231360) {
            fprintf(stderr, "kernel_launch: unexpected n_in %d / ws_size %zu (need %zu) / out_size %d\n", n_in, ws_size, (size_t)WS_NEED, out_size);
            grid_blocks = -1; return;
        }
        int dev = 0, cus = 0, per_cu = 0;
        hipGetDevice(&dev);
        hipDeviceGetAttribute(&cus, hipDeviceAttributeMultiprocessorCount, dev);
#if ONE_LAUNCH
        hipOccupancyMaxActiveBlocksPerMultiprocessor(&per_cu, (const void*)mega_kernel, 256, 0);
#else
        hipOccupancyMaxActiveBlocksPerMultiprocessor(&per_cu, (const void*)phase_kernel, 256, 0);
#endif
        if (per_cu < 1) per_cu = 1;
#if ONE_LAUNCH
        if (per_cu > 1) per_cu = 1;
#else
        if (per_cu > 2) per_cu = 2;
#endif
        grid_blocks = cus * per_cu;
    }
    if (grid_blocks < 0) return;
    Params p{};
    const float** pp = (const float**)&p;
    for (int i = 0; i < 26; ++i) pp[i] = (const float*)d_in[i];
    p.out = (float*)d_out;
    p.ws = (unsigned char*)d_ws;
#if ONE_LAUNCH
    void* args[] = {&p};
    hipError_t e = hipLaunchCooperativeKernel((const void*)mega_kernel, dim3(grid_blocks), dim3(256), args, 0, stream);
    if (e != hipSuccess) fprintf(stderr, "cooperative launch failed: %s (grid %d)\n", hipGetErrorString(e), grid_blocks);
#else
    phase_kernel<<<grid_blocks, 256, 0, stream>>>(p, PH_INIT, 0);
    phase_kernel<<<grid_blocks, 256, 0, stream>>>(p, PH_PRENORM, 0);
    for (int l = 0; l < 2; ++l)
        for (int ph = PH_GEMM1; ph <= PH_POST; ++ph)
            phase_kernel<<<grid_blocks, 256, 0, stream>>>(p, ph, l);
#endif
}
```

```cpp
#include <hip/hip_runtime.h>
#include <hip/hip_cooperative_groups.h>
#include <cstdio>
#include <cstdint>
namespace cg = cooperative_groups;

#ifndef ONE_LAUNCH
#define ONE_LAUNCH 1
#endif

typedef unsigned short bf16_t;
#define DEV __device__ __forceinline__

constexpr int D = 1024;
constexpr int NCTX = 4096;
constexpr int NLAT = 8192;
constexpr int M = NCTX + NLAT;
constexpr int NW = 7680;
constexpr int N_RQ = 0, N_RK = 512, N_RV = 1024, N_RG = 2048, N_LX = 3072, N_LG = 4096,
              N_AQ = 5120, N_AK = 6144, N_AV = 6400, N_AG = 6656;
constexpr int PW = 6656;
constexpr int C_RQ = 0, C_RK = 512, C_RG = 1024, C_LX = 2048, C_LG = 3072,
              C_AQ = 4096, C_AK = 5120, C_AV = 5376, C_AG = 5632;
constexpr float EPS = 1e-6f;

constexpr size_t O_YP = 0, O_YS = 4194304, O_NK = 12582912, O_NV = 14680064, O_NRET = 16777216, O_NLRU = 25165824;

constexpr size_t OFF_MOD  = 0;
constexpr size_t OFF_LRUW = 122880;
constexpr size_t OFF_WBR  = OFF_LRUW + 1048576;
constexpr size_t OFF_WOUT = OFF_WBR + 6291456;
constexpr size_t OFF_WMG  = OFF_WOUT + 2097152;
constexpr size_t OFF_H    = OFF_WMG + 6291456;
constexpr size_t OFF_P    = OFF_H + (size_t)M * 1024 * 2;
constexpr size_t OFF_RVT  = OFF_P + (size_t)M * PW * 2;
constexpr size_t OFF_W1T  = OFF_RVT + (size_t)1024 * M * 2;
constexpr size_t OFF_OFTMP = OFF_W1T;
constexpr size_t OFF_LRUC = 262266880;
constexpr size_t OFF_ROPE = OFF_LRUC + (size_t)2 * 192 * 2 * 1024 * 4;
constexpr size_t WS_NEED  = OFF_ROPE + (size_t)2048 * 96 * 8;
static_assert(OFF_OFTMP + (size_t)M * 1024 * 2 <= OFF_LRUC, "overlap");
static_assert(WS_NEED <= 268435456, "ws budget");

struct Params {
    const float *x_prompt, *x_sample, *cache_k, *cache_v, *state_ret, *state_lru, *c, *c_ctx,
                *w_ada, *b_ada, *norm_pre, *norm_post, *w_in, *ret_decay, *conv_w, *conv_b,
                *lru_wa, *lru_ba, *lru_wx, *lru_bx, *lru_lambda, *att_sink, *w_branch, *w_merge, *b_merge, *w_out;
    float* out;
    unsigned char* ws;
};

DEV int TIDX() { int t = threadIdx.x; asm volatile("" : "+v"(t)); return t; }
DEV float bf2f(bf16_t v) { return __uint_as_float(((unsigned)v) << 16); }
DEV bf16_t f2bf(float f) { unsigned u = __float_as_uint(f); u += 0x7fffu + ((u >> 16) & 1u); return (bf16_t)(u >> 16); }
DEV float siluf(float x) { return x / (1.f + __expf(-x)); }
DEV float sigmf(float x) { return 1.f / (1.f + __expf(-x)); }
DEV float softplusf(float x) { return fmaxf(x, 0.f) + log1pf(__expf(-fabsf(x))); }

DEV float* ws_mod(const Params& p) { return (float*)(p.ws + OFF_MOD); }
DEV bf16_t* ws_bf(const Params& p, size_t off) { return (bf16_t*)(p.ws + off); }

DEV const float* x_row(const Params& p, int l, int m) {
    const float* xp = p.x_prompt; const float* xs = p.x_sample; const float* po = p.out;
    if (l == 0) return m < NCTX ? xp + (size_t)m * D : xs + (size_t)(m - NCTX) * D;
    return po + (size_t)m * D;
}
DEV int cond_row(int m) { return m < NCTX ? 0 : 1 + ((m - NCTX) >> 11); }

DEV float wave_sum(float v) {
#pragma unroll
    for (int o = 1; o < 64; o <<= 1) v += __shfl_xor(v, o);
    return v;
}
DEV float block_sum(float v, float* red) {
    v = wave_sum(v);
    __syncthreads();
    if ((TIDX() & 63) == 0) red[TIDX() >> 6] = v;
    __syncthreads();
    return (red[0] + red[1]) + (red[2] + red[3]);
}

DEV float dot_bf16(const bf16_t* a, const bf16_t* b, int K) {
    float acc = 0.f;
    const uint4* a4 = (const uint4*)a; const uint4* b4 = (const uint4*)b;
    for (int i = 0; i < K / 8; ++i) {
        uint4 x = a4[i], y = b4[i];
        unsigned xs[4] = {x.x, x.y, x.z, x.w}, ys[4] = {y.x, y.y, y.z, y.w};
#pragma unroll
        for (int j = 0; j < 4; ++j) {
            acc += __uint_as_float(xs[j] << 16) * __uint_as_float(ys[j] << 16);
            acc += __uint_as_float(xs[j] & 0xffff0000u) * __uint_as_float(ys[j] & 0xffff0000u);
        }
    }
    return acc;
}

DEV void phase_mod(const Params& p) {
    float* mod = ws_mod(p);
    const int gt = blockIdx.x * blockDim.x + TIDX(), gs = gridDim.x * blockDim.x;
    for (int idx = gt; idx < 2 * 5 * 3072; idx += gs) {
        const int j = idx % 3072, r = (idx / 3072) % 5, l = idx / 15360;
        const float* cctx = p.c_ctx; const float* cb = p.c;
        const float* cond = r == 0 ? cctx : cb + (r - 1) * D;
        const float* w = p.w_ada + (size_t)l * D * 3072 + j;
        float acc = p.b_ada[l * 3072 + j];
        for (int k = 0; k < D; ++k) acc += siluf(cond[k]) * w[(size_t)k * 3072];
        mod[idx] = acc;
    }
}

DEV void phase_rope_table(const Params& p) {
    float2* tab = (float2*)(p.ws + OFF_ROPE);
    const int gt = blockIdx.x * blockDim.x + TIDX(), gs = gridDim.x * blockDim.x;
    for (int idx = gt; idx < 2048 * 96; idx += gs) {
        const int t = idx / 96, e = idx % 96;
        int a, c; float nq;
        if (e < 64) { a = e >> 5; c = e & 31; nq = 32.f; } else { a = (e - 64) >> 4; c = (e - 64) & 15; nq = 16.f; }
        const float pos = (float)(a ? (t & 63) : (t >> 6));
        const float inv = powf(10000.f, -(float)c / nq);
        float sn, cs; sincosf(pos * inv, &sn, &cs);
        tab[idx] = make_float2(cs, sn);
    }
}

DEV void transpose_tile(const float* src, int K, int N, bf16_t* dst, int k0, int n0, float* tile) {
    const int tid = TIDX();
#pragma unroll 4
    for (int i = 0; i < 16; ++i) {
        const int r = i * 4 + (tid >> 6), c = tid & 63;
        tile[r * 65 + c] = src[(size_t)(k0 + r) * N + n0 + c];
    }
    __syncthreads();
#pragma unroll 4
    for (int i = 0; i < 16; ++i) {
        const int n = i * 4 + (tid >> 6), k = tid & 63;
        dst[(size_t)(n0 + n) * K + k0 + k] = f2bf(tile[k * 65 + n]);
    }
    __syncthreads();
}
DEV void phase_convert(const Params& p, int l, float* tile) {
    constexpr int T_IN = 16 * 120, T_MG = 16 * 48, T_BR = 3 * 256, T_OUT = 256, T_LRU = 32 * 4;
    constexpr int TOT = T_IN + T_MG + T_BR + T_OUT + T_LRU;
    for (int it = blockIdx.x; it < TOT; it += gridDim.x) {
        int r = it;
        if (r < T_IN) { transpose_tile(p.w_in + (size_t)l * D * NW, D, NW, ws_bf(p, OFF_W1T), (r / 120) * 64, (r % 120) * 64, tile); continue; }
        r -= T_IN;
        if (r < T_MG) { transpose_tile(p.w_merge + (size_t)l * D * 3072, D, 3072, ws_bf(p, OFF_WMG), (r / 48) * 64, (r % 48) * 64, tile); continue; }
        r -= T_MG;
        if (r < T_BR) { const int nb = r / 256, q = r % 256;
            transpose_tile(p.w_branch + ((size_t)l * 3 + nb) * D * D, D, D, ws_bf(p, OFF_WBR) + (size_t)nb * D * D, (q / 16) * 64, (q % 16) * 64, tile); continue; }
        r -= T_BR;
        if (r < T_OUT) { transpose_tile(p.w_out + (size_t)l * D * D, D, D, ws_bf(p, OFF_WOUT), (r / 16) * 64, (r % 16) * 64, tile); continue; }
        r -= T_OUT;
        {
            const int mat = r / 4, q = r % 4;
            const int dir = mat >> 4, gate = (mat >> 3) & 1, blk = mat & 7;
            const float* wa_ = p.lru_wa; const float* wx_ = p.lru_wx;
            const float* src = (gate ? wx_ : wa_) + (((size_t)l * 2 + dir) * 8 + blk) * 128 * 128;
            transpose_tile(src, 128, 128, ws_bf(p, OFF_LRUW) + (size_t)mat * 128 * 128, (q >> 1) * 64, (q & 1) * 64, tile);
        }
    }
}

DEV void prenorm_row(const Params& p, int l, int m, float4 v, float* red) {
    const int tid = TIDX();
    const float ss = block_sum(v.x * v.x + v.y * v.y + v.z * v.z + v.w * v.w, red);
    const float rstd = rsqrtf(ss * (1.f / D) + EPS);
    const float* mod = ws_mod(p) + (size_t)(l * 5 + cond_row(m)) * 3072;
    const float4 g = ((const float4*)(p.norm_pre + l * D))[tid];
    const float4 sh = ((const float4*)mod)[tid];
    const float4 sc = ((const float4*)(mod + 1024))[tid];
    bf16_t* h = ws_bf(p, OFF_H) + (size_t)m * D + tid * 4;
    ushort4 o;
    o.x = f2bf(v.x * rstd * g.x * (1.f + sc.x) + sh.x);
    o.y = f2bf(v.y * rstd * g.y * (1.f + sc.y) + sh.y);
    o.z = f2bf(v.z * rstd * g.z * (1.f + sc.z) + sh.z);
    o.w = f2bf(v.w * rstd * g.w * (1.f + sc.w) + sh.w);
    *(ushort4*)h = o;
}
DEV void phase_prenorm(const Params& p, int l, float* red) {
    for (int m = blockIdx.x; m < M; m += gridDim.x) {
        const float4 v = ((const float4*)x_row(p, l, m))[TIDX()];
        prenorm_row(p, l, m, v, red);
    }
}

DEV void p2_store(const Params& p, int l, int m, int n, float v, float partner) {
    const bool lat = m >= NCTX;
    const int t = lat ? ((m - NCTX) & 2047) : (m & 255);
    bf16_t* P = ws_bf(p, OFF_P) + (size_t)m * PW;
    float o = v;
    if (n < N_RV) {
        if (lat) {
            const int d = n & 127, c = d & 31, a = d >> 6, b = (d >> 5) & 1;
            const float2 cssn = ((const float2*)(p.ws + OFF_ROPE))[t * 96 + a * 32 + c];
            o = b ? v * cssn.x + partner * cssn.y : v * cssn.x - partner * cssn.y;
        }
        if (n < N_RK) o *= 0.08838834764831845f;
        P[n] = f2bf(o);
        return;
    }
    if (n < N_LX) { o = siluf(v);
    } else if (n < N_LG) {
    } else if (n < N_AQ) { o = siluf(v);
    } else if (n < N_AV) {
        if (lat) {
            const int d = (n - N_AQ) & 63, c = d & 15, a = d >> 5, b = (d >> 4) & 1;
            const float2 cssn = ((const float2*)(p.ws + OFF_ROPE))[t * 96 + 64 + a * 16 + c];
            o = b ? v * cssn.x + partner * cssn.y : v * cssn.x - partner * cssn.y;
        } else if (n >= N_AK) {
            p.out[O_NK + ((size_t)((m >> 8) * 2 + l) * 256 + t) * 256 + (n - N_AK)] = v;
        }
        if (n < N_AK) o *= 0.125f;
    } else if (n < N_AG) {
        if (!lat) p.out[O_NV + ((size_t)((m >> 8) * 2 + l) * 256 + t) * 256 + (n - N_AV)] = v;
    } else { o = siluf(v); }
    P[n - 1024] = f2bf(o);
}

typedef short bf16x8 __attribute__((ext_vector_type(8)));
typedef float f32x4 __attribute__((ext_vector_type(4)));

template <int FM, int FN>
DEV void gemm_mainloop(const bf16_t* __restrict__ A, int lda, const bf16_t* __restrict__ Bt, int ldb, int K,
                       f32x4 (&acc)[FM][FN], unsigned char* lds) {
    const int tid = TIDX(), lane = tid & 63, w = tid >> 6, wm = w >> 1, wn = w & 1;
    unsigned char* As = lds;
    unsigned char* Bs = lds + 2 * FM * 4096;
    const int srow = tid >> 3, sc = tid & 7;
    const bf16_t* ga = A + (size_t)srow * lda + sc * 8;
    const bf16_t* gb = Bt + (size_t)srow * ldb + sc * 8;
    const int woff = srow * 128 + ((sc ^ ((srow >> 1) & 7)) << 4);
    const int fsw = (lane >> 1) & 7;
    const int a_roff = (wm * 16 * FM + (lane & 15)) * 128;
    const int b_roff = (wn * 16 * FN + (lane & 15)) * 128;
    uint4 ra[FM], rb[FN];
#pragma unroll
    for (int i = 0; i < FM; ++i) ra[i] = *(const uint4*)(ga + (size_t)i * 32 * lda);
#pragma unroll
    for (int i = 0; i < FN; ++i) rb[i] = *(const uint4*)(gb + (size_t)i * 32 * ldb);
#pragma unroll
    for (int i = 0; i < FM; ++i) *(uint4*)(As + woff + i * 4096) = ra[i];
#pragma unroll
    for (int i = 0; i < FN; ++i) *(uint4*)(Bs + woff + i * 4096) = rb[i];
    __syncthreads();
    const int nk = K >> 6;
    for (int kt = 0; kt < nk; ++kt) {
        const int cur = kt & 1;
        if (kt + 1 < nk) {
            const int k0 = (kt + 1) << 6;
#pragma unroll
            for (int i = 0; i < FM; ++i) ra[i] = *(const uint4*)(ga + (size_t)i * 32 * lda + k0);
#pragma unroll
            for (int i = 0; i < FN; ++i) rb[i] = *(const uint4*)(gb + (size_t)i * 32 * ldb + k0);
        }
        const unsigned char* Ac = As + cur * (FM * 4096);
        const unsigned char* Bc = Bs + cur * (FN * 4096);
#pragma unroll
        for (int kk = 0; kk < 2; ++kk) {
            const int coff = ((kk * 4 + (lane >> 4)) ^ fsw) << 4;
            bf16x8 af[FM], bfr[FN];
#pragma unroll
            for (int i = 0; i < FM; ++i) af[i] = *(const bf16x8*)(Ac + a_roff + i * 2048 + coff);
#pragma unroll
            for (int j = 0; j < FN; ++j) bfr[j] = *(const bf16x8*)(Bc + b_roff + j * 2048 + coff);
#pragma unroll
            for (int i = 0; i < FM; ++i)
#pragma unroll
                for (int j = 0; j < FN; ++j)
                    acc[i][j] = __builtin_amdgcn_mfma_f32_16x16x32_bf16(af[i], bfr[j], acc[i][j], 0, 0, 0);
        }
        if (kt + 1 < nk) {
            unsigned char* An = As + (cur ^ 1) * (FM * 4096);
            unsigned char* Bn = Bs + (cur ^ 1) * (FN * 4096);
#pragma unroll
            for (int i = 0; i < FM; ++i) *(uint4*)(An + woff + i * 4096) = ra[i];
#pragma unroll
            for (int i = 0; i < FN; ++i) *(uint4*)(Bn + woff + i * 4096) = rb[i];
        }
        __syncthreads();
    }
}

DEV void phase_gemm1(const Params& p, int l, unsigned char* lds) {
    const bf16_t* H = ws_bf(p, OFF_H); const bf16_t* W = ws_bf(p, OFF_W1T);
    const int lane = TIDX() & 63, w = TIDX() >> 6, wm = w >> 1, wn = w & 1;
    constexpr int NT_N = NW / 128, NT = (M / 128) * NT_N;
    for (int tile = blockIdx.x; tile < NT; tile += gridDim.x) {
        const int m0 = (tile / NT_N) * 128, n0 = (tile % NT_N) * 128;
        f32x4 acc[4][4];
#pragma unroll
        for (int i = 0; i < 4; ++i)
#pragma unroll
            for (int j = 0; j < 4; ++j) acc[i][j] = (f32x4){0.f, 0.f, 0.f, 0.f};
        gemm_mainloop<4, 4>(H + (size_t)m0 * D, D, W + (size_t)n0 * D, D, D, acc, lds);
        if (n0 >= N_RV && n0 < N_RG) {
            bf16_t* RVT = ws_bf(p, OFF_RVT);
#pragma unroll
            for (int i = 0; i < 4; ++i)
#pragma unroll
                for (int j = 0; j < 4; ++j) {
                    const int m = m0 + wm * 64 + i * 16 + (lane >> 4) * 4;
                    const int chn = n0 - N_RV + wn * 64 + j * 16 + (lane & 15);
                    uint2 o;
                    o.x = (unsigned)f2bf(acc[i][j][0]) | ((unsigned)f2bf(acc[i][j][1]) << 16);
                    o.y = (unsigned)f2bf(acc[i][j][2]) | ((unsigned)f2bf(acc[i][j][3]) << 16);
                    *(uint2*)(RVT + (size_t)chn * M + m) = o;
                }
            continue;
        }
        const bool ret_rope = n0 < N_RV, att_rope = n0 >= N_AQ && n0 < N_AV;
#pragma unroll
        for (int i = 0; i < 4; ++i)
#pragma unroll
            for (int j = 0; j < 4; ++j) {
#pragma unroll
                for (int r = 0; r < 4; ++r) {
                    const int m = m0 + wm * 64 + i * 16 + (lane >> 4) * 4 + r;
                    const int n = n0 + wn * 64 + j * 16 + (lane & 15);
                    const float partner = ret_rope ? acc[i][j ^ 2][r] : att_rope ? acc[i][j ^ 1][r] : 0.f;
                    p2_store(p, l, m, n, acc[i][j][r], partner);
                }
            }
    }
}

DEV void phase_merge(const Params& p, int l, unsigned char* lds) {
    bf16_t* Pb = ws_bf(p, OFF_P);
    const bf16_t* H = ws_bf(p, OFF_H);
    const int lane = TIDX() & 63, w = TIDX() >> 6, wm = w >> 1, wn = w & 1;
    constexpr int NT_N = D / 128, NT = (M / 64) * NT_N;
    for (int tile = blockIdx.x; tile < NT; tile += gridDim.x) {
        const int m0 = (tile / NT_N) * 64, n0 = (tile % NT_N) * 128;
        f32x4 tot[2][4];
#pragma unroll
        for (int i = 0; i < 2; ++i)
#pragma unroll
            for (int j = 0; j < 4; ++j) tot[i][j] = (f32x4){0.f, 0.f, 0.f, 0.f};
#pragma unroll 1
        for (int nb = 0; nb < 3; ++nb) {
            f32x4 g[2][4], z[2][4];
#pragma unroll
            for (int i = 0; i < 2; ++i)
#pragma unroll
                for (int j = 0; j < 4; ++j) { g[i][j] = (f32x4){0.f, 0.f, 0.f, 0.f}; z[i][j] = (f32x4){0.f, 0.f, 0.f, 0.f}; }
            gemm_mainloop<2, 4>(H + (size_t)m0 * D, D, ws_bf(p, OFF_WMG) + (size_t)(nb * D + n0) * D, D, D, g, lds);
            const int bcol = nb == 0 ? C_RG : nb == 1 ? C_LG : C_AQ;
            gemm_mainloop<2, 4>(Pb + (size_t)m0 * PW + bcol, PW, ws_bf(p, OFF_WBR) + ((size_t)nb * D + n0) * D, D, D, z, lds);
#pragma unroll
            for (int j = 0; j < 4; ++j) {
                const float bias = p.b_merge[l * 3072 + nb * D + n0 + wn * 64 + j * 16 + (lane & 15)];
#pragma unroll
                for (int i = 0; i < 2; ++i)
#pragma unroll
                    for (int r = 0; r < 4; ++r) tot[i][j][r] += sigmf(g[i][j][r] + bias) * z[i][j][r];
            }
        }
#pragma unroll
        for (int i = 0; i < 2; ++i)
#pragma unroll
            for (int j = 0; j < 4; ++j)
#pragma unroll
                for (int r = 0; r < 4; ++r) {
                    const int m = m0 + wm * 32 + i * 16 + (lane >> 4) * 4 + r;
                    const int n = n0 + wn * 64 + j * 16 + (lane & 15);
                    Pb[(size_t)m * PW + n] = f2bf(tot[i][j][r]);
                }
    }
}

DEV void phase_out(const Params& p, int l, unsigned char* lds) {
    bf16_t* Pb = ws_bf(p, OFF_P);
    const int lane = TIDX() & 63, w = TIDX() >> 6, wm = w >> 1, wn = w & 1;
    constexpr int NT_N = D / 128, NT = (M / 64) * NT_N;
    for (int tile = blockIdx.x; tile < NT; tile += gridDim.x) {
        const int m0 = (tile / NT_N) * 64, n0 = (tile % NT_N) * 128;
        f32x4 acc[2][4];
#pragma unroll
        for (int i = 0; i < 2; ++i)
#pragma unroll
            for (int j = 0; j < 4; ++j) acc[i][j] = (f32x4){0.f, 0.f, 0.f, 0.f};
        gemm_mainloop<2, 4>(Pb + (size_t)m0 * PW, PW, ws_bf(p, OFF_WOUT) + (size_t)n0 * D, D, D, acc, lds);
#pragma unroll
        for (int i = 0; i < 2; ++i)
#pragma unroll
            for (int j = 0; j < 4; ++j)
#pragma unroll
                for (int r = 0; r < 4; ++r) {
                    const int m = m0 + wm * 32 + i * 16 + (lane >> 4) * 4 + r;
                    const int n = n0 + wn * 64 + j * 16 + (lane & 15);
                    ((float*)(Pb + (size_t)m * PW + 1024))[n] = acc[i][j][r];
                }
    }
}

DEV uint4 pack8(const float4 a, const float4 b) {
    uint4 r;
    r.x = (unsigned)f2bf(a.x) | ((unsigned)f2bf(a.y) << 16); r.y = (unsigned)f2bf(a.z) | ((unsigned)f2bf(a.w) << 16);
    r.z = (unsigned)f2bf(b.x) | ((unsigned)f2bf(b.y) << 16); r.w = (unsigned)f2bf(b.z) | ((unsigned)f2bf(b.w) << 16);
    return r;
}
DEV void attn_item(const Params& p, int l, int item, unsigned char* lds) {
    bf16_t* Pb = ws_bf(p, OFF_P);
    unsigned char* Ks = lds; unsigned char* Vt = lds + 8192;
    const int tid = TIDX(), lane = tid & 63, w = tid >> 6, g = lane >> 4, lc = lane & 15;
    const bool lat = item < 1024;
    int b, hk, qb, row0, L;
    if (lat) { b = item >> 8; hk = (item >> 6) & 3; qb = item & 63; row0 = NCTX + b * 2048; L = 2048; }
    else { const int it = item - 1024; b = it >> 5; hk = (it >> 3) & 3; qb = it & 7; row0 = b * 256; L = 256; }
    const int q0 = qb * 32;
    const int hq = hk * 4 + w;
    bf16x8 qfr[2][2];
#pragma unroll
    for (int qf = 0; qf < 2; ++qf)
#pragma unroll
        for (int ks = 0; ks < 2; ++ks)
            qfr[qf][ks] = *(const bf16x8*)(Pb + (size_t)(row0 + q0 + qf * 16 + lc) * PW + C_AQ + hq * 64 + ks * 32 + g * 8);
    f32x4 O[4][2];
    float mrun[2], lrun[2];
    const float sink = p.att_sink[l * 16 + hq];
#pragma unroll
    for (int qf = 0; qf < 2; ++qf) { mrun[qf] = sink; lrun[qf] = g == 0 ? 1.f : 0.f;
#pragma unroll
        for (int df = 0; df < 4; ++df) O[df][qf] = (f32x4){0.f, 0.f, 0.f, 0.f}; }
    const int kbase = q0 & ~63;
    const int nband = lat ? 5 : 4;
    const int ntile = lat ? 9 : 4;
    const int fsw = (lane >> 1) & 7;
    for (int t = 0; t < ntile; ++t) {
        const bool cache = t >= nband;
        int kp0 = 0;
        if (!cache) { kp0 = lat ? kbase + 64 * (t - 2) : 64 * t; if (kp0 < 0 || kp0 >= L) continue; }
        __syncthreads();
        if (!cache) {
#pragma unroll
            for (int i = 0; i < 2; ++i) {
                const int id = i * 256 + tid, row = id >> 3, c = id & 7;
                const uint4 v = *(const uint4*)(Pb + (size_t)(row0 + kp0 + row) * PW + C_AK + hk * 64 + c * 8);
                *(uint4*)(Ks + row * 128 + ((c ^ ((row >> 1) & 7)) << 4)) = v;
            }
#pragma unroll
            for (int i = 0; i < 2; ++i) {
                const int key = lane, c = w + 4 * i;
                const uint4 v = *(const uint4*)(Pb + (size_t)(row0 + kp0 + key) * PW + C_AV + hk * 64 + c * 8);
                bf16_t* dst = (bf16_t*)(Vt + (c * 8) * 136 + key * 2);
                dst[0 * 68] = (bf16_t)(v.x & 0xffff); dst[1 * 68] = (bf16_t)(v.x >> 16);
                dst[2 * 68] = (bf16_t)(v.y & 0xffff); dst[3 * 68] = (bf16_t)(v.y >> 16);
                dst[4 * 68] = (bf16_t)(v.z & 0xffff); dst[5 * 68] = (bf16_t)(v.z >> 16);
                dst[6 * 68] = (bf16_t)(v.w & 0xffff); dst[7 * 68] = (bf16_t)(v.w >> 16);
            }
        } else {
            const int j0 = (t - nband) * 64;
            const float* ck = p.cache_k + (size_t)((b * 2 + l) * 256 + j0) * 256 + hk * 64;
            const float* cv = p.cache_v + (size_t)((b * 2 + l) * 256 + j0) * 256 + hk * 64;
#pragma unroll
            for (int i = 0; i < 2; ++i) {
                const int id = i * 256 + tid, row = id >> 3, c = id & 7;
                const float4 x0 = *(const float4*)(ck + (size_t)row * 256 + c * 8), x1 = *(const float4*)(ck + (size_t)row * 256 + c * 8 + 4);
                *(uint4*)(Ks + row * 128 + ((c ^ ((row >> 1) & 7)) << 4)) = pack8(x0, x1);
            }
#pragma unroll
            for (int i = 0; i < 2; ++i) {
                const int key = lane, c = w + 4 * i;
                const float4 x0 = *(const float4*)(cv + (size_t)key * 256 + c * 8), x1 = *(const float4*)(cv + (size_t)key * 256 + c * 8 + 4);
                bf16_t* dst = (bf16_t*)(Vt + (c * 8) * 136 + key * 2);
                dst[0 * 68] = f2bf(x0.x); dst[1 * 68] = f2bf(x0.y); dst[2 * 68] = f2bf(x0.z); dst[3 * 68] = f2bf(x0.w);
                dst[4 * 68] = f2bf(x1.x); dst[5 * 68] = f2bf(x1.y); dst[6 * 68] = f2bf(x1.z); dst[7 * 68] = f2bf(x1.w);
            }
        }
        __syncthreads();
        f32x4 sc[4][2];
#pragma unroll
        for (int kf = 0; kf < 4; ++kf)
#pragma unroll
            for (int qf = 0; qf < 2; ++qf) sc[kf][qf] = (f32x4){0.f, 0.f, 0.f, 0.f};
#pragma unroll
        for (int ks = 0; ks < 2; ++ks) {
            bf16x8 ak[4];
#pragma unroll
            for (int kf = 0; kf < 4; ++kf) ak[kf] = *(const bf16x8*)(Ks + (kf * 16 + lc) * 128 + (((ks * 4 + g) ^ fsw) << 4));
#pragma unroll
            for (int kf = 0; kf < 4; ++kf)
#pragma unroll
                for (int qf = 0; qf < 2; ++qf)
                    sc[kf][qf] = __builtin_amdgcn_mfma_f32_16x16x32_bf16(ak[kf], qfr[qf][ks], sc[kf][qf], 0, 0, 0);
        }
        if (lat && !cache) {
#pragma unroll
            for (int kf = 0; kf < 4; ++kf)
#pragma unroll
                for (int qf = 0; qf < 2; ++qf)
#pragma unroll
                    for (int r = 0; r < 4; ++r) {
                        const int kpos = kp0 + kf * 16 + g * 4 + r, qpos = q0 + qf * 16 + lc;
                        const int dd = qpos - kpos;
                        if (dd > 128 || dd < -128) sc[kf][qf][r] = -INFINITY;
                    }
        }
        bf16x8 pb[2][2];
#pragma unroll
        for (int qf = 0; qf < 2; ++qf) {
            float mx = -INFINITY;
#pragma unroll
            for (int kf = 0; kf < 4; ++kf)
#pragma unroll
                for (int r = 0; r < 4; ++r) mx = fmaxf(mx, sc[kf][qf][r]);
            mx = fmaxf(mx, __shfl_xor(mx, 16));
            mx = fmaxf(mx, __shfl_xor(mx, 32));
            const float mnew = fmaxf(mrun[qf], mx);
            const float alpha = __expf(mrun[qf] - mnew);
            mrun[qf] = mnew;
            float ps = 0.f;
#pragma unroll
            for (int kf = 0; kf < 4; ++kf)
#pragma unroll
                for (int r = 0; r < 4; ++r) { const float e = __expf(sc[kf][qf][r] - mnew); sc[kf][qf][r] = e; ps += e; }
            lrun[qf] = lrun[qf] * alpha + ps;
#pragma unroll
            for (int df = 0; df < 4; ++df) O[df][qf] *= alpha;
#pragma unroll
            for (int s2 = 0; s2 < 2; ++s2) {
                bf16x8 v;
#pragma unroll
                for (int r = 0; r < 4; ++r) { v[r] = (short)f2bf(sc[2 * s2][qf][r]); v[4 + r] = (short)f2bf(sc[2 * s2 + 1][qf][r]); }
                pb[s2][qf] = v;
            }
        }
#pragma unroll
        for (int s2 = 0; s2 < 2; ++s2)
#pragma unroll
            for (int df = 0; df < 4; ++df) {
                const unsigned char* vr = Vt + (df * 16 + lc) * 136 + (32 * s2 + 4 * g) * 2;
                const uint2 lo = *(const uint2*)vr, hi = *(const uint2*)(vr + 32);
                union { uint4 u; bf16x8 v; } av; av.u = make_uint4(lo.x, lo.y, hi.x, hi.y);
#pragma unroll
                for (int qf = 0; qf < 2; ++qf)
                    O[df][qf] = __builtin_amdgcn_mfma_f32_16x16x32_bf16(av.v, pb[s2][qf], O[df][qf], 0, 0, 0);
            }
    }
#pragma unroll
    for (int qf = 0; qf < 2; ++qf) {
        float lt = lrun[qf];
        lt += __shfl_xor(lt, 16); lt += __shfl_xor(lt, 32);
        const float inv = 1.f / lt;
        const size_t m = (size_t)(row0 + q0 + qf * 16 + lc);
#pragma unroll
        for (int df = 0; df < 4; ++df) {
            const int col = hq * 64 + df * 16 + g * 4;
            const uint2 gt = *(const uint2*)(Pb + m * PW + C_AG + col);
            uint2 o;
            o.x = (unsigned)f2bf(O[df][qf][0] * inv * __uint_as_float(gt.x << 16)) | ((unsigned)f2bf(O[df][qf][1] * inv * __uint_as_float(gt.x & 0xffff0000u)) << 16);
            o.y = (unsigned)f2bf(O[df][qf][2] * inv * __uint_as_float(gt.y << 16)) | ((unsigned)f2bf(O[df][qf][3] * inv * __uint_as_float(gt.y & 0xffff0000u)) << 16);
            *(uint2*)(Pb + m * PW + C_AQ + col) = o;
        }
    }
}
DEV void phase_attn(const Params& p, int l, unsigned char* lds) {
    for (int item = blockIdx.x; item < 1536; item += gridDim.x) attn_item(p, l, item, lds);
}

constexpr size_t OFF_RS = OFF_W1T;
static_assert(OFF_RS + (size_t)4 * 4 * 2 * 8 * 32768 * 2 <= OFF_LRUC, "RS overlap");
DEV float ret_logg(const Params& p, int l, int dir, int h) { return -softplusf(-p.ret_decay[(l * 2 + dir) * 4 + h]); }

DEV void ret_kv_tile(const Params& p, int l, int item, unsigned char* lds) {
    bf16_t* Pb = ws_bf(p, OFF_P); const bf16_t* RVT = ws_bf(p, OFF_RVT);
    bf16_t* Kt = (bf16_t*)lds;
    const int tid = TIDX(), lane = tid & 63, w = tid >> 6, g = lane >> 4, lc = lane & 15;
    const bool lat = item < 448;
    int b, h, dir, dvh, c;
    if (lat) { dvh = item & 1; dir = (item >> 1) & 1; const int rest = item >> 2; const int cc = rest % 7, bh = rest / 7; h = bh & 3; b = bh >> 2; c = dir == 0 ? cc : cc + 1; }
    else { const int it = item - 448; dvh = it & 1; dir = (it >> 1) & 1; h = (it >> 2) & 3; b = it >> 4; c = 0; }
    const int row0 = lat ? NCTX + b * 2048 + c * 256 : b * 256;
    const float lg = ret_logg(p, l, dir, h);
    const int dvbase = dvh * 128 + w * 32;
    f32x4 acc[2][8];
#pragma unroll
    for (int i = 0; i < 2; ++i)
#pragma unroll
        for (int j = 0; j < 8; ++j) acc[i][j] = (f32x4){0.f, 0.f, 0.f, 0.f};
#pragma unroll 1
    for (int st = 0; st < 4; ++st) {
        {
            const int tok = lane, ti = st * 64 + tok;
            const float wt = __expf(lg * (float)(dir == 0 ? 255 - ti : ti));
#pragma unroll
            for (int i = 0; i < 4; ++i) {
                const int c8 = w + 4 * i;
                const uint4 v = *(const uint4*)(Pb + (size_t)(row0 + ti) * PW + C_RK + h * 128 + c8 * 8);
                bf16_t* dst = Kt + (c8 * 8) * 72 + tok;
                dst[0 * 72] = f2bf(wt * __uint_as_float(v.x << 16)); dst[1 * 72] = f2bf(wt * __uint_as_float(v.x & 0xffff0000u));
                dst[2 * 72] = f2bf(wt * __uint_as_float(v.y << 16)); dst[3 * 72] = f2bf(wt * __uint_as_float(v.y & 0xffff0000u));
                dst[4 * 72] = f2bf(wt * __uint_as_float(v.z << 16)); dst[5 * 72] = f2bf(wt * __uint_as_float(v.z & 0xffff0000u));
                dst[6 * 72] = f2bf(wt * __uint_as_float(v.w << 16)); dst[7 * 72] = f2bf(wt * __uint_as_float(v.w & 0xffff0000u));
            }
        }
        __syncthreads();
#pragma unroll
        for (int ks = 0; ks < 2; ++ks) {
            bf16x8 av[2];
#pragma unroll
            for (int mf = 0; mf < 2; ++mf)
                av[mf] = *(const bf16x8*)(RVT + (size_t)(h * 256 + dvbase + mf * 16 + lc) * M + row0 + st * 64 + ks * 32 + g * 8);
#pragma unroll
            for (int nf = 0; nf < 8; ++nf) {
                const bf16x8 bk = *(const bf16x8*)((const unsigned char*)Kt + (nf * 16 + lc) * 144 + (ks * 32 + g * 8) * 2);
#pragma unroll
                for (int mf = 0; mf < 2; ++mf) acc[mf][nf] = __builtin_amdgcn_mfma_f32_16x16x32_bf16(av[mf], bk, acc[mf][nf], 0, 0, 0);
            }
        }
        __syncthreads();
    }
    if (lat) {
        const int slot = dir == 0 ? c + 1 : c - 1;
        bf16_t* dst = ws_bf(p, OFF_RS) + ((size_t)((b * 4 + h) * 2 + dir) * 8 + slot) * 32768;
#pragma unroll
        for (int mf = 0; mf < 2; ++mf)
#pragma unroll
            for (int nf = 0; nf < 8; ++nf)
#pragma unroll
                for (int r = 0; r < 4; ++r) dst[(size_t)(dvbase + mf * 16 + g * 4 + r) * 128 + nf * 16 + lc] = f2bf(acc[mf][nf][r]);
    } else {
        float* dst = p.out + O_NRET + ((((size_t)b * 2 + l) * 2 + dir) * 4 + h) * 128 * 256;
#pragma unroll
        for (int mf = 0; mf < 2; ++mf)
#pragma unroll
            for (int nf = 0; nf < 8; ++nf)
                *(float4*)(dst + (size_t)(nf * 16 + lc) * 256 + dvbase + mf * 16 + g * 4) = make_float4(acc[mf][nf][0], acc[mf][nf][1], acc[mf][nf][2], acc[mf][nf][3]);
    }
}
DEV void phase_ret_kv(const Params& p, int l, unsigned char* lds) {
    for (int item = blockIdx.x; item < 704; item += gridDim.x) ret_kv_tile(p, l, item, lds);
}

DEV void phase_ret_scan(const Params& p, int l) {
    bf16_t* RS = ws_bf(p, OFF_RS);
    const int gt = blockIdx.x * blockDim.x + TIDX(), gs = gridDim.x * blockDim.x;
    for (int idx = gt; idx < 4 * 4 * 2 * 32768; idx += gs) {
        const int dk = idx & 127, dv = (idx >> 7) & 255, dir = (idx >> 15) & 1, h = (idx >> 16) & 3, b = idx >> 18;
        const float g256 = __expf(ret_logg(p, l, dir, h) * 256.f);
        float st = p.state_ret[(((((size_t)b * 2 + l) * 2 + dir) * 4 + h) * 128 + dk) * 256 + dv];
        bf16_t* base = RS + (size_t)((b * 4 + h) * 2 + dir) * 8 * 32768 + dv * 128 + dk;
        if (dir == 0) {
            base[0] = f2bf(st);
            for (int c = 1; c < 8; ++c) { st = g256 * st + bf2f(base[(size_t)c * 32768]); base[(size_t)c * 32768] = f2bf(st); }
        } else {
            base[(size_t)7 * 32768] = f2bf(st);
            for (int c = 6; c >= 0; --c) { st = g256 * st + bf2f(base[(size_t)c * 32768]); base[(size_t)c * 32768] = f2bf(st); }
        }
    }
}

DEV void ret_out_tile(const Params& p, int l, int item, unsigned char* lds) {
    bf16_t* Pb = ws_bf(p, OFF_P); const bf16_t* RVT = ws_bf(p, OFF_RVT);
    unsigned char* Ks = lds; unsigned char* Vt = lds + 16384; unsigned char* SB = Vt;
    const int tid = TIDX(), lane = tid & 63, w = tid >> 6, g = lane >> 4, lc = lane & 15;
    const bool lat = item < 512;
    int b, h, qb, rowc, qi0, c;
    if (lat) { qb = item & 31; h = (item >> 5) & 3; b = item >> 7; c = qb >> 2; rowc = NCTX + b * 2048 + c * 256; qi0 = (qb & 3) * 64; }
    else { const int it = item - 512; qb = it & 3; h = (it >> 2) & 3; b = it >> 4; c = 0; rowc = b * 256; qi0 = qb * 64; }
    const int qi = qi0 + w * 16 + lc;
    const size_t rowq = (size_t)(rowc + qi);
    const float lgf = ret_logg(p, l, 0, h), lgb = ret_logg(p, l, 1, h);
    bf16x8 qfr[4];
#pragma unroll
    for (int ks = 0; ks < 4; ++ks) qfr[ks] = *(const bf16x8*)(Pb + rowq * PW + C_RQ + h * 128 + ks * 32 + g * 8);
    f32x4 acc[16];
#pragma unroll
    for (int df = 0; df < 16; ++df) acc[df] = (f32x4){0.f, 0.f, 0.f, 0.f};
#pragma unroll 1
    for (int kt = 0; kt < 4; ++kt) {
        __syncthreads();
#pragma unroll
        for (int i = 0; i < 4; ++i) {
            const int id = i * 256 + tid, row = id >> 4, ch = id & 15;
            const uint4 v = *(const uint4*)(Pb + (size_t)(rowc + kt * 64 + row) * PW + C_RK + h * 128 + ch * 8);
            *(uint4*)(Ks + row * 256 + ((ch ^ (row & 15)) << 4)) = v;
        }
#pragma unroll
        for (int i = 0; i < 8; ++i) {
            const int id = i * 256 + tid, dv = id >> 3, ch = id & 7;
            const uint4 v = *(const uint4*)(RVT + (size_t)(h * 256 + dv) * M + rowc + kt * 64 + ch * 8);
            *(uint2*)(Vt + dv * 136 + ch * 16) = make_uint2(v.x, v.y);
            *(uint2*)(Vt + dv * 136 + ch * 16 + 8) = make_uint2(v.z, v.w);
        }
        __syncthreads();
        f32x4 sc[4];
#pragma unroll
        for (int kf = 0; kf < 4; ++kf) sc[kf] = (f32x4){0.f, 0.f, 0.f, 0.f};
#pragma unroll
        for (int ks = 0; ks < 4; ++ks)
#pragma unroll
            for (int kf = 0; kf < 4; ++kf) {
                const bf16x8 ak = *(const bf16x8*)(Ks + (kf * 16 + lc) * 256 + (((ks * 4 + g) ^ lc) << 4));
                sc[kf] = __builtin_amdgcn_mfma_f32_16x16x32_bf16(ak, qfr[ks], sc[kf], 0, 0, 0);
            }
        bf16x8 pb[2];
#pragma unroll
        for (int kf = 0; kf < 4; ++kf)
#pragma unroll
            for (int r = 0; r < 4; ++r) {
                const int dd = qi - (kt * 64 + kf * 16 + g * 4 + r);
                float wgt = 0.f;
                if (dd >= 0) wgt += __expf(lgf * (float)dd);
                if (dd <= 0) wgt += __expf(lgb * (float)(-dd));
                pb[kf >> 1][(kf & 1) * 4 + r] = (short)f2bf(sc[kf][r] * wgt);
            }
#pragma unroll
        for (int s2 = 0; s2 < 2; ++s2)
#pragma unroll
            for (int df = 0; df < 16; ++df) {
                const unsigned char* vr = Vt + (df * 16 + lc) * 136 + (32 * s2 + 4 * g) * 2;
                const uint2 lo = *(const uint2*)vr, hi = *(const uint2*)(vr + 32);
                union { uint4 u; bf16x8 v; } av; av.u = make_uint4(lo.x, lo.y, hi.x, hi.y);
                acc[df] = __builtin_amdgcn_mfma_f32_16x16x32_bf16(av.v, pb[s2], acc[df], 0, 0, 0);
                if ((df & 3) == 3) __builtin_amdgcn_sched_barrier(0);
            }
    }
    if (lat) {
#pragma unroll 1
        for (int dir = 0; dir < 2; ++dir) {
            const float qs = dir == 0 ? __expf(lgf * (float)(qi + 1)) : __expf(lgb * (float)(256 - qi));
            bf16x8 qx[4];
#pragma unroll
            for (int ks = 0; ks < 4; ++ks)
#pragma unroll
                for (int e = 0; e < 8; ++e) qx[ks][e] = (short)f2bf(qs * bf2f((bf16_t)qfr[ks][e]));
            const bf16_t* Sg = ws_bf(p, OFF_RS) + ((size_t)((b * 4 + h) * 2 + dir) * 8 + c) * 32768;
#pragma unroll 1
            for (int kh = 0; kh < 2; ++kh) {
                __syncthreads();
#pragma unroll
                for (int i = 0; i < 8; ++i) {
                    const int id = i * 256 + tid, row = id >> 3, ch = id & 7;
                    const uint4 v = *(const uint4*)(Sg + (size_t)row * 128 + kh * 64 + ch * 8);
                    *(uint4*)(SB + row * 128 + ((ch ^ ((row >> 1) & 7)) << 4)) = v;
                }
                __syncthreads();
#pragma unroll
                for (int k2 = 0; k2 < 2; ++k2)
#pragma unroll
                    for (int df = 0; df < 16; ++df) {
                        const bf16x8 as = *(const bf16x8*)(SB + (df * 16 + lc) * 128 + (((k2 * 4 + g) ^ ((lc >> 1) & 7)) << 4));
                        acc[df] = __builtin_amdgcn_mfma_f32_16x16x32_bf16(as, kh == 0 ? qx[k2] : qx[2 + k2], acc[df], 0, 0, 0);
                        if ((df & 3) == 3) __builtin_amdgcn_sched_barrier(0);
                    }
            }
        }
    }
    float s1 = 0.f;
#pragma unroll
    for (int df = 0; df < 16; ++df) s1 += (acc[df][0] + acc[df][1]) + (acc[df][2] + acc[df][3]);
    s1 += __shfl_xor(s1, 16); s1 += __shfl_xor(s1, 32);
    const float mu = s1 * (1.f / 256.f);
    float s2 = 0.f;
#pragma unroll
    for (int df = 0; df < 16; ++df)
#pragma unroll
        for (int r = 0; r < 4; ++r) { const float xc = acc[df][r] - mu; s2 += xc * xc; }
    s2 += __shfl_xor(s2, 16); s2 += __shfl_xor(s2, 32);
    const float rstd = rsqrtf(s2 * (1.f / 256.f) + EPS);
#pragma unroll
    for (int df = 0; df < 16; ++df) {
        bf16_t* gp = Pb + rowq * PW + C_RG + h * 256 + df * 16 + g * 4;
        const uint2 gv = *(const uint2*)gp;
        uint2 o;
        o.x = (unsigned)f2bf((acc[df][0] - mu) * rstd * __uint_as_float(gv.x << 16)) | ((unsigned)f2bf((acc[df][1] - mu) * rstd * __uint_as_float(gv.x & 0xffff0000u)) << 16);
        o.y = (unsigned)f2bf((acc[df][2] - mu) * rstd * __uint_as_float(gv.y << 16)) | ((unsigned)f2bf((acc[df][3] - mu) * rstd * __uint_as_float(gv.y & 0xffff0000u)) << 16);
        *(uint2*)gp = o;
    }
}
DEV void phase_ret_out(const Params& p, int l, unsigned char* lds) {
    for (int item = blockIdx.x; item < 768; item += gridDim.x) ret_out_tile(p, l, item, lds);
}

DEV void phase_ret_naive(const Params& p, int l, float* red) {
    bf16_t* Pb = ws_bf(p, OFF_P);
    bf16_t* tmp = ws_bf(p, OFF_OFTMP);
    const int dv = TIDX();
    for (int item = blockIdx.x; item < 80; item += gridDim.x) {
        const int seq = item >> 2, h = item & 3;
        const bool lat = seq >= 16;
        const int b = lat ? seq - 16 : seq;
        const int row0 = lat ? NCTX + b * 2048 : b * 256;
        const int L = lat ? 2048 : 256;
        for (int dir = 0; dir < 2; ++dir) {
            const float g = 1.f / (1.f + __expf(-p.ret_decay[(l * 2 + dir) * 4 + h]));
            float S[128];
            if (lat) {
                const float* s0 = p.state_ret + ((((size_t)b * 2 + l) * 2 + dir) * 4 + h) * 128 * 256 + dv;
#pragma unroll
                for (int j = 0; j < 128; ++j) S[j] = s0[(size_t)j * 256];
            } else {
#pragma unroll
                for (int j = 0; j < 128; ++j) S[j] = 0.f;
            }
            for (int s = 0; s < L; ++s) {
                const int t = dir == 0 ? s : L - 1 - s;
                const int m = row0 + t;
                const bf16_t* row = Pb + (size_t)m * PW;
                const float v = bf2f(ws_bf(p, OFF_RVT)[(size_t)(h * 256 + dv) * M + m]);
                const uint4* k4 = (const uint4*)(row + C_RK + h * 128);
                const uint4* q4 = (const uint4*)(row + C_RQ + h * 128);
                float o = 0.f;
#pragma unroll
                for (int jj = 0; jj < 16; ++jj) {
                    const uint4 kk = k4[jj], qq = q4[jj];
                    const unsigned ks[4] = {kk.x, kk.y, kk.z, kk.w}, qs[4] = {qq.x, qq.y, qq.z, qq.w};
#pragma unroll
                    for (int e = 0; e < 4; ++e) {
                        const int j = jj * 8 + e * 2;
                        S[j] = g * S[j] + __uint_as_float(ks[e] << 16) * v;
                        o += __uint_as_float(qs[e] << 16) * S[j];
                        S[j + 1] = g * S[j + 1] + __uint_as_float(ks[e] & 0xffff0000u) * v;
                        o += __uint_as_float(qs[e] & 0xffff0000u) * S[j + 1];
                    }
                }
                if (dir == 0) {
                    tmp[(size_t)m * D + h * 256 + dv] = f2bf(o);
                } else {
                    o += bf2f(tmp[(size_t)m * D + h * 256 + dv]);
                    const float mu = block_sum(o, red) * (1.f / 256.f);
                    const float xc = o - mu;
                    const float var = block_sum(xc * xc, red) * (1.f / 256.f);
                    const float y = xc * rsqrtf(var + EPS);
                    bf16_t* gp = Pb + (size_t)m * PW + C_RG + h * 256 + dv;
                    *gp = f2bf(y * bf2f(*gp));
                }
            }
            if (!lat) {
                float* so = p.out + O_NRET + ((((size_t)b * 2 + l) * 2 + dir) * 4 + h) * 128 * 256 + dv;
#pragma unroll
                for (int j = 0; j < 128; ++j) so[(size_t)j * 256] = S[j];
            }
        }
    }
}


template <bool REV>
DEV void lru_scan16(const float (&a)[4][4], const float (&u)[4][4], float cin, int g, int lc, float (&h)[4][4], float& cout, float& Aprod) {
    float carry = cin, Ap = 1.f;
#pragma unroll
    for (int ii = 0; ii < 4; ++ii) {
        const int i = REV ? 3 - ii : ii;
        float hl[4], cp[4];
        {
            float hh = 0.f, cc = 1.f;
#pragma unroll
            for (int rr = 0; rr < 4; ++rr) { const int r = REV ? 3 - rr : rr; hh = a[i][r] * hh + u[i][r]; cc *= a[i][r]; hl[r] = hh; cp[r] = cc; }
        }
        const float As = REV ? cp[0] : cp[3], Hs = REV ? hl[0] : hl[3];
        float Ag[4], Hg[4];
#pragma unroll
        for (int gg = 0; gg < 4; ++gg) { Ag[gg] = __shfl(As, lc + 16 * gg); Hg[gg] = __shfl(Hs, lc + 16 * gg); }
        float cur = carry, mine = carry;
#pragma unroll
        for (int sI = 0; sI < 4; ++sI) {
            const int gg = REV ? 3 - sI : sI;
            mine = (g == gg) ? cur : mine;
            cur = Ag[gg] * cur + Hg[gg];
            Ap *= Ag[gg];
        }
        carry = cur;
#pragma unroll
        for (int r = 0; r < 4; ++r) h[i][r] = hl[r] + cp[r] * mine;
    }
    cout = carry; Aprod = Ap;
}

DEV void lru_tile(const Params& p, int l, int gc, int blk, int mode, unsigned char* lds) {
    unsigned char* xa = lds; float* hs = (float*)(lds + 16384);
    bf16_t* Pb = ws_bf(p, OFF_P);
    const int tid = TIDX(), lane = tid & 63, w = tid >> 6, g = lane >> 4, lc = lane & 15;
    const int dir = w >> 1, chh = w & 1;
    const int m0 = gc * 64;
    const bool lat = m0 >= NCTX;
    const int L = lat ? 2048 : 256;
    const int t0 = lat ? ((m0 - NCTX) & 2047) : (m0 & 255);
    {
        const int chunk = tid & 15, chb = blk * 128 + chunk * 8;
        float cw[4][8], cb[8];
#pragma unroll
        for (int j = 0; j < 4; ++j) {
            const float4 a0 = *(const float4*)(p.conv_w + (size_t)(l * 4 + j) * D + chb), a1 = *(const float4*)(p.conv_w + (size_t)(l * 4 + j) * D + chb + 4);
            cw[j][0] = a0.x; cw[j][1] = a0.y; cw[j][2] = a0.z; cw[j][3] = a0.w; cw[j][4] = a1.x; cw[j][5] = a1.y; cw[j][6] = a1.z; cw[j][7] = a1.w;
        }
        {
            const float4 a0 = *(const float4*)(p.conv_b + (size_t)l * D + chb), a1 = *(const float4*)(p.conv_b + (size_t)l * D + chb + 4);
            cb[0] = a0.x; cb[1] = a0.y; cb[2] = a0.z; cb[3] = a0.w; cb[4] = a1.x; cb[5] = a1.y; cb[6] = a1.z; cb[7] = a1.w;
        }
#pragma unroll
        for (int i = 0; i < 4; ++i) {
            const int tt = (tid >> 4) + 16 * i;
            float acc[8];
#pragma unroll
            for (int e = 0; e < 8; ++e) acc[e] = cb[e];
#pragma unroll
            for (int j = 0; j < 4; ++j) {
                const int tp = t0 + tt + j - 1;
                if (tp >= 0 && tp < L) {
                    const uint4 v = *(const uint4*)(Pb + (size_t)(m0 + tt + j - 1) * PW + C_LX + chb);
                    acc[0] += cw[j][0] * __uint_as_float(v.x << 16); acc[1] += cw[j][1] * __uint_as_float(v.x & 0xffff0000u);
                    acc[2] += cw[j][2] * __uint_as_float(v.y << 16); acc[3] += cw[j][3] * __uint_as_float(v.y & 0xffff0000u);
                    acc[4] += cw[j][4] * __uint_as_float(v.z << 16); acc[5] += cw[j][5] * __uint_as_float(v.z & 0xffff0000u);
                    acc[6] += cw[j][6] * __uint_as_float(v.w << 16); acc[7] += cw[j][7] * __uint_as_float(v.w & 0xffff0000u);
                }
            }
            uint4 o;
            o.x = (unsigned)f2bf(acc[0]) | ((unsigned)f2bf(acc[1]) << 16); o.y = (unsigned)f2bf(acc[2]) | ((unsigned)f2bf(acc[3]) << 16);
            o.z = (unsigned)f2bf(acc[4]) | ((unsigned)f2bf(acc[5]) << 16); o.w = (unsigned)f2bf(acc[6]) | ((unsigned)f2bf(acc[7]) << 16);
            *(uint4*)(xa + tt * 256 + ((chunk ^ (tt & 15)) << 4)) = o;
        }
        if (mode) for (int e = tid; e < 64 * 128; e += 256) hs[e] = 0.f;
    }
    __syncthreads();
    float* LA = (float*)(p.ws + OFF_LRUC);
    float* LH = LA + 192 * 2 * 1024;
    const bf16_t* Wa = ws_bf(p, OFF_LRUW) + (size_t)((dir * 2 + 0) * 8 + blk) * 128 * 128;
    const bf16_t* Wx = ws_bf(p, OFF_LRUW) + (size_t)((dir * 2 + 1) * 8 + blk) * 128 * 128;
#pragma unroll 1
    for (int nq = 0; nq < 4; ++nq) {
        f32x4 accA[4], accX[4];
#pragma unroll
        for (int i = 0; i < 4; ++i) { accA[i] = (f32x4){0.f, 0.f, 0.f, 0.f}; accX[i] = (f32x4){0.f, 0.f, 0.f, 0.f}; }
        const int cl = chh * 64 + nq * 16 + lc;
#pragma unroll
        for (int ks = 0; ks < 4; ++ks) {
            const bf16x8 bA = *(const bf16x8*)(Wa + (size_t)cl * 128 + ks * 32 + g * 8);
            const bf16x8 bX = *(const bf16x8*)(Wx + (size_t)cl * 128 + ks * 32 + g * 8);
#pragma unroll
            for (int i = 0; i < 4; ++i) {
                const bf16x8 af = *(const bf16x8*)(xa + (i * 16 + lc) * 256 + (((ks * 4 + g) ^ lc) << 4));
                accA[i] = __builtin_amdgcn_mfma_f32_16x16x32_bf16(af, bA, accA[i], 0, 0, 0);
                accX[i] = __builtin_amdgcn_mfma_f32_16x16x32_bf16(af, bX, accX[i], 0, 0, 0);
            }
        }
        {
            const int ch = blk * 128 + cl;
            const float ba = p.lru_ba[(l * 2 + dir) * D + ch], bx = p.lru_bx[(l * 2 + dir) * D + ch];
            const float sp = softplusf(-p.lru_lambda[(l * 2 + dir) * D + ch]);
            const size_t ci = ((size_t)gc * 2 + dir) * 1024 + ch;
            const float cin = mode ? LH[ci] : 0.f;
            float a[4][4], u[4][4], h[4][4];
#pragma unroll
            for (int i = 0; i < 4; ++i)
#pragma unroll
                for (int r = 0; r < 4; ++r) {
                    const int tok = i * 16 + g * 4 + r;
                    const float x = bf2f(*(const bf16_t*)(xa + tok * 256 + (((cl >> 3) ^ (tok & 15)) << 4) + (cl & 7) * 2));
                    const float rg = sigmf(accA[i][r] + ba), ig = sigmf(accX[i][r] + bx);
                    const float la = -8.f * rg * sp;
                    a[i][r] = __expf(la);
                    u[i][r] = sqrtf(-expm1f(2.f * la)) * (ig * x);
                }
            float cout, Ap;
            if (dir == 0) lru_scan16<false>(a, u, cin, g, lc, h, cout, Ap);
            else          lru_scan16<true>(a, u, cin, g, lc, h, cout, Ap);
            if (!mode) { if (g == 0) { LA[ci] = Ap; LH[ci] = cout; } }
            else {
#pragma unroll
                for (int i = 0; i < 4; ++i)
#pragma unroll
                    for (int r = 0; r < 4; ++r) atomicAdd(&hs[(i * 16 + g * 4 + r) * 128 + cl], h[i][r]);
                if (!lat && g == 0) {
                    const int b = m0 >> 8;
                    if (dir == 0 && t0 == 192) p.out[O_NLRU + ((size_t)(b * 2 + l) * 2 + 0) * 1024 + ch] = cout;
                    if (dir == 1 && t0 == 0)   p.out[O_NLRU + ((size_t)(b * 2 + l) * 2 + 1) * 1024 + ch] = cout;
                }
            }
        }
    }
    __syncthreads();
    if (mode) {
#pragma unroll
        for (int i = 0; i < 4; ++i) {
            const int tt = (tid >> 4) + 16 * i, c8 = (tid & 15) * 8;
            bf16_t* gp = Pb + (size_t)(m0 + tt) * PW + C_LG + blk * 128 + c8;
            const uint4 gv = *(const uint4*)gp;
            const float4 h0 = *(const float4*)(hs + tt * 128 + c8), h1 = *(const float4*)(hs + tt * 128 + c8 + 4);
            uint4 o;
            o.x = (unsigned)f2bf(h0.x * __uint_as_float(gv.x << 16)) | ((unsigned)f2bf(h0.y * __uint_as_float(gv.x & 0xffff0000u)) << 16);
            o.y = (unsigned)f2bf(h0.z * __uint_as_float(gv.y << 16)) | ((unsigned)f2bf(h0.w * __uint_as_float(gv.y & 0xffff0000u)) << 16);
            o.z = (unsigned)f2bf(h1.x * __uint_as_float(gv.z << 16)) | ((unsigned)f2bf(h1.y * __uint_as_float(gv.z & 0xffff0000u)) << 16);
            o.w = (unsigned)f2bf(h1.z * __uint_as_float(gv.w << 16)) | ((unsigned)f2bf(h1.w * __uint_as_float(gv.w & 0xffff0000u)) << 16);
            *(uint4*)gp = o;
        }
    }
    __syncthreads();
}
DEV void phase_lru_tiles(const Params& p, int l, int mode, unsigned char* lds) {
    for (int it = blockIdx.x; it < 192 * 8; it += gridDim.x) lru_tile(p, l, it >> 3, it & 7, mode, lds);
}

DEV void phase_lru_carry(const Params& p, int l) {
    float* LA = (float*)(p.ws + OFF_LRUC);
    float* LH = LA + 192 * 2 * 1024;
    const int gt = blockIdx.x * blockDim.x + TIDX(), gs = gridDim.x * blockDim.x;
    for (int idx = gt; idx < 20 * 2 * 1024; idx += gs) {
        const int ch = idx & 1023, dir = (idx >> 10) & 1, seq = idx >> 11;
        const bool lat = seq >= 16;
        const int nch = lat ? 32 : 4;
        const int gc0 = lat ? 64 + (seq - 16) * 32 : seq * 4;
        float carry = lat ? p.state_lru[((size_t)((seq - 16) * 2 + l) * 2 + dir) * 1024 + ch] : 0.f;
        for (int s = 0; s < nch; ++s) {
            const int cidx = dir == 0 ? s : nch - 1 - s;
            const size_t ci = ((size_t)(gc0 + cidx) * 2 + dir) * 1024 + ch;
            const float A = LA[ci], Hh = LH[ci];
            LH[ci] = carry;
            carry = A * carry + Hh;
        }
    }
}

DEV void phase_post(const Params& p, int l, float* red) {
    const int tid = TIDX();
    for (int m = blockIdx.x; m < M; m += gridDim.x) {
        const float4 o = ((const float4*)(ws_bf(p, OFF_P) + (size_t)m * PW + 1024))[tid];
        const float ss = block_sum(o.x * o.x + o.y * o.y + o.z * o.z + o.w * o.w, red);
        const float rstd = rsqrtf(ss * (1.f / D) + EPS);
        const float4 x = ((const float4*)x_row(p, l, m))[tid];
        const float4 g = ((const float4*)(p.norm_post + l * D))[tid];
        const float4 gate = ((const float4*)(ws_mod(p) + (size_t)(l * 5 + cond_row(m)) * 3072 + 2048))[tid];
        float4 y;
        y.x = x.x + gate.x * (o.x * rstd * g.x);
        y.y = x.y + gate.y * (o.y * rstd * g.y);
        y.z = x.z + gate.z * (o.z * rstd * g.z);
        y.w = x.w + gate.w * (o.w * rstd * g.w);
        ((float4*)(p.out + (size_t)m * D))[tid] = y;
        if (l == 0) prenorm_row(p, 1, m, y, red);
    }
}

enum { PH_INIT = 0, PH_PRENORM, PH_GEMM1, PH_MIX1, PH_MIX2, PH_MIX3, PH_MERGE, PH_OUT, PH_POST, PH_COUNT };

DEV void run_phase(const Params& p, int ph, int l, float* lds) {
    switch (ph) {
    case PH_INIT:    phase_mod(p); phase_rope_table(p); __syncthreads(); phase_convert(p, 0, lds); break;
    case PH_PRENORM: phase_prenorm(p, l, lds); break;
    case PH_GEMM1:   phase_gemm1(p, l, (unsigned char*)lds); break;
    case PH_MIX1:    phase_attn(p, l, (unsigned char*)lds); __syncthreads(); phase_lru_tiles(p, l, 0, (unsigned char*)lds); __syncthreads(); phase_ret_kv(p, l, (unsigned char*)lds); break;
    case PH_MIX2:    phase_lru_carry(p, l); phase_ret_scan(p, l); break;
    case PH_MIX3:    phase_lru_tiles(p, l, 1, (unsigned char*)lds); __syncthreads(); phase_ret_out(p, l, (unsigned char*)lds); break;
    case PH_MERGE:   phase_merge(p, l, (unsigned char*)lds); break;
    case PH_OUT:     phase_out(p, l, (unsigned char*)lds); break;
    case PH_POST:    phase_post(p, l, lds); __syncthreads(); if (l == 0) phase_convert(p, 1, lds); break;
    }
}

#if !ONE_LAUNCH
__global__ void __launch_bounds__(256, 2) phase_kernel(Params p, int ph, int l) {
    __shared__ __attribute__((aligned(16))) float lds[16384];
    run_phase(p, ph, l, lds);
}
#endif

#if ONE_LAUNCH
__global__ void __launch_bounds__(256, 2) mega_kernel(Params p) {
    __shared__ __attribute__((aligned(16))) float lds[16384];
    cg::grid_group grid = cg::this_grid();
    run_phase(p, PH_INIT, 0, lds); grid.sync();
    run_phase(p, PH_PRENORM, 0, lds); grid.sync();
    for (int l = 0; l < 2; ++l) {
        for (int ph = PH_GEMM1; ph <= PH_POST; ++ph) {
            run_phase(p, ph, l, lds);
            if (!(l == 1 && ph == PH_POST)) grid.sync();
        }
    }
}
#endif

extern "C" void kernel_launch(void* const* d_in, const int* in_sizes, int n_in,
                              void* d_out, int out_size, void* d_ws, size_t ws_size,
                              hipStream_t stream) {
    static int grid_blocks = 0;
    if (grid_blocks == 0) {
        if (n_in != 26 || ws_size < WS_NEED || out_size != 25231360) {
            fprintf(stderr, "kernel_launch: unexpected n_in %d / ws_size %zu (need %zu) / out_size %d\n", n_in, ws_size, (size_t)WS_NEED, out_size);
            grid_blocks = -1; return;
        }
        int dev = 0, cus = 0, per_cu = 0;
        hipGetDevice(&dev);
        hipDeviceGetAttribute(&cus, hipDeviceAttributeMultiprocessorCount, dev);
#if ONE_LAUNCH
        hipOccupancyMaxActiveBlocksPerMultiprocessor(&per_cu, (const void*)mega_kernel, 256, 0);
#else
        hipOccupancyMaxActiveBlocksPerMultiprocessor(&per_cu, (const void*)phase_kernel, 256, 0);
#endif
        if (per_cu < 1) per_cu = 1;
#if ONE_LAUNCH
        if (per_cu > 2) per_cu = 2;
#else
        if (per_cu > 2) per_cu = 2;
#endif
        grid_blocks = cus * per_cu;
    }
    if (grid_blocks < 0) return;
    Params p{};
    const float** pp = (const float**)&p;
    for (int i = 0; i < 26; ++i) pp[i] = (const float*)d_in[i];
    p.out = (float*)d_out;
    p.ws = (unsigned char*)d_ws;
#if ONE_LAUNCH
    void* args[] = {&p};
    hipError_t e = hipLaunchCooperativeKernel((const void*)mega_kernel, dim3(grid_blocks), dim3(256), args, 0, stream);
    if (e != hipSuccess) fprintf(stderr, "cooperative launch failed: %s (grid %d)\n", hipGetErrorString(e), grid_blocks);
#else
    phase_kernel<<<grid_blocks, 256, 0, stream>>>(p, PH_INIT, 0);
    phase_kernel<<<grid_blocks, 256, 0, stream>>>(p, PH_PRENORM, 0);
    for (int l = 0; l < 2; ++l)
        for (int ph = PH_GEMM1; ph <= PH_POST; ++ph)
            phase_kernel<<<grid_blocks, 256, 0, stream>>>(p, ph, l);
#endif
}
```

```cpp
#include <hip/hip_runtime.h>
#include <hip/hip_cooperative_groups.h>
#include <cstdio>
#include <cstdint>
namespace cg = cooperative_groups;

#ifndef ONE_LAUNCH
#define ONE_LAUNCH 1
#endif

typedef unsigned short bf16_t;
#define DEV __device__ __forceinline__

constexpr int D = 1024;
constexpr int NCTX = 4096;
constexpr int NLAT = 8192;
constexpr int M = NCTX + NLAT;
constexpr int NW = 7680;
constexpr int N_RQ = 0, N_RK = 512, N_RV = 1024, N_RG = 2048, N_LX = 3072, N_LG = 4096,
              N_AQ = 5120, N_AK = 6144, N_AV = 6400, N_AG = 6656;
constexpr int PW = 6656;
constexpr int C_RQ = 0, C_RK = 512, C_RG = 1024, C_LX = 2048, C_LG = 3072,
              C_AQ = 4096, C_AK = 5120, C_AV = 5376, C_AG = 5632;
constexpr float EPS = 1e-6f;

constexpr size_t O_YP = 0, O_YS = 4194304, O_NK = 12582912, O_NV = 14680064, O_NRET = 16777216, O_NLRU = 25165824;

constexpr size_t OFF_MOD  = 0;
constexpr size_t OFF_LRUW = 122880;
constexpr size_t OFF_WBR  = OFF_LRUW + 1048576;
constexpr size_t OFF_WOUT = OFF_WBR + 6291456;
constexpr size_t OFF_WMG  = OFF_WOUT + 2097152;
constexpr size_t OFF_H    = OFF_WMG + 6291456;
constexpr size_t OFF_P    = OFF_H + (size_t)M * 1024 * 2;
constexpr size_t OFF_RVT  = OFF_P + (size_t)M * PW * 2;
constexpr size_t OFF_W1T  = OFF_RVT + (size_t)1024 * M * 2;
constexpr size_t OFF_OFTMP = OFF_W1T;
constexpr size_t OFF_LRUC = 262266880;
constexpr size_t OFF_ROPE = OFF_LRUC + (size_t)2 * 192 * 2 * 1024 * 4;
constexpr size_t WS_NEED  = OFF_ROPE + (size_t)2048 * 96 * 8;
static_assert(OFF_OFTMP + (size_t)M * 1024 * 2 <= OFF_LRUC, "overlap");
static_assert(WS_NEED <= 268435456, "ws budget");

struct Params {
    const float *x_prompt, *x_sample, *cache_k, *cache_v, *state_ret, *state_lru, *c, *c_ctx,
                *w_ada, *b_ada, *norm_pre, *norm_post, *w_in, *ret_decay, *conv_w, *conv_b,
                *lru_wa, *lru_ba, *lru_wx, *lru_bx, *lru_lambda, *att_sink, *w_branch, *w_merge, *b_merge, *w_out;
    float* out;
    unsigned char* ws;
};

DEV int TIDX() { int t = threadIdx.x; asm volatile("" : "+v"(t)); return t; }
DEV float bf2f(bf16_t v) { return __uint_as_float(((unsigned)v) << 16); }
DEV bf16_t f2bf(float f) { unsigned u = __float_as_uint(f); u += 0x7fffu + ((u >> 16) & 1u); return (bf16_t)(u >> 16); }
DEV float siluf(float x) { return x / (1.f + __expf(-x)); }
DEV float sigmf(float x) { return 1.f / (1.f + __expf(-x)); }
DEV float softplusf(float x) { return fmaxf(x, 0.f) + log1pf(__expf(-fabsf(x))); }

DEV float* ws_mod(const Params& p) { return (float*)(p.ws + OFF_MOD); }
DEV bf16_t* ws_bf(const Params& p, size_t off) { return (bf16_t*)(p.ws + off); }

DEV const float* x_row(const Params& p, int l, int m) {
    const float* xp = p.x_prompt; const float* xs = p.x_sample; const float* po = p.out;
    if (l == 0) return m < NCTX ? xp + (size_t)m * D : xs + (size_t)(m - NCTX) * D;
    return po + (size_t)m * D;
}
DEV int cond_row(int m) { return m < NCTX ? 0 : 1 + ((m - NCTX) >> 11); }

DEV float wave_sum(float v) {
#pragma unroll
    for (int o = 1; o < 64; o <<= 1) v += __shfl_xor(v, o);
    return v;
}
DEV float block_sum(float v, float* red) {
    v = wave_sum(v);
    __syncthreads();
    if ((TIDX() & 63) == 0) red[TIDX() >> 6] = v;
    __syncthreads();
    return (red[0] + red[1]) + (red[2] + red[3]);
}

DEV float dot_bf16(const bf16_t* a, const bf16_t* b, int K) {
    float acc = 0.f;
    const uint4* a4 = (const uint4*)a; const uint4* b4 = (const uint4*)b;
    for (int i = 0; i < K / 8; ++i) {
        uint4 x = a4[i], y = b4[i];
        unsigned xs[4] = {x.x, x.y, x.z, x.w}, ys[4] = {y.x, y.y, y.z, y.w};
#pragma unroll
        for (int j = 0; j < 4; ++j) {
            acc += __uint_as_float(xs[j] << 16) * __uint_as_float(ys[j] << 16);
            acc += __uint_as_float(xs[j] & 0xffff0000u) * __uint_as_float(ys[j] & 0xffff0000u);
        }
    }
    return acc;
}

DEV void phase_mod(const Params& p) {
    float* mod = ws_mod(p);
    const int gt = blockIdx.x * blockDim.x + TIDX(), gs = gridDim.x * blockDim.x;
    for (int idx = gt; idx < 2 * 5 * 3072; idx += gs) {
        const int j = idx % 3072, r = (idx / 3072) % 5, l = idx / 15360;
        const float* cctx = p.c_ctx; const float* cb = p.c;
        const float* cond = r == 0 ? cctx : cb + (r - 1) * D;
        const float* w = p.w_ada + (size_t)l * D * 3072 + j;
        float acc = p.b_ada[l * 3072 + j];
        for (int k = 0; k < D; ++k) acc += siluf(cond[k]) * w[(size_t)k * 3072];
        mod[idx] = acc;
    }
}

DEV void phase_rope_table(const Params& p) {
    float2* tab = (float2*)(p.ws + OFF_ROPE);
    const int gt = blockIdx.x * blockDim.x + TIDX(), gs = gridDim.x * blockDim.x;
    for (int idx = gt; idx < 2048 * 96; idx += gs) {
        const int t = idx / 96, e = idx % 96;
        int a, c; float nq;
        if (e < 64) { a = e >> 5; c = e & 31; nq = 32.f; } else { a = (e - 64) >> 4; c = (e - 64) & 15; nq = 16.f; }
        const float pos = (float)(a ? (t & 63) : (t >> 6));
        const float inv = powf(10000.f, -(float)c / nq);
        float sn, cs; sincosf(pos * inv, &sn, &cs);
        tab[idx] = make_float2(cs, sn);
    }
}

DEV int w1t_row(int n) {
    if (n < N_RV) return (n & ~48) | ((n & 16) << 1) | ((n & 32) >> 1);
    if (n < N_RG) return PW + (n - N_RV);
    return n - 1024;
}
DEV void transpose_tile(const float* src, int K, int N, bf16_t* dst, int k0, int n0, float* tile, bool w1map = false) {
    const int tid = TIDX();
#pragma unroll 4
    for (int i = 0; i < 16; ++i) {
        const int r = i * 4 + (tid >> 6), c = tid & 63;
        tile[r * 65 + c] = src[(size_t)(k0 + r) * N + n0 + c];
    }
    __syncthreads();
#pragma unroll 4
    for (int i = 0; i < 16; ++i) {
        const int n = i * 4 + (tid >> 6), k = tid & 63;
        const int dr = w1map ? w1t_row(n0 + n) : n0 + n;
        dst[(size_t)dr * K + k0 + k] = f2bf(tile[k * 65 + n]);
    }
    __syncthreads();
}
DEV void phase_convert(const Params& p, int l, float* tile) {
    constexpr int T_IN = 16 * 120, T_MG = 16 * 48, T_BR = 3 * 256, T_OUT = 256, T_LRU = 32 * 4;
    constexpr int TOT = T_IN + T_MG + T_BR + T_OUT + T_LRU;
    for (int it = blockIdx.x; it < TOT; it += gridDim.x) {
        int r = it;
        if (r < T_IN) { transpose_tile(p.w_in + (size_t)l * D * NW, D, NW, ws_bf(p, OFF_W1T), (r / 120) * 64, (r % 120) * 64, tile, true); continue; }
        r -= T_IN;
        if (r < T_MG) { transpose_tile(p.w_merge + (size_t)l * D * 3072, D, 3072, ws_bf(p, OFF_WMG), (r / 48) * 64, (r % 48) * 64, tile); continue; }
        r -= T_MG;
        if (r < T_BR) { const int nb = r / 256, q = r % 256;
            transpose_tile(p.w_branch + ((size_t)l * 3 + nb) * D * D, D, D, ws_bf(p, OFF_WBR) + (size_t)nb * D * D, (q / 16) * 64, (q % 16) * 64, tile); continue; }
        r -= T_BR;
        if (r < T_OUT) { transpose_tile(p.w_out + (size_t)l * D * D, D, D, ws_bf(p, OFF_WOUT), (r / 16) * 64, (r % 16) * 64, tile); continue; }
        r -= T_OUT;
        {
            const int mat = r / 4, q = r % 4;
            const int dir = mat >> 4, gate = (mat >> 3) & 1, blk = mat & 7;
            const float* wa_ = p.lru_wa; const float* wx_ = p.lru_wx;
            const float* src = (gate ? wx_ : wa_) + (((size_t)l * 2 + dir) * 8 + blk) * 128 * 128;
            transpose_tile(src, 128, 128, ws_bf(p, OFF_LRUW) + (size_t)mat * 128 * 128, (q >> 1) * 64, (q & 1) * 64, tile);
        }
    }
}

DEV void prenorm_row(const Params& p, int l, int m, float4 v, float* red) {
    const int tid = TIDX();
    const float ss = block_sum(v.x * v.x + v.y * v.y + v.z * v.z + v.w * v.w, red);
    const float rstd = rsqrtf(ss * (1.f / D) + EPS);
    const float* mod = ws_mod(p) + (size_t)(l * 5 + cond_row(m)) * 3072;
    const float4 g = ((const float4*)(p.norm_pre + l * D))[tid];
    const float4 sh = ((const float4*)mod)[tid];
    const float4 sc = ((const float4*)(mod + 1024))[tid];
    bf16_t* h = ws_bf(p, OFF_H) + (size_t)m * D + tid * 4;
    ushort4 o;
    o.x = f2bf(v.x * rstd * g.x * (1.f + sc.x) + sh.x);
    o.y = f2bf(v.y * rstd * g.y * (1.f + sc.y) + sh.y);
    o.z = f2bf(v.z * rstd * g.z * (1.f + sc.z) + sh.z);
    o.w = f2bf(v.w * rstd * g.w * (1.f + sc.w) + sh.w);
    *(ushort4*)h = o;
}
DEV void phase_prenorm(const Params& p, int l, float* red) {
    for (int m = blockIdx.x; m < M; m += gridDim.x) {
        const float4 v = ((const float4*)x_row(p, l, m))[TIDX()];
        prenorm_row(p, l, m, v, red);
    }
}

typedef short bf16x8 __attribute__((ext_vector_type(8)));
typedef float f32x4 __attribute__((ext_vector_type(4)));
#define LAS __attribute__((address_space(3)))
namespace g8 {
constexpr int BK = 64, HALF = 128, HTB = HALF * BK * 2, STAGE_BYTES = 8 * HTB;
DEV int lds_byte(int r, int c) { const int st = (r >> 4) * 2 + (c >> 5), rr = r & 15, cc = c & 31, ob = rr * 64 + cc * 2; return st * 1024 + (ob ^ (((ob >> 9) & 1) << 5)); }
DEV void stage_rc(int b, int& R, int& C) { const int st = b / 1024, sb = b % 1024, swz = sb ^ (((sb >> 9) & 1) << 5); R = (st >> 1) * 16 + swz / 64; C = (st & 1) * 32 + (swz % 64) / 2; }
struct Unit { const char* a; const char* b; int kind, pm, pn; };

template <class Sched, class Epi>
DEV void gemm_phase(LAS unsigned char* lds, const unsigned lda, const unsigned ldb, const int nt, const Sched& S, const Epi& E) {
    const int tid = TIDX(), wid = __builtin_amdgcn_readfirstlane(tid >> 6), lane = tid & 63, wr = wid >> 2, wc = wid & 3, fr = lane & 15, fq = lane >> 4;
    unsigned voffA[2], voffB[2];
#pragma unroll
    for (int i = 0; i < 2; ++i) { int R, C; stage_rc(tid * 16 + i * 8192, R, C); voffA[i] = (unsigned)R * lda + (unsigned)C * 2u; voffB[i] = (unsigned)R * ldb + (unsigned)C * 2u; }
    const size_t kstep = (size_t)(BK * 2);
    const size_t hstepA = (size_t)HALF * lda, hstepB = (size_t)HALF * ldb;
    const unsigned ldsw = (unsigned)wid * 1024u;
    const int aoff = lds_byte(wr * 64 + fr, fq * 8), boff = lds_byte(wc * 32 + fr, fq * 8);
#define G8_SA(b, h) (((b) * 2 + (h)) * HTB)
#define G8_SB(b, h) ((4 + (b) * 2 + (h)) * HTB)
#define G8_STAGE(bufoff, gbase, voff) do { _Pragma("unroll") for (int _i = 0; _i < 2; ++_i) \
        __builtin_amdgcn_global_load_lds((const unsigned*)((const char*)(gbase) + (voff)[_i]), (LAS unsigned*)(lds + (bufoff) + ldsw + _i * 8192), 16, 0, 0); } while (0)
#define G8_LDA(dst, b, h) do { _Pragma("unroll") for (int m = 0; m < 4; ++m) _Pragma("unroll") for (int k = 0; k < 2; ++k) dst[m][k] = *(const LAS bf16x8*)(lds + G8_SA(b, h) + aoff + m * 2048 + k * 1024); } while (0)
#define G8_LDB(dst, b, h) do { _Pragma("unroll") for (int n = 0; n < 2; ++n) _Pragma("unroll") for (int k = 0; k < 2; ++k) dst[n][k] = *(const LAS bf16x8*)(lds + G8_SB(b, h) + boff + n * 2048 + k * 1024); } while (0)
#define G8_MMA(ai, bj, At, Bt) do { __builtin_amdgcn_s_setprio(1); _Pragma("unroll") for (int m = 0; m < 4; ++m) _Pragma("unroll") for (int n = 0; n < 2; ++n) _Pragma("unroll") for (int k = 0; k < 2; ++k) \
        acc[ai][bj][m][n] = __builtin_amdgcn_mfma_f32_16x16x32_bf16(Bt[n][k], At[m][k], acc[ai][bj][m][n], 0, 0, 0); __builtin_amdgcn_s_setprio(0); } while (0)
#define G8_WAIT_V(n) asm volatile("s_waitcnt vmcnt(" #n ")" ::: "memory")
#define G8_WAIT_L(n) asm volatile("s_waitcnt lgkmcnt(" #n ")" ::: "memory")
#define G8_BAR __builtin_amdgcn_s_barrier()
#define G8_SCHED __builtin_amdgcn_sched_barrier(0)
    Unit cur, nxt; int ui = 0;
    if (!S.next(0, cur)) return;
    f32x4 acc[2][2][4][2];
#pragma unroll
    for (int a = 0; a < 2; ++a)
#pragma unroll
        for (int b = 0; b < 2; ++b)
#pragma unroll
            for (int m = 0; m < 4; ++m)
#pragma unroll
                for (int n = 0; n < 2; ++n) acc[a][b][m][n] = (f32x4){0.f, 0.f, 0.f, 0.f};
    bf16x8 At[4][2], B0[2][2], B1[2][2];
    const char* cA = cur.a; const char* cB = cur.b;
    G8_STAGE(G8_SB(0, 0), cB, voffB); G8_STAGE(G8_SB(0, 1), cB + hstepB, voffB); G8_STAGE(G8_SA(0, 0), cA, voffA); G8_STAGE(G8_SA(0, 1), cA + hstepA, voffA);
    if (wr == 1) G8_BAR;
    G8_WAIT_V(2); G8_BAR;
    G8_STAGE(G8_SB(1, 0), cB + kstep, voffB); G8_STAGE(G8_SA(1, 0), cA + kstep, voffA); G8_STAGE(G8_SB(1, 1), cB + hstepB + kstep, voffB);
    G8_WAIT_V(6); G8_BAR;
    for (;;) {
        const bool has_next = S.next(ui + 1, nxt);
        const char* nA = has_next ? nxt.a : cA; const char* nB = has_next ? nxt.b : cB;
        for (int t = 0; t < nt; t += 2) {
            const bool last = (t == nt - 2);
            const char* a1 = cA + (size_t)(t + 1) * kstep;
            const char* a2 = last ? nA : cA + (size_t)(t + 2) * kstep; const char* b2 = last ? nB : cB + (size_t)(t + 2) * kstep;
            const char* a3 = a2 + kstep; const char* b3 = b2 + kstep;
            G8_LDB(B0, 0, 0); G8_LDB(B1, 0, 1); G8_SCHED; G8_LDA(At, 0, 0); G8_STAGE(G8_SA(1, 1), a1 + hstepA, voffA);
            G8_WAIT_V(8); G8_WAIT_L(0); G8_BAR; G8_MMA(0, 0, At, B0); G8_MMA(0, 1, At, B1); G8_BAR; G8_SCHED;
            G8_LDA(At, 0, 1); G8_STAGE(G8_SB(0, 0), b2, voffB); G8_STAGE(G8_SB(0, 1), b2 + hstepB, voffB); G8_STAGE(G8_SA(0, 0), a2, voffA);
            G8_WAIT_V(8); G8_WAIT_L(0); G8_BAR; G8_MMA(1, 0, At, B0); G8_MMA(1, 1, At, B1); G8_BAR; G8_SCHED;
            G8_LDB(B0, 1, 0); G8_LDB(B1, 1, 1); G8_SCHED; G8_LDA(At, 1, 0); G8_STAGE(G8_SA(0, 1), a2 + hstepA, voffA);
            G8_WAIT_V(8); G8_WAIT_L(0); G8_BAR; G8_MMA(0, 0, At, B0); G8_MMA(0, 1, At, B1); G8_BAR; G8_SCHED;
            G8_LDA(At, 1, 1); G8_STAGE(G8_SB(1, 0), b3, voffB); G8_STAGE(G8_SB(1, 1), b3 + hstepB, voffB); G8_STAGE(G8_SA(1, 0), a3, voffA);
            G8_WAIT_V(8); G8_WAIT_L(0); G8_BAR; G8_MMA(1, 0, At, B0); G8_MMA(1, 1, At, B1); G8_BAR; G8_SCHED;
        }
        if (wr == 0) G8_BAR;
        E(acc, cur, wr, wc, fr, fq);
        if (!has_next) break;
#pragma unroll
        for (int a = 0; a < 2; ++a)
#pragma unroll
            for (int b = 0; b < 2; ++b)
#pragma unroll
                for (int m = 0; m < 4; ++m)
#pragma unroll
                    for (int n = 0; n < 2; ++n) acc[a][b][m][n] = (f32x4){0.f, 0.f, 0.f, 0.f};
        cur = nxt; cA = nA; cB = nB; ++ui;
        if (wr == 1) G8_BAR;
    }
    G8_WAIT_V(0);
    G8_BAR;
#undef G8_SA
#undef G8_SB
#undef G8_STAGE
#undef G8_LDA
#undef G8_LDB
#undef G8_MMA
#undef G8_WAIT_V
#undef G8_WAIT_L
#undef G8_BAR
#undef G8_SCHED
}

DEV void grid_unit(int wgid, int nM, int nN, int& pm, int& pn) {
    const int nwg = nM * nN, q = nwg / 8, r = nwg % 8, xcd = wgid % 8, off = wgid / 8;
    wgid = (xcd < r ? xcd * (q + 1) : r * (q + 1) + (xcd - r) * q) + off;
    const int nig = 8 * nN, gid = wgid / nig, fm = gid * 8, gsz = (nM - fm) < 8 ? (nM - fm) : 8;
    pm = fm + ((wgid % nig) % gsz); pn = (wgid % nig) / gsz;
}
DEV unsigned pk2(float lo, float hi) { return (unsigned)f2bf(lo) | ((unsigned)f2bf(hi) << 16); }
DEV uint2 pk4(const f32x4 v) { return make_uint2(pk2(v[0], v[1]), pk2(v[2], v[3])); }
DEV float lo16(unsigned u) { return __uint_as_float(u << 16); }
DEV float hi16(unsigned u) { return __uint_as_float(u & 0xffff0000u); }
}

struct SchedG1 {
    const char* H; const char* W; int G, c;
    DEV bool next(int i, g8::Unit& u) const {
        int L = i * G + c;
        if (L >= 1440) return false;
        if (L < 1248) { g8::grid_unit(L, 48, 26, u.pm, u.pn); u.kind = 0; u.a = H + (size_t)u.pm * 256 * 2048; u.b = W + (size_t)u.pn * 256 * 2048; }
        else { g8::grid_unit(L - 1248, 4, 48, u.pm, u.pn); u.kind = 1; u.a = W + (size_t)(PW + u.pm * 256) * 2048; u.b = H + (size_t)u.pn * 256 * 2048; }
        return true;
    }
};
struct EpiG1 {
    unsigned char* ws; float* out; int l;
    DEV void operator()(const f32x4 (&acc)[2][2][4][2], const g8::Unit& u, int wr, int wc, int fr, int fq) const {
        using namespace g8;
        bf16_t* Pb = (bf16_t*)(ws + OFF_P);
        if (u.kind == 1) {
            bf16_t* RVT = (bf16_t*)(ws + OFF_RVT);
#pragma unroll
            for (int ai = 0; ai < 2; ++ai)
#pragma unroll
                for (int bj = 0; bj < 2; ++bj)
#pragma unroll
                    for (int m = 0; m < 4; ++m)
#pragma unroll
                        for (int n = 0; n < 2; ++n) {
                            const int ch = u.pm * 256 + ai * 128 + wr * 64 + m * 16 + fr;
                            const int tok = u.pn * 256 + bj * 128 + wc * 32 + n * 16 + fq * 4;
                            *(uint2*)(RVT + (size_t)ch * M + tok) = pk4(acc[ai][bj][m][n]);
                        }
            return;
        }
        const int pn = u.pn;
        const bool rope_ret = pn < 4, rope_att = pn >= 16 && pn <= 20;
#pragma unroll
        for (int ai = 0; ai < 2; ++ai)
#pragma unroll
            for (int m = 0; m < 4; ++m) {
                const int row = u.pm * 256 + ai * 128 + wr * 64 + m * 16 + fr;
                const bool lat = row >= NCTX;
                const int t = lat ? ((row - NCTX) & 2047) : (row & 255);
                bf16_t* Pr = Pb + (size_t)row * PW;
#pragma unroll
                for (int bj = 0; bj < 2; ++bj) {
                    const int cb = pn * 256 + bj * 128 + wc * 32 + fq * 4;
                    if (rope_ret || rope_att) {
                        f32x4 x1 = acc[ai][bj][m][0], x2 = acc[ai][bj][m][1];
                        int lc1, lc2, te;
                        if (rope_ret) { lc1 = pn * 256 + bj * 128 + (wc >> 1) * 64 + (wc & 1) * 16 + fq * 4; lc2 = lc1 + 32; te = (wc >> 1) * 32 + (wc & 1) * 16 + fq * 4; }
                        else { lc1 = cb; lc2 = cb + 16; te = 64 + (wc & 1) * 16 + fq * 4; }
                        if (rope_att && !lat && pn == 20) {
                            float* ok = out + O_NK + ((size_t)((row >> 8) * 2 + l) * 256 + t) * 256 + (lc1 - C_AK);
                            *(float4*)ok = make_float4(x1[0], x1[1], x1[2], x1[3]);
                            *(float4*)(ok + 16) = make_float4(x2[0], x2[1], x2[2], x2[3]);
                        }
                        if (lat) {
                            const float4* tb = (const float4*)((const float2*)(ws + OFF_ROPE) + (size_t)t * 96 + te);
                            const float4 c01 = tb[0], c23 = tb[1];
                            const float cs[4] = {c01.x, c01.z, c23.x, c23.z}, sn[4] = {c01.y, c01.w, c23.y, c23.w};
                            f32x4 o1, o2;
#pragma unroll
                            for (int j = 0; j < 4; ++j) { o1[j] = x1[j] * cs[j] - x2[j] * sn[j]; o2[j] = x2[j] * cs[j] + x1[j] * sn[j]; }
                            x1 = o1; x2 = o2;
                        }
                        const float sc = pn < 2 ? 0.08838834764831845f : (pn >= 16 && pn < 20) ? 0.125f : 1.f;
                        x1 *= sc; x2 *= sc;
                        *(uint2*)(Pr + lc1) = pk4(x1);
                        *(uint2*)(Pr + lc2) = pk4(x2);
                    } else {
#pragma unroll
                        for (int n = 0; n < 2; ++n) {
                            f32x4 v = acc[ai][bj][m][n];
                            const int col = cb + n * 16;
                            if (pn == 21) {
                                if (!lat) *(float4*)(out + O_NV + ((size_t)((row >> 8) * 2 + l) * 256 + t) * 256 + (col - C_AV)) = make_float4(v[0], v[1], v[2], v[3]);
                            } else if (!(pn >= 8 && pn < 12)) {
#pragma unroll
                                for (int j = 0; j < 4; ++j) v[j] = siluf(v[j]);
                            }
                            *(uint2*)(Pr + col) = pk4(v);
                        }
                    }
                }
            }
    }
};
DEV void phase8_gemm1(const Params& p, int l, LAS unsigned char* lds) {
    SchedG1 S{(const char*)(p.ws + OFF_H), (const char*)(p.ws + OFF_W1T), (int)gridDim.x, (int)blockIdx.x};
    EpiG1 E{p.ws, p.out, l};
    g8::gemm_phase(lds, 2048u, 2048u, 16, S, E);
}

constexpr size_t OFF_G2 = OFF_RVT;
struct SchedMg {
    const char* A; const char* B; unsigned lda; int G, c, zpass;
    DEV bool next(int i, g8::Unit& u) const {
        const int tile = (i / 3) * G + c, n = i % 3;
        if (tile >= 192) return false;
        u.pm = tile >> 2; u.pn = tile & 3; u.kind = n;
        const int acol = zpass ? (n == 0 ? C_RG : n == 1 ? C_LG : C_AQ) : 0;
        u.a = A + (size_t)u.pm * 256 * lda + (size_t)acol * 2;
        u.b = B + ((size_t)n * 1024 + u.pn * 256) * 2048;
        return true;
    }
};
struct EpiMg {
    unsigned char* ws; const float* bias; int zpass;
    DEV bf16_t* gslot(int n, int row) const {
        bf16_t* Pb = (bf16_t*)(ws + OFF_P);
        return n == 0 ? Pb + (size_t)row * PW + C_LX : n == 1 ? Pb + (size_t)row * PW + C_AG : (bf16_t*)(ws + OFF_G2) + (size_t)row * 1024;
    }
    DEV void operator()(const f32x4 (&acc)[2][2][4][2], const g8::Unit& u, int wr, int wc, int fr, int fq) const {
        using namespace g8;
        const int n = u.kind;
#pragma unroll
        for (int ai = 0; ai < 2; ++ai)
#pragma unroll
            for (int m = 0; m < 4; ++m) {
                const int row = u.pm * 256 + ai * 128 + wr * 64 + m * 16 + fr;
                bf16_t* gs = gslot(n, row);
                bf16_t* Tr = (bf16_t*)(ws + OFF_P) + (size_t)row * PW;
#pragma unroll
                for (int bj = 0; bj < 2; ++bj)
#pragma unroll
                    for (int nn = 0; nn < 2; ++nn) {
                        const int col = u.pn * 256 + bj * 128 + wc * 32 + nn * 16 + fq * 4;
                        f32x4 v = acc[ai][bj][m][nn];
                        if (!zpass) {
                            const float4 bz = *(const float4*)(bias + n * 1024 + col);
                            v[0] = sigmf(v[0] + bz.x); v[1] = sigmf(v[1] + bz.y); v[2] = sigmf(v[2] + bz.z); v[3] = sigmf(v[3] + bz.w);
                            *(uint2*)(gs + col) = pk4(v);
                        } else {
                            const uint2 gv = *(const uint2*)(gs + col);
                            v[0] *= lo16(gv.x); v[1] *= hi16(gv.x); v[2] *= lo16(gv.y); v[3] *= hi16(gv.y);
                            if (n > 0) { const uint2 tv = *(const uint2*)(Tr + col); v[0] += lo16(tv.x); v[1] += hi16(tv.x); v[2] += lo16(tv.y); v[3] += hi16(tv.y); }
                            *(uint2*)(Tr + col) = pk4(v);
                        }
                    }
            }
    }
};
DEV void phase8_merge(const Params& p, int l, LAS unsigned char* lds) {
    {
        SchedMg S{(const char*)(p.ws + OFF_H), (const char*)(p.ws + OFF_WMG), 2048u, (int)gridDim.x, (int)blockIdx.x, 0};
        EpiMg E{p.ws, p.b_merge + (size_t)l * 3072, 0};
        g8::gemm_phase(lds, 2048u, 2048u, 16, S, E);
    }
    {
        SchedMg S{(const char*)(p.ws + OFF_P), (const char*)(p.ws + OFF_WBR), (unsigned)PW * 2u, (int)gridDim.x, (int)blockIdx.x, 1};
        EpiMg E{p.ws, p.b_merge + (size_t)l * 3072, 1};
        g8::gemm_phase(lds, (unsigned)PW * 2u, 2048u, 16, S, E);
    }
}

struct SchedOut {
    const char* A; const char* B; int G, c;
    DEV bool next(int i, g8::Unit& u) const {
        const int tile = i * G + c;
        if (tile >= 192) return false;
        u.pm = tile >> 2; u.pn = tile & 3; u.kind = 0;
        u.a = A + (size_t)u.pm * 256 * PW * 2; u.b = B + (size_t)u.pn * 256 * 2048;
        return true;
    }
};
struct EpiOut {
    unsigned char* ws;
    DEV void operator()(const f32x4 (&acc)[2][2][4][2], const g8::Unit& u, int wr, int wc, int fr, int fq) const {
#pragma unroll
        for (int ai = 0; ai < 2; ++ai)
#pragma unroll
            for (int m = 0; m < 4; ++m) {
                const int row = u.pm * 256 + ai * 128 + wr * 64 + m * 16 + fr;
                float* orow = (float*)((bf16_t*)(ws + OFF_P) + (size_t)row * PW + 1024);
#pragma unroll
                for (int bj = 0; bj < 2; ++bj)
#pragma unroll
                    for (int n = 0; n < 2; ++n) {
                        const f32x4 v = acc[ai][bj][m][n];
                        *(float4*)(orow + u.pn * 256 + bj * 128 + wc * 32 + n * 16 + fq * 4) = make_float4(v[0], v[1], v[2], v[3]);
                    }
            }
    }
};
DEV void phase8_out(const Params& p, int l, LAS unsigned char* lds) {
    SchedOut S{(const char*)(p.ws + OFF_P), (const char*)(p.ws + OFF_WOUT), (int)gridDim.x, (int)blockIdx.x};
    EpiOut E{p.ws};
    g8::gemm_phase(lds, (unsigned)PW * 2u, 2048u, 16, S, E);
}

DEV uint4 pack8(const float4 a, const float4 b) {
    uint4 r;
    r.x = (unsigned)f2bf(a.x) | ((unsigned)f2bf(a.y) << 16); r.y = (unsigned)f2bf(a.z) | ((unsigned)f2bf(a.w) << 16);
    r.z = (unsigned)f2bf(b.x) | ((unsigned)f2bf(b.y) << 16); r.w = (unsigned)f2bf(b.z) | ((unsigned)f2bf(b.w) << 16);
    return r;
}
DEV void attn_item(const Params& p, int l, int item, unsigned char* lds) {
    bf16_t* Pb = ws_bf(p, OFF_P);
    unsigned char* Ks = lds; unsigned char* Vt = lds + 8192;
    const int tid = TIDX(), lane = tid & 63, w = tid >> 6, g = lane >> 4, lc = lane & 15;
    const bool lat = item < 1024;
    int b, hk, qb, row0, L;
    if (lat) { b = item >> 8; hk = (item >> 6) & 3; qb = item & 63; row0 = NCTX + b * 2048; L = 2048; }
    else { const int it = item - 1024; b = it >> 5; hk = (it >> 3) & 3; qb = it & 7; row0 = b * 256; L = 256; }
    const int q0 = qb * 32;
    const int hq = hk * 4 + w;
    bf16x8 qfr[2][2];
#pragma unroll
    for (int qf = 0; qf < 2; ++qf)
#pragma unroll
        for (int ks = 0; ks < 2; ++ks)
            qfr[qf][ks] = *(const bf16x8*)(Pb + (size_t)(row0 + q0 + qf * 16 + lc) * PW + C_AQ + hq * 64 + ks * 32 + g * 8);
    f32x4 O[4][2];
    float mrun[2], lrun[2];
    const float sink = p.att_sink[l * 16 + hq];
#pragma unroll
    for (int qf = 0; qf < 2; ++qf) { mrun[qf] = sink; lrun[qf] = g == 0 ? 1.f : 0.f;
#pragma unroll
        for (int df = 0; df < 4; ++df) O[df][qf] = (f32x4){0.f, 0.f, 0.f, 0.f}; }
    const int kbase = q0 & ~63;
    const int nband = lat ? 5 : 4;
    const int ntile = lat ? 9 : 4;
    const int fsw = (lane >> 1) & 7;
    for (int t = 0; t < ntile; ++t) {
        const bool cache = t >= nband;
        int kp0 = 0;
        if (!cache) { kp0 = lat ? kbase + 64 * (t - 2) : 64 * t; if (kp0 < 0 || kp0 >= L) continue; }
        __syncthreads();
        if (!cache) {
#pragma unroll
            for (int i = 0; i < 2; ++i) {
                const int id = i * 256 + tid, row = id >> 3, c = id & 7;
                const uint4 v = *(const uint4*)(Pb + (size_t)(row0 + kp0 + row) * PW + C_AK + hk * 64 + c * 8);
                *(uint4*)(Ks + row * 128 + ((c ^ ((row >> 1) & 7)) << 4)) = v;
            }
#pragma unroll
            for (int i = 0; i < 2; ++i) {
                const int key = lane, c = w + 4 * i;
                const uint4 v = *(const uint4*)(Pb + (size_t)(row0 + kp0 + key) * PW + C_AV + hk * 64 + c * 8);
                bf16_t* dst = (bf16_t*)(Vt + (c * 8) * 136 + key * 2);
                dst[0 * 68] = (bf16_t)(v.x & 0xffff); dst[1 * 68] = (bf16_t)(v.x >> 16);
                dst[2 * 68] = (bf16_t)(v.y & 0xffff); dst[3 * 68] = (bf16_t)(v.y >> 16);
                dst[4 * 68] = (bf16_t)(v.z & 0xffff); dst[5 * 68] = (bf16_t)(v.z >> 16);
                dst[6 * 68] = (bf16_t)(v.w & 0xffff); dst[7 * 68] = (bf16_t)(v.w >> 16);
            }
        } else {
            const int j0 = (t - nband) * 64;
            const float* ck = p.cache_k + (size_t)((b * 2 + l) * 256 + j0) * 256 + hk * 64;
            const float* cv = p.cache_v + (size_t)((b * 2 + l) * 256 + j0) * 256 + hk * 64;
#pragma unroll
            for (int i = 0; i < 2; ++i) {
                const int id = i * 256 + tid, row = id >> 3, c = id & 7;
                const float4 x0 = *(const float4*)(ck + (size_t)row * 256 + c * 8), x1 = *(const float4*)(ck + (size_t)row * 256 + c * 8 + 4);
                *(uint4*)(Ks + row * 128 + ((c ^ ((row >> 1) & 7)) << 4)) = pack8(x0, x1);
            }
#pragma unroll
            for (int i = 0; i < 2; ++i) {
                const int key = lane, c = w + 4 * i;
                const float4 x0 = *(const float4*)(cv + (size_t)key * 256 + c * 8), x1 = *(const float4*)(cv + (size_t)key * 256 + c * 8 + 4);
                bf16_t* dst = (bf16_t*)(Vt + (c * 8) * 136 + key * 2);
                dst[0 * 68] = f2bf(x0.x); dst[1 * 68] = f2bf(x0.y); dst[2 * 68] = f2bf(x0.z); dst[3 * 68] = f2bf(x0.w);
                dst[4 * 68] = f2bf(x1.x); dst[5 * 68] = f2bf(x1.y); dst[6 * 68] = f2bf(x1.z); dst[7 * 68] = f2bf(x1.w);
            }
        }
        __syncthreads();
        f32x4 sc[4][2];
#pragma unroll
        for (int kf = 0; kf < 4; ++kf)
#pragma unroll
            for (int qf = 0; qf < 2; ++qf) sc[kf][qf] = (f32x4){0.f, 0.f, 0.f, 0.f};
#pragma unroll
        for (int ks = 0; ks < 2; ++ks) {
            bf16x8 ak[4];
#pragma unroll
            for (int kf = 0; kf < 4; ++kf) ak[kf] = *(const bf16x8*)(Ks + (kf * 16 + lc) * 128 + (((ks * 4 + g) ^ fsw) << 4));
#pragma unroll
            for (int kf = 0; kf < 4; ++kf)
#pragma unroll
                for (int qf = 0; qf < 2; ++qf)
                    sc[kf][qf] = __builtin_amdgcn_mfma_f32_16x16x32_bf16(ak[kf], qfr[qf][ks], sc[kf][qf], 0, 0, 0);
        }
        if (lat && !cache) {
#pragma unroll
            for (int kf = 0; kf < 4; ++kf)
#pragma unroll
                for (int qf = 0; qf < 2; ++qf)
#pragma unroll
                    for (int r = 0; r < 4; ++r) {
                        const int kpos = kp0 + kf * 16 + g * 4 + r, qpos = q0 + qf * 16 + lc;
                        const int dd = qpos - kpos;
                        if (dd > 128 || dd < -128) sc[kf][qf][r] = -INFINITY;
                    }
        }
        bf16x8 pb[2][2];
#pragma unroll
        for (int qf = 0; qf < 2; ++qf) {
            float mx = -INFINITY;
#pragma unroll
            for (int kf = 0; kf < 4; ++kf)
#pragma unroll
                for (int r = 0; r < 4; ++r) mx = fmaxf(mx, sc[kf][qf][r]);
            mx = fmaxf(mx, __shfl_xor(mx, 16));
            mx = fmaxf(mx, __shfl_xor(mx, 32));
            const float mnew = fmaxf(mrun[qf], mx);
            const float alpha = __expf(mrun[qf] - mnew);
            mrun[qf] = mnew;
            float ps = 0.f;
#pragma unroll
            for (int kf = 0; kf < 4; ++kf)
#pragma unroll
                for (int r = 0; r < 4; ++r) { const float e = __expf(sc[kf][qf][r] - mnew); sc[kf][qf][r] = e; ps += e; }
            lrun[qf] = lrun[qf] * alpha + ps;
#pragma unroll
            for (int df = 0; df < 4; ++df) O[df][qf] *= alpha;
#pragma unroll
            for (int s2 = 0; s2 < 2; ++s2) {
                bf16x8 v;
#pragma unroll
                for (int r = 0; r < 4; ++r) { v[r] = (short)f2bf(sc[2 * s2][qf][r]); v[4 + r] = (short)f2bf(sc[2 * s2 + 1][qf][r]); }
                pb[s2][qf] = v;
            }
        }
#pragma unroll
        for (int s2 = 0; s2 < 2; ++s2)
#pragma unroll
            for (int df = 0; df < 4; ++df) {
                const unsigned char* vr = Vt + (df * 16 + lc) * 136 + (32 * s2 + 4 * g) * 2;
                const uint2 lo = *(const uint2*)vr, hi = *(const uint2*)(vr + 32);
                union { uint4 u; bf16x8 v; } av; av.u = make_uint4(lo.x, lo.y, hi.x, hi.y);
#pragma unroll
                for (int qf = 0; qf < 2; ++qf)
                    O[df][qf] = __builtin_amdgcn_mfma_f32_16x16x32_bf16(av.v, pb[s2][qf], O[df][qf], 0, 0, 0);
            }
    }
#pragma unroll
    for (int qf = 0; qf < 2; ++qf) {
        float lt = lrun[qf];
        lt += __shfl_xor(lt, 16); lt += __shfl_xor(lt, 32);
        const float inv = 1.f / lt;
        const size_t m = (size_t)(row0 + q0 + qf * 16 + lc);
#pragma unroll
        for (int df = 0; df < 4; ++df) {
            const int col = hq * 64 + df * 16 + g * 4;
            const uint2 gt = *(const uint2*)(Pb + m * PW + C_AG + col);
            uint2 o;
            o.x = (unsigned)f2bf(O[df][qf][0] * inv * __uint_as_float(gt.x << 16)) | ((unsigned)f2bf(O[df][qf][1] * inv * __uint_as_float(gt.x & 0xffff0000u)) << 16);
            o.y = (unsigned)f2bf(O[df][qf][2] * inv * __uint_as_float(gt.y << 16)) | ((unsigned)f2bf(O[df][qf][3] * inv * __uint_as_float(gt.y & 0xffff0000u)) << 16);
            *(uint2*)(Pb + m * PW + C_AQ + col) = o;
        }
    }
}
DEV void phase_attn(const Params& p, int l, unsigned char* lds) {
    for (int item = blockIdx.x; item < 1536; item += gridDim.x) attn_item(p, l, item, lds);
}

constexpr size_t OFF_RS = OFF_W1T;
static_assert(OFF_RS + (size_t)4 * 4 * 2 * 8 * 32768 * 2 <= OFF_LRUC, "RS overlap");
DEV float ret_logg(const Params& p, int l, int dir, int h) { return -softplusf(-p.ret_decay[(l * 2 + dir) * 4 + h]); }

DEV void ret_kv_tile(const Params& p, int l, int item, unsigned char* lds) {
    bf16_t* Pb = ws_bf(p, OFF_P); const bf16_t* RVT = ws_bf(p, OFF_RVT);
    bf16_t* Kt = (bf16_t*)lds;
    const int tid = TIDX(), lane = tid & 63, w = tid >> 6, g = lane >> 4, lc = lane & 15;
    const bool lat = item < 448;
    int b, h, dir, dvh, c;
    if (lat) { dvh = item & 1; dir = (item >> 1) & 1; const int rest = item >> 2; const int cc = rest % 7, bh = rest / 7; h = bh & 3; b = bh >> 2; c = dir == 0 ? cc : cc + 1; }
    else { const int it = item - 448; dvh = it & 1; dir = (it >> 1) & 1; h = (it >> 2) & 3; b = it >> 4; c = 0; }
    const int row0 = lat ? NCTX + b * 2048 + c * 256 : b * 256;
    const float lg = ret_logg(p, l, dir, h);
    const int dvbase = dvh * 128 + w * 32;
    f32x4 acc[2][8];
#pragma unroll
    for (int i = 0; i < 2; ++i)
#pragma unroll
        for (int j = 0; j < 8; ++j) acc[i][j] = (f32x4){0.f, 0.f, 0.f, 0.f};
#pragma unroll 1
    for (int st = 0; st < 4; ++st) {
        {
            const int tok = lane, ti = st * 64 + tok;
            const float wt = __expf(lg * (float)(dir == 0 ? 255 - ti : ti));
#pragma unroll
            for (int i = 0; i < 4; ++i) {
                const int c8 = w + 4 * i;
                const uint4 v = *(const uint4*)(Pb + (size_t)(row0 + ti) * PW + C_RK + h * 128 + c8 * 8);
                bf16_t* dst = Kt + (c8 * 8) * 72 + tok;
                dst[0 * 72] = f2bf(wt * __uint_as_float(v.x << 16)); dst[1 * 72] = f2bf(wt * __uint_as_float(v.x & 0xffff0000u));
                dst[2 * 72] = f2bf(wt * __uint_as_float(v.y << 16)); dst[3 * 72] = f2bf(wt * __uint_as_float(v.y & 0xffff0000u));
                dst[4 * 72] = f2bf(wt * __uint_as_float(v.z << 16)); dst[5 * 72] = f2bf(wt * __uint_as_float(v.z & 0xffff0000u));
                dst[6 * 72] = f2bf(wt * __uint_as_float(v.w << 16)); dst[7 * 72] = f2bf(wt * __uint_as_float(v.w & 0xffff0000u));
            }
        }
        __syncthreads();
#pragma unroll
        for (int ks = 0; ks < 2; ++ks) {
            bf16x8 av[2];
#pragma unroll
            for (int mf = 0; mf < 2; ++mf)
                av[mf] = *(const bf16x8*)(RVT + (size_t)(h * 256 + dvbase + mf * 16 + lc) * M + row0 + st * 64 + ks * 32 + g * 8);
#pragma unroll
            for (int nf = 0; nf < 8; ++nf) {
                const bf16x8 bk = *(const bf16x8*)((const unsigned char*)Kt + (nf * 16 + lc) * 144 + (ks * 32 + g * 8) * 2);
#pragma unroll
                for (int mf = 0; mf < 2; ++mf) acc[mf][nf] = __builtin_amdgcn_mfma_f32_16x16x32_bf16(av[mf], bk, acc[mf][nf], 0, 0, 0);
            }
        }
        __syncthreads();
    }
    if (lat) {
        const int slot = dir == 0 ? c + 1 : c - 1;
        bf16_t* dst = ws_bf(p, OFF_RS) + ((size_t)((b * 4 + h) * 2 + dir) * 8 + slot) * 32768;
#pragma unroll
        for (int mf = 0; mf < 2; ++mf)
#pragma unroll
            for (int nf = 0; nf < 8; ++nf)
#pragma unroll
                for (int r = 0; r < 4; ++r) dst[(size_t)(dvbase + mf * 16 + g * 4 + r) * 128 + nf * 16 + lc] = f2bf(acc[mf][nf][r]);
    } else {
        float* dst = p.out + O_NRET + ((((size_t)b * 2 + l) * 2 + dir) * 4 + h) * 128 * 256;
#pragma unroll
        for (int mf = 0; mf < 2; ++mf)
#pragma unroll
            for (int nf = 0; nf < 8; ++nf)
                *(float4*)(dst + (size_t)(nf * 16 + lc) * 256 + dvbase + mf * 16 + g * 4) = make_float4(acc[mf][nf][0], acc[mf][nf][1], acc[mf][nf][2], acc[mf][nf][3]);
    }
}
DEV void phase_ret_kv(const Params& p, int l, unsigned char* lds) {
    for (int item = blockIdx.x; item < 704; item += gridDim.x) ret_kv_tile(p, l, item, lds);
}

DEV void phase_ret_scan(const Params& p, int l) {
    bf16_t* RS = ws_bf(p, OFF_RS);
    const int gt = blockIdx.x * blockDim.x + TIDX(), gs = gridDim.x * blockDim.x;
    for (int idx = gt; idx < 4 * 4 * 2 * 32768; idx += gs) {
        const int dk = idx & 127, dv = (idx >> 7) & 255, dir = (idx >> 15) & 1, h = (idx >> 16) & 3, b = idx >> 18;
        const float g256 = __expf(ret_logg(p, l, dir, h) * 256.f);
        float st = p.state_ret[(((((size_t)b * 2 + l) * 2 + dir) * 4 + h) * 128 + dk) * 256 + dv];
        bf16_t* base = RS + (size_t)((b * 4 + h) * 2 + dir) * 8 * 32768 + dv * 128 + dk;
        if (dir == 0) {
            base[0] = f2bf(st);
            for (int c = 1; c < 8; ++c) { st = g256 * st + bf2f(base[(size_t)c * 32768]); base[(size_t)c * 32768] = f2bf(st); }
        } else {
            base[(size_t)7 * 32768] = f2bf(st);
            for (int c = 6; c >= 0; --c) { st = g256 * st + bf2f(base[(size_t)c * 32768]); base[(size_t)c * 32768] = f2bf(st); }
        }
    }
}

DEV void ret_out_tile(const Params& p, int l, int item, unsigned char* lds) {
    bf16_t* Pb = ws_bf(p, OFF_P); const bf16_t* RVT = ws_bf(p, OFF_RVT);
    unsigned char* Ks = lds; unsigned char* Vt = lds + 16384; unsigned char* SB = Vt;
    const int tid = TIDX(), lane = tid & 63, w = tid >> 6, g = lane >> 4, lc = lane & 15;
    const bool lat = item < 512;
    int b, h, qb, rowc, qi0, c;
    if (lat) { qb = item & 31; h = (item >> 5) & 3; b = item >> 7; c = qb >> 2; rowc = NCTX + b * 2048 + c * 256; qi0 = (qb & 3) * 64; }
    else { const int it = item - 512; qb = it & 3; h = (it >> 2) & 3; b = it >> 4; c = 0; rowc = b * 256; qi0 = qb * 64; }
    const int qi = qi0 + w * 16 + lc;
    const size_t rowq = (size_t)(rowc + qi);
    const float lgf = ret_logg(p, l, 0, h), lgb = ret_logg(p, l, 1, h);
    bf16x8 qfr[4];
#pragma unroll
    for (int ks = 0; ks < 4; ++ks) qfr[ks] = *(const bf16x8*)(Pb + rowq * PW + C_RQ + h * 128 + ks * 32 + g * 8);
    f32x4 acc[16];
#pragma unroll
    for (int df = 0; df < 16; ++df) acc[df] = (f32x4){0.f, 0.f, 0.f, 0.f};
#pragma unroll 1
    for (int kt = 0; kt < 4; ++kt) {
        __syncthreads();
#pragma unroll
        for (int i = 0; i < 4; ++i) {
            const int id = i * 256 + tid, row = id >> 4, ch = id & 15;
            const uint4 v = *(const uint4*)(Pb + (size_t)(rowc + kt * 64 + row) * PW + C_RK + h * 128 + ch * 8);
            *(uint4*)(Ks + row * 256 + ((ch ^ (row & 15)) << 4)) = v;
        }
#pragma unroll
        for (int i = 0; i < 8; ++i) {
            const int id = i * 256 + tid, dv = id >> 3, ch = id & 7;
            const uint4 v = *(const uint4*)(RVT + (size_t)(h * 256 + dv) * M + rowc + kt * 64 + ch * 8);
            *(uint2*)(Vt + dv * 136 + ch * 16) = make_uint2(v.x, v.y);
            *(uint2*)(Vt + dv * 136 + ch * 16 + 8) = make_uint2(v.z, v.w);
        }
        __syncthreads();
        f32x4 sc[4];
#pragma unroll
        for (int kf = 0; kf < 4; ++kf) sc[kf] = (f32x4){0.f, 0.f, 0.f, 0.f};
#pragma unroll
        for (int ks = 0; ks < 4; ++ks)
#pragma unroll
            for (int kf = 0; kf < 4; ++kf) {
                const bf16x8 ak = *(const bf16x8*)(Ks + (kf * 16 + lc) * 256 + (((ks * 4 + g) ^ lc) << 4));
                sc[kf] = __builtin_amdgcn_mfma_f32_16x16x32_bf16(ak, qfr[ks], sc[kf], 0, 0, 0);
            }
        bf16x8 pb[2];
#pragma unroll
        for (int kf = 0; kf < 4; ++kf)
#pragma unroll
            for (int r = 0; r < 4; ++r) {
                const int dd = qi - (kt * 64 + kf * 16 + g * 4 + r);
                float wgt = 0.f;
                if (dd >= 0) wgt += __expf(lgf * (float)dd);
                if (dd <= 0) wgt += __expf(lgb * (float)(-dd));
                pb[kf >> 1][(kf & 1) * 4 + r] = (short)f2bf(sc[kf][r] * wgt);
            }
#pragma unroll
        for (int s2 = 0; s2 < 2; ++s2)
#pragma unroll
            for (int df = 0; df < 16; ++df) {
                const unsigned char* vr = Vt + (df * 16 + lc) * 136 + (32 * s2 + 4 * g) * 2;
                const uint2 lo = *(const uint2*)vr, hi = *(const uint2*)(vr + 32);
                union { uint4 u; bf16x8 v; } av; av.u = make_uint4(lo.x, lo.y, hi.x, hi.y);
                acc[df] = __builtin_amdgcn_mfma_f32_16x16x32_bf16(av.v, pb[s2], acc[df], 0, 0, 0);
                if ((df & 3) == 3) __builtin_amdgcn_sched_barrier(0);
            }
    }
    if (lat) {
#pragma unroll 1
        for (int dir = 0; dir < 2; ++dir) {
            const float qs = dir == 0 ? __expf(lgf * (float)(qi + 1)) : __expf(lgb * (float)(256 - qi));
            bf16x8 qx[4];
#pragma unroll
            for (int ks = 0; ks < 4; ++ks)
#pragma unroll
                for (int e = 0; e < 8; ++e) qx[ks][e] = (short)f2bf(qs * bf2f((bf16_t)qfr[ks][e]));
            const bf16_t* Sg = ws_bf(p, OFF_RS) + ((size_t)((b * 4 + h) * 2 + dir) * 8 + c) * 32768;
#pragma unroll 1
            for (int kh = 0; kh < 2; ++kh) {
                __syncthreads();
#pragma unroll
                for (int i = 0; i < 8; ++i) {
                    const int id = i * 256 + tid, row = id >> 3, ch = id & 7;
                    const uint4 v = *(const uint4*)(Sg + (size_t)row * 128 + kh * 64 + ch * 8);
                    *(uint4*)(SB + row * 128 + ((ch ^ ((row >> 1) & 7)) << 4)) = v;
                }
                __syncthreads();
#pragma unroll
                for (int k2 = 0; k2 < 2; ++k2)
#pragma unroll
                    for (int df = 0; df < 16; ++df) {
                        const bf16x8 as = *(const bf16x8*)(SB + (df * 16 + lc) * 128 + (((k2 * 4 + g) ^ ((lc >> 1) & 7)) << 4));
                        acc[df] = __builtin_amdgcn_mfma_f32_16x16x32_bf16(as, kh == 0 ? qx[k2] : qx[2 + k2], acc[df], 0, 0, 0);
                        if ((df & 3) == 3) __builtin_amdgcn_sched_barrier(0);
                    }
            }
        }
    }
    float s1 = 0.f;
#pragma unroll
    for (int df = 0; df < 16; ++df) s1 += (acc[df][0] + acc[df][1]) + (acc[df][2] + acc[df][3]);
    s1 += __shfl_xor(s1, 16); s1 += __shfl_xor(s1, 32);
    const float mu = s1 * (1.f / 256.f);
    float s2 = 0.f;
#pragma unroll
    for (int df = 0; df < 16; ++df)
#pragma unroll
        for (int r = 0; r < 4; ++r) { const float xc = acc[df][r] - mu; s2 += xc * xc; }
    s2 += __shfl_xor(s2, 16); s2 += __shfl_xor(s2, 32);
    const float rstd = rsqrtf(s2 * (1.f / 256.f) + EPS);
#pragma unroll
    for (int df = 0; df < 16; ++df) {
        bf16_t* gp = Pb + rowq * PW + C_RG + h * 256 + df * 16 + g * 4;
        const uint2 gv = *(const uint2*)gp;
        uint2 o;
        o.x = (unsigned)f2bf((acc[df][0] - mu) * rstd * __uint_as_float(gv.x << 16)) | ((unsigned)f2bf((acc[df][1] - mu) * rstd * __uint_as_float(gv.x & 0xffff0000u)) << 16);
        o.y = (unsigned)f2bf((acc[df][2] - mu) * rstd * __uint_as_float(gv.y << 16)) | ((unsigned)f2bf((acc[df][3] - mu) * rstd * __uint_as_float(gv.y & 0xffff0000u)) << 16);
        *(uint2*)gp = o;
    }
}
DEV void phase_ret_out(const Params& p, int l, unsigned char* lds) {
    for (int item = blockIdx.x; item < 768; item += gridDim.x) ret_out_tile(p, l, item, lds);
}

template <bool REV>
DEV void lru_scan16(const float (&a)[4][4], const float (&u)[4][4], float cin, int g, int lc, float (&h)[4][4], float& cout, float& Aprod) {
    float carry = cin, Ap = 1.f;
#pragma unroll
    for (int ii = 0; ii < 4; ++ii) {
        const int i = REV ? 3 - ii : ii;
        float hl[4], cp[4];
        {
            float hh = 0.f, cc = 1.f;
#pragma unroll
            for (int rr = 0; rr < 4; ++rr) { const int r = REV ? 3 - rr : rr; hh = a[i][r] * hh + u[i][r]; cc *= a[i][r]; hl[r] = hh; cp[r] = cc; }
        }
        const float As = REV ? cp[0] : cp[3], Hs = REV ? hl[0] : hl[3];
        float Ag[4], Hg[4];
#pragma unroll
        for (int gg = 0; gg < 4; ++gg) { Ag[gg] = __shfl(As, lc + 16 * gg); Hg[gg] = __shfl(Hs, lc + 16 * gg); }
        float cur = carry, mine = carry;
#pragma unroll
        for (int sI = 0; sI < 4; ++sI) {
            const int gg = REV ? 3 - sI : sI;
            mine = (g == gg) ? cur : mine;
            cur = Ag[gg] * cur + Hg[gg];
            Ap *= Ag[gg];
        }
        carry = cur;
#pragma unroll
        for (int r = 0; r < 4; ++r) h[i][r] = hl[r] + cp[r] * mine;
    }
    cout = carry; Aprod = Ap;
}

DEV void lru_tile(const Params& p, int l, int gc, int blk, int mode, unsigned char* lds) {
    unsigned char* xa = lds; float* hs = (float*)(lds + 16384);
    bf16_t* Pb = ws_bf(p, OFF_P);
    const int tid = TIDX(), lane = tid & 63, w = tid >> 6, g = lane >> 4, lc = lane & 15;
    const int dir = w >> 1, chh = w & 1;
    const int m0 = gc * 64;
    const bool lat = m0 >= NCTX;
    const int L = lat ? 2048 : 256;
    const int t0 = lat ? ((m0 - NCTX) & 2047) : (m0 & 255);
    {
        const int chunk = tid & 15, chb = blk * 128 + chunk * 8;
        float cw[4][8], cb[8];
#pragma unroll
        for (int j = 0; j < 4; ++j) {
            const float4 a0 = *(const float4*)(p.conv_w + (size_t)(l * 4 + j) * D + chb), a1 = *(const float4*)(p.conv_w + (size_t)(l * 4 + j) * D + chb + 4);
            cw[j][0] = a0.x; cw[j][1] = a0.y; cw[j][2] = a0.z; cw[j][3] = a0.w; cw[j][4] = a1.x; cw[j][5] = a1.y; cw[j][6] = a1.z; cw[j][7] = a1.w;
        }
        {
            const float4 a0 = *(const float4*)(p.conv_b + (size_t)l * D + chb), a1 = *(const float4*)(p.conv_b + (size_t)l * D + chb + 4);
            cb[0] = a0.x; cb[1] = a0.y; cb[2] = a0.z; cb[3] = a0.w; cb[4] = a1.x; cb[5] = a1.y; cb[6] = a1.z; cb[7] = a1.w;
        }
#pragma unroll
        for (int i = 0; i < 4; ++i) {
            const int tt = (tid >> 4) + 16 * i;
            float acc[8];
#pragma unroll
            for (int e = 0; e < 8; ++e) acc[e] = cb[e];
#pragma unroll
            for (int j = 0; j < 4; ++j) {
                const int tp = t0 + tt + j - 1;
                if (tp >= 0 && tp < L) {
                    const uint4 v = *(const uint4*)(Pb + (size_t)(m0 + tt + j - 1) * PW + C_LX + chb);
                    acc[0] += cw[j][0] * __uint_as_float(v.x << 16); acc[1] += cw[j][1] * __uint_as_float(v.x & 0xffff0000u);
                    acc[2] += cw[j][2] * __uint_as_float(v.y << 16); acc[3] += cw[j][3] * __uint_as_float(v.y & 0xffff0000u);
                    acc[4] += cw[j][4] * __uint_as_float(v.z << 16); acc[5] += cw[j][5] * __uint_as_float(v.z & 0xffff0000u);
                    acc[6] += cw[j][6] * __uint_as_float(v.w << 16); acc[7] += cw[j][7] * __uint_as_float(v.w & 0xffff0000u);
                }
            }
            uint4 o;
            o.x = (unsigned)f2bf(acc[0]) | ((unsigned)f2bf(acc[1]) << 16); o.y = (unsigned)f2bf(acc[2]) | ((unsigned)f2bf(acc[3]) << 16);
            o.z = (unsigned)f2bf(acc[4]) | ((unsigned)f2bf(acc[5]) << 16); o.w = (unsigned)f2bf(acc[6]) | ((unsigned)f2bf(acc[7]) << 16);
            *(uint4*)(xa + tt * 256 + ((chunk ^ (tt & 15)) << 4)) = o;
        }
        if (mode) for (int e = tid; e < 64 * 128; e += 256) hs[e] = 0.f;
    }
    __syncthreads();
    float* LA = (float*)(p.ws + OFF_LRUC);
    float* LH = LA + 192 * 2 * 1024;
    const bf16_t* Wa = ws_bf(p, OFF_LRUW) + (size_t)((dir * 2 + 0) * 8 + blk) * 128 * 128;
    const bf16_t* Wx = ws_bf(p, OFF_LRUW) + (size_t)((dir * 2 + 1) * 8 + blk) * 128 * 128;
#pragma unroll 1
    for (int nq = 0; nq < 4; ++nq) {
        f32x4 accA[4], accX[4];
#pragma unroll
        for (int i = 0; i < 4; ++i) { accA[i] = (f32x4){0.f, 0.f, 0.f, 0.f}; accX[i] = (f32x4){0.f, 0.f, 0.f, 0.f}; }
        const int cl = chh * 64 + nq * 16 + lc;
#pragma unroll
        for (int ks = 0; ks < 4; ++ks) {
            const bf16x8 bA = *(const bf16x8*)(Wa + (size_t)cl * 128 + ks * 32 + g * 8);
            const bf16x8 bX = *(const bf16x8*)(Wx + (size_t)cl * 128 + ks * 32 + g * 8);
#pragma unroll
            for (int i = 0; i < 4; ++i) {
                const bf16x8 af = *(const bf16x8*)(xa + (i * 16 + lc) * 256 + (((ks * 4 + g) ^ lc) << 4));
                accA[i] = __builtin_amdgcn_mfma_f32_16x16x32_bf16(af, bA, accA[i], 0, 0, 0);
                accX[i] = __builtin_amdgcn_mfma_f32_16x16x32_bf16(af, bX, accX[i], 0, 0, 0);
            }
        }
        {
            const int ch = blk * 128 + cl;
            const float ba = p.lru_ba[(l * 2 + dir) * D + ch], bx = p.lru_bx[(l * 2 + dir) * D + ch];
            const float sp = softplusf(-p.lru_lambda[(l * 2 + dir) * D + ch]);
            const size_t ci = ((size_t)gc * 2 + dir) * 1024 + ch;
            const float cin = mode ? LH[ci] : 0.f;
            float a[4][4], u[4][4], h[4][4];
#pragma unroll
            for (int i = 0; i < 4; ++i)
#pragma unroll
                for (int r = 0; r < 4; ++r) {
                    const int tok = i * 16 + g * 4 + r;
                    const float x = bf2f(*(const bf16_t*)(xa + tok * 256 + (((cl >> 3) ^ (tok & 15)) << 4) + (cl & 7) * 2));
                    const float rg = sigmf(accA[i][r] + ba), ig = sigmf(accX[i][r] + bx);
                    const float la = -8.f * rg * sp;
                    a[i][r] = __expf(la);
                    u[i][r] = sqrtf(-expm1f(2.f * la)) * (ig * x);
                }
            float cout, Ap;
            if (dir == 0) lru_scan16<false>(a, u, cin, g, lc, h, cout, Ap);
            else          lru_scan16<true>(a, u, cin, g, lc, h, cout, Ap);
            if (!mode) { if (g == 0) { LA[ci] = Ap; LH[ci] = cout; } }
            else {
#pragma unroll
                for (int i = 0; i < 4; ++i)
#pragma unroll
                    for (int r = 0; r < 4; ++r) atomicAdd(&hs[(i * 16 + g * 4 + r) * 128 + cl], h[i][r]);
                if (!lat && g == 0) {
                    const int b = m0 >> 8;
                    if (dir == 0 && t0 == 192) p.out[O_NLRU + ((size_t)(b * 2 + l) * 2 + 0) * 1024 + ch] = cout;
                    if (dir == 1 && t0 == 0)   p.out[O_NLRU + ((size_t)(b * 2 + l) * 2 + 1) * 1024 + ch] = cout;
                }
            }
        }
    }
    __syncthreads();
    if (mode) {
#pragma unroll
        for (int i = 0; i < 4; ++i) {
            const int tt = (tid >> 4) + 16 * i, c8 = (tid & 15) * 8;
            bf16_t* gp = Pb + (size_t)(m0 + tt) * PW + C_LG + blk * 128 + c8;
            const uint4 gv = *(const uint4*)gp;
            const float4 h0 = *(const float4*)(hs + tt * 128 + c8), h1 = *(const float4*)(hs + tt * 128 + c8 + 4);
            uint4 o;
            o.x = (unsigned)f2bf(h0.x * __uint_as_float(gv.x << 16)) | ((unsigned)f2bf(h0.y * __uint_as_float(gv.x & 0xffff0000u)) << 16);
            o.y = (unsigned)f2bf(h0.z * __uint_as_float(gv.y << 16)) | ((unsigned)f2bf(h0.w * __uint_as_float(gv.y & 0xffff0000u)) << 16);
            o.z = (unsigned)f2bf(h1.x * __uint_as_float(gv.z << 16)) | ((unsigned)f2bf(h1.y * __uint_as_float(gv.z & 0xffff0000u)) << 16);
            o.w = (unsigned)f2bf(h1.z * __uint_as_float(gv.w << 16)) | ((unsigned)f2bf(h1.w * __uint_as_float(gv.w & 0xffff0000u)) << 16);
            *(uint4*)gp = o;
        }
    }
    __syncthreads();
}
DEV void phase_lru_tiles(const Params& p, int l, int mode, unsigned char* lds) {
    for (int it = blockIdx.x; it < 192 * 8; it += gridDim.x) lru_tile(p, l, it >> 3, it & 7, mode, lds);
}

DEV void phase_lru_carry(const Params& p, int l) {
    float* LA = (float*)(p.ws + OFF_LRUC);
    float* LH = LA + 192 * 2 * 1024;
    const int gt = blockIdx.x * blockDim.x + TIDX(), gs = gridDim.x * blockDim.x;
    for (int idx = gt; idx < 20 * 2 * 1024; idx += gs) {
        const int ch = idx & 1023, dir = (idx >> 10) & 1, seq = idx >> 11;
        const bool lat = seq >= 16;
        const int nch = lat ? 32 : 4;
        const int gc0 = lat ? 64 + (seq - 16) * 32 : seq * 4;
        float carry = lat ? p.state_lru[((size_t)((seq - 16) * 2 + l) * 2 + dir) * 1024 + ch] : 0.f;
        for (int s = 0; s < nch; ++s) {
            const int cidx = dir == 0 ? s : nch - 1 - s;
            const size_t ci = ((size_t)(gc0 + cidx) * 2 + dir) * 1024 + ch;
            const float A = LA[ci], Hh = LH[ci];
            LH[ci] = carry;
            carry = A * carry + Hh;
        }
    }
}

DEV void phase_post(const Params& p, int l, float* red) {
    const int tid = TIDX();
    for (int m = blockIdx.x; m < M; m += gridDim.x) {
        const float4 o = ((const float4*)(ws_bf(p, OFF_P) + (size_t)m * PW + 1024))[tid];
        const float ss = block_sum(o.x * o.x + o.y * o.y + o.z * o.z + o.w * o.w, red);
        const float rstd = rsqrtf(ss * (1.f / D) + EPS);
        const float4 x = ((const float4*)x_row(p, l, m))[tid];
        const float4 g = ((const float4*)(p.norm_post + l * D))[tid];
        const float4 gate = ((const float4*)(ws_mod(p) + (size_t)(l * 5 + cond_row(m)) * 3072 + 2048))[tid];
        float4 y;
        y.x = x.x + gate.x * (o.x * rstd * g.x);
        y.y = x.y + gate.y * (o.y * rstd * g.y);
        y.z = x.z + gate.z * (o.z * rstd * g.z);
        y.w = x.w + gate.w * (o.w * rstd * g.w);
        ((float4*)(p.out + (size_t)m * D))[tid] = y;
        if (l == 0) prenorm_row(p, 1, m, y, red);
    }
}

enum { PH_INIT = 0, PH_PRENORM, PH_GEMM1, PH_MIX1, PH_MIX2, PH_MIX3, PH_MERGE, PH_OUT, PH_POST, PH_COUNT };

DEV void run_phase256(const Params& p, int ph, int l, float* lds) {
    switch (ph) {
    case PH_INIT:    phase_mod(p); phase_rope_table(p); __syncthreads(); phase_convert(p, 0, lds); break;
    case PH_PRENORM: phase_prenorm(p, l, lds); break;
    case PH_MIX1:    phase_attn(p, l, (unsigned char*)lds); __syncthreads(); phase_lru_tiles(p, l, 0, (unsigned char*)lds); __syncthreads(); phase_ret_kv(p, l, (unsigned char*)lds); break;
    case PH_MIX2:    phase_lru_carry(p, l); phase_ret_scan(p, l); break;
    case PH_MIX3:    phase_lru_tiles(p, l, 1, (unsigned char*)lds); __syncthreads(); phase_ret_out(p, l, (unsigned char*)lds); break;
    case PH_POST:    phase_post(p, l, lds); __syncthreads(); if (l == 0) phase_convert(p, 1, lds); break;
    }
}
DEV void run_phase512(const Params& p, int ph, int l, LAS unsigned char* lds) {
    switch (ph) {
    case PH_GEMM1:   phase8_gemm1(p, l, lds); break;
    case PH_MERGE:   phase8_merge(p, l, lds); break;
    case PH_OUT:     phase8_out(p, l, lds); break;
    }
}

__global__ void __launch_bounds__(256, 2) phase_kernel256(Params p, int ph, int l) {
    __shared__ __attribute__((aligned(16))) float lds[16384];
    run_phase256(p, ph, l, lds);
}
__global__ void __launch_bounds__(512, 2) phase_kernel512(Params p, int ph, int l) {
    extern __shared__ __attribute__((aligned(16))) unsigned char dsm[];
    run_phase512(p, ph, l, (LAS unsigned char*)dsm);
}

extern "C" void kernel_launch(void* const* d_in, const int* in_sizes, int n_in,
                              void* d_out, int out_size, void* d_ws, size_t ws_size,
                              hipStream_t stream) {
    static int grid_blocks = 0;
    if (grid_blocks == 0) {
        if (n_in != 26 || ws_size < WS_NEED || out_size != 25231360) {
            fprintf(stderr, "kernel_launch: unexpected n_in %d / ws_size %zu (need %zu) / out_size %d\n", n_in, ws_size, (size_t)WS_NEED, out_size);
            grid_blocks = -1; return;
        }
        int dev = 0, cus = 0;
        (void)hipGetDevice(&dev);
        (void)hipDeviceGetAttribute(&cus, hipDeviceAttributeMultiprocessorCount, dev);
        if (hipFuncSetAttribute((const void*)phase_kernel512, hipFuncAttributeMaxDynamicSharedMemorySize, g8::STAGE_BYTES) != hipSuccess) {
            fprintf(stderr, "kernel_launch: hipFuncSetAttribute failed\n"); grid_blocks = -1; return;
        }
        grid_blocks = cus;
    }
    if (grid_blocks < 0) return;
    Params p{};
    const float** pp = (const float**)&p;
    for (int i = 0; i < 26; ++i) pp[i] = (const float*)d_in[i];
    p.out = (float*)d_out;
    p.ws = (unsigned char*)d_ws;
    const int g256 = grid_blocks * 2, g512 = grid_blocks;
    phase_kernel256<<<g256, 256, 0, stream>>>(p, PH_INIT, 0);
    phase_kernel256<<<g256, 256, 0, stream>>>(p, PH_PRENORM, 0);
    for (int l = 0; l < 2; ++l) {
        phase_kernel512<<<g512, 512, g8::STAGE_BYTES, stream>>>(p, PH_GEMM1, l);
        phase_kernel256<<<g256, 256, 0, stream>>>(p, PH_MIX1, l);
        phase_kernel256<<<g256, 256, 0, stream>>>(p, PH_MIX2, l);
        phase_kernel256<<<g256, 256, 0, stream>>>(p, PH_MIX3, l);
        phase_kernel512<<<g512, 512, g8::STAGE_BYTES, stream>>>(p, PH_MERGE, l);
        phase_kernel512<<<g512, 512, g8::STAGE_BYTES, stream>>>(p, PH_OUT, l);
        phase_kernel256<<<g256, 256, 0, stream>>>(p, PH_POST, l);
    }
}
```

```cpp
#include <hip/hip_runtime.h>
#include <hip/hip_cooperative_groups.h>
#include <cstdio>
#include <cstdint>
namespace cg = cooperative_groups;

#ifndef ONE_LAUNCH
#define ONE_LAUNCH 1
#endif

typedef unsigned short bf16_t;
#define DEV __device__ __forceinline__

constexpr int D = 1024;
constexpr int NCTX = 4096;
constexpr int NLAT = 8192;
constexpr int M = NCTX + NLAT;
constexpr int NW = 7680;
constexpr int N_RQ = 0, N_RK = 512, N_RV = 1024, N_RG = 2048, N_LX = 3072, N_LG = 4096,
              N_AQ = 5120, N_AK = 6144, N_AV = 6400, N_AG = 6656;
constexpr int PW = 6656;
constexpr int C_RQ = 0, C_RK = 512, C_RG = 1024, C_LX = 2048, C_LG = 3072,
              C_AQ = 4096, C_AK = 5120, C_AV = 5376, C_AG = 5632;
constexpr float EPS = 1e-6f;

constexpr size_t O_YP = 0, O_YS = 4194304, O_NK = 12582912, O_NV = 14680064, O_NRET = 16777216, O_NLRU = 25165824;

constexpr size_t OFF_MOD  = 0;
constexpr size_t OFF_LRUW = 122880;
constexpr size_t OFF_WBR  = OFF_LRUW + 1048576;
constexpr size_t OFF_WOUT = OFF_WBR + 6291456;
constexpr size_t OFF_WMG  = OFF_WOUT + 2097152;
constexpr size_t OFF_H    = OFF_WMG + 6291456;
constexpr size_t OFF_P    = OFF_H + (size_t)M * 1024 * 2;
constexpr size_t OFF_RVT  = OFF_P + (size_t)M * PW * 2;
constexpr size_t OFF_W1T  = OFF_RVT + (size_t)1024 * M * 2;
constexpr size_t OFF_OFTMP = OFF_W1T;
constexpr size_t OFF_LRUC = 262266880;
constexpr size_t OFF_ROPE = OFF_LRUC + (size_t)2 * 192 * 2 * 1024 * 4;
constexpr size_t WS_NEED  = OFF_ROPE + (size_t)2048 * 96 * 8;
static_assert(OFF_OFTMP + (size_t)M * 1024 * 2 <= OFF_LRUC, "overlap");
static_assert(WS_NEED <= 268435456, "ws budget");

struct Params {
    const float *x_prompt, *x_sample, *cache_k, *cache_v, *state_ret, *state_lru, *c, *c_ctx,
                *w_ada, *b_ada, *norm_pre, *norm_post, *w_in, *ret_decay, *conv_w, *conv_b,
                *lru_wa, *lru_ba, *lru_wx, *lru_bx, *lru_lambda, *att_sink, *w_branch, *w_merge, *b_merge, *w_out;
    float* out;
    unsigned char* ws;
};

DEV int TIDX() { int t = threadIdx.x; asm volatile("" : "+v"(t)); return t; }
DEV float bf2f(bf16_t v) { return __uint_as_float(((unsigned)v) << 16); }
DEV bf16_t f2bf(float f) { unsigned u = __float_as_uint(f); u += 0x7fffu + ((u >> 16) & 1u); return (bf16_t)(u >> 16); }
DEV float siluf(float x) { return x / (1.f + __expf(-x)); }
DEV float sigmf(float x) { return 1.f / (1.f + __expf(-x)); }
DEV float softplusf(float x) { return fmaxf(x, 0.f) + log1pf(__expf(-fabsf(x))); }

DEV float* ws_mod(const Params& p) { return (float*)(p.ws + OFF_MOD); }
DEV bf16_t* ws_bf(const Params& p, size_t off) { return (bf16_t*)(p.ws + off); }

DEV const float* x_row(const Params& p, int l, int m) {
    const float* xp = p.x_prompt; const float* xs = p.x_sample; const float* po = p.out;
    if (l == 0) return m < NCTX ? xp + (size_t)m * D : xs + (size_t)(m - NCTX) * D;
    return po + (size_t)m * D;
}
DEV int cond_row(int m) { return m < NCTX ? 0 : 1 + ((m - NCTX) >> 11); }

DEV float wave_sum(float v) {
#pragma unroll
    for (int o = 1; o < 64; o <<= 1) v += __shfl_xor(v, o);
    return v;
}
DEV float half_sum(float v, float* red) {
    v = wave_sum(v);
    const int t = TIDX();
    __syncthreads();
    if ((t & 63) == 0) red[t >> 6] = v;
    __syncthreads();
    const float* r4 = red + ((t >> 8) << 2);
    return (r4[0] + r4[1]) + (r4[2] + r4[3]);
}

DEV void phase_mod(const Params& p, float* lds) {
    float* mod = ws_mod(p);
    const int tid = TIDX(), jj = tid & 31, kq = tid >> 5;
    const float* cctx = p.c_ctx; const float* cb = p.c;
    for (int unit = blockIdx.x; unit < 192; unit += gridDim.x) {
        const int l = unit / 96, j = (unit % 96) * 32 + jj;
        const float* w = p.w_ada + (size_t)l * D * 3072 + j;
        float acc[5] = {0.f, 0.f, 0.f, 0.f, 0.f};
        for (int k = kq * 64; k < kq * 64 + 64; ++k) {
            const float wv = w[(size_t)k * 3072];
            acc[0] += siluf(cctx[k]) * wv;
#pragma unroll
            for (int r = 1; r < 5; ++r) acc[r] += siluf(cb[(r - 1) * D + k]) * wv;
        }
        __syncthreads();
#pragma unroll
        for (int r = 0; r < 5; ++r) lds[(kq * 5 + r) * 32 + jj] = acc[r];
        __syncthreads();
        if (tid < 160) {
            const int r = tid >> 5;
            float sum = p.b_ada[l * 3072 + j];
#pragma unroll
            for (int q = 0; q < 16; ++q) sum += lds[(q * 5 + r) * 32 + jj];
            mod[(size_t)(l * 5 + r) * 3072 + j] = sum;
        }
    }
    __syncthreads();
}

DEV void phase_rope_table(const Params& p) {
    float2* tab = (float2*)(p.ws + OFF_ROPE);
    const int gt = blockIdx.x * blockDim.x + TIDX(), gs = gridDim.x * blockDim.x;
    for (int idx = gt; idx < 2048 * 96; idx += gs) {
        const int t = idx / 96, e = idx % 96;
        int a, c; float nq;
        if (e < 64) { a = e >> 5; c = e & 31; nq = 32.f; } else { a = (e - 64) >> 4; c = (e - 64) & 15; nq = 16.f; }
        const float pos = (float)(a ? (t & 63) : (t >> 6));
        const float inv = powf(10000.f, -(float)c / nq);
        float sn, cs; sincosf(pos * inv, &sn, &cs);
        tab[idx] = make_float2(cs, sn);
    }
}

DEV int w1t_row(int n) {
    if (n < N_RV) return (n & ~48) | ((n & 16) << 1) | ((n & 32) >> 1);
    if (n < N_RG) return PW + (n - N_RV);
    return n - 1024;
}
DEV void transpose_tile(const float* src, int K, int N, bf16_t* dst, int k0, int n0, float* tile, bool w1map = false) {
    const int tid = TIDX();
#pragma unroll 4
    for (int i = 0; i < 8; ++i) {
        const int r = i * 8 + (tid >> 6), c = tid & 63;
        tile[r * 65 + c] = src[(size_t)(k0 + r) * N + n0 + c];
    }
    __syncthreads();
#pragma unroll 4
    for (int i = 0; i < 8; ++i) {
        const int n = i * 8 + (tid >> 6), k = tid & 63;
        const int dr = w1map ? w1t_row(n0 + n) : n0 + n;
        dst[(size_t)dr * K + k0 + k] = f2bf(tile[k * 65 + n]);
    }
    __syncthreads();
}
DEV void phase_convert(const Params& p, int l, float* tile) {
    constexpr int T_IN = 16 * 120, T_MG = 16 * 48, T_BR = 3 * 256, T_OUT = 256, T_LRU = 32 * 4;
    constexpr int TOT = T_IN + T_MG + T_BR + T_OUT + T_LRU;
    for (int it = blockIdx.x; it < TOT; it += gridDim.x) {
        int r = it;
        if (r < T_IN) { transpose_tile(p.w_in + (size_t)l * D * NW, D, NW, ws_bf(p, OFF_W1T), (r / 120) * 64, (r % 120) * 64, tile, true); continue; }
        r -= T_IN;
        if (r < T_MG) { transpose_tile(p.w_merge + (size_t)l * D * 3072, D, 3072, ws_bf(p, OFF_WMG), (r / 48) * 64, (r % 48) * 64, tile); continue; }
        r -= T_MG;
        if (r < T_BR) { const int nb = r / 256, q = r % 256;
            transpose_tile(p.w_branch + ((size_t)l * 3 + nb) * D * D, D, D, ws_bf(p, OFF_WBR) + (size_t)nb * D * D, (q / 16) * 64, (q % 16) * 64, tile); continue; }
        r -= T_BR;
        if (r < T_OUT) { transpose_tile(p.w_out + (size_t)l * D * D, D, D, ws_bf(p, OFF_WOUT), (r / 16) * 64, (r % 16) * 64, tile); continue; }
        r -= T_OUT;
        {
            const int mat = r / 4, q = r % 4;
            const int dir = mat >> 4, gate = (mat >> 3) & 1, blk = mat & 7;
            const float* wa_ = p.lru_wa; const float* wx_ = p.lru_wx;
            const float* src = (gate ? wx_ : wa_) + (((size_t)l * 2 + dir) * 8 + blk) * 128 * 128;
            transpose_tile(src, 128, 128, ws_bf(p, OFF_LRUW) + (size_t)mat * 128 * 128, (q >> 1) * 64, (q & 1) * 64, tile);
        }
    }
}

DEV void prenorm_row(const Params& p, int l, int m, float4 v, float* red) {
    const int tid = TIDX() & 255;
    const float ss = half_sum(v.x * v.x + v.y * v.y + v.z * v.z + v.w * v.w, red);
    const float rstd = rsqrtf(ss * (1.f / D) + EPS);
    const float* mod = ws_mod(p) + (size_t)(l * 5 + cond_row(m)) * 3072;
    const float4 g = ((const float4*)(p.norm_pre + l * D))[tid];
    const float4 sh = ((const float4*)mod)[tid];
    const float4 sc = ((const float4*)(mod + 1024))[tid];
    bf16_t* h = ws_bf(p, OFF_H) + (size_t)m * D + tid * 4;
    ushort4 o;
    o.x = f2bf(v.x * rstd * g.x * (1.f + sc.x) + sh.x);
    o.y = f2bf(v.y * rstd * g.y * (1.f + sc.y) + sh.y);
    o.z = f2bf(v.z * rstd * g.z * (1.f + sc.z) + sh.z);
    o.w = f2bf(v.w * rstd * g.w * (1.f + sc.w) + sh.w);
    *(ushort4*)h = o;
}
DEV void phase_prenorm(const Params& p, int l, float* red) {
    const int half = TIDX() >> 8;
    for (int m = blockIdx.x * 2 + half; m < M; m += gridDim.x * 2) {
        const float4 v = ((const float4*)x_row(p, l, m))[TIDX() & 255];
        prenorm_row(p, l, m, v, red);
    }
}

typedef short bf16x8 __attribute__((ext_vector_type(8)));
typedef float f32x4 __attribute__((ext_vector_type(4)));
#define LAS __attribute__((address_space(3)))
namespace g8 {
constexpr int BK = 64, HALF = 128, HTB = HALF * BK * 2, STAGE_BYTES = 8 * HTB;
DEV int lds_byte(int r, int c) { const int st = (r >> 4) * 2 + (c >> 5), rr = r & 15, cc = c & 31, ob = rr * 64 + cc * 2; return st * 1024 + (ob ^ (((ob >> 9) & 1) << 5)); }
DEV void stage_rc(int b, int& R, int& C) { const int st = b / 1024, sb = b % 1024, swz = sb ^ (((sb >> 9) & 1) << 5); R = (st >> 1) * 16 + swz / 64; C = (st & 1) * 32 + (swz % 64) / 2; }
struct Unit { const char* a; const char* b; int kind, pm, pn; };

template <class Sched, class Epi>
DEV void gemm_phase(LAS unsigned char* lds, const unsigned lda, const unsigned ldb, const int nt, const Sched& S, const Epi& E) {
    const int tid = TIDX(), wid = __builtin_amdgcn_readfirstlane(tid >> 6), lane = tid & 63, wr = wid >> 2, wc = wid & 3, fr = lane & 15, fq = lane >> 4;
    unsigned voffA[2], voffB[2];
#pragma unroll
    for (int i = 0; i < 2; ++i) { int R, C; stage_rc(tid * 16 + i * 8192, R, C); voffA[i] = (unsigned)R * lda + (unsigned)C * 2u; voffB[i] = (unsigned)R * ldb + (unsigned)C * 2u; }
    const size_t kstep = (size_t)(BK * 2);
    const size_t hstepA = (size_t)HALF * lda, hstepB = (size_t)HALF * ldb;
    const unsigned ldsw = (unsigned)wid * 1024u;
    const int aoff = lds_byte(wr * 64 + fr, fq * 8), boff = lds_byte(wc * 32 + fr, fq * 8);
#define G8_SA(b, h) (((b) * 2 + (h)) * HTB)
#define G8_SB(b, h) ((4 + (b) * 2 + (h)) * HTB)
#define G8_STAGE(bufoff, gbase, voff) do { _Pragma("unroll") for (int _i = 0; _i < 2; ++_i) \
        __builtin_amdgcn_global_load_lds((const unsigned*)((const char*)(gbase) + (voff)[_i]), (LAS unsigned*)(lds + (bufoff) + ldsw + _i * 8192), 16, 0, 0); } while (0)
#define G8_LDA(dst, b, h) do { _Pragma("unroll") for (int m = 0; m < 4; ++m) _Pragma("unroll") for (int k = 0; k < 2; ++k) dst[m][k] = *(const LAS bf16x8*)(lds + G8_SA(b, h) + aoff + m * 2048 + k * 1024); } while (0)
#define G8_LDB(dst, b, h) do { _Pragma("unroll") for (int n = 0; n < 2; ++n) _Pragma("unroll") for (int k = 0; k < 2; ++k) dst[n][k] = *(const LAS bf16x8*)(lds + G8_SB(b, h) + boff + n * 2048 + k * 1024); } while (0)
#define G8_MMA(ai, bj, At, Bt) do { __builtin_amdgcn_s_setprio(1); _Pragma("unroll") for (int m = 0; m < 4; ++m) _Pragma("unroll") for (int n = 0; n < 2; ++n) _Pragma("unroll") for (int k = 0; k < 2; ++k) \
        acc[ai][bj][m][n] = __builtin_amdgcn_mfma_f32_16x16x32_bf16(Bt[n][k], At[m][k], acc[ai][bj][m][n], 0, 0, 0); __builtin_amdgcn_s_setprio(0); } while (0)
#define G8_WAIT_V(n) asm volatile("s_waitcnt vmcnt(" #n ")" ::: "memory")
#define G8_WAIT_L(n) asm volatile("s_waitcnt lgkmcnt(" #n ")" ::: "memory")
#define G8_BAR __builtin_amdgcn_s_barrier()
#define G8_SCHED __builtin_amdgcn_sched_barrier(0)
    Unit cur, nxt; int ui = 0;
    if (!S.next(0, cur)) return;
    f32x4 acc[2][2][4][2];
#pragma unroll
    for (int a = 0; a < 2; ++a)
#pragma unroll
        for (int b = 0; b < 2; ++b)
#pragma unroll
            for (int m = 0; m < 4; ++m)
#pragma unroll
                for (int n = 0; n < 2; ++n) acc[a][b][m][n] = (f32x4){0.f, 0.f, 0.f, 0.f};
    bf16x8 At[4][2], B0[2][2], B1[2][2];
    const char* cA = cur.a; const char* cB = cur.b;
    G8_STAGE(G8_SB(0, 0), cB, voffB); G8_STAGE(G8_SB(0, 1), cB + hstepB, voffB); G8_STAGE(G8_SA(0, 0), cA, voffA); G8_STAGE(G8_SA(0, 1), cA + hstepA, voffA);
    if (wr == 1) G8_BAR;
    G8_WAIT_V(2); G8_BAR;
    G8_STAGE(G8_SB(1, 0), cB + kstep, voffB); G8_STAGE(G8_SA(1, 0), cA + kstep, voffA); G8_STAGE(G8_SB(1, 1), cB + hstepB + kstep, voffB);
    G8_WAIT_V(6); G8_BAR;
    for (;;) {
        const bool has_next = S.next(ui + 1, nxt);
        const char* nA = has_next ? nxt.a : cA; const char* nB = has_next ? nxt.b : cB;
        for (int t = 0; t < nt; t += 2) {
            const bool last = (t == nt - 2);
            const char* a1 = cA + (size_t)(t + 1) * kstep;
            const char* a2 = last ? nA : cA + (size_t)(t + 2) * kstep; const char* b2 = last ? nB : cB + (size_t)(t + 2) * kstep;
            const char* a3 = a2 + kstep; const char* b3 = b2 + kstep;
            G8_LDB(B0, 0, 0); G8_LDB(B1, 0, 1); G8_SCHED; G8_LDA(At, 0, 0); G8_STAGE(G8_SA(1, 1), a1 + hstepA, voffA);
            G8_WAIT_V(8); G8_WAIT_L(0); G8_BAR; G8_MMA(0, 0, At, B0); G8_MMA(0, 1, At, B1); G8_BAR; G8_SCHED;
            G8_LDA(At, 0, 1); G8_STAGE(G8_SB(0, 0), b2, voffB); G8_STAGE(G8_SB(0, 1), b2 + hstepB, voffB); G8_STAGE(G8_SA(0, 0), a2, voffA);
            G8_WAIT_V(8); G8_WAIT_L(0); G8_BAR; G8_MMA(1, 0, At, B0); G8_MMA(1, 1, At, B1); G8_BAR; G8_SCHED;
            G8_LDB(B0, 1, 0); G8_LDB(B1, 1, 1); G8_SCHED; G8_LDA(At, 1, 0); G8_STAGE(G8_SA(0, 1), a2 + hstepA, voffA);
            G8_WAIT_V(8); G8_WAIT_L(0); G8_BAR; G8_MMA(0, 0, At, B0); G8_MMA(0, 1, At, B1); G8_BAR; G8_SCHED;
            G8_LDA(At, 1, 1); G8_STAGE(G8_SB(1, 0), b3, voffB); G8_STAGE(G8_SB(1, 1), b3 + hstepB, voffB); G8_STAGE(G8_SA(1, 0), a3, voffA);
            G8_WAIT_V(8); G8_WAIT_L(0); G8_BAR; G8_MMA(1, 0, At, B0); G8_MMA(1, 1, At, B1); G8_BAR; G8_SCHED;
        }
        if (wr == 0) G8_BAR;
        E(acc, cur, wr, wc, fr, fq);
        if (!has_next) break;
#pragma unroll
        for (int a = 0; a < 2; ++a)
#pragma unroll
            for (int b = 0; b < 2; ++b)
#pragma unroll
                for (int m = 0; m < 4; ++m)
#pragma unroll
                    for (int n = 0; n < 2; ++n) acc[a][b][m][n] = (f32x4){0.f, 0.f, 0.f, 0.f};
        cur = nxt; cA = nA; cB = nB; ++ui;
        if (wr == 1) G8_BAR;
    }
    G8_WAIT_V(0);
    G8_BAR;
#undef G8_SA
#undef G8_SB
#undef G8_STAGE
#undef G8_LDA
#undef G8_LDB
#undef G8_MMA
#undef G8_WAIT_V
#undef G8_WAIT_L
#undef G8_BAR
#undef G8_SCHED
}

DEV void grid_unit(int wgid, int nM, int nN, int& pm, int& pn) {
    const int nwg = nM * nN, q = nwg / 8, r = nwg % 8, xcd = wgid % 8, off = wgid / 8;
    wgid = (xcd < r ? xcd * (q + 1) : r * (q + 1) + (xcd - r) * q) + off;
    const int nig = 8 * nN, gid = wgid / nig, fm = gid * 8, gsz = (nM - fm) < 8 ? (nM - fm) : 8;
    pm = fm + ((wgid % nig) % gsz); pn = (wgid % nig) / gsz;
}
DEV unsigned pk2(float lo, float hi) { return (unsigned)f2bf(lo) | ((unsigned)f2bf(hi) << 16); }
DEV uint2 pk4(const f32x4 v) { return make_uint2(pk2(v[0], v[1]), pk2(v[2], v[3])); }
DEV float lo16(unsigned u) { return __uint_as_float(u << 16); }
DEV float hi16(unsigned u) { return __uint_as_float(u & 0xffff0000u); }
}

struct SchedG1 {
    const char* H; const char* W; int G, c;
    DEV bool next(int i, g8::Unit& u) const {
        int L = i * G + c;
        if (L >= 1440) return false;
        if (L < 1248) { g8::grid_unit(L, 48, 26, u.pm, u.pn); u.kind = 0; u.a = H + (size_t)u.pm * 256 * 2048; u.b = W + (size_t)u.pn * 256 * 2048; }
        else { g8::grid_unit(L - 1248, 4, 48, u.pm, u.pn); u.kind = 1; u.a = W + (size_t)(PW + u.pm * 256) * 2048; u.b = H + (size_t)u.pn * 256 * 2048; }
        return true;
    }
};
struct EpiG1 {
    unsigned char* ws; float* out; int l;
    DEV void operator()(const f32x4 (&acc)[2][2][4][2], const g8::Unit& u, int wr, int wc, int fr, int fq) const {
        using namespace g8;
        bf16_t* Pb = (bf16_t*)(ws + OFF_P);
        if (u.kind == 1) {
            bf16_t* RVT = (bf16_t*)(ws + OFF_RVT);
#pragma unroll
            for (int ai = 0; ai < 2; ++ai)
#pragma unroll
                for (int bj = 0; bj < 2; ++bj)
#pragma unroll
                    for (int m = 0; m < 4; ++m)
#pragma unroll
                        for (int n = 0; n < 2; ++n) {
                            const int ch = u.pm * 256 + ai * 128 + wr * 64 + m * 16 + fr;
                            const int tok = u.pn * 256 + bj * 128 + wc * 32 + n * 16 + fq * 4;
                            *(uint2*)(RVT + (size_t)ch * M + tok) = pk4(acc[ai][bj][m][n]);
                        }
            return;
        }
        const int pn = u.pn;
        const bool rope_ret = pn < 4, rope_att = pn >= 16 && pn <= 20;
#pragma unroll
        for (int ai = 0; ai < 2; ++ai)
#pragma unroll
            for (int m = 0; m < 4; ++m) {
                const int row = u.pm * 256 + ai * 128 + wr * 64 + m * 16 + fr;
                const bool lat = row >= NCTX;
                const int t = lat ? ((row - NCTX) & 2047) : (row & 255);
                bf16_t* Pr = Pb + (size_t)row * PW;
#pragma unroll
                for (int bj = 0; bj < 2; ++bj) {
                    const int cb = pn * 256 + bj * 128 + wc * 32 + fq * 4;
                    if (rope_ret || rope_att) {
                        f32x4 x1 = acc[ai][bj][m][0], x2 = acc[ai][bj][m][1];
                        int lc1, lc2, te;
                        if (rope_ret) { lc1 = pn * 256 + bj * 128 + (wc >> 1) * 64 + (wc & 1) * 16 + fq * 4; lc2 = lc1 + 32; te = (wc >> 1) * 32 + (wc & 1) * 16 + fq * 4; }
                        else { lc1 = cb; lc2 = cb + 16; te = 64 + (wc & 1) * 16 + fq * 4; }
                        if (rope_att && !lat && pn == 20) {
                            float* ok = out + O_NK + ((size_t)((row >> 8) * 2 + l) * 256 + t) * 256 + (lc1 - C_AK);
                            *(float4*)ok = make_float4(x1[0], x1[1], x1[2], x1[3]);
                            *(float4*)(ok + 16) = make_float4(x2[0], x2[1], x2[2], x2[3]);
                        }
                        if (lat) {
                            const float4* tb = (const float4*)((const float2*)(ws + OFF_ROPE) + (size_t)t * 96 + te);
                            const float4 c01 = tb[0], c23 = tb[1];
                            const float cs[4] = {c01.x, c01.z, c23.x, c23.z}, sn[4] = {c01.y, c01.w, c23.y, c23.w};
                            f32x4 o1, o2;
#pragma unroll
                            for (int j = 0; j < 4; ++j) { o1[j] = x1[j] * cs[j] - x2[j] * sn[j]; o2[j] = x2[j] * cs[j] + x1[j] * sn[j]; }
                            x1 = o1; x2 = o2;
                        }
                        const float sc = pn < 2 ? 0.08838834764831845f : (pn >= 16 && pn < 20) ? 0.125f : 1.f;
                        x1 *= sc; x2 *= sc;
                        *(uint2*)(Pr + lc1) = pk4(x1);
                        *(uint2*)(Pr + lc2) = pk4(x2);
                    } else {
#pragma unroll
                        for (int n = 0; n < 2; ++n) {
                            f32x4 v = acc[ai][bj][m][n];
                            const int col = cb + n * 16;
                            if (pn == 21) {
                                if (!lat) *(float4*)(out + O_NV + ((size_t)((row >> 8) * 2 + l) * 256 + t) * 256 + (col - C_AV)) = make_float4(v[0], v[1], v[2], v[3]);
                            } else if (!(pn >= 8 && pn < 12)) {
#pragma unroll
                                for (int j = 0; j < 4; ++j) v[j] = siluf(v[j]);
                            }
                            *(uint2*)(Pr + col) = pk4(v);
                        }
                    }
                }
            }
    }
};
DEV void phase8_gemm1(const Params& p, int l, LAS unsigned char* lds) {
    SchedG1 S{(const char*)(p.ws + OFF_H), (const char*)(p.ws + OFF_W1T), (int)gridDim.x, (int)blockIdx.x};
    EpiG1 E{p.ws, p.out, l};
    g8::gemm_phase(lds, 2048u, 2048u, 16, S, E);
}

constexpr size_t OFF_G2 = OFF_RVT;
struct SchedMg {
    const char* A; const char* B; unsigned lda; int G, c, zpass;
    DEV bool next(int i, g8::Unit& u) const {
        const int tile = (i / 3) * G + c, n = i % 3;
        if (tile >= 192) return false;
        u.pm = tile >> 2; u.pn = tile & 3; u.kind = n;
        const int acol = zpass ? (n == 0 ? C_RG : n == 1 ? C_LG : C_AQ) : 0;
        u.a = A + (size_t)u.pm * 256 * lda + (size_t)acol * 2;
        u.b = B + ((size_t)n * 1024 + u.pn * 256) * 2048;
        return true;
    }
};
struct EpiMg {
    unsigned char* ws; const float* bias; int zpass;
    DEV bf16_t* gslot(int n, int row) const {
        bf16_t* Pb = (bf16_t*)(ws + OFF_P);
        return n == 0 ? Pb + (size_t)row * PW + C_LX : n == 1 ? Pb + (size_t)row * PW + C_AG : (bf16_t*)(ws + OFF_G2) + (size_t)row * 1024;
    }
    DEV void operator()(const f32x4 (&acc)[2][2][4][2], const g8::Unit& u, int wr, int wc, int fr, int fq) const {
        using namespace g8;
        const int n = u.kind;
#pragma unroll
        for (int ai = 0; ai < 2; ++ai)
#pragma unroll
            for (int m = 0; m < 4; ++m) {
                const int row = u.pm * 256 + ai * 128 + wr * 64 + m * 16 + fr;
                bf16_t* gs = gslot(n, row);
                bf16_t* Tr = (bf16_t*)(ws + OFF_P) + (size_t)row * PW;
#pragma unroll
                for (int bj = 0; bj < 2; ++bj)
#pragma unroll
                    for (int nn = 0; nn < 2; ++nn) {
                        const int col = u.pn * 256 + bj * 128 + wc * 32 + nn * 16 + fq * 4;
                        f32x4 v = acc[ai][bj][m][nn];
                        if (!zpass) {
                            const float4 bz = *(const float4*)(bias + n * 1024 + col);
                            v[0] = sigmf(v[0] + bz.x); v[1] = sigmf(v[1] + bz.y); v[2] = sigmf(v[2] + bz.z); v[3] = sigmf(v[3] + bz.w);
                            *(uint2*)(gs + col) = pk4(v);
                        } else {
                            const uint2 gv = *(const uint2*)(gs + col);
                            v[0] *= lo16(gv.x); v[1] *= hi16(gv.x); v[2] *= lo16(gv.y); v[3] *= hi16(gv.y);
                            if (n > 0) { const uint2 tv = *(const uint2*)(Tr + col); v[0] += lo16(tv.x); v[1] += hi16(tv.x); v[2] += lo16(tv.y); v[3] += hi16(tv.y); }
                            *(uint2*)(Tr + col) = pk4(v);
                        }
                    }
            }
    }
};
DEV void phase8_merge(const Params& p, int l, LAS unsigned char* lds) {
    {
        SchedMg S{(const char*)(p.ws + OFF_H), (const char*)(p.ws + OFF_WMG), 2048u, (int)gridDim.x, (int)blockIdx.x, 0};
        EpiMg E{p.ws, p.b_merge + (size_t)l * 3072, 0};
        g8::gemm_phase(lds, 2048u, 2048u, 16, S, E);
    }
    {
        SchedMg S{(const char*)(p.ws + OFF_P), (const char*)(p.ws + OFF_WBR), (unsigned)PW * 2u, (int)gridDim.x, (int)blockIdx.x, 1};
        EpiMg E{p.ws, p.b_merge + (size_t)l * 3072, 1};
        g8::gemm_phase(lds, (unsigned)PW * 2u, 2048u, 16, S, E);
    }
}

struct SchedOut {
    const char* A; const char* B; int G, c;
    DEV bool next(int i, g8::Unit& u) const {
        const int tile = i * G + c;
        if (tile >= 192) return false;
        u.pm = tile >> 2; u.pn = tile & 3; u.kind = 0;
        u.a = A + (size_t)u.pm * 256 * PW * 2; u.b = B + (size_t)u.pn * 256 * 2048;
        return true;
    }
};
struct EpiOut {
    unsigned char* ws;
    DEV void operator()(const f32x4 (&acc)[2][2][4][2], const g8::Unit& u, int wr, int wc, int fr, int fq) const {
#pragma unroll
        for (int ai = 0; ai < 2; ++ai)
#pragma unroll
            for (int m = 0; m < 4; ++m) {
                const int row = u.pm * 256 + ai * 128 + wr * 64 + m * 16 + fr;
                float* orow = (float*)((bf16_t*)(ws + OFF_P) + (size_t)row * PW + 1024);
#pragma unroll
                for (int bj = 0; bj < 2; ++bj)
#pragma unroll
                    for (int n = 0; n < 2; ++n) {
                        const f32x4 v = acc[ai][bj][m][n];
                        *(float4*)(orow + u.pn * 256 + bj * 128 + wc * 32 + n * 16 + fq * 4) = make_float4(v[0], v[1], v[2], v[3]);
                    }
            }
    }
};
DEV void phase8_out(const Params& p, int l, LAS unsigned char* lds) {
    SchedOut S{(const char*)(p.ws + OFF_P), (const char*)(p.ws + OFF_WOUT), (int)gridDim.x, (int)blockIdx.x};
    EpiOut E{p.ws};
    g8::gemm_phase(lds, (unsigned)PW * 2u, 2048u, 16, S, E);
}

DEV uint4 pack8(const float4 a, const float4 b) {
    uint4 r;
    r.x = (unsigned)f2bf(a.x) | ((unsigned)f2bf(a.y) << 16); r.y = (unsigned)f2bf(a.z) | ((unsigned)f2bf(a.w) << 16);
    r.z = (unsigned)f2bf(b.x) | ((unsigned)f2bf(b.y) << 16); r.w = (unsigned)f2bf(b.z) | ((unsigned)f2bf(b.w) << 16);
    return r;
}
DEV void attn_item(const Params& p, int l, int item, unsigned char* lds) {
    bf16_t* Pb = ws_bf(p, OFF_P);
    unsigned char* Ks = lds; unsigned char* Vt = lds + 8192;
    const int tid = TIDX(), lane = tid & 63, w = tid >> 6, g = lane >> 4, lc = lane & 15;
    const bool lat = item < 512;
    int b, hk, qb, row0, L;
    if (lat) { b = item >> 7; hk = (item >> 5) & 3; qb = item & 31; row0 = NCTX + b * 2048; L = 2048; }
    else { const int it = item - 512; b = it >> 4; hk = (it >> 2) & 3; qb = it & 3; row0 = b * 256; L = 256; }
    const int q0 = qb * 64 + (w >> 2) * 32;
    const int hq = hk * 4 + (w & 3);
    bf16x8 qfr[2][2];
#pragma unroll
    for (int qf = 0; qf < 2; ++qf)
#pragma unroll
        for (int ks = 0; ks < 2; ++ks)
            qfr[qf][ks] = *(const bf16x8*)(Pb + (size_t)(row0 + q0 + qf * 16 + lc) * PW + C_AQ + hq * 64 + ks * 32 + g * 8);
    f32x4 O[4][2];
    float mrun[2], lrun[2];
    const float sink = p.att_sink[l * 16 + hq];
#pragma unroll
    for (int qf = 0; qf < 2; ++qf) { mrun[qf] = sink; lrun[qf] = g == 0 ? 1.f : 0.f;
#pragma unroll
        for (int df = 0; df < 4; ++df) O[df][qf] = (f32x4){0.f, 0.f, 0.f, 0.f}; }
    const int kbase = qb * 64;
    const int nband = lat ? 5 : 4;
    const int ntile = lat ? 9 : 4;
    const int fsw = (lane >> 1) & 7;
    for (int t = 0; t < ntile; ++t) {
        const bool cache = t >= nband;
        int kp0 = 0;
        if (!cache) { kp0 = lat ? kbase + 64 * (t - 2) : 64 * t; if (kp0 < 0 || kp0 >= L) continue; }
        __syncthreads();
        if (!cache) {
            {
                const int row = tid >> 3, c = tid & 7;
                const uint4 v = *(const uint4*)(Pb + (size_t)(row0 + kp0 + row) * PW + C_AK + hk * 64 + c * 8);
                *(uint4*)(Ks + row * 128 + ((c ^ ((row >> 1) & 7)) << 4)) = v;
            }
            {
                const int key = lane, c = w;
                const uint4 v = *(const uint4*)(Pb + (size_t)(row0 + kp0 + key) * PW + C_AV + hk * 64 + c * 8);
                bf16_t* dst = (bf16_t*)(Vt + (c * 8) * 136 + key * 2);
                dst[0 * 68] = (bf16_t)(v.x & 0xffff); dst[1 * 68] = (bf16_t)(v.x >> 16);
                dst[2 * 68] = (bf16_t)(v.y & 0xffff); dst[3 * 68] = (bf16_t)(v.y >> 16);
                dst[4 * 68] = (bf16_t)(v.z & 0xffff); dst[5 * 68] = (bf16_t)(v.z >> 16);
                dst[6 * 68] = (bf16_t)(v.w & 0xffff); dst[7 * 68] = (bf16_t)(v.w >> 16);
            }
        } else {
            const int j0 = (t - nband) * 64;
            const float* ck = p.cache_k + (size_t)((b * 2 + l) * 256 + j0) * 256 + hk * 64;
            const float* cv = p.cache_v + (size_t)((b * 2 + l) * 256 + j0) * 256 + hk * 64;
            {
                const int row = tid >> 3, c = tid & 7;
                const float4 x0 = *(const float4*)(ck + (size_t)row * 256 + c * 8), x1 = *(const float4*)(ck + (size_t)row * 256 + c * 8 + 4);
                *(uint4*)(Ks + row * 128 + ((c ^ ((row >> 1) & 7)) << 4)) = pack8(x0, x1);
            }
            {
                const int key = lane, c = w;
                const float4 x0 = *(const float4*)(cv + (size_t)key * 256 + c * 8), x1 = *(const float4*)(cv + (size_t)key * 256 + c * 8 + 4);
                bf16_t* dst = (bf16_t*)(Vt + (c * 8) * 136 + key * 2);
                dst[0 * 68] = f2bf(x0.x); dst[1 * 68] = f2bf(x0.y); dst[2 * 68] = f2bf(x0.z); dst[3 * 68] = f2bf(x0.w);
                dst[4 * 68] = f2bf(x1.x); dst[5 * 68] = f2bf(x1.y); dst[6 * 68] = f2bf(x1.z); dst[7 * 68] = f2bf(x1.w);
            }
        }
        __syncthreads();
        f32x4 sc[4][2];
#pragma unroll
        for (int kf = 0; kf < 4; ++kf)
#pragma unroll
            for (int qf = 0; qf < 2; ++qf) sc[kf][qf] = (f32x4){0.f, 0.f, 0.f, 0.f};
#pragma unroll
        for (int ks = 0; ks < 2; ++ks) {
            bf16x8 ak[4];
#pragma unroll
            for (int kf = 0; kf < 4; ++kf) ak[kf] = *(const bf16x8*)(Ks + (kf * 16 + lc) * 128 + (((ks * 4 + g) ^ fsw) << 4));
#pragma unroll
            for (int kf = 0; kf < 4; ++kf)
#pragma unroll
                for (int qf = 0; qf < 2; ++qf)
                    sc[kf][qf] = __builtin_amdgcn_mfma_f32_16x16x32_bf16(ak[kf], qfr[qf][ks], sc[kf][qf], 0, 0, 0);
        }
        if (lat && !cache && (t == 0 || t == 4)) {
#pragma unroll
            for (int kf = 0; kf < 4; ++kf)
#pragma unroll
                for (int qf = 0; qf < 2; ++qf)
#pragma unroll
                    for (int r = 0; r < 4; ++r) {
                        const int kpos = kp0 + kf * 16 + g * 4 + r, qpos = q0 + qf * 16 + lc;
                        const int dd = qpos - kpos;
                        if (dd > 128 || dd < -128) sc[kf][qf][r] = -INFINITY;
                    }
        }
        bf16x8 pb[2][2];
#pragma unroll
        for (int qf = 0; qf < 2; ++qf) {
            float mx = -INFINITY;
#pragma unroll
            for (int kf = 0; kf < 4; ++kf)
#pragma unroll
                for (int r = 0; r < 4; ++r) mx = fmaxf(mx, sc[kf][qf][r]);
            mx = fmaxf(mx, __shfl_xor(mx, 16));
            mx = fmaxf(mx, __shfl_xor(mx, 32));
            const float mnew = fmaxf(mrun[qf], mx);
            const float alpha = __expf(mrun[qf] - mnew);
            mrun[qf] = mnew;
            float ps = 0.f;
#pragma unroll
            for (int kf = 0; kf < 4; ++kf)
#pragma unroll
                for (int r = 0; r < 4; ++r) { const float e = __expf(sc[kf][qf][r] - mnew); sc[kf][qf][r] = e; ps += e; }
            lrun[qf] = lrun[qf] * alpha + ps;
#pragma unroll
            for (int df = 0; df < 4; ++df) O[df][qf] *= alpha;
#pragma unroll
            for (int s2 = 0; s2 < 2; ++s2) {
                bf16x8 v;
#pragma unroll
                for (int r = 0; r < 4; ++r) { v[r] = (short)f2bf(sc[2 * s2][qf][r]); v[4 + r] = (short)f2bf(sc[2 * s2 + 1][qf][r]); }
                pb[s2][qf] = v;
            }
        }
#pragma unroll
        for (int s2 = 0; s2 < 2; ++s2)
#pragma unroll
            for (int df = 0; df < 4; ++df) {
                const unsigned char* vr = Vt + (df * 16 + lc) * 136 + (32 * s2 + 4 * g) * 2;
                const uint2 lo = *(const uint2*)vr, hi = *(const uint2*)(vr + 32);
                union { uint4 u; bf16x8 v; } av; av.u = make_uint4(lo.x, lo.y, hi.x, hi.y);
#pragma unroll
                for (int qf = 0; qf < 2; ++qf)
                    O[df][qf] = __builtin_amdgcn_mfma_f32_16x16x32_bf16(av.v, pb[s2][qf], O[df][qf], 0, 0, 0);
            }
    }
#pragma unroll
    for (int qf = 0; qf < 2; ++qf) {
        float lt = lrun[qf];
        lt += __shfl_xor(lt, 16); lt += __shfl_xor(lt, 32);
        const float inv = 1.f / lt;
        const size_t m = (size_t)(row0 + q0 + qf * 16 + lc);
#pragma unroll
        for (int df = 0; df < 4; ++df) {
            const int col = hq * 64 + df * 16 + g * 4;
            const uint2 gt = *(const uint2*)(Pb + m * PW + C_AG + col);
            uint2 o;
            o.x = (unsigned)f2bf(O[df][qf][0] * inv * __uint_as_float(gt.x << 16)) | ((unsigned)f2bf(O[df][qf][1] * inv * __uint_as_float(gt.x & 0xffff0000u)) << 16);
            o.y = (unsigned)f2bf(O[df][qf][2] * inv * __uint_as_float(gt.y << 16)) | ((unsigned)f2bf(O[df][qf][3] * inv * __uint_as_float(gt.y & 0xffff0000u)) << 16);
            *(uint2*)(Pb + m * PW + C_AQ + col) = o;
        }
    }
}
DEV void phase_attn(const Params& p, int l, unsigned char* lds) {
    for (int item = blockIdx.x; item < 768; item += gridDim.x) attn_item(p, l, item, lds);
}

constexpr size_t OFF_RS = OFF_W1T;
static_assert(OFF_RS + (size_t)4 * 4 * 2 * 8 * 32768 * 2 <= OFF_LRUC, "RS overlap");
DEV float ret_logg(const Params& p, int l, int dir, int h) { return -softplusf(-p.ret_decay[(l * 2 + dir) * 4 + h]); }

DEV void ret_kv_tile(const Params& p, int l, int item, unsigned char* lds) {
    bf16_t* Pb = ws_bf(p, OFF_P); const bf16_t* RVT = ws_bf(p, OFF_RVT);
    bf16_t* Kt = (bf16_t*)lds;
    const int tid = TIDX(), lane = tid & 63, w = tid >> 6, g = lane >> 4, lc = lane & 15;
    const bool lat = item < 224;
    int b, h, dir, c;
    if (lat) { dir = item & 1; const int rest = item >> 1; const int cc = rest % 7, bh = rest / 7; h = bh & 3; b = bh >> 2; c = dir == 0 ? cc : cc + 1; }
    else { const int it = item - 224; dir = it & 1; h = (it >> 1) & 3; b = it >> 3; c = 0; }
    const int row0 = lat ? NCTX + b * 2048 + c * 256 : b * 256;
    const float lg = ret_logg(p, l, dir, h);
    const int dvbase = w * 32;
    f32x4 acc[2][8];
#pragma unroll
    for (int i = 0; i < 2; ++i)
#pragma unroll
        for (int j = 0; j < 8; ++j) acc[i][j] = (f32x4){0.f, 0.f, 0.f, 0.f};
#pragma unroll 1
    for (int st = 0; st < 4; ++st) {
        {
            const int tok = lane, ti = st * 64 + tok;
            const float wt = __expf(lg * (float)(dir == 0 ? 255 - ti : ti));
#pragma unroll
            for (int i = 0; i < 2; ++i) {
                const int c8 = w + 8 * i;
                const uint4 v = *(const uint4*)(Pb + (size_t)(row0 + ti) * PW + C_RK + h * 128 + c8 * 8);
                bf16_t* dst = Kt + (c8 * 8) * 72 + tok;
                dst[0 * 72] = f2bf(wt * __uint_as_float(v.x << 16)); dst[1 * 72] = f2bf(wt * __uint_as_float(v.x & 0xffff0000u));
                dst[2 * 72] = f2bf(wt * __uint_as_float(v.y << 16)); dst[3 * 72] = f2bf(wt * __uint_as_float(v.y & 0xffff0000u));
                dst[4 * 72] = f2bf(wt * __uint_as_float(v.z << 16)); dst[5 * 72] = f2bf(wt * __uint_as_float(v.z & 0xffff0000u));
                dst[6 * 72] = f2bf(wt * __uint_as_float(v.w << 16)); dst[7 * 72] = f2bf(wt * __uint_as_float(v.w & 0xffff0000u));
            }
        }
        __syncthreads();
#pragma unroll
        for (int ks = 0; ks < 2; ++ks) {
            bf16x8 av[2];
#pragma unroll
            for (int mf = 0; mf < 2; ++mf)
                av[mf] = *(const bf16x8*)(RVT + (size_t)(h * 256 + dvbase + mf * 16 + lc) * M + row0 + st * 64 + ks * 32 + g * 8);
#pragma unroll
            for (int nf = 0; nf < 8; ++nf) {
                const bf16x8 bk = *(const bf16x8*)((const unsigned char*)Kt + (nf * 16 + lc) * 144 + (ks * 32 + g * 8) * 2);
#pragma unroll
                for (int mf = 0; mf < 2; ++mf) acc[mf][nf] = __builtin_amdgcn_mfma_f32_16x16x32_bf16(av[mf], bk, acc[mf][nf], 0, 0, 0);
            }
        }
        __syncthreads();
    }
    if (lat) {
        const int slot = dir == 0 ? c + 1 : c - 1;
        bf16_t* dst = ws_bf(p, OFF_RS) + ((size_t)((b * 4 + h) * 2 + dir) * 8 + slot) * 32768;
#pragma unroll
        for (int mf = 0; mf < 2; ++mf)
#pragma unroll
            for (int nf = 0; nf < 8; ++nf)
#pragma unroll
                for (int r = 0; r < 4; ++r) dst[(size_t)(dvbase + mf * 16 + g * 4 + r) * 128 + nf * 16 + lc] = f2bf(acc[mf][nf][r]);
    } else {
        float* dst = p.out + O_NRET + ((((size_t)b * 2 + l) * 2 + dir) * 4 + h) * 128 * 256;
#pragma unroll
        for (int mf = 0; mf < 2; ++mf)
#pragma unroll
            for (int nf = 0; nf < 8; ++nf)
                *(float4*)(dst + (size_t)(nf * 16 + lc) * 256 + dvbase + mf * 16 + g * 4) = make_float4(acc[mf][nf][0], acc[mf][nf][1], acc[mf][nf][2], acc[mf][nf][3]);
    }
}
DEV void phase_ret_kv(const Params& p, int l, unsigned char* lds) {
    for (int item = blockIdx.x; item < 352; item += gridDim.x) ret_kv_tile(p, l, item, lds);
}

DEV void phase_ret_scan(const Params& p, int l) {
    bf16_t* RS = ws_bf(p, OFF_RS);
    const int gt = blockIdx.x * blockDim.x + TIDX(), gs = gridDim.x * blockDim.x;
    for (int idx = gt; idx < 4 * 4 * 2 * 32768; idx += gs) {
        const int dk = idx & 127, dv = (idx >> 7) & 255, dir = (idx >> 15) & 1, h = (idx >> 16) & 3, b = idx >> 18;
        const float g256 = __expf(ret_logg(p, l, dir, h) * 256.f);
        float st = p.state_ret[(((((size_t)b * 2 + l) * 2 + dir) * 4 + h) * 128 + dk) * 256 + dv];
        bf16_t* base = RS + (size_t)((b * 4 + h) * 2 + dir) * 8 * 32768 + dv * 128 + dk;
        if (dir == 0) {
            base[0] = f2bf(st);
            for (int c = 1; c < 8; ++c) { st = g256 * st + bf2f(base[(size_t)c * 32768]); base[(size_t)c * 32768] = f2bf(st); }
        } else {
            base[(size_t)7 * 32768] = f2bf(st);
            for (int c = 6; c >= 0; --c) { st = g256 * st + bf2f(base[(size_t)c * 32768]); base[(size_t)c * 32768] = f2bf(st); }
        }
    }
}

DEV void ret_out_tile(const Params& p, int l, int item, unsigned char* lds) {
    bf16_t* Pb = ws_bf(p, OFF_P); const bf16_t* RVT = ws_bf(p, OFF_RVT);
    unsigned char* Ks = lds; unsigned char* Vt = lds + 16384; unsigned char* SB = Vt;
    const int tid = TIDX(), lane = tid & 63, w = tid >> 6, g = lane >> 4, lc = lane & 15;
    const bool lat = item < 256;
    int b, h, qb, rowc, qi0, c;
    if (lat) { qb = item & 15; h = (item >> 4) & 3; b = item >> 6; c = qb >> 1; rowc = NCTX + b * 2048 + c * 256; qi0 = (qb & 1) * 128; }
    else { const int it = item - 256; qb = it & 1; h = (it >> 1) & 3; b = it >> 3; c = 0; rowc = b * 256; qi0 = qb * 128; }
    const int qi = qi0 + w * 16 + lc;
    const size_t rowq = (size_t)(rowc + qi);
    const float lgf = ret_logg(p, l, 0, h), lgb = ret_logg(p, l, 1, h);
    bf16x8 qfr[4];
#pragma unroll
    for (int ks = 0; ks < 4; ++ks) qfr[ks] = *(const bf16x8*)(Pb + rowq * PW + C_RQ + h * 128 + ks * 32 + g * 8);
    f32x4 acc[16];
#pragma unroll
    for (int df = 0; df < 16; ++df) acc[df] = (f32x4){0.f, 0.f, 0.f, 0.f};
#pragma unroll 1
    for (int kt = 0; kt < 4; ++kt) {
        __syncthreads();
#pragma unroll
        for (int i = 0; i < 2; ++i) {
            const int id = i * 512 + tid, row = id >> 4, ch = id & 15;
            const uint4 v = *(const uint4*)(Pb + (size_t)(rowc + kt * 64 + row) * PW + C_RK + h * 128 + ch * 8);
            *(uint4*)(Ks + row * 256 + ((ch ^ (row & 15)) << 4)) = v;
        }
#pragma unroll
        for (int i = 0; i < 4; ++i) {
            const int id = i * 512 + tid, dv = id >> 3, ch = id & 7;
            const uint4 v = *(const uint4*)(RVT + (size_t)(h * 256 + dv) * M + rowc + kt * 64 + ch * 8);
            *(uint2*)(Vt + dv * 136 + ch * 16) = make_uint2(v.x, v.y);
            *(uint2*)(Vt + dv * 136 + ch * 16 + 8) = make_uint2(v.z, v.w);
        }
        __syncthreads();
        f32x4 sc[4];
#pragma unroll
        for (int kf = 0; kf < 4; ++kf) sc[kf] = (f32x4){0.f, 0.f, 0.f, 0.f};
#pragma unroll
        for (int ks = 0; ks < 4; ++ks)
#pragma unroll
            for (int kf = 0; kf < 4; ++kf) {
                const bf16x8 ak = *(const bf16x8*)(Ks + (kf * 16 + lc) * 256 + (((ks * 4 + g) ^ lc) << 4));
                sc[kf] = __builtin_amdgcn_mfma_f32_16x16x32_bf16(ak, qfr[ks], sc[kf], 0, 0, 0);
            }
        bf16x8 pb[2];
#pragma unroll
        for (int kf = 0; kf < 4; ++kf)
#pragma unroll
            for (int r = 0; r < 4; ++r) {
                const int dd = qi - (kt * 64 + kf * 16 + g * 4 + r);
                float wgt = 0.f;
                if (dd >= 0) wgt += __expf(lgf * (float)dd);
                if (dd <= 0) wgt += __expf(lgb * (float)(-dd));
                pb[kf >> 1][(kf & 1) * 4 + r] = (short)f2bf(sc[kf][r] * wgt);
            }
#pragma unroll
        for (int s2 = 0; s2 < 2; ++s2)
#pragma unroll
            for (int df = 0; df < 16; ++df) {
                const unsigned char* vr = Vt + (df * 16 + lc) * 136 + (32 * s2 + 4 * g) * 2;
                const uint2 lo = *(const uint2*)vr, hi = *(const uint2*)(vr + 32);
                union { uint4 u; bf16x8 v; } av; av.u = make_uint4(lo.x, lo.y, hi.x, hi.y);
                acc[df] = __builtin_amdgcn_mfma_f32_16x16x32_bf16(av.v, pb[s2], acc[df], 0, 0, 0);
                if ((df & 3) == 3) __builtin_amdgcn_sched_barrier(0);
            }
    }
    if (lat) {
#pragma unroll 1
        for (int dir = 0; dir < 2; ++dir) {
            const float qs = dir == 0 ? __expf(lgf * (float)(qi + 1)) : __expf(lgb * (float)(256 - qi));
            bf16x8 qx[4];
#pragma unroll
            for (int ks = 0; ks < 4; ++ks)
#pragma unroll
                for (int e = 0; e < 8; ++e) qx[ks][e] = (short)f2bf(qs * bf2f((bf16_t)qfr[ks][e]));
            const bf16_t* Sg = ws_bf(p, OFF_RS) + ((size_t)((b * 4 + h) * 2 + dir) * 8 + c) * 32768;
#pragma unroll 1
            for (int kh = 0; kh < 2; ++kh) {
                __syncthreads();
#pragma unroll
                for (int i = 0; i < 4; ++i) {
                    const int id = i * 512 + tid, row = id >> 3, ch = id & 7;
                    const uint4 v = *(const uint4*)(Sg + (size_t)row * 128 + kh * 64 + ch * 8);
                    *(uint4*)(SB + row * 128 + ((ch ^ ((row >> 1) & 7)) << 4)) = v;
                }
                __syncthreads();
#pragma unroll
                for (int k2 = 0; k2 < 2; ++k2)
#pragma unroll
                    for (int df = 0; df < 16; ++df) {
                        const bf16x8 as = *(const bf16x8*)(SB + (df * 16 + lc) * 128 + (((k2 * 4 + g) ^ ((lc >> 1) & 7)) << 4));
                        acc[df] = __builtin_amdgcn_mfma_f32_16x16x32_bf16(as, kh == 0 ? qx[k2] : qx[2 + k2], acc[df], 0, 0, 0);
                        if ((df & 3) == 3) __builtin_amdgcn_sched_barrier(0);
                    }
            }
        }
    }
    float s1 = 0.f;
#pragma unroll
    for (int df = 0; df < 16; ++df) s1 += (acc[df][0] + acc[df][1]) + (acc[df][2] + acc[df][3]);
    s1 += __shfl_xor(s1, 16); s1 += __shfl_xor(s1, 32);
    const float mu = s1 * (1.f / 256.f);
    float s2 = 0.f;
#pragma unroll
    for (int df = 0; df < 16; ++df)
#pragma unroll
        for (int r = 0; r < 4; ++r) { const float xc = acc[df][r] - mu; s2 += xc * xc; }
    s2 += __shfl_xor(s2, 16); s2 += __shfl_xor(s2, 32);
    const float rstd = rsqrtf(s2 * (1.f / 256.f) + EPS);
#pragma unroll
    for (int df = 0; df < 16; ++df) {
        bf16_t* gp = Pb + rowq * PW + C_RG + h * 256 + df * 16 + g * 4;
        const uint2 gv = *(const uint2*)gp;
        uint2 o;
        o.x = (unsigned)f2bf((acc[df][0] - mu) * rstd * __uint_as_float(gv.x << 16)) | ((unsigned)f2bf((acc[df][1] - mu) * rstd * __uint_as_float(gv.x & 0xffff0000u)) << 16);
        o.y = (unsigned)f2bf((acc[df][2] - mu) * rstd * __uint_as_float(gv.y << 16)) | ((unsigned)f2bf((acc[df][3] - mu) * rstd * __uint_as_float(gv.y & 0xffff0000u)) << 16);
        *(uint2*)gp = o;
    }
}
DEV void phase_ret_out(const Params& p, int l, unsigned char* lds) {
    for (int item = blockIdx.x; item < 384; item += gridDim.x) ret_out_tile(p, l, item, lds);
}

template <bool REV>
DEV void lru_scan16(const float (&a)[4][4], const float (&u)[4][4], float cin, int g, int lc, float (&h)[4][4], float& cout, float& Aprod) {
    float carry = cin, Ap = 1.f;
#pragma unroll
    for (int ii = 0; ii < 4; ++ii) {
        const int i = REV ? 3 - ii : ii;
        float hl[4], cp[4];
        {
            float hh = 0.f, cc = 1.f;
#pragma unroll
            for (int rr = 0; rr < 4; ++rr) { const int r = REV ? 3 - rr : rr; hh = a[i][r] * hh + u[i][r]; cc *= a[i][r]; hl[r] = hh; cp[r] = cc; }
        }
        const float As = REV ? cp[0] : cp[3], Hs = REV ? hl[0] : hl[3];
        float Ag[4], Hg[4];
#pragma unroll
        for (int gg = 0; gg < 4; ++gg) { Ag[gg] = __shfl(As, lc + 16 * gg); Hg[gg] = __shfl(Hs, lc + 16 * gg); }
        float cur = carry, mine = carry;
#pragma unroll
        for (int sI = 0; sI < 4; ++sI) {
            const int gg = REV ? 3 - sI : sI;
            mine = (g == gg) ? cur : mine;
            cur = Ag[gg] * cur + Hg[gg];
            Ap *= Ag[gg];
        }
        carry = cur;
#pragma unroll
        for (int r = 0; r < 4; ++r) h[i][r] = hl[r] + cp[r] * mine;
    }
    cout = carry; Aprod = Ap;
}

DEV void lru_tile(const Params& p, int l, int gc, int blk, int mode, unsigned char* lds) {
    unsigned char* xa = lds; float* hs = (float*)(lds + 16384);
    bf16_t* Pb = ws_bf(p, OFF_P);
    const int tid = TIDX(), lane = tid & 63, w = tid >> 6, g = lane >> 4, lc = lane & 15;
    const int dir = w >> 2, chq = w & 3;
    const int m0 = gc * 64;
    const bool lat = m0 >= NCTX;
    const int L = lat ? 2048 : 256;
    const int t0 = lat ? ((m0 - NCTX) & 2047) : (m0 & 255);
    {
        const int chunk = tid & 15, chb = blk * 128 + chunk * 8;
        float cw[4][8], cb[8];
#pragma unroll
        for (int j = 0; j < 4; ++j) {
            const float4 a0 = *(const float4*)(p.conv_w + (size_t)(l * 4 + j) * D + chb), a1 = *(const float4*)(p.conv_w + (size_t)(l * 4 + j) * D + chb + 4);
            cw[j][0] = a0.x; cw[j][1] = a0.y; cw[j][2] = a0.z; cw[j][3] = a0.w; cw[j][4] = a1.x; cw[j][5] = a1.y; cw[j][6] = a1.z; cw[j][7] = a1.w;
        }
        {
            const float4 a0 = *(const float4*)(p.conv_b + (size_t)l * D + chb), a1 = *(const float4*)(p.conv_b + (size_t)l * D + chb + 4);
            cb[0] = a0.x; cb[1] = a0.y; cb[2] = a0.z; cb[3] = a0.w; cb[4] = a1.x; cb[5] = a1.y; cb[6] = a1.z; cb[7] = a1.w;
        }
#pragma unroll
        for (int i = 0; i < 2; ++i) {
            const int tt = (tid >> 4) + 32 * i;
            float acc[8];
#pragma unroll
            for (int e = 0; e < 8; ++e) acc[e] = cb[e];
#pragma unroll
            for (int j = 0; j < 4; ++j) {
                const int tp = t0 + tt + j - 1;
                if (tp >= 0 && tp < L) {
                    const uint4 v = *(const uint4*)(Pb + (size_t)(m0 + tt + j - 1) * PW + C_LX + chb);
                    acc[0] += cw[j][0] * __uint_as_float(v.x << 16); acc[1] += cw[j][1] * __uint_as_float(v.x & 0xffff0000u);
                    acc[2] += cw[j][2] * __uint_as_float(v.y << 16); acc[3] += cw[j][3] * __uint_as_float(v.y & 0xffff0000u);
                    acc[4] += cw[j][4] * __uint_as_float(v.z << 16); acc[5] += cw[j][5] * __uint_as_float(v.z & 0xffff0000u);
                    acc[6] += cw[j][6] * __uint_as_float(v.w << 16); acc[7] += cw[j][7] * __uint_as_float(v.w & 0xffff0000u);
                }
            }
            uint4 o;
            o.x = (unsigned)f2bf(acc[0]) | ((unsigned)f2bf(acc[1]) << 16); o.y = (unsigned)f2bf(acc[2]) | ((unsigned)f2bf(acc[3]) << 16);
            o.z = (unsigned)f2bf(acc[4]) | ((unsigned)f2bf(acc[5]) << 16); o.w = (unsigned)f2bf(acc[6]) | ((unsigned)f2bf(acc[7]) << 16);
            *(uint4*)(xa + tt * 256 + ((chunk ^ (tt & 15)) << 4)) = o;
        }
        if (mode) for (int e = tid; e < 64 * 128; e += 512) hs[e] = 0.f;
    }
    __syncthreads();
    float* LA = (float*)(p.ws + OFF_LRUC);
    float* LH = LA + 192 * 2 * 1024;
    const bf16_t* Wa = ws_bf(p, OFF_LRUW) + (size_t)((dir * 2 + 0) * 8 + blk) * 128 * 128;
    const bf16_t* Wx = ws_bf(p, OFF_LRUW) + (size_t)((dir * 2 + 1) * 8 + blk) * 128 * 128;
#pragma unroll 1
    for (int nq = 0; nq < 2; ++nq) {
        f32x4 accA[4], accX[4];
#pragma unroll
        for (int i = 0; i < 4; ++i) { accA[i] = (f32x4){0.f, 0.f, 0.f, 0.f}; accX[i] = (f32x4){0.f, 0.f, 0.f, 0.f}; }
        const int cl = chq * 32 + nq * 16 + lc;
#pragma unroll
        for (int ks = 0; ks < 4; ++ks) {
            const bf16x8 bA = *(const bf16x8*)(Wa + (size_t)cl * 128 + ks * 32 + g * 8);
            const bf16x8 bX = *(const bf16x8*)(Wx + (size_t)cl * 128 + ks * 32 + g * 8);
#pragma unroll
            for (int i = 0; i < 4; ++i) {
                const bf16x8 af = *(const bf16x8*)(xa + (i * 16 + lc) * 256 + (((ks * 4 + g) ^ lc) << 4));
                accA[i] = __builtin_amdgcn_mfma_f32_16x16x32_bf16(af, bA, accA[i], 0, 0, 0);
                accX[i] = __builtin_amdgcn_mfma_f32_16x16x32_bf16(af, bX, accX[i], 0, 0, 0);
            }
        }
        {
            const int ch = blk * 128 + cl;
            const float ba = p.lru_ba[(l * 2 + dir) * D + ch], bx = p.lru_bx[(l * 2 + dir) * D + ch];
            const float sp = softplusf(-p.lru_lambda[(l * 2 + dir) * D + ch]);
            const size_t ci = ((size_t)gc * 2 + dir) * 1024 + ch;
            const float cin = mode ? LH[ci] : 0.f;
            float a[4][4], u[4][4], h[4][4];
#pragma unroll
            for (int i = 0; i < 4; ++i)
#pragma unroll
                for (int r = 0; r < 4; ++r) {
                    const int tok = i * 16 + g * 4 + r;
                    const float x = bf2f(*(const bf16_t*)(xa + tok * 256 + (((cl >> 3) ^ (tok & 15)) << 4) + (cl & 7) * 2));
                    const float rg = sigmf(accA[i][r] + ba), ig = sigmf(accX[i][r] + bx);
                    const float la = -8.f * rg * sp;
                    a[i][r] = __expf(la);
                    u[i][r] = sqrtf(-expm1f(2.f * la)) * (ig * x);
                }
            float cout, Ap;
            if (dir == 0) lru_scan16<false>(a, u, cin, g, lc, h, cout, Ap);
            else          lru_scan16<true>(a, u, cin, g, lc, h, cout, Ap);
            if (!mode) { if (g == 0) { LA[ci] = Ap; LH[ci] = cout; } }
            else {
#pragma unroll
                for (int i = 0; i < 4; ++i)
#pragma unroll
                    for (int r = 0; r < 4; ++r) atomicAdd(&hs[(i * 16 + g * 4 + r) * 128 + cl], h[i][r]);
                if (!lat && g == 0) {
                    const int b = m0 >> 8;
                    if (dir == 0 && t0 == 192) p.out[O_NLRU + ((size_t)(b * 2 + l) * 2 + 0) * 1024 + ch] = cout;
                    if (dir == 1 && t0 == 0)   p.out[O_NLRU + ((size_t)(b * 2 + l) * 2 + 1) * 1024 + ch] = cout;
                }
            }
        }
    }
    __syncthreads();
    if (mode) {
#pragma unroll
        for (int i = 0; i < 2; ++i) {
            const int tt = (tid >> 4) + 32 * i, c8 = (tid & 15) * 8;
            bf16_t* gp = Pb + (size_t)(m0 + tt) * PW + C_LG + blk * 128 + c8;
            const uint4 gv = *(const uint4*)gp;
            const float4 h0 = *(const float4*)(hs + tt * 128 + c8), h1 = *(const float4*)(hs + tt * 128 + c8 + 4);
            uint4 o;
            o.x = (unsigned)f2bf(h0.x * __uint_as_float(gv.x << 16)) | ((unsigned)f2bf(h0.y * __uint_as_float(gv.x & 0xffff0000u)) << 16);
            o.y = (unsigned)f2bf(h0.z * __uint_as_float(gv.y << 16)) | ((unsigned)f2bf(h0.w * __uint_as_float(gv.y & 0xffff0000u)) << 16);
            o.z = (unsigned)f2bf(h1.x * __uint_as_float(gv.z << 16)) | ((unsigned)f2bf(h1.y * __uint_as_float(gv.z & 0xffff0000u)) << 16);
            o.w = (unsigned)f2bf(h1.z * __uint_as_float(gv.w << 16)) | ((unsigned)f2bf(h1.w * __uint_as_float(gv.w & 0xffff0000u)) << 16);
            *(uint4*)gp = o;
        }
    }
    __syncthreads();
}
DEV void phase_lru_tiles(const Params& p, int l, int mode, unsigned char* lds) {
    for (int it = blockIdx.x; it < 192 * 8; it += gridDim.x) lru_tile(p, l, it >> 3, it & 7, mode, lds);
}

DEV void phase_lru_carry(const Params& p, int l) {
    float* LA = (float*)(p.ws + OFF_LRUC);
    float* LH = LA + 192 * 2 * 1024;
    const int gt = blockIdx.x * blockDim.x + TIDX(), gs = gridDim.x * blockDim.x;
    for (int idx = gt; idx < 20 * 2 * 1024; idx += gs) {
        const int ch = idx & 1023, dir = (idx >> 10) & 1, seq = idx >> 11;
        const bool lat = seq >= 16;
        const int nch = lat ? 32 : 4;
        const int gc0 = lat ? 64 + (seq - 16) * 32 : seq * 4;
        float carry = lat ? p.state_lru[((size_t)((seq - 16) * 2 + l) * 2 + dir) * 1024 + ch] : 0.f;
        for (int s = 0; s < nch; ++s) {
            const int cidx = dir == 0 ? s : nch - 1 - s;
            const size_t ci = ((size_t)(gc0 + cidx) * 2 + dir) * 1024 + ch;
            const float A = LA[ci], Hh = LH[ci];
            LH[ci] = carry;
            carry = A * carry + Hh;
        }
    }
}

DEV void phase_post(const Params& p, int l, float* red) {
    const int tid = TIDX() & 255, half = TIDX() >> 8;
    for (int m = blockIdx.x * 2 + half; m < M; m += gridDim.x * 2) {
        const float4 o = ((const float4*)(ws_bf(p, OFF_P) + (size_t)m * PW + 1024))[tid];
        const float ss = half_sum(o.x * o.x + o.y * o.y + o.z * o.z + o.w * o.w, red);
        const float rstd = rsqrtf(ss * (1.f / D) + EPS);
        const float4 x = ((const float4*)x_row(p, l, m))[tid];
        const float4 g = ((const float4*)(p.norm_post + l * D))[tid];
        const float4 gate = ((const float4*)(ws_mod(p) + (size_t)(l * 5 + cond_row(m)) * 3072 + 2048))[tid];
        float4 y;
        y.x = x.x + gate.x * (o.x * rstd * g.x);
        y.y = x.y + gate.y * (o.y * rstd * g.y);
        y.z = x.z + gate.z * (o.z * rstd * g.z);
        y.w = x.w + gate.w * (o.w * rstd * g.w);
        ((float4*)(p.out + (size_t)m * D))[tid] = y;
        if (l == 0) prenorm_row(p, 1, m, y, red);
    }
}

enum { PH_INIT = 0, PH_PRENORM, PH_GEMM1, PH_MIX1, PH_MIX2, PH_MIX3, PH_MERGE, PH_OUT, PH_POST, PH_COUNT };

DEV void run_phase(const Params& p, int ph, int l, unsigned char* lds) {
    switch (ph) {
    case PH_INIT:    phase_mod(p, (float*)lds); phase_rope_table(p); __syncthreads(); phase_convert(p, 0, (float*)lds); break;
    case PH_PRENORM: phase_prenorm(p, l, (float*)lds); break;
    case PH_GEMM1:   phase8_gemm1(p, l, (LAS unsigned char*)lds); break;
    case PH_MIX1:    phase_attn(p, l, lds); __syncthreads(); phase_lru_tiles(p, l, 0, lds); __syncthreads(); phase_ret_kv(p, l, lds); break;
    case PH_MIX2:    phase_lru_carry(p, l); phase_ret_scan(p, l); break;
    case PH_MIX3:    phase_lru_tiles(p, l, 1, lds); __syncthreads(); phase_ret_out(p, l, lds); break;
    case PH_MERGE:   phase8_merge(p, l, (LAS unsigned char*)lds); break;
    case PH_OUT:     phase8_out(p, l, (LAS unsigned char*)lds); break;
    case PH_POST:    phase_post(p, l, (float*)lds); __syncthreads(); if (l == 0) phase_convert(p, 1, (float*)lds); break;
    }
}

#if !ONE_LAUNCH
__global__ void __launch_bounds__(512, 2) phase_kernel(Params p, int ph, int l) {
    extern __shared__ __attribute__((aligned(16))) unsigned char dsm[];
    run_phase(p, ph, l, dsm);
}
#else
__global__ void __launch_bounds__(512, 2) mega_kernel(Params p) {
    extern __shared__ __attribute__((aligned(16))) unsigned char dsm[];
    cg::grid_group grid = cg::this_grid();
    run_phase(p, PH_INIT, 0, dsm); grid.sync();
    run_phase(p, PH_PRENORM, 0, dsm); grid.sync();
    for (int l = 0; l < 2; ++l) {
        for (int ph = PH_GEMM1; ph <= PH_POST; ++ph) {
            run_phase(p, ph, l, dsm);
            if (!(l == 1 && ph == PH_POST)) grid.sync();
        }
    }
}
#endif

extern "C" void kernel_launch(void* const* d_in, const int* in_sizes, int n_in,
                              void* d_out, int out_size, void* d_ws, size_t ws_size,
                              hipStream_t stream) {
    constexpr size_t kDynLds = g8::STAGE_BYTES;
    static int grid_blocks = 0;
    if (grid_blocks == 0) {
        if (n_in != 26 || ws_size < WS_NEED || out_size != 25231360) {
            fprintf(stderr, "kernel_launch: unexpected n_in %d / ws_size %zu (need %zu) / out_size %d\n", n_in, ws_size, (size_t)WS_NEED, out_size);
            grid_blocks = -1; return;
        }
        int dev = 0, cus = 0, per_cu = 0;
        (void)hipGetDevice(&dev);
        (void)hipDeviceGetAttribute(&cus, hipDeviceAttributeMultiprocessorCount, dev);
#if ONE_LAUNCH
        const void* kfn = (const void*)mega_kernel;
#else
        const void* kfn = (const void*)phase_kernel;
#endif
        if (hipFuncSetAttribute(kfn, hipFuncAttributeMaxDynamicSharedMemorySize, (int)kDynLds) != hipSuccess) {
            fprintf(stderr, "kernel_launch: hipFuncSetAttribute failed\n"); grid_blocks = -1; return;
        }
        if (hipOccupancyMaxActiveBlocksPerMultiprocessor(&per_cu, kfn, 512, kDynLds) != hipSuccess || per_cu < 1) {
            fprintf(stderr, "kernel_launch: occupancy query says %d blocks per CU\n", per_cu); grid_blocks = -1; return;
        }
        grid_blocks = cus;
    }
    if (grid_blocks < 0) return;
    Params p{};
    const float** pp = (const float**)&p;
    for (int i = 0; i < 26; ++i) pp[i] = (const float*)d_in[i];
    p.out = (float*)d_out;
    p.ws = (unsigned char*)d_ws;
#if ONE_LAUNCH
    void* args[] = {&p};
    hipError_t e = hipLaunchCooperativeKernel((const void*)mega_kernel, dim3(grid_blocks), dim3(512), args, kDynLds, stream);
    if (e != hipSuccess) fprintf(stderr, "cooperative launch failed: %s (grid %d)\n", hipGetErrorString(e), grid_blocks);
#else
    phase_kernel<<<grid_blocks, 512, kDynLds, stream>>>(p, PH_INIT, 0);
    phase_kernel<<<grid_blocks, 512, kDynLds, stream>>>(p, PH_PRENORM, 0);
    for (int l = 0; l < 2; ++l)
        for (int ph = PH_GEMM1; ph <= PH_POST; ++ph)
            phase_kernel<<<grid_blocks, 512, kDynLds, stream>>>(p, ph, l);
#endif
}
```

```cpp
#include <hip/hip_runtime.h>
#include <hip/hip_cooperative_groups.h>
#include <cstdio>
#include <cstdint>
namespace cg = cooperative_groups;

#ifndef ONE_LAUNCH
#define ONE_LAUNCH 1
#endif

typedef unsigned short bf16_t;
#define DEV __device__ __forceinline__

constexpr int D = 1024;
constexpr int NCTX = 4096;
constexpr int NLAT = 8192;
constexpr int M = NCTX + NLAT;
constexpr int NW = 7680;
constexpr int N_RQ = 0, N_RK = 512, N_RV = 1024, N_RG = 2048, N_LX = 3072, N_LG = 4096,
              N_AQ = 5120, N_AK = 6144, N_AV = 6400, N_AG = 6656;
constexpr int PW = 6656;
constexpr int C_RQ = 0, C_RK = 512, C_RG = 1024, C_LX = 2048, C_LG = 3072,
              C_AQ = 4096, C_AK = 5120, C_AV = 5376, C_AG = 5632;
constexpr float EPS = 1e-6f;

constexpr size_t O_YP = 0, O_YS = 4194304, O_NK = 12582912, O_NV = 14680064, O_NRET = 16777216, O_NLRU = 25165824;

constexpr size_t OFF_MOD  = 0;
constexpr size_t OFF_LRUW = 122880;
constexpr size_t OFF_WBR  = OFF_LRUW + 1048576;
constexpr size_t OFF_WOUT = OFF_WBR + 6291456;
constexpr size_t OFF_WMG  = OFF_WOUT + 2097152;
constexpr size_t OFF_H    = OFF_WMG + 6291456;
constexpr size_t OFF_P    = OFF_H + (size_t)M * 1024 * 2;
constexpr size_t OFF_RVT  = OFF_P + (size_t)M * PW * 2;
constexpr size_t OFF_W1T  = OFF_RVT + (size_t)1024 * M * 2;
constexpr size_t OFF_OFTMP = OFF_W1T;
constexpr size_t OFF_LRUC = 262266880;
constexpr size_t OFF_ROPE = OFF_LRUC + (size_t)2 * 192 * 2 * 1024 * 4;
constexpr size_t OFF_BAR  = OFF_ROPE + (size_t)2048 * 96 * 8;
constexpr size_t OFF_XC   = OFF_BAR + 16384;
constexpr size_t OFF_XP   = OFF_XC + 1024;
constexpr size_t WS_NEED  = OFF_XP + 983040;
constexpr int LDS_XOFF = 131072 + 64;
static_assert(OFF_OFTMP + (size_t)M * 1024 * 2 <= OFF_LRUC, "overlap");
static_assert(WS_NEED <= 268435456, "ws budget");

struct Params;
typedef const __attribute__((address_space(4))) Params CParams;
struct Params {
    const float *x_prompt, *x_sample, *cache_k, *cache_v, *state_ret, *state_lru, *c, *c_ctx,
                *w_ada, *b_ada, *norm_pre, *norm_post, *w_in, *ret_decay, *conv_w, *conv_b,
                *lru_wa, *lru_ba, *lru_wx, *lru_bx, *lru_lambda, *att_sink, *w_branch, *w_merge, *b_merge, *w_out;
    float* out;
    unsigned char* ws;
};

DEV int BIDX() { int b = (int)blockIdx.x; asm volatile("" : "+s"(b)); return b; }
DEV int GDIM() { int g = (int)gridDim.x; asm volatile("" : "+s"(g)); return g; }
DEV int TIDX() { int t = threadIdx.x; asm volatile("" : "+v"(t)); return t; }
DEV float bf2f(bf16_t v) { return __uint_as_float(((unsigned)v) << 16); }
typedef __bf16 bf16x2_t __attribute__((ext_vector_type(2)));
DEV bf16_t f2bf(float f) { return __builtin_bit_cast(unsigned short, (__bf16)f); }
DEV unsigned pk2(float lo, float hi) { bf16x2_t v; v[0] = (__bf16)lo; v[1] = (__bf16)hi; return __builtin_bit_cast(unsigned, v); }
DEV float sigmf(float z) { return __builtin_amdgcn_rcpf(1.f + __builtin_amdgcn_exp2f(-1.4426950408889634f * z)); }
DEV float siluf(float x) { return x * sigmf(x); }
DEV float softplusf(float x) { return fmaxf(x, 0.f) + log1pf(__expf(-fabsf(x))); }

DEV float* ws_mod(CParams& p) { return (float*)(p.ws + OFF_MOD); }
DEV bf16_t* ws_bf(CParams& p, size_t off) { return (bf16_t*)(p.ws + off); }

DEV const float* x_row(CParams& p, int l, int m) {
    const float* xp = p.x_prompt; const float* xs = p.x_sample; const float* po = p.out;
    if (l == 0) return m < NCTX ? xp + (size_t)m * D : xs + (size_t)(m - NCTX) * D;
    return po + (size_t)m * D;
}
DEV int cond_row(int m) { return m < NCTX ? 0 : 1 + ((m - NCTX) >> 11); }

DEV float wave_sum(float v) {
#pragma unroll
    for (int o = 1; o < 64; o <<= 1) v += __shfl_xor(v, o);
    return v;
}
DEV float xrow16_max(float x) {
    auto s = __builtin_amdgcn_permlane16_swap(__float_as_uint(x), __float_as_uint(x), false, false);
    x = fmaxf(__uint_as_float(s[0]), __uint_as_float(s[1]));
    auto t = __builtin_amdgcn_permlane32_swap(__float_as_uint(x), __float_as_uint(x), false, false);
    return fmaxf(__uint_as_float(t[0]), __uint_as_float(t[1]));
}
DEV float xrow16_sum(float x) {
    auto s = __builtin_amdgcn_permlane16_swap(__float_as_uint(x), __float_as_uint(x), false, false);
    x = __uint_as_float(s[0]) + __uint_as_float(s[1]);
    auto t = __builtin_amdgcn_permlane32_swap(__float_as_uint(x), __float_as_uint(x), false, false);
    return __uint_as_float(t[0]) + __uint_as_float(t[1]);
}
DEV void xrow16_gather(float x, float (&v)[4]) {
    auto s = __builtin_amdgcn_permlane16_swap(__float_as_uint(x), __float_as_uint(x), false, false);
    auto e = __builtin_amdgcn_permlane32_swap(s[0], s[0], false, false);
    auto o = __builtin_amdgcn_permlane32_swap(s[1], s[1], false, false);
    v[0] = __uint_as_float(e[0]); v[1] = __uint_as_float(o[0]); v[2] = __uint_as_float(e[1]); v[3] = __uint_as_float(o[1]);
}
DEV void phase_mod(CParams& p, float* lds) {
    float* mod = ws_mod(p);
    float* sl = lds;
    float* part = lds + 1024;
    unsigned* lastf = (unsigned*)(lds + 1024 + 8 * 5 * 256);
    const int tid = TIDX(), lane = tid & 63, w = tid >> 6;
    const float* cctx = p.c_ctx; const float* cb_ = p.c;
    unsigned* MPu = (unsigned*)(p.ws + OFF_XP);
    unsigned* cnt = (unsigned*)(p.ws + OFF_XC) + 192;
    for (int unit = BIDX(); unit < 192; unit += GDIM()) {
        const int ks = unit & 7, cbk = (unit >> 3) % 12, l = unit / 96;
        __syncthreads();
        for (int e = tid; e < 5 * 128; e += 512) { const int r = e >> 7, k = ks * 128 + (e & 127); sl[e] = siluf(r == 0 ? cctx[k] : cb_[(r - 1) * D + k]); }
        __syncthreads();
        const float* wp = p.w_ada + ((size_t)l * D + ks * 128 + w * 16) * 3072 + cbk * 256 + lane * 4;
        float4 acc[5];
#pragma unroll
        for (int r = 0; r < 5; ++r) acc[r] = make_float4(0.f, 0.f, 0.f, 0.f);
#pragma unroll
        for (int k = 0; k < 16; ++k) {
            const float4 wv = *(const float4*)(wp + (size_t)k * 3072);
#pragma unroll
            for (int r = 0; r < 5; ++r) { const float sv = sl[r * 128 + w * 16 + k]; acc[r].x += sv * wv.x; acc[r].y += sv * wv.y; acc[r].z += sv * wv.z; acc[r].w += sv * wv.w; }
        }
#pragma unroll
        for (int r = 0; r < 5; ++r) *(float4*)(part + (w * 5 + r) * 256 + lane * 4) = acc[r];
        __syncthreads();
        unsigned* mp = MPu + (size_t)((l * 12 + cbk) * 8 + ks) * 1280;
        for (int e = tid; e < 1280; e += 512) {
            float v = 0.f;
#pragma unroll
            for (int q = 0; q < 8; ++q) v += part[q * 1280 + e];
            __hip_atomic_store(mp + e, __float_as_uint(v), __ATOMIC_RELAXED, __HIP_MEMORY_SCOPE_AGENT);
        }
        asm volatile("s_waitcnt vmcnt(0)" ::: "memory");
        __syncthreads();
        if (tid == 0) {
            const unsigned old = __hip_atomic_fetch_add(cnt + l * 12 + cbk, 1u, __ATOMIC_RELAXED, __HIP_MEMORY_SCOPE_AGENT);
            if (old == 7u) { __builtin_amdgcn_fence(__ATOMIC_ACQUIRE, "agent"); asm volatile("s_waitcnt vmcnt(0)" ::: "memory"); }
            *lastf = old == 7u ? 1u : 0u;
        }
        __syncthreads();
        if (*lastf) {
            const unsigned* m0 = MPu + (size_t)((l * 12 + cbk) * 8) * 1280;
            for (int e = tid; e < 1280; e += 512) {
                const int r = e >> 8, j = cbk * 256 + (e & 255);
                float v = p.b_ada[l * 3072 + j];
#pragma unroll
                for (int q = 0; q < 8; ++q) v += __uint_as_float(__hip_atomic_load(m0 + q * 1280 + e, __ATOMIC_RELAXED, __HIP_MEMORY_SCOPE_AGENT));
                mod[(size_t)(l * 5 + r) * 3072 + j] = v;
            }
        }
    }
    __syncthreads();
}

DEV void phase_rope_table(CParams& p) {
    float2* tab = (float2*)(p.ws + OFF_ROPE);
    const int gt = BIDX() * blockDim.x + TIDX(), gs = GDIM() * blockDim.x;
    for (int idx = gt; idx < 2048 * 96; idx += gs) {
        const int t = idx / 96, e = idx % 96;
        int a, c; float nq;
        if (e < 64) { a = e >> 5; c = e & 31; nq = 32.f; } else { a = (e - 64) >> 4; c = (e - 64) & 15; nq = 16.f; }
        const float pos = (float)(a ? (t & 63) : (t >> 6));
        const float inv = powf(10000.f, -(float)c / nq);
        float sn, cs; sincosf(pos * inv, &sn, &cs);
        tab[idx] = make_float2(cs, sn);
    }
}

DEV int w1t_row(int n) {
    if (n < N_RV) return (n & ~48) | ((n & 16) << 1) | ((n & 32) >> 1);
    if (n < N_RG) return PW + (n - N_RV);
    return n - 1024;
}
DEV void transpose_tile(const float* src, int K, int N, bf16_t* dst, int k0, int n0, float* tile, bool w1map = false) {
    const int tid = TIDX();
#pragma unroll 4
    for (int i = 0; i < 8; ++i) {
        const int r = i * 8 + (tid >> 6), c = tid & 63;
        tile[r * 65 + c] = src[(size_t)(k0 + r) * N + n0 + c];
    }
    __syncthreads();
    {
        const int n = tid >> 3, kc = tid & 7;
        const int dr = w1map ? w1t_row(n0 + n) : n0 + n;
        const float* t = tile + (kc * 8) * 65 + n;
        uint4 o;
        o.x = pk2(t[0], t[65]);       o.y = pk2(t[130], t[195]);
        o.z = pk2(t[260], t[325]);    o.w = pk2(t[390], t[455]);
        *(uint4*)(dst + (size_t)dr * K + k0 + kc * 8) = o;
    }
    __syncthreads();
}
DEV void phase_convert(CParams& p, int l, float* tile, int which = 0, int start = 0) {
    constexpr int T_IN = 16 * 120, T_MG = 16 * 48, T_BR = 3 * 256, T_OUT = 256, T_LRU = 32 * 4;
    constexpr int TOT = T_IN + T_MG + T_BR + T_OUT + T_LRU;
    const int first = which == 2 ? T_IN + T_MG + T_BR : 0, last = which == 2 ? T_IN + T_MG + T_BR + T_OUT : TOT;
    const int rot = ((BIDX() - start) % GDIM() + GDIM()) % GDIM();
    for (int it = first + rot; it < last; it += GDIM()) {
        int r = it;
        if (which == 1 && r >= T_IN + T_MG + T_BR && r < T_IN + T_MG + T_BR + T_OUT) continue;
        if (r < T_IN) { transpose_tile(p.w_in + (size_t)l * D * NW, D, NW, ws_bf(p, OFF_W1T), (r / 120) * 64, (r % 120) * 64, tile, true); continue; }
        r -= T_IN;
        if (r < T_MG) { transpose_tile(p.w_merge + (size_t)l * D * 3072, D, 3072, ws_bf(p, OFF_WMG), (r / 48) * 64, (r % 48) * 64, tile); continue; }
        r -= T_MG;
        if (r < T_BR) { const int nb = r / 256, q = r % 256;
            transpose_tile(p.w_branch + ((size_t)l * 3 + nb) * D * D, D, D, ws_bf(p, OFF_WBR) + (size_t)nb * D * D, (q / 16) * 64, (q % 16) * 64, tile); continue; }
        r -= T_BR;
        if (r < T_OUT) { transpose_tile(p.w_out + (size_t)l * D * D, D, D, ws_bf(p, OFF_WOUT), (r / 16) * 64, (r % 16) * 64, tile); continue; }
        r -= T_OUT;
        {
            const int mat = r / 4, q = r % 4;
            const int dir = mat >> 4, gate = (mat >> 3) & 1, blk = mat & 7;
            const float* wa_ = p.lru_wa; const float* wx_ = p.lru_wx;
            const float* src = (gate ? wx_ : wa_) + (((size_t)l * 2 + dir) * 8 + blk) * 128 * 128;
            transpose_tile(src, 128, 128, ws_bf(p, OFF_LRUW) + (size_t)mat * 128 * 128, (q >> 1) * 64, (q & 1) * 64, tile);
        }
    }
}

DEV void prenorm_row(CParams& p, int l, int m, const float4 (&v)[4], int lane) {
    float ss = 0.f;
#pragma unroll
    for (int j = 0; j < 4; ++j) ss += (v[j].x * v[j].x + v[j].y * v[j].y) + (v[j].z * v[j].z + v[j].w * v[j].w);
    ss = wave_sum(ss);
    const float rstd = rsqrtf(ss * (1.f / D) + EPS);
    const float* mod = ws_mod(p) + (size_t)(l * 5 + cond_row(m)) * 3072;
    bf16_t* h = ws_bf(p, OFF_H) + (size_t)m * D;
#pragma unroll
    for (int j = 0; j < 4; ++j) {
        const int i4 = lane + 64 * j;
        const float4 g = ((const float4*)(p.norm_pre + l * D))[i4];
        const float4 sh = ((const float4*)mod)[i4];
        const float4 sc = ((const float4*)(mod + 1024))[i4];
        ushort4 o;
        o.x = f2bf(v[j].x * rstd * g.x * (1.f + sc.x) + sh.x);
        o.y = f2bf(v[j].y * rstd * g.y * (1.f + sc.y) + sh.y);
        o.z = f2bf(v[j].z * rstd * g.z * (1.f + sc.z) + sh.z);
        o.w = f2bf(v[j].w * rstd * g.w * (1.f + sc.w) + sh.w);
        ((ushort4*)h)[i4] = o;
    }
}
DEV void phase_prenorm(CParams& p, int l) {
    const int tid = TIDX(), lane = tid & 63;
    for (int m = BIDX() * 8 + (tid >> 6); m < M; m += GDIM() * 8) {
        const float4* xr = (const float4*)x_row(p, l, m);
        float4 v[4];
#pragma unroll
        for (int j = 0; j < 4; ++j) v[j] = xr[lane + 64 * j];
        prenorm_row(p, l, m, v, lane);
    }
}

typedef short bf16x8 __attribute__((ext_vector_type(8)));
typedef float f32x4 __attribute__((ext_vector_type(4)));
typedef short v4i16_t __attribute__((ext_vector_type(4)));
#define LAS __attribute__((address_space(3)))
namespace g8 {
constexpr int BK = 64, HALF = 128, HTB = HALF * BK * 2, STAGE_BYTES = 8 * HTB;
DEV int lds_byte(int r, int c) { const int st = (r >> 4) * 2 + (c >> 5), rr = r & 15, cc = c & 31, ob = rr * 64 + cc * 2; return st * 1024 + (ob ^ (((ob >> 9) & 1) << 5)); }
DEV void stage_rc(int b, int& R, int& C) { const int st = b / 1024, sb = b % 1024, swz = sb ^ (((sb >> 9) & 1) << 5); R = (st >> 1) * 16 + swz / 64; C = (st & 1) * 32 + (swz % 64) / 2; }
struct Unit { const char* a; const char* b; int kind, pm, pn; unsigned lda; };

template <class Sched, class Epi>
DEV void gemm_phase(LAS unsigned char* lds, const unsigned ldb, const int nt, const Sched& S, const Epi& E) {
    const int tid = TIDX(), wid = __builtin_amdgcn_readfirstlane(tid >> 6), lane = tid & 63, wr = wid >> 2, wc = wid & 3, fr = lane & 15, fq = lane >> 4;
    unsigned rowA[2], colA[2], voffB[2];
#pragma unroll
    for (int i = 0; i < 2; ++i) { int R, C; stage_rc(tid * 16 + i * 8192, R, C); rowA[i] = (unsigned)R; colA[i] = (unsigned)C * 2u; voffB[i] = (unsigned)R * ldb + (unsigned)C * 2u; }
    const size_t kstep = (size_t)(BK * 2);
    const size_t hstepB = (size_t)HALF * ldb;
    const unsigned ldsw = (unsigned)wid * 1024u;
    const int aoff = lds_byte(wr * 64 + fr, fq * 8), boff = lds_byte(wc * 32 + fr, fq * 8);
#define G8_SA(b, h) (((b) * 2 + (h)) * HTB)
#define G8_SB(b, h) ((4 + (b) * 2 + (h)) * HTB)
#define G8_STAGE(bufoff, gbase, voff) do { _Pragma("unroll") for (int _i = 0; _i < 2; ++_i) \
        __builtin_amdgcn_global_load_lds((const unsigned*)((const char*)(gbase) + (voff)[_i]), (LAS unsigned*)(lds + (bufoff) + ldsw + _i * 8192), 16, 0, 0); } while (0)
#define G8_STAGEA(bufoff, gbase, ld) do { _Pragma("unroll") for (int _i = 0; _i < 2; ++_i) \
        __builtin_amdgcn_global_load_lds((const unsigned*)((const char*)(gbase) + (rowA[_i] * (ld) + colA[_i])), (LAS unsigned*)(lds + (bufoff) + ldsw + _i * 8192), 16, 0, 0); } while (0)
#define G8_LDA(dst, b, h) do { _Pragma("unroll") for (int m = 0; m < 4; ++m) _Pragma("unroll") for (int k = 0; k < 2; ++k) dst[m][k] = *(const LAS bf16x8*)(lds + G8_SA(b, h) + aoff + m * 2048 + k * 1024); } while (0)
#define G8_LDB(dst, b, h) do { _Pragma("unroll") for (int n = 0; n < 2; ++n) _Pragma("unroll") for (int k = 0; k < 2; ++k) dst[n][k] = *(const LAS bf16x8*)(lds + G8_SB(b, h) + boff + n * 2048 + k * 1024); } while (0)
#define G8_MMA(ai, bj, At, Bt) do { __builtin_amdgcn_s_setprio(1); _Pragma("unroll") for (int m = 0; m < 4; ++m) _Pragma("unroll") for (int n = 0; n < 2; ++n) _Pragma("unroll") for (int k = 0; k < 2; ++k) \
        acc[ai][bj][m][n] = __builtin_amdgcn_mfma_f32_16x16x32_bf16(Bt[n][k], At[m][k], acc[ai][bj][m][n], 0, 0, 0); __builtin_amdgcn_s_setprio(0); } while (0)
#define G8_WAIT_V(n) asm volatile("s_waitcnt vmcnt(" #n ")" ::: "memory")
#define G8_WAIT_L(n) asm volatile("s_waitcnt lgkmcnt(" #n ")" ::: "memory")
#define G8_BAR __builtin_amdgcn_s_barrier()
#define G8_SCHED __builtin_amdgcn_sched_barrier(0)
    Unit cur, nxt; int ui = 0;
    if (!S.next(0, cur)) return;
    f32x4 acc[2][2][4][2];
#pragma unroll
    for (int a = 0; a < 2; ++a)
#pragma unroll
        for (int b = 0; b < 2; ++b)
#pragma unroll
            for (int m = 0; m < 4; ++m)
#pragma unroll
                for (int n = 0; n < 2; ++n) acc[a][b][m][n] = (f32x4){0.f, 0.f, 0.f, 0.f};
    bf16x8 At[4][2], B0[2][2], B1[2][2];
    const char* cA = cur.a; const char* cB = cur.b;
    unsigned ldc = cur.lda;
    G8_STAGE(G8_SB(0, 0), cB, voffB); G8_STAGE(G8_SB(0, 1), cB + hstepB, voffB); G8_STAGEA(G8_SA(0, 0), cA, ldc); G8_STAGEA(G8_SA(0, 1), cA + (size_t)HALF * ldc, ldc);
    if (wr == 1) G8_BAR;
    G8_WAIT_V(2); G8_BAR;
    G8_STAGE(G8_SB(1, 0), cB + kstep, voffB); G8_STAGEA(G8_SA(1, 0), cA + kstep, ldc); G8_STAGE(G8_SB(1, 1), cB + hstepB + kstep, voffB);
    G8_WAIT_V(6); G8_BAR;
    for (;;) {
        const bool has_next = S.next(ui + 1, nxt);
        const char* nA = has_next ? nxt.a : cA; const char* nB = has_next ? nxt.b : cB;
        const unsigned ldn = has_next ? nxt.lda : ldc;
        for (int t = 0; t < nt; t += 2) {
            const bool last = (t == nt - 2);
            const char* a1 = cA + (size_t)(t + 1) * kstep;
            const char* a2 = last ? nA : cA + (size_t)(t + 2) * kstep; const char* b2 = last ? nB : cB + (size_t)(t + 2) * kstep;
            const char* a3 = a2 + kstep; const char* b3 = b2 + kstep;
            const unsigned ld2 = last ? ldn : ldc;
            const size_t h1 = (size_t)HALF * ldc, h2 = (size_t)HALF * ld2;
            G8_LDB(B0, 0, 0); G8_LDB(B1, 0, 1); G8_SCHED; G8_LDA(At, 0, 0); G8_STAGEA(G8_SA(1, 1), a1 + h1, ldc);
            G8_WAIT_V(8); G8_WAIT_L(0); G8_BAR; G8_MMA(0, 0, At, B0); G8_MMA(0, 1, At, B1); G8_BAR; G8_SCHED;
            G8_LDA(At, 0, 1); G8_STAGE(G8_SB(0, 0), b2, voffB); G8_STAGE(G8_SB(0, 1), b2 + hstepB, voffB); G8_STAGEA(G8_SA(0, 0), a2, ld2);
            G8_WAIT_V(8); G8_WAIT_L(0); G8_BAR; G8_MMA(1, 0, At, B0); G8_MMA(1, 1, At, B1); G8_BAR; G8_SCHED;
            G8_LDB(B0, 1, 0); G8_LDB(B1, 1, 1); G8_SCHED; G8_LDA(At, 1, 0); G8_STAGEA(G8_SA(0, 1), a2 + h2, ld2);
            G8_WAIT_V(8); G8_WAIT_L(0); G8_BAR; G8_MMA(0, 0, At, B0); G8_MMA(0, 1, At, B1); G8_BAR; G8_SCHED;
            G8_LDA(At, 1, 1); G8_STAGE(G8_SB(1, 0), b3, voffB); G8_STAGE(G8_SB(1, 1), b3 + hstepB, voffB); G8_STAGEA(G8_SA(1, 0), a3, ld2);
            G8_WAIT_V(8); G8_WAIT_L(0); G8_BAR; G8_MMA(1, 0, At, B0); G8_MMA(1, 1, At, B1); G8_BAR; G8_SCHED;
        }
        if (wr == 0) G8_BAR;
        E(acc, cur, wr, wc, fr, fq);
        if (!has_next) break;
#pragma unroll
        for (int a = 0; a < 2; ++a)
#pragma unroll
            for (int b = 0; b < 2; ++b)
#pragma unroll
                for (int m = 0; m < 4; ++m)
#pragma unroll
                    for (int n = 0; n < 2; ++n) acc[a][b][m][n] = (f32x4){0.f, 0.f, 0.f, 0.f};
        cur = nxt; cA = nA; cB = nB; ldc = ldn; ++ui;
        if (wr == 1) G8_BAR;
    }
    G8_WAIT_V(0);
    G8_BAR;
#undef G8_SA
#undef G8_SB
#undef G8_STAGE
#undef G8_STAGEA
#undef G8_LDA
#undef G8_LDB
#undef G8_MMA
#undef G8_WAIT_V
#undef G8_WAIT_L
#undef G8_BAR
#undef G8_SCHED
}

DEV void grid_unit(int wgid, int nM, int nN, int& pm, int& pn) {
    const int nwg = nM * nN, q = nwg / 8, r = nwg % 8, xcd = wgid % 8, off = wgid / 8;
    wgid = (xcd < r ? xcd * (q + 1) : r * (q + 1) + (xcd - r) * q) + off;
    const int nig = 4 * nN, gid = wgid / nig, fm = gid * 4, gsz = (nM - fm) < 4 ? (nM - fm) : 4;
    pm = fm + ((wgid % nig) % gsz); pn = (wgid % nig) / gsz;
}
DEV uint2 pk4(const f32x4 v) { return make_uint2(pk2(v[0], v[1]), pk2(v[2], v[3])); }
DEV float lo16(unsigned u) { return __uint_as_float(u << 16); }
DEV float hi16(unsigned u) { return __uint_as_float(u & 0xffff0000u); }
}

struct SchedG1 {
    const char* H; const char* W; int G, c;
    DEV bool next(int i, g8::Unit& u) const {
        int L = i * G + c;
        if (L >= 1440) return false;
        if (L < 1248) { g8::grid_unit(L, 48, 26, u.pm, u.pn); u.kind = 0; u.lda = 2048u; u.a = H + (size_t)u.pm * 256 * 2048; u.b = W + (size_t)u.pn * 256 * 2048; }
        else { g8::grid_unit(L - 1248, 4, 48, u.pm, u.pn); u.kind = 0; u.lda = 2048u; u.a = W + (size_t)(PW + u.pm * 256) * 2048; u.b = H + (size_t)u.pn * 256 * 2048; u.pn += 64; }
        return true;
    }
};
struct EpiG1 {
    unsigned char* ws; float* out; int l;
    DEV void operator()(const f32x4 (&acc)[2][2][4][2], const g8::Unit& u, int wr, int wc, int fr, int fq) const {
        using namespace g8;
        bf16_t* Pb = (bf16_t*)(ws + OFF_P);
        if (u.pn >= 64) {
            bf16_t* RVT = (bf16_t*)(ws + OFF_RVT);
#pragma unroll
            for (int ai = 0; ai < 2; ++ai)
#pragma unroll
                for (int bj = 0; bj < 2; ++bj)
#pragma unroll
                    for (int m = 0; m < 4; ++m)
#pragma unroll
                        for (int n = 0; n < 2; ++n) {
                            const int ch = u.pm * 256 + ai * 128 + wr * 64 + m * 16 + fr;
                            const int tok = (u.pn - 64) * 256 + bj * 128 + wc * 32 + n * 16 + fq * 4;
                            *(uint2*)(RVT + (size_t)ch * M + tok) = pk4(acc[ai][bj][m][n]);
                        }
            return;
        }
        const int pn = u.pn;
        const bool rope_ret = pn < 4, rope_att = pn >= 16 && pn <= 20;
        const bool lat = u.pm >= 16;
        if (rope_ret || rope_att) {
            const int te = rope_ret ? (wc >> 1) * 32 + (wc & 1) * 16 + fq * 4 : 64 + (wc & 1) * 16 + fq * 4;
            const float sc = pn < 2 ? 0.08838834764831845f : (pn >= 16 && pn < 20) ? 0.125f * 1.4426950408889634f : 1.f;
#pragma unroll
            for (int ai = 0; ai < 2; ++ai) {
                float4 c01[4], c23[4];
                if (lat) {
#pragma unroll
                    for (int m = 0; m < 4; ++m) {
                        const int t = (u.pm * 256 + ai * 128 + wr * 64 + m * 16 + fr - NCTX) & 2047;
                        const float4* tb = (const float4*)((const float2*)(ws + OFF_ROPE) + (size_t)t * 96 + te);
                        c01[m] = tb[0]; c23[m] = tb[1];
                    }
                }
#pragma unroll
                for (int m = 0; m < 4; ++m) {
                    const int row = u.pm * 256 + ai * 128 + wr * 64 + m * 16 + fr;
                    bf16_t* Pr = Pb + (size_t)row * PW;
#pragma unroll
                    for (int bj = 0; bj < 2; ++bj) {
                        f32x4 x1 = acc[ai][bj][m][0], x2 = acc[ai][bj][m][1];
                        const int lc1 = rope_ret ? pn * 256 + bj * 128 + (wc >> 1) * 64 + (wc & 1) * 16 + fq * 4 : pn * 256 + bj * 128 + wc * 32 + fq * 4;
                        const int lc2 = rope_ret ? lc1 + 32 : lc1 + 16;
                        if (!lat && pn == 20) {
                            float* ok = out + O_NK + ((size_t)((row >> 8) * 2 + l) * 256 + (row & 255)) * 256 + (lc1 - C_AK);
                            *(float4*)ok = make_float4(x1[0], x1[1], x1[2], x1[3]);
                            *(float4*)(ok + 16) = make_float4(x2[0], x2[1], x2[2], x2[3]);
                        }
                        if (lat) {
                            const float cs[4] = {c01[m].x, c01[m].z, c23[m].x, c23[m].z}, sn[4] = {c01[m].y, c01[m].w, c23[m].y, c23[m].w};
                            f32x4 o1, o2;
#pragma unroll
                            for (int j = 0; j < 4; ++j) { o1[j] = x1[j] * cs[j] - x2[j] * sn[j]; o2[j] = x2[j] * cs[j] + x1[j] * sn[j]; }
                            x1 = o1; x2 = o2;
                        }
                        x1 *= sc; x2 *= sc;
                        *(uint2*)(Pr + lc1) = pk4(x1);
                        *(uint2*)(Pr + lc2) = pk4(x2);
                    }
                }
            }
            return;
        }
#pragma unroll
        for (int ai = 0; ai < 2; ++ai)
#pragma unroll
            for (int m = 0; m < 4; ++m) {
                const int row = u.pm * 256 + ai * 128 + wr * 64 + m * 16 + fr;
                bf16_t* Pr = Pb + (size_t)row * PW;
#pragma unroll
                for (int bj = 0; bj < 2; ++bj)
#pragma unroll
                    for (int n = 0; n < 2; ++n) {
                        f32x4 v = acc[ai][bj][m][n];
                        const int col = pn * 256 + bj * 128 + wc * 32 + n * 16 + fq * 4;
                        if (pn == 21) {
                            if (!lat) *(float4*)(out + O_NV + ((size_t)((row >> 8) * 2 + l) * 256 + (row & 255)) * 256 + (col - C_AV)) = make_float4(v[0], v[1], v[2], v[3]);
                        } else if (!(pn >= 8 && pn < 12)) {
#pragma unroll
                            for (int j = 0; j < 4; ++j) v[j] = siluf(v[j]);
                        }
                        *(uint2*)(Pr + col) = pk4(v);
                    }
            }
    }
};
DEV void phase8_gemm1(CParams& p, int l, LAS unsigned char* lds) {
    SchedG1 S{(const char*)(p.ws + OFF_H), (const char*)(p.ws + OFF_W1T), GDIM(), BIDX()};
    EpiG1 E{p.ws, p.out, l};
    g8::gemm_phase(lds, 2048u, 16, S, E);
}

constexpr size_t OFF_G2 = OFF_RVT;
constexpr size_t OFF_Z2B = OFF_W1T + 16777216;
static_assert(OFF_Z2B + (size_t)M * 512 * 2 <= OFF_LRUC, "z2 scratch");
struct SchedMg {
    const char *H, *P, *WMG, *WBR; int G, c, part;
    DEV void fill(g8::Unit& u, int tile, int n, int isz) const {
        u.pm = tile >> 2; u.pn = tile & 3; u.kind = n * 2 + isz;
        if (isz) { const int acol = n == 0 ? C_RG : n == 1 ? C_LG : C_AQ;
                   u.lda = (unsigned)PW * 2u; u.a = P + (size_t)u.pm * 256 * PW * 2 + (size_t)acol * 2; u.b = WBR + ((size_t)n * 1024 + u.pn * 256) * 2048; }
        else { u.lda = 2048u; u.a = H + (size_t)u.pm * 256 * 2048; u.b = WMG + ((size_t)n * 1024 + u.pn * 256) * 2048; }
    }
    DEV bool next(int i, g8::Unit& u) const {
        if (G == 256) {
            const int xg = c & 7, j = c >> 3;
            if (part == 2) {
                if (c >= 192 || i >= 2) return false;
                if (i == 0) fill(u, xg * 24 + j, 1, 0); else { fill(u, xg * 24 + j, 2, 1); u.kind |= 8; }
            } else if (part == 0) {
                if (i >= 3) return false;
                if (c < 192) { if (i == 0) fill(u, xg * 24 + j, 0, 0); else { fill(u, xg * 24 + j, i - 1, 1); if (i == 2) u.kind |= 16; } }
                else { fill(u, xg * 24 + (j - 24) * 3 + i, 2, 0); u.kind |= 32; }
            } else return false;
            return true;
        }
        if (part != 0) return false;
        const int tile = c + (i / 6) * G, sI = i % 6;
        if (tile >= 192) return false;
        fill(u, tile, sI >> 1, sI & 1);
        return true;
    }
};
struct EpiMg {
    unsigned char* ws; const float* bias; unsigned* flags;
    DEV bf16_t* gslot(int n, int row) const {
        bf16_t* Pb = (bf16_t*)(ws + OFF_P);
        return n == 0 ? Pb + (size_t)row * PW + C_LX : n == 1 ? Pb + (size_t)row * PW + C_AG : (bf16_t*)(ws + OFF_G2) + (size_t)row * 1024;
    }
    DEV bf16_t* z2slot(int pn, int row) const {
        return pn < 2 ? (bf16_t*)(ws + OFF_P) + (size_t)row * PW + C_AK : (bf16_t*)(ws + OFF_Z2B) + (size_t)row * 512 - 512;
    }
    DEV void operator()(const f32x4 (&acc)[2][2][4][2], const g8::Unit& u, int wr, int wc, int fr, int fq) const {
        using namespace g8;
        const int n = (u.kind >> 1) & 3; const bool zpass = u.kind & 1;
        const int colb = u.pn * 256 + wc * 32 + fq * 4;
        if (u.kind & 8) {
#pragma unroll
            for (int ai = 0; ai < 2; ++ai)
#pragma unroll
                for (int m = 0; m < 4; ++m) {
                    bf16_t* zs = z2slot(u.pn, u.pm * 256 + ai * 128 + wr * 64 + m * 16 + fr);
#pragma unroll
                    for (int bj = 0; bj < 2; ++bj)
#pragma unroll
                        for (int nn = 0; nn < 2; ++nn) *(uint2*)(zs + colb + bj * 128 + nn * 16) = pk4(acc[ai][bj][m][nn]);
                }
            return;
        }
        if (!zpass) {
            const bool publish = u.kind & 32;
            float4 bz[2][2];
#pragma unroll
            for (int bj = 0; bj < 2; ++bj)
#pragma unroll
                for (int nn = 0; nn < 2; ++nn) bz[bj][nn] = *(const float4*)(bias + n * 1024 + colb + bj * 128 + nn * 16);
#pragma unroll
            for (int ai = 0; ai < 2; ++ai)
#pragma unroll
                for (int m = 0; m < 4; ++m) {
                    bf16_t* gs = gslot(n, u.pm * 256 + ai * 128 + wr * 64 + m * 16 + fr);
#pragma unroll
                    for (int bj = 0; bj < 2; ++bj)
#pragma unroll
                        for (int nn = 0; nn < 2; ++nn) {
                            f32x4 v = acc[ai][bj][m][nn];
                            v[0] = sigmf(v[0] + bz[bj][nn].x); v[1] = sigmf(v[1] + bz[bj][nn].y); v[2] = sigmf(v[2] + bz[bj][nn].z); v[3] = sigmf(v[3] + bz[bj][nn].w);
                            const uint2 pv = pk4(v);
                            if (publish) __hip_atomic_store((unsigned long long*)(gs + colb + bj * 128 + nn * 16), (unsigned long long)pv.x | ((unsigned long long)pv.y << 32), __ATOMIC_RELAXED, __HIP_MEMORY_SCOPE_AGENT);
                            else *(uint2*)(gs + colb + bj * 128 + nn * 16) = pv;
                        }
                }
            if (publish) {
                asm volatile("s_waitcnt vmcnt(0)" ::: "memory");
                __syncthreads();
                if (TIDX() == 0) __hip_atomic_store(flags + u.pm * 4 + u.pn, 1u, __ATOMIC_RELAXED, __HIP_MEMORY_SCOPE_AGENT);
            }
            return;
        }
        if (u.kind & 16) {
            if (TIDX() == 0) {
                unsigned sp = 0;
                while (__hip_atomic_load(flags + u.pm * 4 + u.pn, __ATOMIC_RELAXED, __HIP_MEMORY_SCOPE_AGENT) == 0u && ++sp < (1u << 22)) __builtin_amdgcn_s_sleep(1);
                __builtin_amdgcn_fence(__ATOMIC_ACQUIRE, "agent");
                asm volatile("s_waitcnt vmcnt(0)" ::: "memory");
            }
            __syncthreads();
#pragma unroll
            for (int ai = 0; ai < 2; ++ai)
#pragma unroll
                for (int mh = 0; mh < 2; ++mh) {
                    uint2 g1q[2][2][2], tq[2][2][2], g2q[2][2][2], zq[2][2][2];
#pragma unroll
                    for (int mm = 0; mm < 2; ++mm) {
                        const int row = u.pm * 256 + ai * 128 + wr * 64 + (mh * 2 + mm) * 16 + fr;
                        const bf16_t* g1 = gslot(1, row); const bf16_t* g2 = gslot(2, row); const bf16_t* zs = z2slot(u.pn, row);
                        const bf16_t* Tr = (const bf16_t*)(ws + OFF_P) + (size_t)row * PW;
#pragma unroll
                        for (int bj = 0; bj < 2; ++bj)
#pragma unroll
                            for (int nn = 0; nn < 2; ++nn) {
                                const int cc = colb + bj * 128 + nn * 16;
                                g1q[mm][bj][nn] = *(const uint2*)(g1 + cc); tq[mm][bj][nn] = *(const uint2*)(Tr + cc);
                                g2q[mm][bj][nn] = *(const uint2*)(g2 + cc); zq[mm][bj][nn] = *(const uint2*)(zs + cc);
                            }
                    }
#pragma unroll
                    for (int mm = 0; mm < 2; ++mm) {
                        const int row = u.pm * 256 + ai * 128 + wr * 64 + (mh * 2 + mm) * 16 + fr;
                        bf16_t* Tr = (bf16_t*)(ws + OFF_P) + (size_t)row * PW;
#pragma unroll
                        for (int bj = 0; bj < 2; ++bj)
#pragma unroll
                            for (int nn = 0; nn < 2; ++nn) {
                                f32x4 v = acc[ai][bj][mh * 2 + mm][nn];
                                const uint2 gv = g1q[mm][bj][nn], tv = tq[mm][bj][nn], hv = g2q[mm][bj][nn], zv = zq[mm][bj][nn];
                                v[0] = v[0] * lo16(gv.x) + lo16(tv.x) + lo16(hv.x) * lo16(zv.x);
                                v[1] = v[1] * hi16(gv.x) + hi16(tv.x) + hi16(hv.x) * hi16(zv.x);
                                v[2] = v[2] * lo16(gv.y) + lo16(tv.y) + lo16(hv.y) * lo16(zv.y);
                                v[3] = v[3] * hi16(gv.y) + hi16(tv.y) + hi16(hv.y) * hi16(zv.y);
                                *(uint2*)(Tr + colb + bj * 128 + nn * 16) = pk4(v);
                            }
                    }
                }
            return;
        }
#pragma unroll
        for (int ai = 0; ai < 2; ++ai) {
            uint2 gq[4][2][2], tq[4][2][2];
#pragma unroll
            for (int m = 0; m < 4; ++m) {
                const int row = u.pm * 256 + ai * 128 + wr * 64 + m * 16 + fr;
                const bf16_t* gs = gslot(n, row);
                const bf16_t* Tr = (const bf16_t*)(ws + OFF_P) + (size_t)row * PW;
#pragma unroll
                for (int bj = 0; bj < 2; ++bj)
#pragma unroll
                    for (int nn = 0; nn < 2; ++nn) {
                        gq[m][bj][nn] = *(const uint2*)(gs + colb + bj * 128 + nn * 16);
                        if (n > 0) tq[m][bj][nn] = *(const uint2*)(Tr + colb + bj * 128 + nn * 16);
                    }
            }
#pragma unroll
            for (int m = 0; m < 4; ++m) {
                const int row = u.pm * 256 + ai * 128 + wr * 64 + m * 16 + fr;
                bf16_t* Tr = (bf16_t*)(ws + OFF_P) + (size_t)row * PW;
#pragma unroll
                for (int bj = 0; bj < 2; ++bj)
#pragma unroll
                    for (int nn = 0; nn < 2; ++nn) {
                        f32x4 v = acc[ai][bj][m][nn];
                        const uint2 gv = gq[m][bj][nn];
                        v[0] *= lo16(gv.x); v[1] *= hi16(gv.x); v[2] *= lo16(gv.y); v[3] *= hi16(gv.y);
                        if (n > 0) { const uint2 tv = tq[m][bj][nn]; v[0] += lo16(tv.x); v[1] += hi16(tv.x); v[2] += lo16(tv.y); v[3] += hi16(tv.y); }
                        *(uint2*)(Tr + colb + bj * 128 + nn * 16) = pk4(v);
                    }
            }
        }
    }
};
DEV void phase8_merge(CParams& p, int l, int part, LAS unsigned char* lds) {
    SchedMg S{(const char*)(p.ws + OFF_H), (const char*)(p.ws + OFF_P), (const char*)(p.ws + OFF_WMG), (const char*)(p.ws + OFF_WBR), GDIM(), BIDX(), part};
    EpiMg E{p.ws, p.b_merge + (size_t)l * 3072, (unsigned*)(p.ws + OFF_BAR) + 3584 + l * 192};
    g8::gemm_phase(lds, 2048u, 16, S, E);
}

struct SchedOut {
    const char* A; const char* B; int G, c;
    DEV bool next(int i, g8::Unit& u) const {
        int tile = i * G + c;
        if (G == 256) { if (i > 0 || c >= 192) return false; tile = (c & 7) * 24 + (c >> 3); }
        if (tile >= 192) return false;
        u.pm = tile >> 2; u.pn = tile & 3; u.kind = 0; u.lda = (unsigned)PW * 2u;
        u.a = A + (size_t)u.pm * 256 * PW * 2; u.b = B + (size_t)u.pn * 256 * 2048;
        return true;
    }
};
DEV void row_exchange(unsigned char* ws, int slot, int pn, float* part, float* rs) {
    const int tid = TIDX();
    __syncthreads();
    unsigned* XPd = (unsigned*)(ws + OFF_XP) + (size_t)slot * 4 * 256;
    unsigned* cnt = (unsigned*)(ws + OFF_XC) + slot;
    if (tid < 256) {
        const float v = (part[tid] + part[256 + tid]) + (part[512 + tid] + part[768 + tid]);
        __hip_atomic_store(XPd + pn * 256 + tid, __float_as_uint(v), __ATOMIC_RELAXED, __HIP_MEMORY_SCOPE_AGENT);
    }
    asm volatile("s_waitcnt vmcnt(0)" ::: "memory");
    __syncthreads();
    if (tid == 0) {
        (void)__hip_atomic_fetch_add(cnt, 1u, __ATOMIC_RELAXED, __HIP_MEMORY_SCOPE_AGENT);
        unsigned sp = 0;
        while (__hip_atomic_load(cnt, __ATOMIC_RELAXED, __HIP_MEMORY_SCOPE_AGENT) < 4u) { __builtin_amdgcn_s_sleep(1); if (++sp > (1u << 20)) break; }
        __builtin_amdgcn_fence(__ATOMIC_ACQUIRE, "agent");
        asm volatile("s_waitcnt vmcnt(0)" ::: "memory");
    }
    __syncthreads();
    if (tid < 256) {
        float t = 0.f;
#pragma unroll
        for (int q = 0; q < 4; ++q) t += __uint_as_float(__hip_atomic_load(XPd + q * 256 + tid, __ATOMIC_RELAXED, __HIP_MEMORY_SCOPE_AGENT));
        rs[tid] = rsqrtf(t * (1.f / D) + EPS);
    }
    __syncthreads();
}
struct EpiOutPost {
    CParams* kp; int l; unsigned char* ldsx;
    DEV void row_ssq(const f32x4 (&v)[2][2][4][2], float* part, int wr, int wc, int fr, int fq) const {
#pragma unroll
        for (int ai = 0; ai < 2; ++ai)
#pragma unroll
            for (int m = 0; m < 4; ++m) {
                float ss = 0.f;
#pragma unroll
                for (int bj = 0; bj < 2; ++bj)
#pragma unroll
                    for (int n = 0; n < 2; ++n) { const f32x4 x = v[ai][bj][m][n]; ss += (x[0] * x[0] + x[1] * x[1]) + (x[2] * x[2] + x[3] * x[3]); }
                ss = xrow16_sum(ss);
                if (fq == 0) part[wc * 256 + ai * 128 + wr * 64 + m * 16 + fr] = ss;
            }
    }
    DEV void operator()(f32x4 (&acc)[2][2][4][2], const g8::Unit& u, int wr, int wc, int fr, int fq) const {
        CParams& p = *kp;
        unsigned char* ws = p.ws;
        float* part = (float*)ldsx; float* rs = part + 1024;
        const int colb = u.pn * 256 + wc * 32 + fq * 4;
        const int crow = u.pm < 16 ? 0 : 1 + ((u.pm - 16) >> 3);
        const float* mod = ws_mod(p) + (size_t)(l * 5 + crow) * 3072;
        row_ssq(acc, part, wr, wc, fr, fq);
        row_exchange(ws, (l * 2 + 0) * 48 + u.pm, u.pn, part, rs);
        {
            float4 gt[2][2], gp[2][2];
#pragma unroll
            for (int bj = 0; bj < 2; ++bj)
#pragma unroll
                for (int n = 0; n < 2; ++n) {
                    gt[bj][n] = *(const float4*)(mod + 2048 + colb + bj * 128 + n * 16);
                    gp[bj][n] = *(const float4*)(p.norm_post + l * D + colb + bj * 128 + n * 16);
                    gt[bj][n].x *= gp[bj][n].x; gt[bj][n].y *= gp[bj][n].y; gt[bj][n].z *= gp[bj][n].z; gt[bj][n].w *= gp[bj][n].w;
                }
#pragma unroll
            for (int ai = 0; ai < 2; ++ai)
#pragma unroll
                for (int mh = 0; mh < 2; ++mh) {
                    float4 xv[2][2][2];
#pragma unroll
                    for (int m2 = 0; m2 < 2; ++m2) {
                        const int row = u.pm * 256 + ai * 128 + wr * 64 + (mh * 2 + m2) * 16 + fr;
                        const float* xr = x_row(p, l, row);
#pragma unroll
                        for (int bj = 0; bj < 2; ++bj)
#pragma unroll
                            for (int n = 0; n < 2; ++n) xv[m2][bj][n] = *(const float4*)(xr + colb + bj * 128 + n * 16);
                    }
#pragma unroll
                    for (int m2 = 0; m2 < 2; ++m2) {
                        const int m = mh * 2 + m2;
                        const int rl = ai * 128 + wr * 64 + m * 16 + fr;
                        const float rstd = rs[rl];
                        float* yr = p.out + (size_t)(u.pm * 256 + rl) * D;
#pragma unroll
                        for (int bj = 0; bj < 2; ++bj)
#pragma unroll
                            for (int n = 0; n < 2; ++n) {
                                f32x4 y;
                                y[0] = xv[m2][bj][n].x + gt[bj][n].x * (acc[ai][bj][m][n][0] * rstd);
                                y[1] = xv[m2][bj][n].y + gt[bj][n].y * (acc[ai][bj][m][n][1] * rstd);
                                y[2] = xv[m2][bj][n].z + gt[bj][n].z * (acc[ai][bj][m][n][2] * rstd);
                                y[3] = xv[m2][bj][n].w + gt[bj][n].w * (acc[ai][bj][m][n][3] * rstd);
                                acc[ai][bj][m][n] = y;
                                *(float4*)(yr + colb + bj * 128 + n * 16) = make_float4(y[0], y[1], y[2], y[3]);
                            }
                    }
                }
        }
        if (l != 0) return;
        row_ssq(acc, part, wr, wc, fr, fq);
        row_exchange(ws, (l * 2 + 1) * 48 + u.pm, u.pn, part, rs);
        {
            const float* mod1 = ws_mod(p) + (size_t)(1 * 5 + crow) * 3072;
            float4 a_[2][2], b_[2][2];
#pragma unroll
            for (int bj = 0; bj < 2; ++bj)
#pragma unroll
                for (int n = 0; n < 2; ++n) {
                    const int cc = colb + bj * 128 + n * 16;
                    const float4 g = *(const float4*)(p.norm_pre + 1 * D + cc), sc = *(const float4*)(mod1 + 1024 + cc);
                    a_[bj][n] = make_float4(g.x * (1.f + sc.x), g.y * (1.f + sc.y), g.z * (1.f + sc.z), g.w * (1.f + sc.w));
                    b_[bj][n] = *(const float4*)(mod1 + cc);
                }
#pragma unroll
            for (int ai = 0; ai < 2; ++ai)
#pragma unroll
                for (int m = 0; m < 4; ++m) {
                    const int rl = ai * 128 + wr * 64 + m * 16 + fr;
                    const float rstd = rs[rl];
                    bf16_t* hr = ws_bf(p, OFF_H) + (size_t)(u.pm * 256 + rl) * D;
#pragma unroll
                    for (int bj = 0; bj < 2; ++bj)
#pragma unroll
                        for (int n = 0; n < 2; ++n) {
                            const f32x4 y = acc[ai][bj][m][n];
                            uint2 o;
                            o.x = pk2(y[0] * rstd * a_[bj][n].x + b_[bj][n].x, y[1] * rstd * a_[bj][n].y + b_[bj][n].y);
                            o.y = pk2(y[2] * rstd * a_[bj][n].z + b_[bj][n].z, y[3] * rstd * a_[bj][n].w + b_[bj][n].w);
                            *(uint2*)(hr + colb + bj * 128 + n * 16) = o;
                        }
                }
        }
    }
};
DEV void phase8_out(CParams& p, int l, LAS unsigned char* lds) {
    SchedOut S{(const char*)(p.ws + OFF_P), (const char*)(p.ws + OFF_WOUT), GDIM(), BIDX()};
    EpiOutPost E{&p, l, (unsigned char*)lds + LDS_XOFF};
    g8::gemm_phase(lds, 2048u, 16, S, E);
}

DEV uint4 pack8(const float4 a, const float4 b) {
    uint4 r;
    r.x = pk2(a.x, a.y); r.y = pk2(a.z, a.w);
    r.z = pk2(b.x, b.y); r.w = pk2(b.z, b.w);
    return r;
}
template <int NU>
DEV void attn_item(CParams& p, int l, bool lat, int b, int hk, int qs0, unsigned char* lds) {
    bf16_t* Pb = ws_bf(p, OFF_P);
    const int tid = TIDX(), lane = tid & 63, w = tid >> 6, g = lane >> 4, lc = lane & 15;
    const int row0 = lat ? NCTX + b * 2048 : b * 256, L = lat ? 2048 : 256;
    const int hq = hk * 4 + (w & 3);
    const int qw = qs0 + (w >> 2) * 32;
    bf16x8 qfr[NU][2][2];
    f32x4 O[NU][4][2];
    float mrun[NU][2], lrun[NU][2];
    const float sink = p.att_sink[l * 16 + hq] * 1.4426950408889634f;
#pragma unroll
    for (int u = 0; u < NU; ++u)
#pragma unroll
        for (int qf = 0; qf < 2; ++qf) {
#pragma unroll
            for (int ks = 0; ks < 2; ++ks)
                qfr[u][qf][ks] = *(const bf16x8*)(Pb + (size_t)(row0 + qw + u * 64 + qf * 16 + lc) * PW + C_AQ + hq * 64 + ks * 32 + g * 8);
            mrun[u][qf] = sink; lrun[u][qf] = g == 0 ? 1.f : 0.f;
#pragma unroll
            for (int df = 0; df < 4; ++df) O[u][df][qf] = (f32x4){0.f, 0.f, 0.f, 0.f};
        }
    const int nband = lat ? 4 + NU : 4;
    const int ntile = lat ? nband + 4 : 4;
    const int qsb = qs0 >> 6;
    const int t_lo = lat ? (qsb < 2 ? 2 - qsb : 0) : 0;
    const int t_hi = lat ? ((33 - qsb) < (nband - 1) ? (33 - qsb) : (nband - 1)) : 3;
    const int fsw = (lane >> 1) & 7;
    const int srow = tid >> 3, sc8 = tid & 7;
    float4 R[4];
    auto tile_load = [&](int t) __attribute__((always_inline)) {
        if (t < nband) {
            const int kp0 = lat ? qs0 + 64 * (t - 2) : 64 * t;
            const uint4 kv = *(const uint4*)(Pb + (size_t)(row0 + kp0 + srow) * PW + C_AK + hk * 64 + sc8 * 8);
            const uint4 vv = *(const uint4*)(Pb + (size_t)(row0 + kp0 + srow) * PW + C_AV + hk * 64 + sc8 * 8);
            R[0] = make_float4(__uint_as_float(kv.x), __uint_as_float(kv.y), __uint_as_float(kv.z), __uint_as_float(kv.w));
            R[2] = make_float4(__uint_as_float(vv.x), __uint_as_float(vv.y), __uint_as_float(vv.z), __uint_as_float(vv.w));
        } else {
            const int j0 = (t - nband) * 64;
            const float* ck = p.cache_k + (size_t)((b * 2 + l) * 256 + j0) * 256 + hk * 64;
            const float* cv = p.cache_v + (size_t)((b * 2 + l) * 256 + j0) * 256 + hk * 64;
            R[0] = *(const float4*)(ck + (size_t)srow * 256 + sc8 * 8); R[1] = *(const float4*)(ck + (size_t)srow * 256 + sc8 * 8 + 4);
            R[2] = *(const float4*)(cv + (size_t)srow * 256 + sc8 * 8); R[3] = *(const float4*)(cv + (size_t)srow * 256 + sc8 * 8 + 4);
        }
    };
    auto tile_store = [&](bool cache_t, unsigned char* KsB, unsigned char* VtB) __attribute__((always_inline)) {
        uint4 kq, vq;
        if (!cache_t) {
            kq = make_uint4(__float_as_uint(R[0].x), __float_as_uint(R[0].y), __float_as_uint(R[0].z), __float_as_uint(R[0].w));
            vq = make_uint4(__float_as_uint(R[2].x), __float_as_uint(R[2].y), __float_as_uint(R[2].z), __float_as_uint(R[2].w));
        } else { kq = pack8(R[0], R[1]); vq = pack8(R[2], R[3]); }
        *(uint4*)(KsB + srow * 128 + ((sc8 ^ ((srow >> 1) & 7)) << 4)) = kq;
        *(uint4*)(VtB + srow * 128 + ((sc8 ^ (((srow >> 1) & 3) << 1)) << 4)) = vq;
    };
    int t = t_lo;
    tile_load(t);
    __syncthreads();
    tile_store(t >= nband, lds, lds + 8192);
    int tn = (lat && t == t_hi) ? nband : t + 1;
    if (tn < ntile) tile_load(tn);
    int cur = 0;
    while (t < ntile) {
        const bool cache = t >= nband;
        const int kp0 = lat ? qs0 + 64 * (t - 2) : 64 * t;
        const unsigned char* Ks = lds + cur * 16384; const unsigned char* Vt = Ks + 8192;
        __syncthreads();
        int tnn = ntile;
        if (tn < ntile) {
            tile_store(tn >= nband, lds + (cur ^ 1) * 16384, lds + (cur ^ 1) * 16384 + 8192);
            tnn = (lat && tn == t_hi) ? nband : tn + 1;
            if (tnn < ntile) tile_load(tnn);
        }
#pragma unroll
        for (int u = 0; u < NU; ++u) {
            const int tu = t - u;
            if (lat && !cache && (tu < 0 || tu > 4)) continue;
            __builtin_amdgcn_s_setprio(1);
            f32x4 sc[4][2];
#pragma unroll
            for (int kf = 0; kf < 4; ++kf)
#pragma unroll
                for (int qf = 0; qf < 2; ++qf) sc[kf][qf] = (f32x4){0.f, 0.f, 0.f, 0.f};
#pragma unroll
            for (int ks = 0; ks < 2; ++ks) {
                bf16x8 ak[4];
#pragma unroll
                for (int kf = 0; kf < 4; ++kf) ak[kf] = *(const bf16x8*)(Ks + (kf * 16 + lc) * 128 + (((ks * 4 + g) ^ fsw) << 4));
#pragma unroll
                for (int kf = 0; kf < 4; ++kf)
#pragma unroll
                    for (int qf = 0; qf < 2; ++qf)
                        sc[kf][qf] = __builtin_amdgcn_mfma_f32_16x16x32_bf16(ak[kf], qfr[u][qf][ks], sc[kf][qf], 0, 0, 0);
            }
            __builtin_amdgcn_s_setprio(0);
            if (lat && !cache && (tu == 0 || tu == 4)) {
#pragma unroll
                for (int kf = 0; kf < 4; ++kf)
#pragma unroll
                    for (int qf = 0; qf < 2; ++qf)
#pragma unroll
                        for (int r = 0; r < 4; ++r) {
                            const int kpos = kp0 + kf * 16 + g * 4 + r, qpos = qw + u * 64 + qf * 16 + lc;
                            const int dd = qpos - kpos;
                            if (dd > 128 || dd < -128) sc[kf][qf][r] = -INFINITY;
                        }
            }
            bf16x8 pb[2][2];
#pragma unroll
            for (int qf = 0; qf < 2; ++qf) {
                float mx = -INFINITY;
#pragma unroll
                for (int kf = 0; kf < 4; ++kf)
#pragma unroll
                    for (int r = 0; r < 4; ++r) mx = fmaxf(mx, sc[kf][qf][r]);
                mx = xrow16_max(mx);
                const float mnew = fmaxf(mrun[u][qf], mx);
                const float alpha = __builtin_amdgcn_exp2f(mrun[u][qf] - mnew);
                mrun[u][qf] = mnew;
                float ps = 0.f;
#pragma unroll
                for (int kf = 0; kf < 4; ++kf)
#pragma unroll
                    for (int r = 0; r < 4; ++r) { const float e = __builtin_amdgcn_exp2f(sc[kf][qf][r] - mnew); sc[kf][qf][r] = e; ps += e; }
                lrun[u][qf] = lrun[u][qf] * alpha + ps;
#pragma unroll
                for (int df = 0; df < 4; ++df) O[u][df][qf] *= alpha;
#pragma unroll
                for (int s2 = 0; s2 < 2; ++s2) {
                    bf16x8 v;
#pragma unroll
                    for (int r = 0; r < 4; ++r) { v[r] = (short)f2bf(sc[2 * s2][qf][r]); v[4 + r] = (short)f2bf(sc[2 * s2 + 1][qf][r]); }
                    pb[s2][qf] = v;
                }
            }
            __builtin_amdgcn_s_setprio(1);
#pragma unroll
            for (int s2 = 0; s2 < 2; ++s2)
#pragma unroll
                for (int df = 0; df < 4; ++df) {
                    const int vrow = 32 * s2 + 4 * g + (lc >> 2);
                    const unsigned char* vr = Vt + vrow * 128 + (((2 * df + ((lc >> 1) & 1)) ^ (((vrow >> 1) & 3) << 1)) << 4) + 8 * (lc & 1);
                    const v4i16_t lo = __builtin_amdgcn_ds_read_tr16_b64_v4i16((LAS v4i16_t*)vr);
                    const v4i16_t hi = __builtin_amdgcn_ds_read_tr16_b64_v4i16((LAS v4i16_t*)(vr + 2048));
                    union { v4i16_t h[2]; bf16x8 v; } av; av.h[0] = lo; av.h[1] = hi;
#pragma unroll
                    for (int qf = 0; qf < 2; ++qf)
                        O[u][df][qf] = __builtin_amdgcn_mfma_f32_16x16x32_bf16(av.v, pb[s2][qf], O[u][df][qf], 0, 0, 0);
                }
            __builtin_amdgcn_s_setprio(0);
        }
        t = tn; tn = tnn; cur ^= 1;
    }
#pragma unroll
    for (int u = 0; u < NU; ++u)
#pragma unroll
        for (int qf = 0; qf < 2; ++qf) {
            const float lt = xrow16_sum(lrun[u][qf]);
            const float inv = 1.f / lt;
            const size_t m = (size_t)(row0 + qw + u * 64 + qf * 16 + lc);
#pragma unroll
            for (int df = 0; df < 4; ++df) {
                const int col = hq * 64 + df * 16 + g * 4;
                const uint2 gt = *(const uint2*)(Pb + m * PW + C_AG + col);
                uint2 o;
                o.x = pk2(O[u][df][qf][0] * inv * __uint_as_float(gt.x << 16), O[u][df][qf][1] * inv * __uint_as_float(gt.x & 0xffff0000u));
                o.y = pk2(O[u][df][qf][2] * inv * __uint_as_float(gt.y << 16), O[u][df][qf][3] * inv * __uint_as_float(gt.y & 0xffff0000u));
                *(uint2*)(Pb + m * PW + C_AQ + col) = o;
            }
        }
}
DEV void phase_attn(CParams& p, int l, unsigned char* lds) {
    if (GDIM() == 256) {
        const int xg = BIDX() & 7, j = BIDX() >> 3;
        { const int grp = xg * 2 + (j >> 4); attn_item<2>(p, l, true, grp >> 2, grp & 3, (j & 15) * 128, lds); }
        { const int grp = xg * 8 + (j >> 2); attn_item<1>(p, l, false, grp >> 2, grp & 3, (j & 3) * 64, lds); }
        return;
    }
    for (int item = BIDX(); item < 768; item += GDIM()) {
        if (item < 512) attn_item<1>(p, l, true, item >> 7, (item >> 5) & 3, (item & 31) * 64, lds);
        else { const int it = item - 512; attn_item<1>(p, l, false, it >> 4, (it >> 2) & 3, (it & 3) * 64, lds); }
    }
}

constexpr size_t OFF_RS = OFF_W1T;
static_assert(OFF_RS + (size_t)4 * 4 * 2 * 8 * 32768 * 2 <= OFF_LRUC, "RS overlap");
DEV float ret_logg(CParams& p, int l, int dir, int h) { return -softplusf(-p.ret_decay[(l * 2 + dir) * 4 + h]); }

DEV void ret_kv_tile(CParams& p, int l, int item, unsigned char* lds) {
    bf16_t* Pb = ws_bf(p, OFF_P); const bf16_t* RVT = ws_bf(p, OFF_RVT);
    const int tid = TIDX(), lane = tid & 63, w = __builtin_amdgcn_readfirstlane(tid >> 6), g = lane >> 4, lc = lane & 15;
    const bool lat = item < 128;
    int b, h, c;
    if (lat) { c = item & 7; h = (item >> 3) & 3; b = item >> 5; }
    else { const int it = item - 128; h = it & 3; b = it >> 2; c = 0; }
    const int row0 = lat ? NCTX + b * 2048 + c * 256 : b * 256;
    const bool doF = !lat || c < 7, doB = !lat || c > 0;
    const float lgf = ret_logg(p, l, 0, h), lgb = ret_logg(p, l, 1, h);
    const float rf = __expf(-lgf), rb = __expf(lgb);
    const int dvbase = w * 32;
    auto dma_k = [&](int st) __attribute__((always_inline)) {
        LAS unsigned char* base = (LAS unsigned char*)lds + (st & 1) * 16384;
#pragma unroll
        for (int i = 0; i < 2; ++i) {
            const int q = w * 2 + i, row = 4 * q + (lane >> 4), lch = (lane & 15) ^ (((row & 3) << 2) | ((row >> 2) & 3));
            __builtin_amdgcn_global_load_lds((const unsigned*)(Pb + (size_t)(row0 + st * 64 + row) * PW + C_RK + h * 128 + lch * 8), (LAS unsigned*)(base + q * 1024), 16, 0, 0);
        }
    };
    __syncthreads();
    dma_k(0);
    f32x4 accF[2][8], accB[2][8];
#pragma unroll
    for (int i = 0; i < 2; ++i)
#pragma unroll
        for (int j = 0; j < 8; ++j) { accF[i][j] = (f32x4){0.f, 0.f, 0.f, 0.f}; accB[i][j] = (f32x4){0.f, 0.f, 0.f, 0.f}; }
    const int tq = lc >> 2, tp = lc & 3;
#pragma unroll 1
    for (int st = 0; st < 4; ++st) {
        bf16x8 av[2][2];
#pragma unroll
        for (int ks = 0; ks < 2; ++ks)
#pragma unroll
            for (int mf = 0; mf < 2; ++mf)
                av[ks][mf] = *(const bf16x8*)(RVT + (size_t)(h * 256 + dvbase + mf * 16 + lc) * M + row0 + st * 64 + ks * 32 + g * 8);
        bf16x8 avF[2][2], avB[2][2];
#pragma unroll
        for (int ks = 0; ks < 2; ++ks) {
            const int ti0 = st * 64 + ks * 32 + g * 8;
            float wf = __expf(lgf * (float)(255 - ti0)), wb = __expf(lgb * (float)ti0);
#pragma unroll
            for (int j = 0; j < 8; ++j) {
#pragma unroll
                for (int mf = 0; mf < 2; ++mf) {
                    const float v = bf2f((bf16_t)av[ks][mf][j]);
                    avF[ks][mf][j] = (short)f2bf(v * wf); avB[ks][mf][j] = (short)f2bf(v * wb);
                }
                wf *= rf; wb *= rb;
            }
        }
        asm volatile("s_waitcnt vmcnt(0)" ::: "memory");
        __syncthreads();
        if (st + 1 < 4) dma_k(st + 1);
        const unsigned char* Kt = lds + (st & 1) * 16384;
#pragma unroll
        for (int ks = 0; ks < 2; ++ks)
#pragma unroll
            for (int nf = 0; nf < 8; ++nf) {
                const int r0 = 32 * ks + 8 * g + tq, r1 = r0 + 4;
                const unsigned char* a0 = Kt + r0 * 256 + (((2 * nf + (tp >> 1)) ^ (((r0 & 3) << 2) | ((r0 >> 2) & 3))) << 4) + 8 * (tp & 1);
                const unsigned char* a1 = Kt + r1 * 256 + (((2 * nf + (tp >> 1)) ^ (((r1 & 3) << 2) | ((r1 >> 2) & 3))) << 4) + 8 * (tp & 1);
                union { v4i16_t hlf[2]; bf16x8 v; } bk;
                bk.hlf[0] = __builtin_amdgcn_ds_read_tr16_b64_v4i16((LAS v4i16_t*)a0);
                bk.hlf[1] = __builtin_amdgcn_ds_read_tr16_b64_v4i16((LAS v4i16_t*)a1);
#pragma unroll
                for (int mf = 0; mf < 2; ++mf) {
                    accF[mf][nf] = __builtin_amdgcn_mfma_f32_16x16x32_bf16(avF[ks][mf], bk.v, accF[mf][nf], 0, 0, 0);
                    accB[mf][nf] = __builtin_amdgcn_mfma_f32_16x16x32_bf16(avB[ks][mf], bk.v, accB[mf][nf], 0, 0, 0);
                }
            }
    }
    if (lat) {
        bf16_t* dF = ws_bf(p, OFF_RS) + ((size_t)((b * 4 + h) * 2 + 0) * 8 + (c + 1)) * 32768;
        bf16_t* dB = ws_bf(p, OFF_RS) + ((size_t)((b * 4 + h) * 2 + 1) * 8 + (c - 1)) * 32768;
#pragma unroll
        for (int mf = 0; mf < 2; ++mf)
#pragma unroll
            for (int nf = 0; nf < 8; ++nf)
#pragma unroll
                for (int r = 0; r < 4; ++r) {
                    const size_t o = (size_t)(dvbase + mf * 16 + g * 4 + r) * 128 + nf * 16 + lc;
                    if (doF) dF[o] = f2bf(accF[mf][nf][r]);
                    if (doB) dB[o] = f2bf(accB[mf][nf][r]);
                }
    } else {
        float* dF = p.out + O_NRET + ((((size_t)b * 2 + l) * 2 + 0) * 4 + h) * 128 * 256;
        float* dB = p.out + O_NRET + ((((size_t)b * 2 + l) * 2 + 1) * 4 + h) * 128 * 256;
#pragma unroll
        for (int mf = 0; mf < 2; ++mf)
#pragma unroll
            for (int nf = 0; nf < 8; ++nf) {
                const size_t o = (size_t)(nf * 16 + lc) * 256 + dvbase + mf * 16 + g * 4;
                *(float4*)(dF + o) = make_float4(accF[mf][nf][0], accF[mf][nf][1], accF[mf][nf][2], accF[mf][nf][3]);
                *(float4*)(dB + o) = make_float4(accB[mf][nf][0], accB[mf][nf][1], accB[mf][nf][2], accB[mf][nf][3]);
            }
    }
}
DEV void phase_ret_kv(CParams& p, int l, unsigned char* lds) {
    for (int item = BIDX(); item < 192; item += GDIM()) ret_kv_tile(p, l, item, lds);
}

DEV void phase_ret_scan(CParams& p, int l, int vb, int nvb) {
    bf16_t* RS = ws_bf(p, OFF_RS);
    const int gt = vb * 512 + TIDX(), gs = nvb * 512;
    for (int idx = gt; idx < 4 * 4 * 2 * 4096; idx += gs) {
        const int dk0 = (idx & 15) * 8, dv = (idx >> 4) & 255, dir = (idx >> 12) & 1, h = (idx >> 13) & 3, b = idx >> 15;
        const float g256 = __expf(ret_logg(p, l, dir, h) * 256.f);
        const float* s0 = p.state_ret + (((((size_t)b * 2 + l) * 2 + dir) * 4 + h) * 128 + dk0) * 256 + dv;
        float st[8];
#pragma unroll
        for (int e = 0; e < 8; ++e) st[e] = s0[(size_t)e * 256];
        bf16_t* base = RS + (size_t)((b * 4 + h) * 2 + dir) * 8 * 32768 + dv * 128 + dk0;
        uint4 kv[7];
#pragma unroll
        for (int j = 0; j < 7; ++j) kv[j] = *(const uint4*)(base + (size_t)(dir == 0 ? j + 1 : 6 - j) * 32768);
        *(uint4*)(base + (size_t)(dir == 0 ? 0 : 7) * 32768) = make_uint4(pk2(st[0], st[1]), pk2(st[2], st[3]), pk2(st[4], st[5]), pk2(st[6], st[7]));
#pragma unroll
        for (int j = 0; j < 7; ++j) {
            st[0] = g256 * st[0] + g8::lo16(kv[j].x); st[1] = g256 * st[1] + g8::hi16(kv[j].x);
            st[2] = g256 * st[2] + g8::lo16(kv[j].y); st[3] = g256 * st[3] + g8::hi16(kv[j].y);
            st[4] = g256 * st[4] + g8::lo16(kv[j].z); st[5] = g256 * st[5] + g8::hi16(kv[j].z);
            st[6] = g256 * st[6] + g8::lo16(kv[j].w); st[7] = g256 * st[7] + g8::hi16(kv[j].w);
            *(uint4*)(base + (size_t)(dir == 0 ? j + 1 : 6 - j) * 32768) = make_uint4(pk2(st[0], st[1]), pk2(st[2], st[3]), pk2(st[4], st[5]), pk2(st[6], st[7]));
        }
    }
}

DEV void ret_out_tile(CParams& p, int l, int item, unsigned char* lds) {
    bf16_t* Pb = ws_bf(p, OFF_P); const bf16_t* RVT = ws_bf(p, OFF_RVT);
    const int tid = TIDX(), lane = tid & 63, w = __builtin_amdgcn_readfirstlane(tid >> 6), g = lane >> 4, lc = lane & 15;
    const bool lat = item < 256;
    int b, h, qb, rowc, qi0, c;
    if (lat) { qb = item & 15; h = (item >> 4) & 3; b = item >> 6; c = qb >> 1; rowc = NCTX + b * 2048 + c * 256; qi0 = (qb & 1) * 128; }
    else { const int it = item - 256; qb = it & 1; h = (it >> 1) & 3; b = it >> 3; c = 0; rowc = b * 256; qi0 = qb * 128; }
    const int qi = qi0 + w * 16 + lc;
    const size_t rowq = (size_t)(rowc + qi);
    const float lgf = ret_logg(p, l, 0, h), lgb = ret_logg(p, l, 1, h);
    const int nstep = lat ? 8 : 4;
    auto dma_step = [&](int sI) __attribute__((always_inline)) {
        LAS unsigned char* base = (LAS unsigned char*)lds + (sI & 1) * 49152;
        if (sI < 4) {
#pragma unroll
            for (int i = 0; i < 2; ++i) {
                const int q = w * 2 + i, row = 4 * q + (lane >> 4), lch = (lane & 15) ^ (row & 15);
                __builtin_amdgcn_global_load_lds((const unsigned*)(Pb + (size_t)(rowc + sI * 64 + row) * PW + C_RK + h * 128 + lch * 8), (LAS unsigned*)(base + q * 1024), 16, 0, 0);
            }
#pragma unroll
            for (int i = 0; i < 4; ++i) {
                const int q = w * 4 + i, row = 8 * q + (lane >> 3), lch = (lane & 7) ^ ((row >> 1) & 7);
                __builtin_amdgcn_global_load_lds((const unsigned*)(RVT + (size_t)(h * 256 + row) * M + rowc + sI * 64 + lch * 8), (LAS unsigned*)(base + 16384 + q * 1024), 16, 0, 0);
            }
        } else {
            const int dir = (sI - 4) >> 1, kh = (sI - 4) & 1;
            const bf16_t* Sg = ws_bf(p, OFF_RS) + ((size_t)((b * 4 + h) * 2 + dir) * 8 + c) * 32768;
#pragma unroll
            for (int i = 0; i < 4; ++i) {
                const int q = w * 4 + i, row = 8 * q + (lane >> 3), lch = (lane & 7) ^ ((row >> 1) & 7);
                __builtin_amdgcn_global_load_lds((const unsigned*)(Sg + (size_t)row * 128 + kh * 64 + lch * 8), (LAS unsigned*)(base + 16384 + q * 1024), 16, 0, 0);
            }
        }
    };
    dma_step(0);
    f32x4 acc[16];
#pragma unroll
    for (int df = 0; df < 16; ++df) acc[df] = (f32x4){0.f, 0.f, 0.f, 0.f};
    const int vsw = (lc >> 1) & 7;
    unsigned char* qsave = lds + 98304 + tid * 64;
    {
        bf16x8 qfr[4];
#pragma unroll
        for (int ks = 0; ks < 4; ++ks) { qfr[ks] = *(const bf16x8*)(Pb + rowq * PW + C_RQ + h * 128 + ks * 32 + g * 8); *(bf16x8*)(qsave + ks * 16) = qfr[ks]; }
#pragma unroll 1
        for (int sI = 0; sI < 4; ++sI) {
            asm volatile("s_waitcnt vmcnt(0)" ::: "memory");
            __syncthreads();
            if (sI + 1 < nstep) dma_step(sI + 1);
            const unsigned char* Ks = lds + (sI & 1) * 49152;
            const unsigned char* Vt = Ks + 16384;
            f32x4 sc[4];
#pragma unroll
            for (int kf = 0; kf < 4; ++kf) sc[kf] = (f32x4){0.f, 0.f, 0.f, 0.f};
#pragma unroll
            for (int kb = 0; kb < 2; ++kb) {
                bf16x8 ak[2][4];
#pragma unroll
                for (int k2 = 0; k2 < 2; ++k2)
#pragma unroll
                    for (int kf = 0; kf < 4; ++kf) ak[k2][kf] = *(const bf16x8*)(Ks + (kf * 16 + lc) * 256 + ((((kb * 2 + k2) * 4 + g) ^ lc) << 4));
                __builtin_amdgcn_sched_barrier(0);
#pragma unroll
                for (int k2 = 0; k2 < 2; ++k2)
#pragma unroll
                    for (int kf = 0; kf < 4; ++kf) sc[kf] = __builtin_amdgcn_mfma_f32_16x16x32_bf16(ak[k2][kf], qfr[kb * 2 + k2], sc[kf], 0, 0, 0);
                __builtin_amdgcn_sched_barrier(0);
            }
            bf16x8 pb[2];
#pragma unroll
            for (int kf = 0; kf < 4; ++kf)
#pragma unroll
                for (int r = 0; r < 4; ++r) {
                    const int dd = qi - (sI * 64 + kf * 16 + g * 4 + r);
                    float wgt = 0.f;
                    if (dd >= 0) wgt += __expf(lgf * (float)dd);
                    if (dd <= 0) wgt += __expf(lgb * (float)(-dd));
                    pb[kf >> 1][(kf & 1) * 4 + r] = (short)f2bf(sc[kf][r] * wgt);
                }
#pragma unroll
            for (int s2 = 0; s2 < 2; ++s2)
#pragma unroll
                for (int db = 0; db < 2; ++db) {
                    uint2 lo[8], hi[8];
#pragma unroll
                    for (int j = 0; j < 8; ++j) {
                        const unsigned char* vr = Vt + ((db * 8 + j) * 16 + lc) * 128 + 8 * (g & 1);
                        lo[j] = *(const uint2*)(vr + (((4 * s2 + (g >> 1)) ^ vsw) << 4));
                        hi[j] = *(const uint2*)(vr + (((4 * s2 + 2 + (g >> 1)) ^ vsw) << 4));
                    }
                    __builtin_amdgcn_sched_barrier(0);
#pragma unroll
                    for (int j = 0; j < 8; ++j) {
                        union { uint4 u; bf16x8 v; } av; av.u = make_uint4(lo[j].x, lo[j].y, hi[j].x, hi[j].y);
                        acc[db * 8 + j] = __builtin_amdgcn_mfma_f32_16x16x32_bf16(av.v, pb[s2], acc[db * 8 + j], 0, 0, 0);
                    }
                    __builtin_amdgcn_sched_barrier(0);
                }
        }
    }
    if (lat) {
#pragma unroll 1
        for (int dir = 0; dir < 2; ++dir) {
            const float qs = dir == 0 ? __expf(lgf * (float)(qi + 1)) : __expf(lgb * (float)(256 - qi));
            bf16x8 qx[4];
#pragma unroll
            for (int ks = 0; ks < 4; ++ks) {
                const bf16x8 qv = *(const bf16x8*)(qsave + ks * 16);
#pragma unroll
                for (int e = 0; e < 8; ++e) qx[ks][e] = (short)f2bf(qs * bf2f((bf16_t)qv[e]));
            }
#pragma unroll
            for (int kh = 0; kh < 2; ++kh) {
                const int sI = 4 + dir * 2 + kh;
                asm volatile("s_waitcnt vmcnt(0)" ::: "memory");
                __syncthreads();
                if (sI + 1 < nstep) dma_step(sI + 1);
                const unsigned char* Vt = lds + (sI & 1) * 49152 + 16384;
#pragma unroll
                for (int db = 0; db < 4; ++db) {
                    bf16x8 as0[4], as1[4];
#pragma unroll
                    for (int j = 0; j < 4; ++j) {
                        as0[j] = *(const bf16x8*)(Vt + ((db * 4 + j) * 16 + lc) * 128 + (((0 + g) ^ vsw) << 4));
                        as1[j] = *(const bf16x8*)(Vt + ((db * 4 + j) * 16 + lc) * 128 + (((4 + g) ^ vsw) << 4));
                    }
                    __builtin_amdgcn_sched_barrier(0);
#pragma unroll
                    for (int j = 0; j < 4; ++j) {
                        acc[db * 4 + j] = __builtin_amdgcn_mfma_f32_16x16x32_bf16(as0[j], qx[kh * 2 + 0], acc[db * 4 + j], 0, 0, 0);
                        acc[db * 4 + j] = __builtin_amdgcn_mfma_f32_16x16x32_bf16(as1[j], qx[kh * 2 + 1], acc[db * 4 + j], 0, 0, 0);
                    }
                    __builtin_amdgcn_sched_barrier(0);
                }
            }
        }
    }
    float s1 = 0.f;
#pragma unroll
    for (int df = 0; df < 16; ++df) s1 += (acc[df][0] + acc[df][1]) + (acc[df][2] + acc[df][3]);
    s1 = xrow16_sum(s1);
    const float mu = s1 * (1.f / 256.f);
    float s2 = 0.f;
#pragma unroll
    for (int df = 0; df < 16; ++df)
#pragma unroll
        for (int r = 0; r < 4; ++r) { const float xc = acc[df][r] - mu; s2 += xc * xc; }
    s2 = xrow16_sum(s2);
    const float rstd = rsqrtf(s2 * (1.f / 256.f) + EPS);
#pragma unroll
    for (int df = 0; df < 16; ++df) {
        bf16_t* gp = Pb + rowq * PW + C_RG + h * 256 + df * 16 + g * 4;
        const uint2 gv = *(const uint2*)gp;
        uint2 o;
        o.x = pk2((acc[df][0] - mu) * rstd * __uint_as_float(gv.x << 16), (acc[df][1] - mu) * rstd * __uint_as_float(gv.x & 0xffff0000u));
        o.y = pk2((acc[df][2] - mu) * rstd * __uint_as_float(gv.y << 16), (acc[df][3] - mu) * rstd * __uint_as_float(gv.y & 0xffff0000u));
        *(uint2*)gp = o;
    }
}
DEV void phase_ret_out(CParams& p, int l, unsigned char* lds) {
    if (GDIM() == 256) {
        const int xg = BIDX() & 7, j = BIDX() >> 3;
        ret_out_tile(p, l, ((j >> 1) * 8 + xg) * 2 + (j & 1), lds);
        if (j < 16) ret_out_tile(p, l, 256 + ((j >> 1) * 8 + xg) * 2 + (j & 1), lds);
        return;
    }
    for (int item = BIDX(); item < 384; item += GDIM()) ret_out_tile(p, l, item, lds);
}

template <bool REV>
DEV void lru_scan16(const float (&a)[4][4], const float (&u)[4][4], float cin, int g, int lc, float (&h)[4][4], float& cout, float& Aprod) {
    float carry = cin, Ap = 1.f;
#pragma unroll
    for (int ii = 0; ii < 4; ++ii) {
        const int i = REV ? 3 - ii : ii;
        float hl[4], cp[4];
        {
            float hh = 0.f, cc = 1.f;
#pragma unroll
            for (int rr = 0; rr < 4; ++rr) { const int r = REV ? 3 - rr : rr; hh = a[i][r] * hh + u[i][r]; cc *= a[i][r]; hl[r] = hh; cp[r] = cc; }
        }
        const float As = REV ? cp[0] : cp[3], Hs = REV ? hl[0] : hl[3];
        float Ag[4], Hg[4];
        xrow16_gather(As, Ag); xrow16_gather(Hs, Hg);
        float cur = carry, mine = carry;
#pragma unroll
        for (int sI = 0; sI < 4; ++sI) {
            const int gg = REV ? 3 - sI : sI;
            mine = (g == gg) ? cur : mine;
            cur = Ag[gg] * cur + Hg[gg];
            Ap *= Ag[gg];
        }
        carry = cur;
#pragma unroll
        for (int r = 0; r < 4; ++r) h[i][r] = hl[r] + cp[r] * mine;
    }
    cout = carry; Aprod = Ap;
}

template <bool REV>
DEV void lru_dir(const unsigned char* xa, const bf16x8 (&bA)[4], const bf16x8 (&bX)[4], float ba, float bx, float c2, float cin,
                 const float (&x)[4][4], int g, int lc, float (&h)[4][4], float& cout, float& Ap) {
    f32x4 accA[4], accX[4];
#pragma unroll
    for (int i = 0; i < 4; ++i) { accA[i] = (f32x4){0.f, 0.f, 0.f, 0.f}; accX[i] = (f32x4){0.f, 0.f, 0.f, 0.f}; }
#pragma unroll
    for (int ks = 0; ks < 4; ++ks)
#pragma unroll
        for (int i = 0; i < 4; ++i) {
            const bf16x8 af = *(const bf16x8*)(xa + (i * 16 + lc) * 256 + (((ks * 4 + g) ^ lc) << 4));
            accA[i] = __builtin_amdgcn_mfma_f32_16x16x32_bf16(af, bA[ks], accA[i], 0, 0, 0);
            accX[i] = __builtin_amdgcn_mfma_f32_16x16x32_bf16(af, bX[ks], accX[i], 0, 0, 0);
        }
    float a[4][4], u[4][4];
#pragma unroll
    for (int i = 0; i < 4; ++i)
#pragma unroll
        for (int r = 0; r < 4; ++r) {
            const float rg = sigmf(accA[i][r] + ba), ig = sigmf(accX[i][r] + bx);
            const float av = __builtin_amdgcn_exp2f(rg * c2);
            a[i][r] = av;
            u[i][r] = __builtin_amdgcn_sqrtf(fmaxf(1.f - av * av, 0.f)) * (ig * x[i][r]);
        }
    lru_scan16<REV>(a, u, cin, g, lc, h, cout, Ap);
}

DEV void phase_lru_tiles(CParams& p, int l, int mode, unsigned char* lds) {
    unsigned char* xa = lds; float* hs = (float*)(lds + 16384); float* cwl = (float*)(lds + 49152); unsigned char* rawb = lds + 53248;
    bf16_t* Pb = ws_bf(p, OFF_P);
    const int tid = TIDX(), lane = tid & 63, w = __builtin_amdgcn_readfirstlane(tid >> 6), g = lane >> 4, lc = lane & 15;
    const int blk = BIDX() & 7, gstep = GDIM() >> 3;
    const int cl = w * 16 + lc, ch = blk * 128 + cl;
    for (int e = tid; e < 5 * 128; e += 512) {
        const int j = e >> 7, c = e & 127;
        cwl[e] = j < 4 ? p.conv_w[(size_t)(l * 4 + j) * D + blk * 128 + c] : p.conv_b[(size_t)l * D + blk * 128 + c];
    }
    bf16x8 bAf[4], bXf[4], bAb[4], bXb[4];
    {
        const bf16_t* W = ws_bf(p, OFF_LRUW) + ((size_t)blk * 128 + cl) * 128 + g * 8;
#pragma unroll
        for (int ks = 0; ks < 4; ++ks) {
            bAf[ks] = *(const bf16x8*)(W + ks * 32);
            bXf[ks] = *(const bf16x8*)(W + (size_t)1 * 8 * 16384 + ks * 32);
            bAb[ks] = *(const bf16x8*)(W + (size_t)2 * 8 * 16384 + ks * 32);
            bXb[ks] = *(const bf16x8*)(W + (size_t)3 * 8 * 16384 + ks * 32);
        }
    }
    const float baF = p.lru_ba[(l * 2 + 0) * D + ch], bxF = p.lru_bx[(l * 2 + 0) * D + ch];
    const float baB = p.lru_ba[(l * 2 + 1) * D + ch], bxB = p.lru_bx[(l * 2 + 1) * D + ch];
    const float c2F = -8.f * 1.4426950408889634f * softplusf(-p.lru_lambda[(l * 2 + 0) * D + ch]);
    const float c2B = -8.f * 1.4426950408889634f * softplusf(-p.lru_lambda[(l * 2 + 1) * D + ch]);
    float* LA = (float*)(p.ws + OFF_LRUC);
    float* LH = LA + 192 * 2 * 1024;
    const int chunk = tid & 15, chb = blk * 128 + chunk * 8, trow = tid >> 4;
#define LRU_PREFETCH(gcn) do { const bf16_t* src_ = Pb + (long)((gcn) * 64 - 1 + (lane >> 4)) * (long)PW + C_LX + blk * 128 + (lane & 15) * 8; \
        _Pragma("unroll") for (int q_ = 0; q_ < 3; ++q_) { const int qq_ = w + 8 * q_; if (qq_ < 17) \
            __builtin_amdgcn_global_load_lds((const unsigned*)(src_ + (long)qq_ * 4 * PW), (LAS unsigned*)((LAS unsigned char*)rawb + qq_ * 1024), 16, 0, 0); } } while (0)
    int gc = BIDX() >> 3;
    if (gc < 192) LRU_PREFETCH(gc);
    for (; gc < 192; gc += gstep) {
        const int m0 = gc * 64;
        const bool lat = m0 >= NCTX;
        const int L = lat ? 2048 : 256, t0 = lat ? ((m0 - NCTX) & 2047) : (m0 & 255);
        asm volatile("s_waitcnt vmcnt(0)" ::: "memory");
        __syncthreads();
#pragma unroll
        for (int i = 0; i < 2; ++i) {
            const int tt = trow + 32 * i;
            float acc[8];
#pragma unroll
            for (int e = 0; e < 8; ++e) acc[e] = cwl[4 * 128 + chunk * 8 + e];
#pragma unroll
            for (int j = 0; j < 4; ++j) {
                const int tp = t0 + tt + j - 1;
                if (tp >= 0 && tp < L) {
                    const uint4 v = *(const uint4*)(rawb + (tt + j) * 256 + chunk * 16);
                    const float* cw = cwl + j * 128 + chunk * 8;
                    acc[0] += cw[0] * __uint_as_float(v.x << 16); acc[1] += cw[1] * __uint_as_float(v.x & 0xffff0000u);
                    acc[2] += cw[2] * __uint_as_float(v.y << 16); acc[3] += cw[3] * __uint_as_float(v.y & 0xffff0000u);
                    acc[4] += cw[4] * __uint_as_float(v.z << 16); acc[5] += cw[5] * __uint_as_float(v.z & 0xffff0000u);
                    acc[6] += cw[6] * __uint_as_float(v.w << 16); acc[7] += cw[7] * __uint_as_float(v.w & 0xffff0000u);
                }
            }
            uint4 o;
            o.x = pk2(acc[0], acc[1]); o.y = pk2(acc[2], acc[3]);
            o.z = pk2(acc[4], acc[5]); o.w = pk2(acc[6], acc[7]);
            *(uint4*)(xa + tt * 256 + ((chunk ^ (tt & 15)) << 4)) = o;
        }
        __syncthreads();
        if (gc + gstep < 192) LRU_PREFETCH(gc + gstep);
        const size_t ci = ((size_t)gc * 2) * 1024 + ch;
        const float cinF = mode ? LH[ci] : 0.f, cinB = mode ? LH[ci + 1024] : 0.f;
        uint4 gv[2];
        if (mode) {
#pragma unroll
            for (int i = 0; i < 2; ++i) gv[i] = *(const uint4*)(Pb + (size_t)(m0 + trow + 32 * i) * PW + C_LG + chb);
        }
        {
            float x[4][4];
#pragma unroll
            for (int i = 0; i < 4; ++i)
#pragma unroll
                for (int r = 0; r < 4; ++r) {
                    const int tok = i * 16 + g * 4 + r;
                    x[i][r] = bf2f(*(const bf16_t*)(xa + tok * 256 + (((cl >> 3) ^ (tok & 15)) << 4) + (cl & 7) * 2));
                }
            float h[4][4], cout, Ap;
            lru_dir<false>(xa, bAf, bXf, baF, bxF, c2F, cinF, x, g, lc, h, cout, Ap);
            if (!mode) { if (g == 0) { LA[ci] = Ap; LH[ci] = cout; } }
            else {
#pragma unroll
                for (int i = 0; i < 4; ++i)
#pragma unroll
                    for (int r = 0; r < 4; ++r) hs[(i * 16 + g * 4 + r) * 128 + cl] = h[i][r];
                if (!lat && g == 0 && t0 == 192) p.out[O_NLRU + ((size_t)((m0 >> 8) * 2 + l) * 2 + 0) * 1024 + ch] = cout;
            }
            lru_dir<true>(xa, bAb, bXb, baB, bxB, c2B, cinB, x, g, lc, h, cout, Ap);
            if (!mode) { if (g == 0) { LA[ci + 1024] = Ap; LH[ci + 1024] = cout; } }
            else {
#pragma unroll
                for (int i = 0; i < 4; ++i)
#pragma unroll
                    for (int r = 0; r < 4; ++r) hs[(i * 16 + g * 4 + r) * 128 + cl] += h[i][r];
                if (!lat && g == 0 && t0 == 0) p.out[O_NLRU + ((size_t)((m0 >> 8) * 2 + l) * 2 + 1) * 1024 + ch] = cout;
            }
        }
        if (mode) {
            __syncthreads();
#pragma unroll
            for (int i = 0; i < 2; ++i) {
                const int tt = trow + 32 * i, c8 = chunk * 8;
                const float4 h0 = *(const float4*)(hs + tt * 128 + c8), h1 = *(const float4*)(hs + tt * 128 + c8 + 4);
                uint4 o;
                o.x = pk2(h0.x * __uint_as_float(gv[i].x << 16), h0.y * __uint_as_float(gv[i].x & 0xffff0000u));
                o.y = pk2(h0.z * __uint_as_float(gv[i].y << 16), h0.w * __uint_as_float(gv[i].y & 0xffff0000u));
                o.z = pk2(h1.x * __uint_as_float(gv[i].z << 16), h1.y * __uint_as_float(gv[i].z & 0xffff0000u));
                o.w = pk2(h1.z * __uint_as_float(gv[i].w << 16), h1.w * __uint_as_float(gv[i].w & 0xffff0000u));
                *(uint4*)(Pb + (size_t)(m0 + tt) * PW + C_LG + chb) = o;
            }
        }
    }
    asm volatile("s_waitcnt vmcnt(0)" ::: "memory");
    __syncthreads();
#undef LRU_PREFETCH
}

DEV void phase_lru_carry(CParams& p, int l, int vb, int nvb) {
    float* LA = (float*)(p.ws + OFF_LRUC);
    float* LH = LA + 192 * 2 * 1024;
    const int gt = vb * 512 + TIDX(), gs = nvb * 512;
    for (int idx = gt; idx < 20 * 2 * 1024; idx += gs) {
        const int ch = idx & 1023, dir = (idx >> 10) & 1, seq = idx >> 11;
        const bool lat = seq >= 16;
        const int nch = lat ? 32 : 4;
        const int gc0 = lat ? 64 + (seq - 16) * 32 : seq * 4;
        float carry = lat ? p.state_lru[((size_t)((seq - 16) * 2 + l) * 2 + dir) * 1024 + ch] : 0.f;
        for (int s0 = 0; s0 < nch; s0 += 4) {
            float A[4], Hh[4]; size_t ci[4];
#pragma unroll
            for (int k = 0; k < 4; ++k) {
                const int sI = s0 + k, cidx = dir == 0 ? sI : nch - 1 - sI;
                ci[k] = ((size_t)(gc0 + cidx) * 2 + dir) * 1024 + ch;
                A[k] = LA[ci[k]]; Hh[k] = LH[ci[k]];
            }
#pragma unroll
            for (int k = 0; k < 4; ++k) { LH[ci[k]] = carry; carry = A[k] * carry + Hh[k]; }
        }
    }
}

DEV CParams* KARGS() { CParams* kp = (CParams*)__builtin_amdgcn_kernarg_segment_ptr(); asm volatile("" : "+s"(kp)); return kp; }

#define XB_TMO      128
#define XB_XCNT(j)  (256  + 64 * (j))
#define XB_XSUB(j)  (1280 + 64 * (j))
#define XB_XGEN(j)  (2304 + 64 * (j))
#define XB_TOP      3328
#define XB_TOPGEN   3392
#define XCD_BAR_WORDS 3456
#define XB_SPIN_CAP (1u << 18)
DEV unsigned xb_ld(unsigned* p)              { return __hip_atomic_load(p, __ATOMIC_RELAXED, __HIP_MEMORY_SCOPE_AGENT); }
DEV unsigned xb_add(unsigned* p, unsigned v) { return __hip_atomic_fetch_add(p, v, __ATOMIC_RELAXED, __HIP_MEMORY_SCOPE_AGENT); }
DEV unsigned xb_xcc_id() { return (unsigned)__builtin_amdgcn_s_getreg((3 << 11) | 20) & 0xFu; }
#define XB_SPIN(cond, bar) do { unsigned _sp = 0; while (cond) { __builtin_amdgcn_s_sleep(1); \
    if ((++_sp & 255u) == 0u) { if (xb_ld(&(bar)[XB_TMO])) break; if (_sp > XB_SPIN_CAP) { atomicAdd(&(bar)[XB_TMO], 1u); break; } } } } while (0)
struct XcdBarrier { unsigned* bar; unsigned x; volatile LAS unsigned* st; };
DEV XcdBarrier xcd_barrier_post(unsigned* bar, volatile LAS unsigned* st) {
    XcdBarrier b; b.bar = bar; b.x = xb_xcc_id(); b.st = st;
    if (threadIdx.x == 0) (void)xb_add(&bar[XB_XCNT(b.x)], 1u);
    return b;
}
DEV void xcd_barrier_complete(unsigned* bar, unsigned x, unsigned& nloc, unsigned& nx) {
    const unsigned G = gridDim.x * gridDim.y * gridDim.z;
    unsigned sum, cnt, mine, sp = 0u;
    for (;;) {
        sum = 0u; cnt = 0u; mine = 0u;
#pragma unroll
        for (unsigned j = 0; j < 16; ++j) { const unsigned c = xb_ld(&bar[XB_XCNT(j)]); sum += c; cnt += (c > 0u) ? 1u : 0u; mine = (j == x) ? c : mine; }
        if (sum == G) break;
        __builtin_amdgcn_s_sleep(1);
        if ((++sp & 255u) == 0u) { if (xb_ld(&bar[XB_TMO])) break; if (sp > XB_SPIN_CAP) { atomicAdd(&bar[XB_TMO], 1u); break; } }
    }
    nloc = mine > 0u ? mine : 1u; nx = cnt > 0u ? cnt : 1u;
}
DEV void xcd_barrier(const XcdBarrier& b0) {
    asm volatile("s_waitcnt vmcnt(0)" ::: "memory");
    __syncthreads();
    if (threadIdx.x == 0) {
        XcdBarrier b; b.x = b0.x; b.st = b0.st;
        asm volatile("" : "+s"(b.x));
        unsigned* bar = (unsigned*)(KARGS()->ws + OFF_BAR);
        __builtin_amdgcn_s_waitcnt(0);
        unsigned nloc = b.st[0], nx = b.st[1];
        if (nloc == 0u) { xcd_barrier_complete(bar, b.x, nloc, nx); b.st[0] = nloc; b.st[1] = nx; }
        const unsigned old = xb_add(&bar[XB_XSUB(b.x)], 1u);
        const unsigned gen = old / nloc;
        if (old + 1u == (gen + 1u) * nloc) {
            __builtin_amdgcn_fence(__ATOMIC_RELEASE, "agent");
            asm volatile("s_waitcnt vmcnt(0)" ::: "memory");
            const unsigned og = xb_add(&bar[XB_TOP], 1u);
            const unsigned tg = og / nx;
            if (og + 1u == (tg + 1u) * nx) xb_add(&bar[XB_TOPGEN], 1u);
            else XB_SPIN(xb_ld(&bar[XB_TOPGEN]) == tg, bar);
            __builtin_amdgcn_fence(__ATOMIC_ACQUIRE, "agent");
            xb_add(&bar[XB_XGEN(b.x)], 1u);
            asm volatile("s_waitcnt vmcnt(0)" ::: "memory");
        } else {
            XB_SPIN(xb_ld(&bar[XB_XGEN(b.x)]) == gen, bar);
            __builtin_amdgcn_fence(__ATOMIC_ACQUIRE, "agent");
            asm volatile("s_waitcnt vmcnt(0)" ::: "memory");
        }
    }
    __syncthreads();
}

enum { PH_INIT = 0, PH_PRENORM, PH_GEMM1, PH_MIX1, PH_MIX2, PH_MIX3, PH_MERGE, PH_OUT, PH_COUNT };

DEV void run_phase(CParams& p, int ph, int l, unsigned char* lds) {
    switch (ph) {
    case PH_INIT:    phase_mod(p, (float*)lds); phase_rope_table(p); __syncthreads(); phase_convert(p, 0, (float*)lds); break;
    case PH_PRENORM: phase_prenorm(p, l); break;
    case PH_GEMM1:   phase8_gemm1(p, l, (LAS unsigned char*)lds); break;
    case PH_MIX1:    phase_attn(p, l, lds); __syncthreads(); phase_lru_tiles(p, l, 0, lds); __syncthreads(); phase_ret_kv(p, l, lds); break;
    case PH_MIX2:
        if (GDIM() == 256) {
            if (BIDX() < 192) phase8_merge(p, l, 2, (LAS unsigned char*)lds);
            else { phase_lru_carry(p, l, BIDX() - 192, 64); phase_ret_scan(p, l, BIDX() - 192, 64); }
        } else { phase_lru_carry(p, l, BIDX(), GDIM()); phase_ret_scan(p, l, BIDX(), GDIM()); }
        if (l == 1) phase_convert(p, 1, (float*)lds, 2);
        break;
    case PH_MIX3:    phase_lru_tiles(p, l, 1, lds); __syncthreads(); phase_ret_out(p, l, lds); break;
    case PH_MERGE:   phase8_merge(p, l, 0, (LAS unsigned char*)lds); break;
    case PH_OUT:     phase8_out(p, l, (LAS unsigned char*)lds); if (l == 0) phase_convert(p, 1, (float*)lds, 1, 192); break;
    }
}

#if !ONE_LAUNCH
__global__ void __launch_bounds__(512, 2) phase_kernel(Params p, int ph, int l) {
    extern __shared__ __attribute__((aligned(16))) unsigned char dsm[];
    run_phase(p, ph, l, dsm);
}
#else
#ifndef PROBE_MASK
#define PROBE_MASK 0
#endif
#define PROBE_MULT 8
__global__ void __launch_bounds__(512, 2) mega_kernel(Params p) {
    extern __shared__ __attribute__((aligned(16))) unsigned char dsm[];
    cg::grid_group grid = cg::this_grid();
    volatile LAS unsigned* st = (volatile LAS unsigned*)((LAS unsigned char*)dsm + g8::STAGE_BYTES);
    if (threadIdx.x < 4) st[threadIdx.x] = 0u;
    __syncthreads();
    const XcdBarrier xb = xcd_barrier_post((unsigned*)(KARGS()->ws + OFF_BAR), st);
#define GSYNC() xcd_barrier(xb)
#if PROBE_MASK
    long long t_acc = 0, t0 = 0;
#define PROBE_BEGIN(ph) if ((PROBE_MASK >> (ph)) & 1) t0 = wall_clock64();
#define PROBE_END(ph) if ((PROBE_MASK >> (ph)) & 1) t_acc += wall_clock64() - t0;
#else
#define PROBE_BEGIN(ph)
#define PROBE_END(ph)
#endif
    if (KARGS()->out == nullptr) grid.sync();
    PROBE_BEGIN(PH_INIT) run_phase(*KARGS(), PH_INIT, 0, dsm); GSYNC(); PROBE_END(PH_INIT)
    PROBE_BEGIN(PH_PRENORM) run_phase(*KARGS(), PH_PRENORM, 0, dsm); GSYNC(); PROBE_END(PH_PRENORM)
    for (int l = 0; l < 2; ++l) {
        for (int ph = PH_GEMM1; ph <= PH_OUT; ++ph) {
            PROBE_BEGIN(ph)
            run_phase(*KARGS(), ph, l, dsm);
            if (!(l == 1 && ph == PH_OUT)) GSYNC();
            PROBE_END(ph)
        }
    }
#if PROBE_MASK
    if (blockIdx.x == 0 && threadIdx.x == 0) {
        const long long tgt = wall_clock64() + (long long)PROBE_MULT * t_acc;
        while (wall_clock64() < tgt) __builtin_amdgcn_s_sleep(8);
    }
#endif
}
#endif

extern "C" void kernel_launch(void* const* d_in, const int* in_sizes, int n_in,
                              void* d_out, int out_size, void* d_ws, size_t ws_size,
                              hipStream_t stream) {
    constexpr size_t kDynLds = LDS_XOFF + 5120;
    static int grid_blocks = 0;
    if (grid_blocks == 0) {
        if (n_in != 26 || ws_size < WS_NEED || out_size != 25231360) {
            fprintf(stderr, "kernel_launch: unexpected n_in %d / ws_size %zu (need %zu) / out_size %d\n", n_in, ws_size, (size_t)WS_NEED, out_size);
            grid_blocks = -1; return;
        }
        int dev = 0, cus = 0, per_cu = 0;
        (void)hipGetDevice(&dev);
        (void)hipDeviceGetAttribute(&cus, hipDeviceAttributeMultiprocessorCount, dev);
#if ONE_LAUNCH
        const void* kfn = (const void*)mega_kernel;
#else
        const void* kfn = (const void*)phase_kernel;
#endif
        if (hipFuncSetAttribute(kfn, hipFuncAttributeMaxDynamicSharedMemorySize, (int)kDynLds) != hipSuccess) {
            fprintf(stderr, "kernel_launch: hipFuncSetAttribute failed\n"); grid_blocks = -1; return;
        }
        if (hipOccupancyMaxActiveBlocksPerMultiprocessor(&per_cu, kfn, 512, kDynLds) != hipSuccess || per_cu < 1) {
            fprintf(stderr, "kernel_launch: occupancy query says %d blocks per CU\n", per_cu); grid_blocks = -1; return;
        }
        grid_blocks = cus & ~7;
    }
    if (grid_blocks < 0) return;
    Params p{};
    const float** pp = (const float**)&p;
    for (int i = 0; i < 26; ++i) pp[i] = (const float*)d_in[i];
    p.out = (float*)d_out;
    p.ws = (unsigned char*)d_ws;
#if ONE_LAUNCH
    (void)hipMemsetAsync((unsigned char*)d_ws + OFF_BAR, 0, 16384 + 1024, stream);
    void* args[] = {&p};
    hipError_t e = hipLaunchCooperativeKernel((const void*)mega_kernel, dim3(grid_blocks), dim3(512), args, kDynLds, stream);
    if (e != hipSuccess) fprintf(stderr, "cooperative launch failed: %s (grid %d)\n", hipGetErrorString(e), grid_blocks);
#else
    phase_kernel<<<grid_blocks, 512, kDynLds, stream>>>(p, PH_INIT, 0);
    phase_kernel<<<grid_blocks, 512, kDynLds, stream>>>(p, PH_PRENORM, 0);
    for (int l = 0; l < 2; ++l)
        for (int ph = PH_GEMM1; ph <= PH_OUT; ++ph)
            phase_kernel<<<grid_blocks, 512, kDynLds, stream>>>(p, ph, l);
#endif
}
```

```cpp
#include <hip/hip_runtime.h>
#include <hip/hip_cooperative_groups.h>
#include <cstdio>
#include <cstdint>
namespace cg = cooperative_groups;

#ifndef ONE_LAUNCH
#define ONE_LAUNCH 1
#endif

typedef unsigned short bf16_t;
#define DEV __device__ __forceinline__

constexpr int D = 1024;
constexpr int NCTX = 4096;
constexpr int NLAT = 8192;
constexpr int M = NCTX + NLAT;
constexpr int NW = 7680;
constexpr int N_RQ = 0, N_RK = 512, N_RV = 1024, N_RG = 2048, N_LX = 3072, N_LG = 4096,
              N_AQ = 5120, N_AK = 6144, N_AV = 6400, N_AG = 6656;
constexpr int PW = 6656;
constexpr int C_RQ = 0, C_RK = 512, C_RG = 1024, C_LX = 2048, C_LG = 3072,
              C_AQ = 4096, C_AK = 5120, C_AV = 5376, C_AG = 5632;
constexpr float EPS = 1e-6f;

constexpr size_t O_YP = 0, O_YS = 4194304, O_NK = 12582912, O_NV = 14680064, O_NRET = 16777216, O_NLRU = 25165824;

constexpr size_t OFF_MOD  = 0;
constexpr size_t OFF_LRUW = 122880;
constexpr size_t OFF_WBR  = OFF_LRUW + 1048576;
constexpr size_t OFF_WOUT = OFF_WBR + 6291456;
constexpr size_t OFF_WMG  = OFF_WOUT + 2097152;
constexpr size_t OFF_H    = OFF_WMG + 6291456;
constexpr size_t OFF_P    = OFF_H + (size_t)M * 1024 * 2;
constexpr size_t OFF_RVT  = OFF_P + (size_t)M * PW * 2;
constexpr size_t OFF_W1T  = OFF_RVT + (size_t)1024 * M * 2;
constexpr size_t OFF_OFTMP = OFF_W1T;
constexpr size_t OFF_LRUC = 262266880;
constexpr size_t OFF_ROPE = OFF_LRUC + (size_t)2 * 192 * 2 * 1024 * 4;
constexpr size_t OFF_BAR  = OFF_ROPE + (size_t)2048 * 96 * 8;
constexpr size_t OFF_XC   = OFF_BAR + 16384;
constexpr size_t OFF_XP   = OFF_XC + 1024;
constexpr size_t WS_NEED  = OFF_XP + 983040;
constexpr int LDS_XOFF = 131072 + 64;
static_assert(OFF_OFTMP + (size_t)M * 1024 * 2 <= OFF_LRUC, "overlap");
static_assert(WS_NEED <= 268435456, "ws budget");

struct Params;
typedef const __attribute__((address_space(4))) Params CParams;
struct Params {
    const float *x_prompt, *x_sample, *cache_k, *cache_v, *state_ret, *state_lru, *c, *c_ctx,
                *w_ada, *b_ada, *norm_pre, *norm_post, *w_in, *ret_decay, *conv_w, *conv_b,
                *lru_wa, *lru_ba, *lru_wx, *lru_bx, *lru_lambda, *att_sink, *w_branch, *w_merge, *b_merge, *w_out;
    float* out;
    unsigned char* ws;
};

DEV int BIDX() { int b = (int)blockIdx.x; asm volatile("" : "+s"(b)); return b; }
DEV int GDIM() { int g = (int)gridDim.x; asm volatile("" : "+s"(g)); return g; }
DEV int TIDX() { int t = threadIdx.x; asm volatile("" : "+v"(t)); return t; }
DEV float bf2f(bf16_t v) { return __uint_as_float(((unsigned)v) << 16); }
typedef __bf16 bf16x2_t __attribute__((ext_vector_type(2)));
DEV bf16_t f2bf(float f) { return __builtin_bit_cast(unsigned short, (__bf16)f); }
DEV unsigned pk2(float lo, float hi) { bf16x2_t v; v[0] = (__bf16)lo; v[1] = (__bf16)hi; return __builtin_bit_cast(unsigned, v); }
DEV float sigmf(float z) { return __builtin_amdgcn_rcpf(1.f + __builtin_amdgcn_exp2f(-1.4426950408889634f * z)); }
DEV float siluf(float x) { return x * sigmf(x); }
DEV float softplusf(float x) { return fmaxf(x, 0.f) + log1pf(__expf(-fabsf(x))); }

DEV float* ws_mod(CParams& p) { return (float*)(p.ws + OFF_MOD); }
DEV bf16_t* ws_bf(CParams& p, size_t off) { return (bf16_t*)(p.ws + off); }

DEV const float* x_row(CParams& p, int l, int m) {
    const float* xp = p.x_prompt; const float* xs = p.x_sample; const float* po = p.out;
    if (l == 0) return m < NCTX ? xp + (size_t)m * D : xs + (size_t)(m - NCTX) * D;
    return po + (size_t)m * D;
}
DEV int cond_row(int m) { return m < NCTX ? 0 : 1 + ((m - NCTX) >> 11); }

DEV float wave_sum(float v) {
#pragma unroll
    for (int o = 1; o < 64; o <<= 1) v += __shfl_xor(v, o);
    return v;
}
DEV float xrow16_max(float x) {
    auto s = __builtin_amdgcn_permlane16_swap(__float_as_uint(x), __float_as_uint(x), false, false);
    x = fmaxf(__uint_as_float(s[0]), __uint_as_float(s[1]));
    auto t = __builtin_amdgcn_permlane32_swap(__float_as_uint(x), __float_as_uint(x), false, false);
    return fmaxf(__uint_as_float(t[0]), __uint_as_float(t[1]));
}
DEV float xrow16_sum(float x) {
    auto s = __builtin_amdgcn_permlane16_swap(__float_as_uint(x), __float_as_uint(x), false, false);
    x = __uint_as_float(s[0]) + __uint_as_float(s[1]);
    auto t = __builtin_amdgcn_permlane32_swap(__float_as_uint(x), __float_as_uint(x), false, false);
    return __uint_as_float(t[0]) + __uint_as_float(t[1]);
}
DEV void xrow16_gather(float x, float (&v)[4]) {
    auto s = __builtin_amdgcn_permlane16_swap(__float_as_uint(x), __float_as_uint(x), false, false);
    auto e = __builtin_amdgcn_permlane32_swap(s[0], s[0], false, false);
    auto o = __builtin_amdgcn_permlane32_swap(s[1], s[1], false, false);
    v[0] = __uint_as_float(e[0]); v[1] = __uint_as_float(o[0]); v[2] = __uint_as_float(e[1]); v[3] = __uint_as_float(o[1]);
}
DEV void phase_mod(CParams& p, float* lds) {
    float* mod = ws_mod(p);
    float* sl = lds;
    float* part = lds + 1024;
    unsigned* lastf = (unsigned*)(lds + 1024 + 8 * 5 * 256);
    const int tid = TIDX(), lane = tid & 63, w = tid >> 6;
    const float* cctx = p.c_ctx; const float* cb_ = p.c;
    unsigned* MPu = (unsigned*)(p.ws + OFF_XP);
    unsigned* cnt = (unsigned*)(p.ws + OFF_XC) + 192;
    for (int unit = BIDX(); unit < 192; unit += GDIM()) {
        const int ks = unit & 7, cbk = (unit >> 3) % 12, l = unit / 96;
        __syncthreads();
        for (int e = tid; e < 5 * 128; e += 512) { const int r = e >> 7, k = ks * 128 + (e & 127); sl[e] = siluf(r == 0 ? cctx[k] : cb_[(r - 1) * D + k]); }
        __syncthreads();
        const float* wp = p.w_ada + ((size_t)l * D + ks * 128 + w * 16) * 3072 + cbk * 256 + lane * 4;
        float4 acc[5];
#pragma unroll
        for (int r = 0; r < 5; ++r) acc[r] = make_float4(0.f, 0.f, 0.f, 0.f);
#pragma unroll
        for (int k = 0; k < 16; ++k) {
            const float4 wv = *(const float4*)(wp + (size_t)k * 3072);
#pragma unroll
            for (int r = 0; r < 5; ++r) { const float sv = sl[r * 128 + w * 16 + k]; acc[r].x += sv * wv.x; acc[r].y += sv * wv.y; acc[r].z += sv * wv.z; acc[r].w += sv * wv.w; }
        }
#pragma unroll
        for (int r = 0; r < 5; ++r) *(float4*)(part + (w * 5 + r) * 256 + lane * 4) = acc[r];
        __syncthreads();
        unsigned* mp = MPu + (size_t)((l * 12 + cbk) * 8 + ks) * 1280;
        for (int e = tid; e < 1280; e += 512) {
            float v = 0.f;
#pragma unroll
            for (int q = 0; q < 8; ++q) v += part[q * 1280 + e];
            __hip_atomic_store(mp + e, __float_as_uint(v), __ATOMIC_RELAXED, __HIP_MEMORY_SCOPE_AGENT);
        }
        asm volatile("s_waitcnt vmcnt(0)" ::: "memory");
        __syncthreads();
        if (tid == 0) {
            const unsigned old = __hip_atomic_fetch_add(cnt + l * 12 + cbk, 1u, __ATOMIC_RELAXED, __HIP_MEMORY_SCOPE_AGENT);
            if (old == 7u) { __builtin_amdgcn_fence(__ATOMIC_ACQUIRE, "agent"); asm volatile("s_waitcnt vmcnt(0)" ::: "memory"); }
            *lastf = old == 7u ? 1u : 0u;
        }
        __syncthreads();
        if (*lastf) {
            const unsigned* m0 = MPu + (size_t)((l * 12 + cbk) * 8) * 1280;
            for (int e = tid; e < 1280; e += 512) {
                const int r = e >> 8, j = cbk * 256 + (e & 255);
                float v = p.b_ada[l * 3072 + j];
#pragma unroll
                for (int q = 0; q < 8; ++q) v += __uint_as_float(__hip_atomic_load(m0 + q * 1280 + e, __ATOMIC_RELAXED, __HIP_MEMORY_SCOPE_AGENT));
                mod[(size_t)(l * 5 + r) * 3072 + j] = v;
            }
        }
    }
    __syncthreads();
}

DEV void phase_rope_table(CParams& p) {
    float2* tab = (float2*)(p.ws + OFF_ROPE);
    const int gt = BIDX() * blockDim.x + TIDX(), gs = GDIM() * blockDim.x;
    for (int idx = gt; idx < 2048 * 96; idx += gs) {
        const int t = idx / 96, e = idx % 96;
        int a, c; float nq;
        if (e < 64) { a = e >> 5; c = e & 31; nq = 32.f; } else { a = (e - 64) >> 4; c = (e - 64) & 15; nq = 16.f; }
        const float pos = (float)(a ? (t & 63) : (t >> 6));
        const float inv = powf(10000.f, -(float)c / nq);
        float sn, cs; sincosf(pos * inv, &sn, &cs);
        tab[idx] = make_float2(cs, sn);
    }
}

DEV int w1t_row(int n) {
    if (n < N_RV) return (n & ~48) | ((n & 16) << 1) | ((n & 32) >> 1);
    if (n < N_RG) return PW + (n - N_RV);
    return n - 1024;
}
DEV void transpose_tile(const float* src, int K, int N, bf16_t* dst, int k0, int n0, float* tile, bool w1map = false) {
    const int tid = TIDX();
#pragma unroll 4
    for (int i = 0; i < 8; ++i) {
        const int r = i * 8 + (tid >> 6), c = tid & 63;
        tile[r * 65 + c] = src[(size_t)(k0 + r) * N + n0 + c];
    }
    __syncthreads();
    {
        const int n = tid >> 3, kc = tid & 7;
        const int dr = w1map ? w1t_row(n0 + n) : n0 + n;
        const float* t = tile + (kc * 8) * 65 + n;
        uint4 o;
        o.x = pk2(t[0], t[65]);       o.y = pk2(t[130], t[195]);
        o.z = pk2(t[260], t[325]);    o.w = pk2(t[390], t[455]);
        *(uint4*)(dst + (size_t)dr * K + k0 + kc * 8) = o;
    }
    __syncthreads();
}
DEV void phase_convert(CParams& p, int l, float* tile, int which = 0, int start = 0) {
    constexpr int T_IN = 16 * 120, T_MG = 16 * 48, T_BR = 3 * 256, T_OUT = 256, T_LRU = 32 * 4;
    constexpr int TOT = T_IN + T_MG + T_BR + T_OUT + T_LRU;
    const int first = which == 2 ? T_IN + T_MG + T_BR : 0, last = which == 2 ? T_IN + T_MG + T_BR + T_OUT : TOT;
    const int rot = ((BIDX() - start) % GDIM() + GDIM()) % GDIM();
    for (int it = first + rot; it < last; it += GDIM()) {
        int r = it;
        if (which == 1 && r >= T_IN + T_MG + T_BR && r < T_IN + T_MG + T_BR + T_OUT) continue;
        if (r < T_IN) { transpose_tile(p.w_in + (size_t)l * D * NW, D, NW, ws_bf(p, OFF_W1T), (r / 120) * 64, (r % 120) * 64, tile, true); continue; }
        r -= T_IN;
        if (r < T_MG) { transpose_tile(p.w_merge + (size_t)l * D * 3072, D, 3072, ws_bf(p, OFF_WMG), (r / 48) * 64, (r % 48) * 64, tile); continue; }
        r -= T_MG;
        if (r < T_BR) { const int nb = r / 256, q = r % 256;
            transpose_tile(p.w_branch + ((size_t)l * 3 + nb) * D * D, D, D, ws_bf(p, OFF_WBR) + (size_t)nb * D * D, (q / 16) * 64, (q % 16) * 64, tile); continue; }
        r -= T_BR;
        if (r < T_OUT) { transpose_tile(p.w_out + (size_t)l * D * D, D, D, ws_bf(p, OFF_WOUT), (r / 16) * 64, (r % 16) * 64, tile); continue; }
        r -= T_OUT;
        {
            const int mat = r / 4, q = r % 4;
            const int dir = mat >> 4, gate = (mat >> 3) & 1, blk = mat & 7;
            const float* wa_ = p.lru_wa; const float* wx_ = p.lru_wx;
            const float* src = (gate ? wx_ : wa_) + (((size_t)l * 2 + dir) * 8 + blk) * 128 * 128;
            transpose_tile(src, 128, 128, ws_bf(p, OFF_LRUW) + (size_t)mat * 128 * 128, (q >> 1) * 64, (q & 1) * 64, tile);
        }
    }
}

DEV void prenorm_row(CParams& p, int l, int m, const float4 (&v)[4], int lane) {
    float ss = 0.f;
#pragma unroll
    for (int j = 0; j < 4; ++j) ss += (v[j].x * v[j].x + v[j].y * v[j].y) + (v[j].z * v[j].z + v[j].w * v[j].w);
    ss = wave_sum(ss);
    const float rstd = rsqrtf(ss * (1.f / D) + EPS);
    const float* mod = ws_mod(p) + (size_t)(l * 5 + cond_row(m)) * 3072;
    bf16_t* h = ws_bf(p, OFF_H) + (size_t)m * D;
#pragma unroll
    for (int j = 0; j < 4; ++j) {
        const int i4 = lane + 64 * j;
        const float4 g = ((const float4*)(p.norm_pre + l * D))[i4];
        const float4 sh = ((const float4*)mod)[i4];
        const float4 sc = ((const float4*)(mod + 1024))[i4];
        ushort4 o;
        o.x = f2bf(v[j].x * rstd * g.x * (1.f + sc.x) + sh.x);
        o.y = f2bf(v[j].y * rstd * g.y * (1.f + sc.y) + sh.y);
        o.z = f2bf(v[j].z * rstd * g.z * (1.f + sc.z) + sh.z);
        o.w = f2bf(v[j].w * rstd * g.w * (1.f + sc.w) + sh.w);
        ((ushort4*)h)[i4] = o;
    }
}
DEV void phase_prenorm(CParams& p, int l) {
    const int tid = TIDX(), lane = tid & 63;
    for (int m = BIDX() * 8 + (tid >> 6); m < M; m += GDIM() * 8) {
        const float4* xr = (const float4*)x_row(p, l, m);
        float4 v[4];
#pragma unroll
        for (int j = 0; j < 4; ++j) v[j] = xr[lane + 64 * j];
        prenorm_row(p, l, m, v, lane);
    }
}

typedef short bf16x8 __attribute__((ext_vector_type(8)));
typedef float f32x4 __attribute__((ext_vector_type(4)));
typedef short v4i16_t __attribute__((ext_vector_type(4)));
#define LAS __attribute__((address_space(3)))
namespace g8 {
constexpr int BK = 64, HALF = 128, HTB = HALF * BK * 2, STAGE_BYTES = 8 * HTB;
DEV int lds_byte(int r, int c) { const int st = (r >> 4) * 2 + (c >> 5), rr = r & 15, cc = c & 31, ob = rr * 64 + cc * 2; return st * 1024 + (ob ^ (((ob >> 9) & 1) << 5)); }
DEV void stage_rc(int b, int& R, int& C) { const int st = b / 1024, sb = b % 1024, swz = sb ^ (((sb >> 9) & 1) << 5); R = (st >> 1) * 16 + swz / 64; C = (st & 1) * 32 + (swz % 64) / 2; }
struct Unit { const char* a; const char* b; int kind, pm, pn; unsigned lda; };

template <class Sched, class Epi>
DEV void gemm_phase(LAS unsigned char* lds, const unsigned ldb, const int nt, const Sched& S, const Epi& E) {
    const int tid = TIDX(), wid = __builtin_amdgcn_readfirstlane(tid >> 6), lane = tid & 63, wr = wid >> 2, wc = wid & 3, fr = lane & 15, fq = lane >> 4;
    unsigned rowA[2], colA[2], voffB[2];
#pragma unroll
    for (int i = 0; i < 2; ++i) { int R, C; stage_rc(tid * 16 + i * 8192, R, C); rowA[i] = (unsigned)R; colA[i] = (unsigned)C * 2u; voffB[i] = (unsigned)R * ldb + (unsigned)C * 2u; }
    const size_t kstep = (size_t)(BK * 2);
    const size_t hstepB = (size_t)HALF * ldb;
    const unsigned ldsw = (unsigned)wid * 1024u;
    const int aoff = lds_byte(wr * 64 + fr, fq * 8), boff = lds_byte(wc * 32 + fr, fq * 8);
#define G8_SA(b, h) (((b) * 2 + (h)) * HTB)
#define G8_SB(b, h) ((4 + (b) * 2 + (h)) * HTB)
#define G8_STAGE(bufoff, gbase, voff) do { _Pragma("unroll") for (int _i = 0; _i < 2; ++_i) \
        __builtin_amdgcn_global_load_lds((const unsigned*)((const char*)(gbase) + (voff)[_i]), (LAS unsigned*)(lds + (bufoff) + ldsw + _i * 8192), 16, 0, 0); } while (0)
#define G8_STAGEA(bufoff, gbase, ld) do { _Pragma("unroll") for (int _i = 0; _i < 2; ++_i) \
        __builtin_amdgcn_global_load_lds((const unsigned*)((const char*)(gbase) + (rowA[_i] * (ld) + colA[_i])), (LAS unsigned*)(lds + (bufoff) + ldsw + _i * 8192), 16, 0, 0); } while (0)
#define G8_LDA(dst, b, h) do { _Pragma("unroll") for (int m = 0; m < 4; ++m) _Pragma("unroll") for (int k = 0; k < 2; ++k) dst[m][k] = *(const LAS bf16x8*)(lds + G8_SA(b, h) + aoff + m * 2048 + k * 1024); } while (0)
#define G8_LDB(dst, b, h) do { _Pragma("unroll") for (int n = 0; n < 2; ++n) _Pragma("unroll") for (int k = 0; k < 2; ++k) dst[n][k] = *(const LAS bf16x8*)(lds + G8_SB(b, h) + boff + n * 2048 + k * 1024); } while (0)
#define G8_MMA(ai, bj, At, Bt) do { __builtin_amdgcn_s_setprio(1); _Pragma("unroll") for (int m = 0; m < 4; ++m) _Pragma("unroll") for (int n = 0; n < 2; ++n) _Pragma("unroll") for (int k = 0; k < 2; ++k) \
        acc[ai][bj][m][n] = __builtin_amdgcn_mfma_f32_16x16x32_bf16(Bt[n][k], At[m][k], acc[ai][bj][m][n], 0, 0, 0); __builtin_amdgcn_s_setprio(0); } while (0)
#define G8_WAIT_V(n) asm volatile("s_waitcnt vmcnt(" #n ")" ::: "memory")
#define G8_WAIT_L(n) asm volatile("s_waitcnt lgkmcnt(" #n ")" ::: "memory")
#define G8_BAR __builtin_amdgcn_s_barrier()
#define G8_SCHED __builtin_amdgcn_sched_barrier(0)
    Unit cur, nxt; int ui = 0;
    if (!S.next(0, cur)) return;
    f32x4 acc[2][2][4][2];
#pragma unroll
    for (int a = 0; a < 2; ++a)
#pragma unroll
        for (int b = 0; b < 2; ++b)
#pragma unroll
            for (int m = 0; m < 4; ++m)
#pragma unroll
                for (int n = 0; n < 2; ++n) acc[a][b][m][n] = (f32x4){0.f, 0.f, 0.f, 0.f};
    bf16x8 At[4][2], B0[2][2], B1[2][2];
    const char* cA = cur.a; const char* cB = cur.b;
    unsigned ldc = cur.lda;
    G8_STAGE(G8_SB(0, 0), cB, voffB); G8_STAGE(G8_SB(0, 1), cB + hstepB, voffB); G8_STAGEA(G8_SA(0, 0), cA, ldc); G8_STAGEA(G8_SA(0, 1), cA + (size_t)HALF * ldc, ldc);
    if (wr == 1) G8_BAR;
    G8_WAIT_V(2); G8_BAR;
    G8_STAGE(G8_SB(1, 0), cB + kstep, voffB); G8_STAGEA(G8_SA(1, 0), cA + kstep, ldc); G8_STAGE(G8_SB(1, 1), cB + hstepB + kstep, voffB);
    G8_WAIT_V(6); G8_BAR;
    for (;;) {
        const bool has_next = S.next(ui + 1, nxt);
        const char* nA = has_next ? nxt.a : cA; const char* nB = has_next ? nxt.b : cB;
        const unsigned ldn = has_next ? nxt.lda : ldc;
        for (int t = 0; t < nt; t += 2) {
            const bool last = (t == nt - 2);
            const char* a1 = cA + (size_t)(t + 1) * kstep;
            const char* a2 = last ? nA : cA + (size_t)(t + 2) * kstep; const char* b2 = last ? nB : cB + (size_t)(t + 2) * kstep;
            const char* a3 = a2 + kstep; const char* b3 = b2 + kstep;
            const unsigned ld2 = last ? ldn : ldc;
            const size_t h1 = (size_t)HALF * ldc, h2 = (size_t)HALF * ld2;
            G8_LDB(B0, 0, 0); G8_LDB(B1, 0, 1); G8_SCHED; G8_LDA(At, 0, 0); G8_STAGEA(G8_SA(1, 1), a1 + h1, ldc);
            G8_WAIT_V(8); G8_WAIT_L(0); G8_BAR; G8_MMA(0, 0, At, B0); G8_MMA(0, 1, At, B1); G8_BAR; G8_SCHED;
            G8_LDA(At, 0, 1); G8_STAGE(G8_SB(0, 0), b2, voffB); G8_STAGE(G8_SB(0, 1), b2 + hstepB, voffB); G8_STAGEA(G8_SA(0, 0), a2, ld2);
            G8_WAIT_V(8); G8_WAIT_L(0); G8_BAR; G8_MMA(1, 0, At, B0); G8_MMA(1, 1, At, B1); G8_BAR; G8_SCHED;
            G8_LDB(B0, 1, 0); G8_LDB(B1, 1, 1); G8_SCHED; G8_LDA(At, 1, 0); G8_STAGEA(G8_SA(0, 1), a2 + h2, ld2);
            G8_WAIT_V(8); G8_WAIT_L(0); G8_BAR; G8_MMA(0, 0, At, B0); G8_MMA(0, 1, At, B1); G8_BAR; G8_SCHED;
            G8_LDA(At, 1, 1); G8_STAGE(G8_SB(1, 0), b3, voffB); G8_STAGE(G8_SB(1, 1), b3 + hstepB, voffB); G8_STAGEA(G8_SA(1, 0), a3, ld2);
            G8_WAIT_V(8); G8_WAIT_L(0); G8_BAR; G8_MMA(1, 0, At, B0); G8_MMA(1, 1, At, B1); G8_BAR; G8_SCHED;
        }
        if (wr == 0) G8_BAR;
        E(acc, cur, wr, wc, fr, fq);
        if (!has_next) break;
#pragma unroll
        for (int a = 0; a < 2; ++a)
#pragma unroll
            for (int b = 0; b < 2; ++b)
#pragma unroll
                for (int m = 0; m < 4; ++m)
#pragma unroll
                    for (int n = 0; n < 2; ++n) acc[a][b][m][n] = (f32x4){0.f, 0.f, 0.f, 0.f};
        cur = nxt; cA = nA; cB = nB; ldc = ldn; ++ui;
        if (wr == 1) G8_BAR;
    }
    G8_WAIT_V(0);
    G8_BAR;
#undef G8_SA
#undef G8_SB
#undef G8_STAGE
#undef G8_STAGEA
#undef G8_LDA
#undef G8_LDB
#undef G8_MMA
#undef G8_WAIT_V
#undef G8_WAIT_L
#undef G8_BAR
#undef G8_SCHED
}

DEV void grid_unit(int wgid, int nM, int nN, int& pm, int& pn) {
    const int nwg = nM * nN, q = nwg / 8, r = nwg % 8, xcd = wgid % 8, off = wgid / 8;
    wgid = (xcd < r ? xcd * (q + 1) : r * (q + 1) + (xcd - r) * q) + off;
    const int nig = 4 * nN, gid = wgid / nig, fm = gid * 4, gsz = (nM - fm) < 4 ? (nM - fm) : 4;
    pm = fm + ((wgid % nig) % gsz); pn = (wgid % nig) / gsz;
}
DEV uint2 pk4(const f32x4 v) { return make_uint2(pk2(v[0], v[1]), pk2(v[2], v[3])); }
DEV float lo16(unsigned u) { return __uint_as_float(u << 16); }
DEV float hi16(unsigned u) { return __uint_as_float(u & 0xffff0000u); }
}

struct SchedG1 {
    const char* H; const char* W; int G, c;
    DEV bool next(int i, g8::Unit& u) const {
        int L = i * G + c;
        if (L >= 1440) return false;
        if (L < 1248) { g8::grid_unit(L, 48, 26, u.pm, u.pn); u.kind = 0; u.lda = 2048u; u.a = H + (size_t)u.pm * 256 * 2048; u.b = W + (size_t)u.pn * 256 * 2048; }
        else { g8::grid_unit(L - 1248, 4, 48, u.pm, u.pn); u.kind = 0; u.lda = 2048u; u.a = W + (size_t)(PW + u.pm * 256) * 2048; u.b = H + (size_t)u.pn * 256 * 2048; u.pn += 64; }
        return true;
    }
};
struct EpiG1 {
    unsigned char* ws; float* out; int l;
    DEV void operator()(const f32x4 (&acc)[2][2][4][2], const g8::Unit& u, int wr, int wc, int fr, int fq) const {
        using namespace g8;
        bf16_t* Pb = (bf16_t*)(ws + OFF_P);
        if (u.pn >= 64) {
            bf16_t* RVT = (bf16_t*)(ws + OFF_RVT);
#pragma unroll
            for (int ai = 0; ai < 2; ++ai)
#pragma unroll
                for (int bj = 0; bj < 2; ++bj)
#pragma unroll
                    for (int m = 0; m < 4; ++m)
#pragma unroll
                        for (int n = 0; n < 2; ++n) {
                            const int ch = u.pm * 256 + ai * 128 + wr * 64 + m * 16 + fr;
                            const int tok = (u.pn - 64) * 256 + bj * 128 + wc * 32 + n * 16 + fq * 4;
                            *(uint2*)(RVT + (size_t)ch * M + tok) = pk4(acc[ai][bj][m][n]);
                        }
            return;
        }
        const int pn = u.pn;
        const bool rope_ret = pn < 4, rope_att = pn >= 16 && pn <= 20;
        const bool lat = u.pm >= 16;
        if (rope_ret || rope_att) {
            const int te = rope_ret ? (wc >> 1) * 32 + (wc & 1) * 16 + fq * 4 : 64 + (wc & 1) * 16 + fq * 4;
            const float sc = pn < 2 ? 0.08838834764831845f : (pn >= 16 && pn < 20) ? 0.125f * 1.4426950408889634f : 1.f;
#pragma unroll
            for (int ai = 0; ai < 2; ++ai) {
                float4 c01[4], c23[4];
                if (lat) {
#pragma unroll
                    for (int m = 0; m < 4; ++m) {
                        const int t = (u.pm * 256 + ai * 128 + wr * 64 + m * 16 + fr - NCTX) & 2047;
                        const float4* tb = (const float4*)((const float2*)(ws + OFF_ROPE) + (size_t)t * 96 + te);
                        c01[m] = tb[0]; c23[m] = tb[1];
                    }
                }
#pragma unroll
                for (int m = 0; m < 4; ++m) {
                    const int row = u.pm * 256 + ai * 128 + wr * 64 + m * 16 + fr;
                    bf16_t* Pr = Pb + (size_t)row * PW;
#pragma unroll
                    for (int bj = 0; bj < 2; ++bj) {
                        f32x4 x1 = acc[ai][bj][m][0], x2 = acc[ai][bj][m][1];
                        const int lc1 = rope_ret ? pn * 256 + bj * 128 + (wc >> 1) * 64 + (wc & 1) * 16 + fq * 4 : pn * 256 + bj * 128 + wc * 32 + fq * 4;
                        const int lc2 = rope_ret ? lc1 + 32 : lc1 + 16;
                        if (!lat && pn == 20) {
                            float* ok = out + O_NK + ((size_t)((row >> 8) * 2 + l) * 256 + (row & 255)) * 256 + (lc1 - C_AK);
                            *(float4*)ok = make_float4(x1[0], x1[1], x1[2], x1[3]);
                            *(float4*)(ok + 16) = make_float4(x2[0], x2[1], x2[2], x2[3]);
                        }
                        if (lat) {
                            const float cs[4] = {c01[m].x, c01[m].z, c23[m].x, c23[m].z}, sn[4] = {c01[m].y, c01[m].w, c23[m].y, c23[m].w};
                            f32x4 o1, o2;
#pragma unroll
                            for (int j = 0; j < 4; ++j) { o1[j] = x1[j] * cs[j] - x2[j] * sn[j]; o2[j] = x2[j] * cs[j] + x1[j] * sn[j]; }
                            x1 = o1; x2 = o2;
                        }
                        x1 *= sc; x2 *= sc;
                        *(uint2*)(Pr + lc1) = pk4(x1);
                        *(uint2*)(Pr + lc2) = pk4(x2);
                    }
                }
            }
            return;
        }
#pragma unroll
        for (int ai = 0; ai < 2; ++ai)
#pragma unroll
            for (int m = 0; m < 4; ++m) {
                const int row = u.pm * 256 + ai * 128 + wr * 64 + m * 16 + fr;
                bf16_t* Pr = Pb + (size_t)row * PW;
#pragma unroll
                for (int bj = 0; bj < 2; ++bj)
#pragma unroll
                    for (int n = 0; n < 2; ++n) {
                        f32x4 v = acc[ai][bj][m][n];
                        const int col = pn * 256 + bj * 128 + wc * 32 + n * 16 + fq * 4;
                        if (pn == 21) {
                            if (!lat) *(float4*)(out + O_NV + ((size_t)((row >> 8) * 2 + l) * 256 + (row & 255)) * 256 + (col - C_AV)) = make_float4(v[0], v[1], v[2], v[3]);
                        } else if (!(pn >= 8 && pn < 12)) {
#pragma unroll
                            for (int j = 0; j < 4; ++j) v[j] = siluf(v[j]);
                        }
                        *(uint2*)(Pr + col) = pk4(v);
                    }
            }
    }
};
DEV void phase8_gemm1(CParams& p, int l, LAS unsigned char* lds) {
    SchedG1 S{(const char*)(p.ws + OFF_H), (const char*)(p.ws + OFF_W1T), GDIM(), BIDX()};
    EpiG1 E{p.ws, p.out, l};
    g8::gemm_phase(lds, 2048u, 16, S, E);
}

constexpr size_t OFF_G2 = OFF_RVT;
struct SchedMg {
    const char *H, *P, *WMG, *WBR; int G, c, part;
    DEV void fill(g8::Unit& u, int tile, int n, int isz) const {
        u.pm = tile >> 2; u.pn = tile & 3; u.kind = n * 2 + isz;
        if (isz) { const int acol = n == 0 ? C_RG : n == 1 ? C_LG : C_AQ;
                   u.lda = (unsigned)PW * 2u; u.a = P + (size_t)u.pm * 256 * PW * 2 + (size_t)acol * 2; u.b = WBR + ((size_t)n * 1024 + u.pn * 256) * 2048; }
        else { u.lda = 2048u; u.a = H + (size_t)u.pm * 256 * 2048; u.b = WMG + ((size_t)n * 1024 + u.pn * 256) * 2048; }
    }
    DEV bool next(int i, g8::Unit& u) const {
        if (G == 256) {
            const int xg = c & 7, j = c >> 3;
            if (part == 2) {
                if (c >= 192 || i >= 1) return false;
                fill(u, xg * 24 + j, 1, 0);
            } else if (part == 0) {
                if (c < 192) { if (i >= 3) return false; if (i == 0) fill(u, xg * 24 + j, 0, 0); else fill(u, xg * 24 + j, i - 1, 1); }
                else { if (i >= 3) return false; fill(u, xg * 24 + (j - 24) * 3 + i, 2, 0); }
            } else {
                if (c >= 192 || i >= 1) return false;
                fill(u, xg * 24 + j, 2, 1);
            }
            return true;
        }
        if (part != 0) return false;
        const int tile = c + (i / 6) * G, sI = i % 6;
        if (tile >= 192) return false;
        fill(u, tile, sI >> 1, sI & 1);
        return true;
    }
};
struct EpiMg {
    unsigned char* ws; const float* bias;
    DEV bf16_t* gslot(int n, int row) const {
        bf16_t* Pb = (bf16_t*)(ws + OFF_P);
        return n == 0 ? Pb + (size_t)row * PW + C_LX : n == 1 ? Pb + (size_t)row * PW + C_AG : (bf16_t*)(ws + OFF_G2) + (size_t)row * 1024;
    }
    DEV void operator()(const f32x4 (&acc)[2][2][4][2], const g8::Unit& u, int wr, int wc, int fr, int fq) const {
        using namespace g8;
        const int n = u.kind >> 1; const bool zpass = u.kind & 1;
        const int colb = u.pn * 256 + wc * 32 + fq * 4;
        if (!zpass) {
            float4 bz[2][2];
#pragma unroll
            for (int bj = 0; bj < 2; ++bj)
#pragma unroll
                for (int nn = 0; nn < 2; ++nn) bz[bj][nn] = *(const float4*)(bias + n * 1024 + colb + bj * 128 + nn * 16);
#pragma unroll
            for (int ai = 0; ai < 2; ++ai)
#pragma unroll
                for (int m = 0; m < 4; ++m) {
                    bf16_t* gs = gslot(n, u.pm * 256 + ai * 128 + wr * 64 + m * 16 + fr);
#pragma unroll
                    for (int bj = 0; bj < 2; ++bj)
#pragma unroll
                        for (int nn = 0; nn < 2; ++nn) {
                            f32x4 v = acc[ai][bj][m][nn];
                            v[0] = sigmf(v[0] + bz[bj][nn].x); v[1] = sigmf(v[1] + bz[bj][nn].y); v[2] = sigmf(v[2] + bz[bj][nn].z); v[3] = sigmf(v[3] + bz[bj][nn].w);
                            *(uint2*)(gs + colb + bj * 128 + nn * 16) = pk4(v);
                        }
                }
            return;
        }
#pragma unroll
        for (int ai = 0; ai < 2; ++ai) {
            uint2 gq[4][2][2], tq[4][2][2];
#pragma unroll
            for (int m = 0; m < 4; ++m) {
                const int row = u.pm * 256 + ai * 128 + wr * 64 + m * 16 + fr;
                const bf16_t* gs = gslot(n, row);
                const bf16_t* Tr = (const bf16_t*)(ws + OFF_P) + (size_t)row * PW;
#pragma unroll
                for (int bj = 0; bj < 2; ++bj)
#pragma unroll
                    for (int nn = 0; nn < 2; ++nn) {
                        gq[m][bj][nn] = *(const uint2*)(gs + colb + bj * 128 + nn * 16);
                        if (n > 0) tq[m][bj][nn] = *(const uint2*)(Tr + colb + bj * 128 + nn * 16);
                    }
            }
#pragma unroll
            for (int m = 0; m < 4; ++m) {
                const int row = u.pm * 256 + ai * 128 + wr * 64 + m * 16 + fr;
                bf16_t* Tr = (bf16_t*)(ws + OFF_P) + (size_t)row * PW;
#pragma unroll
                for (int bj = 0; bj < 2; ++bj)
#pragma unroll
                    for (int nn = 0; nn < 2; ++nn) {
                        f32x4 v = acc[ai][bj][m][nn];
                        const uint2 gv = gq[m][bj][nn];
                        v[0] *= lo16(gv.x); v[1] *= hi16(gv.x); v[2] *= lo16(gv.y); v[3] *= hi16(gv.y);
                        if (n > 0) { const uint2 tv = tq[m][bj][nn]; v[0] += lo16(tv.x); v[1] += hi16(tv.x); v[2] += lo16(tv.y); v[3] += hi16(tv.y); }
                        *(uint2*)(Tr + colb + bj * 128 + nn * 16) = pk4(v);
                    }
            }
        }
    }
};
DEV void phase8_merge(CParams& p, int l, int part, LAS unsigned char* lds) {
    SchedMg S{(const char*)(p.ws + OFF_H), (const char*)(p.ws + OFF_P), (const char*)(p.ws + OFF_WMG), (const char*)(p.ws + OFF_WBR), GDIM(), BIDX(), part};
    EpiMg E{p.ws, p.b_merge + (size_t)l * 3072};
    g8::gemm_phase(lds, 2048u, 16, S, E);
}

struct SchedOut {
    const char* A; const char* B; int G, c;
    DEV bool next(int i, g8::Unit& u) const {
        int tile = i * G + c;
        if (G == 256) { if (i > 0 || c >= 192) return false; tile = (c & 7) * 24 + (c >> 3); }
        if (tile >= 192) return false;
        u.pm = tile >> 2; u.pn = tile & 3; u.kind = 0; u.lda = (unsigned)PW * 2u;
        u.a = A + (size_t)u.pm * 256 * PW * 2; u.b = B + (size_t)u.pn * 256 * 2048;
        return true;
    }
};
DEV void row_exchange(unsigned char* ws, int slot, int pn, float* part, float* rs) {
    const int tid = TIDX();
    __syncthreads();
    unsigned* XPd = (unsigned*)(ws + OFF_XP) + (size_t)slot * 4 * 256;
    unsigned* cnt = (unsigned*)(ws + OFF_XC) + slot;
    if (tid < 256) {
        const float v = (part[tid] + part[256 + tid]) + (part[512 + tid] + part[768 + tid]);
        __hip_atomic_store(XPd + pn * 256 + tid, __float_as_uint(v), __ATOMIC_RELAXED, __HIP_MEMORY_SCOPE_AGENT);
    }
    asm volatile("s_waitcnt vmcnt(0)" ::: "memory");
    __syncthreads();
    if (tid == 0) {
        (void)__hip_atomic_fetch_add(cnt, 1u, __ATOMIC_RELAXED, __HIP_MEMORY_SCOPE_AGENT);
        unsigned sp = 0;
        while (__hip_atomic_load(cnt, __ATOMIC_RELAXED, __HIP_MEMORY_SCOPE_AGENT) < 4u) { __builtin_amdgcn_s_sleep(1); if (++sp > (1u << 20)) break; }
        __builtin_amdgcn_fence(__ATOMIC_ACQUIRE, "agent");
        asm volatile("s_waitcnt vmcnt(0)" ::: "memory");
    }
    __syncthreads();
    if (tid < 256) {
        float t = 0.f;
#pragma unroll
        for (int q = 0; q < 4; ++q) t += __uint_as_float(__hip_atomic_load(XPd + q * 256 + tid, __ATOMIC_RELAXED, __HIP_MEMORY_SCOPE_AGENT));
        rs[tid] = rsqrtf(t * (1.f / D) + EPS);
    }
    __syncthreads();
}
struct EpiOutPost {
    CParams* kp; int l; unsigned char* ldsx;
    DEV void row_ssq(const f32x4 (&v)[2][2][4][2], float* part, int wr, int wc, int fr, int fq) const {
#pragma unroll
        for (int ai = 0; ai < 2; ++ai)
#pragma unroll
            for (int m = 0; m < 4; ++m) {
                float ss = 0.f;
#pragma unroll
                for (int bj = 0; bj < 2; ++bj)
#pragma unroll
                    for (int n = 0; n < 2; ++n) { const f32x4 x = v[ai][bj][m][n]; ss += (x[0] * x[0] + x[1] * x[1]) + (x[2] * x[2] + x[3] * x[3]); }
                ss = xrow16_sum(ss);
                if (fq == 0) part[wc * 256 + ai * 128 + wr * 64 + m * 16 + fr] = ss;
            }
    }
    DEV void operator()(f32x4 (&acc)[2][2][4][2], const g8::Unit& u, int wr, int wc, int fr, int fq) const {
        CParams& p = *kp;
        unsigned char* ws = p.ws;
        float* part = (float*)ldsx; float* rs = part + 1024;
        const int colb = u.pn * 256 + wc * 32 + fq * 4;
        const int crow = u.pm < 16 ? 0 : 1 + ((u.pm - 16) >> 3);
        const float* mod = ws_mod(p) + (size_t)(l * 5 + crow) * 3072;
        row_ssq(acc, part, wr, wc, fr, fq);
        row_exchange(ws, (l * 2 + 0) * 48 + u.pm, u.pn, part, rs);
        {
            float4 gt[2][2], gp[2][2];
#pragma unroll
            for (int bj = 0; bj < 2; ++bj)
#pragma unroll
                for (int n = 0; n < 2; ++n) {
                    gt[bj][n] = *(const float4*)(mod + 2048 + colb + bj * 128 + n * 16);
                    gp[bj][n] = *(const float4*)(p.norm_post + l * D + colb + bj * 128 + n * 16);
                    gt[bj][n].x *= gp[bj][n].x; gt[bj][n].y *= gp[bj][n].y; gt[bj][n].z *= gp[bj][n].z; gt[bj][n].w *= gp[bj][n].w;
                }
#pragma unroll
            for (int ai = 0; ai < 2; ++ai)
#pragma unroll
                for (int mh = 0; mh < 2; ++mh) {
                    float4 xv[2][2][2];
#pragma unroll
                    for (int m2 = 0; m2 < 2; ++m2) {
                        const int row = u.pm * 256 + ai * 128 + wr * 64 + (mh * 2 + m2) * 16 + fr;
                        const float* xr = x_row(p, l, row);
#pragma unroll
                        for (int bj = 0; bj < 2; ++bj)
#pragma unroll
                            for (int n = 0; n < 2; ++n) xv[m2][bj][n] = *(const float4*)(xr + colb + bj * 128 + n * 16);
                    }
#pragma unroll
                    for (int m2 = 0; m2 < 2; ++m2) {
                        const int m = mh * 2 + m2;
                        const int rl = ai * 128 + wr * 64 + m * 16 + fr;
                        const float rstd = rs[rl];
                        float* yr = p.out + (size_t)(u.pm * 256 + rl) * D;
#pragma unroll
                        for (int bj = 0; bj < 2; ++bj)
#pragma unroll
                            for (int n = 0; n < 2; ++n) {
                                f32x4 y;
                                y[0] = xv[m2][bj][n].x + gt[bj][n].x * (acc[ai][bj][m][n][0] * rstd);
                                y[1] = xv[m2][bj][n].y + gt[bj][n].y * (acc[ai][bj][m][n][1] * rstd);
                                y[2] = xv[m2][bj][n].z + gt[bj][n].z * (acc[ai][bj][m][n][2] * rstd);
                                y[3] = xv[m2][bj][n].w + gt[bj][n].w * (acc[ai][bj][m][n][3] * rstd);
                                acc[ai][bj][m][n] = y;
                                *(float4*)(yr + colb + bj * 128 + n * 16) = make_float4(y[0], y[1], y[2], y[3]);
                            }
                    }
                }
        }
        if (l != 0) return;
        row_ssq(acc, part, wr, wc, fr, fq);
        row_exchange(ws, (l * 2 + 1) * 48 + u.pm, u.pn, part, rs);
        {
            const float* mod1 = ws_mod(p) + (size_t)(1 * 5 + crow) * 3072;
            float4 a_[2][2], b_[2][2];
#pragma unroll
            for (int bj = 0; bj < 2; ++bj)
#pragma unroll
                for (int n = 0; n < 2; ++n) {
                    const int cc = colb + bj * 128 + n * 16;
                    const float4 g = *(const float4*)(p.norm_pre + 1 * D + cc), sc = *(const float4*)(mod1 + 1024 + cc);
                    a_[bj][n] = make_float4(g.x * (1.f + sc.x), g.y * (1.f + sc.y), g.z * (1.f + sc.z), g.w * (1.f + sc.w));
                    b_[bj][n] = *(const float4*)(mod1 + cc);
                }
#pragma unroll
            for (int ai = 0; ai < 2; ++ai)
#pragma unroll
                for (int m = 0; m < 4; ++m) {
                    const int rl = ai * 128 + wr * 64 + m * 16 + fr;
                    const float rstd = rs[rl];
                    bf16_t* hr = ws_bf(p, OFF_H) + (size_t)(u.pm * 256 + rl) * D;
#pragma unroll
                    for (int bj = 0; bj < 2; ++bj)
#pragma unroll
                        for (int n = 0; n < 2; ++n) {
                            const f32x4 y = acc[ai][bj][m][n];
                            uint2 o;
                            o.x = pk2(y[0] * rstd * a_[bj][n].x + b_[bj][n].x, y[1] * rstd * a_[bj][n].y + b_[bj][n].y);
                            o.y = pk2(y[2] * rstd * a_[bj][n].z + b_[bj][n].z, y[3] * rstd * a_[bj][n].w + b_[bj][n].w);
                            *(uint2*)(hr + colb + bj * 128 + n * 16) = o;
                        }
                }
        }
    }
};
DEV void phase8_out(CParams& p, int l, LAS unsigned char* lds) {
    SchedOut S{(const char*)(p.ws + OFF_P), (const char*)(p.ws + OFF_WOUT), GDIM(), BIDX()};
    EpiOutPost E{&p, l, (unsigned char*)lds + LDS_XOFF};
    g8::gemm_phase(lds, 2048u, 16, S, E);
}

DEV uint4 pack8(const float4 a, const float4 b) {
    uint4 r;
    r.x = pk2(a.x, a.y); r.y = pk2(a.z, a.w);
    r.z = pk2(b.x, b.y); r.w = pk2(b.z, b.w);
    return r;
}
template <int NU>
DEV void attn_item(CParams& p, int l, bool lat, int b, int hk, int qs0, unsigned char* lds) {
    bf16_t* Pb = ws_bf(p, OFF_P);
    const int tid = TIDX(), lane = tid & 63, w = tid >> 6, g = lane >> 4, lc = lane & 15;
    const int row0 = lat ? NCTX + b * 2048 : b * 256, L = lat ? 2048 : 256;
    const int hq = hk * 4 + (w & 3);
    const int qw = qs0 + (w >> 2) * 32;
    bf16x8 qfr[NU][2][2];
    f32x4 O[NU][4][2];
    float mrun[NU][2], lrun[NU][2];
    const float sink = p.att_sink[l * 16 + hq] * 1.4426950408889634f;
#pragma unroll
    for (int u = 0; u < NU; ++u)
#pragma unroll
        for (int qf = 0; qf < 2; ++qf) {
#pragma unroll
            for (int ks = 0; ks < 2; ++ks)
                qfr[u][qf][ks] = *(const bf16x8*)(Pb + (size_t)(row0 + qw + u * 64 + qf * 16 + lc) * PW + C_AQ + hq * 64 + ks * 32 + g * 8);
            mrun[u][qf] = sink; lrun[u][qf] = g == 0 ? 1.f : 0.f;
#pragma unroll
            for (int df = 0; df < 4; ++df) O[u][df][qf] = (f32x4){0.f, 0.f, 0.f, 0.f};
        }
    const int nband = lat ? 4 + NU : 4;
    const int ntile = lat ? nband + 4 : 4;
    const int qsb = qs0 >> 6;
    const int t_lo = lat ? (qsb < 2 ? 2 - qsb : 0) : 0;
    const int t_hi = lat ? ((33 - qsb) < (nband - 1) ? (33 - qsb) : (nband - 1)) : 3;
    const int fsw = (lane >> 1) & 7;
    const int srow = tid >> 3, sc8 = tid & 7;
    float4 R[4];
    auto tile_load = [&](int t) __attribute__((always_inline)) {
        if (t < nband) {
            const int kp0 = lat ? qs0 + 64 * (t - 2) : 64 * t;
            const uint4 kv = *(const uint4*)(Pb + (size_t)(row0 + kp0 + srow) * PW + C_AK + hk * 64 + sc8 * 8);
            const uint4 vv = *(const uint4*)(Pb + (size_t)(row0 + kp0 + srow) * PW + C_AV + hk * 64 + sc8 * 8);
            R[0] = make_float4(__uint_as_float(kv.x), __uint_as_float(kv.y), __uint_as_float(kv.z), __uint_as_float(kv.w));
            R[2] = make_float4(__uint_as_float(vv.x), __uint_as_float(vv.y), __uint_as_float(vv.z), __uint_as_float(vv.w));
        } else {
            const int j0 = (t - nband) * 64;
            const float* ck = p.cache_k + (size_t)((b * 2 + l) * 256 + j0) * 256 + hk * 64;
            const float* cv = p.cache_v + (size_t)((b * 2 + l) * 256 + j0) * 256 + hk * 64;
            R[0] = *(const float4*)(ck + (size_t)srow * 256 + sc8 * 8); R[1] = *(const float4*)(ck + (size_t)srow * 256 + sc8 * 8 + 4);
            R[2] = *(const float4*)(cv + (size_t)srow * 256 + sc8 * 8); R[3] = *(const float4*)(cv + (size_t)srow * 256 + sc8 * 8 + 4);
        }
    };
    auto tile_store = [&](bool cache_t, unsigned char* KsB, unsigned char* VtB) __attribute__((always_inline)) {
        uint4 kq, vq;
        if (!cache_t) {
            kq = make_uint4(__float_as_uint(R[0].x), __float_as_uint(R[0].y), __float_as_uint(R[0].z), __float_as_uint(R[0].w));
            vq = make_uint4(__float_as_uint(R[2].x), __float_as_uint(R[2].y), __float_as_uint(R[2].z), __float_as_uint(R[2].w));
        } else { kq = pack8(R[0], R[1]); vq = pack8(R[2], R[3]); }
        *(uint4*)(KsB + srow * 128 + ((sc8 ^ ((srow >> 1) & 7)) << 4)) = kq;
        *(uint4*)(VtB + srow * 128 + ((sc8 ^ (((srow >> 1) & 3) << 1)) << 4)) = vq;
    };
    int t = t_lo;
    tile_load(t);
    __syncthreads();
    tile_store(t >= nband, lds, lds + 8192);
    int tn = (lat && t == t_hi) ? nband : t + 1;
    if (tn < ntile) tile_load(tn);
    int cur = 0;
    while (t < ntile) {
        const bool cache = t >= nband;
        const int kp0 = lat ? qs0 + 64 * (t - 2) : 64 * t;
        const unsigned char* Ks = lds + cur * 16384; const unsigned char* Vt = Ks + 8192;
        __syncthreads();
        int tnn = ntile;
        if (tn < ntile) {
            tile_store(tn >= nband, lds + (cur ^ 1) * 16384, lds + (cur ^ 1) * 16384 + 8192);
            tnn = (lat && tn == t_hi) ? nband : tn + 1;
            if (tnn < ntile) tile_load(tnn);
        }
#pragma unroll
        for (int u = 0; u < NU; ++u) {
            const int tu = t - u;
            if (lat && !cache && (tu < 0 || tu > 4)) continue;
            __builtin_amdgcn_s_setprio(1);
            f32x4 sc[4][2];
#pragma unroll
            for (int kf = 0; kf < 4; ++kf)
#pragma unroll
                for (int qf = 0; qf < 2; ++qf) sc[kf][qf] = (f32x4){0.f, 0.f, 0.f, 0.f};
#pragma unroll
            for (int ks = 0; ks < 2; ++ks) {
                bf16x8 ak[4];
#pragma unroll
                for (int kf = 0; kf < 4; ++kf) ak[kf] = *(const bf16x8*)(Ks + (kf * 16 + lc) * 128 + (((ks * 4 + g) ^ fsw) << 4));
#pragma unroll
                for (int kf = 0; kf < 4; ++kf)
#pragma unroll
                    for (int qf = 0; qf < 2; ++qf)
                        sc[kf][qf] = __builtin_amdgcn_mfma_f32_16x16x32_bf16(ak[kf], qfr[u][qf][ks], sc[kf][qf], 0, 0, 0);
            }
            __builtin_amdgcn_s_setprio(0);
            if (lat && !cache && (tu == 0 || tu == 4)) {
#pragma unroll
                for (int kf = 0; kf < 4; ++kf)
#pragma unroll
                    for (int qf = 0; qf < 2; ++qf)
#pragma unroll
                        for (int r = 0; r < 4; ++r) {
                            const int kpos = kp0 + kf * 16 + g * 4 + r, qpos = qw + u * 64 + qf * 16 + lc;
                            const int dd = qpos - kpos;
                            if (dd > 128 || dd < -128) sc[kf][qf][r] = -INFINITY;
                        }
            }
            bf16x8 pb[2][2];
#pragma unroll
            for (int qf = 0; qf < 2; ++qf) {
                float mx = -INFINITY;
#pragma unroll
                for (int kf = 0; kf < 4; ++kf)
#pragma unroll
                    for (int r = 0; r < 4; ++r) mx = fmaxf(mx, sc[kf][qf][r]);
                mx = xrow16_max(mx);
                const float mnew = fmaxf(mrun[u][qf], mx);
                const float alpha = __builtin_amdgcn_exp2f(mrun[u][qf] - mnew);
                mrun[u][qf] = mnew;
                float ps = 0.f;
#pragma unroll
                for (int kf = 0; kf < 4; ++kf)
#pragma unroll
                    for (int r = 0; r < 4; ++r) { const float e = __builtin_amdgcn_exp2f(sc[kf][qf][r] - mnew); sc[kf][qf][r] = e; ps += e; }
                lrun[u][qf] = lrun[u][qf] * alpha + ps;
#pragma unroll
                for (int df = 0; df < 4; ++df) O[u][df][qf] *= alpha;
#pragma unroll
                for (int s2 = 0; s2 < 2; ++s2) {
                    bf16x8 v;
#pragma unroll
                    for (int r = 0; r < 4; ++r) { v[r] = (short)f2bf(sc[2 * s2][qf][r]); v[4 + r] = (short)f2bf(sc[2 * s2 + 1][qf][r]); }
                    pb[s2][qf] = v;
                }
            }
            __builtin_amdgcn_s_setprio(1);
#pragma unroll
            for (int s2 = 0; s2 < 2; ++s2)
#pragma unroll
                for (int df = 0; df < 4; ++df) {
                    const int vrow = 32 * s2 + 4 * g + (lc >> 2);
                    const unsigned char* vr = Vt + vrow * 128 + (((2 * df + ((lc >> 1) & 1)) ^ (((vrow >> 1) & 3) << 1)) << 4) + 8 * (lc & 1);
                    const v4i16_t lo = __builtin_amdgcn_ds_read_tr16_b64_v4i16((LAS v4i16_t*)vr);
                    const v4i16_t hi = __builtin_amdgcn_ds_read_tr16_b64_v4i16((LAS v4i16_t*)(vr + 2048));
                    union { v4i16_t h[2]; bf16x8 v; } av; av.h[0] = lo; av.h[1] = hi;
#pragma unroll
                    for (int qf = 0; qf < 2; ++qf)
                        O[u][df][qf] = __builtin_amdgcn_mfma_f32_16x16x32_bf16(av.v, pb[s2][qf], O[u][df][qf], 0, 0, 0);
                }
            __builtin_amdgcn_s_setprio(0);
        }
        t = tn; tn = tnn; cur ^= 1;
    }
#pragma unroll
    for (int u = 0; u < NU; ++u)
#pragma unroll
        for (int qf = 0; qf < 2; ++qf) {
            const float lt = xrow16_sum(lrun[u][qf]);
            const float inv = 1.f / lt;
            const size_t m = (size_t)(row0 + qw + u * 64 + qf * 16 + lc);
#pragma unroll
            for (int df = 0; df < 4; ++df) {
                const int col = hq * 64 + df * 16 + g * 4;
                const uint2 gt = *(const uint2*)(Pb + m * PW + C_AG + col);
                uint2 o;
                o.x = pk2(O[u][df][qf][0] * inv * __uint_as_float(gt.x << 16), O[u][df][qf][1] * inv * __uint_as_float(gt.x & 0xffff0000u));
                o.y = pk2(O[u][df][qf][2] * inv * __uint_as_float(gt.y << 16), O[u][df][qf][3] * inv * __uint_as_float(gt.y & 0xffff0000u));
                *(uint2*)(Pb + m * PW + C_AQ + col) = o;
            }
        }
}
DEV void phase_attn(CParams& p, int l, unsigned char* lds) {
    if (GDIM() == 256) {
        const int xg = BIDX() & 7, j = BIDX() >> 3;
        { const int grp = xg * 2 + (j >> 4); attn_item<2>(p, l, true, grp >> 2, grp & 3, (j & 15) * 128, lds); }
        { const int grp = xg * 8 + (j >> 2); attn_item<1>(p, l, false, grp >> 2, grp & 3, (j & 3) * 64, lds); }
        return;
    }
    for (int item = BIDX(); item < 768; item += GDIM()) {
        if (item < 512) attn_item<1>(p, l, true, item >> 7, (item >> 5) & 3, (item & 31) * 64, lds);
        else { const int it = item - 512; attn_item<1>(p, l, false, it >> 4, (it >> 2) & 3, (it & 3) * 64, lds); }
    }
}

constexpr size_t OFF_RS = OFF_W1T;
static_assert(OFF_RS + (size_t)4 * 4 * 2 * 8 * 32768 * 2 <= OFF_LRUC, "RS overlap");
DEV float ret_logg(CParams& p, int l, int dir, int h) { return -softplusf(-p.ret_decay[(l * 2 + dir) * 4 + h]); }

DEV void ret_kv_tile(CParams& p, int l, int item, unsigned char* lds) {
    bf16_t* Pb = ws_bf(p, OFF_P); const bf16_t* RVT = ws_bf(p, OFF_RVT);
    const int tid = TIDX(), lane = tid & 63, w = __builtin_amdgcn_readfirstlane(tid >> 6), g = lane >> 4, lc = lane & 15;
    const bool lat = item < 128;
    int b, h, c;
    if (lat) { c = item & 7; h = (item >> 3) & 3; b = item >> 5; }
    else { const int it = item - 128; h = it & 3; b = it >> 2; c = 0; }
    const int row0 = lat ? NCTX + b * 2048 + c * 256 : b * 256;
    const bool doF = !lat || c < 7, doB = !lat || c > 0;
    const float lgf = ret_logg(p, l, 0, h), lgb = ret_logg(p, l, 1, h);
    const float rf = __expf(-lgf), rb = __expf(lgb);
    const int dvbase = w * 32;
    auto dma_k = [&](int st) __attribute__((always_inline)) {
        LAS unsigned char* base = (LAS unsigned char*)lds + (st & 1) * 16384;
#pragma unroll
        for (int i = 0; i < 2; ++i) {
            const int q = w * 2 + i, row = 4 * q + (lane >> 4), lch = (lane & 15) ^ (((row & 3) << 2) | ((row >> 2) & 3));
            __builtin_amdgcn_global_load_lds((const unsigned*)(Pb + (size_t)(row0 + st * 64 + row) * PW + C_RK + h * 128 + lch * 8), (LAS unsigned*)(base + q * 1024), 16, 0, 0);
        }
    };
    __syncthreads();
    dma_k(0);
    f32x4 accF[2][8], accB[2][8];
#pragma unroll
    for (int i = 0; i < 2; ++i)
#pragma unroll
        for (int j = 0; j < 8; ++j) { accF[i][j] = (f32x4){0.f, 0.f, 0.f, 0.f}; accB[i][j] = (f32x4){0.f, 0.f, 0.f, 0.f}; }
    const int tq = lc >> 2, tp = lc & 3;
#pragma unroll 1
    for (int st = 0; st < 4; ++st) {
        bf16x8 av[2][2];
#pragma unroll
        for (int ks = 0; ks < 2; ++ks)
#pragma unroll
            for (int mf = 0; mf < 2; ++mf)
                av[ks][mf] = *(const bf16x8*)(RVT + (size_t)(h * 256 + dvbase + mf * 16 + lc) * M + row0 + st * 64 + ks * 32 + g * 8);
        bf16x8 avF[2][2], avB[2][2];
#pragma unroll
        for (int ks = 0; ks < 2; ++ks) {
            const int ti0 = st * 64 + ks * 32 + g * 8;
            float wf = __expf(lgf * (float)(255 - ti0)), wb = __expf(lgb * (float)ti0);
#pragma unroll
            for (int j = 0; j < 8; ++j) {
#pragma unroll
                for (int mf = 0; mf < 2; ++mf) {
                    const float v = bf2f((bf16_t)av[ks][mf][j]);
                    avF[ks][mf][j] = (short)f2bf(v * wf); avB[ks][mf][j] = (short)f2bf(v * wb);
                }
                wf *= rf; wb *= rb;
            }
        }
        asm volatile("s_waitcnt vmcnt(0)" ::: "memory");
        __syncthreads();
        if (st + 1 < 4) dma_k(st + 1);
        const unsigned char* Kt = lds + (st & 1) * 16384;
#pragma unroll
        for (int ks = 0; ks < 2; ++ks)
#pragma unroll
            for (int nf = 0; nf < 8; ++nf) {
                const int r0 = 32 * ks + 8 * g + tq, r1 = r0 + 4;
                const unsigned char* a0 = Kt + r0 * 256 + (((2 * nf + (tp >> 1)) ^ (((r0 & 3) << 2) | ((r0 >> 2) & 3))) << 4) + 8 * (tp & 1);
                const unsigned char* a1 = Kt + r1 * 256 + (((2 * nf + (tp >> 1)) ^ (((r1 & 3) << 2) | ((r1 >> 2) & 3))) << 4) + 8 * (tp & 1);
                union { v4i16_t hlf[2]; bf16x8 v; } bk;
                bk.hlf[0] = __builtin_amdgcn_ds_read_tr16_b64_v4i16((LAS v4i16_t*)a0);
                bk.hlf[1] = __builtin_amdgcn_ds_read_tr16_b64_v4i16((LAS v4i16_t*)a1);
#pragma unroll
                for (int mf = 0; mf < 2; ++mf) {
                    accF[mf][nf] = __builtin_amdgcn_mfma_f32_16x16x32_bf16(avF[ks][mf], bk.v, accF[mf][nf], 0, 0, 0);
                    accB[mf][nf] = __builtin_amdgcn_mfma_f32_16x16x32_bf16(avB[ks][mf], bk.v, accB[mf][nf], 0, 0, 0);
                }
            }
    }
    if (lat) {
        bf16_t* dF = ws_bf(p, OFF_RS) + ((size_t)((b * 4 + h) * 2 + 0) * 8 + (c + 1)) * 32768;
        bf16_t* dB = ws_bf(p, OFF_RS) + ((size_t)((b * 4 + h) * 2 + 1) * 8 + (c - 1)) * 32768;
#pragma unroll
        for (int mf = 0; mf < 2; ++mf)
#pragma unroll
            for (int nf = 0; nf < 8; ++nf)
#pragma unroll
                for (int r = 0; r < 4; ++r) {
                    const size_t o = (size_t)(dvbase + mf * 16 + g * 4 + r) * 128 + nf * 16 + lc;
                    if (doF) dF[o] = f2bf(accF[mf][nf][r]);
                    if (doB) dB[o] = f2bf(accB[mf][nf][r]);
                }
    } else {
        float* dF = p.out + O_NRET + ((((size_t)b * 2 + l) * 2 + 0) * 4 + h) * 128 * 256;
        float* dB = p.out + O_NRET + ((((size_t)b * 2 + l) * 2 + 1) * 4 + h) * 128 * 256;
#pragma unroll
        for (int mf = 0; mf < 2; ++mf)
#pragma unroll
            for (int nf = 0; nf < 8; ++nf) {
                const size_t o = (size_t)(nf * 16 + lc) * 256 + dvbase + mf * 16 + g * 4;
                *(float4*)(dF + o) = make_float4(accF[mf][nf][0], accF[mf][nf][1], accF[mf][nf][2], accF[mf][nf][3]);
                *(float4*)(dB + o) = make_float4(accB[mf][nf][0], accB[mf][nf][1], accB[mf][nf][2], accB[mf][nf][3]);
            }
    }
}
DEV void phase_ret_kv(CParams& p, int l, unsigned char* lds) {
    for (int item = BIDX(); item < 192; item += GDIM()) ret_kv_tile(p, l, item, lds);
}

DEV void phase_ret_scan(CParams& p, int l, int vb, int nvb) {
    bf16_t* RS = ws_bf(p, OFF_RS);
    const int gt = vb * 512 + TIDX(), gs = nvb * 512;
    for (int idx = gt; idx < 4 * 4 * 2 * 4096; idx += gs) {
        const int dk0 = (idx & 15) * 8, dv = (idx >> 4) & 255, dir = (idx >> 12) & 1, h = (idx >> 13) & 3, b = idx >> 15;
        const float g256 = __expf(ret_logg(p, l, dir, h) * 256.f);
        const float* s0 = p.state_ret + (((((size_t)b * 2 + l) * 2 + dir) * 4 + h) * 128 + dk0) * 256 + dv;
        float st[8];
#pragma unroll
        for (int e = 0; e < 8; ++e) st[e] = s0[(size_t)e * 256];
        bf16_t* base = RS + (size_t)((b * 4 + h) * 2 + dir) * 8 * 32768 + dv * 128 + dk0;
        uint4 kv[7];
#pragma unroll
        for (int j = 0; j < 7; ++j) kv[j] = *(const uint4*)(base + (size_t)(dir == 0 ? j + 1 : 6 - j) * 32768);
        *(uint4*)(base + (size_t)(dir == 0 ? 0 : 7) * 32768) = make_uint4(pk2(st[0], st[1]), pk2(st[2], st[3]), pk2(st[4], st[5]), pk2(st[6], st[7]));
#pragma unroll
        for (int j = 0; j < 7; ++j) {
            st[0] = g256 * st[0] + g8::lo16(kv[j].x); st[1] = g256 * st[1] + g8::hi16(kv[j].x);
            st[2] = g256 * st[2] + g8::lo16(kv[j].y); st[3] = g256 * st[3] + g8::hi16(kv[j].y);
            st[4] = g256 * st[4] + g8::lo16(kv[j].z); st[5] = g256 * st[5] + g8::hi16(kv[j].z);
            st[6] = g256 * st[6] + g8::lo16(kv[j].w); st[7] = g256 * st[7] + g8::hi16(kv[j].w);
            *(uint4*)(base + (size_t)(dir == 0 ? j + 1 : 6 - j) * 32768) = make_uint4(pk2(st[0], st[1]), pk2(st[2], st[3]), pk2(st[4], st[5]), pk2(st[6], st[7]));
        }
    }
}

DEV void ret_out_tile(CParams& p, int l, int item, unsigned char* lds) {
    bf16_t* Pb = ws_bf(p, OFF_P); const bf16_t* RVT = ws_bf(p, OFF_RVT);
    const int tid = TIDX(), lane = tid & 63, w = __builtin_amdgcn_readfirstlane(tid >> 6), g = lane >> 4, lc = lane & 15;
    const bool lat = item < 256;
    int b, h, qb, rowc, qi0, c;
    if (lat) { qb = item & 15; h = (item >> 4) & 3; b = item >> 6; c = qb >> 1; rowc = NCTX + b * 2048 + c * 256; qi0 = (qb & 1) * 128; }
    else { const int it = item - 256; qb = it & 1; h = (it >> 1) & 3; b = it >> 3; c = 0; rowc = b * 256; qi0 = qb * 128; }
    const int qi = qi0 + w * 16 + lc;
    const size_t rowq = (size_t)(rowc + qi);
    const float lgf = ret_logg(p, l, 0, h), lgb = ret_logg(p, l, 1, h);
    const int nstep = lat ? 8 : 4;
    auto dma_step = [&](int sI) __attribute__((always_inline)) {
        LAS unsigned char* base = (LAS unsigned char*)lds + (sI & 1) * 49152;
        if (sI < 4) {
#pragma unroll
            for (int i = 0; i < 2; ++i) {
                const int q = w * 2 + i, row = 4 * q + (lane >> 4), lch = (lane & 15) ^ (row & 15);
                __builtin_amdgcn_global_load_lds((const unsigned*)(Pb + (size_t)(rowc + sI * 64 + row) * PW + C_RK + h * 128 + lch * 8), (LAS unsigned*)(base + q * 1024), 16, 0, 0);
            }
#pragma unroll
            for (int i = 0; i < 4; ++i) {
                const int q = w * 4 + i, row = 8 * q + (lane >> 3), lch = (lane & 7) ^ ((row >> 1) & 7);
                __builtin_amdgcn_global_load_lds((const unsigned*)(RVT + (size_t)(h * 256 + row) * M + rowc + sI * 64 + lch * 8), (LAS unsigned*)(base + 16384 + q * 1024), 16, 0, 0);
            }
        } else {
            const int dir = (sI - 4) >> 1, kh = (sI - 4) & 1;
            const bf16_t* Sg = ws_bf(p, OFF_RS) + ((size_t)((b * 4 + h) * 2 + dir) * 8 + c) * 32768;
#pragma unroll
            for (int i = 0; i < 4; ++i) {
                const int q = w * 4 + i, row = 8 * q + (lane >> 3), lch = (lane & 7) ^ ((row >> 1) & 7);
                __builtin_amdgcn_global_load_lds((const unsigned*)(Sg + (size_t)row * 128 + kh * 64 + lch * 8), (LAS unsigned*)(base + 16384 + q * 1024), 16, 0, 0);
            }
        }
    };
    dma_step(0);
    f32x4 acc[16];
#pragma unroll
    for (int df = 0; df < 16; ++df) acc[df] = (f32x4){0.f, 0.f, 0.f, 0.f};
    const int vsw = (lc >> 1) & 7;
    unsigned char* qsave = lds + 98304 + tid * 64;
    {
        bf16x8 qfr[4];
#pragma unroll
        for (int ks = 0; ks < 4; ++ks) { qfr[ks] = *(const bf16x8*)(Pb + rowq * PW + C_RQ + h * 128 + ks * 32 + g * 8); *(bf16x8*)(qsave + ks * 16) = qfr[ks]; }
#pragma unroll 1
        for (int sI = 0; sI < 4; ++sI) {
            asm volatile("s_waitcnt vmcnt(0)" ::: "memory");
            __syncthreads();
            if (sI + 1 < nstep) dma_step(sI + 1);
            const unsigned char* Ks = lds + (sI & 1) * 49152;
            const unsigned char* Vt = Ks + 16384;
            f32x4 sc[4];
#pragma unroll
            for (int kf = 0; kf < 4; ++kf) sc[kf] = (f32x4){0.f, 0.f, 0.f, 0.f};
#pragma unroll
            for (int kb = 0; kb < 2; ++kb) {
                bf16x8 ak[2][4];
#pragma unroll
                for (int k2 = 0; k2 < 2; ++k2)
#pragma unroll
                    for (int kf = 0; kf < 4; ++kf) ak[k2][kf] = *(const bf16x8*)(Ks + (kf * 16 + lc) * 256 + ((((kb * 2 + k2) * 4 + g) ^ lc) << 4));
                __builtin_amdgcn_sched_barrier(0);
#pragma unroll
                for (int k2 = 0; k2 < 2; ++k2)
#pragma unroll
                    for (int kf = 0; kf < 4; ++kf) sc[kf] = __builtin_amdgcn_mfma_f32_16x16x32_bf16(ak[k2][kf], qfr[kb * 2 + k2], sc[kf], 0, 0, 0);
                __builtin_amdgcn_sched_barrier(0);
            }
            bf16x8 pb[2];
#pragma unroll
            for (int kf = 0; kf < 4; ++kf)
#pragma unroll
                for (int r = 0; r < 4; ++r) {
                    const int dd = qi - (sI * 64 + kf * 16 + g * 4 + r);
                    float wgt = 0.f;
                    if (dd >= 0) wgt += __expf(lgf * (float)dd);
                    if (dd <= 0) wgt += __expf(lgb * (float)(-dd));
                    pb[kf >> 1][(kf & 1) * 4 + r] = (short)f2bf(sc[kf][r] * wgt);
                }
#pragma unroll
            for (int s2 = 0; s2 < 2; ++s2)
#pragma unroll
                for (int db = 0; db < 2; ++db) {
                    uint2 lo[8], hi[8];
#pragma unroll
                    for (int j = 0; j < 8; ++j) {
                        const unsigned char* vr = Vt + ((db * 8 + j) * 16 + lc) * 128 + 8 * (g & 1);
                        lo[j] = *(const uint2*)(vr + (((4 * s2 + (g >> 1)) ^ vsw) << 4));
                        hi[j] = *(const uint2*)(vr + (((4 * s2 + 2 + (g >> 1)) ^ vsw) << 4));
                    }
                    __builtin_amdgcn_sched_barrier(0);
#pragma unroll
                    for (int j = 0; j < 8; ++j) {
                        union { uint4 u; bf16x8 v; } av; av.u = make_uint4(lo[j].x, lo[j].y, hi[j].x, hi[j].y);
                        acc[db * 8 + j] = __builtin_amdgcn_mfma_f32_16x16x32_bf16(av.v, pb[s2], acc[db * 8 + j], 0, 0, 0);
                    }
                    __builtin_amdgcn_sched_barrier(0);
                }
        }
    }
    if (lat) {
#pragma unroll 1
        for (int dir = 0; dir < 2; ++dir) {
            const float qs = dir == 0 ? __expf(lgf * (float)(qi + 1)) : __expf(lgb * (float)(256 - qi));
            bf16x8 qx[4];
#pragma unroll
            for (int ks = 0; ks < 4; ++ks) {
                const bf16x8 qv = *(const bf16x8*)(qsave + ks * 16);
#pragma unroll
                for (int e = 0; e < 8; ++e) qx[ks][e] = (short)f2bf(qs * bf2f((bf16_t)qv[e]));
            }
#pragma unroll
            for (int kh = 0; kh < 2; ++kh) {
                const int sI = 4 + dir * 2 + kh;
                asm volatile("s_waitcnt vmcnt(0)" ::: "memory");
                __syncthreads();
                if (sI + 1 < nstep) dma_step(sI + 1);
                const unsigned char* Vt = lds + (sI & 1) * 49152 + 16384;
#pragma unroll
                for (int db = 0; db < 4; ++db) {
                    bf16x8 as0[4], as1[4];
#pragma unroll
                    for (int j = 0; j < 4; ++j) {
                        as0[j] = *(const bf16x8*)(Vt + ((db * 4 + j) * 16 + lc) * 128 + (((0 + g) ^ vsw) << 4));
                        as1[j] = *(const bf16x8*)(Vt + ((db * 4 + j) * 16 + lc) * 128 + (((4 + g) ^ vsw) << 4));
                    }
                    __builtin_amdgcn_sched_barrier(0);
#pragma unroll
                    for (int j = 0; j < 4; ++j) {
                        acc[db * 4 + j] = __builtin_amdgcn_mfma_f32_16x16x32_bf16(as0[j], qx[kh * 2 + 0], acc[db * 4 + j], 0, 0, 0);
                        acc[db * 4 + j] = __builtin_amdgcn_mfma_f32_16x16x32_bf16(as1[j], qx[kh * 2 + 1], acc[db * 4 + j], 0, 0, 0);
                    }
                    __builtin_amdgcn_sched_barrier(0);
                }
            }
        }
    }
    float s1 = 0.f;
#pragma unroll
    for (int df = 0; df < 16; ++df) s1 += (acc[df][0] + acc[df][1]) + (acc[df][2] + acc[df][3]);
    s1 = xrow16_sum(s1);
    const float mu = s1 * (1.f / 256.f);
    float s2 = 0.f;
#pragma unroll
    for (int df = 0; df < 16; ++df)
#pragma unroll
        for (int r = 0; r < 4; ++r) { const float xc = acc[df][r] - mu; s2 += xc * xc; }
    s2 = xrow16_sum(s2);
    const float rstd = rsqrtf(s2 * (1.f / 256.f) + EPS);
#pragma unroll
    for (int df = 0; df < 16; ++df) {
        bf16_t* gp = Pb + rowq * PW + C_RG + h * 256 + df * 16 + g * 4;
        const uint2 gv = *(const uint2*)gp;
        uint2 o;
        o.x = pk2((acc[df][0] - mu) * rstd * __uint_as_float(gv.x << 16), (acc[df][1] - mu) * rstd * __uint_as_float(gv.x & 0xffff0000u));
        o.y = pk2((acc[df][2] - mu) * rstd * __uint_as_float(gv.y << 16), (acc[df][3] - mu) * rstd * __uint_as_float(gv.y & 0xffff0000u));
        *(uint2*)gp = o;
    }
}
DEV void phase_ret_out(CParams& p, int l, unsigned char* lds) {
    if (GDIM() == 256) {
        const int xg = BIDX() & 7, j = BIDX() >> 3;
        ret_out_tile(p, l, ((j >> 1) * 8 + xg) * 2 + (j & 1), lds);
        if (j < 16) ret_out_tile(p, l, 256 + ((j >> 1) * 8 + xg) * 2 + (j & 1), lds);
        return;
    }
    for (int item = BIDX(); item < 384; item += GDIM()) ret_out_tile(p, l, item, lds);
}

template <bool REV>
DEV void lru_scan16(const float (&a)[4][4], const float (&u)[4][4], float cin, int g, int lc, float (&h)[4][4], float& cout, float& Aprod) {
    float carry = cin, Ap = 1.f;
#pragma unroll
    for (int ii = 0; ii < 4; ++ii) {
        const int i = REV ? 3 - ii : ii;
        float hl[4], cp[4];
        {
            float hh = 0.f, cc = 1.f;
#pragma unroll
            for (int rr = 0; rr < 4; ++rr) { const int r = REV ? 3 - rr : rr; hh = a[i][r] * hh + u[i][r]; cc *= a[i][r]; hl[r] = hh; cp[r] = cc; }
        }
        const float As = REV ? cp[0] : cp[3], Hs = REV ? hl[0] : hl[3];
        float Ag[4], Hg[4];
        xrow16_gather(As, Ag); xrow16_gather(Hs, Hg);
        float cur = carry, mine = carry;
#pragma unroll
        for (int sI = 0; sI < 4; ++sI) {
            const int gg = REV ? 3 - sI : sI;
            mine = (g == gg) ? cur : mine;
            cur = Ag[gg] * cur + Hg[gg];
            Ap *= Ag[gg];
        }
        carry = cur;
#pragma unroll
        for (int r = 0; r < 4; ++r) h[i][r] = hl[r] + cp[r] * mine;
    }
    cout = carry; Aprod = Ap;
}

template <bool REV>
DEV void lru_dir(const unsigned char* xa, const bf16x8 (&bA)[4], const bf16x8 (&bX)[4], float ba, float bx, float c2, float cin,
                 const float (&x)[4][4], int g, int lc, float (&h)[4][4], float& cout, float& Ap) {
    f32x4 accA[4], accX[4];
#pragma unroll
    for (int i = 0; i < 4; ++i) { accA[i] = (f32x4){0.f, 0.f, 0.f, 0.f}; accX[i] = (f32x4){0.f, 0.f, 0.f, 0.f}; }
#pragma unroll
    for (int ks = 0; ks < 4; ++ks)
#pragma unroll
        for (int i = 0; i < 4; ++i) {
            const bf16x8 af = *(const bf16x8*)(xa + (i * 16 + lc) * 256 + (((ks * 4 + g) ^ lc) << 4));
            accA[i] = __builtin_amdgcn_mfma_f32_16x16x32_bf16(af, bA[ks], accA[i], 0, 0, 0);
            accX[i] = __builtin_amdgcn_mfma_f32_16x16x32_bf16(af, bX[ks], accX[i], 0, 0, 0);
        }
    float a[4][4], u[4][4];
#pragma unroll
    for (int i = 0; i < 4; ++i)
#pragma unroll
        for (int r = 0; r < 4; ++r) {
            const float rg = sigmf(accA[i][r] + ba), ig = sigmf(accX[i][r] + bx);
            const float av = __builtin_amdgcn_exp2f(rg * c2);
            a[i][r] = av;
            u[i][r] = __builtin_amdgcn_sqrtf(fmaxf(1.f - av * av, 0.f)) * (ig * x[i][r]);
        }
    lru_scan16<REV>(a, u, cin, g, lc, h, cout, Ap);
}

DEV void phase_lru_tiles(CParams& p, int l, int mode, unsigned char* lds) {
    unsigned char* xa = lds; float* hs = (float*)(lds + 16384); float* cwl = (float*)(lds + 49152); unsigned char* rawb = lds + 53248;
    bf16_t* Pb = ws_bf(p, OFF_P);
    const int tid = TIDX(), lane = tid & 63, w = __builtin_amdgcn_readfirstlane(tid >> 6), g = lane >> 4, lc = lane & 15;
    const int blk = BIDX() & 7, gstep = GDIM() >> 3;
    const int cl = w * 16 + lc, ch = blk * 128 + cl;
    for (int e = tid; e < 5 * 128; e += 512) {
        const int j = e >> 7, c = e & 127;
        cwl[e] = j < 4 ? p.conv_w[(size_t)(l * 4 + j) * D + blk * 128 + c] : p.conv_b[(size_t)l * D + blk * 128 + c];
    }
    bf16x8 bAf[4], bXf[4], bAb[4], bXb[4];
    {
        const bf16_t* W = ws_bf(p, OFF_LRUW) + ((size_t)blk * 128 + cl) * 128 + g * 8;
#pragma unroll
        for (int ks = 0; ks < 4; ++ks) {
            bAf[ks] = *(const bf16x8*)(W + ks * 32);
            bXf[ks] = *(const bf16x8*)(W + (size_t)1 * 8 * 16384 + ks * 32);
            bAb[ks] = *(const bf16x8*)(W + (size_t)2 * 8 * 16384 + ks * 32);
            bXb[ks] = *(const bf16x8*)(W + (size_t)3 * 8 * 16384 + ks * 32);
        }
    }
    const float baF = p.lru_ba[(l * 2 + 0) * D + ch], bxF = p.lru_bx[(l * 2 + 0) * D + ch];
    const float baB = p.lru_ba[(l * 2 + 1) * D + ch], bxB = p.lru_bx[(l * 2 + 1) * D + ch];
    const float c2F = -8.f * 1.4426950408889634f * softplusf(-p.lru_lambda[(l * 2 + 0) * D + ch]);
    const float c2B = -8.f * 1.4426950408889634f * softplusf(-p.lru_lambda[(l * 2 + 1) * D + ch]);
    float* LA = (float*)(p.ws + OFF_LRUC);
    float* LH = LA + 192 * 2 * 1024;
    const int chunk = tid & 15, chb = blk * 128 + chunk * 8, trow = tid >> 4;
#define LRU_PREFETCH(gcn) do { const bf16_t* src_ = Pb + (long)((gcn) * 64 - 1 + (lane >> 4)) * (long)PW + C_LX + blk * 128 + (lane & 15) * 8; \
        _Pragma("unroll") for (int q_ = 0; q_ < 3; ++q_) { const int qq_ = w + 8 * q_; if (qq_ < 17) \
            __builtin_amdgcn_global_load_lds((const unsigned*)(src_ + (long)qq_ * 4 * PW), (LAS unsigned*)((LAS unsigned char*)rawb + qq_ * 1024), 16, 0, 0); } } while (0)
    int gc = BIDX() >> 3;
    if (gc < 192) LRU_PREFETCH(gc);
    for (; gc < 192; gc += gstep) {
        const int m0 = gc * 64;
        const bool lat = m0 >= NCTX;
        const int L = lat ? 2048 : 256, t0 = lat ? ((m0 - NCTX) & 2047) : (m0 & 255);
        asm volatile("s_waitcnt vmcnt(0)" ::: "memory");
        __syncthreads();
#pragma unroll
        for (int i = 0; i < 2; ++i) {
            const int tt = trow + 32 * i;
            float acc[8];
#pragma unroll
            for (int e = 0; e < 8; ++e) acc[e] = cwl[4 * 128 + chunk * 8 + e];
#pragma unroll
            for (int j = 0; j < 4; ++j) {
                const int tp = t0 + tt + j - 1;
                if (tp >= 0 && tp < L) {
                    const uint4 v = *(const uint4*)(rawb + (tt + j) * 256 + chunk * 16);
                    const float* cw = cwl + j * 128 + chunk * 8;
                    acc[0] += cw[0] * __uint_as_float(v.x << 16); acc[1] += cw[1] * __uint_as_float(v.x & 0xffff0000u);
                    acc[2] += cw[2] * __uint_as_float(v.y << 16); acc[3] += cw[3] * __uint_as_float(v.y & 0xffff0000u);
                    acc[4] += cw[4] * __uint_as_float(v.z << 16); acc[5] += cw[5] * __uint_as_float(v.z & 0xffff0000u);
                    acc[6] += cw[6] * __uint_as_float(v.w << 16); acc[7] += cw[7] * __uint_as_float(v.w & 0xffff0000u);
                }
            }
            uint4 o;
            o.x = pk2(acc[0], acc[1]); o.y = pk2(acc[2], acc[3]);
            o.z = pk2(acc[4], acc[5]); o.w = pk2(acc[6], acc[7]);
            *(uint4*)(xa + tt * 256 + ((chunk ^ (tt & 15)) << 4)) = o;
        }
        __syncthreads();
        if (gc + gstep < 192) LRU_PREFETCH(gc + gstep);
        const size_t ci = ((size_t)gc * 2) * 1024 + ch;
        const float cinF = mode ? LH[ci] : 0.f, cinB = mode ? LH[ci + 1024] : 0.f;
        uint4 gv[2];
        if (mode) {
#pragma unroll
            for (int i = 0; i < 2; ++i) gv[i] = *(const uint4*)(Pb + (size_t)(m0 + trow + 32 * i) * PW + C_LG + chb);
        }
        {
            float x[4][4];
#pragma unroll
            for (int i = 0; i < 4; ++i)
#pragma unroll
                for (int r = 0; r < 4; ++r) {
                    const int tok = i * 16 + g * 4 + r;
                    x[i][r] = bf2f(*(const bf16_t*)(xa + tok * 256 + (((cl >> 3) ^ (tok & 15)) << 4) + (cl & 7) * 2));
                }
            float h[4][4], cout, Ap;
            lru_dir<false>(xa, bAf, bXf, baF, bxF, c2F, cinF, x, g, lc, h, cout, Ap);
            if (!mode) { if (g == 0) { LA[ci] = Ap; LH[ci] = cout; } }
            else {
#pragma unroll
                for (int i = 0; i < 4; ++i)
#pragma unroll
                    for (int r = 0; r < 4; ++r) hs[(i * 16 + g * 4 + r) * 128 + cl] = h[i][r];
                if (!lat && g == 0 && t0 == 192) p.out[O_NLRU + ((size_t)((m0 >> 8) * 2 + l) * 2 + 0) * 1024 + ch] = cout;
            }
            lru_dir<true>(xa, bAb, bXb, baB, bxB, c2B, cinB, x, g, lc, h, cout, Ap);
            if (!mode) { if (g == 0) { LA[ci + 1024] = Ap; LH[ci + 1024] = cout; } }
            else {
#pragma unroll
                for (int i = 0; i < 4; ++i)
#pragma unroll
                    for (int r = 0; r < 4; ++r) hs[(i * 16 + g * 4 + r) * 128 + cl] += h[i][r];
                if (!lat && g == 0 && t0 == 0) p.out[O_NLRU + ((size_t)((m0 >> 8) * 2 + l) * 2 + 1) * 1024 + ch] = cout;
            }
        }
        if (mode) {
            __syncthreads();
#pragma unroll
            for (int i = 0; i < 2; ++i) {
                const int tt = trow + 32 * i, c8 = chunk * 8;
                const float4 h0 = *(const float4*)(hs + tt * 128 + c8), h1 = *(const float4*)(hs + tt * 128 + c8 + 4);
                uint4 o;
                o.x = pk2(h0.x * __uint_as_float(gv[i].x << 16), h0.y * __uint_as_float(gv[i].x & 0xffff0000u));
                o.y = pk2(h0.z * __uint_as_float(gv[i].y << 16), h0.w * __uint_as_float(gv[i].y & 0xffff0000u));
                o.z = pk2(h1.x * __uint_as_float(gv[i].z << 16), h1.y * __uint_as_float(gv[i].z & 0xffff0000u));
                o.w = pk2(h1.z * __uint_as_float(gv[i].w << 16), h1.w * __uint_as_float(gv[i].w & 0xffff0000u));
                *(uint4*)(Pb + (size_t)(m0 + tt) * PW + C_LG + chb) = o;
            }
        }
    }
    asm volatile("s_waitcnt vmcnt(0)" ::: "memory");
    __syncthreads();
#undef LRU_PREFETCH
}

DEV void phase_lru_carry(CParams& p, int l, int vb, int nvb) {
    float* LA = (float*)(p.ws + OFF_LRUC);
    float* LH = LA + 192 * 2 * 1024;
    const int gt = vb * 512 + TIDX(), gs = nvb * 512;
    for (int idx = gt; idx < 20 * 2 * 1024; idx += gs) {
        const int ch = idx & 1023, dir = (idx >> 10) & 1, seq = idx >> 11;
        const bool lat = seq >= 16;
        const int nch = lat ? 32 : 4;
        const int gc0 = lat ? 64 + (seq - 16) * 32 : seq * 4;
        float carry = lat ? p.state_lru[((size_t)((seq - 16) * 2 + l) * 2 + dir) * 1024 + ch] : 0.f;
        for (int s0 = 0; s0 < nch; s0 += 4) {
            float A[4], Hh[4]; size_t ci[4];
#pragma unroll
            for (int k = 0; k < 4; ++k) {
                const int sI = s0 + k, cidx = dir == 0 ? sI : nch - 1 - sI;
                ci[k] = ((size_t)(gc0 + cidx) * 2 + dir) * 1024 + ch;
                A[k] = LA[ci[k]]; Hh[k] = LH[ci[k]];
            }
#pragma unroll
            for (int k = 0; k < 4; ++k) { LH[ci[k]] = carry; carry = A[k] * carry + Hh[k]; }
        }
    }
}

DEV CParams* KARGS() { CParams* kp = (CParams*)__builtin_amdgcn_kernarg_segment_ptr(); asm volatile("" : "+s"(kp)); return kp; }

#define XB_TMO      128
#define XB_XCNT(j)  (256  + 64 * (j))
#define XB_XSUB(j)  (1280 + 64 * (j))
#define XB_XGEN(j)  (2304 + 64 * (j))
#define XB_TOP      3328
#define XB_TOPGEN   3392
#define XCD_BAR_WORDS 3456
#define XB_SPIN_CAP (1u << 18)
DEV unsigned xb_ld(unsigned* p)              { return __hip_atomic_load(p, __ATOMIC_RELAXED, __HIP_MEMORY_SCOPE_AGENT); }
DEV unsigned xb_add(unsigned* p, unsigned v) { return __hip_atomic_fetch_add(p, v, __ATOMIC_RELAXED, __HIP_MEMORY_SCOPE_AGENT); }
DEV unsigned xb_xcc_id() { return (unsigned)__builtin_amdgcn_s_getreg((3 << 11) | 20) & 0xFu; }
#define XB_SPIN(cond, bar) do { unsigned _sp = 0; while (cond) { __builtin_amdgcn_s_sleep(1); \
    if ((++_sp & 255u) == 0u) { if (xb_ld(&(bar)[XB_TMO])) break; if (_sp > XB_SPIN_CAP) { atomicAdd(&(bar)[XB_TMO], 1u); break; } } } } while (0)
struct XcdBarrier { unsigned* bar; unsigned x; volatile LAS unsigned* st; };
DEV XcdBarrier xcd_barrier_post(unsigned* bar, volatile LAS unsigned* st) {
    XcdBarrier b; b.bar = bar; b.x = xb_xcc_id(); b.st = st;
    if (threadIdx.x == 0) (void)xb_add(&bar[XB_XCNT(b.x)], 1u);
    return b;
}
DEV void xcd_barrier_complete(unsigned* bar, unsigned x, unsigned& nloc, unsigned& nx) {
    const unsigned G = gridDim.x * gridDim.y * gridDim.z;
    unsigned sum, cnt, mine, sp = 0u;
    for (;;) {
        sum = 0u; cnt = 0u; mine = 0u;
#pragma unroll
        for (unsigned j = 0; j < 16; ++j) { const unsigned c = xb_ld(&bar[XB_XCNT(j)]); sum += c; cnt += (c > 0u) ? 1u : 0u; mine = (j == x) ? c : mine; }
        if (sum == G) break;
        __builtin_amdgcn_s_sleep(1);
        if ((++sp & 255u) == 0u) { if (xb_ld(&bar[XB_TMO])) break; if (sp > XB_SPIN_CAP) { atomicAdd(&bar[XB_TMO], 1u); break; } }
    }
    nloc = mine > 0u ? mine : 1u; nx = cnt > 0u ? cnt : 1u;
}
DEV void xcd_barrier(const XcdBarrier& b0) {
    asm volatile("s_waitcnt vmcnt(0)" ::: "memory");
    __syncthreads();
    if (threadIdx.x == 0) {
        XcdBarrier b; b.x = b0.x; b.st = b0.st;
        asm volatile("" : "+s"(b.x));
        unsigned* bar = (unsigned*)(KARGS()->ws + OFF_BAR);
        __builtin_amdgcn_s_waitcnt(0);
        unsigned nloc = b.st[0], nx = b.st[1];
        if (nloc == 0u) { xcd_barrier_complete(bar, b.x, nloc, nx); b.st[0] = nloc; b.st[1] = nx; }
        const unsigned old = xb_add(&bar[XB_XSUB(b.x)], 1u);
        const unsigned gen = old / nloc;
        if (old + 1u == (gen + 1u) * nloc) {
            __builtin_amdgcn_fence(__ATOMIC_RELEASE, "agent");
            asm volatile("s_waitcnt vmcnt(0)" ::: "memory");
            const unsigned og = xb_add(&bar[XB_TOP], 1u);
            const unsigned tg = og / nx;
            if (og + 1u == (tg + 1u) * nx) xb_add(&bar[XB_TOPGEN], 1u);
            else XB_SPIN(xb_ld(&bar[XB_TOPGEN]) == tg, bar);
            __builtin_amdgcn_fence(__ATOMIC_ACQUIRE, "agent");
            xb_add(&bar[XB_XGEN(b.x)], 1u);
            asm volatile("s_waitcnt vmcnt(0)" ::: "memory");
        } else {
            XB_SPIN(xb_ld(&bar[XB_XGEN(b.x)]) == gen, bar);
            __builtin_amdgcn_fence(__ATOMIC_ACQUIRE, "agent");
            asm volatile("s_waitcnt vmcnt(0)" ::: "memory");
        }
    }
    __syncthreads();
}

enum { PH_INIT = 0, PH_PRENORM, PH_GEMM1, PH_MIX1, PH_MIX2, PH_MIX3, PH_MERGE, PH_MERGE2, PH_OUT, PH_COUNT };

DEV void run_phase(CParams& p, int ph, int l, unsigned char* lds) {
    switch (ph) {
    case PH_INIT:    phase_mod(p, (float*)lds); phase_rope_table(p); __syncthreads(); phase_convert(p, 0, (float*)lds); break;
    case PH_PRENORM: phase_prenorm(p, l); break;
    case PH_GEMM1:   phase8_gemm1(p, l, (LAS unsigned char*)lds); break;
    case PH_MIX1:    phase_attn(p, l, lds); __syncthreads(); phase_lru_tiles(p, l, 0, lds); __syncthreads(); phase_ret_kv(p, l, lds); break;
    case PH_MIX2:
        if (GDIM() == 256) {
            if (BIDX() < 192) phase8_merge(p, l, 2, (LAS unsigned char*)lds);
            else { phase_lru_carry(p, l, BIDX() - 192, 64); phase_ret_scan(p, l, BIDX() - 192, 64); }
        } else { phase_lru_carry(p, l, BIDX(), GDIM()); phase_ret_scan(p, l, BIDX(), GDIM()); }
        if (l == 1) phase_convert(p, 1, (float*)lds, 2);
        break;
    case PH_MIX3:    phase_lru_tiles(p, l, 1, lds); __syncthreads(); phase_ret_out(p, l, lds); break;
    case PH_MERGE:   phase8_merge(p, l, 0, (LAS unsigned char*)lds); break;
    case PH_MERGE2:  phase8_merge(p, l, 1, (LAS unsigned char*)lds); break;
    case PH_OUT:     phase8_out(p, l, (LAS unsigned char*)lds); if (l == 0) phase_convert(p, 1, (float*)lds, 1, 192); break;
    }
}

#if !ONE_LAUNCH
__global__ void __launch_bounds__(512, 2) phase_kernel(Params p, int ph, int l) {
    extern __shared__ __attribute__((aligned(16))) unsigned char dsm[];
    run_phase(p, ph, l, dsm);
}
#else
#ifndef PROBE_MASK
#define PROBE_MASK 0
#endif
#define PROBE_MULT 8
__global__ void __launch_bounds__(512, 2) mega_kernel(Params p) {
    extern __shared__ __attribute__((aligned(16))) unsigned char dsm[];
    cg::grid_group grid = cg::this_grid();
    volatile LAS unsigned* st = (volatile LAS unsigned*)((LAS unsigned char*)dsm + g8::STAGE_BYTES);
    if (threadIdx.x < 4) st[threadIdx.x] = 0u;
    __syncthreads();
    const XcdBarrier xb = xcd_barrier_post((unsigned*)(KARGS()->ws + OFF_BAR), st);
#define GSYNC() xcd_barrier(xb)
#if PROBE_MASK
    long long t_acc = 0, t0 = 0;
#define PROBE_BEGIN(ph) if ((PROBE_MASK >> (ph)) & 1) t0 = wall_clock64();
#define PROBE_END(ph) if ((PROBE_MASK >> (ph)) & 1) t_acc += wall_clock64() - t0;
#else
#define PROBE_BEGIN(ph)
#define PROBE_END(ph)
#endif
    if (KARGS()->out == nullptr) grid.sync();
    PROBE_BEGIN(PH_INIT) run_phase(*KARGS(), PH_INIT, 0, dsm); GSYNC(); PROBE_END(PH_INIT)
    PROBE_BEGIN(PH_PRENORM) run_phase(*KARGS(), PH_PRENORM, 0, dsm); GSYNC(); PROBE_END(PH_PRENORM)
    for (int l = 0; l < 2; ++l) {
        for (int ph = PH_GEMM1; ph <= PH_OUT; ++ph) {
            PROBE_BEGIN(ph)
            run_phase(*KARGS(), ph, l, dsm);
            if (!(l == 1 && ph == PH_OUT)) GSYNC();
            PROBE_END(ph)
        }
    }
#if PROBE_MASK
    if (blockIdx.x == 0 && threadIdx.x == 0) {
        const long long tgt = wall_clock64() + (long long)PROBE_MULT * t_acc;
        while (wall_clock64() < tgt) __builtin_amdgcn_s_sleep(8);
    }
#endif
}
#endif

extern "C" void kernel_launch(void* const* d_in, const int* in_sizes, int n_in,
                              void* d_out, int out_size, void* d_ws, size_t ws_size,
                              hipStream_t stream) {
    constexpr size_t kDynLds = LDS_XOFF + 5120;
    static int grid_blocks = 0;
    if (grid_blocks == 0) {
        if (n_in != 26 || ws_size < WS_NEED || out_size != 25231360) {
            fprintf(stderr, "kernel_launch: unexpected n_in %d / ws_size %zu (need %zu) / out_size %d\n", n_in, ws_size, (size_t)WS_NEED, out_size);
            grid_blocks = -1; return;
        }
        int dev = 0, cus = 0, per_cu = 0;
        (void)hipGetDevice(&dev);
        (void)hipDeviceGetAttribute(&cus, hipDeviceAttributeMultiprocessorCount, dev);
#if ONE_LAUNCH
        const void* kfn = (const void*)mega_kernel;
#else
        const void* kfn = (const void*)phase_kernel;
#endif
        if (hipFuncSetAttribute(kfn, hipFuncAttributeMaxDynamicSharedMemorySize, (int)kDynLds) != hipSuccess) {
            fprintf(stderr, "kernel_launch: hipFuncSetAttribute failed\n"); grid_blocks = -1; return;
        }
        if (hipOccupancyMaxActiveBlocksPerMultiprocessor(&per_cu, kfn, 512, kDynLds) != hipSuccess || per_cu < 1) {
            fprintf(stderr, "kernel_launch: occupancy query says %d blocks per CU\n", per_cu); grid_blocks = -1; return;
        }
        grid_blocks = cus & ~7;
    }
    if (grid_blocks < 0) return;
    Params p{};
    const float** pp = (const float**)&p;
    for (int i = 0; i < 26; ++i) pp[i] = (const float*)d_in[i];
    p.out = (float*)d_out;
    p.ws = (unsigned char*)d_ws;
#if ONE_LAUNCH
    (void)hipMemsetAsync((unsigned char*)d_ws + OFF_BAR, 0, 16384 + 1024, stream);
    void* args[] = {&p};
    hipError_t e = hipLaunchCooperativeKernel((const void*)mega_kernel, dim3(grid_blocks), dim3(512), args, kDynLds, stream);
    if (e != hipSuccess) fprintf(stderr, "cooperative launch failed: %s (grid %d)\n", hipGetErrorString(e), grid_blocks);
#else
    phase_kernel<<<grid_blocks, 512, kDynLds, stream>>>(p, PH_INIT, 0);
    phase_kernel<<<grid_blocks, 512, kDynLds, stream>>>(p, PH_PRENORM, 0);
    for (int l = 0; l < 2; ++l)
        for (int ph = PH_GEMM1; ph <= PH_OUT; ++ph)
            phase_kernel<<<grid_blocks, 512, kDynLds, stream>>>(p, ph, l);
#endif
}
```

```cpp
#include <hip/hip_runtime.h>
#include <hip/hip_cooperative_groups.h>
#include <cstdio>
#include <cstdint>
namespace cg = cooperative_groups;

#ifndef ONE_LAUNCH
#define ONE_LAUNCH 1
#endif

typedef unsigned short bf16_t;
#define DEV __device__ __forceinline__

constexpr int D = 1024;
constexpr int NCTX = 4096;
constexpr int NLAT = 8192;
constexpr int M = NCTX + NLAT;
constexpr int NW = 7680;
constexpr int N_RQ = 0, N_RK = 512, N_RV = 1024, N_RG = 2048, N_LX = 3072, N_LG = 4096,
              N_AQ = 5120, N_AK = 6144, N_AV = 6400, N_AG = 6656;
constexpr int PW = 6656;
constexpr int C_RQ = 0, C_RK = 512, C_RG = 1024, C_LX = 2048, C_LG = 3072,
              C_AQ = 4096, C_AK = 5120, C_AV = 5376, C_AG = 5632;
constexpr float EPS = 1e-6f;

constexpr size_t O_YP = 0, O_YS = 4194304, O_NK = 12582912, O_NV = 14680064, O_NRET = 16777216, O_NLRU = 25165824;

constexpr size_t OFF_MOD  = 0;
constexpr size_t OFF_LRUW = 122880;
constexpr size_t OFF_WBR  = OFF_LRUW + 1048576;
constexpr size_t OFF_WOUT = OFF_WBR + 6291456;
constexpr size_t OFF_WMG  = OFF_WOUT + 2097152;
constexpr size_t OFF_H    = OFF_WMG + 6291456;
constexpr size_t OFF_P    = OFF_H + (size_t)M * 1024 * 2;
constexpr size_t OFF_RVT  = OFF_P + (size_t)M * PW * 2;
constexpr size_t OFF_W1T  = OFF_RVT + (size_t)1024 * M * 2;
constexpr size_t OFF_OFTMP = OFF_W1T;
constexpr size_t OFF_LRUC = 262266880;
constexpr size_t OFF_ROPE = OFF_LRUC + (size_t)2 * 192 * 2 * 1024 * 4;
constexpr size_t OFF_BAR  = OFF_ROPE + (size_t)2048 * 96 * 8;
constexpr size_t OFF_XC   = OFF_BAR + 16384;
constexpr size_t OFF_XP   = OFF_XC + 1024;
constexpr size_t WS_NEED  = OFF_XP + 983040;
constexpr int LDS_XOFF = 131072 + 64;
static_assert(OFF_OFTMP + (size_t)M * 1024 * 2 <= OFF_LRUC, "overlap");
static_assert(WS_NEED <= 268435456, "ws budget");

struct Params;
typedef const __attribute__((address_space(4))) Params CParams;
struct Params {
    const float *x_prompt, *x_sample, *cache_k, *cache_v, *state_ret, *state_lru, *c, *c_ctx,
                *w_ada, *b_ada, *norm_pre, *norm_post, *w_in, *ret_decay, *conv_w, *conv_b,
                *lru_wa, *lru_ba, *lru_wx, *lru_bx, *lru_lambda, *att_sink, *w_branch, *w_merge, *b_merge, *w_out;
    float* out;
    unsigned char* ws;
};

DEV int BIDX() { int b = (int)blockIdx.x; asm volatile("" : "+s"(b)); return b; }
DEV int GDIM() { int g = (int)gridDim.x; asm volatile("" : "+s"(g)); return g; }
DEV int TIDX() { int t = threadIdx.x; asm volatile("" : "+v"(t)); return t; }
DEV float bf2f(bf16_t v) { return __uint_as_float(((unsigned)v) << 16); }
typedef __bf16 bf16x2_t __attribute__((ext_vector_type(2)));
DEV bf16_t f2bf(float f) { return __builtin_bit_cast(unsigned short, (__bf16)f); }
DEV unsigned pk2(float lo, float hi) { bf16x2_t v; v[0] = (__bf16)lo; v[1] = (__bf16)hi; return __builtin_bit_cast(unsigned, v); }
DEV float sigmf(float z) { return __builtin_amdgcn_rcpf(1.f + __builtin_amdgcn_exp2f(-1.4426950408889634f * z)); }
DEV float siluf(float x) { return x * sigmf(x); }
DEV float softplusf(float x) { return fmaxf(x, 0.f) + log1pf(__expf(-fabsf(x))); }

DEV float* ws_mod(CParams& p) { return (float*)(p.ws + OFF_MOD); }
DEV bf16_t* ws_bf(CParams& p, size_t off) { return (bf16_t*)(p.ws + off); }

DEV const float* x_row(CParams& p, int l, int m) {
    const float* xp = p.x_prompt; const float* xs = p.x_sample; const float* po = p.out;
    if (l == 0) return m < NCTX ? xp + (size_t)m * D : xs + (size_t)(m - NCTX) * D;
    return po + (size_t)m * D;
}
DEV int cond_row(int m) { return m < NCTX ? 0 : 1 + ((m - NCTX) >> 11); }

DEV float wave_sum(float v) {
#pragma unroll
    for (int o = 1; o < 64; o <<= 1) v += __shfl_xor(v, o);
    return v;
}
DEV float xrow16_max(float x) {
    auto s = __builtin_amdgcn_permlane16_swap(__float_as_uint(x), __float_as_uint(x), false, false);
    x = fmaxf(__uint_as_float(s[0]), __uint_as_float(s[1]));
    auto t = __builtin_amdgcn_permlane32_swap(__float_as_uint(x), __float_as_uint(x), false, false);
    return fmaxf(__uint_as_float(t[0]), __uint_as_float(t[1]));
}
DEV float xrow16_sum(float x) {
    auto s = __builtin_amdgcn_permlane16_swap(__float_as_uint(x), __float_as_uint(x), false, false);
    x = __uint_as_float(s[0]) + __uint_as_float(s[1]);
    auto t = __builtin_amdgcn_permlane32_swap(__float_as_uint(x), __float_as_uint(x), false, false);
    return __uint_as_float(t[0]) + __uint_as_float(t[1]);
}
DEV void xrow16_gather(float x, float (&v)[4]) {
    auto s = __builtin_amdgcn_permlane16_swap(__float_as_uint(x), __float_as_uint(x), false, false);
    auto e = __builtin_amdgcn_permlane32_swap(s[0], s[0], false, false);
    auto o = __builtin_amdgcn_permlane32_swap(s[1], s[1], false, false);
    v[0] = __uint_as_float(e[0]); v[1] = __uint_as_float(o[0]); v[2] = __uint_as_float(e[1]); v[3] = __uint_as_float(o[1]);
}
DEV void phase_mod(CParams& p, float* lds) {
    float* mod = ws_mod(p);
    float* sl = lds;
    float* part = lds + 1024;
    unsigned* lastf = (unsigned*)(lds + 1024 + 8 * 5 * 256);
    const int tid = TIDX(), lane = tid & 63, w = tid >> 6;
    const float* cctx = p.c_ctx; const float* cb_ = p.c;
    unsigned* MPu = (unsigned*)(p.ws + OFF_XP);
    unsigned* cnt = (unsigned*)(p.ws + OFF_XC) + 192;
    for (int unit = BIDX(); unit < 192; unit += GDIM()) {
        const int ks = unit & 7, cbk = (unit >> 3) % 12, l = unit / 96;
        __syncthreads();
        for (int e = tid; e < 5 * 128; e += 512) { const int r = e >> 7, k = ks * 128 + (e & 127); sl[e] = siluf(r == 0 ? cctx[k] : cb_[(r - 1) * D + k]); }
        __syncthreads();
        const float* wp = p.w_ada + ((size_t)l * D + ks * 128 + w * 16) * 3072 + cbk * 256 + lane * 4;
        float4 acc[5];
#pragma unroll
        for (int r = 0; r < 5; ++r) acc[r] = make_float4(0.f, 0.f, 0.f, 0.f);
#pragma unroll
        for (int k = 0; k < 16; ++k) {
            const float4 wv = *(const float4*)(wp + (size_t)k * 3072);
#pragma unroll
            for (int r = 0; r < 5; ++r) { const float sv = sl[r * 128 + w * 16 + k]; acc[r].x += sv * wv.x; acc[r].y += sv * wv.y; acc[r].z += sv * wv.z; acc[r].w += sv * wv.w; }
        }
#pragma unroll
        for (int r = 0; r < 5; ++r) *(float4*)(part + (w * 5 + r) * 256 + lane * 4) = acc[r];
        __syncthreads();
        unsigned* mp = MPu + (size_t)((l * 12 + cbk) * 8 + ks) * 1280;
        for (int e = tid; e < 1280; e += 512) {
            float v = 0.f;
#pragma unroll
            for (int q = 0; q < 8; ++q) v += part[q * 1280 + e];
            __hip_atomic_store(mp + e, __float_as_uint(v), __ATOMIC_RELAXED, __HIP_MEMORY_SCOPE_AGENT);
        }
        asm volatile("s_waitcnt vmcnt(0)" ::: "memory");
        __syncthreads();
        if (tid == 0) {
            const unsigned old = __hip_atomic_fetch_add(cnt + l * 12 + cbk, 1u, __ATOMIC_RELAXED, __HIP_MEMORY_SCOPE_AGENT);
            if (old == 7u) { __builtin_amdgcn_fence(__ATOMIC_ACQUIRE, "agent"); asm volatile("s_waitcnt vmcnt(0)" ::: "memory"); }
            *lastf = old == 7u ? 1u : 0u;
        }
        __syncthreads();
        if (*lastf) {
            const unsigned* m0 = MPu + (size_t)((l * 12 + cbk) * 8) * 1280;
            for (int e = tid; e < 1280; e += 512) {
                const int r = e >> 8, j = cbk * 256 + (e & 255);
                float v = p.b_ada[l * 3072 + j];
#pragma unroll
                for (int q = 0; q < 8; ++q) v += __uint_as_float(__hip_atomic_load(m0 + q * 1280 + e, __ATOMIC_RELAXED, __HIP_MEMORY_SCOPE_AGENT));
                mod[(size_t)(l * 5 + r) * 3072 + j] = v;
            }
        }
    }
    __syncthreads();
}

DEV void phase_rope_table(CParams& p) {
    float2* tab = (float2*)(p.ws + OFF_ROPE);
    const int gt = BIDX() * blockDim.x + TIDX(), gs = GDIM() * blockDim.x;
    for (int idx = gt; idx < 2048 * 96; idx += gs) {
        const int t = idx / 96, e = idx % 96;
        int a, c; float nq;
        if (e < 64) { a = e >> 5; c = e & 31; nq = 32.f; } else { a = (e - 64) >> 4; c = (e - 64) & 15; nq = 16.f; }
        const float pos = (float)(a ? (t & 63) : (t >> 6));
        const float inv = powf(10000.f, -(float)c / nq);
        float sn, cs; sincosf(pos * inv, &sn, &cs);
        tab[idx] = make_float2(cs, sn);
    }
}

DEV int w1t_row(int n) {
    if (n < N_RV) return (n & ~48) | ((n & 16) << 1) | ((n & 32) >> 1);
    if (n < N_RG) return PW + (n - N_RV);
    return n - 1024;
}
DEV void transpose_tile(const float* src, int K, int N, bf16_t* dst, int k0, int n0, float* tile, bool w1map = false) {
    const int tid = TIDX();
#pragma unroll 4
    for (int i = 0; i < 8; ++i) {
        const int r = i * 8 + (tid >> 6), c = tid & 63;
        tile[r * 65 + c] = src[(size_t)(k0 + r) * N + n0 + c];
    }
    __syncthreads();
    {
        const int n = tid >> 3, kc = tid & 7;
        const int dr = w1map ? w1t_row(n0 + n) : n0 + n;
        const float* t = tile + (kc * 8) * 65 + n;
        uint4 o;
        o.x = pk2(t[0], t[65]);       o.y = pk2(t[130], t[195]);
        o.z = pk2(t[260], t[325]);    o.w = pk2(t[390], t[455]);
        *(uint4*)(dst + (size_t)dr * K + k0 + kc * 8) = o;
    }
    __syncthreads();
}
DEV void phase_convert(CParams& p, int l, float* tile, int which = 0, int start = 0) {
    constexpr int T_IN = 16 * 120, T_MG = 16 * 48, T_BR = 3 * 256, T_OUT = 256, T_LRU = 32 * 4;
    constexpr int TOT = T_IN + T_MG + T_BR + T_OUT + T_LRU;
    const int first = which == 2 ? T_IN + T_MG + T_BR : 0, last = which == 2 ? T_IN + T_MG + T_BR + T_OUT : TOT;
    const int rot = ((BIDX() - start) % GDIM() + GDIM()) % GDIM();
    for (int it = first + rot; it < last; it += GDIM()) {
        int r = it;
        if (which == 1 && r >= T_IN + T_MG + T_BR && r < T_IN + T_MG + T_BR + T_OUT) continue;
        if (r < T_IN) { transpose_tile(p.w_in + (size_t)l * D * NW, D, NW, ws_bf(p, OFF_W1T), (r / 120) * 64, (r % 120) * 64, tile, true); continue; }
        r -= T_IN;
        if (r < T_MG) { transpose_tile(p.w_merge + (size_t)l * D * 3072, D, 3072, ws_bf(p, OFF_WMG), (r / 48) * 64, (r % 48) * 64, tile); continue; }
        r -= T_MG;
        if (r < T_BR) { const int nb = r / 256, q = r % 256;
            transpose_tile(p.w_branch + ((size_t)l * 3 + nb) * D * D, D, D, ws_bf(p, OFF_WBR) + (size_t)nb * D * D, (q / 16) * 64, (q % 16) * 64, tile); continue; }
        r -= T_BR;
        if (r < T_OUT) { transpose_tile(p.w_out + (size_t)l * D * D, D, D, ws_bf(p, OFF_WOUT), (r / 16) * 64, (r % 16) * 64, tile); continue; }
        r -= T_OUT;
        {
            const int mat = r / 4, q = r % 4;
            const int dir = mat >> 4, gate = (mat >> 3) & 1, blk = mat & 7;
            const float* wa_ = p.lru_wa; const float* wx_ = p.lru_wx;
            const float* src = (gate ? wx_ : wa_) + (((size_t)l * 2 + dir) * 8 + blk) * 128 * 128;
            transpose_tile(src, 128, 128, ws_bf(p, OFF_LRUW) + (size_t)mat * 128 * 128, (q >> 1) * 64, (q & 1) * 64, tile);
        }
    }
}

DEV void prenorm_row(CParams& p, int l, int m, const float4 (&v)[4], int lane) {
    float ss = 0.f;
#pragma unroll
    for (int j = 0; j < 4; ++j) ss += (v[j].x * v[j].x + v[j].y * v[j].y) + (v[j].z * v[j].z + v[j].w * v[j].w);
    ss = wave_sum(ss);
    const float rstd = rsqrtf(ss * (1.f / D) + EPS);
    const float* mod = ws_mod(p) + (size_t)(l * 5 + cond_row(m)) * 3072;
    bf16_t* h = ws_bf(p, OFF_H) + (size_t)m * D;
#pragma unroll
    for (int j = 0; j < 4; ++j) {
        const int i4 = lane + 64 * j;
        const float4 g = ((const float4*)(p.norm_pre + l * D))[i4];
        const float4 sh = ((const float4*)mod)[i4];
        const float4 sc = ((const float4*)(mod + 1024))[i4];
        ushort4 o;
        o.x = f2bf(v[j].x * rstd * g.x * (1.f + sc.x) + sh.x);
        o.y = f2bf(v[j].y * rstd * g.y * (1.f + sc.y) + sh.y);
        o.z = f2bf(v[j].z * rstd * g.z * (1.f + sc.z) + sh.z);
        o.w = f2bf(v[j].w * rstd * g.w * (1.f + sc.w) + sh.w);
        ((ushort4*)h)[i4] = o;
    }
}
DEV void phase_prenorm(CParams& p, int l) {
    const int tid = TIDX(), lane = tid & 63;
    for (int m = BIDX() * 8 + (tid >> 6); m < M; m += GDIM() * 8) {
        const float4* xr = (const float4*)x_row(p, l, m);
        float4 v[4];
#pragma unroll
        for (int j = 0; j < 4; ++j) v[j] = xr[lane + 64 * j];
        prenorm_row(p, l, m, v, lane);
    }
}

typedef short bf16x8 __attribute__((ext_vector_type(8)));
typedef float f32x4 __attribute__((ext_vector_type(4)));
typedef short v4i16_t __attribute__((ext_vector_type(4)));
#define LAS __attribute__((address_space(3)))
namespace g8 {
constexpr int BK = 64, HALF = 128, HTB = HALF * BK * 2, STAGE_BYTES = 8 * HTB;
DEV int lds_byte(int r, int c) { const int st = (r >> 4) * 2 + (c >> 5), rr = r & 15, cc = c & 31, ob = rr * 64 + cc * 2; return st * 1024 + (ob ^ (((ob >> 9) & 1) << 5)); }
DEV void stage_rc(int b, int& R, int& C) { const int st = b / 1024, sb = b % 1024, swz = sb ^ (((sb >> 9) & 1) << 5); R = (st >> 1) * 16 + swz / 64; C = (st & 1) * 32 + (swz % 64) / 2; }
struct Unit { const char* a; const char* b; int kind, pm, pn; unsigned lda; };

template <class Sched, class Epi>
DEV void gemm_phase(LAS unsigned char* lds, const unsigned ldb, const int nt, const Sched& S, const Epi& E) {
    const int tid = TIDX(), wid = __builtin_amdgcn_readfirstlane(tid >> 6), lane = tid & 63, wr = wid >> 2, wc = wid & 3, fr = lane & 15, fq = lane >> 4;
    unsigned rowA[2], colA[2], voffB[2];
#pragma unroll
    for (int i = 0; i < 2; ++i) { int R, C; stage_rc(tid * 16 + i * 8192, R, C); rowA[i] = (unsigned)R; colA[i] = (unsigned)C * 2u; voffB[i] = (unsigned)R * ldb + (unsigned)C * 2u; }
    const size_t kstep = (size_t)(BK * 2);
    const size_t hstepB = (size_t)HALF * ldb;
    const unsigned ldsw = (unsigned)wid * 1024u;
    const int aoff = lds_byte(wr * 64 + fr, fq * 8), boff = lds_byte(wc * 32 + fr, fq * 8);
#define G8_SA(b, h) (((b) * 2 + (h)) * HTB)
#define G8_SB(b, h) ((4 + (b) * 2 + (h)) * HTB)
#define G8_STAGE(bufoff, gbase, voff) do { _Pragma("unroll") for (int _i = 0; _i < 2; ++_i) \
        __builtin_amdgcn_global_load_lds((const unsigned*)((const char*)(gbase) + (voff)[_i]), (LAS unsigned*)(lds + (bufoff) + ldsw + _i * 8192), 16, 0, 0); } while (0)
#define G8_STAGEA(bufoff, gbase, ld) do { _Pragma("unroll") for (int _i = 0; _i < 2; ++_i) \
        __builtin_amdgcn_global_load_lds((const unsigned*)((const char*)(gbase) + (rowA[_i] * (ld) + colA[_i])), (LAS unsigned*)(lds + (bufoff) + ldsw + _i * 8192), 16, 0, 0); } while (0)
#define G8_LDA(dst, b, h) do { _Pragma("unroll") for (int m = 0; m < 4; ++m) _Pragma("unroll") for (int k = 0; k < 2; ++k) dst[m][k] = *(const LAS bf16x8*)(lds + G8_SA(b, h) + aoff + m * 2048 + k * 1024); } while (0)
#define G8_LDB(dst, b, h) do { _Pragma("unroll") for (int n = 0; n < 2; ++n) _Pragma("unroll") for (int k = 0; k < 2; ++k) dst[n][k] = *(const LAS bf16x8*)(lds + G8_SB(b, h) + boff + n * 2048 + k * 1024); } while (0)
#define G8_MMA(ai, bj, At, Bt) do { __builtin_amdgcn_s_setprio(1); _Pragma("unroll") for (int m = 0; m < 4; ++m) _Pragma("unroll") for (int n = 0; n < 2; ++n) _Pragma("unroll") for (int k = 0; k < 2; ++k) \
        acc[ai][bj][m][n] = __builtin_amdgcn_mfma_f32_16x16x32_bf16(Bt[n][k], At[m][k], acc[ai][bj][m][n], 0, 0, 0); __builtin_amdgcn_s_setprio(0); } while (0)
#define G8_WAIT_V(n) asm volatile("s_waitcnt vmcnt(" #n ")" ::: "memory")
#define G8_WAIT_L(n) asm volatile("s_waitcnt lgkmcnt(" #n ")" ::: "memory")
#define G8_BAR __builtin_amdgcn_s_barrier()
#define G8_SCHED __builtin_amdgcn_sched_barrier(0)
    Unit cur, nxt; int ui = 0;
    if (!S.next(0, cur)) return;
    f32x4 acc[2][2][4][2];
#pragma unroll
    for (int a = 0; a < 2; ++a)
#pragma unroll
        for (int b = 0; b < 2; ++b)
#pragma unroll
            for (int m = 0; m < 4; ++m)
#pragma unroll
                for (int n = 0; n < 2; ++n) acc[a][b][m][n] = (f32x4){0.f, 0.f, 0.f, 0.f};
    bf16x8 At[4][2], B0[2][2], B1[2][2];
    const char* cA = cur.a; const char* cB = cur.b;
    unsigned ldc = cur.lda;
    G8_STAGE(G8_SB(0, 0), cB, voffB); G8_STAGE(G8_SB(0, 1), cB + hstepB, voffB); G8_STAGEA(G8_SA(0, 0), cA, ldc); G8_STAGEA(G8_SA(0, 1), cA + (size_t)HALF * ldc, ldc);
    if (wr == 1) G8_BAR;
    G8_WAIT_V(2); G8_BAR;
    G8_STAGE(G8_SB(1, 0), cB + kstep, voffB); G8_STAGEA(G8_SA(1, 0), cA + kstep, ldc); G8_STAGE(G8_SB(1, 1), cB + hstepB + kstep, voffB);
    G8_WAIT_V(6); G8_BAR;
    for (;;) {
        const bool has_next = S.next(ui + 1, nxt);
        const char* nA = has_next ? nxt.a : cA; const char* nB = has_next ? nxt.b : cB;
        const unsigned ldn = has_next ? nxt.lda : ldc;
        for (int t = 0; t < nt; t += 2) {
            const bool last = (t == nt - 2);
            const char* a1 = cA + (size_t)(t + 1) * kstep;
            const char* a2 = last ? nA : cA + (size_t)(t + 2) * kstep; const char* b2 = last ? nB : cB + (size_t)(t + 2) * kstep;
            const char* a3 = a2 + kstep; const char* b3 = b2 + kstep;
            const unsigned ld2 = last ? ldn : ldc;
            const size_t h1 = (size_t)HALF * ldc, h2 = (size_t)HALF * ld2;
            G8_LDB(B0, 0, 0); G8_LDB(B1, 0, 1); G8_SCHED; G8_LDA(At, 0, 0); G8_STAGEA(G8_SA(1, 1), a1 + h1, ldc);
            G8_WAIT_V(8); G8_WAIT_L(0); G8_BAR; G8_MMA(0, 0, At, B0); G8_MMA(0, 1, At, B1); G8_BAR; G8_SCHED;
            G8_LDA(At, 0, 1); G8_STAGE(G8_SB(0, 0), b2, voffB); G8_STAGE(G8_SB(0, 1), b2 + hstepB, voffB); G8_STAGEA(G8_SA(0, 0), a2, ld2);
            G8_WAIT_V(8); G8_WAIT_L(0); G8_BAR; G8_MMA(1, 0, At, B0); G8_MMA(1, 1, At, B1); G8_BAR; G8_SCHED;
            G8_LDB(B0, 1, 0); G8_LDB(B1, 1, 1); G8_SCHED; G8_LDA(At, 1, 0); G8_STAGEA(G8_SA(0, 1), a2 + h2, ld2);
            G8_WAIT_V(8); G8_WAIT_L(0); G8_BAR; G8_MMA(0, 0, At, B0); G8_MMA(0, 1, At, B1); G8_BAR; G8_SCHED;
            G8_LDA(At, 1, 1); G8_STAGE(G8_SB(1, 0), b3, voffB); G8_STAGE(G8_SB(1, 1), b3 + hstepB, voffB); G8_STAGEA(G8_SA(1, 0), a3, ld2);
            G8_WAIT_V(8); G8_WAIT_L(0); G8_BAR; G8_MMA(1, 0, At, B0); G8_MMA(1, 1, At, B1); G8_BAR; G8_SCHED;
        }
        if (wr == 0) G8_BAR;
        E(acc, cur, wr, wc, fr, fq);
        if (!has_next) break;
#pragma unroll
        for (int a = 0; a < 2; ++a)
#pragma unroll
            for (int b = 0; b < 2; ++b)
#pragma unroll
                for (int m = 0; m < 4; ++m)
#pragma unroll
                    for (int n = 0; n < 2; ++n) acc[a][b][m][n] = (f32x4){0.f, 0.f, 0.f, 0.f};
        cur = nxt; cA = nA; cB = nB; ldc = ldn; ++ui;
        if (wr == 1) G8_BAR;
    }
    G8_WAIT_V(0);
    G8_BAR;
#undef G8_SA
#undef G8_SB
#undef G8_STAGE
#undef G8_STAGEA
#undef G8_LDA
#undef G8_LDB
#undef G8_MMA
#undef G8_WAIT_V
#undef G8_WAIT_L
#undef G8_BAR
#undef G8_SCHED
}

DEV void grid_unit(int wgid, int nM, int nN, int& pm, int& pn) {
    const int nwg = nM * nN, q = nwg / 8, r = nwg % 8, xcd = wgid % 8, off = wgid / 8;
    wgid = (xcd < r ? xcd * (q + 1) : r * (q + 1) + (xcd - r) * q) + off;
    const int nig = 4 * nN, gid = wgid / nig, fm = gid * 4, gsz = (nM - fm) < 4 ? (nM - fm) : 4;
    pm = fm + ((wgid % nig) % gsz); pn = (wgid % nig) / gsz;
}
DEV uint2 pk4(const f32x4 v) { return make_uint2(pk2(v[0], v[1]), pk2(v[2], v[3])); }
DEV float lo16(unsigned u) { return __uint_as_float(u << 16); }
DEV float hi16(unsigned u) { return __uint_as_float(u & 0xffff0000u); }
}

struct SchedG1 {
    const char* H; const char* W; int G, c;
    DEV bool next(int i, g8::Unit& u) const {
        int L = i * G + c;
        if (L >= 1440) return false;
        if (L < 1248) { g8::grid_unit(L, 48, 26, u.pm, u.pn); u.kind = 0; u.lda = 2048u; u.a = H + (size_t)u.pm * 256 * 2048; u.b = W + (size_t)u.pn * 256 * 2048; }
        else { g8::grid_unit(L - 1248, 4, 48, u.pm, u.pn); u.kind = 0; u.lda = 2048u; u.a = W + (size_t)(PW + u.pm * 256) * 2048; u.b = H + (size_t)u.pn * 256 * 2048; u.pn += 64; }
        return true;
    }
};
struct EpiG1 {
    unsigned char* ws; float* out; int l;
    DEV void operator()(const f32x4 (&acc)[2][2][4][2], const g8::Unit& u, int wr, int wc, int fr, int fq) const {
        using namespace g8;
        bf16_t* Pb = (bf16_t*)(ws + OFF_P);
        if (u.pn >= 64) {
            bf16_t* RVT = (bf16_t*)(ws + OFF_RVT);
#pragma unroll
            for (int ai = 0; ai < 2; ++ai)
#pragma unroll
                for (int bj = 0; bj < 2; ++bj)
#pragma unroll
                    for (int m = 0; m < 4; ++m)
#pragma unroll
                        for (int n = 0; n < 2; ++n) {
                            const int ch = u.pm * 256 + ai * 128 + wr * 64 + m * 16 + fr;
                            const int tok = (u.pn - 64) * 256 + bj * 128 + wc * 32 + n * 16 + fq * 4;
                            *(uint2*)(RVT + (size_t)ch * M + tok) = pk4(acc[ai][bj][m][n]);
                        }
            return;
        }
        const int pn = u.pn;
        const bool rope_ret = pn < 4, rope_att = pn >= 16 && pn <= 20;
        const bool lat = u.pm >= 16;
        if (rope_ret || rope_att) {
            const int te = rope_ret ? (wc >> 1) * 32 + (wc & 1) * 16 + fq * 4 : 64 + (wc & 1) * 16 + fq * 4;
            const float sc = pn < 2 ? 0.08838834764831845f : (pn >= 16 && pn < 20) ? 0.125f * 1.4426950408889634f : 1.f;
#pragma unroll
            for (int ai = 0; ai < 2; ++ai) {
                float4 c01[4], c23[4];
                if (lat) {
#pragma unroll
                    for (int m = 0; m < 4; ++m) {
                        const int t = (u.pm * 256 + ai * 128 + wr * 64 + m * 16 + fr - NCTX) & 2047;
                        const float4* tb = (const float4*)((const float2*)(ws + OFF_ROPE) + (size_t)t * 96 + te);
                        c01[m] = tb[0]; c23[m] = tb[1];
                    }
                }
#pragma unroll
                for (int m = 0; m < 4; ++m) {
                    const int row = u.pm * 256 + ai * 128 + wr * 64 + m * 16 + fr;
                    bf16_t* Pr = Pb + (size_t)row * PW;
#pragma unroll
                    for (int bj = 0; bj < 2; ++bj) {
                        f32x4 x1 = acc[ai][bj][m][0], x2 = acc[ai][bj][m][1];
                        const int lc1 = rope_ret ? pn * 256 + bj * 128 + (wc >> 1) * 64 + (wc & 1) * 16 + fq * 4 : pn * 256 + bj * 128 + wc * 32 + fq * 4;
                        const int lc2 = rope_ret ? lc1 + 32 : lc1 + 16;
                        if (!lat && pn == 20) {
                            float* ok = out + O_NK + ((size_t)((row >> 8) * 2 + l) * 256 + (row & 255)) * 256 + (lc1 - C_AK);
                            *(float4*)ok = make_float4(x1[0], x1[1], x1[2], x1[3]);
                            *(float4*)(ok + 16) = make_float4(x2[0], x2[1], x2[2], x2[3]);
                        }
                        if (lat) {
                            const float cs[4] = {c01[m].x, c01[m].z, c23[m].x, c23[m].z}, sn[4] = {c01[m].y, c01[m].w, c23[m].y, c23[m].w};
                            f32x4 o1, o2;
#pragma unroll
                            for (int j = 0; j < 4; ++j) { o1[j] = x1[j] * cs[j] - x2[j] * sn[j]; o2[j] = x2[j] * cs[j] + x1[j] * sn[j]; }
                            x1 = o1; x2 = o2;
                        }
                        x1 *= sc; x2 *= sc;
                        *(uint2*)(Pr + lc1) = pk4(x1);
                        *(uint2*)(Pr + lc2) = pk4(x2);
                    }
                }
            }
            return;
        }
#pragma unroll
        for (int ai = 0; ai < 2; ++ai)
#pragma unroll
            for (int m = 0; m < 4; ++m) {
                const int row = u.pm * 256 + ai * 128 + wr * 64 + m * 16 + fr;
                bf16_t* Pr = Pb + (size_t)row * PW;
#pragma unroll
                for (int bj = 0; bj < 2; ++bj)
#pragma unroll
                    for (int n = 0; n < 2; ++n) {
                        f32x4 v = acc[ai][bj][m][n];
                        const int col = pn * 256 + bj * 128 + wc * 32 + n * 16 + fq * 4;
                        if (pn == 21) {
                            if (!lat) *(float4*)(out + O_NV + ((size_t)((row >> 8) * 2 + l) * 256 + (row & 255)) * 256 + (col - C_AV)) = make_float4(v[0], v[1], v[2], v[3]);
                        } else if (!(pn >= 8 && pn < 12)) {
#pragma unroll
                            for (int j = 0; j < 4; ++j) v[j] = siluf(v[j]);
                        }
                        *(uint2*)(Pr + col) = pk4(v);
                    }
            }
    }
};
DEV void phase8_gemm1(CParams& p, int l, LAS unsigned char* lds) {
    SchedG1 S{(const char*)(p.ws + OFF_H), (const char*)(p.ws + OFF_W1T), GDIM(), BIDX()};
    EpiG1 E{p.ws, p.out, l};
    g8::gemm_phase(lds, 2048u, 16, S, E);
}

constexpr size_t OFF_G2 = OFF_RVT;
struct SchedMg {
    const char *H, *P, *WMG, *WBR; int G, c, part;
    DEV void fill(g8::Unit& u, int tile, int n, int isz) const {
        u.pm = tile >> 2; u.pn = tile & 3; u.kind = n * 2 + isz;
        if (isz) { const int acol = n == 0 ? C_RG : n == 1 ? C_LG : C_AQ;
                   u.lda = (unsigned)PW * 2u; u.a = P + (size_t)u.pm * 256 * PW * 2 + (size_t)acol * 2; u.b = WBR + ((size_t)n * 1024 + u.pn * 256) * 2048; }
        else { u.lda = 2048u; u.a = H + (size_t)u.pm * 256 * 2048; u.b = WMG + ((size_t)n * 1024 + u.pn * 256) * 2048; }
    }
    DEV bool next(int i, g8::Unit& u) const {
        if (G == 256) {
            const int xg = c & 7, j = c >> 3;
            if (part == 2) {
                if (c >= 192 || i >= 1) return false;
                fill(u, xg * 24 + j, 1, 0);
            } else if (part == 0) {
                if (c < 192) { if (i >= 3) return false; if (i == 0) fill(u, xg * 24 + j, 0, 0); else fill(u, xg * 24 + j, i - 1, 1); }
                else { if (i >= 3) return false; fill(u, xg * 24 + (j - 24) * 3 + i, 2, 0); }
            } else {
                if (c >= 192 || i >= 1) return false;
                fill(u, xg * 24 + j, 2, 1);
            }
            return true;
        }
        if (part != 0) return false;
        const int tile = c + (i / 6) * G, sI = i % 6;
        if (tile >= 192) return false;
        fill(u, tile, sI >> 1, sI & 1);
        return true;
    }
};
struct EpiMg {
    unsigned char* ws; const float* bias;
    DEV bf16_t* gslot(int n, int row) const {
        bf16_t* Pb = (bf16_t*)(ws + OFF_P);
        return n == 0 ? Pb + (size_t)row * PW + C_LX : n == 1 ? Pb + (size_t)row * PW + C_AG : (bf16_t*)(ws + OFF_G2) + (size_t)row * 1024;
    }
    DEV void operator()(const f32x4 (&acc)[2][2][4][2], const g8::Unit& u, int wr, int wc, int fr, int fq) const {
        using namespace g8;
        const int n = u.kind >> 1; const bool zpass = u.kind & 1;
        const int colb = u.pn * 256 + wc * 32 + fq * 4;
        if (!zpass) {
            float4 bz[2][2];
#pragma unroll
            for (int bj = 0; bj < 2; ++bj)
#pragma unroll
                for (int nn = 0; nn < 2; ++nn) bz[bj][nn] = *(const float4*)(bias + n * 1024 + colb + bj * 128 + nn * 16);
#pragma unroll
            for (int ai = 0; ai < 2; ++ai)
#pragma unroll
                for (int m = 0; m < 4; ++m) {
                    bf16_t* gs = gslot(n, u.pm * 256 + ai * 128 + wr * 64 + m * 16 + fr);
#pragma unroll
                    for (int bj = 0; bj < 2; ++bj)
#pragma unroll
                        for (int nn = 0; nn < 2; ++nn) {
                            f32x4 v = acc[ai][bj][m][nn];
                            v[0] = sigmf(v[0] + bz[bj][nn].x); v[1] = sigmf(v[1] + bz[bj][nn].y); v[2] = sigmf(v[2] + bz[bj][nn].z); v[3] = sigmf(v[3] + bz[bj][nn].w);
                            *(uint2*)(gs + colb + bj * 128 + nn * 16) = pk4(v);
                        }
                }
            return;
        }
#pragma unroll
        for (int ai = 0; ai < 2; ++ai) {
            uint2 gq[4][2][2], tq[4][2][2];
#pragma unroll
            for (int m = 0; m < 4; ++m) {
                const int row = u.pm * 256 + ai * 128 + wr * 64 + m * 16 + fr;
                const bf16_t* gs = gslot(n, row);
                const bf16_t* Tr = (const bf16_t*)(ws + OFF_P) + (size_t)row * PW;
#pragma unroll
                for (int bj = 0; bj < 2; ++bj)
#pragma unroll
                    for (int nn = 0; nn < 2; ++nn) {
                        gq[m][bj][nn] = *(const uint2*)(gs + colb + bj * 128 + nn * 16);
                        if (n > 0) tq[m][bj][nn] = *(const uint2*)(Tr + colb + bj * 128 + nn * 16);
                    }
            }
#pragma unroll
            for (int m = 0; m < 4; ++m) {
                const int row = u.pm * 256 + ai * 128 + wr * 64 + m * 16 + fr;
                bf16_t* Tr = (bf16_t*)(ws + OFF_P) + (size_t)row * PW;
#pragma unroll
                for (int bj = 0; bj < 2; ++bj)
#pragma unroll
                    for (int nn = 0; nn < 2; ++nn) {
                        f32x4 v = acc[ai][bj][m][nn];
                        const uint2 gv = gq[m][bj][nn];
                        v[0] *= lo16(gv.x); v[1] *= hi16(gv.x); v[2] *= lo16(gv.y); v[3] *= hi16(gv.y);
                        if (n > 0) { const uint2 tv = tq[m][bj][nn]; v[0] += lo16(tv.x); v[1] += hi16(tv.x); v[2] += lo16(tv.y); v[3] += hi16(tv.y); }
                        *(uint2*)(Tr + colb + bj * 128 + nn * 16) = pk4(v);
                    }
            }
        }
    }
};
DEV void phase8_merge(CParams& p, int l, int part, LAS unsigned char* lds) {
    SchedMg S{(const char*)(p.ws + OFF_H), (const char*)(p.ws + OFF_P), (const char*)(p.ws + OFF_WMG), (const char*)(p.ws + OFF_WBR), GDIM(), BIDX(), part};
    EpiMg E{p.ws, p.b_merge + (size_t)l * 3072};
    g8::gemm_phase(lds, 2048u, 16, S, E);
}

struct SchedOut {
    const char* A; const char* B; int G, c;
    DEV bool next(int i, g8::Unit& u) const {
        int tile = i * G + c;
        if (G == 256) { if (i > 0 || c >= 192) return false; tile = (c & 7) * 24 + (c >> 3); }
        if (tile >= 192) return false;
        u.pm = tile >> 2; u.pn = tile & 3; u.kind = 0; u.lda = (unsigned)PW * 2u;
        u.a = A + (size_t)u.pm * 256 * PW * 2; u.b = B + (size_t)u.pn * 256 * 2048;
        return true;
    }
};
DEV void row_exchange(unsigned char* ws, int slot, int pn, float* part, float* rs) {
    const int tid = TIDX();
    __syncthreads();
    unsigned* XPd = (unsigned*)(ws + OFF_XP) + (size_t)slot * 4 * 256;
    unsigned* cnt = (unsigned*)(ws + OFF_XC) + slot;
    if (tid < 256) {
        const float v = (part[tid] + part[256 + tid]) + (part[512 + tid] + part[768 + tid]);
        __hip_atomic_store(XPd + pn * 256 + tid, __float_as_uint(v), __ATOMIC_RELAXED, __HIP_MEMORY_SCOPE_AGENT);
    }
    asm volatile("s_waitcnt vmcnt(0)" ::: "memory");
    __syncthreads();
    if (tid == 0) {
        (void)__hip_atomic_fetch_add(cnt, 1u, __ATOMIC_RELAXED, __HIP_MEMORY_SCOPE_AGENT);
        unsigned sp = 0;
        while (__hip_atomic_load(cnt, __ATOMIC_RELAXED, __HIP_MEMORY_SCOPE_AGENT) < 4u) { __builtin_amdgcn_s_sleep(1); if (++sp > (1u << 20)) break; }
        __builtin_amdgcn_fence(__ATOMIC_ACQUIRE, "agent");
        asm volatile("s_waitcnt vmcnt(0)" ::: "memory");
    }
    __syncthreads();
    if (tid < 256) {
        float t = 0.f;
#pragma unroll
        for (int q = 0; q < 4; ++q) t += __uint_as_float(__hip_atomic_load(XPd + q * 256 + tid, __ATOMIC_RELAXED, __HIP_MEMORY_SCOPE_AGENT));
        rs[tid] = rsqrtf(t * (1.f / D) + EPS);
    }
    __syncthreads();
}
struct EpiOutPost {
    CParams* kp; int l; unsigned char* ldsx;
    DEV void row_ssq(const f32x4 (&v)[2][2][4][2], float* part, int wr, int wc, int fr, int fq) const {
#pragma unroll
        for (int ai = 0; ai < 2; ++ai)
#pragma unroll
            for (int m = 0; m < 4; ++m) {
                float ss = 0.f;
#pragma unroll
                for (int bj = 0; bj < 2; ++bj)
#pragma unroll
                    for (int n = 0; n < 2; ++n) { const f32x4 x = v[ai][bj][m][n]; ss += (x[0] * x[0] + x[1] * x[1]) + (x[2] * x[2] + x[3] * x[3]); }
                ss = xrow16_sum(ss);
                if (fq == 0) part[wc * 256 + ai * 128 + wr * 64 + m * 16 + fr] = ss;
            }
    }
    DEV void operator()(f32x4 (&acc)[2][2][4][2], const g8::Unit& u, int wr, int wc, int fr, int fq) const {
        CParams& p = *kp;
        unsigned char* ws = p.ws;
        float* part = (float*)ldsx; float* rs = part + 1024;
        const int colb = u.pn * 256 + wc * 32 + fq * 4;
        const int crow = u.pm < 16 ? 0 : 1 + ((u.pm - 16) >> 3);
        const float* mod = ws_mod(p) + (size_t)(l * 5 + crow) * 3072;
        row_ssq(acc, part, wr, wc, fr, fq);
        row_exchange(ws, (l * 2 + 0) * 48 + u.pm, u.pn, part, rs);
        {
            float4 gt[2][2], gp[2][2];
#pragma unroll
            for (int bj = 0; bj < 2; ++bj)
#pragma unroll
                for (int n = 0; n < 2; ++n) {
                    gt[bj][n] = *(const float4*)(mod + 2048 + colb + bj * 128 + n * 16);
                    gp[bj][n] = *(const float4*)(p.norm_post + l * D + colb + bj * 128 + n * 16);
                    gt[bj][n].x *= gp[bj][n].x; gt[bj][n].y *= gp[bj][n].y; gt[bj][n].z *= gp[bj][n].z; gt[bj][n].w *= gp[bj][n].w;
                }
#pragma unroll
            for (int ai = 0; ai < 2; ++ai)
#pragma unroll
                for (int mh = 0; mh < 2; ++mh) {
                    float4 xv[2][2][2];
#pragma unroll
                    for (int m2 = 0; m2 < 2; ++m2) {
                        const int row = u.pm * 256 + ai * 128 + wr * 64 + (mh * 2 + m2) * 16 + fr;
                        const float* xr = x_row(p, l, row);
#pragma unroll
                        for (int bj = 0; bj < 2; ++bj)
#pragma unroll
                            for (int n = 0; n < 2; ++n) xv[m2][bj][n] = *(const float4*)(xr + colb + bj * 128 + n * 16);
                    }
#pragma unroll
                    for (int m2 = 0; m2 < 2; ++m2) {
                        const int m = mh * 2 + m2;
                        const int rl = ai * 128 + wr * 64 + m * 16 + fr;
                        const float rstd = rs[rl];
                        float* yr = p.out + (size_t)(u.pm * 256 + rl) * D;
#pragma unroll
                        for (int bj = 0; bj < 2; ++bj)
#pragma unroll
                            for (int n = 0; n < 2; ++n) {
                                f32x4 y;
                                y[0] = xv[m2][bj][n].x + gt[bj][n].x * (acc[ai][bj][m][n][0] * rstd);
                                y[1] = xv[m2][bj][n].y + gt[bj][n].y * (acc[ai][bj][m][n][1] * rstd);
                                y[2] = xv[m2][bj][n].z + gt[bj][n].z * (acc[ai][bj][m][n][2] * rstd);
                                y[3] = xv[m2][bj][n].w + gt[bj][n].w * (acc[ai][bj][m][n][3] * rstd);
                                acc[ai][bj][m][n] = y;
                                *(float4*)(yr + colb + bj * 128 + n * 16) = make_float4(y[0], y[1], y[2], y[3]);
                            }
                    }
                }
        }
        if (l != 0) return;
        row_ssq(acc, part, wr, wc, fr, fq);
        row_exchange(ws, (l * 2 + 1) * 48 + u.pm, u.pn, part, rs);
        {
            const float* mod1 = ws_mod(p) + (size_t)(1 * 5 + crow) * 3072;
            float4 a_[2][2], b_[2][2];
#pragma unroll
            for (int bj = 0; bj < 2; ++bj)
#pragma unroll
                for (int n = 0; n < 2; ++n) {
                    const int cc = colb + bj * 128 + n * 16;
                    const float4 g = *(const float4*)(p.norm_pre + 1 * D + cc), sc = *(const float4*)(mod1 + 1024 + cc);
                    a_[bj][n] = make_float4(g.x * (1.f + sc.x), g.y * (1.f + sc.y), g.z * (1.f + sc.z), g.w * (1.f + sc.w));
                    b_[bj][n] = *(const float4*)(mod1 + cc);
                }
#pragma unroll
            for (int ai = 0; ai < 2; ++ai)
#pragma unroll
                for (int m = 0; m < 4; ++m) {
                    const int rl = ai * 128 + wr * 64 + m * 16 + fr;
                    const float rstd = rs[rl];
                    bf16_t* hr = ws_bf(p, OFF_H) + (size_t)(u.pm * 256 + rl) * D;
#pragma unroll
                    for (int bj = 0; bj < 2; ++bj)
#pragma unroll
                        for (int n = 0; n < 2; ++n) {
                            const f32x4 y = acc[ai][bj][m][n];
                            uint2 o;
                            o.x = pk2(y[0] * rstd * a_[bj][n].x + b_[bj][n].x, y[1] * rstd * a_[bj][n].y + b_[bj][n].y);
                            o.y = pk2(y[2] * rstd * a_[bj][n].z + b_[bj][n].z, y[3] * rstd * a_[bj][n].w + b_[bj][n].w);
                            *(uint2*)(hr + colb + bj * 128 + n * 16) = o;
                        }
                }
        }
    }
};
DEV void phase8_out(CParams& p, int l, LAS unsigned char* lds) {
    SchedOut S{(const char*)(p.ws + OFF_P), (const char*)(p.ws + OFF_WOUT), GDIM(), BIDX()};
    EpiOutPost E{&p, l, (unsigned char*)lds + LDS_XOFF};
    g8::gemm_phase(lds, 2048u, 16, S, E);
}

DEV uint4 pack8(const float4 a, const float4 b) {
    uint4 r;
    r.x = pk2(a.x, a.y); r.y = pk2(a.z, a.w);
    r.z = pk2(b.x, b.y); r.w = pk2(b.z, b.w);
    return r;
}
template <int NU>
DEV void attn_item(CParams& p, int l, bool lat, int b, int hk, int qs0, unsigned char* lds) {
    bf16_t* Pb = ws_bf(p, OFF_P);
    const int tid = TIDX(), lane = tid & 63, w = tid >> 6, g = lane >> 4, lc = lane & 15;
    const int row0 = lat ? NCTX + b * 2048 : b * 256, L = lat ? 2048 : 256;
    const int hq = hk * 4 + (w & 3);
    const int qw = qs0 + (w >> 2) * 32;
    bf16x8 qfr[NU][2][2];
    f32x4 O[NU][4][2];
    float mrun[NU][2], lrun[NU][2];
    const float sink = p.att_sink[l * 16 + hq] * 1.4426950408889634f;
#pragma unroll
    for (int u = 0; u < NU; ++u)
#pragma unroll
        for (int qf = 0; qf < 2; ++qf) {
#pragma unroll
            for (int ks = 0; ks < 2; ++ks)
                qfr[u][qf][ks] = *(const bf16x8*)(Pb + (size_t)(row0 + qw + u * 64 + qf * 16 + lc) * PW + C_AQ + hq * 64 + ks * 32 + g * 8);
            mrun[u][qf] = sink; lrun[u][qf] = g == 0 ? 1.f : 0.f;
#pragma unroll
            for (int df = 0; df < 4; ++df) O[u][df][qf] = (f32x4){0.f, 0.f, 0.f, 0.f};
        }
    const int nband = lat ? 4 + NU : 4;
    const int ntile = lat ? nband + 4 : 4;
    const int qsb = qs0 >> 6;
    const int t_lo = lat ? (qsb < 2 ? 2 - qsb : 0) : 0;
    const int t_hi = lat ? ((33 - qsb) < (nband - 1) ? (33 - qsb) : (nband - 1)) : 3;
    const int fsw = (lane >> 1) & 7;
    const int srow = tid >> 3, sc8 = tid & 7;
    float4 R[4];
    auto tile_load = [&](int t) __attribute__((always_inline)) {
        if (t < nband) {
            const int kp0 = lat ? qs0 + 64 * (t - 2) : 64 * t;
            const uint4 kv = *(const uint4*)(Pb + (size_t)(row0 + kp0 + srow) * PW + C_AK + hk * 64 + sc8 * 8);
            const uint4 vv = *(const uint4*)(Pb + (size_t)(row0 + kp0 + srow) * PW + C_AV + hk * 64 + sc8 * 8);
            R[0] = make_float4(__uint_as_float(kv.x), __uint_as_float(kv.y), __uint_as_float(kv.z), __uint_as_float(kv.w));
            R[2] = make_float4(__uint_as_float(vv.x), __uint_as_float(vv.y), __uint_as_float(vv.z), __uint_as_float(vv.w));
        } else {
            const int j0 = (t - nband) * 64;
            const float* ck = p.cache_k + (size_t)((b * 2 + l) * 256 + j0) * 256 + hk * 64;
            const float* cv = p.cache_v + (size_t)((b * 2 + l) * 256 + j0) * 256 + hk * 64;
            R[0] = *(const float4*)(ck + (size_t)srow * 256 + sc8 * 8); R[1] = *(const float4*)(ck + (size_t)srow * 256 + sc8 * 8 + 4);
            R[2] = *(const float4*)(cv + (size_t)srow * 256 + sc8 * 8); R[3] = *(const float4*)(cv + (size_t)srow * 256 + sc8 * 8 + 4);
        }
    };
    auto tile_store = [&](bool cache_t, unsigned char* KsB, unsigned char* VtB) __attribute__((always_inline)) {
        uint4 kq, vq;
        if (!cache_t) {
            kq = make_uint4(__float_as_uint(R[0].x), __float_as_uint(R[0].y), __float_as_uint(R[0].z), __float_as_uint(R[0].w));
            vq = make_uint4(__float_as_uint(R[2].x), __float_as_uint(R[2].y), __float_as_uint(R[2].z), __float_as_uint(R[2].w));
        } else { kq = pack8(R[0], R[1]); vq = pack8(R[2], R[3]); }
        *(uint4*)(KsB + srow * 128 + ((sc8 ^ ((srow >> 1) & 7)) << 4)) = kq;
        *(uint4*)(VtB + srow * 128 + ((sc8 ^ (((srow >> 1) & 3) << 1)) << 4)) = vq;
    };
    int t = t_lo;
    tile_load(t);
    __syncthreads();
    tile_store(t >= nband, lds, lds + 8192);
    int tn = (lat && t == t_hi) ? nband : t + 1;
    if (tn < ntile) tile_load(tn);
    int cur = 0;
    while (t < ntile) {
        const bool cache = t >= nband;
        const int kp0 = lat ? qs0 + 64 * (t - 2) : 64 * t;
        const unsigned char* Ks = lds + cur * 16384; const unsigned char* Vt = Ks + 8192;
        __syncthreads();
        int tnn = ntile;
        if (tn < ntile) {
            tile_store(tn >= nband, lds + (cur ^ 1) * 16384, lds + (cur ^ 1) * 16384 + 8192);
            tnn = (lat && tn == t_hi) ? nband : tn + 1;
            if (tnn < ntile) tile_load(tnn);
        }
#pragma unroll
        for (int u = 0; u < NU; ++u) {
            const int tu = t - u;
            if (lat && !cache && (tu < 0 || tu > 4)) continue;
            __builtin_amdgcn_s_setprio(1);
            f32x4 sc[4][2];
#pragma unroll
            for (int kf = 0; kf < 4; ++kf)
#pragma unroll
                for (int qf = 0; qf < 2; ++qf) sc[kf][qf] = (f32x4){0.f, 0.f, 0.f, 0.f};
#pragma unroll
            for (int ks = 0; ks < 2; ++ks) {
                bf16x8 ak[4];
#pragma unroll
                for (int kf = 0; kf < 4; ++kf) ak[kf] = *(const bf16x8*)(Ks + (kf * 16 + lc) * 128 + (((ks * 4 + g) ^ fsw) << 4));
#pragma unroll
                for (int kf = 0; kf < 4; ++kf)
#pragma unroll
                    for (int qf = 0; qf < 2; ++qf)
                        sc[kf][qf] = __builtin_amdgcn_mfma_f32_16x16x32_bf16(ak[kf], qfr[u][qf][ks], sc[kf][qf], 0, 0, 0);
            }
            __builtin_amdgcn_s_setprio(0);
            if (lat && !cache && (tu == 0 || tu == 4)) {
#pragma unroll
                for (int kf = 0; kf < 4; ++kf)
#pragma unroll
                    for (int qf = 0; qf < 2; ++qf)
#pragma unroll
                        for (int r = 0; r < 4; ++r) {
                            const int kpos = kp0 + kf * 16 + g * 4 + r, qpos = qw + u * 64 + qf * 16 + lc;
                            const int dd = qpos - kpos;
                            if (dd > 128 || dd < -128) sc[kf][qf][r] = -INFINITY;
                        }
            }
            bf16x8 pb[2][2];
#pragma unroll
            for (int qf = 0; qf < 2; ++qf) {
                float mx = -INFINITY;
#pragma unroll
                for (int kf = 0; kf < 4; ++kf)
#pragma unroll
                    for (int r = 0; r < 4; ++r) mx = fmaxf(mx, sc[kf][qf][r]);
                mx = xrow16_max(mx);
                const float mnew = fmaxf(mrun[u][qf], mx);
                const float alpha = __builtin_amdgcn_exp2f(mrun[u][qf] - mnew);
                mrun[u][qf] = mnew;
                float ps = 0.f;
#pragma unroll
                for (int kf = 0; kf < 4; ++kf)
#pragma unroll
                    for (int r = 0; r < 4; ++r) { const float e = __builtin_amdgcn_exp2f(sc[kf][qf][r] - mnew); sc[kf][qf][r] = e; ps += e; }
                lrun[u][qf] = lrun[u][qf] * alpha + ps;
#pragma unroll
                for (int df = 0; df < 4; ++df) O[u][df][qf] *= alpha;
#pragma unroll
                for (int s2 = 0; s2 < 2; ++s2) {
                    bf16x8 v;
#pragma unroll
                    for (int r = 0; r < 4; ++r) { v[r] = (short)f2bf(sc[2 * s2][qf][r]); v[4 + r] = (short)f2bf(sc[2 * s2 + 1][qf][r]); }
                    pb[s2][qf] = v;
                }
            }
            __builtin_amdgcn_s_setprio(1);
#pragma unroll
            for (int s2 = 0; s2 < 2; ++s2)
#pragma unroll
                for (int df = 0; df < 4; ++df) {
                    const int vrow = 32 * s2 + 4 * g + (lc >> 2);
                    const unsigned char* vr = Vt + vrow * 128 + (((2 * df + ((lc >> 1) & 1)) ^ (((vrow >> 1) & 3) << 1)) << 4) + 8 * (lc & 1);
                    const v4i16_t lo = __builtin_amdgcn_ds_read_tr16_b64_v4i16((LAS v4i16_t*)vr);
                    const v4i16_t hi = __builtin_amdgcn_ds_read_tr16_b64_v4i16((LAS v4i16_t*)(vr + 2048));
                    union { v4i16_t h[2]; bf16x8 v; } av; av.h[0] = lo; av.h[1] = hi;
#pragma unroll
                    for (int qf = 0; qf < 2; ++qf)
                        O[u][df][qf] = __builtin_amdgcn_mfma_f32_16x16x32_bf16(av.v, pb[s2][qf], O[u][df][qf], 0, 0, 0);
                }
            __builtin_amdgcn_s_setprio(0);
        }
        t = tn; tn = tnn; cur ^= 1;
    }
#pragma unroll
    for (int u = 0; u < NU; ++u)
#pragma unroll
        for (int qf = 0; qf < 2; ++qf) {
            const float lt = xrow16_sum(lrun[u][qf]);
            const float inv = 1.f / lt;
            const size_t m = (size_t)(row0 + qw + u * 64 + qf * 16 + lc);
#pragma unroll
            for (int df = 0; df < 4; ++df) {
                const int col = hq * 64 + df * 16 + g * 4;
                const uint2 gt = *(const uint2*)(Pb + m * PW + C_AG + col);
                uint2 o;
                o.x = pk2(O[u][df][qf][0] * inv * __uint_as_float(gt.x << 16), O[u][df][qf][1] * inv * __uint_as_float(gt.x & 0xffff0000u));
                o.y = pk2(O[u][df][qf][2] * inv * __uint_as_float(gt.y << 16), O[u][df][qf][3] * inv * __uint_as_float(gt.y & 0xffff0000u));
                *(uint2*)(Pb + m * PW + C_AQ + col) = o;
            }
        }
}
DEV void phase_attn(CParams& p, int l, unsigned char* lds) {
    if (GDIM() == 256) {
        const int xg = BIDX() & 7, j = BIDX() >> 3;
        { const int grp = xg * 2 + (j >> 4); attn_item<2>(p, l, true, grp >> 2, grp & 3, (j & 15) * 128, lds); }
        { const int grp = xg * 8 + (j >> 2); attn_item<1>(p, l, false, grp >> 2, grp & 3, (j & 3) * 64, lds); }
        return;
    }
    for (int item = BIDX(); item < 768; item += GDIM()) {
        if (item < 512) attn_item<1>(p, l, true, item >> 7, (item >> 5) & 3, (item & 31) * 64, lds);
        else { const int it = item - 512; attn_item<1>(p, l, false, it >> 4, (it >> 2) & 3, (it & 3) * 64, lds); }
    }
}

constexpr size_t OFF_RS = OFF_W1T;
static_assert(OFF_RS + (size_t)4 * 4 * 2 * 8 * 32768 * 2 <= OFF_LRUC, "RS overlap");
DEV float ret_logg(CParams& p, int l, int dir, int h) { return -softplusf(-p.ret_decay[(l * 2 + dir) * 4 + h]); }

DEV void ret_kv_tile(CParams& p, int l, int item, unsigned char* lds) {
    bf16_t* Pb = ws_bf(p, OFF_P); const bf16_t* RVT = ws_bf(p, OFF_RVT);
    const int tid = TIDX(), lane = tid & 63, w = __builtin_amdgcn_readfirstlane(tid >> 6), g = lane >> 4, lc = lane & 15;
    const bool lat = item < 128;
    int b, h, c;
    if (lat) { c = item & 7; h = (item >> 3) & 3; b = item >> 5; }
    else { const int it = item - 128; h = it & 3; b = it >> 2; c = 0; }
    const int row0 = lat ? NCTX + b * 2048 + c * 256 : b * 256;
    const bool doF = !lat || c < 7, doB = !lat || c > 0;
    const float lgf = ret_logg(p, l, 0, h), lgb = ret_logg(p, l, 1, h);
    const float rf = __expf(-lgf), rb = __expf(lgb);
    const int dvbase = w * 32;
    auto dma_k = [&](int st) __attribute__((always_inline)) {
        LAS unsigned char* base = (LAS unsigned char*)lds + (st & 1) * 16384;
#pragma unroll
        for (int i = 0; i < 2; ++i) {
            const int q = w * 2 + i, row = 4 * q + (lane >> 4), lch = (lane & 15) ^ (((row & 3) << 2) | ((row >> 2) & 3));
            __builtin_amdgcn_global_load_lds((const unsigned*)(Pb + (size_t)(row0 + st * 64 + row) * PW + C_RK + h * 128 + lch * 8), (LAS unsigned*)(base + q * 1024), 16, 0, 0);
        }
    };
    __syncthreads();
    dma_k(0);
    f32x4 accF[2][8], accB[2][8];
#pragma unroll
    for (int i = 0; i < 2; ++i)
#pragma unroll
        for (int j = 0; j < 8; ++j) { accF[i][j] = (f32x4){0.f, 0.f, 0.f, 0.f}; accB[i][j] = (f32x4){0.f, 0.f, 0.f, 0.f}; }
    const int tq = lc >> 2, tp = lc & 3;
#pragma unroll 1
    for (int st = 0; st < 4; ++st) {
        bf16x8 av[2][2];
#pragma unroll
        for (int ks = 0; ks < 2; ++ks)
#pragma unroll
            for (int mf = 0; mf < 2; ++mf)
                av[ks][mf] = *(const bf16x8*)(RVT + (size_t)(h * 256 + dvbase + mf * 16 + lc) * M + row0 + st * 64 + ks * 32 + g * 8);
        bf16x8 avF[2][2], avB[2][2];
#pragma unroll
        for (int ks = 0; ks < 2; ++ks) {
            const int ti0 = st * 64 + ks * 32 + g * 8;
            float wf = __expf(lgf * (float)(255 - ti0)), wb = __expf(lgb * (float)ti0);
#pragma unroll
            for (int j = 0; j < 8; ++j) {
#pragma unroll
                for (int mf = 0; mf < 2; ++mf) {
                    const float v = bf2f((bf16_t)av[ks][mf][j]);
                    avF[ks][mf][j] = (short)f2bf(v * wf); avB[ks][mf][j] = (short)f2bf(v * wb);
                }
                wf *= rf; wb *= rb;
            }
        }
        asm volatile("s_waitcnt vmcnt(0)" ::: "memory");
        __syncthreads();
        if (st + 1 < 4) dma_k(st + 1);
        const unsigned char* Kt = lds + (st & 1) * 16384;
#pragma unroll
        for (int ks = 0; ks < 2; ++ks)
#pragma unroll
            for (int nf = 0; nf < 8; ++nf) {
                const int r0 = 32 * ks + 8 * g + tq, r1 = r0 + 4;
                const unsigned char* a0 = Kt + r0 * 256 + (((2 * nf + (tp >> 1)) ^ (((r0 & 3) << 2) | ((r0 >> 2) & 3))) << 4) + 8 * (tp & 1);
                const unsigned char* a1 = Kt + r1 * 256 + (((2 * nf + (tp >> 1)) ^ (((r1 & 3) << 2) | ((r1 >> 2) & 3))) << 4) + 8 * (tp & 1);
                union { v4i16_t hlf[2]; bf16x8 v; } bk;
                bk.hlf[0] = __builtin_amdgcn_ds_read_tr16_b64_v4i16((LAS v4i16_t*)a0);
                bk.hlf[1] = __builtin_amdgcn_ds_read_tr16_b64_v4i16((LAS v4i16_t*)a1);
#pragma unroll
                for (int mf = 0; mf < 2; ++mf) {
                    accF[mf][nf] = __builtin_amdgcn_mfma_f32_16x16x32_bf16(avF[ks][mf], bk.v, accF[mf][nf], 0, 0, 0);
                    accB[mf][nf] = __builtin_amdgcn_mfma_f32_16x16x32_bf16(avB[ks][mf], bk.v, accB[mf][nf], 0, 0, 0);
                }
            }
    }
    if (lat) {
        bf16_t* dF = ws_bf(p, OFF_RS) + ((size_t)((b * 4 + h) * 2 + 0) * 8 + (c + 1)) * 32768;
        bf16_t* dB = ws_bf(p, OFF_RS) + ((size_t)((b * 4 + h) * 2 + 1) * 8 + (c - 1)) * 32768;
#pragma unroll
        for (int mf = 0; mf < 2; ++mf)
#pragma unroll
            for (int nf = 0; nf < 8; ++nf)
#pragma unroll
                for (int r = 0; r < 4; ++r) {
                    const size_t o = (size_t)(dvbase + mf * 16 + g * 4 + r) * 128 + nf * 16 + lc;
                    if (doF) dF[o] = f2bf(accF[mf][nf][r]);
                    if (doB) dB[o] = f2bf(accB[mf][nf][r]);
                }
    } else {
        float* dF = p.out + O_NRET + ((((size_t)b * 2 + l) * 2 + 0) * 4 + h) * 128 * 256;
        float* dB = p.out + O_NRET + ((((size_t)b * 2 + l) * 2 + 1) * 4 + h) * 128 * 256;
#pragma unroll
        for (int mf = 0; mf < 2; ++mf)
#pragma unroll
            for (int nf = 0; nf < 8; ++nf) {
                const size_t o = (size_t)(nf * 16 + lc) * 256 + dvbase + mf * 16 + g * 4;
                *(float4*)(dF + o) = make_float4(accF[mf][nf][0], accF[mf][nf][1], accF[mf][nf][2], accF[mf][nf][3]);
                *(float4*)(dB + o) = make_float4(accB[mf][nf][0], accB[mf][nf][1], accB[mf][nf][2], accB[mf][nf][3]);
            }
    }
}
DEV void phase_ret_kv(CParams& p, int l, unsigned char* lds) {
    for (int item = BIDX(); item < 192; item += GDIM()) ret_kv_tile(p, l, item, lds);
}

DEV void phase_ret_scan(CParams& p, int l, int vb, int nvb) {
    bf16_t* RS = ws_bf(p, OFF_RS);
    const int gt = vb * 512 + TIDX(), gs = nvb * 512;
    for (int idx = gt; idx < 4 * 4 * 2 * 4096; idx += gs) {
        const int dk0 = (idx & 15) * 8, dv = (idx >> 4) & 255, dir = (idx >> 12) & 1, h = (idx >> 13) & 3, b = idx >> 15;
        const float g256 = __expf(ret_logg(p, l, dir, h) * 256.f);
        const float* s0 = p.state_ret + (((((size_t)b * 2 + l) * 2 + dir) * 4 + h) * 128 + dk0) * 256 + dv;
        float st[8];
#pragma unroll
        for (int e = 0; e < 8; ++e) st[e] = s0[(size_t)e * 256];
        bf16_t* base = RS + (size_t)((b * 4 + h) * 2 + dir) * 8 * 32768 + dv * 128 + dk0;
        uint4 kv[7];
#pragma unroll
        for (int j = 0; j < 7; ++j) kv[j] = *(const uint4*)(base + (size_t)(dir == 0 ? j + 1 : 6 - j) * 32768);
        *(uint4*)(base + (size_t)(dir == 0 ? 0 : 7) * 32768) = make_uint4(pk2(st[0], st[1]), pk2(st[2], st[3]), pk2(st[4], st[5]), pk2(st[6], st[7]));
#pragma unroll
        for (int j = 0; j < 7; ++j) {
            st[0] = g256 * st[0] + g8::lo16(kv[j].x); st[1] = g256 * st[1] + g8::hi16(kv[j].x);
            st[2] = g256 * st[2] + g8::lo16(kv[j].y); st[3] = g256 * st[3] + g8::hi16(kv[j].y);
            st[4] = g256 * st[4] + g8::lo16(kv[j].z); st[5] = g256 * st[5] + g8::hi16(kv[j].z);
            st[6] = g256 * st[6] + g8::lo16(kv[j].w); st[7] = g256 * st[7] + g8::hi16(kv[j].w);
            *(uint4*)(base + (size_t)(dir == 0 ? j + 1 : 6 - j) * 32768) = make_uint4(pk2(st[0], st[1]), pk2(st[2], st[3]), pk2(st[4], st[5]), pk2(st[6], st[7]));
        }
    }
}

DEV void ret_out_tile(CParams& p, int l, int item, unsigned char* lds) {
    bf16_t* Pb = ws_bf(p, OFF_P); const bf16_t* RVT = ws_bf(p, OFF_RVT);
    const int tid = TIDX(), lane = tid & 63, w = __builtin_amdgcn_readfirstlane(tid >> 6), g = lane >> 4, lc = lane & 15;
    const bool lat = item < 256;
    int b, h, qb, rowc, qi0, c;
    if (lat) { qb = item & 15; h = (item >> 4) & 3; b = item >> 6; c = qb >> 1; rowc = NCTX + b * 2048 + c * 256; qi0 = (qb & 1) * 128; }
    else { const int it = item - 256; qb = it & 1; h = (it >> 1) & 3; b = it >> 3; c = 0; rowc = b * 256; qi0 = qb * 128; }
    const int qi = qi0 + w * 16 + lc;
    const size_t rowq = (size_t)(rowc + qi);
    const float lgf = ret_logg(p, l, 0, h), lgb = ret_logg(p, l, 1, h);
    const int nstep = lat ? 8 : 4;
    auto dma_step = [&](int sI) __attribute__((always_inline)) {
        LAS unsigned char* base = (LAS unsigned char*)lds + (sI & 1) * 49152;
        if (sI < 4) {
#pragma unroll
            for (int i = 0; i < 2; ++i) {
                const int q = w * 2 + i, row = 4 * q + (lane >> 4), lch = (lane & 15) ^ (row & 15);
                __builtin_amdgcn_global_load_lds((const unsigned*)(Pb + (size_t)(rowc + sI * 64 + row) * PW + C_RK + h * 128 + lch * 8), (LAS unsigned*)(base + q * 1024), 16, 0, 0);
            }
#pragma unroll
            for (int i = 0; i < 4; ++i) {
                const int q = w * 4 + i, row = 8 * q + (lane >> 3), lch = (lane & 7) ^ ((row >> 1) & 7);
                __builtin_amdgcn_global_load_lds((const unsigned*)(RVT + (size_t)(h * 256 + row) * M + rowc + sI * 64 + lch * 8), (LAS unsigned*)(base + 16384 + q * 1024), 16, 0, 0);
            }
        } else {
            const int dir = (sI - 4) >> 1, kh = (sI - 4) & 1;
            const bf16_t* Sg = ws_bf(p, OFF_RS) + ((size_t)((b * 4 + h) * 2 + dir) * 8 + c) * 32768;
#pragma unroll
            for (int i = 0; i < 4; ++i) {
                const int q = w * 4 + i, row = 8 * q + (lane >> 3), lch = (lane & 7) ^ ((row >> 1) & 7);
                __builtin_amdgcn_global_load_lds((const unsigned*)(Sg + (size_t)row * 128 + kh * 64 + lch * 8), (LAS unsigned*)(base + 16384 + q * 1024), 16, 0, 0);
            }
        }
    };
    dma_step(0);
    f32x4 acc[16];
#pragma unroll
    for (int df = 0; df < 16; ++df) acc[df] = (f32x4){0.f, 0.f, 0.f, 0.f};
    const int vsw = (lc >> 1) & 7;
    unsigned char* qsave = lds + 98304 + tid * 64;
    {
        bf16x8 qfr[4];
#pragma unroll
        for (int ks = 0; ks < 4; ++ks) { qfr[ks] = *(const bf16x8*)(Pb + rowq * PW + C_RQ + h * 128 + ks * 32 + g * 8); *(bf16x8*)(qsave + ks * 16) = qfr[ks]; }
#pragma unroll 1
        for (int sI = 0; sI < 4; ++sI) {
            asm volatile("s_waitcnt vmcnt(0)" ::: "memory");
            __syncthreads();
            if (sI + 1 < nstep) dma_step(sI + 1);
            const unsigned char* Ks = lds + (sI & 1) * 49152;
            const unsigned char* Vt = Ks + 16384;
            f32x4 sc[4];
#pragma unroll
            for (int kf = 0; kf < 4; ++kf) sc[kf] = (f32x4){0.f, 0.f, 0.f, 0.f};
#pragma unroll
            for (int kb = 0; kb < 2; ++kb) {
                bf16x8 ak[2][4];
#pragma unroll
                for (int k2 = 0; k2 < 2; ++k2)
#pragma unroll
                    for (int kf = 0; kf < 4; ++kf) ak[k2][kf] = *(const bf16x8*)(Ks + (kf * 16 + lc) * 256 + ((((kb * 2 + k2) * 4 + g) ^ lc) << 4));
                __builtin_amdgcn_sched_barrier(0);
#pragma unroll
                for (int k2 = 0; k2 < 2; ++k2)
#pragma unroll
                    for (int kf = 0; kf < 4; ++kf) sc[kf] = __builtin_amdgcn_mfma_f32_16x16x32_bf16(ak[k2][kf], qfr[kb * 2 + k2], sc[kf], 0, 0, 0);
                __builtin_amdgcn_sched_barrier(0);
            }
            bf16x8 pb[2];
#pragma unroll
            for (int kf = 0; kf < 4; ++kf)
#pragma unroll
                for (int r = 0; r < 4; ++r) {
                    const int dd = qi - (sI * 64 + kf * 16 + g * 4 + r);
                    float wgt = 0.f;
                    if (dd >= 0) wgt += __expf(lgf * (float)dd);
                    if (dd <= 0) wgt += __expf(lgb * (float)(-dd));
                    pb[kf >> 1][(kf & 1) * 4 + r] = (short)f2bf(sc[kf][r] * wgt);
                }
#pragma unroll
            for (int s2 = 0; s2 < 2; ++s2)
#pragma unroll
                for (int db = 0; db < 2; ++db) {
                    uint2 lo[8], hi[8];
#pragma unroll
                    for (int j = 0; j < 8; ++j) {
                        const unsigned char* vr = Vt + ((db * 8 + j) * 16 + lc) * 128 + 8 * (g & 1);
                        lo[j] = *(const uint2*)(vr + (((4 * s2 + (g >> 1)) ^ vsw) << 4));
                        hi[j] = *(const uint2*)(vr + (((4 * s2 + 2 + (g >> 1)) ^ vsw) << 4));
                    }
                    __builtin_amdgcn_sched_barrier(0);
#pragma unroll
                    for (int j = 0; j < 8; ++j) {
                        union { uint4 u; bf16x8 v; } av; av.u = make_uint4(lo[j].x, lo[j].y, hi[j].x, hi[j].y);
                        acc[db * 8 + j] = __builtin_amdgcn_mfma_f32_16x16x32_bf16(av.v, pb[s2], acc[db * 8 + j], 0, 0, 0);
                    }
                    __builtin_amdgcn_sched_barrier(0);
                }
        }
    }
    if (lat) {
#pragma unroll 1
        for (int dir = 0; dir < 2; ++dir) {
            const float qs = dir == 0 ? __expf(lgf * (float)(qi + 1)) : __expf(lgb * (float)(256 - qi));
            bf16x8 qx[4];
#pragma unroll
            for (int ks = 0; ks < 4; ++ks) {
                const bf16x8 qv = *(const bf16x8*)(qsave + ks * 16);
#pragma unroll
                for (int e = 0; e < 8; ++e) qx[ks][e] = (short)f2bf(qs * bf2f((bf16_t)qv[e]));
            }
#pragma unroll
            for (int kh = 0; kh < 2; ++kh) {
                const int sI = 4 + dir * 2 + kh;
                asm volatile("s_waitcnt vmcnt(0)" ::: "memory");
                __syncthreads();
                if (sI + 1 < nstep) dma_step(sI + 1);
                const unsigned char* Vt = lds + (sI & 1) * 49152 + 16384;
#pragma unroll
                for (int db = 0; db < 4; ++db) {
                    bf16x8 as0[4], as1[4];
#pragma unroll
                    for (int j = 0; j < 4; ++j) {
                        as0[j] = *(const bf16x8*)(Vt + ((db * 4 + j) * 16 + lc) * 128 + (((0 + g) ^ vsw) << 4));
                        as1[j] = *(const bf16x8*)(Vt + ((db * 4 + j) * 16 + lc) * 128 + (((4 + g) ^ vsw) << 4));
                    }
                    __builtin_amdgcn_sched_barrier(0);
#pragma unroll
                    for (int j = 0; j < 4; ++j) {
                        acc[db * 4 + j] = __builtin_amdgcn_mfma_f32_16x16x32_bf16(as0[j], qx[kh * 2 + 0], acc[db * 4 + j], 0, 0, 0);
                        acc[db * 4 + j] = __builtin_amdgcn_mfma_f32_16x16x32_bf16(as1[j], qx[kh * 2 + 1], acc[db * 4 + j], 0, 0, 0);
                    }
                    __builtin_amdgcn_sched_barrier(0);
                }
            }
        }
    }
    float s1 = 0.f;
#pragma unroll
    for (int df = 0; df < 16; ++df) s1 += (acc[df][0] + acc[df][1]) + (acc[df][2] + acc[df][3]);
    s1 = xrow16_sum(s1);
    const float mu = s1 * (1.f / 256.f);
    float s2 = 0.f;
#pragma unroll
    for (int df = 0; df < 16; ++df)
#pragma unroll
        for (int r = 0; r < 4; ++r) { const float xc = acc[df][r] - mu; s2 += xc * xc; }
    s2 = xrow16_sum(s2);
    const float rstd = rsqrtf(s2 * (1.f / 256.f) + EPS);
#pragma unroll
    for (int df = 0; df < 16; ++df) {
        bf16_t* gp = Pb + rowq * PW + C_RG + h * 256 + df * 16 + g * 4;
        const uint2 gv = *(const uint2*)gp;
        uint2 o;
        o.x = pk2((acc[df][0] - mu) * rstd * __uint_as_float(gv.x << 16), (acc[df][1] - mu) * rstd * __uint_as_float(gv.x & 0xffff0000u));
        o.y = pk2((acc[df][2] - mu) * rstd * __uint_as_float(gv.y << 16), (acc[df][3] - mu) * rstd * __uint_as_float(gv.y & 0xffff0000u));
        *(uint2*)gp = o;
    }
}
DEV void phase_ret_out(CParams& p, int l, unsigned char* lds) {
    if (GDIM() == 256) {
        const int xg = BIDX() & 7, j = BIDX() >> 3;
        ret_out_tile(p, l, ((j >> 1) * 8 + xg) * 2 + (j & 1), lds);
        if (j < 16) ret_out_tile(p, l, 256 + ((j >> 1) * 8 + xg) * 2 + (j & 1), lds);
        return;
    }
    for (int item = BIDX(); item < 384; item += GDIM()) ret_out_tile(p, l, item, lds);
}

template <bool REV>
DEV void lru_scan16(const float (&a)[4][4], const float (&u)[4][4], float cin, int g, int lc, float (&h)[4][4], float& cout, float& Aprod) {
    float carry = cin, Ap = 1.f;
#pragma unroll
    for (int ii = 0; ii < 4; ++ii) {
        const int i = REV ? 3 - ii : ii;
        float hl[4], cp[4];
        {
            float hh = 0.f, cc = 1.f;
#pragma unroll
            for (int rr = 0; rr < 4; ++rr) { const int r = REV ? 3 - rr : rr; hh = a[i][r] * hh + u[i][r]; cc *= a[i][r]; hl[r] = hh; cp[r] = cc; }
        }
        const float As = REV ? cp[0] : cp[3], Hs = REV ? hl[0] : hl[3];
        float Ag[4], Hg[4];
        xrow16_gather(As, Ag); xrow16_gather(Hs, Hg);
        float cur = carry, mine = carry;
#pragma unroll
        for (int sI = 0; sI < 4; ++sI) {
            const int gg = REV ? 3 - sI : sI;
            mine = (g == gg) ? cur : mine;
            cur = Ag[gg] * cur + Hg[gg];
            Ap *= Ag[gg];
        }
        carry = cur;
#pragma unroll
        for (int r = 0; r < 4; ++r) h[i][r] = hl[r] + cp[r] * mine;
    }
    cout = carry; Aprod = Ap;
}

template <bool REV>
DEV void lru_dir(const unsigned char* xa, const bf16x8 (&bA)[4], const bf16x8 (&bX)[4], float ba, float bx, float c2, float cin,
                 const float (&x)[4][4], int g, int lc, float (&h)[4][4], float& cout, float& Ap) {
    f32x4 accA[4], accX[4];
#pragma unroll
    for (int i = 0; i < 4; ++i) { accA[i] = (f32x4){0.f, 0.f, 0.f, 0.f}; accX[i] = (f32x4){0.f, 0.f, 0.f, 0.f}; }
#pragma unroll
    for (int ks = 0; ks < 4; ++ks)
#pragma unroll
        for (int i = 0; i < 4; ++i) {
            const bf16x8 af = *(const bf16x8*)(xa + (i * 16 + lc) * 256 + (((ks * 4 + g) ^ lc) << 4));
            accA[i] = __builtin_amdgcn_mfma_f32_16x16x32_bf16(af, bA[ks], accA[i], 0, 0, 0);
            accX[i] = __builtin_amdgcn_mfma_f32_16x16x32_bf16(af, bX[ks], accX[i], 0, 0, 0);
        }
    float a[4][4], u[4][4];
#pragma unroll
    for (int i = 0; i < 4; ++i)
#pragma unroll
        for (int r = 0; r < 4; ++r) {
            const float rg = sigmf(accA[i][r] + ba), ig = sigmf(accX[i][r] + bx);
            const float av = __builtin_amdgcn_exp2f(rg * c2);
            a[i][r] = av;
            u[i][r] = __builtin_amdgcn_sqrtf(fmaxf(1.f - av * av, 0.f)) * (ig * x[i][r]);
        }
    lru_scan16<REV>(a, u, cin, g, lc, h, cout, Ap);
}

DEV void phase_lru_tiles(CParams& p, int l, int mode, unsigned char* lds) {
    unsigned char* xa = lds; float* hs = (float*)(lds + 16384); float* cwl = (float*)(lds + 49152); unsigned char* rawb = lds + 53248;
    bf16_t* Pb = ws_bf(p, OFF_P);
    const int tid = TIDX(), lane = tid & 63, w = __builtin_amdgcn_readfirstlane(tid >> 6), g = lane >> 4, lc = lane & 15;
    const int blk = BIDX() & 7, gstep = GDIM() >> 3;
    const int cl = w * 16 + lc, ch = blk * 128 + cl;
    for (int e = tid; e < 5 * 128; e += 512) {
        const int j = e >> 7, c = e & 127;
        cwl[e] = j < 4 ? p.conv_w[(size_t)(l * 4 + j) * D + blk * 128 + c] : p.conv_b[(size_t)l * D + blk * 128 + c];
    }
    bf16x8 bAf[4], bXf[4], bAb[4], bXb[4];
    {
        const bf16_t* W = ws_bf(p, OFF_LRUW) + ((size_t)blk * 128 + cl) * 128 + g * 8;
#pragma unroll
        for (int ks = 0; ks < 4; ++ks) {
            bAf[ks] = *(const bf16x8*)(W + ks * 32);
            bXf[ks] = *(const bf16x8*)(W + (size_t)1 * 8 * 16384 + ks * 32);
            bAb[ks] = *(const bf16x8*)(W + (size_t)2 * 8 * 16384 + ks * 32);
            bXb[ks] = *(const bf16x8*)(W + (size_t)3 * 8 * 16384 + ks * 32);
        }
    }
    const float baF = p.lru_ba[(l * 2 + 0) * D + ch], bxF = p.lru_bx[(l * 2 + 0) * D + ch];
    const float baB = p.lru_ba[(l * 2 + 1) * D + ch], bxB = p.lru_bx[(l * 2 + 1) * D + ch];
    const float c2F = -8.f * 1.4426950408889634f * softplusf(-p.lru_lambda[(l * 2 + 0) * D + ch]);
    const float c2B = -8.f * 1.4426950408889634f * softplusf(-p.lru_lambda[(l * 2 + 1) * D + ch]);
    float* LA = (float*)(p.ws + OFF_LRUC);
    float* LH = LA + 192 * 2 * 1024;
    const int chunk = tid & 15, chb = blk * 128 + chunk * 8, trow = tid >> 4;
#define LRU_PREFETCH(gcn) do { const bf16_t* src_ = Pb + (long)((gcn) * 64 - 1 + (lane >> 4)) * (long)PW + C_LX + blk * 128 + (lane & 15) * 8; \
        _Pragma("unroll") for (int q_ = 0; q_ < 3; ++q_) { const int qq_ = w + 8 * q_; if (qq_ < 17) \
            __builtin_amdgcn_global_load_lds((const unsigned*)(src_ + (long)qq_ * 4 * PW), (LAS unsigned*)((LAS unsigned char*)rawb + qq_ * 1024), 16, 0, 0); } } while (0)
    int gc = BIDX() >> 3, gend = 192, gst = gstep;
    if (mode && GDIM() == 256) { const int j = BIDX() >> 3; gc = j < 16 ? j * 5 : 80 + (j - 16) * 7; gend = gc + (j < 16 ? 5 : 7); gst = 1; }
    if (gc < gend) LRU_PREFETCH(gc);
    for (; gc < gend; gc += gst) {
        const int m0 = gc * 64;
        const bool lat = m0 >= NCTX;
        const int L = lat ? 2048 : 256, t0 = lat ? ((m0 - NCTX) & 2047) : (m0 & 255);
        asm volatile("s_waitcnt vmcnt(0)" ::: "memory");
        __syncthreads();
#pragma unroll
        for (int i = 0; i < 2; ++i) {
            const int tt = trow + 32 * i;
            float acc[8];
#pragma unroll
            for (int e = 0; e < 8; ++e) acc[e] = cwl[4 * 128 + chunk * 8 + e];
#pragma unroll
            for (int j = 0; j < 4; ++j) {
                const int tp = t0 + tt + j - 1;
                if (tp >= 0 && tp < L) {
                    const uint4 v = *(const uint4*)(rawb + (tt + j) * 256 + chunk * 16);
                    const float* cw = cwl + j * 128 + chunk * 8;
                    acc[0] += cw[0] * __uint_as_float(v.x << 16); acc[1] += cw[1] * __uint_as_float(v.x & 0xffff0000u);
                    acc[2] += cw[2] * __uint_as_float(v.y << 16); acc[3] += cw[3] * __uint_as_float(v.y & 0xffff0000u);
                    acc[4] += cw[4] * __uint_as_float(v.z << 16); acc[5] += cw[5] * __uint_as_float(v.z & 0xffff0000u);
                    acc[6] += cw[6] * __uint_as_float(v.w << 16); acc[7] += cw[7] * __uint_as_float(v.w & 0xffff0000u);
                }
            }
            uint4 o;
            o.x = pk2(acc[0], acc[1]); o.y = pk2(acc[2], acc[3]);
            o.z = pk2(acc[4], acc[5]); o.w = pk2(acc[6], acc[7]);
            *(uint4*)(xa + tt * 256 + ((chunk ^ (tt & 15)) << 4)) = o;
        }
        __syncthreads();
        if (gc + gst < gend) LRU_PREFETCH(gc + gst);
        const size_t ci = ((size_t)gc * 2) * 1024 + ch;
        const float cinF = mode ? LH[ci] : 0.f, cinB = mode ? LH[ci + 1024] : 0.f;
        uint4 gv[2];
        if (mode) {
#pragma unroll
            for (int i = 0; i < 2; ++i) gv[i] = *(const uint4*)(Pb + (size_t)(m0 + trow + 32 * i) * PW + C_LG + chb);
        }
        {
            float x[4][4];
#pragma unroll
            for (int i = 0; i < 4; ++i)
#pragma unroll
                for (int r = 0; r < 4; ++r) {
                    const int tok = i * 16 + g * 4 + r;
                    x[i][r] = bf2f(*(const bf16_t*)(xa + tok * 256 + (((cl >> 3) ^ (tok & 15)) << 4) + (cl & 7) * 2));
                }
            float h[4][4], cout, Ap;
            lru_dir<false>(xa, bAf, bXf, baF, bxF, c2F, cinF, x, g, lc, h, cout, Ap);
            if (!mode) { if (g == 0) { LA[ci] = Ap; LH[ci] = cout; } }
            else {
#pragma unroll
                for (int i = 0; i < 4; ++i)
#pragma unroll
                    for (int r = 0; r < 4; ++r) hs[(i * 16 + g * 4 + r) * 128 + cl] = h[i][r];
                if (!lat && g == 0 && t0 == 192) p.out[O_NLRU + ((size_t)((m0 >> 8) * 2 + l) * 2 + 0) * 1024 + ch] = cout;
            }
            lru_dir<true>(xa, bAb, bXb, baB, bxB, c2B, cinB, x, g, lc, h, cout, Ap);
            if (!mode) { if (g == 0) { LA[ci + 1024] = Ap; LH[ci + 1024] = cout; } }
            else {
#pragma unroll
                for (int i = 0; i < 4; ++i)
#pragma unroll
                    for (int r = 0; r < 4; ++r) hs[(i * 16 + g * 4 + r) * 128 + cl] += h[i][r];
                if (!lat && g == 0 && t0 == 0) p.out[O_NLRU + ((size_t)((m0 >> 8) * 2 + l) * 2 + 1) * 1024 + ch] = cout;
            }
        }
        if (mode) {
            __syncthreads();
#pragma unroll
            for (int i = 0; i < 2; ++i) {
                const int tt = trow + 32 * i, c8 = chunk * 8;
                const float4 h0 = *(const float4*)(hs + tt * 128 + c8), h1 = *(const float4*)(hs + tt * 128 + c8 + 4);
                uint4 o;
                o.x = pk2(h0.x * __uint_as_float(gv[i].x << 16), h0.y * __uint_as_float(gv[i].x & 0xffff0000u));
                o.y = pk2(h0.z * __uint_as_float(gv[i].y << 16), h0.w * __uint_as_float(gv[i].y & 0xffff0000u));
                o.z = pk2(h1.x * __uint_as_float(gv[i].z << 16), h1.y * __uint_as_float(gv[i].z & 0xffff0000u));
                o.w = pk2(h1.z * __uint_as_float(gv[i].w << 16), h1.w * __uint_as_float(gv[i].w & 0xffff0000u));
                *(uint4*)(Pb + (size_t)(m0 + tt) * PW + C_LG + chb) = o;
            }
        }
    }
    asm volatile("s_waitcnt vmcnt(0)" ::: "memory");
    __syncthreads();
#undef LRU_PREFETCH
}

DEV void phase_lru_carry(CParams& p, int l, int vb, int nvb) {
    float* LA = (float*)(p.ws + OFF_LRUC);
    float* LH = LA + 192 * 2 * 1024;
    const int gt = vb * 512 + TIDX(), gs = nvb * 512;
    for (int idx = gt; idx < 20 * 2 * 1024; idx += gs) {
        const int ch = idx & 1023, dir = (idx >> 10) & 1, seq = idx >> 11;
        const bool lat = seq >= 16;
        const int nch = lat ? 32 : 4;
        const int gc0 = lat ? 64 + (seq - 16) * 32 : seq * 4;
        float carry = lat ? p.state_lru[((size_t)((seq - 16) * 2 + l) * 2 + dir) * 1024 + ch] : 0.f;
        for (int s0 = 0; s0 < nch; s0 += 4) {
            float A[4], Hh[4]; size_t ci[4];
#pragma unroll
            for (int k = 0; k < 4; ++k) {
                const int sI = s0 + k, cidx = dir == 0 ? sI : nch - 1 - sI;
                ci[k] = ((size_t)(gc0 + cidx) * 2 + dir) * 1024 + ch;
                A[k] = LA[ci[k]]; Hh[k] = LH[ci[k]];
            }
#pragma unroll
            for (int k = 0; k < 4; ++k) { LH[ci[k]] = carry; carry = A[k] * carry + Hh[k]; }
        }
    }
}

DEV CParams* KARGS() { CParams* kp = (CParams*)__builtin_amdgcn_kernarg_segment_ptr(); asm volatile("" : "+s"(kp)); return kp; }

#define XB_TMO      128
#define XB_XCNT(j)  (256  + 64 * (j))
#define XB_XSUB(j)  (1280 + 64 * (j))
#define XB_XGEN(j)  (2304 + 64 * (j))
#define XB_TOP      3328
#define XB_TOPGEN   3392
#define XCD_BAR_WORDS 3456
#define XB_SPIN_CAP (1u << 18)
DEV unsigned xb_ld(unsigned* p)              { return __hip_atomic_load(p, __ATOMIC_RELAXED, __HIP_MEMORY_SCOPE_AGENT); }
DEV unsigned xb_add(unsigned* p, unsigned v) { return __hip_atomic_fetch_add(p, v, __ATOMIC_RELAXED, __HIP_MEMORY_SCOPE_AGENT); }
DEV unsigned xb_xcc_id() { return (unsigned)__builtin_amdgcn_s_getreg((3 << 11) | 20) & 0xFu; }
#define XB_SPIN(cond, bar) do { unsigned _sp = 0; while (cond) { __builtin_amdgcn_s_sleep(1); \
    if ((++_sp & 255u) == 0u) { if (xb_ld(&(bar)[XB_TMO])) break; if (_sp > XB_SPIN_CAP) { atomicAdd(&(bar)[XB_TMO], 1u); break; } } } } while (0)
struct XcdBarrier { unsigned* bar; unsigned x; volatile LAS unsigned* st; };
DEV XcdBarrier xcd_barrier_post(unsigned* bar, volatile LAS unsigned* st) {
    XcdBarrier b; b.bar = bar; b.x = xb_xcc_id(); b.st = st;
    if (threadIdx.x == 0) (void)xb_add(&bar[XB_XCNT(b.x)], 1u);
    return b;
}
DEV void xcd_barrier_complete(unsigned* bar, unsigned x, unsigned& nloc, unsigned& nx) {
    const unsigned G = gridDim.x * gridDim.y * gridDim.z;
    unsigned sum, cnt, mine, sp = 0u;
    for (;;) {
        sum = 0u; cnt = 0u; mine = 0u;
#pragma unroll
        for (unsigned j = 0; j < 16; ++j) { const unsigned c = xb_ld(&bar[XB_XCNT(j)]); sum += c; cnt += (c > 0u) ? 1u : 0u; mine = (j == x) ? c : mine; }
        if (sum == G) break;
        __builtin_amdgcn_s_sleep(1);
        if ((++sp & 255u) == 0u) { if (xb_ld(&bar[XB_TMO])) break; if (sp > XB_SPIN_CAP) { atomicAdd(&bar[XB_TMO], 1u); break; } }
    }
    nloc = mine > 0u ? mine : 1u; nx = cnt > 0u ? cnt : 1u;
}
DEV void xcd_barrier(const XcdBarrier& b0) {
    asm volatile("s_waitcnt vmcnt(0)" ::: "memory");
    __syncthreads();
    if (threadIdx.x == 0) {
        XcdBarrier b; b.x = b0.x; b.st = b0.st;
        asm volatile("" : "+s"(b.x));
        unsigned* bar = (unsigned*)(KARGS()->ws + OFF_BAR);
        __builtin_amdgcn_s_waitcnt(0);
        unsigned nloc = b.st[0], nx = b.st[1];
        if (nloc == 0u) { xcd_barrier_complete(bar, b.x, nloc, nx); b.st[0] = nloc; b.st[1] = nx; }
        const unsigned old = xb_add(&bar[XB_XSUB(b.x)], 1u);
        const unsigned gen = old / nloc;
        if (old + 1u == (gen + 1u) * nloc) {
            __builtin_amdgcn_fence(__ATOMIC_RELEASE, "agent");
            asm volatile("s_waitcnt vmcnt(0)" ::: "memory");
            const unsigned og = xb_add(&bar[XB_TOP], 1u);
            const unsigned tg = og / nx;
            if (og + 1u == (tg + 1u) * nx) xb_add(&bar[XB_TOPGEN], 1u);
            else XB_SPIN(xb_ld(&bar[XB_TOPGEN]) == tg, bar);
            __builtin_amdgcn_fence(__ATOMIC_ACQUIRE, "agent");
            xb_add(&bar[XB_XGEN(b.x)], 1u);
            asm volatile("s_waitcnt vmcnt(0)" ::: "memory");
        } else {
            XB_SPIN(xb_ld(&bar[XB_XGEN(b.x)]) == gen, bar);
            __builtin_amdgcn_fence(__ATOMIC_ACQUIRE, "agent");
            asm volatile("s_waitcnt vmcnt(0)" ::: "memory");
        }
    }
    __syncthreads();
}

enum { PH_INIT = 0, PH_PRENORM, PH_GEMM1, PH_MIX1, PH_MIX2, PH_MIX3, PH_MERGE, PH_MERGE2, PH_OUT, PH_COUNT };

DEV void run_phase(CParams& p, int ph, int l, unsigned char* lds) {
    switch (ph) {
    case PH_INIT:    phase_mod(p, (float*)lds); phase_rope_table(p); __syncthreads(); phase_convert(p, 0, (float*)lds); break;
    case PH_PRENORM: phase_prenorm(p, l); break;
    case PH_GEMM1:   phase8_gemm1(p, l, (LAS unsigned char*)lds); break;
    case PH_MIX1:    phase_attn(p, l, lds); __syncthreads(); phase_lru_tiles(p, l, 0, lds); __syncthreads(); phase_ret_kv(p, l, lds); break;
    case PH_MIX2:
        if (GDIM() == 256) {
            if (BIDX() < 192) phase8_merge(p, l, 2, (LAS unsigned char*)lds);
            else { phase_lru_carry(p, l, BIDX() - 192, 64); phase_ret_scan(p, l, BIDX() - 192, 64); }
        } else { phase_lru_carry(p, l, BIDX(), GDIM()); phase_ret_scan(p, l, BIDX(), GDIM()); }
        if (l == 1) phase_convert(p, 1, (float*)lds, 2);
        break;
    case PH_MIX3:    phase_lru_tiles(p, l, 1, lds); __syncthreads(); phase_ret_out(p, l, lds); break;
    case PH_MERGE:   phase8_merge(p, l, 0, (LAS unsigned char*)lds); break;
    case PH_MERGE2:  phase8_merge(p, l, 1, (LAS unsigned char*)lds); break;
    case PH_OUT:     phase8_out(p, l, (LAS unsigned char*)lds); if (l == 0) phase_convert(p, 1, (float*)lds, 1, 192); break;
    }
}

#if !ONE_LAUNCH
__global__ void __launch_bounds__(512, 2) phase_kernel(Params p, int ph, int l) {
    extern __shared__ __attribute__((aligned(16))) unsigned char dsm[];
    run_phase(p, ph, l, dsm);
}
#else
#ifndef PROBE_MASK
#define PROBE_MASK 0
#endif
#define PROBE_MULT 8
__global__ void __launch_bounds__(512, 2) mega_kernel(Params p) {
    extern __shared__ __attribute__((aligned(16))) unsigned char dsm[];
    cg::grid_group grid = cg::this_grid();
    volatile LAS unsigned* st = (volatile LAS unsigned*)((LAS unsigned char*)dsm + g8::STAGE_BYTES);
    if (threadIdx.x < 4) st[threadIdx.x] = 0u;
    __syncthreads();
    const XcdBarrier xb = xcd_barrier_post((unsigned*)(KARGS()->ws + OFF_BAR), st);
#define GSYNC() xcd_barrier(xb)
#if PROBE_MASK
    long long t_acc = 0, t0 = 0;
#define PROBE_BEGIN(ph) if ((PROBE_MASK >> (ph)) & 1) t0 = wall_clock64();
#define PROBE_END(ph) if ((PROBE_MASK >> (ph)) & 1) t_acc += wall_clock64() - t0;
#else
#define PROBE_BEGIN(ph)
#define PROBE_END(ph)
#endif
    if (KARGS()->out == nullptr) grid.sync();
    PROBE_BEGIN(PH_INIT) run_phase(*KARGS(), PH_INIT, 0, dsm); GSYNC(); PROBE_END(PH_INIT)
    PROBE_BEGIN(PH_PRENORM) run_phase(*KARGS(), PH_PRENORM, 0, dsm); GSYNC(); PROBE_END(PH_PRENORM)
    for (int l = 0; l < 2; ++l) {
        for (int ph = PH_GEMM1; ph <= PH_OUT; ++ph) {
            PROBE_BEGIN(ph)
            run_phase(*KARGS(), ph, l, dsm);
            if (!(l == 1 && ph == PH_OUT)) GSYNC();
            PROBE_END(ph)
        }
    }
#if PROBE_MASK
    if (blockIdx.x == 0 && threadIdx.x == 0) {
        const long long tgt = wall_clock64() + (long long)PROBE_MULT * t_acc;
        while (wall_clock64() < tgt) __builtin_amdgcn_s_sleep(8);
    }
#endif
}
#endif

extern "C" void kernel_launch(void* const* d_in, const int* in_sizes, int n_in,
                              void* d_out, int out_size, void* d_ws, size_t ws_size,
                              hipStream_t stream) {
    constexpr size_t kDynLds = LDS_XOFF + 5120;
    static int grid_blocks = 0;
    if (grid_blocks == 0) {
        if (n_in != 26 || ws_size < WS_NEED || out_size != 25231360) {
            fprintf(stderr, "kernel_launch: unexpected n_in %d / ws_size %zu (need %zu) / out_size %d\n", n_in, ws_size, (size_t)WS_NEED, out_size);
            grid_blocks = -1; return;
        }
        int dev = 0, cus = 0, per_cu = 0;
        (void)hipGetDevice(&dev);
        (void)hipDeviceGetAttribute(&cus, hipDeviceAttributeMultiprocessorCount, dev);
#if ONE_LAUNCH
        const void* kfn = (const void*)mega_kernel;
#else
        const void* kfn = (const void*)phase_kernel;
#endif
        if (hipFuncSetAttribute(kfn, hipFuncAttributeMaxDynamicSharedMemorySize, (int)kDynLds) != hipSuccess) {
            fprintf(stderr, "kernel_launch: hipFuncSetAttribute failed\n"); grid_blocks = -1; return;
        }
        if (hipOccupancyMaxActiveBlocksPerMultiprocessor(&per_cu, kfn, 512, kDynLds) != hipSuccess || per_cu < 1) {
            fprintf(stderr, "kernel_launch: occupancy query says %d blocks per CU\n", per_cu); grid_blocks = -1; return;
        }
        grid_blocks = cus & ~7;
    }
    if (grid_blocks < 0) return;
    Params p{};
    const float** pp = (const float**)&p;
    for (int i = 0; i < 26; ++i) pp[i] = (const float*)d_in[i];
    p.out = (float*)d_out;
    p.ws = (unsigned char*)d_ws;
#if ONE_LAUNCH
    (void)hipMemsetAsync((unsigned char*)d_ws + OFF_BAR, 0, 16384 + 1024, stream);
    void* args[] = {&p};
    hipError_t e = hipLaunchCooperativeKernel((const void*)mega_kernel, dim3(grid_blocks), dim3(512), args, kDynLds, stream);
    if (e != hipSuccess) fprintf(stderr, "cooperative launch failed: %s (grid %d)\n", hipGetErrorString(e), grid_blocks);
#else
    phase_kernel<<<grid_blocks, 512, kDynLds, stream>>>(p, PH_INIT, 0);
    phase_kernel<<<grid_blocks, 512, kDynLds, stream>>>(p, PH_PRENORM, 0);
    for (int l = 0; l < 2; ++l)
        for (int ph = PH_GEMM1; ph <= PH_OUT; ++ph)
            phase_kernel<<<grid_blocks, 512, kDynLds, stream>>>(p, ph, l);
#endif
}
```

```cpp
#include <hip/hip_runtime.h>
#include <hip/hip_cooperative_groups.h>
#include <cstdio>
#include <cstdint>
namespace cg = cooperative_groups;

#ifndef ONE_LAUNCH
#define ONE_LAUNCH 1
#endif

typedef unsigned short bf16_t;
#define DEV __device__ __forceinline__

constexpr int D = 1024;
constexpr int NCTX = 4096;
constexpr int NLAT = 8192;
constexpr int M = NCTX + NLAT;
constexpr int NW = 7680;
constexpr int N_RQ = 0, N_RK = 512, N_RV = 1024, N_RG = 2048, N_LX = 3072, N_LG = 4096,
              N_AQ = 5120, N_AK = 6144, N_AV = 6400, N_AG = 6656;
constexpr int PW = 6656;
constexpr int C_RQ = 0, C_RK = 512, C_RG = 1024, C_LX = 2048, C_LG = 3072,
              C_AQ = 4096, C_AK = 5120, C_AV = 5376, C_AG = 5632;
constexpr float EPS = 1e-6f;

constexpr size_t O_YP = 0, O_YS = 4194304, O_NK = 12582912, O_NV = 14680064, O_NRET = 16777216, O_NLRU = 25165824;

constexpr size_t OFF_MOD  = 0;
constexpr size_t OFF_LRUW = 122880;
constexpr size_t OFF_WBR  = OFF_LRUW + 1048576;
constexpr size_t OFF_WOUT = OFF_WBR + 6291456;
constexpr size_t OFF_WMG  = OFF_WOUT + 2097152;
constexpr size_t OFF_H    = OFF_WMG + 6291456;
constexpr size_t OFF_P    = OFF_H + (size_t)M * 1024 * 2;
constexpr size_t OFF_RVT  = OFF_P + (size_t)M * PW * 2;
constexpr size_t OFF_W1T  = OFF_RVT + (size_t)1024 * M * 2;
constexpr size_t OFF_OFTMP = OFF_W1T;
constexpr size_t OFF_LRUC = 262266880;
constexpr size_t OFF_ROPE = OFF_LRUC + (size_t)2 * 192 * 2 * 1024 * 4;
constexpr size_t OFF_BAR  = OFF_ROPE + (size_t)2048 * 96 * 8;
constexpr size_t OFF_XC   = OFF_BAR + 16384;
constexpr size_t OFF_XP   = OFF_XC + 1024;
constexpr size_t WS_NEED  = OFF_XP + 983040;
constexpr int LDS_XOFF = 131072 + 64;
static_assert(OFF_OFTMP + (size_t)M * 1024 * 2 <= OFF_LRUC, "overlap");
static_assert(WS_NEED <= 268435456, "ws budget");

struct Params;
typedef const __attribute__((address_space(4))) Params CParams;
struct Params {
    const float *x_prompt, *x_sample, *cache_k, *cache_v, *state_ret, *state_lru, *c, *c_ctx,
                *w_ada, *b_ada, *norm_pre, *norm_post, *w_in, *ret_decay, *conv_w, *conv_b,
                *lru_wa, *lru_ba, *lru_wx, *lru_bx, *lru_lambda, *att_sink, *w_branch, *w_merge, *b_merge, *w_out;
    float* out;
    unsigned char* ws;
};

DEV int BIDX() { int b = (int)blockIdx.x; asm volatile("" : "+s"(b)); return b; }
DEV int GDIM() { int g = (int)gridDim.x; asm volatile("" : "+s"(g)); return g; }
DEV int TIDX() { int t = threadIdx.x; asm volatile("" : "+v"(t)); return t; }
DEV float bf2f(bf16_t v) { return __uint_as_float(((unsigned)v) << 16); }
typedef __bf16 bf16x2_t __attribute__((ext_vector_type(2)));
DEV bf16_t f2bf(float f) { return __builtin_bit_cast(unsigned short, (__bf16)f); }
DEV unsigned pk2(float lo, float hi) { bf16x2_t v; v[0] = (__bf16)lo; v[1] = (__bf16)hi; return __builtin_bit_cast(unsigned, v); }
DEV float sigmf(float z) { return __builtin_amdgcn_rcpf(1.f + __builtin_amdgcn_exp2f(-1.4426950408889634f * z)); }
DEV float siluf(float x) { return x * sigmf(x); }
DEV float softplusf(float x) { return fmaxf(x, 0.f) + log1pf(__expf(-fabsf(x))); }

DEV float* ws_mod(CParams& p) { return (float*)(p.ws + OFF_MOD); }
DEV bf16_t* ws_bf(CParams& p, size_t off) { return (bf16_t*)(p.ws + off); }

DEV const float* x_row(CParams& p, int l, int m) {
    const float* xp = p.x_prompt; const float* xs = p.x_sample; const float* po = p.out;
    if (l == 0) return m < NCTX ? xp + (size_t)m * D : xs + (size_t)(m - NCTX) * D;
    return po + (size_t)m * D;
}
DEV int cond_row(int m) { return m < NCTX ? 0 : 1 + ((m - NCTX) >> 11); }

DEV float wave_sum(float v) {
#pragma unroll
    for (int o = 1; o < 64; o <<= 1) v += __shfl_xor(v, o);
    return v;
}
DEV float xrow16_max(float x) {
    auto s = __builtin_amdgcn_permlane16_swap(__float_as_uint(x), __float_as_uint(x), false, false);
    x = fmaxf(__uint_as_float(s[0]), __uint_as_float(s[1]));
    auto t = __builtin_amdgcn_permlane32_swap(__float_as_uint(x), __float_as_uint(x), false, false);
    return fmaxf(__uint_as_float(t[0]), __uint_as_float(t[1]));
}
DEV float xrow16_sum(float x) {
    auto s = __builtin_amdgcn_permlane16_swap(__float_as_uint(x), __float_as_uint(x), false, false);
    x = __uint_as_float(s[0]) + __uint_as_float(s[1]);
    auto t = __builtin_amdgcn_permlane32_swap(__float_as_uint(x), __float_as_uint(x), false, false);
    return __uint_as_float(t[0]) + __uint_as_float(t[1]);
}
DEV void xrow16_gather(float x, float (&v)[4]) {
    auto s = __builtin_amdgcn_permlane16_swap(__float_as_uint(x), __float_as_uint(x), false, false);
    auto e = __builtin_amdgcn_permlane32_swap(s[0], s[0], false, false);
    auto o = __builtin_amdgcn_permlane32_swap(s[1], s[1], false, false);
    v[0] = __uint_as_float(e[0]); v[1] = __uint_as_float(o[0]); v[2] = __uint_as_float(e[1]); v[3] = __uint_as_float(o[1]);
}
DEV void phase_mod(CParams& p, float* lds) {
    float* mod = ws_mod(p);
    float* sl = lds;
    float* part = lds + 1024;
    unsigned* lastf = (unsigned*)(lds + 1024 + 8 * 5 * 256);
    const int tid = TIDX(), lane = tid & 63, w = tid >> 6;
    const float* cctx = p.c_ctx; const float* cb_ = p.c;
    unsigned* MPu = (unsigned*)(p.ws + OFF_XP);
    unsigned* cnt = (unsigned*)(p.ws + OFF_XC) + 192;
    for (int unit = BIDX(); unit < 192; unit += GDIM()) {
        const int ks = unit & 7, cbk = (unit >> 3) % 12, l = unit / 96;
        __syncthreads();
        for (int e = tid; e < 5 * 128; e += 512) { const int r = e >> 7, k = ks * 128 + (e & 127); sl[e] = siluf(r == 0 ? cctx[k] : cb_[(r - 1) * D + k]); }
        __syncthreads();
        const float* wp = p.w_ada + ((size_t)l * D + ks * 128 + w * 16) * 3072 + cbk * 256 + lane * 4;
        float4 acc[5];
#pragma unroll
        for (int r = 0; r < 5; ++r) acc[r] = make_float4(0.f, 0.f, 0.f, 0.f);
#pragma unroll
        for (int k = 0; k < 16; ++k) {
            const float4 wv = *(const float4*)(wp + (size_t)k * 3072);
#pragma unroll
            for (int r = 0; r < 5; ++r) { const float sv = sl[r * 128 + w * 16 + k]; acc[r].x += sv * wv.x; acc[r].y += sv * wv.y; acc[r].z += sv * wv.z; acc[r].w += sv * wv.w; }
        }
#pragma unroll
        for (int r = 0; r < 5; ++r) *(float4*)(part + (w * 5 + r) * 256 + lane * 4) = acc[r];
        __syncthreads();
        unsigned* mp = MPu + (size_t)((l * 12 + cbk) * 8 + ks) * 1280;
        for (int e = tid; e < 1280; e += 512) {
            float v = 0.f;
#pragma unroll
            for (int q = 0; q < 8; ++q) v += part[q * 1280 + e];
            __hip_atomic_store(mp + e, __float_as_uint(v), __ATOMIC_RELAXED, __HIP_MEMORY_SCOPE_AGENT);
        }
        asm volatile("s_waitcnt vmcnt(0)" ::: "memory");
        __syncthreads();
        if (tid == 0) {
            const unsigned old = __hip_atomic_fetch_add(cnt + l * 12 + cbk, 1u, __ATOMIC_RELAXED, __HIP_MEMORY_SCOPE_AGENT);
            if (old == 7u) { __builtin_amdgcn_fence(__ATOMIC_ACQUIRE, "agent"); asm volatile("s_waitcnt vmcnt(0)" ::: "memory"); }
            *lastf = old == 7u ? 1u : 0u;
        }
        __syncthreads();
        if (*lastf) {
            const unsigned* m0 = MPu + (size_t)((l * 12 + cbk) * 8) * 1280;
            for (int e = tid; e < 1280; e += 512) {
                const int r = e >> 8, j = cbk * 256 + (e & 255);
                float v = p.b_ada[l * 3072 + j];
#pragma unroll
                for (int q = 0; q < 8; ++q) v += __uint_as_float(__hip_atomic_load(m0 + q * 1280 + e, __ATOMIC_RELAXED, __HIP_MEMORY_SCOPE_AGENT));
                mod[(size_t)(l * 5 + r) * 3072 + j] = v;
            }
        }
    }
    __syncthreads();
}

DEV void phase_rope_table(CParams& p) {
    float2* tab = (float2*)(p.ws + OFF_ROPE);
    const int gt = BIDX() * blockDim.x + TIDX(), gs = GDIM() * blockDim.x;
    for (int idx = gt; idx < 2048 * 96; idx += gs) {
        const int t = idx / 96, e = idx % 96;
        int a, c; float nq;
        if (e < 64) { a = e >> 5; c = e & 31; nq = 32.f; } else { a = (e - 64) >> 4; c = (e - 64) & 15; nq = 16.f; }
        const float pos = (float)(a ? (t & 63) : (t >> 6));
        const float inv = powf(10000.f, -(float)c / nq);
        float sn, cs; sincosf(pos * inv, &sn, &cs);
        tab[idx] = make_float2(cs, sn);
    }
}

DEV int w1t_row(int n) {
    if (n < N_RV) return (n & ~48) | ((n & 16) << 1) | ((n & 32) >> 1);
    if (n < N_RG) return PW + (n - N_RV);
    return n - 1024;
}
struct ConvTile { const float* src; bf16_t* dst; int N, K, k0, n0; bool w1; };
DEV void conv_load(const ConvTile& t, float4 (&v)[2]) {
    const int tid = TIDX();
#pragma unroll
    for (int i = 0; i < 2; ++i) v[i] = *(const float4*)(t.src + (size_t)(t.k0 + (tid >> 4) + 32 * i) * t.N + t.n0 + (tid & 15) * 4);
}
DEV void conv_park(const float4 (&v)[2], float* tile) {
    const int tid = TIDX();
#pragma unroll
    for (int i = 0; i < 2; ++i) {
        float* d = tile + ((tid >> 4) + 32 * i) * 65 + (tid & 15) * 4;
        d[0] = v[i].x; d[1] = v[i].y; d[2] = v[i].z; d[3] = v[i].w;
    }
}
DEV void conv_store(const ConvTile& t, const float* tile) {
    const int tid = TIDX();
    const int n = tid >> 3, kc = tid & 7;
    const int dr = t.w1 ? w1t_row(t.n0 + n) : t.n0 + n;
    const float* s = tile + (kc * 8) * 65 + n;
    uint4 o;
    o.x = pk2(s[0], s[65]);       o.y = pk2(s[130], s[195]);
    o.z = pk2(s[260], s[325]);    o.w = pk2(s[390], s[455]);
    *(uint4*)(t.dst + (size_t)dr * t.K + t.k0 + kc * 8) = o;
}
DEV void conv_tile(CParams& p, int l, int r, int which, ConvTile& t) {
    constexpr int T_IN = 16 * 120, T_MG = 16 * 48, T_BR = 3 * 256, T_OUT = 256;
    if (which == 2) r += T_IN + T_MG + T_BR;
    if (which == 1 && r >= T_IN + T_MG + T_BR) r += T_OUT;
    t.K = D; t.w1 = false;
    if (r < T_IN) { t.src = p.w_in + (size_t)l * D * NW; t.N = NW; t.dst = ws_bf(p, OFF_W1T); t.k0 = (r / 120) * 64; t.n0 = (r % 120) * 64; t.w1 = true; return; }
    r -= T_IN;
    if (r < T_MG) { t.src = p.w_merge + (size_t)l * D * 3072; t.N = 3072; t.dst = ws_bf(p, OFF_WMG); t.k0 = (r / 48) * 64; t.n0 = (r % 48) * 64; return; }
    r -= T_MG;
    if (r < T_BR) { const int nb = r / 256, q = r % 256;
        t.src = p.w_branch + ((size_t)l * 3 + nb) * D * D; t.N = D; t.dst = ws_bf(p, OFF_WBR) + (size_t)nb * D * D; t.k0 = (q / 16) * 64; t.n0 = (q % 16) * 64; return; }
    r -= T_BR;
    if (r < T_OUT) { t.src = p.w_out + (size_t)l * D * D; t.N = D; t.dst = ws_bf(p, OFF_WOUT); t.k0 = (r / 16) * 64; t.n0 = (r % 16) * 64; return; }
    r -= T_OUT;
    {
        const int mat = r / 4, q = r % 4;
        const int dir = mat >> 4, gate = (mat >> 3) & 1, blk = mat & 7;
        const float* wa_ = p.lru_wa; const float* wx_ = p.lru_wx;
        t.src = (gate ? wx_ : wa_) + (((size_t)l * 2 + dir) * 8 + blk) * 128 * 128; t.N = 128; t.K = 128;
        t.dst = ws_bf(p, OFF_LRUW) + (size_t)mat * 128 * 128; t.k0 = (q >> 1) * 64; t.n0 = (q & 1) * 64;
    }
}
DEV void phase_convert(CParams& p, int l, float* tile, int which = 0, int start = 0) {
    constexpr int T_IN = 16 * 120, T_MG = 16 * 48, T_BR = 3 * 256, T_OUT = 256, T_LRU = 32 * 4;
    constexpr int TOT = T_IN + T_MG + T_BR + T_OUT + T_LRU;
    const int G = GDIM();
    const int count = which == 2 ? T_OUT : which == 1 ? TOT - T_OUT : TOT;
    const int rot = ((BIDX() - start) % G + G) % G;
    for (int it = rot; it < count; it += 2 * G) {
        const bool two = it + G < count;
        ConvTile ta, tb;
        conv_tile(p, l, it, which, ta);
        conv_tile(p, l, two ? it + G : it, which, tb);
        float4 va[2], vb[2];
        conv_load(ta, va);
        if (two) conv_load(tb, vb);
        conv_park(va, tile);
        if (two) conv_park(vb, tile + 4224);
        __syncthreads();
        conv_store(ta, tile);
        if (two) conv_store(tb, tile + 4224);
        __syncthreads();
    }
}

DEV void prenorm_row(CParams& p, int l, int m, const float4 (&v)[4], int lane) {
    float ss = 0.f;
#pragma unroll
    for (int j = 0; j < 4; ++j) ss += (v[j].x * v[j].x + v[j].y * v[j].y) + (v[j].z * v[j].z + v[j].w * v[j].w);
    ss = wave_sum(ss);
    const float rstd = rsqrtf(ss * (1.f / D) + EPS);
    const float* mod = ws_mod(p) + (size_t)(l * 5 + cond_row(m)) * 3072;
    bf16_t* h = ws_bf(p, OFF_H) + (size_t)m * D;
#pragma unroll
    for (int j = 0; j < 4; ++j) {
        const int i4 = lane + 64 * j;
        const float4 g = ((const float4*)(p.norm_pre + l * D))[i4];
        const float4 sh = ((const float4*)mod)[i4];
        const float4 sc = ((const float4*)(mod + 1024))[i4];
        ushort4 o;
        o.x = f2bf(v[j].x * rstd * g.x * (1.f + sc.x) + sh.x);
        o.y = f2bf(v[j].y * rstd * g.y * (1.f + sc.y) + sh.y);
        o.z = f2bf(v[j].z * rstd * g.z * (1.f + sc.z) + sh.z);
        o.w = f2bf(v[j].w * rstd * g.w * (1.f + sc.w) + sh.w);
        ((ushort4*)h)[i4] = o;
    }
}
DEV void phase_prenorm(CParams& p, int l) {
    const int tid = TIDX(), lane = tid & 63;
    for (int m = BIDX() * 8 + (tid >> 6); m < M; m += GDIM() * 8) {
        const float4* xr = (const float4*)x_row(p, l, m);
        float4 v[4];
#pragma unroll
        for (int j = 0; j < 4; ++j) v[j] = xr[lane + 64 * j];
        prenorm_row(p, l, m, v, lane);
    }
}

typedef short bf16x8 __attribute__((ext_vector_type(8)));
typedef float f32x4 __attribute__((ext_vector_type(4)));
typedef short v4i16_t __attribute__((ext_vector_type(4)));
#define LAS __attribute__((address_space(3)))
namespace g8 {
constexpr int BK = 64, HALF = 128, HTB = HALF * BK * 2, STAGE_BYTES = 8 * HTB;
DEV int lds_byte(int r, int c) { const int st = (r >> 4) * 2 + (c >> 5), rr = r & 15, cc = c & 31, ob = rr * 64 + cc * 2; return st * 1024 + (ob ^ (((ob >> 9) & 1) << 5)); }
DEV void stage_rc(int b, int& R, int& C) { const int st = b / 1024, sb = b % 1024, swz = sb ^ (((sb >> 9) & 1) << 5); R = (st >> 1) * 16 + swz / 64; C = (st & 1) * 32 + (swz % 64) / 2; }
struct Unit { const char* a; const char* b; int kind, pm, pn; unsigned lda; };

template <class Sched, class Epi>
DEV void gemm_phase(LAS unsigned char* lds, const unsigned ldb, const int nt, const Sched& S, const Epi& E) {
    const int tid = TIDX(), wid = __builtin_amdgcn_readfirstlane(tid >> 6), lane = tid & 63, wr = wid >> 2, wc = wid & 3, fr = lane & 15, fq = lane >> 4;
    unsigned rowA[2], colA[2], voffB[2];
#pragma unroll
    for (int i = 0; i < 2; ++i) { int R, C; stage_rc(tid * 16 + i * 8192, R, C); rowA[i] = (unsigned)R; colA[i] = (unsigned)C * 2u; voffB[i] = (unsigned)R * ldb + (unsigned)C * 2u; }
    const size_t kstep = (size_t)(BK * 2);
    const size_t hstepB = (size_t)HALF * ldb;
    const unsigned ldsw = (unsigned)wid * 1024u;
    const int aoff = lds_byte(wr * 64 + fr, fq * 8), boff = lds_byte(wc * 32 + fr, fq * 8);
#define G8_SA(b, h) (((b) * 2 + (h)) * HTB)
#define G8_SB(b, h) ((4 + (b) * 2 + (h)) * HTB)
#define G8_STAGE(bufoff, gbase, voff) do { _Pragma("unroll") for (int _i = 0; _i < 2; ++_i) \
        __builtin_amdgcn_global_load_lds((const unsigned*)((const char*)(gbase) + (voff)[_i]), (LAS unsigned*)(lds + (bufoff) + ldsw + _i * 8192), 16, 0, 0); } while (0)
#define G8_STAGEA(bufoff, gbase, ld) do { _Pragma("unroll") for (int _i = 0; _i < 2; ++_i) \
        __builtin_amdgcn_global_load_lds((const unsigned*)((const char*)(gbase) + (rowA[_i] * (ld) + colA[_i])), (LAS unsigned*)(lds + (bufoff) + ldsw + _i * 8192), 16, 0, 0); } while (0)
#define G8_LDA(dst, b, h) do { _Pragma("unroll") for (int m = 0; m < 4; ++m) _Pragma("unroll") for (int k = 0; k < 2; ++k) dst[m][k] = *(const LAS bf16x8*)(lds + G8_SA(b, h) + aoff + m * 2048 + k * 1024); } while (0)
#define G8_LDB(dst, b, h) do { _Pragma("unroll") for (int n = 0; n < 2; ++n) _Pragma("unroll") for (int k = 0; k < 2; ++k) dst[n][k] = *(const LAS bf16x8*)(lds + G8_SB(b, h) + boff + n * 2048 + k * 1024); } while (0)
#define G8_MMA(ai, bj, At, Bt) do { __builtin_amdgcn_s_setprio(1); _Pragma("unroll") for (int m = 0; m < 4; ++m) _Pragma("unroll") for (int n = 0; n < 2; ++n) _Pragma("unroll") for (int k = 0; k < 2; ++k) \
        acc[ai][bj][m][n] = __builtin_amdgcn_mfma_f32_16x16x32_bf16(Bt[n][k], At[m][k], acc[ai][bj][m][n], 0, 0, 0); __builtin_amdgcn_s_setprio(0); } while (0)
#define G8_WAIT_V(n) asm volatile("s_waitcnt vmcnt(" #n ")" ::: "memory")
#define G8_WAIT_L(n) asm volatile("s_waitcnt lgkmcnt(" #n ")" ::: "memory")
#define G8_BAR __builtin_amdgcn_s_barrier()
#define G8_SCHED __builtin_amdgcn_sched_barrier(0)
    Unit cur, nxt; int ui = 0;
    if (!S.next(0, cur)) return;
    f32x4 acc[2][2][4][2];
#pragma unroll
    for (int a = 0; a < 2; ++a)
#pragma unroll
        for (int b = 0; b < 2; ++b)
#pragma unroll
            for (int m = 0; m < 4; ++m)
#pragma unroll
                for (int n = 0; n < 2; ++n) acc[a][b][m][n] = (f32x4){0.f, 0.f, 0.f, 0.f};
    bf16x8 At[4][2], B0[2][2], B1[2][2];
    const char* cA = cur.a; const char* cB = cur.b;
    unsigned ldc = cur.lda;
    G8_STAGE(G8_SB(0, 0), cB, voffB); G8_STAGE(G8_SB(0, 1), cB + hstepB, voffB); G8_STAGEA(G8_SA(0, 0), cA, ldc); G8_STAGEA(G8_SA(0, 1), cA + (size_t)HALF * ldc, ldc);
    if (wr == 1) G8_BAR;
    G8_WAIT_V(2); G8_BAR;
    G8_STAGE(G8_SB(1, 0), cB + kstep, voffB); G8_STAGEA(G8_SA(1, 0), cA + kstep, ldc); G8_STAGE(G8_SB(1, 1), cB + hstepB + kstep, voffB);
    G8_WAIT_V(6); G8_BAR;
    for (;;) {
        const bool has_next = S.next(ui + 1, nxt);
        const char* nA = has_next ? nxt.a : cA; const char* nB = has_next ? nxt.b : cB;
        const unsigned ldn = has_next ? nxt.lda : ldc;
        for (int t = 0; t < nt; t += 2) {
            const bool last = (t == nt - 2);
            const char* a1 = cA + (size_t)(t + 1) * kstep;
            const char* a2 = last ? nA : cA + (size_t)(t + 2) * kstep; const char* b2 = last ? nB : cB + (size_t)(t + 2) * kstep;
            const char* a3 = a2 + kstep; const char* b3 = b2 + kstep;
            const unsigned ld2 = last ? ldn : ldc;
            const size_t h1 = (size_t)HALF * ldc, h2 = (size_t)HALF * ld2;
            G8_LDB(B0, 0, 0); G8_LDB(B1, 0, 1); G8_SCHED; G8_LDA(At, 0, 0); G8_STAGEA(G8_SA(1, 1), a1 + h1, ldc);
            G8_WAIT_V(8); G8_WAIT_L(0); G8_BAR; G8_MMA(0, 0, At, B0); G8_MMA(0, 1, At, B1); G8_BAR; G8_SCHED;
            G8_LDA(At, 0, 1); G8_STAGE(G8_SB(0, 0), b2, voffB); G8_STAGE(G8_SB(0, 1), b2 + hstepB, voffB); G8_STAGEA(G8_SA(0, 0), a2, ld2);
            G8_WAIT_V(8); G8_WAIT_L(0); G8_BAR; G8_MMA(1, 0, At, B0); G8_MMA(1, 1, At, B1); G8_BAR; G8_SCHED;
            G8_LDB(B0, 1, 0); G8_LDB(B1, 1, 1); G8_SCHED; G8_LDA(At, 1, 0); G8_STAGEA(G8_SA(0, 1), a2 + h2, ld2);
            G8_WAIT_V(8); G8_WAIT_L(0); G8_BAR; G8_MMA(0, 0, At, B0); G8_MMA(0, 1, At, B1); G8_BAR; G8_SCHED;
            G8_LDA(At, 1, 1); G8_STAGE(G8_SB(1, 0), b3, voffB); G8_STAGE(G8_SB(1, 1), b3 + hstepB, voffB); G8_STAGEA(G8_SA(1, 0), a3, ld2);
            G8_WAIT_V(8); G8_WAIT_L(0); G8_BAR; G8_MMA(1, 0, At, B0); G8_MMA(1, 1, At, B1); G8_BAR; G8_SCHED;
        }
        if (wr == 0) G8_BAR;
        E(acc, cur, wr, wc, fr, fq);
        if (!has_next) break;
#pragma unroll
        for (int a = 0; a < 2; ++a)
#pragma unroll
            for (int b = 0; b < 2; ++b)
#pragma unroll
                for (int m = 0; m < 4; ++m)
#pragma unroll
                    for (int n = 0; n < 2; ++n) acc[a][b][m][n] = (f32x4){0.f, 0.f, 0.f, 0.f};
        cur = nxt; cA = nA; cB = nB; ldc = ldn; ++ui;
        if (wr == 1) G8_BAR;
    }
    G8_WAIT_V(0);
    G8_BAR;
#undef G8_SA
#undef G8_SB
#undef G8_STAGE
#undef G8_STAGEA
#undef G8_LDA
#undef G8_LDB
#undef G8_MMA
#undef G8_WAIT_V
#undef G8_WAIT_L
#undef G8_BAR
#undef G8_SCHED
}

DEV void grid_unit(int wgid, int nM, int nN, int& pm, int& pn) {
    const int nwg = nM * nN, q = nwg / 8, r = nwg % 8, xcd = wgid % 8, off = wgid / 8;
    wgid = (xcd < r ? xcd * (q + 1) : r * (q + 1) + (xcd - r) * q) + off;
    const int nig = 4 * nN, gid = wgid / nig, fm = gid * 4, gsz = (nM - fm) < 4 ? (nM - fm) : 4;
    pm = fm + ((wgid % nig) % gsz); pn = (wgid % nig) / gsz;
}
DEV uint2 pk4(const f32x4 v) { return make_uint2(pk2(v[0], v[1]), pk2(v[2], v[3])); }
DEV float lo16(unsigned u) { return __uint_as_float(u << 16); }
DEV float hi16(unsigned u) { return __uint_as_float(u & 0xffff0000u); }
}

struct SchedG1 {
    const char* H; const char* W; int G, c;
    DEV bool next(int i, g8::Unit& u) const {
        int L = i * G + c;
        if (L >= 1440) return false;
        if (L < 1248) { g8::grid_unit(L, 48, 26, u.pm, u.pn); u.kind = 0; u.lda = 2048u; u.a = H + (size_t)u.pm * 256 * 2048; u.b = W + (size_t)u.pn * 256 * 2048; }
        else { g8::grid_unit(L - 1248, 4, 48, u.pm, u.pn); u.kind = 0; u.lda = 2048u; u.a = W + (size_t)(PW + u.pm * 256) * 2048; u.b = H + (size_t)u.pn * 256 * 2048; u.pn += 64; }
        return true;
    }
};
struct EpiG1 {
    unsigned char* ws; float* out; int l;
    DEV void operator()(const f32x4 (&acc)[2][2][4][2], const g8::Unit& u, int wr, int wc, int fr, int fq) const {
        using namespace g8;
        bf16_t* Pb = (bf16_t*)(ws + OFF_P);
        if (u.pn >= 64) {
            bf16_t* RVT = (bf16_t*)(ws + OFF_RVT);
#pragma unroll
            for (int ai = 0; ai < 2; ++ai)
#pragma unroll
                for (int bj = 0; bj < 2; ++bj)
#pragma unroll
                    for (int m = 0; m < 4; ++m)
#pragma unroll
                        for (int n = 0; n < 2; ++n) {
                            const int ch = u.pm * 256 + ai * 128 + wr * 64 + m * 16 + fr;
                            const int tok = (u.pn - 64) * 256 + bj * 128 + wc * 32 + n * 16 + fq * 4;
                            *(uint2*)(RVT + (size_t)ch * M + tok) = pk4(acc[ai][bj][m][n]);
                        }
            return;
        }
        const int pn = u.pn;
        const bool rope_ret = pn < 4, rope_att = pn >= 16 && pn <= 20;
        const bool lat = u.pm >= 16;
        if (rope_ret || rope_att) {
            const int te = rope_ret ? (wc >> 1) * 32 + (wc & 1) * 16 + fq * 4 : 64 + (wc & 1) * 16 + fq * 4;
            const float sc = pn < 2 ? 0.08838834764831845f : (pn >= 16 && pn < 20) ? 0.125f * 1.4426950408889634f : 1.f;
#pragma unroll
            for (int ai = 0; ai < 2; ++ai) {
                float4 c01[4], c23[4];
                if (lat) {
#pragma unroll
                    for (int m = 0; m < 4; ++m) {
                        const int t = (u.pm * 256 + ai * 128 + wr * 64 + m * 16 + fr - NCTX) & 2047;
                        const float4* tb = (const float4*)((const float2*)(ws + OFF_ROPE) + (size_t)t * 96 + te);
                        c01[m] = tb[0]; c23[m] = tb[1];
                    }
                }
#pragma unroll
                for (int m = 0; m < 4; ++m) {
                    const int row = u.pm * 256 + ai * 128 + wr * 64 + m * 16 + fr;
                    bf16_t* Pr = Pb + (size_t)row * PW;
#pragma unroll
                    for (int bj = 0; bj < 2; ++bj) {
                        f32x4 x1 = acc[ai][bj][m][0], x2 = acc[ai][bj][m][1];
                        const int lc1 = rope_ret ? pn * 256 + bj * 128 + (wc >> 1) * 64 + (wc & 1) * 16 + fq * 4 : pn * 256 + bj * 128 + wc * 32 + fq * 4;
                        const int lc2 = rope_ret ? lc1 + 32 : lc1 + 16;
                        if (!lat && pn == 20) {
                            float* ok = out + O_NK + ((size_t)((row >> 8) * 2 + l) * 256 + (row & 255)) * 256 + (lc1 - C_AK);
                            *(float4*)ok = make_float4(x1[0], x1[1], x1[2], x1[3]);
                            *(float4*)(ok + 16) = make_float4(x2[0], x2[1], x2[2], x2[3]);
                        }
                        if (lat) {
                            const float cs[4] = {c01[m].x, c01[m].z, c23[m].x, c23[m].z}, sn[4] = {c01[m].y, c01[m].w, c23[m].y, c23[m].w};
                            f32x4 o1, o2;
#pragma unroll
                            for (int j = 0; j < 4; ++j) { o1[j] = x1[j] * cs[j] - x2[j] * sn[j]; o2[j] = x2[j] * cs[j] + x1[j] * sn[j]; }
                            x1 = o1; x2 = o2;
                        }
                        x1 *= sc; x2 *= sc;
                        *(uint2*)(Pr + lc1) = pk4(x1);
                        *(uint2*)(Pr + lc2) = pk4(x2);
                    }
                }
            }
            return;
        }
#pragma unroll
        for (int ai = 0; ai < 2; ++ai)
#pragma unroll
            for (int m = 0; m < 4; ++m) {
                const int row = u.pm * 256 + ai * 128 + wr * 64 + m * 16 + fr;
                bf16_t* Pr = Pb + (size_t)row * PW;
#pragma unroll
                for (int bj = 0; bj < 2; ++bj)
#pragma unroll
                    for (int n = 0; n < 2; ++n) {
                        f32x4 v = acc[ai][bj][m][n];
                        const int col = pn * 256 + bj * 128 + wc * 32 + n * 16 + fq * 4;
                        if (pn == 21) {
                            if (!lat) *(float4*)(out + O_NV + ((size_t)((row >> 8) * 2 + l) * 256 + (row & 255)) * 256 + (col - C_AV)) = make_float4(v[0], v[1], v[2], v[3]);
                        } else if (!(pn >= 8 && pn < 12)) {
#pragma unroll
                            for (int j = 0; j < 4; ++j) v[j] = siluf(v[j]);
                        }
                        *(uint2*)(Pr + col) = pk4(v);
                    }
            }
    }
};
DEV void phase8_gemm1(CParams& p, int l, LAS unsigned char* lds) {
    SchedG1 S{(const char*)(p.ws + OFF_H), (const char*)(p.ws + OFF_W1T), GDIM(), BIDX()};
    EpiG1 E{p.ws, p.out, l};
    g8::gemm_phase(lds, 2048u, 16, S, E);
}

constexpr size_t OFF_G2 = OFF_RVT;
struct SchedMg {
    const char *H, *P, *WMG, *WBR; int G, c, part;
    DEV void fill(g8::Unit& u, int tile, int n, int isz) const {
        u.pm = tile >> 2; u.pn = tile & 3; u.kind = n * 2 + isz;
        if (isz) { const int acol = n == 0 ? C_RG : n == 1 ? C_LG : C_AQ;
                   u.lda = (unsigned)PW * 2u; u.a = P + (size_t)u.pm * 256 * PW * 2 + (size_t)acol * 2; u.b = WBR + ((size_t)n * 1024 + u.pn * 256) * 2048; }
        else { u.lda = 2048u; u.a = H + (size_t)u.pm * 256 * 2048; u.b = WMG + ((size_t)n * 1024 + u.pn * 256) * 2048; }
    }
    DEV bool next(int i, g8::Unit& u) const {
        if (G == 256) {
            const int xg = c & 7, j = c >> 3;
            if (part == 2) {
                if (c >= 192 || i >= 1) return false;
                fill(u, xg * 24 + j, 1, 0);
            } else if (part == 0) {
                if (c < 192) { if (i >= 3) return false; if (i == 0) fill(u, xg * 24 + j, 0, 0); else fill(u, xg * 24 + j, i - 1, 1); }
                else { if (i >= 3) return false; fill(u, xg * 24 + (j - 24) * 3 + i, 2, 0); }
            } else {
                if (c >= 192 || i >= 1) return false;
                fill(u, xg * 24 + j, 2, 1);
            }
            return true;
        }
        if (part != 0) return false;
        const int tile = c + (i / 6) * G, sI = i % 6;
        if (tile >= 192) return false;
        fill(u, tile, sI >> 1, sI & 1);
        return true;
    }
};
struct EpiMg {
    unsigned char* ws; const float* bias;
    DEV bf16_t* gslot(int n, int row) const {
        bf16_t* Pb = (bf16_t*)(ws + OFF_P);
        return n == 0 ? Pb + (size_t)row * PW + C_LX : n == 1 ? Pb + (size_t)row * PW + C_AG : (bf16_t*)(ws + OFF_G2) + (size_t)row * 1024;
    }
    DEV void operator()(const f32x4 (&acc)[2][2][4][2], const g8::Unit& u, int wr, int wc, int fr, int fq) const {
        using namespace g8;
        const int n = u.kind >> 1; const bool zpass = u.kind & 1;
        const int colb = u.pn * 256 + wc * 32 + fq * 4;
        if (!zpass) {
            float4 bz[2][2];
#pragma unroll
            for (int bj = 0; bj < 2; ++bj)
#pragma unroll
                for (int nn = 0; nn < 2; ++nn) bz[bj][nn] = *(const float4*)(bias + n * 1024 + colb + bj * 128 + nn * 16);
#pragma unroll
            for (int ai = 0; ai < 2; ++ai)
#pragma unroll
                for (int m = 0; m < 4; ++m) {
                    bf16_t* gs = gslot(n, u.pm * 256 + ai * 128 + wr * 64 + m * 16 + fr);
#pragma unroll
                    for (int bj = 0; bj < 2; ++bj)
#pragma unroll
                        for (int nn = 0; nn < 2; ++nn) {
                            f32x4 v = acc[ai][bj][m][nn];
                            v[0] = sigmf(v[0] + bz[bj][nn].x); v[1] = sigmf(v[1] + bz[bj][nn].y); v[2] = sigmf(v[2] + bz[bj][nn].z); v[3] = sigmf(v[3] + bz[bj][nn].w);
                            *(uint2*)(gs + colb + bj * 128 + nn * 16) = pk4(v);
                        }
                }
            return;
        }
#pragma unroll
        for (int ai = 0; ai < 2; ++ai) {
            uint2 gq[4][2][2], tq[4][2][2];
#pragma unroll
            for (int m = 0; m < 4; ++m) {
                const int row = u.pm * 256 + ai * 128 + wr * 64 + m * 16 + fr;
                const bf16_t* gs = gslot(n, row);
                const bf16_t* Tr = (const bf16_t*)(ws + OFF_P) + (size_t)row * PW;
#pragma unroll
                for (int bj = 0; bj < 2; ++bj)
#pragma unroll
                    for (int nn = 0; nn < 2; ++nn) {
                        gq[m][bj][nn] = *(const uint2*)(gs + colb + bj * 128 + nn * 16);
                        if (n > 0) tq[m][bj][nn] = *(const uint2*)(Tr + colb + bj * 128 + nn * 16);
                    }
            }
#pragma unroll
            for (int m = 0; m < 4; ++m) {
                const int row = u.pm * 256 + ai * 128 + wr * 64 + m * 16 + fr;
                bf16_t* Tr = (bf16_t*)(ws + OFF_P) + (size_t)row * PW;
#pragma unroll
                for (int bj = 0; bj < 2; ++bj)
#pragma unroll
                    for (int nn = 0; nn < 2; ++nn) {
                        f32x4 v = acc[ai][bj][m][nn];
                        const uint2 gv = gq[m][bj][nn];
                        v[0] *= lo16(gv.x); v[1] *= hi16(gv.x); v[2] *= lo16(gv.y); v[3] *= hi16(gv.y);
                        if (n > 0) { const uint2 tv = tq[m][bj][nn]; v[0] += lo16(tv.x); v[1] += hi16(tv.x); v[2] += lo16(tv.y); v[3] += hi16(tv.y); }
                        *(uint2*)(Tr + colb + bj * 128 + nn * 16) = pk4(v);
                    }
            }
        }
    }
};
DEV void phase8_merge(CParams& p, int l, int part, LAS unsigned char* lds) {
    SchedMg S{(const char*)(p.ws + OFF_H), (const char*)(p.ws + OFF_P), (const char*)(p.ws + OFF_WMG), (const char*)(p.ws + OFF_WBR), GDIM(), BIDX(), part};
    EpiMg E{p.ws, p.b_merge + (size_t)l * 3072};
    g8::gemm_phase(lds, 2048u, 16, S, E);
}

struct SchedOut {
    const char* A; const char* B; int G, c;
    DEV bool next(int i, g8::Unit& u) const {
        int tile = i * G + c;
        if (G == 256) { if (i > 0 || c >= 192) return false; tile = (c & 7) * 24 + (c >> 3); }
        if (tile >= 192) return false;
        u.pm = tile >> 2; u.pn = tile & 3; u.kind = 0; u.lda = (unsigned)PW * 2u;
        u.a = A + (size_t)u.pm * 256 * PW * 2; u.b = B + (size_t)u.pn * 256 * 2048;
        return true;
    }
};
DEV void row_exchange(unsigned char* ws, int slot, int pn, float* part, float* rs) {
    const int tid = TIDX();
    __syncthreads();
    unsigned* XPd = (unsigned*)(ws + OFF_XP) + (size_t)slot * 4 * 256;
    unsigned* cnt = (unsigned*)(ws + OFF_XC) + slot;
    if (tid < 256) {
        const float v = (part[tid] + part[256 + tid]) + (part[512 + tid] + part[768 + tid]);
        __hip_atomic_store(XPd + pn * 256 + tid, __float_as_uint(v), __ATOMIC_RELAXED, __HIP_MEMORY_SCOPE_AGENT);
    }
    asm volatile("s_waitcnt vmcnt(0)" ::: "memory");
    __syncthreads();
    if (tid == 0) {
        (void)__hip_atomic_fetch_add(cnt, 1u, __ATOMIC_RELAXED, __HIP_MEMORY_SCOPE_AGENT);
        unsigned sp = 0;
        while (__hip_atomic_load(cnt, __ATOMIC_RELAXED, __HIP_MEMORY_SCOPE_AGENT) < 4u) { __builtin_amdgcn_s_sleep(1); if (++sp > (1u << 20)) break; }
        __builtin_amdgcn_fence(__ATOMIC_ACQUIRE, "agent");
        asm volatile("s_waitcnt vmcnt(0)" ::: "memory");
    }
    __syncthreads();
    if (tid < 256) {
        float t = 0.f;
#pragma unroll
        for (int q = 0; q < 4; ++q) t += __uint_as_float(__hip_atomic_load(XPd + q * 256 + tid, __ATOMIC_RELAXED, __HIP_MEMORY_SCOPE_AGENT));
        rs[tid] = rsqrtf(t * (1.f / D) + EPS);
    }
    __syncthreads();
}
struct EpiOutPost {
    CParams* kp; int l; unsigned char* ldsx;
    DEV void row_ssq(const f32x4 (&v)[2][2][4][2], float* part, int wr, int wc, int fr, int fq) const {
#pragma unroll
        for (int ai = 0; ai < 2; ++ai)
#pragma unroll
            for (int m = 0; m < 4; ++m) {
                float ss = 0.f;
#pragma unroll
                for (int bj = 0; bj < 2; ++bj)
#pragma unroll
                    for (int n = 0; n < 2; ++n) { const f32x4 x = v[ai][bj][m][n]; ss += (x[0] * x[0] + x[1] * x[1]) + (x[2] * x[2] + x[3] * x[3]); }
                ss = xrow16_sum(ss);
                if (fq == 0) part[wc * 256 + ai * 128 + wr * 64 + m * 16 + fr] = ss;
            }
    }
    DEV void operator()(f32x4 (&acc)[2][2][4][2], const g8::Unit& u, int wr, int wc, int fr, int fq) const {
        CParams& p = *kp;
        unsigned char* ws = p.ws;
        float* part = (float*)ldsx; float* rs = part + 1024;
        const int colb = u.pn * 256 + wc * 32 + fq * 4;
        const int crow = u.pm < 16 ? 0 : 1 + ((u.pm - 16) >> 3);
        const float* mod = ws_mod(p) + (size_t)(l * 5 + crow) * 3072;
        row_ssq(acc, part, wr, wc, fr, fq);
        row_exchange(ws, (l * 2 + 0) * 48 + u.pm, u.pn, part, rs);
        {
            float4 gt[2][2], gp[2][2];
#pragma unroll
            for (int bj = 0; bj < 2; ++bj)
#pragma unroll
                for (int n = 0; n < 2; ++n) {
                    gt[bj][n] = *(const float4*)(mod + 2048 + colb + bj * 128 + n * 16);
                    gp[bj][n] = *(const float4*)(p.norm_post + l * D + colb + bj * 128 + n * 16);
                    gt[bj][n].x *= gp[bj][n].x; gt[bj][n].y *= gp[bj][n].y; gt[bj][n].z *= gp[bj][n].z; gt[bj][n].w *= gp[bj][n].w;
                }
#pragma unroll
            for (int ai = 0; ai < 2; ++ai)
#pragma unroll
                for (int mh = 0; mh < 2; ++mh) {
                    float4 xv[2][2][2];
#pragma unroll
                    for (int m2 = 0; m2 < 2; ++m2) {
                        const int row = u.pm * 256 + ai * 128 + wr * 64 + (mh * 2 + m2) * 16 + fr;
                        const float* xr = x_row(p, l, row);
#pragma unroll
                        for (int bj = 0; bj < 2; ++bj)
#pragma unroll
                            for (int n = 0; n < 2; ++n) xv[m2][bj][n] = *(const float4*)(xr + colb + bj * 128 + n * 16);
                    }
#pragma unroll
                    for (int m2 = 0; m2 < 2; ++m2) {
                        const int m = mh * 2 + m2;
                        const int rl = ai * 128 + wr * 64 + m * 16 + fr;
                        const float rstd = rs[rl];
                        float* yr = p.out + (size_t)(u.pm * 256 + rl) * D;
#pragma unroll
                        for (int bj = 0; bj < 2; ++bj)
#pragma unroll
                            for (int n = 0; n < 2; ++n) {
                                f32x4 y;
                                y[0] = xv[m2][bj][n].x + gt[bj][n].x * (acc[ai][bj][m][n][0] * rstd);
                                y[1] = xv[m2][bj][n].y + gt[bj][n].y * (acc[ai][bj][m][n][1] * rstd);
                                y[2] = xv[m2][bj][n].z + gt[bj][n].z * (acc[ai][bj][m][n][2] * rstd);
                                y[3] = xv[m2][bj][n].w + gt[bj][n].w * (acc[ai][bj][m][n][3] * rstd);
                                acc[ai][bj][m][n] = y;
                                *(float4*)(yr + colb + bj * 128 + n * 16) = make_float4(y[0], y[1], y[2], y[3]);
                            }
                    }
                }
        }
        if (l != 0) return;
        row_ssq(acc, part, wr, wc, fr, fq);
        row_exchange(ws, (l * 2 + 1) * 48 + u.pm, u.pn, part, rs);
        {
            const float* mod1 = ws_mod(p) + (size_t)(1 * 5 + crow) * 3072;
            float4 a_[2][2], b_[2][2];
#pragma unroll
            for (int bj = 0; bj < 2; ++bj)
#pragma unroll
                for (int n = 0; n < 2; ++n) {
                    const int cc = colb + bj * 128 + n * 16;
                    const float4 g = *(const float4*)(p.norm_pre + 1 * D + cc), sc = *(const float4*)(mod1 + 1024 + cc);
                    a_[bj][n] = make_float4(g.x * (1.f + sc.x), g.y * (1.f + sc.y), g.z * (1.f + sc.z), g.w * (1.f + sc.w));
                    b_[bj][n] = *(const float4*)(mod1 + cc);
                }
#pragma unroll
            for (int ai = 0; ai < 2; ++ai)
#pragma unroll
                for (int m = 0; m < 4; ++m) {
                    const int rl = ai * 128 + wr * 64 + m * 16 + fr;
                    const float rstd = rs[rl];
                    bf16_t* hr = ws_bf(p, OFF_H) + (size_t)(u.pm * 256 + rl) * D;
#pragma unroll
                    for (int bj = 0; bj < 2; ++bj)
#pragma unroll
                        for (int n = 0; n < 2; ++n) {
                            const f32x4 y = acc[ai][bj][m][n];
                            uint2 o;
                            o.x = pk2(y[0] * rstd * a_[bj][n].x + b_[bj][n].x, y[1] * rstd * a_[bj][n].y + b_[bj][n].y);
                            o.y = pk2(y[2] * rstd * a_[bj][n].z + b_[bj][n].z, y[3] * rstd * a_[bj][n].w + b_[bj][n].w);
                            *(uint2*)(hr + colb + bj * 128 + n * 16) = o;
                        }
                }
        }
    }
};
DEV void phase8_out(CParams& p, int l, LAS unsigned char* lds) {
    SchedOut S{(const char*)(p.ws + OFF_P), (const char*)(p.ws + OFF_WOUT), GDIM(), BIDX()};
    EpiOutPost E{&p, l, (unsigned char*)lds + LDS_XOFF};
    g8::gemm_phase(lds, 2048u, 16, S, E);
}

DEV uint4 pack8(const float4 a, const float4 b) {
    uint4 r;
    r.x = pk2(a.x, a.y); r.y = pk2(a.z, a.w);
    r.z = pk2(b.x, b.y); r.w = pk2(b.z, b.w);
    return r;
}
template <int NU>
DEV void attn_item(CParams& p, int l, bool lat, int b, int hk, int qs0, unsigned char* lds) {
    bf16_t* Pb = ws_bf(p, OFF_P);
    const int tid = TIDX(), lane = tid & 63, w = tid >> 6, g = lane >> 4, lc = lane & 15;
    const int row0 = lat ? NCTX + b * 2048 : b * 256, L = lat ? 2048 : 256;
    const int hq = hk * 4 + (w & 3);
    const int qw = qs0 + (w >> 2) * 32;
    bf16x8 qfr[NU][2][2];
    f32x4 O[NU][4][2];
    float mrun[NU][2], lrun[NU][2];
    const float sink = p.att_sink[l * 16 + hq] * 1.4426950408889634f;
#pragma unroll
    for (int u = 0; u < NU; ++u)
#pragma unroll
        for (int qf = 0; qf < 2; ++qf) {
#pragma unroll
            for (int ks = 0; ks < 2; ++ks)
                qfr[u][qf][ks] = *(const bf16x8*)(Pb + (size_t)(row0 + qw + u * 64 + qf * 16 + lc) * PW + C_AQ + hq * 64 + ks * 32 + g * 8);
            mrun[u][qf] = sink; lrun[u][qf] = g == 0 ? 1.f : 0.f;
#pragma unroll
            for (int df = 0; df < 4; ++df) O[u][df][qf] = (f32x4){0.f, 0.f, 0.f, 0.f};
        }
    const int nband = lat ? 4 + NU : 4;
    const int ntile = lat ? nband + 4 : 4;
    const int qsb = qs0 >> 6;
    const int t_lo = lat ? (qsb < 2 ? 2 - qsb : 0) : 0;
    const int t_hi = lat ? ((33 - qsb) < (nband - 1) ? (33 - qsb) : (nband - 1)) : 3;
    const int fsw = (lane >> 1) & 7;
    const int srow = tid >> 3, sc8 = tid & 7;
    float4 R[4];
    auto tile_load = [&](int t) __attribute__((always_inline)) {
        if (t < nband) {
            const int kp0 = lat ? qs0 + 64 * (t - 2) : 64 * t;
            const uint4 kv = *(const uint4*)(Pb + (size_t)(row0 + kp0 + srow) * PW + C_AK + hk * 64 + sc8 * 8);
            const uint4 vv = *(const uint4*)(Pb + (size_t)(row0 + kp0 + srow) * PW + C_AV + hk * 64 + sc8 * 8);
            R[0] = make_float4(__uint_as_float(kv.x), __uint_as_float(kv.y), __uint_as_float(kv.z), __uint_as_float(kv.w));
            R[2] = make_float4(__uint_as_float(vv.x), __uint_as_float(vv.y), __uint_as_float(vv.z), __uint_as_float(vv.w));
        } else {
            const int j0 = (t - nband) * 64;
            const float* ck = p.cache_k + (size_t)((b * 2 + l) * 256 + j0) * 256 + hk * 64;
            const float* cv = p.cache_v + (size_t)((b * 2 + l) * 256 + j0) * 256 + hk * 64;
            R[0] = *(const float4*)(ck + (size_t)srow * 256 + sc8 * 8); R[1] = *(const float4*)(ck + (size_t)srow * 256 + sc8 * 8 + 4);
            R[2] = *(const float4*)(cv + (size_t)srow * 256 + sc8 * 8); R[3] = *(const float4*)(cv + (size_t)srow * 256 + sc8 * 8 + 4);
        }
    };
    auto tile_store = [&](bool cache_t, unsigned char* KsB, unsigned char* VtB) __attribute__((always_inline)) {
        uint4 kq, vq;
        if (!cache_t) {
            kq = make_uint4(__float_as_uint(R[0].x), __float_as_uint(R[0].y), __float_as_uint(R[0].z), __float_as_uint(R[0].w));
            vq = make_uint4(__float_as_uint(R[2].x), __float_as_uint(R[2].y), __float_as_uint(R[2].z), __float_as_uint(R[2].w));
        } else { kq = pack8(R[0], R[1]); vq = pack8(R[2], R[3]); }
        *(uint4*)(KsB + srow * 128 + ((sc8 ^ ((srow >> 1) & 7)) << 4)) = kq;
        *(uint4*)(VtB + srow * 128 + ((sc8 ^ (((srow >> 1) & 3) << 1)) << 4)) = vq;
    };
    int t = t_lo;
    tile_load(t);
    __syncthreads();
    tile_store(t >= nband, lds, lds + 8192);
    int tn = (lat && t == t_hi) ? nband : t + 1;
    if (tn < ntile) tile_load(tn);
    int cur = 0;
    while (t < ntile) {
        const bool cache = t >= nband;
        const int kp0 = lat ? qs0 + 64 * (t - 2) : 64 * t;
        const unsigned char* Ks = lds + cur * 16384; const unsigned char* Vt = Ks + 8192;
        __syncthreads();
        int tnn = ntile;
        if (tn < ntile) {
            tile_store(tn >= nband, lds + (cur ^ 1) * 16384, lds + (cur ^ 1) * 16384 + 8192);
            tnn = (lat && tn == t_hi) ? nband : tn + 1;
            if (tnn < ntile) tile_load(tnn);
        }
#pragma unroll
        for (int u = 0; u < NU; ++u) {
            const int tu = t - u;
            if (lat && !cache && (tu < 0 || tu > 4)) continue;
            __builtin_amdgcn_s_setprio(1);
            f32x4 sc[4][2];
#pragma unroll
            for (int kf = 0; kf < 4; ++kf)
#pragma unroll
                for (int qf = 0; qf < 2; ++qf) sc[kf][qf] = (f32x4){0.f, 0.f, 0.f, 0.f};
#pragma unroll
            for (int ks = 0; ks < 2; ++ks) {
                bf16x8 ak[4];
#pragma unroll
                for (int kf = 0; kf < 4; ++kf) ak[kf] = *(const bf16x8*)(Ks + (kf * 16 + lc) * 128 + (((ks * 4 + g) ^ fsw) << 4));
#pragma unroll
                for (int kf = 0; kf < 4; ++kf)
#pragma unroll
                    for (int qf = 0; qf < 2; ++qf)
                        sc[kf][qf] = __builtin_amdgcn_mfma_f32_16x16x32_bf16(ak[kf], qfr[u][qf][ks], sc[kf][qf], 0, 0, 0);
            }
            __builtin_amdgcn_s_setprio(0);
            if (lat && !cache && (tu == 0 || tu == 4)) {
#pragma unroll
                for (int kf = 0; kf < 4; ++kf)
#pragma unroll
                    for (int qf = 0; qf < 2; ++qf)
#pragma unroll
                        for (int r = 0; r < 4; ++r) {
                            const int kpos = kp0 + kf * 16 + g * 4 + r, qpos = qw + u * 64 + qf * 16 + lc;
                            const int dd = qpos - kpos;
                            if (dd > 128 || dd < -128) sc[kf][qf][r] = -INFINITY;
                        }
            }
            bf16x8 pb[2][2];
#pragma unroll
            for (int qf = 0; qf < 2; ++qf) {
                float mx = -INFINITY;
#pragma unroll
                for (int kf = 0; kf < 4; ++kf)
#pragma unroll
                    for (int r = 0; r < 4; ++r) mx = fmaxf(mx, sc[kf][qf][r]);
                mx = xrow16_max(mx);
                const float mnew = fmaxf(mrun[u][qf], mx);
                const float alpha = __builtin_amdgcn_exp2f(mrun[u][qf] - mnew);
                mrun[u][qf] = mnew;
                float ps = 0.f;
#pragma unroll
                for (int kf = 0; kf < 4; ++kf)
#pragma unroll
                    for (int r = 0; r < 4; ++r) { const float e = __builtin_amdgcn_exp2f(sc[kf][qf][r] - mnew); sc[kf][qf][r] = e; ps += e; }
                lrun[u][qf] = lrun[u][qf] * alpha + ps;
#pragma unroll
                for (int df = 0; df < 4; ++df) O[u][df][qf] *= alpha;
#pragma unroll
                for (int s2 = 0; s2 < 2; ++s2) {
                    bf16x8 v;
#pragma unroll
                    for (int r = 0; r < 4; ++r) { v[r] = (short)f2bf(sc[2 * s2][qf][r]); v[4 + r] = (short)f2bf(sc[2 * s2 + 1][qf][r]); }
                    pb[s2][qf] = v;
                }
            }
            __builtin_amdgcn_s_setprio(1);
#pragma unroll
            for (int s2 = 0; s2 < 2; ++s2)
#pragma unroll
                for (int df = 0; df < 4; ++df) {
                    const int vrow = 32 * s2 + 4 * g + (lc >> 2);
                    const unsigned char* vr = Vt + vrow * 128 + (((2 * df + ((lc >> 1) & 1)) ^ (((vrow >> 1) & 3) << 1)) << 4) + 8 * (lc & 1);
                    const v4i16_t lo = __builtin_amdgcn_ds_read_tr16_b64_v4i16((LAS v4i16_t*)vr);
                    const v4i16_t hi = __builtin_amdgcn_ds_read_tr16_b64_v4i16((LAS v4i16_t*)(vr + 2048));
                    union { v4i16_t h[2]; bf16x8 v; } av; av.h[0] = lo; av.h[1] = hi;
#pragma unroll
                    for (int qf = 0; qf < 2; ++qf)
                        O[u][df][qf] = __builtin_amdgcn_mfma_f32_16x16x32_bf16(av.v, pb[s2][qf], O[u][df][qf], 0, 0, 0);
                }
            __builtin_amdgcn_s_setprio(0);
        }
        t = tn; tn = tnn; cur ^= 1;
    }
#pragma unroll
    for (int u = 0; u < NU; ++u)
#pragma unroll
        for (int qf = 0; qf < 2; ++qf) {
            const float lt = xrow16_sum(lrun[u][qf]);
            const float inv = 1.f / lt;
            const size_t m = (size_t)(row0 + qw + u * 64 + qf * 16 + lc);
#pragma unroll
            for (int df = 0; df < 4; ++df) {
                const int col = hq * 64 + df * 16 + g * 4;
                const uint2 gt = *(const uint2*)(Pb + m * PW + C_AG + col);
                uint2 o;
                o.x = pk2(O[u][df][qf][0] * inv * __uint_as_float(gt.x << 16), O[u][df][qf][1] * inv * __uint_as_float(gt.x & 0xffff0000u));
                o.y = pk2(O[u][df][qf][2] * inv * __uint_as_float(gt.y << 16), O[u][df][qf][3] * inv * __uint_as_float(gt.y & 0xffff0000u));
                *(uint2*)(Pb + m * PW + C_AQ + col) = o;
            }
        }
}
DEV void phase_attn(CParams& p, int l, unsigned char* lds) {
    if (GDIM() == 256) {
        const int xg = BIDX() & 7, j = BIDX() >> 3;
        { const int grp = xg * 2 + (j >> 4); attn_item<2>(p, l, true, grp >> 2, grp & 3, (j & 15) * 128, lds); }
        { const int grp = xg * 8 + (j >> 2); attn_item<1>(p, l, false, grp >> 2, grp & 3, (j & 3) * 64, lds); }
        return;
    }
    for (int item = BIDX(); item < 768; item += GDIM()) {
        if (item < 512) attn_item<1>(p, l, true, item >> 7, (item >> 5) & 3, (item & 31) * 64, lds);
        else { const int it = item - 512; attn_item<1>(p, l, false, it >> 4, (it >> 2) & 3, (it & 3) * 64, lds); }
    }
}

constexpr size_t OFF_RS = OFF_W1T;
static_assert(OFF_RS + (size_t)4 * 4 * 2 * 8 * 32768 * 2 <= OFF_LRUC, "RS overlap");
DEV float ret_logg(CParams& p, int l, int dir, int h) { return -softplusf(-p.ret_decay[(l * 2 + dir) * 4 + h]); }

DEV void ret_kv_tile(CParams& p, int l, int item, unsigned char* lds) {
    bf16_t* Pb = ws_bf(p, OFF_P); const bf16_t* RVT = ws_bf(p, OFF_RVT);
    const int tid = TIDX(), lane = tid & 63, w = __builtin_amdgcn_readfirstlane(tid >> 6), g = lane >> 4, lc = lane & 15;
    const bool lat = item < 128;
    int b, h, c;
    if (lat) { c = item & 7; h = (item >> 3) & 3; b = item >> 5; }
    else { const int it = item - 128; h = it & 3; b = it >> 2; c = 0; }
    const int row0 = lat ? NCTX + b * 2048 + c * 256 : b * 256;
    const bool doF = !lat || c < 7, doB = !lat || c > 0;
    const float lgf = ret_logg(p, l, 0, h), lgb = ret_logg(p, l, 1, h);
    const float rf = __expf(-lgf), rb = __expf(lgb);
    const int dvbase = w * 32;
    auto dma_k = [&](int st) __attribute__((always_inline)) {
        LAS unsigned char* base = (LAS unsigned char*)lds + (st & 1) * 16384;
#pragma unroll
        for (int i = 0; i < 2; ++i) {
            const int q = w * 2 + i, row = 4 * q + (lane >> 4), lch = (lane & 15) ^ (((row & 3) << 2) | ((row >> 2) & 3));
            __builtin_amdgcn_global_load_lds((const unsigned*)(Pb + (size_t)(row0 + st * 64 + row) * PW + C_RK + h * 128 + lch * 8), (LAS unsigned*)(base + q * 1024), 16, 0, 0);
        }
    };
    __syncthreads();
    dma_k(0);
    f32x4 accF[2][8], accB[2][8];
#pragma unroll
    for (int i = 0; i < 2; ++i)
#pragma unroll
        for (int j = 0; j < 8; ++j) { accF[i][j] = (f32x4){0.f, 0.f, 0.f, 0.f}; accB[i][j] = (f32x4){0.f, 0.f, 0.f, 0.f}; }
    const int tq = lc >> 2, tp = lc & 3;
#pragma unroll 1
    for (int st = 0; st < 4; ++st) {
        bf16x8 av[2][2];
#pragma unroll
        for (int ks = 0; ks < 2; ++ks)
#pragma unroll
            for (int mf = 0; mf < 2; ++mf)
                av[ks][mf] = *(const bf16x8*)(RVT + (size_t)(h * 256 + dvbase + mf * 16 + lc) * M + row0 + st * 64 + ks * 32 + g * 8);
        bf16x8 avF[2][2], avB[2][2];
#pragma unroll
        for (int ks = 0; ks < 2; ++ks) {
            const int ti0 = st * 64 + ks * 32 + g * 8;
            float wf = __expf(lgf * (float)(255 - ti0)), wb = __expf(lgb * (float)ti0);
#pragma unroll
            for (int j = 0; j < 8; ++j) {
#pragma unroll
                for (int mf = 0; mf < 2; ++mf) {
                    const float v = bf2f((bf16_t)av[ks][mf][j]);
                    avF[ks][mf][j] = (short)f2bf(v * wf); avB[ks][mf][j] = (short)f2bf(v * wb);
                }
                wf *= rf; wb *= rb;
            }
        }
        asm volatile("s_waitcnt vmcnt(0)" ::: "memory");
        __syncthreads();
        if (st + 1 < 4) dma_k(st + 1);
        const unsigned char* Kt = lds + (st & 1) * 16384;
#pragma unroll
        for (int ks = 0; ks < 2; ++ks)
#pragma unroll
            for (int nf = 0; nf < 8; ++nf) {
                const int r0 = 32 * ks + 8 * g + tq, r1 = r0 + 4;
                const unsigned char* a0 = Kt + r0 * 256 + (((2 * nf + (tp >> 1)) ^ (((r0 & 3) << 2) | ((r0 >> 2) & 3))) << 4) + 8 * (tp & 1);
                const unsigned char* a1 = Kt + r1 * 256 + (((2 * nf + (tp >> 1)) ^ (((r1 & 3) << 2) | ((r1 >> 2) & 3))) << 4) + 8 * (tp & 1);
                union { v4i16_t hlf[2]; bf16x8 v; } bk;
                bk.hlf[0] = __builtin_amdgcn_ds_read_tr16_b64_v4i16((LAS v4i16_t*)a0);
                bk.hlf[1] = __builtin_amdgcn_ds_read_tr16_b64_v4i16((LAS v4i16_t*)a1);
#pragma unroll
                for (int mf = 0; mf < 2; ++mf) {
                    accF[mf][nf] = __builtin_amdgcn_mfma_f32_16x16x32_bf16(avF[ks][mf], bk.v, accF[mf][nf], 0, 0, 0);
                    accB[mf][nf] = __builtin_amdgcn_mfma_f32_16x16x32_bf16(avB[ks][mf], bk.v, accB[mf][nf], 0, 0, 0);
                }
            }
    }
    if (lat) {
        bf16_t* dF = ws_bf(p, OFF_RS) + ((size_t)((b * 4 + h) * 2 + 0) * 8 + (c + 1)) * 32768;
        bf16_t* dB = ws_bf(p, OFF_RS) + ((size_t)((b * 4 + h) * 2 + 1) * 8 + (c - 1)) * 32768;
#pragma unroll
        for (int mf = 0; mf < 2; ++mf)
#pragma unroll
            for (int nf = 0; nf < 8; ++nf)
#pragma unroll
                for (int r = 0; r < 4; ++r) {
                    const size_t o = (size_t)(dvbase + mf * 16 + g * 4 + r) * 128 + nf * 16 + lc;
                    if (doF) dF[o] = f2bf(accF[mf][nf][r]);
                    if (doB) dB[o] = f2bf(accB[mf][nf][r]);
                }
    } else {
        float* dF = p.out + O_NRET + ((((size_t)b * 2 + l) * 2 + 0) * 4 + h) * 128 * 256;
        float* dB = p.out + O_NRET + ((((size_t)b * 2 + l) * 2 + 1) * 4 + h) * 128 * 256;
#pragma unroll
        for (int mf = 0; mf < 2; ++mf)
#pragma unroll
            for (int nf = 0; nf < 8; ++nf) {
                const size_t o = (size_t)(nf * 16 + lc) * 256 + dvbase + mf * 16 + g * 4;
                *(float4*)(dF + o) = make_float4(accF[mf][nf][0], accF[mf][nf][1], accF[mf][nf][2], accF[mf][nf][3]);
                *(float4*)(dB + o) = make_float4(accB[mf][nf][0], accB[mf][nf][1], accB[mf][nf][2], accB[mf][nf][3]);
            }
    }
}
DEV void phase_ret_kv(CParams& p, int l, unsigned char* lds) {
    for (int item = BIDX(); item < 192; item += GDIM()) ret_kv_tile(p, l, item, lds);
}

DEV void phase_ret_scan(CParams& p, int l, int vb, int nvb) {
    bf16_t* RS = ws_bf(p, OFF_RS);
    const int gt = vb * 512 + TIDX(), gs = nvb * 512;
    for (int idx = gt; idx < 4 * 4 * 2 * 4096; idx += gs) {
        const int dk0 = (idx & 15) * 8, dv = (idx >> 4) & 255, dir = (idx >> 12) & 1, h = (idx >> 13) & 3, b = idx >> 15;
        const float g256 = __expf(ret_logg(p, l, dir, h) * 256.f);
        const float* s0 = p.state_ret + (((((size_t)b * 2 + l) * 2 + dir) * 4 + h) * 128 + dk0) * 256 + dv;
        float st[8];
#pragma unroll
        for (int e = 0; e < 8; ++e) st[e] = s0[(size_t)e * 256];
        bf16_t* base = RS + (size_t)((b * 4 + h) * 2 + dir) * 8 * 32768 + dv * 128 + dk0;
        uint4 kv[7];
#pragma unroll
        for (int j = 0; j < 7; ++j) kv[j] = *(const uint4*)(base + (size_t)(dir == 0 ? j + 1 : 6 - j) * 32768);
        *(uint4*)(base + (size_t)(dir == 0 ? 0 : 7) * 32768) = make_uint4(pk2(st[0], st[1]), pk2(st[2], st[3]), pk2(st[4], st[5]), pk2(st[6], st[7]));
#pragma unroll
        for (int j = 0; j < 7; ++j) {
            st[0] = g256 * st[0] + g8::lo16(kv[j].x); st[1] = g256 * st[1] + g8::hi16(kv[j].x);
            st[2] = g256 * st[2] + g8::lo16(kv[j].y); st[3] = g256 * st[3] + g8::hi16(kv[j].y);
            st[4] = g256 * st[4] + g8::lo16(kv[j].z); st[5] = g256 * st[5] + g8::hi16(kv[j].z);
            st[6] = g256 * st[6] + g8::lo16(kv[j].w); st[7] = g256 * st[7] + g8::hi16(kv[j].w);
            *(uint4*)(base + (size_t)(dir == 0 ? j + 1 : 6 - j) * 32768) = make_uint4(pk2(st[0], st[1]), pk2(st[2], st[3]), pk2(st[4], st[5]), pk2(st[6], st[7]));
        }
    }
}

DEV void ret_out_tile(CParams& p, int l, int item, unsigned char* lds) {
    bf16_t* Pb = ws_bf(p, OFF_P); const bf16_t* RVT = ws_bf(p, OFF_RVT);
    const int tid = TIDX(), lane = tid & 63, w = __builtin_amdgcn_readfirstlane(tid >> 6), g = lane >> 4, lc = lane & 15;
    const bool lat = item < 256;
    int b, h, qb, rowc, qi0, c;
    if (lat) { qb = item & 15; h = (item >> 4) & 3; b = item >> 6; c = qb >> 1; rowc = NCTX + b * 2048 + c * 256; qi0 = (qb & 1) * 128; }
    else { const int it = item - 256; qb = it & 1; h = (it >> 1) & 3; b = it >> 3; c = 0; rowc = b * 256; qi0 = qb * 128; }
    const int qi = qi0 + w * 16 + lc;
    const size_t rowq = (size_t)(rowc + qi);
    const float lgf = ret_logg(p, l, 0, h), lgb = ret_logg(p, l, 1, h);
    const int nstep = lat ? 8 : 4;
    auto dma_step = [&](int sI) __attribute__((always_inline)) {
        LAS unsigned char* base = (LAS unsigned char*)lds + (sI & 1) * 49152;
        if (sI < 4) {
#pragma unroll
            for (int i = 0; i < 2; ++i) {
                const int q = w * 2 + i, row = 4 * q + (lane >> 4), lch = (lane & 15) ^ (row & 15);
                __builtin_amdgcn_global_load_lds((const unsigned*)(Pb + (size_t)(rowc + sI * 64 + row) * PW + C_RK + h * 128 + lch * 8), (LAS unsigned*)(base + q * 1024), 16, 0, 0);
            }
#pragma unroll
            for (int i = 0; i < 4; ++i) {
                const int q = w * 4 + i, row = 8 * q + (lane >> 3), lch = (lane & 7) ^ ((row >> 1) & 7);
                __builtin_amdgcn_global_load_lds((const unsigned*)(RVT + (size_t)(h * 256 + row) * M + rowc + sI * 64 + lch * 8), (LAS unsigned*)(base + 16384 + q * 1024), 16, 0, 0);
            }
        } else {
            const int dir = (sI - 4) >> 1, kh = (sI - 4) & 1;
            const bf16_t* Sg = ws_bf(p, OFF_RS) + ((size_t)((b * 4 + h) * 2 + dir) * 8 + c) * 32768;
#pragma unroll
            for (int i = 0; i < 4; ++i) {
                const int q = w * 4 + i, row = 8 * q + (lane >> 3), lch = (lane & 7) ^ ((row >> 1) & 7);
                __builtin_amdgcn_global_load_lds((const unsigned*)(Sg + (size_t)row * 128 + kh * 64 + lch * 8), (LAS unsigned*)(base + 16384 + q * 1024), 16, 0, 0);
            }
        }
    };
    dma_step(0);
    f32x4 acc[16];
#pragma unroll
    for (int df = 0; df < 16; ++df) acc[df] = (f32x4){0.f, 0.f, 0.f, 0.f};
    const int vsw = (lc >> 1) & 7;
    unsigned char* qsave = lds + 98304 + tid * 64;
    {
        bf16x8 qfr[4];
#pragma unroll
        for (int ks = 0; ks < 4; ++ks) { qfr[ks] = *(const bf16x8*)(Pb + rowq * PW + C_RQ + h * 128 + ks * 32 + g * 8); *(bf16x8*)(qsave + ks * 16) = qfr[ks]; }
#pragma unroll 1
        for (int sI = 0; sI < 4; ++sI) {
            asm volatile("s_waitcnt vmcnt(0)" ::: "memory");
            __syncthreads();
            if (sI + 1 < nstep) dma_step(sI + 1);
            const unsigned char* Ks = lds + (sI & 1) * 49152;
            const unsigned char* Vt = Ks + 16384;
            f32x4 sc[4];
#pragma unroll
            for (int kf = 0; kf < 4; ++kf) sc[kf] = (f32x4){0.f, 0.f, 0.f, 0.f};
#pragma unroll
            for (int kb = 0; kb < 2; ++kb) {
                bf16x8 ak[2][4];
#pragma unroll
                for (int k2 = 0; k2 < 2; ++k2)
#pragma unroll
                    for (int kf = 0; kf < 4; ++kf) ak[k2][kf] = *(const bf16x8*)(Ks + (kf * 16 + lc) * 256 + ((((kb * 2 + k2) * 4 + g) ^ lc) << 4));
                __builtin_amdgcn_sched_barrier(0);
#pragma unroll
                for (int k2 = 0; k2 < 2; ++k2)
#pragma unroll
                    for (int kf = 0; kf < 4; ++kf) sc[kf] = __builtin_amdgcn_mfma_f32_16x16x32_bf16(ak[k2][kf], qfr[kb * 2 + k2], sc[kf], 0, 0, 0);
                __builtin_amdgcn_sched_barrier(0);
            }
            bf16x8 pb[2];
#pragma unroll
            for (int kf = 0; kf < 4; ++kf)
#pragma unroll
                for (int r = 0; r < 4; ++r) {
                    const int dd = qi - (sI * 64 + kf * 16 + g * 4 + r);
                    float wgt = 0.f;
                    if (dd >= 0) wgt += __expf(lgf * (float)dd);
                    if (dd <= 0) wgt += __expf(lgb * (float)(-dd));
                    pb[kf >> 1][(kf & 1) * 4 + r] = (short)f2bf(sc[kf][r] * wgt);
                }
#pragma unroll
            for (int s2 = 0; s2 < 2; ++s2)
#pragma unroll
                for (int db = 0; db < 2; ++db) {
                    uint2 lo[8], hi[8];
#pragma unroll
                    for (int j = 0; j < 8; ++j) {
                        const unsigned char* vr = Vt + ((db * 8 + j) * 16 + lc) * 128 + 8 * (g & 1);
                        lo[j] = *(const uint2*)(vr + (((4 * s2 + (g >> 1)) ^ vsw) << 4));
                        hi[j] = *(const uint2*)(vr + (((4 * s2 + 2 + (g >> 1)) ^ vsw) << 4));
                    }
                    __builtin_amdgcn_sched_barrier(0);
#pragma unroll
                    for (int j = 0; j < 8; ++j) {
                        union { uint4 u; bf16x8 v; } av; av.u = make_uint4(lo[j].x, lo[j].y, hi[j].x, hi[j].y);
                        acc[db * 8 + j] = __builtin_amdgcn_mfma_f32_16x16x32_bf16(av.v, pb[s2], acc[db * 8 + j], 0, 0, 0);
                    }
                    __builtin_amdgcn_sched_barrier(0);
                }
        }
    }
    if (lat) {
#pragma unroll 1
        for (int dir = 0; dir < 2; ++dir) {
            const float qs = dir == 0 ? __expf(lgf * (float)(qi + 1)) : __expf(lgb * (float)(256 - qi));
            bf16x8 qx[4];
#pragma unroll
            for (int ks = 0; ks < 4; ++ks) {
                const bf16x8 qv = *(const bf16x8*)(qsave + ks * 16);
#pragma unroll
                for (int e = 0; e < 8; ++e) qx[ks][e] = (short)f2bf(qs * bf2f((bf16_t)qv[e]));
            }
#pragma unroll
            for (int kh = 0; kh < 2; ++kh) {
                const int sI = 4 + dir * 2 + kh;
                asm volatile("s_waitcnt vmcnt(0)" ::: "memory");
                __syncthreads();
                if (sI + 1 < nstep) dma_step(sI + 1);
                const unsigned char* Vt = lds + (sI & 1) * 49152 + 16384;
#pragma unroll
                for (int db = 0; db < 4; ++db) {
                    bf16x8 as0[4], as1[4];
#pragma unroll
                    for (int j = 0; j < 4; ++j) {
                        as0[j] = *(const bf16x8*)(Vt + ((db * 4 + j) * 16 + lc) * 128 + (((0 + g) ^ vsw) << 4));
                        as1[j] = *(const bf16x8*)(Vt + ((db * 4 + j) * 16 + lc) * 128 + (((4 + g) ^ vsw) << 4));
                    }
                    __builtin_amdgcn_sched_barrier(0);
#pragma unroll
                    for (int j = 0; j < 4; ++j) {
                        acc[db * 4 + j] = __builtin_amdgcn_mfma_f32_16x16x32_bf16(as0[j], qx[kh * 2 + 0], acc[db * 4 + j], 0, 0, 0);
                        acc[db * 4 + j] = __builtin_amdgcn_mfma_f32_16x16x32_bf16(as1[j], qx[kh * 2 + 1], acc[db * 4 + j], 0, 0, 0);
                    }
                    __builtin_amdgcn_sched_barrier(0);
                }
            }
        }
    }
    float s1 = 0.f;
#pragma unroll
    for (int df = 0; df < 16; ++df) s1 += (acc[df][0] + acc[df][1]) + (acc[df][2] + acc[df][3]);
    s1 = xrow16_sum(s1);
    const float mu = s1 * (1.f / 256.f);
    float s2 = 0.f;
#pragma unroll
    for (int df = 0; df < 16; ++df)
#pragma unroll
        for (int r = 0; r < 4; ++r) { const float xc = acc[df][r] - mu; s2 += xc * xc; }
    s2 = xrow16_sum(s2);
    const float rstd = rsqrtf(s2 * (1.f / 256.f) + EPS);
#pragma unroll
    for (int df = 0; df < 16; ++df) {
        bf16_t* gp = Pb + rowq * PW + C_RG + h * 256 + df * 16 + g * 4;
        const uint2 gv = *(const uint2*)gp;
        uint2 o;
        o.x = pk2((acc[df][0] - mu) * rstd * __uint_as_float(gv.x << 16), (acc[df][1] - mu) * rstd * __uint_as_float(gv.x & 0xffff0000u));
        o.y = pk2((acc[df][2] - mu) * rstd * __uint_as_float(gv.y << 16), (acc[df][3] - mu) * rstd * __uint_as_float(gv.y & 0xffff0000u));
        *(uint2*)gp = o;
    }
}
DEV void phase_ret_out(CParams& p, int l, unsigned char* lds) {
    if (GDIM() == 256) {
        const int xg = BIDX() & 7, j = BIDX() >> 3;
        ret_out_tile(p, l, ((j >> 1) * 8 + xg) * 2 + (j & 1), lds);
        if (j < 16) ret_out_tile(p, l, 256 + ((j >> 1) * 8 + xg) * 2 + (j & 1), lds);
        return;
    }
    for (int item = BIDX(); item < 384; item += GDIM()) ret_out_tile(p, l, item, lds);
}

template <bool REV>
DEV void lru_scan16(const float (&a)[4][4], const float (&u)[4][4], float cin, int g, int lc, float (&h)[4][4], float& cout, float& Aprod) {
    float carry = cin, Ap = 1.f;
#pragma unroll
    for (int ii = 0; ii < 4; ++ii) {
        const int i = REV ? 3 - ii : ii;
        float hl[4], cp[4];
        {
            float hh = 0.f, cc = 1.f;
#pragma unroll
            for (int rr = 0; rr < 4; ++rr) { const int r = REV ? 3 - rr : rr; hh = a[i][r] * hh + u[i][r]; cc *= a[i][r]; hl[r] = hh; cp[r] = cc; }
        }
        const float As = REV ? cp[0] : cp[3], Hs = REV ? hl[0] : hl[3];
        float Ag[4], Hg[4];
        xrow16_gather(As, Ag); xrow16_gather(Hs, Hg);
        float cur = carry, mine = carry;
#pragma unroll
        for (int sI = 0; sI < 4; ++sI) {
            const int gg = REV ? 3 - sI : sI;
            mine = (g == gg) ? cur : mine;
            cur = Ag[gg] * cur + Hg[gg];
            Ap *= Ag[gg];
        }
        carry = cur;
#pragma unroll
        for (int r = 0; r < 4; ++r) h[i][r] = hl[r] + cp[r] * mine;
    }
    cout = carry; Aprod = Ap;
}

template <bool REV>
DEV void lru_dir(const unsigned char* xa, const bf16x8 (&bA)[4], const bf16x8 (&bX)[4], float ba, float bx, float c2, float cin,
                 const float (&x)[4][4], int g, int lc, float (&h)[4][4], float& cout, float& Ap) {
    f32x4 accA[4], accX[4];
#pragma unroll
    for (int i = 0; i < 4; ++i) { accA[i] = (f32x4){0.f, 0.f, 0.f, 0.f}; accX[i] = (f32x4){0.f, 0.f, 0.f, 0.f}; }
#pragma unroll
    for (int ks = 0; ks < 4; ++ks)
#pragma unroll
        for (int i = 0; i < 4; ++i) {
            const bf16x8 af = *(const bf16x8*)(xa + (i * 16 + lc) * 256 + (((ks * 4 + g) ^ lc) << 4));
            accA[i] = __builtin_amdgcn_mfma_f32_16x16x32_bf16(af, bA[ks], accA[i], 0, 0, 0);
            accX[i] = __builtin_amdgcn_mfma_f32_16x16x32_bf16(af, bX[ks], accX[i], 0, 0, 0);
        }
    float a[4][4], u[4][4];
#pragma unroll
    for (int i = 0; i < 4; ++i)
#pragma unroll
        for (int r = 0; r < 4; ++r) {
            const float rg = sigmf(accA[i][r] + ba), ig = sigmf(accX[i][r] + bx);
            const float av = __builtin_amdgcn_exp2f(rg * c2);
            a[i][r] = av;
            u[i][r] = __builtin_amdgcn_sqrtf(fmaxf(1.f - av * av, 0.f)) * (ig * x[i][r]);
        }
    lru_scan16<REV>(a, u, cin, g, lc, h, cout, Ap);
}

DEV void phase_lru_tiles(CParams& p, int l, int mode, unsigned char* lds) {
    unsigned char* xa = lds; float* hs = (float*)(lds + 16384); float* cwl = (float*)(lds + 49152); unsigned char* rawb = lds + 53248;
    bf16_t* Pb = ws_bf(p, OFF_P);
    const int tid = TIDX(), lane = tid & 63, w = __builtin_amdgcn_readfirstlane(tid >> 6), g = lane >> 4, lc = lane & 15;
    const int blk = BIDX() & 7, gstep = GDIM() >> 3;
    const int cl = w * 16 + lc, ch = blk * 128 + cl;
    for (int e = tid; e < 5 * 128; e += 512) {
        const int j = e >> 7, c = e & 127;
        cwl[e] = j < 4 ? p.conv_w[(size_t)(l * 4 + j) * D + blk * 128 + c] : p.conv_b[(size_t)l * D + blk * 128 + c];
    }
    bf16x8 bAf[4], bXf[4], bAb[4], bXb[4];
    {
        const bf16_t* W = ws_bf(p, OFF_LRUW) + ((size_t)blk * 128 + cl) * 128 + g * 8;
#pragma unroll
        for (int ks = 0; ks < 4; ++ks) {
            bAf[ks] = *(const bf16x8*)(W + ks * 32);
            bXf[ks] = *(const bf16x8*)(W + (size_t)1 * 8 * 16384 + ks * 32);
            bAb[ks] = *(const bf16x8*)(W + (size_t)2 * 8 * 16384 + ks * 32);
            bXb[ks] = *(const bf16x8*)(W + (size_t)3 * 8 * 16384 + ks * 32);
        }
    }
    const float baF = p.lru_ba[(l * 2 + 0) * D + ch], bxF = p.lru_bx[(l * 2 + 0) * D + ch];
    const float baB = p.lru_ba[(l * 2 + 1) * D + ch], bxB = p.lru_bx[(l * 2 + 1) * D + ch];
    const float c2F = -8.f * 1.4426950408889634f * softplusf(-p.lru_lambda[(l * 2 + 0) * D + ch]);
    const float c2B = -8.f * 1.4426950408889634f * softplusf(-p.lru_lambda[(l * 2 + 1) * D + ch]);
    float* LA = (float*)(p.ws + OFF_LRUC);
    float* LH = LA + 192 * 2 * 1024;
    const int chunk = tid & 15, chb = blk * 128 + chunk * 8, trow = tid >> 4;
#define LRU_PREFETCH(gcn) do { const bf16_t* src_ = Pb + (long)((gcn) * 64 - 1 + (lane >> 4)) * (long)PW + C_LX + blk * 128 + (lane & 15) * 8; \
        _Pragma("unroll") for (int q_ = 0; q_ < 3; ++q_) { const int qq_ = w + 8 * q_; if (qq_ < 17) \
            __builtin_amdgcn_global_load_lds((const unsigned*)(src_ + (long)qq_ * 4 * PW), (LAS unsigned*)((LAS unsigned char*)rawb + qq_ * 1024), 16, 0, 0); } } while (0)
    int gc = BIDX() >> 3, gend = 192, gst = gstep;
    if (mode && GDIM() == 256) { const int j = BIDX() >> 3; gc = j < 16 ? j * 5 : 80 + (j - 16) * 7; gend = gc + (j < 16 ? 5 : 7); gst = 1; }
    if (gc < gend) LRU_PREFETCH(gc);
    for (; gc < gend; gc += gst) {
        const int m0 = gc * 64;
        const bool lat = m0 >= NCTX;
        const int L = lat ? 2048 : 256, t0 = lat ? ((m0 - NCTX) & 2047) : (m0 & 255);
        asm volatile("s_waitcnt vmcnt(0)" ::: "memory");
        __syncthreads();
#pragma unroll
        for (int i = 0; i < 2; ++i) {
            const int tt = trow + 32 * i;
            float acc[8];
#pragma unroll
            for (int e = 0; e < 8; ++e) acc[e] = cwl[4 * 128 + chunk * 8 + e];
#pragma unroll
            for (int j = 0; j < 4; ++j) {
                const int tp = t0 + tt + j - 1;
                if (tp >= 0 && tp < L) {
                    const uint4 v = *(const uint4*)(rawb + (tt + j) * 256 + chunk * 16);
                    const float* cw = cwl + j * 128 + chunk * 8;
                    acc[0] += cw[0] * __uint_as_float(v.x << 16); acc[1] += cw[1] * __uint_as_float(v.x & 0xffff0000u);
                    acc[2] += cw[2] * __uint_as_float(v.y << 16); acc[3] += cw[3] * __uint_as_float(v.y & 0xffff0000u);
                    acc[4] += cw[4] * __uint_as_float(v.z << 16); acc[5] += cw[5] * __uint_as_float(v.z & 0xffff0000u);
                    acc[6] += cw[6] * __uint_as_float(v.w << 16); acc[7] += cw[7] * __uint_as_float(v.w & 0xffff0000u);
                }
            }
            uint4 o;
            o.x = pk2(acc[0], acc[1]); o.y = pk2(acc[2], acc[3]);
            o.z = pk2(acc[4], acc[5]); o.w = pk2(acc[6], acc[7]);
            *(uint4*)(xa + tt * 256 + ((chunk ^ (tt & 15)) << 4)) = o;
        }
        __syncthreads();
        if (gc + gst < gend) LRU_PREFETCH(gc + gst);
        const size_t ci = ((size_t)gc * 2) * 1024 + ch;
        const float cinF = mode ? LH[ci] : 0.f, cinB = mode ? LH[ci + 1024] : 0.f;
        uint4 gv[2];
        if (mode) {
#pragma unroll
            for (int i = 0; i < 2; ++i) gv[i] = *(const uint4*)(Pb + (size_t)(m0 + trow + 32 * i) * PW + C_LG + chb);
        }
        {
            float x[4][4];
#pragma unroll
            for (int i = 0; i < 4; ++i)
#pragma unroll
                for (int r = 0; r < 4; ++r) {
                    const int tok = i * 16 + g * 4 + r;
                    x[i][r] = bf2f(*(const bf16_t*)(xa + tok * 256 + (((cl >> 3) ^ (tok & 15)) << 4) + (cl & 7) * 2));
                }
            float h[4][4], cout, Ap;
            lru_dir<false>(xa, bAf, bXf, baF, bxF, c2F, cinF, x, g, lc, h, cout, Ap);
            if (!mode) { if (g == 0) { LA[ci] = Ap; LH[ci] = cout; } }
            else {
#pragma unroll
                for (int i = 0; i < 4; ++i)
#pragma unroll
                    for (int r = 0; r < 4; ++r) hs[(i * 16 + g * 4 + r) * 128 + cl] = h[i][r];
                if (!lat && g == 0 && t0 == 192) p.out[O_NLRU + ((size_t)((m0 >> 8) * 2 + l) * 2 + 0) * 1024 + ch] = cout;
            }
            lru_dir<true>(xa, bAb, bXb, baB, bxB, c2B, cinB, x, g, lc, h, cout, Ap);
            if (!mode) { if (g == 0) { LA[ci + 1024] = Ap; LH[ci + 1024] = cout; } }
            else {
#pragma unroll
                for (int i = 0; i < 4; ++i)
#pragma unroll
                    for (int r = 0; r < 4; ++r) hs[(i * 16 + g * 4 + r) * 128 + cl] += h[i][r];
                if (!lat && g == 0 && t0 == 0) p.out[O_NLRU + ((size_t)((m0 >> 8) * 2 + l) * 2 + 1) * 1024 + ch] = cout;
            }
        }
        if (mode) {
            __syncthreads();
#pragma unroll
            for (int i = 0; i < 2; ++i) {
                const int tt = trow + 32 * i, c8 = chunk * 8;
                const float4 h0 = *(const float4*)(hs + tt * 128 + c8), h1 = *(const float4*)(hs + tt * 128 + c8 + 4);
                uint4 o;
                o.x = pk2(h0.x * __uint_as_float(gv[i].x << 16), h0.y * __uint_as_float(gv[i].x & 0xffff0000u));
                o.y = pk2(h0.z * __uint_as_float(gv[i].y << 16), h0.w * __uint_as_float(gv[i].y & 0xffff0000u));
                o.z = pk2(h1.x * __uint_as_float(gv[i].z << 16), h1.y * __uint_as_float(gv[i].z & 0xffff0000u));
                o.w = pk2(h1.z * __uint_as_float(gv[i].w << 16), h1.w * __uint_as_float(gv[i].w & 0xffff0000u));
                *(uint4*)(Pb + (size_t)(m0 + tt) * PW + C_LG + chb) = o;
            }
        }
    }
    asm volatile("s_waitcnt vmcnt(0)" ::: "memory");
    __syncthreads();
#undef LRU_PREFETCH
}

DEV void phase_lru_carry(CParams& p, int l, int vb, int nvb) {
    float* LA = (float*)(p.ws + OFF_LRUC);
    float* LH = LA + 192 * 2 * 1024;
    const int gt = vb * 512 + TIDX(), gs = nvb * 512;
    for (int idx = gt; idx < 20 * 2 * 1024; idx += gs) {
        const int ch = idx & 1023, dir = (idx >> 10) & 1, seq = idx >> 11;
        const bool lat = seq >= 16;
        const int nch = lat ? 32 : 4;
        const int gc0 = lat ? 64 + (seq - 16) * 32 : seq * 4;
        float carry = lat ? p.state_lru[((size_t)((seq - 16) * 2 + l) * 2 + dir) * 1024 + ch] : 0.f;
        for (int s0 = 0; s0 < nch; s0 += 4) {
            float A[4], Hh[4]; size_t ci[4];
#pragma unroll
            for (int k = 0; k < 4; ++k) {
                const int sI = s0 + k, cidx = dir == 0 ? sI : nch - 1 - sI;
                ci[k] = ((size_t)(gc0 + cidx) * 2 + dir) * 1024 + ch;
                A[k] = LA[ci[k]]; Hh[k] = LH[ci[k]];
            }
#pragma unroll
            for (int k = 0; k < 4; ++k) { LH[ci[k]] = carry; carry = A[k] * carry + Hh[k]; }
        }
    }
}

DEV CParams* KARGS() { CParams* kp = (CParams*)__builtin_amdgcn_kernarg_segment_ptr(); asm volatile("" : "+s"(kp)); return kp; }

#define XB_TMO      128
#define XB_XCNT(j)  (256  + 64 * (j))
#define XB_XSUB(j)  (1280 + 64 * (j))
#define XB_XGEN(j)  (2304 + 64 * (j))
#define XB_TOP      3328
#define XB_TOPGEN   3392
#define XCD_BAR_WORDS 3456
#define XB_SPIN_CAP (1u << 18)
DEV unsigned xb_ld(unsigned* p)              { return __hip_atomic_load(p, __ATOMIC_RELAXED, __HIP_MEMORY_SCOPE_AGENT); }
DEV unsigned xb_add(unsigned* p, unsigned v) { return __hip_atomic_fetch_add(p, v, __ATOMIC_RELAXED, __HIP_MEMORY_SCOPE_AGENT); }
DEV unsigned xb_xcc_id() { return (unsigned)__builtin_amdgcn_s_getreg((3 << 11) | 20) & 0xFu; }
#define XB_SPIN(cond, bar) do { unsigned _sp = 0; while (cond) { __builtin_amdgcn_s_sleep(1); \
    if ((++_sp & 255u) == 0u) { if (xb_ld(&(bar)[XB_TMO])) break; if (_sp > XB_SPIN_CAP) { atomicAdd(&(bar)[XB_TMO], 1u); break; } } } } while (0)
struct XcdBarrier { unsigned* bar; unsigned x; volatile LAS unsigned* st; };
DEV XcdBarrier xcd_barrier_post(unsigned* bar, volatile LAS unsigned* st) {
    XcdBarrier b; b.bar = bar; b.x = xb_xcc_id(); b.st = st;
    if (threadIdx.x == 0) (void)xb_add(&bar[XB_XCNT(b.x)], 1u);
    return b;
}
DEV void xcd_barrier_complete(unsigned* bar, unsigned x, unsigned& nloc, unsigned& nx) {
    const unsigned G = gridDim.x * gridDim.y * gridDim.z;
    unsigned sum, cnt, mine, sp = 0u;
    for (;;) {
        sum = 0u; cnt = 0u; mine = 0u;
#pragma unroll
        for (unsigned j = 0; j < 16; ++j) { const unsigned c = xb_ld(&bar[XB_XCNT(j)]); sum += c; cnt += (c > 0u) ? 1u : 0u; mine = (j == x) ? c : mine; }
        if (sum == G) break;
        __builtin_amdgcn_s_sleep(1);
        if ((++sp & 255u) == 0u) { if (xb_ld(&bar[XB_TMO])) break; if (sp > XB_SPIN_CAP) { atomicAdd(&bar[XB_TMO], 1u); break; } }
    }
    nloc = mine > 0u ? mine : 1u; nx = cnt > 0u ? cnt : 1u;
}
DEV void xcd_barrier(const XcdBarrier& b0) {
    asm volatile("s_waitcnt vmcnt(0)" ::: "memory");
    __syncthreads();
    if (threadIdx.x == 0) {
        XcdBarrier b; b.x = b0.x; b.st = b0.st;
        asm volatile("" : "+s"(b.x));
        unsigned* bar = (unsigned*)(KARGS()->ws + OFF_BAR);
        __builtin_amdgcn_s_waitcnt(0);
        unsigned nloc = b.st[0], nx = b.st[1];
        if (nloc == 0u) { xcd_barrier_complete(bar, b.x, nloc, nx); b.st[0] = nloc; b.st[1] = nx; }
        const unsigned old = xb_add(&bar[XB_XSUB(b.x)], 1u);
        const unsigned gen = old / nloc;
        if (old + 1u == (gen + 1u) * nloc) {
            __builtin_amdgcn_fence(__ATOMIC_RELEASE, "agent");
            asm volatile("s_waitcnt vmcnt(0)" ::: "memory");
            const unsigned og = xb_add(&bar[XB_TOP], 1u);
            const unsigned tg = og / nx;
            if (og + 1u == (tg + 1u) * nx) xb_add(&bar[XB_TOPGEN], 1u);
            else XB_SPIN(xb_ld(&bar[XB_TOPGEN]) == tg, bar);
            __builtin_amdgcn_fence(__ATOMIC_ACQUIRE, "agent");
            xb_add(&bar[XB_XGEN(b.x)], 1u);
            asm volatile("s_waitcnt vmcnt(0)" ::: "memory");
        } else {
            XB_SPIN(xb_ld(&bar[XB_XGEN(b.x)]) == gen, bar);
            __builtin_amdgcn_fence(__ATOMIC_ACQUIRE, "agent");
            asm volatile("s_waitcnt vmcnt(0)" ::: "memory");
        }
    }
    __syncthreads();
}

enum { PH_INIT = 0, PH_PRENORM, PH_GEMM1, PH_MIX1, PH_MIX2, PH_MIX3, PH_MERGE, PH_MERGE2, PH_OUT, PH_COUNT };

DEV void run_phase(CParams& p, int ph, int l, unsigned char* lds) {
    switch (ph) {
    case PH_INIT:    phase_mod(p, (float*)lds); phase_rope_table(p); __syncthreads(); phase_convert(p, 0, (float*)lds); break;
    case PH_PRENORM: phase_prenorm(p, l); break;
    case PH_GEMM1:   phase8_gemm1(p, l, (LAS unsigned char*)lds); break;
    case PH_MIX1:    phase_attn(p, l, lds); __syncthreads(); phase_lru_tiles(p, l, 0, lds); __syncthreads(); phase_ret_kv(p, l, lds); break;
    case PH_MIX2:
        if (GDIM() == 256) {
            if (BIDX() < 192) phase8_merge(p, l, 2, (LAS unsigned char*)lds);
            else { phase_lru_carry(p, l, BIDX() - 192, 64); phase_ret_scan(p, l, BIDX() - 192, 64); }
        } else { phase_lru_carry(p, l, BIDX(), GDIM()); phase_ret_scan(p, l, BIDX(), GDIM()); }
        if (l == 1) phase_convert(p, 1, (float*)lds, 2);
        break;
    case PH_MIX3:    phase_lru_tiles(p, l, 1, lds); __syncthreads(); phase_ret_out(p, l, lds); break;
    case PH_MERGE:   phase8_merge(p, l, 0, (LAS unsigned char*)lds); break;
    case PH_MERGE2:  phase8_merge(p, l, 1, (LAS unsigned char*)lds); break;
    case PH_OUT:     phase8_out(p, l, (LAS unsigned char*)lds); if (l == 0) phase_convert(p, 1, (float*)lds, 1, 192); break;
    }
}

#if !ONE_LAUNCH
__global__ void __launch_bounds__(512, 2) phase_kernel(Params p, int ph, int l) {
    extern __shared__ __attribute__((aligned(16))) unsigned char dsm[];
    run_phase(p, ph, l, dsm);
}
#else
#ifndef PROBE_MASK
#define PROBE_MASK 0
#endif
#define PROBE_MULT 8
__global__ void __launch_bounds__(512, 2) mega_kernel(Params p) {
    extern __shared__ __attribute__((aligned(16))) unsigned char dsm[];
    cg::grid_group grid = cg::this_grid();
    volatile LAS unsigned* st = (volatile LAS unsigned*)((LAS unsigned char*)dsm + g8::STAGE_BYTES);
    if (threadIdx.x < 4) st[threadIdx.x] = 0u;
    __syncthreads();
    const XcdBarrier xb = xcd_barrier_post((unsigned*)(KARGS()->ws + OFF_BAR), st);
#define GSYNC() xcd_barrier(xb)
#if PROBE_MASK
    long long t_acc = 0, t0 = 0;
#define PROBE_BEGIN(ph) if ((PROBE_MASK >> (ph)) & 1) t0 = wall_clock64();
#define PROBE_END(ph) if ((PROBE_MASK >> (ph)) & 1) t_acc += wall_clock64() - t0;
#else
#define PROBE_BEGIN(ph)
#define PROBE_END(ph)
#endif
    if (KARGS()->out == nullptr) grid.sync();
    PROBE_BEGIN(PH_INIT) run_phase(*KARGS(), PH_INIT, 0, dsm); GSYNC(); PROBE_END(PH_INIT)
    PROBE_BEGIN(PH_PRENORM) run_phase(*KARGS(), PH_PRENORM, 0, dsm); GSYNC(); PROBE_END(PH_PRENORM)
    for (int l = 0; l < 2; ++l) {
        for (int ph = PH_GEMM1; ph <= PH_OUT; ++ph) {
            PROBE_BEGIN(ph)
            run_phase(*KARGS(), ph, l, dsm);
            if (!(l == 1 && ph == PH_OUT)) GSYNC();
            PROBE_END(ph)
        }
    }
#if PROBE_MASK
    if (blockIdx.x == 0 && threadIdx.x == 0) {
        const long long tgt = wall_clock64() + (long long)PROBE_MULT * t_acc;
        while (wall_clock64() < tgt) __builtin_amdgcn_s_sleep(8);
    }
#endif
}
#endif

extern "C" void kernel_launch(void* const* d_in, const int* in_sizes, int n_in,
                              void* d_out, int out_size, void* d_ws, size_t ws_size,
                              hipStream_t stream) {
    constexpr size_t kDynLds = LDS_XOFF + 5120;
    static int grid_blocks = 0;
    if (grid_blocks == 0) {
        if (n_in != 26 || ws_size < WS_NEED || out_size != 25231360) {
            fprintf(stderr, "kernel_launch: unexpected n_in %d / ws_size %zu (need %zu) / out_size %d\n", n_in, ws_size, (size_t)WS_NEED, out_size);
            grid_blocks = -1; return;
        }
        int dev = 0, cus = 0, per_cu = 0;
        (void)hipGetDevice(&dev);
        (void)hipDeviceGetAttribute(&cus, hipDeviceAttributeMultiprocessorCount, dev);
#if ONE_LAUNCH
        const void* kfn = (const void*)mega_kernel;
#else
        const void* kfn = (const void*)phase_kernel;
#endif
        if (hipFuncSetAttribute(kfn, hipFuncAttributeMaxDynamicSharedMemorySize, (int)kDynLds) != hipSuccess) {
            fprintf(stderr, "kernel_launch: hipFuncSetAttribute failed\n"); grid_blocks = -1; return;
        }
        if (hipOccupancyMaxActiveBlocksPerMultiprocessor(&per_cu, kfn, 512, kDynLds) != hipSuccess || per_cu < 1) {
            fprintf(stderr, "kernel_launch: occupancy query says %d blocks per CU\n", per_cu); grid_blocks = -1; return;
        }
        grid_blocks = cus & ~7;
    }
    if (grid_blocks < 0) return;
    Params p{};
    const float** pp = (const float**)&p;
    for (int i = 0; i < 26; ++i) pp[i] = (const float*)d_in[i];
    p.out = (float*)d_out;
    p.ws = (unsigned char*)d_ws;
#if ONE_LAUNCH
    (void)hipMemsetAsync((unsigned char*)d_ws + OFF_BAR, 0, 16384 + 1024, stream);
    void* args[] = {&p};
    hipError_t e = hipLaunchCooperativeKernel((const void*)mega_kernel, dim3(grid_blocks), dim3(512), args, kDynLds, stream);
    if (e != hipSuccess) fprintf(stderr, "cooperative launch failed: %s (grid %d)\n", hipGetErrorString(e), grid_blocks);
#else
    phase_kernel<<<grid_blocks, 512, kDynLds, stream>>>(p, PH_INIT, 0);
    phase_kernel<<<grid_blocks, 512, kDynLds, stream>>>(p, PH_PRENORM, 0);
    for (int l = 0; l < 2; ++l)
        for (int ph = PH_GEMM1; ph <= PH_OUT; ++ph)
            phase_kernel<<<grid_blocks, 512, kDynLds, stream>>>(p, ph, l);
#endif
}
```

```cpp
#include <hip/hip_runtime.h>
#include <hip/hip_cooperative_groups.h>
#include <cstdio>
#include <cstdint>
namespace cg = cooperative_groups;

#ifndef ONE_LAUNCH
#define ONE_LAUNCH 1
#endif

typedef unsigned short bf16_t;
#define DEV __device__ __forceinline__

constexpr int D = 1024;
constexpr int NCTX = 4096;
constexpr int NLAT = 8192;
constexpr int M = NCTX + NLAT;
constexpr int NW = 7680;
constexpr int N_RQ = 0, N_RK = 512, N_RV = 1024, N_RG = 2048, N_LX = 3072, N_LG = 4096,
              N_AQ = 5120, N_AK = 6144, N_AV = 6400, N_AG = 6656;
constexpr int PW = 6656;
constexpr int C_RQ = 0, C_RK = 512, C_RG = 1024, C_LX = 2048, C_LG = 3072,
              C_AQ = 4096, C_AK = 5120, C_AV = 5376, C_AG = 5632;
constexpr float EPS = 1e-6f;

constexpr size_t O_YP = 0, O_YS = 4194304, O_NK = 12582912, O_NV = 14680064, O_NRET = 16777216, O_NLRU = 25165824;

constexpr size_t OFF_MOD  = 0;
constexpr size_t OFF_LRUW = 122880;
constexpr size_t OFF_WBR  = OFF_LRUW + 1048576;
constexpr size_t OFF_WOUT = OFF_WBR + 6291456;
constexpr size_t OFF_WMG  = OFF_WOUT + 2097152;
constexpr size_t OFF_H    = OFF_WMG + 6291456;
constexpr size_t OFF_P    = OFF_H + (size_t)M * 1024 * 2;
constexpr size_t OFF_RVT  = OFF_P + (size_t)M * PW * 2;
constexpr size_t OFF_W1T  = OFF_RVT + (size_t)1024 * M * 2;
constexpr size_t OFF_OFTMP = OFF_W1T;
constexpr size_t OFF_LRUC = 262266880;
constexpr size_t OFF_ROPE = OFF_LRUC + (size_t)2 * 192 * 2 * 1024 * 4;
constexpr size_t OFF_BAR  = OFF_ROPE + (size_t)2048 * 96 * 8;
constexpr size_t OFF_XC   = OFF_BAR + 16384;
constexpr size_t OFF_XP   = OFF_XC + 1024;
constexpr size_t WS_NEED  = OFF_XP + 983040;
constexpr int LDS_XOFF = 131072 + 64;
static_assert(OFF_OFTMP + (size_t)M * 1024 * 2 <= OFF_LRUC, "overlap");
static_assert(WS_NEED <= 268435456, "ws budget");

struct Params;
typedef const __attribute__((address_space(4))) Params CParams;
struct Params {
    const float *x_prompt, *x_sample, *cache_k, *cache_v, *state_ret, *state_lru, *c, *c_ctx,
                *w_ada, *b_ada, *norm_pre, *norm_post, *w_in, *ret_decay, *conv_w, *conv_b,
                *lru_wa, *lru_ba, *lru_wx, *lru_bx, *lru_lambda, *att_sink, *w_branch, *w_merge, *b_merge, *w_out;
    float* out;
    unsigned char* ws;
};

DEV int BIDX() { int b = (int)blockIdx.x; asm volatile("" : "+s"(b)); return b; }
DEV int GDIM() { int g = (int)gridDim.x; asm volatile("" : "+s"(g)); return g; }
DEV int TIDX() { int t = threadIdx.x; asm volatile("" : "+v"(t)); return t; }
DEV float bf2f(bf16_t v) { return __uint_as_float(((unsigned)v) << 16); }
typedef __bf16 bf16x2_t __attribute__((ext_vector_type(2)));
DEV bf16_t f2bf(float f) { return __builtin_bit_cast(unsigned short, (__bf16)f); }
DEV unsigned pk2(float lo, float hi) { bf16x2_t v; v[0] = (__bf16)lo; v[1] = (__bf16)hi; return __builtin_bit_cast(unsigned, v); }
DEV float sigmf(float z) { return __builtin_amdgcn_rcpf(1.f + __builtin_amdgcn_exp2f(-1.4426950408889634f * z)); }
DEV float siluf(float x) { return x * sigmf(x); }
DEV float softplusf(float x) { return fmaxf(x, 0.f) + log1pf(__expf(-fabsf(x))); }

DEV float* ws_mod(CParams& p) { return (float*)(p.ws + OFF_MOD); }
DEV bf16_t* ws_bf(CParams& p, size_t off) { return (bf16_t*)(p.ws + off); }

DEV const float* x_row(CParams& p, int l, int m) {
    const float* xp = p.x_prompt; const float* xs = p.x_sample; const float* po = p.out;
    if (l == 0) return m < NCTX ? xp + (size_t)m * D : xs + (size_t)(m - NCTX) * D;
    return po + (size_t)m * D;
}
DEV int cond_row(int m) { return m < NCTX ? 0 : 1 + ((m - NCTX) >> 11); }

DEV float wave_sum(float v) {
#pragma unroll
    for (int o = 1; o < 64; o <<= 1) v += __shfl_xor(v, o);
    return v;
}
DEV float xrow16_max(float x) {
    auto s = __builtin_amdgcn_permlane16_swap(__float_as_uint(x), __float_as_uint(x), false, false);
    x = fmaxf(__uint_as_float(s[0]), __uint_as_float(s[1]));
    auto t = __builtin_amdgcn_permlane32_swap(__float_as_uint(x), __float_as_uint(x), false, false);
    return fmaxf(__uint_as_float(t[0]), __uint_as_float(t[1]));
}
DEV float xrow16_sum(float x) {
    auto s = __builtin_amdgcn_permlane16_swap(__float_as_uint(x), __float_as_uint(x), false, false);
    x = __uint_as_float(s[0]) + __uint_as_float(s[1]);
    auto t = __builtin_amdgcn_permlane32_swap(__float_as_uint(x), __float_as_uint(x), false, false);
    return __uint_as_float(t[0]) + __uint_as_float(t[1]);
}
DEV void xrow16_gather(float x, float (&v)[4]) {
    auto s = __builtin_amdgcn_permlane16_swap(__float_as_uint(x), __float_as_uint(x), false, false);
    auto e = __builtin_amdgcn_permlane32_swap(s[0], s[0], false, false);
    auto o = __builtin_amdgcn_permlane32_swap(s[1], s[1], false, false);
    v[0] = __uint_as_float(e[0]); v[1] = __uint_as_float(o[0]); v[2] = __uint_as_float(e[1]); v[3] = __uint_as_float(o[1]);
}
DEV void phase_mod(CParams& p, float* lds) {
    float* mod = ws_mod(p);
    float* sl = lds;
    float* part = lds + 1024;
    unsigned* lastf = (unsigned*)(lds + 1024 + 8 * 5 * 256);
    const int tid = TIDX(), lane = tid & 63, w = tid >> 6;
    const float* cctx = p.c_ctx; const float* cb_ = p.c;
    unsigned* MPu = (unsigned*)(p.ws + OFF_XP);
    unsigned* cnt = (unsigned*)(p.ws + OFF_XC) + 192;
    for (int unit = BIDX(); unit < 192; unit += GDIM()) {
        const int ks = unit & 7, cbk = (unit >> 3) % 12, l = unit / 96;
        __syncthreads();
        for (int e = tid; e < 5 * 128; e += 512) { const int r = e >> 7, k = ks * 128 + (e & 127); sl[e] = siluf(r == 0 ? cctx[k] : cb_[(r - 1) * D + k]); }
        __syncthreads();
        const float* wp = p.w_ada + ((size_t)l * D + ks * 128 + w * 16) * 3072 + cbk * 256 + lane * 4;
        float4 acc[5];
#pragma unroll
        for (int r = 0; r < 5; ++r) acc[r] = make_float4(0.f, 0.f, 0.f, 0.f);
#pragma unroll
        for (int k = 0; k < 16; ++k) {
            const float4 wv = *(const float4*)(wp + (size_t)k * 3072);
#pragma unroll
            for (int r = 0; r < 5; ++r) { const float sv = sl[r * 128 + w * 16 + k]; acc[r].x += sv * wv.x; acc[r].y += sv * wv.y; acc[r].z += sv * wv.z; acc[r].w += sv * wv.w; }
        }
#pragma unroll
        for (int r = 0; r < 5; ++r) *(float4*)(part + (w * 5 + r) * 256 + lane * 4) = acc[r];
        __syncthreads();
        unsigned* mp = MPu + (size_t)((l * 12 + cbk) * 8 + ks) * 1280;
        for (int e = tid; e < 1280; e += 512) {
            float v = 0.f;
#pragma unroll
            for (int q = 0; q < 8; ++q) v += part[q * 1280 + e];
            __hip_atomic_store(mp + e, __float_as_uint(v), __ATOMIC_RELAXED, __HIP_MEMORY_SCOPE_AGENT);
        }
        asm volatile("s_waitcnt vmcnt(0)" ::: "memory");
        __syncthreads();
        if (tid == 0) {
            const unsigned old = __hip_atomic_fetch_add(cnt + l * 12 + cbk, 1u, __ATOMIC_RELAXED, __HIP_MEMORY_SCOPE_AGENT);
            if (old == 7u) { __builtin_amdgcn_fence(__ATOMIC_ACQUIRE, "agent"); asm volatile("s_waitcnt vmcnt(0)" ::: "memory"); }
            *lastf = old == 7u ? 1u : 0u;
        }
        __syncthreads();
        if (*lastf) {
            const unsigned* m0 = MPu + (size_t)((l * 12 + cbk) * 8) * 1280;
            for (int e = tid; e < 1280; e += 512) {
                const int r = e >> 8, j = cbk * 256 + (e & 255);
                float v = p.b_ada[l * 3072 + j];
#pragma unroll
                for (int q = 0; q < 8; ++q) v += __uint_as_float(__hip_atomic_load(m0 + q * 1280 + e, __ATOMIC_RELAXED, __HIP_MEMORY_SCOPE_AGENT));
                mod[(size_t)(l * 5 + r) * 3072 + j] = v;
            }
        }
    }
    __syncthreads();
}

DEV void phase_rope_table(CParams& p) {
    float2* tab = (float2*)(p.ws + OFF_ROPE);
    const int gt = BIDX() * blockDim.x + TIDX(), gs = GDIM() * blockDim.x;
    for (int idx = gt; idx < 2048 * 96; idx += gs) {
        const int t = idx / 96, e = idx % 96;
        int a, c; float nq;
        if (e < 64) { a = e >> 5; c = e & 31; nq = 32.f; } else { a = (e - 64) >> 4; c = (e - 64) & 15; nq = 16.f; }
        const float pos = (float)(a ? (t & 63) : (t >> 6));
        const float inv = powf(10000.f, -(float)c / nq);
        float sn, cs; sincosf(pos * inv, &sn, &cs);
        tab[idx] = make_float2(cs, sn);
    }
}

DEV int w1t_row(int n) {
    if (n < N_RV) return (n & ~48) | ((n & 16) << 1) | ((n & 32) >> 1);
    if (n < N_RG) return PW + (n - N_RV);
    return n - 1024;
}
struct ConvTile { const float* src; bf16_t* dst; int N, K, k0, n0; bool w1; };
DEV void conv_load(const ConvTile& t, float4 (&v)[2]) {
    const int tid = TIDX();
#pragma unroll
    for (int i = 0; i < 2; ++i) v[i] = *(const float4*)(t.src + (size_t)(t.k0 + (tid >> 4) + 32 * i) * t.N + t.n0 + (tid & 15) * 4);
}
DEV void conv_park(const float4 (&v)[2], float* tile) {
    const int tid = TIDX();
#pragma unroll
    for (int i = 0; i < 2; ++i) {
        float* d = tile + ((tid >> 4) + 32 * i) * 65 + (tid & 15) * 4;
        d[0] = v[i].x; d[1] = v[i].y; d[2] = v[i].z; d[3] = v[i].w;
    }
}
DEV void conv_store(const ConvTile& t, const float* tile) {
    const int tid = TIDX();
    const int n = tid >> 3, kc = tid & 7;
    const int dr = t.w1 ? w1t_row(t.n0 + n) : t.n0 + n;
    const float* s = tile + (kc * 8) * 65 + n;
    uint4 o;
    o.x = pk2(s[0], s[65]);       o.y = pk2(s[130], s[195]);
    o.z = pk2(s[260], s[325]);    o.w = pk2(s[390], s[455]);
    *(uint4*)(t.dst + (size_t)dr * t.K + t.k0 + kc * 8) = o;
}
DEV void conv_tile(CParams& p, int l, int r, int which, ConvTile& t) {
    constexpr int T_IN = 16 * 120, T_MG = 16 * 48, T_BR = 3 * 256, T_OUT = 256;
    if (which == 2) r += T_IN + T_MG + T_BR;
    if (which == 1 && r >= T_IN + T_MG + T_BR) r += T_OUT;
    t.K = D; t.w1 = false;
    if (r < T_IN) { t.src = p.w_in + (size_t)l * D * NW; t.N = NW; t.dst = ws_bf(p, OFF_W1T); t.k0 = (r / 120) * 64; t.n0 = (r % 120) * 64; t.w1 = true; return; }
    r -= T_IN;
    if (r < T_MG) { t.src = p.w_merge + (size_t)l * D * 3072; t.N = 3072; t.dst = ws_bf(p, OFF_WMG); t.k0 = (r / 48) * 64; t.n0 = (r % 48) * 64; return; }
    r -= T_MG;
    if (r < T_BR) { const int nb = r / 256, q = r % 256;
        t.src = p.w_branch + ((size_t)l * 3 + nb) * D * D; t.N = D; t.dst = ws_bf(p, OFF_WBR) + (size_t)nb * D * D; t.k0 = (q / 16) * 64; t.n0 = (q % 16) * 64; return; }
    r -= T_BR;
    if (r < T_OUT) { t.src = p.w_out + (size_t)l * D * D; t.N = D; t.dst = ws_bf(p, OFF_WOUT); t.k0 = (r / 16) * 64; t.n0 = (r % 16) * 64; return; }
    r -= T_OUT;
    {
        const int mat = r / 4, q = r % 4;
        const int dir = mat >> 4, gate = (mat >> 3) & 1, blk = mat & 7;
        const float* wa_ = p.lru_wa; const float* wx_ = p.lru_wx;
        t.src = (gate ? wx_ : wa_) + (((size_t)l * 2 + dir) * 8 + blk) * 128 * 128; t.N = 128; t.K = 128;
        t.dst = ws_bf(p, OFF_LRUW) + (size_t)mat * 128 * 128; t.k0 = (q >> 1) * 64; t.n0 = (q & 1) * 64;
    }
}
DEV void phase_convert(CParams& p, int l, float* tile, int which = 0, int start = 0) {
    constexpr int T_IN = 16 * 120, T_MG = 16 * 48, T_BR = 3 * 256, T_OUT = 256, T_LRU = 32 * 4;
    constexpr int TOT = T_IN + T_MG + T_BR + T_OUT + T_LRU;
    const int G = GDIM();
    const int count = which == 2 ? T_OUT : which == 1 ? TOT - T_OUT : TOT;
    const int rot = ((BIDX() - start) % G + G) % G;
    for (int it = rot; it < count; it += 4 * G) {
        ConvTile t[4]; float4 v[4][2];
#pragma unroll
        for (int j = 0; j < 4; ++j) {
            const bool on = it + j * G < count;
            conv_tile(p, l, on ? it + j * G : it, which, t[j]);
            if (on) conv_load(t[j], v[j]);
        }
#pragma unroll
        for (int j = 0; j < 4; ++j) if (it + j * G < count) conv_park(v[j], tile + j * 4224);
        __syncthreads();
#pragma unroll
        for (int j = 0; j < 4; ++j) if (it + j * G < count) conv_store(t[j], tile + j * 4224);
        __syncthreads();
    }
}

DEV void prenorm_row(CParams& p, int l, int m, const float4 (&v)[4], int lane) {
    float ss = 0.f;
#pragma unroll
    for (int j = 0; j < 4; ++j) ss += (v[j].x * v[j].x + v[j].y * v[j].y) + (v[j].z * v[j].z + v[j].w * v[j].w);
    ss = wave_sum(ss);
    const float rstd = rsqrtf(ss * (1.f / D) + EPS);
    const float* mod = ws_mod(p) + (size_t)(l * 5 + cond_row(m)) * 3072;
    bf16_t* h = ws_bf(p, OFF_H) + (size_t)m * D;
#pragma unroll
    for (int j = 0; j < 4; ++j) {
        const int i4 = lane + 64 * j;
        const float4 g = ((const float4*)(p.norm_pre + l * D))[i4];
        const float4 sh = ((const float4*)mod)[i4];
        const float4 sc = ((const float4*)(mod + 1024))[i4];
        ushort4 o;
        o.x = f2bf(v[j].x * rstd * g.x * (1.f + sc.x) + sh.x);
        o.y = f2bf(v[j].y * rstd * g.y * (1.f + sc.y) + sh.y);
        o.z = f2bf(v[j].z * rstd * g.z * (1.f + sc.z) + sh.z);
        o.w = f2bf(v[j].w * rstd * g.w * (1.f + sc.w) + sh.w);
        ((ushort4*)h)[i4] = o;
    }
}
DEV void phase_prenorm(CParams& p, int l) {
    const int tid = TIDX(), lane = tid & 63;
    for (int m = BIDX() * 8 + (tid >> 6); m < M; m += GDIM() * 8) {
        const float4* xr = (const float4*)x_row(p, l, m);
        float4 v[4];
#pragma unroll
        for (int j = 0; j < 4; ++j) v[j] = xr[lane + 64 * j];
        prenorm_row(p, l, m, v, lane);
    }
}

typedef short bf16x8 __attribute__((ext_vector_type(8)));
typedef float f32x4 __attribute__((ext_vector_type(4)));
typedef short v4i16_t __attribute__((ext_vector_type(4)));
#define LAS __attribute__((address_space(3)))
namespace g8 {
constexpr int BK = 64, HALF = 128, HTB = HALF * BK * 2, STAGE_BYTES = 8 * HTB;
DEV int lds_byte(int r, int c) { const int st = (r >> 4) * 2 + (c >> 5), rr = r & 15, cc = c & 31, ob = rr * 64 + cc * 2; return st * 1024 + (ob ^ (((ob >> 9) & 1) << 5)); }
DEV void stage_rc(int b, int& R, int& C) { const int st = b / 1024, sb = b % 1024, swz = sb ^ (((sb >> 9) & 1) << 5); R = (st >> 1) * 16 + swz / 64; C = (st & 1) * 32 + (swz % 64) / 2; }
struct Unit { const char* a; const char* b; int kind, pm, pn; unsigned lda; };

template <class Sched, class Epi>
DEV void gemm_phase(LAS unsigned char* lds, const unsigned ldb, const int nt, const Sched& S, const Epi& E) {
    const int tid = TIDX(), wid = __builtin_amdgcn_readfirstlane(tid >> 6), lane = tid & 63, wr = wid >> 2, wc = wid & 3, fr = lane & 15, fq = lane >> 4;
    unsigned rowA[2], colA[2], voffB[2];
#pragma unroll
    for (int i = 0; i < 2; ++i) { int R, C; stage_rc(tid * 16 + i * 8192, R, C); rowA[i] = (unsigned)R; colA[i] = (unsigned)C * 2u; voffB[i] = (unsigned)R * ldb + (unsigned)C * 2u; }
    const size_t kstep = (size_t)(BK * 2);
    const size_t hstepB = (size_t)HALF * ldb;
    const unsigned ldsw = (unsigned)wid * 1024u;
    const int aoff = lds_byte(wr * 64 + fr, fq * 8), boff = lds_byte(wc * 32 + fr, fq * 8);
#define G8_SA(b, h) (((b) * 2 + (h)) * HTB)
#define G8_SB(b, h) ((4 + (b) * 2 + (h)) * HTB)
#define G8_STAGE(bufoff, gbase, voff) do { _Pragma("unroll") for (int _i = 0; _i < 2; ++_i) \
        __builtin_amdgcn_global_load_lds((const unsigned*)((const char*)(gbase) + (voff)[_i]), (LAS unsigned*)(lds + (bufoff) + ldsw + _i * 8192), 16, 0, 0); } while (0)
#define G8_STAGEA(bufoff, gbase, ld) do { _Pragma("unroll") for (int _i = 0; _i < 2; ++_i) \
        __builtin_amdgcn_global_load_lds((const unsigned*)((const char*)(gbase) + (rowA[_i] * (ld) + colA[_i])), (LAS unsigned*)(lds + (bufoff) + ldsw + _i * 8192), 16, 0, 0); } while (0)
#define G8_LDA(dst, b, h) do { _Pragma("unroll") for (int m = 0; m < 4; ++m) _Pragma("unroll") for (int k = 0; k < 2; ++k) dst[m][k] = *(const LAS bf16x8*)(lds + G8_SA(b, h) + aoff + m * 2048 + k * 1024); } while (0)
#define G8_LDB(dst, b, h) do { _Pragma("unroll") for (int n = 0; n < 2; ++n) _Pragma("unroll") for (int k = 0; k < 2; ++k) dst[n][k] = *(const LAS bf16x8*)(lds + G8_SB(b, h) + boff + n * 2048 + k * 1024); } while (0)
#define G8_MMA(ai, bj, At, Bt) do { __builtin_amdgcn_s_setprio(1); _Pragma("unroll") for (int m = 0; m < 4; ++m) _Pragma("unroll") for (int n = 0; n < 2; ++n) _Pragma("unroll") for (int k = 0; k < 2; ++k) \
        acc[ai][bj][m][n] = __builtin_amdgcn_mfma_f32_16x16x32_bf16(Bt[n][k], At[m][k], acc[ai][bj][m][n], 0, 0, 0); __builtin_amdgcn_s_setprio(0); } while (0)
#define G8_WAIT_V(n) asm volatile("s_waitcnt vmcnt(" #n ")" ::: "memory")
#define G8_WAIT_L(n) asm volatile("s_waitcnt lgkmcnt(" #n ")" ::: "memory")
#define G8_BAR __builtin_amdgcn_s_barrier()
#define G8_SCHED __builtin_amdgcn_sched_barrier(0)
    Unit cur, nxt; int ui = 0;
    if (!S.next(0, cur)) return;
    f32x4 acc[2][2][4][2];
#pragma unroll
    for (int a = 0; a < 2; ++a)
#pragma unroll
        for (int b = 0; b < 2; ++b)
#pragma unroll
            for (int m = 0; m < 4; ++m)
#pragma unroll
                for (int n = 0; n < 2; ++n) acc[a][b][m][n] = (f32x4){0.f, 0.f, 0.f, 0.f};
    bf16x8 At[4][2], B0[2][2], B1[2][2];
    const char* cA = cur.a; const char* cB = cur.b;
    unsigned ldc = cur.lda;
    G8_STAGE(G8_SB(0, 0), cB, voffB); G8_STAGE(G8_SB(0, 1), cB + hstepB, voffB); G8_STAGEA(G8_SA(0, 0), cA, ldc); G8_STAGEA(G8_SA(0, 1), cA + (size_t)HALF * ldc, ldc);
    if (wr == 1) G8_BAR;
    G8_WAIT_V(2); G8_BAR;
    G8_STAGE(G8_SB(1, 0), cB + kstep, voffB); G8_STAGEA(G8_SA(1, 0), cA + kstep, ldc); G8_STAGE(G8_SB(1, 1), cB + hstepB + kstep, voffB);
    G8_WAIT_V(6); G8_BAR;
    for (;;) {
        const bool has_next = S.next(ui + 1, nxt);
        const char* nA = has_next ? nxt.a : cA; const char* nB = has_next ? nxt.b : cB;
        const unsigned ldn = has_next ? nxt.lda : ldc;
        for (int t = 0; t < nt; t += 2) {
            const bool last = (t == nt - 2);
            const char* a1 = cA + (size_t)(t + 1) * kstep;
            const char* a2 = last ? nA : cA + (size_t)(t + 2) * kstep; const char* b2 = last ? nB : cB + (size_t)(t + 2) * kstep;
            const char* a3 = a2 + kstep; const char* b3 = b2 + kstep;
            const unsigned ld2 = last ? ldn : ldc;
            const size_t h1 = (size_t)HALF * ldc, h2 = (size_t)HALF * ld2;
            G8_LDB(B0, 0, 0); G8_LDB(B1, 0, 1); G8_SCHED; G8_LDA(At, 0, 0); G8_STAGEA(G8_SA(1, 1), a1 + h1, ldc);
            G8_WAIT_V(8); G8_WAIT_L(0); G8_BAR; G8_MMA(0, 0, At, B0); G8_MMA(0, 1, At, B1); G8_BAR; G8_SCHED;
            G8_LDA(At, 0, 1); G8_STAGE(G8_SB(0, 0), b2, voffB); G8_STAGE(G8_SB(0, 1), b2 + hstepB, voffB); G8_STAGEA(G8_SA(0, 0), a2, ld2);
            G8_WAIT_V(8); G8_WAIT_L(0); G8_BAR; G8_MMA(1, 0, At, B0); G8_MMA(1, 1, At, B1); G8_BAR; G8_SCHED;
            G8_LDB(B0, 1, 0); G8_LDB(B1, 1, 1); G8_SCHED; G8_LDA(At, 1, 0); G8_STAGEA(G8_SA(0, 1), a2 + h2, ld2);
            G8_WAIT_V(8); G8_WAIT_L(0); G8_BAR; G8_MMA(0, 0, At, B0); G8_MMA(0, 1, At, B1); G8_BAR; G8_SCHED;
            G8_LDA(At, 1, 1); G8_STAGE(G8_SB(1, 0), b3, voffB); G8_STAGE(G8_SB(1, 1), b3 + hstepB, voffB); G8_STAGEA(G8_SA(1, 0), a3, ld2);
            G8_WAIT_V(8); G8_WAIT_L(0); G8_BAR; G8_MMA(1, 0, At, B0); G8_MMA(1, 1, At, B1); G8_BAR; G8_SCHED;
        }
        if (wr == 0) G8_BAR;
        E(acc, cur, wr, wc, fr, fq);
        if (!has_next) break;
#pragma unroll
        for (int a = 0; a < 2; ++a)
#pragma unroll
            for (int b = 0; b < 2; ++b)
#pragma unroll
                for (int m = 0; m < 4; ++m)
#pragma unroll
                    for (int n = 0; n < 2; ++n) acc[a][b][m][n] = (f32x4){0.f, 0.f, 0.f, 0.f};
        cur = nxt; cA = nA; cB = nB; ldc = ldn; ++ui;
        if (wr == 1) G8_BAR;
    }
    G8_WAIT_V(0);
    G8_BAR;
#undef G8_SA
#undef G8_SB
#undef G8_STAGE
#undef G8_STAGEA
#undef G8_LDA
#undef G8_LDB
#undef G8_MMA
#undef G8_WAIT_V
#undef G8_WAIT_L
#undef G8_BAR
#undef G8_SCHED
}

DEV void grid_unit(int wgid, int nM, int nN, int& pm, int& pn) {
    const int nwg = nM * nN, q = nwg / 8, r = nwg % 8, xcd = wgid % 8, off = wgid / 8;
    wgid = (xcd < r ? xcd * (q + 1) : r * (q + 1) + (xcd - r) * q) + off;
    const int nig = 4 * nN, gid = wgid / nig, fm = gid * 4, gsz = (nM - fm) < 4 ? (nM - fm) : 4;
    pm = fm + ((wgid % nig) % gsz); pn = (wgid % nig) / gsz;
}
DEV uint2 pk4(const f32x4 v) { return make_uint2(pk2(v[0], v[1]), pk2(v[2], v[3])); }
DEV float lo16(unsigned u) { return __uint_as_float(u << 16); }
DEV float hi16(unsigned u) { return __uint_as_float(u & 0xffff0000u); }
}

struct SchedG1 {
    const char* H; const char* W; int G, c;
    DEV bool next(int i, g8::Unit& u) const {
        int L = i * G + c;
        if (L >= 1440) return false;
        if (L < 1248) { g8::grid_unit(L, 48, 26, u.pm, u.pn); u.kind = 0; u.lda = 2048u; u.a = H + (size_t)u.pm * 256 * 2048; u.b = W + (size_t)u.pn * 256 * 2048; }
        else { g8::grid_unit(L - 1248, 4, 48, u.pm, u.pn); u.kind = 0; u.lda = 2048u; u.a = W + (size_t)(PW + u.pm * 256) * 2048; u.b = H + (size_t)u.pn * 256 * 2048; u.pn += 64; }
        return true;
    }
};
struct EpiG1 {
    unsigned char* ws; float* out; int l;
    DEV void operator()(const f32x4 (&acc)[2][2][4][2], const g8::Unit& u, int wr, int wc, int fr, int fq) const {
        using namespace g8;
        bf16_t* Pb = (bf16_t*)(ws + OFF_P);
        if (u.pn >= 64) {
            bf16_t* RVT = (bf16_t*)(ws + OFF_RVT);
#pragma unroll
            for (int ai = 0; ai < 2; ++ai)
#pragma unroll
                for (int bj = 0; bj < 2; ++bj)
#pragma unroll
                    for (int m = 0; m < 4; ++m)
#pragma unroll
                        for (int n = 0; n < 2; ++n) {
                            const int ch = u.pm * 256 + ai * 128 + wr * 64 + m * 16 + fr;
                            const int tok = (u.pn - 64) * 256 + bj * 128 + wc * 32 + n * 16 + fq * 4;
                            *(uint2*)(RVT + (size_t)ch * M + tok) = pk4(acc[ai][bj][m][n]);
                        }
            return;
        }
        const int pn = u.pn;
        const bool rope_ret = pn < 4, rope_att = pn >= 16 && pn <= 20;
        const bool lat = u.pm >= 16;
        if (rope_ret || rope_att) {
            const int te = rope_ret ? (wc >> 1) * 32 + (wc & 1) * 16 + fq * 4 : 64 + (wc & 1) * 16 + fq * 4;
            const float sc = pn < 2 ? 0.08838834764831845f : (pn >= 16 && pn < 20) ? 0.125f * 1.4426950408889634f : 1.f;
#pragma unroll
            for (int ai = 0; ai < 2; ++ai) {
                float4 c01[4], c23[4];
                if (lat) {
#pragma unroll
                    for (int m = 0; m < 4; ++m) {
                        const int t = (u.pm * 256 + ai * 128 + wr * 64 + m * 16 + fr - NCTX) & 2047;
                        const float4* tb = (const float4*)((const float2*)(ws + OFF_ROPE) + (size_t)t * 96 + te);
                        c01[m] = tb[0]; c23[m] = tb[1];
                    }
                }
#pragma unroll
                for (int m = 0; m < 4; ++m) {
                    const int row = u.pm * 256 + ai * 128 + wr * 64 + m * 16 + fr;
                    bf16_t* Pr = Pb + (size_t)row * PW;
#pragma unroll
                    for (int bj = 0; bj < 2; ++bj) {
                        f32x4 x1 = acc[ai][bj][m][0], x2 = acc[ai][bj][m][1];
                        const int lc1 = rope_ret ? pn * 256 + bj * 128 + (wc >> 1) * 64 + (wc & 1) * 16 + fq * 4 : pn * 256 + bj * 128 + wc * 32 + fq * 4;
                        const int lc2 = rope_ret ? lc1 + 32 : lc1 + 16;
                        if (!lat && pn == 20) {
                            float* ok = out + O_NK + ((size_t)((row >> 8) * 2 + l) * 256 + (row & 255)) * 256 + (lc1 - C_AK);
                            *(float4*)ok = make_float4(x1[0], x1[1], x1[2], x1[3]);
                            *(float4*)(ok + 16) = make_float4(x2[0], x2[1], x2[2], x2[3]);
                        }
                        if (lat) {
                            const float cs[4] = {c01[m].x, c01[m].z, c23[m].x, c23[m].z}, sn[4] = {c01[m].y, c01[m].w, c23[m].y, c23[m].w};
                            f32x4 o1, o2;
#pragma unroll
                            for (int j = 0; j < 4; ++j) { o1[j] = x1[j] * cs[j] - x2[j] * sn[j]; o2[j] = x2[j] * cs[j] + x1[j] * sn[j]; }
                            x1 = o1; x2 = o2;
                        }
                        x1 *= sc; x2 *= sc;
                        *(uint2*)(Pr + lc1) = pk4(x1);
                        *(uint2*)(Pr + lc2) = pk4(x2);
                    }
                }
            }
            return;
        }
#pragma unroll
        for (int ai = 0; ai < 2; ++ai)
#pragma unroll
            for (int m = 0; m < 4; ++m) {
                const int row = u.pm * 256 + ai * 128 + wr * 64 + m * 16 + fr;
                bf16_t* Pr = Pb + (size_t)row * PW;
#pragma unroll
                for (int bj = 0; bj < 2; ++bj)
#pragma unroll
                    for (int n = 0; n < 2; ++n) {
                        f32x4 v = acc[ai][bj][m][n];
                        const int col = pn * 256 + bj * 128 + wc * 32 + n * 16 + fq * 4;
                        if (pn == 21) {
                            if (!lat) *(float4*)(out + O_NV + ((size_t)((row >> 8) * 2 + l) * 256 + (row & 255)) * 256 + (col - C_AV)) = make_float4(v[0], v[1], v[2], v[3]);
                        } else if (!(pn >= 8 && pn < 12)) {
#pragma unroll
                            for (int j = 0; j < 4; ++j) v[j] = siluf(v[j]);
                        }
                        *(uint2*)(Pr + col) = pk4(v);
                    }
            }
    }
};
DEV void phase8_gemm1(CParams& p, int l, LAS unsigned char* lds) {
    SchedG1 S{(const char*)(p.ws + OFF_H), (const char*)(p.ws + OFF_W1T), GDIM(), BIDX()};
    EpiG1 E{p.ws, p.out, l};
    g8::gemm_phase(lds, 2048u, 16, S, E);
}

constexpr size_t OFF_G2 = OFF_RVT;
struct SchedMg {
    const char *H, *P, *WMG, *WBR; int G, c, part;
    DEV void fill(g8::Unit& u, int tile, int n, int isz) const {
        u.pm = tile >> 2; u.pn = tile & 3; u.kind = n * 2 + isz;
        if (isz) { const int acol = n == 0 ? C_RG : n == 1 ? C_LG : C_AQ;
                   u.lda = (unsigned)PW * 2u; u.a = P + (size_t)u.pm * 256 * PW * 2 + (size_t)acol * 2; u.b = WBR + ((size_t)n * 1024 + u.pn * 256) * 2048; }
        else { u.lda = 2048u; u.a = H + (size_t)u.pm * 256 * 2048; u.b = WMG + ((size_t)n * 1024 + u.pn * 256) * 2048; }
    }
    DEV bool next(int i, g8::Unit& u) const {
        if (G == 256) {
            const int xg = c & 7, j = c >> 3;
            if (part == 2) {
                if (c >= 192 || i >= 1) return false;
                fill(u, xg * 24 + j, 1, 0);
            } else if (part == 0) {
                if (c < 192) { if (i >= 3) return false; if (i == 0) fill(u, xg * 24 + j, 0, 0); else fill(u, xg * 24 + j, i - 1, 1); }
                else { if (i >= 3) return false; fill(u, xg * 24 + (j - 24) * 3 + i, 2, 0); }
            } else {
                if (c >= 192 || i >= 1) return false;
                fill(u, xg * 24 + j, 2, 1);
            }
            return true;
        }
        if (part != 0) return false;
        const int tile = c + (i / 6) * G, sI = i % 6;
        if (tile >= 192) return false;
        fill(u, tile, sI >> 1, sI & 1);
        return true;
    }
};
struct EpiMg {
    unsigned char* ws; const float* bias;
    DEV bf16_t* gslot(int n, int row) const {
        bf16_t* Pb = (bf16_t*)(ws + OFF_P);
        return n == 0 ? Pb + (size_t)row * PW + C_LX : n == 1 ? Pb + (size_t)row * PW + C_AG : (bf16_t*)(ws + OFF_G2) + (size_t)row * 1024;
    }
    DEV void operator()(const f32x4 (&acc)[2][2][4][2], const g8::Unit& u, int wr, int wc, int fr, int fq) const {
        using namespace g8;
        const int n = u.kind >> 1; const bool zpass = u.kind & 1;
        const int colb = u.pn * 256 + wc * 32 + fq * 4;
        if (!zpass) {
            float4 bz[2][2];
#pragma unroll
            for (int bj = 0; bj < 2; ++bj)
#pragma unroll
                for (int nn = 0; nn < 2; ++nn) bz[bj][nn] = *(const float4*)(bias + n * 1024 + colb + bj * 128 + nn * 16);
#pragma unroll
            for (int ai = 0; ai < 2; ++ai)
#pragma unroll
                for (int m = 0; m < 4; ++m) {
                    bf16_t* gs = gslot(n, u.pm * 256 + ai * 128 + wr * 64 + m * 16 + fr);
#pragma unroll
                    for (int bj = 0; bj < 2; ++bj)
#pragma unroll
                        for (int nn = 0; nn < 2; ++nn) {
                            f32x4 v = acc[ai][bj][m][nn];
                            v[0] = sigmf(v[0] + bz[bj][nn].x); v[1] = sigmf(v[1] + bz[bj][nn].y); v[2] = sigmf(v[2] + bz[bj][nn].z); v[3] = sigmf(v[3] + bz[bj][nn].w);
                            *(uint2*)(gs + colb + bj * 128 + nn * 16) = pk4(v);
                        }
                }
            return;
        }
#pragma unroll
        for (int ai = 0; ai < 2; ++ai) {
            uint2 gq[4][2][2], tq[4][2][2];
#pragma unroll
            for (int m = 0; m < 4; ++m) {
                const int row = u.pm * 256 + ai * 128 + wr * 64 + m * 16 + fr;
                const bf16_t* gs = gslot(n, row);
                const bf16_t* Tr = (const bf16_t*)(ws + OFF_P) + (size_t)row * PW;
#pragma unroll
                for (int bj = 0; bj < 2; ++bj)
#pragma unroll
                    for (int nn = 0; nn < 2; ++nn) {
                        gq[m][bj][nn] = *(const uint2*)(gs + colb + bj * 128 + nn * 16);
                        if (n > 0) tq[m][bj][nn] = *(const uint2*)(Tr + colb + bj * 128 + nn * 16);
                    }
            }
#pragma unroll
            for (int m = 0; m < 4; ++m) {
                const int row = u.pm * 256 + ai * 128 + wr * 64 + m * 16 + fr;
                bf16_t* Tr = (bf16_t*)(ws + OFF_P) + (size_t)row * PW;
#pragma unroll
                for (int bj = 0; bj < 2; ++bj)
#pragma unroll
                    for (int nn = 0; nn < 2; ++nn) {
                        f32x4 v = acc[ai][bj][m][nn];
                        const uint2 gv = gq[m][bj][nn];
                        v[0] *= lo16(gv.x); v[1] *= hi16(gv.x); v[2] *= lo16(gv.y); v[3] *= hi16(gv.y);
                        if (n > 0) { const uint2 tv = tq[m][bj][nn]; v[0] += lo16(tv.x); v[1] += hi16(tv.x); v[2] += lo16(tv.y); v[3] += hi16(tv.y); }
                        *(uint2*)(Tr + colb + bj * 128 + nn * 16) = pk4(v);
                    }
            }
        }
    }
};
DEV void phase8_merge(CParams& p, int l, int part, LAS unsigned char* lds) {
    SchedMg S{(const char*)(p.ws + OFF_H), (const char*)(p.ws + OFF_P), (const char*)(p.ws + OFF_WMG), (const char*)(p.ws + OFF_WBR), GDIM(), BIDX(), part};
    EpiMg E{p.ws, p.b_merge + (size_t)l * 3072};
    g8::gemm_phase(lds, 2048u, 16, S, E);
}

struct SchedOut {
    const char* A; const char* B; int G, c;
    DEV bool next(int i, g8::Unit& u) const {
        int tile = i * G + c;
        if (G == 256) { if (i > 0 || c >= 192) return false; tile = (c & 7) * 24 + (c >> 3); }
        if (tile >= 192) return false;
        u.pm = tile >> 2; u.pn = tile & 3; u.kind = 0; u.lda = (unsigned)PW * 2u;
        u.a = A + (size_t)u.pm * 256 * PW * 2; u.b = B + (size_t)u.pn * 256 * 2048;
        return true;
    }
};
DEV void row_exchange(unsigned char* ws, int slot, int pn, float* part, float* rs) {
    const int tid = TIDX();
    __syncthreads();
    unsigned* XPd = (unsigned*)(ws + OFF_XP) + (size_t)slot * 4 * 256;
    unsigned* cnt = (unsigned*)(ws + OFF_XC) + slot;
    if (tid < 256) {
        const float v = (part[tid] + part[256 + tid]) + (part[512 + tid] + part[768 + tid]);
        __hip_atomic_store(XPd + pn * 256 + tid, __float_as_uint(v), __ATOMIC_RELAXED, __HIP_MEMORY_SCOPE_AGENT);
    }
    asm volatile("s_waitcnt vmcnt(0)" ::: "memory");
    __syncthreads();
    if (tid == 0) {
        (void)__hip_atomic_fetch_add(cnt, 1u, __ATOMIC_RELAXED, __HIP_MEMORY_SCOPE_AGENT);
        unsigned sp = 0;
        while (__hip_atomic_load(cnt, __ATOMIC_RELAXED, __HIP_MEMORY_SCOPE_AGENT) < 4u) { __builtin_amdgcn_s_sleep(1); if (++sp > (1u << 20)) break; }
        __builtin_amdgcn_fence(__ATOMIC_ACQUIRE, "agent");
        asm volatile("s_waitcnt vmcnt(0)" ::: "memory");
    }
    __syncthreads();
    if (tid < 256) {
        float t = 0.f;
#pragma unroll
        for (int q = 0; q < 4; ++q) t += __uint_as_float(__hip_atomic_load(XPd + q * 256 + tid, __ATOMIC_RELAXED, __HIP_MEMORY_SCOPE_AGENT));
        rs[tid] = rsqrtf(t * (1.f / D) + EPS);
    }
    __syncthreads();
}
struct EpiOutPost {
    CParams* kp; int l; unsigned char* ldsx;
    DEV void row_ssq(const f32x4 (&v)[2][2][4][2], float* part, int wr, int wc, int fr, int fq) const {
#pragma unroll
        for (int ai = 0; ai < 2; ++ai)
#pragma unroll
            for (int m = 0; m < 4; ++m) {
                float ss = 0.f;
#pragma unroll
                for (int bj = 0; bj < 2; ++bj)
#pragma unroll
                    for (int n = 0; n < 2; ++n) { const f32x4 x = v[ai][bj][m][n]; ss += (x[0] * x[0] + x[1] * x[1]) + (x[2] * x[2] + x[3] * x[3]); }
                ss = xrow16_sum(ss);
                if (fq == 0) part[wc * 256 + ai * 128 + wr * 64 + m * 16 + fr] = ss;
            }
    }
    DEV void operator()(f32x4 (&acc)[2][2][4][2], const g8::Unit& u, int wr, int wc, int fr, int fq) const {
        CParams& p = *kp;
        unsigned char* ws = p.ws;
        float* part = (float*)ldsx; float* rs = part + 1024;
        const int colb = u.pn * 256 + wc * 32 + fq * 4;
        const int crow = u.pm < 16 ? 0 : 1 + ((u.pm - 16) >> 3);
        const float* mod = ws_mod(p) + (size_t)(l * 5 + crow) * 3072;
        row_ssq(acc, part, wr, wc, fr, fq);
        row_exchange(ws, (l * 2 + 0) * 48 + u.pm, u.pn, part, rs);
        {
            float4 gt[2][2], gp[2][2];
#pragma unroll
            for (int bj = 0; bj < 2; ++bj)
#pragma unroll
                for (int n = 0; n < 2; ++n) {
                    gt[bj][n] = *(const float4*)(mod + 2048 + colb + bj * 128 + n * 16);
                    gp[bj][n] = *(const float4*)(p.norm_post + l * D + colb + bj * 128 + n * 16);
                    gt[bj][n].x *= gp[bj][n].x; gt[bj][n].y *= gp[bj][n].y; gt[bj][n].z *= gp[bj][n].z; gt[bj][n].w *= gp[bj][n].w;
                }
#pragma unroll
            for (int ai = 0; ai < 2; ++ai)
#pragma unroll
                for (int mh = 0; mh < 2; ++mh) {
                    float4 xv[2][2][2];
#pragma unroll
                    for (int m2 = 0; m2 < 2; ++m2) {
                        const int row = u.pm * 256 + ai * 128 + wr * 64 + (mh * 2 + m2) * 16 + fr;
                        const float* xr = x_row(p, l, row);
#pragma unroll
                        for (int bj = 0; bj < 2; ++bj)
#pragma unroll
                            for (int n = 0; n < 2; ++n) xv[m2][bj][n] = *(const float4*)(xr + colb + bj * 128 + n * 16);
                    }
#pragma unroll
                    for (int m2 = 0; m2 < 2; ++m2) {
                        const int m = mh * 2 + m2;
                        const int rl = ai * 128 + wr * 64 + m * 16 + fr;
                        const float rstd = rs[rl];
                        float* yr = p.out + (size_t)(u.pm * 256 + rl) * D;
#pragma unroll
                        for (int bj = 0; bj < 2; ++bj)
#pragma unroll
                            for (int n = 0; n < 2; ++n) {
                                f32x4 y;
                                y[0] = xv[m2][bj][n].x + gt[bj][n].x * (acc[ai][bj][m][n][0] * rstd);
                                y[1] = xv[m2][bj][n].y + gt[bj][n].y * (acc[ai][bj][m][n][1] * rstd);
                                y[2] = xv[m2][bj][n].z + gt[bj][n].z * (acc[ai][bj][m][n][2] * rstd);
                                y[3] = xv[m2][bj][n].w + gt[bj][n].w * (acc[ai][bj][m][n][3] * rstd);
                                acc[ai][bj][m][n] = y;
                                *(float4*)(yr + colb + bj * 128 + n * 16) = make_float4(y[0], y[1], y[2], y[3]);
                            }
                    }
                }
        }
        if (l != 0) return;
        row_ssq(acc, part, wr, wc, fr, fq);
        row_exchange(ws, (l * 2 + 1) * 48 + u.pm, u.pn, part, rs);
        {
            const float* mod1 = ws_mod(p) + (size_t)(1 * 5 + crow) * 3072;
            float4 a_[2][2], b_[2][2];
#pragma unroll
            for (int bj = 0; bj < 2; ++bj)
#pragma unroll
                for (int n = 0; n < 2; ++n) {
                    const int cc = colb + bj * 128 + n * 16;
                    const float4 g = *(const float4*)(p.norm_pre + 1 * D + cc), sc = *(const float4*)(mod1 + 1024 + cc);
                    a_[bj][n] = make_float4(g.x * (1.f + sc.x), g.y * (1.f + sc.y), g.z * (1.f + sc.z), g.w * (1.f + sc.w));
                    b_[bj][n] = *(const float4*)(mod1 + cc);
                }
#pragma unroll
            for (int ai = 0; ai < 2; ++ai)
#pragma unroll
                for (int m = 0; m < 4; ++m) {
                    const int rl = ai * 128 + wr * 64 + m * 16 + fr;
                    const float rstd = rs[rl];
                    bf16_t* hr = ws_bf(p, OFF_H) + (size_t)(u.pm * 256 + rl) * D;
#pragma unroll
                    for (int bj = 0; bj < 2; ++bj)
#pragma unroll
                        for (int n = 0; n < 2; ++n) {
                            const f32x4 y = acc[ai][bj][m][n];
                            uint2 o;
                            o.x = pk2(y[0] * rstd * a_[bj][n].x + b_[bj][n].x, y[1] * rstd * a_[bj][n].y + b_[bj][n].y);
                            o.y = pk2(y[2] * rstd * a_[bj][n].z + b_[bj][n].z, y[3] * rstd * a_[bj][n].w + b_[bj][n].w);
                            *(uint2*)(hr + colb + bj * 128 + n * 16) = o;
                        }
                }
        }
    }
};
DEV void phase8_out(CParams& p, int l, LAS unsigned char* lds) {
    SchedOut S{(const char*)(p.ws + OFF_P), (const char*)(p.ws + OFF_WOUT), GDIM(), BIDX()};
    EpiOutPost E{&p, l, (unsigned char*)lds + LDS_XOFF};
    g8::gemm_phase(lds, 2048u, 16, S, E);
}

DEV uint4 pack8(const float4 a, const float4 b) {
    uint4 r;
    r.x = pk2(a.x, a.y); r.y = pk2(a.z, a.w);
    r.z = pk2(b.x, b.y); r.w = pk2(b.z, b.w);
    return r;
}
template <int NU>
DEV void attn_item(CParams& p, int l, bool lat, int b, int hk, int qs0, unsigned char* lds) {
    bf16_t* Pb = ws_bf(p, OFF_P);
    const int tid = TIDX(), lane = tid & 63, w = tid >> 6, g = lane >> 4, lc = lane & 15;
    const int row0 = lat ? NCTX + b * 2048 : b * 256, L = lat ? 2048 : 256;
    const int hq = hk * 4 + (w & 3);
    const int qw = qs0 + (w >> 2) * 32;
    bf16x8 qfr[NU][2][2];
    f32x4 O[NU][4][2];
    float mrun[NU][2], lrun[NU][2];
    const float sink = p.att_sink[l * 16 + hq] * 1.4426950408889634f;
#pragma unroll
    for (int u = 0; u < NU; ++u)
#pragma unroll
        for (int qf = 0; qf < 2; ++qf) {
#pragma unroll
            for (int ks = 0; ks < 2; ++ks)
                qfr[u][qf][ks] = *(const bf16x8*)(Pb + (size_t)(row0 + qw + u * 64 + qf * 16 + lc) * PW + C_AQ + hq * 64 + ks * 32 + g * 8);
            mrun[u][qf] = sink; lrun[u][qf] = g == 0 ? 1.f : 0.f;
#pragma unroll
            for (int df = 0; df < 4; ++df) O[u][df][qf] = (f32x4){0.f, 0.f, 0.f, 0.f};
        }
    const int nband = lat ? 4 + NU : 4;
    const int ntile = lat ? nband + 4 : 4;
    const int qsb = qs0 >> 6;
    const int t_lo = lat ? (qsb < 2 ? 2 - qsb : 0) : 0;
    const int t_hi = lat ? ((33 - qsb) < (nband - 1) ? (33 - qsb) : (nband - 1)) : 3;
    const int fsw = (lane >> 1) & 7;
    const int srow = tid >> 3, sc8 = tid & 7;
    float4 R[4];
    auto tile_load = [&](int t) __attribute__((always_inline)) {
        if (t < nband) {
            const int kp0 = lat ? qs0 + 64 * (t - 2) : 64 * t;
            const uint4 kv = *(const uint4*)(Pb + (size_t)(row0 + kp0 + srow) * PW + C_AK + hk * 64 + sc8 * 8);
            const uint4 vv = *(const uint4*)(Pb + (size_t)(row0 + kp0 + srow) * PW + C_AV + hk * 64 + sc8 * 8);
            R[0] = make_float4(__uint_as_float(kv.x), __uint_as_float(kv.y), __uint_as_float(kv.z), __uint_as_float(kv.w));
            R[2] = make_float4(__uint_as_float(vv.x), __uint_as_float(vv.y), __uint_as_float(vv.z), __uint_as_float(vv.w));
        } else {
            const int j0 = (t - nband) * 64;
            const float* ck = p.cache_k + (size_t)((b * 2 + l) * 256 + j0) * 256 + hk * 64;
            const float* cv = p.cache_v + (size_t)((b * 2 + l) * 256 + j0) * 256 + hk * 64;
            R[0] = *(const float4*)(ck + (size_t)srow * 256 + sc8 * 8); R[1] = *(const float4*)(ck + (size_t)srow * 256 + sc8 * 8 + 4);
            R[2] = *(const float4*)(cv + (size_t)srow * 256 + sc8 * 8); R[3] = *(const float4*)(cv + (size_t)srow * 256 + sc8 * 8 + 4);
        }
    };
    auto tile_store = [&](bool cache_t, unsigned char* KsB, unsigned char* VtB) __attribute__((always_inline)) {
        uint4 kq, vq;
        if (!cache_t) {
            kq = make_uint4(__float_as_uint(R[0].x), __float_as_uint(R[0].y), __float_as_uint(R[0].z), __float_as_uint(R[0].w));
            vq = make_uint4(__float_as_uint(R[2].x), __float_as_uint(R[2].y), __float_as_uint(R[2].z), __float_as_uint(R[2].w));
        } else { kq = pack8(R[0], R[1]); vq = pack8(R[2], R[3]); }
        *(uint4*)(KsB + srow * 128 + ((sc8 ^ ((srow >> 1) & 7)) << 4)) = kq;
        *(uint4*)(VtB + srow * 128 + ((sc8 ^ (((srow >> 1) & 3) << 1)) << 4)) = vq;
    };
    int t = t_lo;
    tile_load(t);
    __syncthreads();
    tile_store(t >= nband, lds, lds + 8192);
    int tn = (lat && t == t_hi) ? nband : t + 1;
    if (tn < ntile) tile_load(tn);
    int cur = 0;
    while (t < ntile) {
        const bool cache = t >= nband;
        const int kp0 = lat ? qs0 + 64 * (t - 2) : 64 * t;
        const unsigned char* Ks = lds + cur * 16384; const unsigned char* Vt = Ks + 8192;
        __syncthreads();
        int tnn = ntile;
        if (tn < ntile) {
            tile_store(tn >= nband, lds + (cur ^ 1) * 16384, lds + (cur ^ 1) * 16384 + 8192);
            tnn = (lat && tn == t_hi) ? nband : tn + 1;
            if (tnn < ntile) tile_load(tnn);
        }
#pragma unroll
        for (int u = 0; u < NU; ++u) {
            const int tu = t - u;
            if (lat && !cache && (tu < 0 || tu > 4)) continue;
            __builtin_amdgcn_s_setprio(1);
            f32x4 sc[4][2];
#pragma unroll
            for (int kf = 0; kf < 4; ++kf)
#pragma unroll
                for (int qf = 0; qf < 2; ++qf) sc[kf][qf] = (f32x4){0.f, 0.f, 0.f, 0.f};
#pragma unroll
            for (int ks = 0; ks < 2; ++ks) {
                bf16x8 ak[4];
#pragma unroll
                for (int kf = 0; kf < 4; ++kf) ak[kf] = *(const bf16x8*)(Ks + (kf * 16 + lc) * 128 + (((ks * 4 + g) ^ fsw) << 4));
#pragma unroll
                for (int kf = 0; kf < 4; ++kf)
#pragma unroll
                    for (int qf = 0; qf < 2; ++qf)
                        sc[kf][qf] = __builtin_amdgcn_mfma_f32_16x16x32_bf16(ak[kf], qfr[u][qf][ks], sc[kf][qf], 0, 0, 0);
            }
            __builtin_amdgcn_s_setprio(0);
            if (lat && !cache && (tu == 0 || tu == 4)) {
#pragma unroll
                for (int kf = 0; kf < 4; ++kf)
#pragma unroll
                    for (int qf = 0; qf < 2; ++qf)
#pragma unroll
                        for (int r = 0; r < 4; ++r) {
                            const int kpos = kp0 + kf * 16 + g * 4 + r, qpos = qw + u * 64 + qf * 16 + lc;
                            const int dd = qpos - kpos;
                            if (dd > 128 || dd < -128) sc[kf][qf][r] = -INFINITY;
                        }
            }
            bf16x8 pb[2][2];
#pragma unroll
            for (int qf = 0; qf < 2; ++qf) {
                float mx = -INFINITY;
#pragma unroll
                for (int kf = 0; kf < 4; ++kf)
#pragma unroll
                    for (int r = 0; r < 4; ++r) mx = fmaxf(mx, sc[kf][qf][r]);
                mx = xrow16_max(mx);
                const float mnew = fmaxf(mrun[u][qf], mx);
                const float alpha = __builtin_amdgcn_exp2f(mrun[u][qf] - mnew);
                mrun[u][qf] = mnew;
                float ps = 0.f;
#pragma unroll
                for (int kf = 0; kf < 4; ++kf)
#pragma unroll
                    for (int r = 0; r < 4; ++r) { const float e = __builtin_amdgcn_exp2f(sc[kf][qf][r] - mnew); sc[kf][qf][r] = e; ps += e; }
                lrun[u][qf] = lrun[u][qf] * alpha + ps;
#pragma unroll
                for (int df = 0; df < 4; ++df) O[u][df][qf] *= alpha;
#pragma unroll
                for (int s2 = 0; s2 < 2; ++s2) {
                    bf16x8 v;
#pragma unroll
                    for (int r = 0; r < 4; ++r) { v[r] = (short)f2bf(sc[2 * s2][qf][r]); v[4 + r] = (short)f2bf(sc[2 * s2 + 1][qf][r]); }
                    pb[s2][qf] = v;
                }
            }
            __builtin_amdgcn_s_setprio(1);
#pragma unroll
            for (int s2 = 0; s2 < 2; ++s2)
#pragma unroll
                for (int df = 0; df < 4; ++df) {
                    const int vrow = 32 * s2 + 4 * g + (lc >> 2);
                    const unsigned char* vr = Vt + vrow * 128 + (((2 * df + ((lc >> 1) & 1)) ^ (((vrow >> 1) & 3) << 1)) << 4) + 8 * (lc & 1);
                    const v4i16_t lo = __builtin_amdgcn_ds_read_tr16_b64_v4i16((LAS v4i16_t*)vr);
                    const v4i16_t hi = __builtin_amdgcn_ds_read_tr16_b64_v4i16((LAS v4i16_t*)(vr + 2048));
                    union { v4i16_t h[2]; bf16x8 v; } av; av.h[0] = lo; av.h[1] = hi;
#pragma unroll
                    for (int qf = 0; qf < 2; ++qf)
                        O[u][df][qf] = __builtin_amdgcn_mfma_f32_16x16x32_bf16(av.v, pb[s2][qf], O[u][df][qf], 0, 0, 0);
                }
            __builtin_amdgcn_s_setprio(0);
        }
        t = tn; tn = tnn; cur ^= 1;
    }
#pragma unroll
    for (int u = 0; u < NU; ++u)
#pragma unroll
        for (int qf = 0; qf < 2; ++qf) {
            const float lt = xrow16_sum(lrun[u][qf]);
            const float inv = 1.f / lt;
            const size_t m = (size_t)(row0 + qw + u * 64 + qf * 16 + lc);
#pragma unroll
            for (int df = 0; df < 4; ++df) {
                const int col = hq * 64 + df * 16 + g * 4;
                const uint2 gt = *(const uint2*)(Pb + m * PW + C_AG + col);
                uint2 o;
                o.x = pk2(O[u][df][qf][0] * inv * __uint_as_float(gt.x << 16), O[u][df][qf][1] * inv * __uint_as_float(gt.x & 0xffff0000u));
                o.y = pk2(O[u][df][qf][2] * inv * __uint_as_float(gt.y << 16), O[u][df][qf][3] * inv * __uint_as_float(gt.y & 0xffff0000u));
                *(uint2*)(Pb + m * PW + C_AQ + col) = o;
            }
        }
}
DEV void phase_attn(CParams& p, int l, unsigned char* lds) {
    if (GDIM() == 256) {
        const int xg = BIDX() & 7, j = BIDX() >> 3;
        { const int grp = xg * 2 + (j >> 4); attn_item<2>(p, l, true, grp >> 2, grp & 3, (j & 15) * 128, lds); }
        { const int grp = xg * 8 + (j >> 2); attn_item<1>(p, l, false, grp >> 2, grp & 3, (j & 3) * 64, lds); }
        return;
    }
    for (int item = BIDX(); item < 768; item += GDIM()) {
        if (item < 512) attn_item<1>(p, l, true, item >> 7, (item >> 5) & 3, (item & 31) * 64, lds);
        else { const int it = item - 512; attn_item<1>(p, l, false, it >> 4, (it >> 2) & 3, (it & 3) * 64, lds); }
    }
}

constexpr size_t OFF_RS = OFF_W1T;
static_assert(OFF_RS + (size_t)4 * 4 * 2 * 8 * 32768 * 2 <= OFF_LRUC, "RS overlap");
DEV float ret_logg(CParams& p, int l, int dir, int h) { return -softplusf(-p.ret_decay[(l * 2 + dir) * 4 + h]); }

DEV void ret_kv_tile(CParams& p, int l, int item, unsigned char* lds) {
    bf16_t* Pb = ws_bf(p, OFF_P); const bf16_t* RVT = ws_bf(p, OFF_RVT);
    const int tid = TIDX(), lane = tid & 63, w = __builtin_amdgcn_readfirstlane(tid >> 6), g = lane >> 4, lc = lane & 15;
    const bool lat = item < 128;
    int b, h, c;
    if (lat) { c = item & 7; h = (item >> 3) & 3; b = item >> 5; }
    else { const int it = item - 128; h = it & 3; b = it >> 2; c = 0; }
    const int row0 = lat ? NCTX + b * 2048 + c * 256 : b * 256;
    const bool doF = !lat || c < 7, doB = !lat || c > 0;
    const float lgf = ret_logg(p, l, 0, h), lgb = ret_logg(p, l, 1, h);
    const float rf = __expf(-lgf), rb = __expf(lgb);
    const int dvbase = w * 32;
    auto dma_k = [&](int st) __attribute__((always_inline)) {
        LAS unsigned char* base = (LAS unsigned char*)lds + (st & 1) * 16384;
#pragma unroll
        for (int i = 0; i < 2; ++i) {
            const int q = w * 2 + i, row = 4 * q + (lane >> 4), lch = (lane & 15) ^ (((row & 3) << 2) | ((row >> 2) & 3));
            __builtin_amdgcn_global_load_lds((const unsigned*)(Pb + (size_t)(row0 + st * 64 + row) * PW + C_RK + h * 128 + lch * 8), (LAS unsigned*)(base + q * 1024), 16, 0, 0);
        }
    };
    __syncthreads();
    dma_k(0);
    f32x4 accF[2][8], accB[2][8];
#pragma unroll
    for (int i = 0; i < 2; ++i)
#pragma unroll
        for (int j = 0; j < 8; ++j) { accF[i][j] = (f32x4){0.f, 0.f, 0.f, 0.f}; accB[i][j] = (f32x4){0.f, 0.f, 0.f, 0.f}; }
    const int tq = lc >> 2, tp = lc & 3;
#pragma unroll 1
    for (int st = 0; st < 4; ++st) {
        bf16x8 av[2][2];
#pragma unroll
        for (int ks = 0; ks < 2; ++ks)
#pragma unroll
            for (int mf = 0; mf < 2; ++mf)
                av[ks][mf] = *(const bf16x8*)(RVT + (size_t)(h * 256 + dvbase + mf * 16 + lc) * M + row0 + st * 64 + ks * 32 + g * 8);
        bf16x8 avF[2][2], avB[2][2];
#pragma unroll
        for (int ks = 0; ks < 2; ++ks) {
            const int ti0 = st * 64 + ks * 32 + g * 8;
            float wf = __expf(lgf * (float)(255 - ti0)), wb = __expf(lgb * (float)ti0);
#pragma unroll
            for (int j = 0; j < 8; ++j) {
#pragma unroll
                for (int mf = 0; mf < 2; ++mf) {
                    const float v = bf2f((bf16_t)av[ks][mf][j]);
                    avF[ks][mf][j] = (short)f2bf(v * wf); avB[ks][mf][j] = (short)f2bf(v * wb);
                }
                wf *= rf; wb *= rb;
            }
        }
        asm volatile("s_waitcnt vmcnt(0)" ::: "memory");
        __syncthreads();
        if (st + 1 < 4) dma_k(st + 1);
        const unsigned char* Kt = lds + (st & 1) * 16384;
#pragma unroll
        for (int ks = 0; ks < 2; ++ks)
#pragma unroll
            for (int nf = 0; nf < 8; ++nf) {
                const int r0 = 32 * ks + 8 * g + tq, r1 = r0 + 4;
                const unsigned char* a0 = Kt + r0 * 256 + (((2 * nf + (tp >> 1)) ^ (((r0 & 3) << 2) | ((r0 >> 2) & 3))) << 4) + 8 * (tp & 1);
                const unsigned char* a1 = Kt + r1 * 256 + (((2 * nf + (tp >> 1)) ^ (((r1 & 3) << 2) | ((r1 >> 2) & 3))) << 4) + 8 * (tp & 1);
                union { v4i16_t hlf[2]; bf16x8 v; } bk;
                bk.hlf[0] = __builtin_amdgcn_ds_read_tr16_b64_v4i16((LAS v4i16_t*)a0);
                bk.hlf[1] = __builtin_amdgcn_ds_read_tr16_b64_v4i16((LAS v4i16_t*)a1);
#pragma unroll
                for (int mf = 0; mf < 2; ++mf) {
                    accF[mf][nf] = __builtin_amdgcn_mfma_f32_16x16x32_bf16(avF[ks][mf], bk.v, accF[mf][nf], 0, 0, 0);
                    accB[mf][nf] = __builtin_amdgcn_mfma_f32_16x16x32_bf16(avB[ks][mf], bk.v, accB[mf][nf], 0, 0, 0);
                }
            }
    }
    if (lat) {
        bf16_t* dF = ws_bf(p, OFF_RS) + ((size_t)((b * 4 + h) * 2 + 0) * 8 + (c + 1)) * 32768;
        bf16_t* dB = ws_bf(p, OFF_RS) + ((size_t)((b * 4 + h) * 2 + 1) * 8 + (c - 1)) * 32768;
#pragma unroll
        for (int mf = 0; mf < 2; ++mf)
#pragma unroll
            for (int nf = 0; nf < 8; ++nf)
#pragma unroll
                for (int r = 0; r < 4; ++r) {
                    const size_t o = (size_t)(dvbase + mf * 16 + g * 4 + r) * 128 + nf * 16 + lc;
                    if (doF) dF[o] = f2bf(accF[mf][nf][r]);
                    if (doB) dB[o] = f2bf(accB[mf][nf][r]);
                }
    } else {
        float* dF = p.out + O_NRET + ((((size_t)b * 2 + l) * 2 + 0) * 4 + h) * 128 * 256;
        float* dB = p.out + O_NRET + ((((size_t)b * 2 + l) * 2 + 1) * 4 + h) * 128 * 256;
#pragma unroll
        for (int mf = 0; mf < 2; ++mf)
#pragma unroll
            for (int nf = 0; nf < 8; ++nf) {
                const size_t o = (size_t)(nf * 16 + lc) * 256 + dvbase + mf * 16 + g * 4;
                *(float4*)(dF + o) = make_float4(accF[mf][nf][0], accF[mf][nf][1], accF[mf][nf][2], accF[mf][nf][3]);
                *(float4*)(dB + o) = make_float4(accB[mf][nf][0], accB[mf][nf][1], accB[mf][nf][2], accB[mf][nf][3]);
            }
    }
}
DEV void phase_ret_kv(CParams& p, int l, unsigned char* lds) {
    for (int item = BIDX(); item < 192; item += GDIM()) ret_kv_tile(p, l, item, lds);
}

DEV void phase_ret_scan(CParams& p, int l, int vb, int nvb) {
    bf16_t* RS = ws_bf(p, OFF_RS);
    const int gt = vb * 512 + TIDX(), gs = nvb * 512;
    for (int idx = gt; idx < 4 * 4 * 2 * 4096; idx += gs) {
        const int dk0 = (idx & 15) * 8, dv = (idx >> 4) & 255, dir = (idx >> 12) & 1, h = (idx >> 13) & 3, b = idx >> 15;
        const float g256 = __expf(ret_logg(p, l, dir, h) * 256.f);
        const float* s0 = p.state_ret + (((((size_t)b * 2 + l) * 2 + dir) * 4 + h) * 128 + dk0) * 256 + dv;
        float st[8];
#pragma unroll
        for (int e = 0; e < 8; ++e) st[e] = s0[(size_t)e * 256];
        bf16_t* base = RS + (size_t)((b * 4 + h) * 2 + dir) * 8 * 32768 + dv * 128 + dk0;
        uint4 kv[7];
#pragma unroll
        for (int j = 0; j < 7; ++j) kv[j] = *(const uint4*)(base + (size_t)(dir == 0 ? j + 1 : 6 - j) * 32768);
        *(uint4*)(base + (size_t)(dir == 0 ? 0 : 7) * 32768) = make_uint4(pk2(st[0], st[1]), pk2(st[2], st[3]), pk2(st[4], st[5]), pk2(st[6], st[7]));
#pragma unroll
        for (int j = 0; j < 7; ++j) {
            st[0] = g256 * st[0] + g8::lo16(kv[j].x); st[1] = g256 * st[1] + g8::hi16(kv[j].x);
            st[2] = g256 * st[2] + g8::lo16(kv[j].y); st[3] = g256 * st[3] + g8::hi16(kv[j].y);
            st[4] = g256 * st[4] + g8::lo16(kv[j].z); st[5] = g256 * st[5] + g8::hi16(kv[j].z);
            st[6] = g256 * st[6] + g8::lo16(kv[j].w); st[7] = g256 * st[7] + g8::hi16(kv[j].w);
            *(uint4*)(base + (size_t)(dir == 0 ? j + 1 : 6 - j) * 32768) = make_uint4(pk2(st[0], st[1]), pk2(st[2], st[3]), pk2(st[4], st[5]), pk2(st[6], st[7]));
        }
    }
}

DEV void ret_out_tile(CParams& p, int l, int item, unsigned char* lds) {
    bf16_t* Pb = ws_bf(p, OFF_P); const bf16_t* RVT = ws_bf(p, OFF_RVT);
    const int tid = TIDX(), lane = tid & 63, w = __builtin_amdgcn_readfirstlane(tid >> 6), g = lane >> 4, lc = lane & 15;
    const bool lat = item < 256;
    int b, h, qb, rowc, qi0, c;
    if (lat) { qb = item & 15; h = (item >> 4) & 3; b = item >> 6; c = qb >> 1; rowc = NCTX + b * 2048 + c * 256; qi0 = (qb & 1) * 128; }
    else { const int it = item - 256; qb = it & 1; h = (it >> 1) & 3; b = it >> 3; c = 0; rowc = b * 256; qi0 = qb * 128; }
    const int qi = qi0 + w * 16 + lc;
    const size_t rowq = (size_t)(rowc + qi);
    const float lgf = ret_logg(p, l, 0, h), lgb = ret_logg(p, l, 1, h);
    const int nstep = lat ? 8 : 4;
    auto dma_step = [&](int sI) __attribute__((always_inline)) {
        LAS unsigned char* base = (LAS unsigned char*)lds + (sI & 1) * 49152;
        if (sI < 4) {
#pragma unroll
            for (int i = 0; i < 2; ++i) {
                const int q = w * 2 + i, row = 4 * q + (lane >> 4), lch = (lane & 15) ^ (row & 15);
                __builtin_amdgcn_global_load_lds((const unsigned*)(Pb + (size_t)(rowc + sI * 64 + row) * PW + C_RK + h * 128 + lch * 8), (LAS unsigned*)(base + q * 1024), 16, 0, 0);
            }
#pragma unroll
            for (int i = 0; i < 4; ++i) {
                const int q = w * 4 + i, row = 8 * q + (lane >> 3), lch = (lane & 7) ^ ((row >> 1) & 7);
                __builtin_amdgcn_global_load_lds((const unsigned*)(RVT + (size_t)(h * 256 + row) * M + rowc + sI * 64 + lch * 8), (LAS unsigned*)(base + 16384 + q * 1024), 16, 0, 0);
            }
        } else {
            const int dir = (sI - 4) >> 1, kh = (sI - 4) & 1;
            const bf16_t* Sg = ws_bf(p, OFF_RS) + ((size_t)((b * 4 + h) * 2 + dir) * 8 + c) * 32768;
#pragma unroll
            for (int i = 0; i < 4; ++i) {
                const int q = w * 4 + i, row = 8 * q + (lane >> 3), lch = (lane & 7) ^ ((row >> 1) & 7);
                __builtin_amdgcn_global_load_lds((const unsigned*)(Sg + (size_t)row * 128 + kh * 64 + lch * 8), (LAS unsigned*)(base + 16384 + q * 1024), 16, 0, 0);
            }
        }
    };
    dma_step(0);
    f32x4 acc[16];
#pragma unroll
    for (int df = 0; df < 16; ++df) acc[df] = (f32x4){0.f, 0.f, 0.f, 0.f};
    const int vsw = (lc >> 1) & 7;
    unsigned char* qsave = lds + 98304 + tid * 64;
    {
        bf16x8 qfr[4];
#pragma unroll
        for (int ks = 0; ks < 4; ++ks) { qfr[ks] = *(const bf16x8*)(Pb + rowq * PW + C_RQ + h * 128 + ks * 32 + g * 8); *(bf16x8*)(qsave + ks * 16) = qfr[ks]; }
#pragma unroll 1
        for (int sI = 0; sI < 4; ++sI) {
            asm volatile("s_waitcnt vmcnt(0)" ::: "memory");
            __syncthreads();
            if (sI + 1 < nstep) dma_step(sI + 1);
            const unsigned char* Ks = lds + (sI & 1) * 49152;
            const unsigned char* Vt = Ks + 16384;
            f32x4 sc[4];
#pragma unroll
            for (int kf = 0; kf < 4; ++kf) sc[kf] = (f32x4){0.f, 0.f, 0.f, 0.f};
#pragma unroll
            for (int kb = 0; kb < 2; ++kb) {
                bf16x8 ak[2][4];
#pragma unroll
                for (int k2 = 0; k2 < 2; ++k2)
#pragma unroll
                    for (int kf = 0; kf < 4; ++kf) ak[k2][kf] = *(const bf16x8*)(Ks + (kf * 16 + lc) * 256 + ((((kb * 2 + k2) * 4 + g) ^ lc) << 4));
                __builtin_amdgcn_sched_barrier(0);
#pragma unroll
                for (int k2 = 0; k2 < 2; ++k2)
#pragma unroll
                    for (int kf = 0; kf < 4; ++kf) sc[kf] = __builtin_amdgcn_mfma_f32_16x16x32_bf16(ak[k2][kf], qfr[kb * 2 + k2], sc[kf], 0, 0, 0);
                __builtin_amdgcn_sched_barrier(0);
            }
            bf16x8 pb[2];
#pragma unroll
            for (int kf = 0; kf < 4; ++kf)
#pragma unroll
                for (int r = 0; r < 4; ++r) {
                    const int dd = qi - (sI * 64 + kf * 16 + g * 4 + r);
                    float wgt = 0.f;
                    if (dd >= 0) wgt += __expf(lgf * (float)dd);
                    if (dd <= 0) wgt += __expf(lgb * (float)(-dd));
                    pb[kf >> 1][(kf & 1) * 4 + r] = (short)f2bf(sc[kf][r] * wgt);
                }
#pragma unroll
            for (int s2 = 0; s2 < 2; ++s2)
#pragma unroll
                for (int db = 0; db < 2; ++db) {
                    uint2 lo[8], hi[8];
#pragma unroll
                    for (int j = 0; j < 8; ++j) {
                        const unsigned char* vr = Vt + ((db * 8 + j) * 16 + lc) * 128 + 8 * (g & 1);
                        lo[j] = *(const uint2*)(vr + (((4 * s2 + (g >> 1)) ^ vsw) << 4));
                        hi[j] = *(const uint2*)(vr + (((4 * s2 + 2 + (g >> 1)) ^ vsw) << 4));
                    }
                    __builtin_amdgcn_sched_barrier(0);
#pragma unroll
                    for (int j = 0; j < 8; ++j) {
                        union { uint4 u; bf16x8 v; } av; av.u = make_uint4(lo[j].x, lo[j].y, hi[j].x, hi[j].y);
                        acc[db * 8 + j] = __builtin_amdgcn_mfma_f32_16x16x32_bf16(av.v, pb[s2], acc[db * 8 + j], 0, 0, 0);
                    }
                    __builtin_amdgcn_sched_barrier(0);
                }
        }
    }
    if (lat) {
#pragma unroll 1
        for (int dir = 0; dir < 2; ++dir) {
            const float qs = dir == 0 ? __expf(lgf * (float)(qi + 1)) : __expf(lgb * (float)(256 - qi));
            bf16x8 qx[4];
#pragma unroll
            for (int ks = 0; ks < 4; ++ks) {
                const bf16x8 qv = *(const bf16x8*)(qsave + ks * 16);
#pragma unroll
                for (int e = 0; e < 8; ++e) qx[ks][e] = (short)f2bf(qs * bf2f((bf16_t)qv[e]));
            }
#pragma unroll
            for (int kh = 0; kh < 2; ++kh) {
                const int sI = 4 + dir * 2 + kh;
                asm volatile("s_waitcnt vmcnt(0)" ::: "memory");
                __syncthreads();
                if (sI + 1 < nstep) dma_step(sI + 1);
                const unsigned char* Vt = lds + (sI & 1) * 49152 + 16384;
#pragma unroll
                for (int db = 0; db < 4; ++db) {
                    bf16x8 as0[4], as1[4];
#pragma unroll
                    for (int j = 0; j < 4; ++j) {
                        as0[j] = *(const bf16x8*)(Vt + ((db * 4 + j) * 16 + lc) * 128 + (((0 + g) ^ vsw) << 4));
                        as1[j] = *(const bf16x8*)(Vt + ((db * 4 + j) * 16 + lc) * 128 + (((4 + g) ^ vsw) << 4));
                    }
                    __builtin_amdgcn_sched_barrier(0);
#pragma unroll
                    for (int j = 0; j < 4; ++j) {
                        acc[db * 4 + j] = __builtin_amdgcn_mfma_f32_16x16x32_bf16(as0[j], qx[kh * 2 + 0], acc[db * 4 + j], 0, 0, 0);
                        acc[db * 4 + j] = __builtin_amdgcn_mfma_f32_16x16x32_bf16(as1[j], qx[kh * 2 + 1], acc[db * 4 + j], 0, 0, 0);
                    }
                    __builtin_amdgcn_sched_barrier(0);
                }
            }
        }
    }
    float s1 = 0.f;
#pragma unroll
    for (int df = 0; df < 16; ++df) s1 += (acc[df][0] + acc[df][1]) + (acc[df][2] + acc[df][3]);
    s1 = xrow16_sum(s1);
    const float mu = s1 * (1.f / 256.f);
    float s2 = 0.f;
#pragma unroll
    for (int df = 0; df < 16; ++df)
#pragma unroll
        for (int r = 0; r < 4; ++r) { const float xc = acc[df][r] - mu; s2 += xc * xc; }
    s2 = xrow16_sum(s2);
    const float rstd = rsqrtf(s2 * (1.f / 256.f) + EPS);
#pragma unroll
    for (int df = 0; df < 16; ++df) {
        bf16_t* gp = Pb + rowq * PW + C_RG + h * 256 + df * 16 + g * 4;
        const uint2 gv = *(const uint2*)gp;
        uint2 o;
        o.x = pk2((acc[df][0] - mu) * rstd * __uint_as_float(gv.x << 16), (acc[df][1] - mu) * rstd * __uint_as_float(gv.x & 0xffff0000u));
        o.y = pk2((acc[df][2] - mu) * rstd * __uint_as_float(gv.y << 16), (acc[df][3] - mu) * rstd * __uint_as_float(gv.y & 0xffff0000u));
        *(uint2*)gp = o;
    }
}
DEV void phase_ret_out(CParams& p, int l, unsigned char* lds) {
    if (GDIM() == 256) {
        const int xg = BIDX() & 7, j = BIDX() >> 3;
        ret_out_tile(p, l, ((j >> 1) * 8 + xg) * 2 + (j & 1), lds);
        if (j < 16) ret_out_tile(p, l, 256 + ((j >> 1) * 8 + xg) * 2 + (j & 1), lds);
        return;
    }
    for (int item = BIDX(); item < 384; item += GDIM()) ret_out_tile(p, l, item, lds);
}

template <bool REV>
DEV void lru_scan16(const float (&a)[4][4], const float (&u)[4][4], float cin, int g, int lc, float (&h)[4][4], float& cout, float& Aprod) {
    float carry = cin, Ap = 1.f;
#pragma unroll
    for (int ii = 0; ii < 4; ++ii) {
        const int i = REV ? 3 - ii : ii;
        float hl[4], cp[4];
        {
            float hh = 0.f, cc = 1.f;
#pragma unroll
            for (int rr = 0; rr < 4; ++rr) { const int r = REV ? 3 - rr : rr; hh = a[i][r] * hh + u[i][r]; cc *= a[i][r]; hl[r] = hh; cp[r] = cc; }
        }
        const float As = REV ? cp[0] : cp[3], Hs = REV ? hl[0] : hl[3];
        float Ag[4], Hg[4];
        xrow16_gather(As, Ag); xrow16_gather(Hs, Hg);
        float cur = carry, mine = carry;
#pragma unroll
        for (int sI = 0; sI < 4; ++sI) {
            const int gg = REV ? 3 - sI : sI;
            mine = (g == gg) ? cur : mine;
            cur = Ag[gg] * cur + Hg[gg];
            Ap *= Ag[gg];
        }
        carry = cur;
#pragma unroll
        for (int r = 0; r < 4; ++r) h[i][r] = hl[r] + cp[r] * mine;
    }
    cout = carry; Aprod = Ap;
}

template <bool REV>
DEV void lru_dir(const unsigned char* xa, const bf16x8 (&bA)[4], const bf16x8 (&bX)[4], float ba, float bx, float c2, float cin,
                 const float (&x)[4][4], int g, int lc, float (&h)[4][4], float& cout, float& Ap) {
    f32x4 accA[4], accX[4];
#pragma unroll
    for (int i = 0; i < 4; ++i) { accA[i] = (f32x4){0.f, 0.f, 0.f, 0.f}; accX[i] = (f32x4){0.f, 0.f, 0.f, 0.f}; }
#pragma unroll
    for (int ks = 0; ks < 4; ++ks)
#pragma unroll
        for (int i = 0; i < 4; ++i) {
            const bf16x8 af = *(const bf16x8*)(xa + (i * 16 + lc) * 256 + (((ks * 4 + g) ^ lc) << 4));
            accA[i] = __builtin_amdgcn_mfma_f32_16x16x32_bf16(af, bA[ks], accA[i], 0, 0, 0);
            accX[i] = __builtin_amdgcn_mfma_f32_16x16x32_bf16(af, bX[ks], accX[i], 0, 0, 0);
        }
    float a[4][4], u[4][4];
#pragma unroll
    for (int i = 0; i < 4; ++i)
#pragma unroll
        for (int r = 0; r < 4; ++r) {
            const float rg = sigmf(accA[i][r] + ba), ig = sigmf(accX[i][r] + bx);
            const float av = __builtin_amdgcn_exp2f(rg * c2);
            a[i][r] = av;
            u[i][r] = __builtin_amdgcn_sqrtf(fmaxf(1.f - av * av, 0.f)) * (ig * x[i][r]);
        }
    lru_scan16<REV>(a, u, cin, g, lc, h, cout, Ap);
}

DEV void phase_lru_tiles(CParams& p, int l, int mode, unsigned char* lds) {
    unsigned char* xa = lds; float* hs = (float*)(lds + 16384); float* cwl = (float*)(lds + 49152); unsigned char* rawb = lds + 53248;
    bf16_t* Pb = ws_bf(p, OFF_P);
    const int tid = TIDX(), lane = tid & 63, w = __builtin_amdgcn_readfirstlane(tid >> 6), g = lane >> 4, lc = lane & 15;
    const int blk = BIDX() & 7, gstep = GDIM() >> 3;
    const int cl = w * 16 + lc, ch = blk * 128 + cl;
    for (int e = tid; e < 5 * 128; e += 512) {
        const int j = e >> 7, c = e & 127;
        cwl[e] = j < 4 ? p.conv_w[(size_t)(l * 4 + j) * D + blk * 128 + c] : p.conv_b[(size_t)l * D + blk * 128 + c];
    }
    bf16x8 bAf[4], bXf[4], bAb[4], bXb[4];
    {
        const bf16_t* W = ws_bf(p, OFF_LRUW) + ((size_t)blk * 128 + cl) * 128 + g * 8;
#pragma unroll
        for (int ks = 0; ks < 4; ++ks) {
            bAf[ks] = *(const bf16x8*)(W + ks * 32);
            bXf[ks] = *(const bf16x8*)(W + (size_t)1 * 8 * 16384 + ks * 32);
            bAb[ks] = *(const bf16x8*)(W + (size_t)2 * 8 * 16384 + ks * 32);
            bXb[ks] = *(const bf16x8*)(W + (size_t)3 * 8 * 16384 + ks * 32);
        }
    }
    const float baF = p.lru_ba[(l * 2 + 0) * D + ch], bxF = p.lru_bx[(l * 2 + 0) * D + ch];
    const float baB = p.lru_ba[(l * 2 + 1) * D + ch], bxB = p.lru_bx[(l * 2 + 1) * D + ch];
    const float c2F = -8.f * 1.4426950408889634f * softplusf(-p.lru_lambda[(l * 2 + 0) * D + ch]);
    const float c2B = -8.f * 1.4426950408889634f * softplusf(-p.lru_lambda[(l * 2 + 1) * D + ch]);
    float* LA = (float*)(p.ws + OFF_LRUC);
    float* LH = LA + 192 * 2 * 1024;
    const int chunk = tid & 15, chb = blk * 128 + chunk * 8, trow = tid >> 4;
#define LRU_PREFETCH(gcn) do { const bf16_t* src_ = Pb + (long)((gcn) * 64 - 1 + (lane >> 4)) * (long)PW + C_LX + blk * 128 + (lane & 15) * 8; \
        _Pragma("unroll") for (int q_ = 0; q_ < 3; ++q_) { const int qq_ = w + 8 * q_; if (qq_ < 17) \
            __builtin_amdgcn_global_load_lds((const unsigned*)(src_ + (long)qq_ * 4 * PW), (LAS unsigned*)((LAS unsigned char*)rawb + qq_ * 1024), 16, 0, 0); } } while (0)
    int gc = BIDX() >> 3, gend = 192, gst = gstep;
    if (mode && GDIM() == 256) { const int j = BIDX() >> 3; gc = j < 16 ? j * 5 : 80 + (j - 16) * 7; gend = gc + (j < 16 ? 5 : 7); gst = 1; }
    if (gc < gend) LRU_PREFETCH(gc);
    for (; gc < gend; gc += gst) {
        const int m0 = gc * 64;
        const bool lat = m0 >= NCTX;
        const int L = lat ? 2048 : 256, t0 = lat ? ((m0 - NCTX) & 2047) : (m0 & 255);
        asm volatile("s_waitcnt vmcnt(0)" ::: "memory");
        __syncthreads();
#pragma unroll
        for (int i = 0; i < 2; ++i) {
            const int tt = trow + 32 * i;
            float acc[8];
#pragma unroll
            for (int e = 0; e < 8; ++e) acc[e] = cwl[4 * 128 + chunk * 8 + e];
#pragma unroll
            for (int j = 0; j < 4; ++j) {
                const int tp = t0 + tt + j - 1;
                if (tp >= 0 && tp < L) {
                    const uint4 v = *(const uint4*)(rawb + (tt + j) * 256 + chunk * 16);
                    const float* cw = cwl + j * 128 + chunk * 8;
                    acc[0] += cw[0] * __uint_as_float(v.x << 16); acc[1] += cw[1] * __uint_as_float(v.x & 0xffff0000u);
                    acc[2] += cw[2] * __uint_as_float(v.y << 16); acc[3] += cw[3] * __uint_as_float(v.y & 0xffff0000u);
                    acc[4] += cw[4] * __uint_as_float(v.z << 16); acc[5] += cw[5] * __uint_as_float(v.z & 0xffff0000u);
                    acc[6] += cw[6] * __uint_as_float(v.w << 16); acc[7] += cw[7] * __uint_as_float(v.w & 0xffff0000u);
                }
            }
            uint4 o;
            o.x = pk2(acc[0], acc[1]); o.y = pk2(acc[2], acc[3]);
            o.z = pk2(acc[4], acc[5]); o.w = pk2(acc[6], acc[7]);
            *(uint4*)(xa + tt * 256 + ((chunk ^ (tt & 15)) << 4)) = o;
        }
        __syncthreads();
        if (gc + gst < gend) LRU_PREFETCH(gc + gst);
        const size_t ci = ((size_t)gc * 2) * 1024 + ch;
        const float cinF = mode ? LH[ci] : 0.f, cinB = mode ? LH[ci + 1024] : 0.f;
        uint4 gv[2];
        if (mode) {
#pragma unroll
            for (int i = 0; i < 2; ++i) gv[i] = *(const uint4*)(Pb + (size_t)(m0 + trow + 32 * i) * PW + C_LG + chb);
        }
        {
            float x[4][4];
#pragma unroll
            for (int i = 0; i < 4; ++i)
#pragma unroll
                for (int r = 0; r < 4; ++r) {
                    const int tok = i * 16 + g * 4 + r;
                    x[i][r] = bf2f(*(const bf16_t*)(xa + tok * 256 + (((cl >> 3) ^ (tok & 15)) << 4) + (cl & 7) * 2));
                }
            float h[4][4], cout, Ap;
            lru_dir<false>(xa, bAf, bXf, baF, bxF, c2F, cinF, x, g, lc, h, cout, Ap);
            if (!mode) { if (g == 0) { LA[ci] = Ap; LH[ci] = cout; } }
            else {
#pragma unroll
                for (int i = 0; i < 4; ++i)
#pragma unroll
                    for (int r = 0; r < 4; ++r) hs[(i * 16 + g * 4 + r) * 128 + cl] = h[i][r];
                if (!lat && g == 0 && t0 == 192) p.out[O_NLRU + ((size_t)((m0 >> 8) * 2 + l) * 2 + 0) * 1024 + ch] = cout;
            }
            lru_dir<true>(xa, bAb, bXb, baB, bxB, c2B, cinB, x, g, lc, h, cout, Ap);
            if (!mode) { if (g == 0) { LA[ci + 1024] = Ap; LH[ci + 1024] = cout; } }
            else {
#pragma unroll
                for (int i = 0; i < 4; ++i)
#pragma unroll
                    for (int r = 0; r < 4; ++r) hs[(i * 16 + g * 4 + r) * 128 + cl] += h[i][r];
                if (!lat && g == 0 && t0 == 0) p.out[O_NLRU + ((size_t)((m0 >> 8) * 2 + l) * 2 + 1) * 1024 + ch] = cout;
            }
        }
        if (mode) {
            __syncthreads();
#pragma unroll
            for (int i = 0; i < 2; ++i) {
                const int tt = trow + 32 * i, c8 = chunk * 8;
                const float4 h0 = *(const float4*)(hs + tt * 128 + c8), h1 = *(const float4*)(hs + tt * 128 + c8 + 4);
                uint4 o;
                o.x = pk2(h0.x * __uint_as_float(gv[i].x << 16), h0.y * __uint_as_float(gv[i].x & 0xffff0000u));
                o.y = pk2(h0.z * __uint_as_float(gv[i].y << 16), h0.w * __uint_as_float(gv[i].y & 0xffff0000u));
                o.z = pk2(h1.x * __uint_as_float(gv[i].z << 16), h1.y * __uint_as_float(gv[i].z & 0xffff0000u));
                o.w = pk2(h1.z * __uint_as_float(gv[i].w << 16), h1.w * __uint_as_float(gv[i].w & 0xffff0000u));
                *(uint4*)(Pb + (size_t)(m0 + tt) * PW + C_LG + chb) = o;
            }
        }
    }
    asm volatile("s_waitcnt vmcnt(0)" ::: "memory");
    __syncthreads();
#undef LRU_PREFETCH
}

DEV void phase_lru_carry(CParams& p, int l, int vb, int nvb) {
    float* LA = (float*)(p.ws + OFF_LRUC);
    float* LH = LA + 192 * 2 * 1024;
    const int gt = vb * 512 + TIDX(), gs = nvb * 512;
    for (int idx = gt; idx < 20 * 2 * 1024; idx += gs) {
        const int ch = idx & 1023, dir = (idx >> 10) & 1, seq = idx >> 11;
        const bool lat = seq >= 16;
        const int nch = lat ? 32 : 4;
        const int gc0 = lat ? 64 + (seq - 16) * 32 : seq * 4;
        float carry = lat ? p.state_lru[((size_t)((seq - 16) * 2 + l) * 2 + dir) * 1024 + ch] : 0.f;
        for (int s0 = 0; s0 < nch; s0 += 4) {
            float A[4], Hh[4]; size_t ci[4];
#pragma unroll
            for (int k = 0; k < 4; ++k) {
                const int sI = s0 + k, cidx = dir == 0 ? sI : nch - 1 - sI;
                ci[k] = ((size_t)(gc0 + cidx) * 2 + dir) * 1024 + ch;
                A[k] = LA[ci[k]]; Hh[k] = LH[ci[k]];
            }
#pragma unroll
            for (int k = 0; k < 4; ++k) { LH[ci[k]] = carry; carry = A[k] * carry + Hh[k]; }
        }
    }
}

DEV CParams* KARGS() { CParams* kp = (CParams*)__builtin_amdgcn_kernarg_segment_ptr(); asm volatile("" : "+s"(kp)); return kp; }

#define XB_TMO      128
#define XB_XCNT(j)  (256  + 64 * (j))
#define XB_XSUB(j)  (1280 + 64 * (j))
#define XB_XGEN(j)  (2304 + 64 * (j))
#define XB_TOP      3328
#define XB_TOPGEN   3392
#define XCD_BAR_WORDS 3456
#define XB_SPIN_CAP (1u << 18)
DEV unsigned xb_ld(unsigned* p)              { return __hip_atomic_load(p, __ATOMIC_RELAXED, __HIP_MEMORY_SCOPE_AGENT); }
DEV unsigned xb_add(unsigned* p, unsigned v) { return __hip_atomic_fetch_add(p, v, __ATOMIC_RELAXED, __HIP_MEMORY_SCOPE_AGENT); }
DEV unsigned xb_xcc_id() { return (unsigned)__builtin_amdgcn_s_getreg((3 << 11) | 20) & 0xFu; }
#define XB_SPIN(cond, bar) do { unsigned _sp = 0; while (cond) { __builtin_amdgcn_s_sleep(1); \
    if ((++_sp & 255u) == 0u) { if (xb_ld(&(bar)[XB_TMO])) break; if (_sp > XB_SPIN_CAP) { atomicAdd(&(bar)[XB_TMO], 1u); break; } } } } while (0)
struct XcdBarrier { unsigned* bar; unsigned x; volatile LAS unsigned* st; };
DEV XcdBarrier xcd_barrier_post(unsigned* bar, volatile LAS unsigned* st) {
    XcdBarrier b; b.bar = bar; b.x = xb_xcc_id(); b.st = st;
    if (threadIdx.x == 0) (void)xb_add(&bar[XB_XCNT(b.x)], 1u);
    return b;
}
DEV void xcd_barrier_complete(unsigned* bar, unsigned x, unsigned& nloc, unsigned& nx) {
    const unsigned G = gridDim.x * gridDim.y * gridDim.z;
    unsigned sum, cnt, mine, sp = 0u;
    for (;;) {
        sum = 0u; cnt = 0u; mine = 0u;
#pragma unroll
        for (unsigned j = 0; j < 16; ++j) { const unsigned c = xb_ld(&bar[XB_XCNT(j)]); sum += c; cnt += (c > 0u) ? 1u : 0u; mine = (j == x) ? c : mine; }
        if (sum == G) break;
        __builtin_amdgcn_s_sleep(1);
        if ((++sp & 255u) == 0u) { if (xb_ld(&bar[XB_TMO])) break; if (sp > XB_SPIN_CAP) { atomicAdd(&bar[XB_TMO], 1u); break; } }
    }
    nloc = mine > 0u ? mine : 1u; nx = cnt > 0u ? cnt : 1u;
}
DEV void xcd_barrier(const XcdBarrier& b0) {
    asm volatile("s_waitcnt vmcnt(0)" ::: "memory");
    __syncthreads();
    if (threadIdx.x == 0) {
        XcdBarrier b; b.x = b0.x; b.st = b0.st;
        asm volatile("" : "+s"(b.x));
        unsigned* bar = (unsigned*)(KARGS()->ws + OFF_BAR);
        __builtin_amdgcn_s_waitcnt(0);
        unsigned nloc = b.st[0], nx = b.st[1];
        if (nloc == 0u) { xcd_barrier_complete(bar, b.x, nloc, nx); b.st[0] = nloc; b.st[1] = nx; }
        const unsigned old = xb_add(&bar[XB_XSUB(b.x)], 1u);
        const unsigned gen = old / nloc;
        if (old + 1u == (gen + 1u) * nloc) {
            __builtin_amdgcn_fence(__ATOMIC_RELEASE, "agent");
            asm volatile("s_waitcnt vmcnt(0)" ::: "memory");
            const unsigned og = xb_add(&bar[XB_TOP], 1u);
            const unsigned tg = og / nx;
            if (og + 1u == (tg + 1u) * nx) xb_add(&bar[XB_TOPGEN], 1u);
            else XB_SPIN(xb_ld(&bar[XB_TOPGEN]) == tg, bar);
            __builtin_amdgcn_fence(__ATOMIC_ACQUIRE, "agent");
            xb_add(&bar[XB_XGEN(b.x)], 1u);
            asm volatile("s_waitcnt vmcnt(0)" ::: "memory");
        } else {
            XB_SPIN(xb_ld(&bar[XB_XGEN(b.x)]) == gen, bar);
            __builtin_amdgcn_fence(__ATOMIC_ACQUIRE, "agent");
            asm volatile("s_waitcnt vmcnt(0)" ::: "memory");
        }
    }
    __syncthreads();
}

enum { PH_INIT = 0, PH_PRENORM, PH_GEMM1, PH_MIX1, PH_MIX2, PH_MIX3, PH_MERGE, PH_MERGE2, PH_OUT, PH_COUNT };

DEV void run_phase(CParams& p, int ph, int l, unsigned char* lds) {
    switch (ph) {
    case PH_INIT:    phase_mod(p, (float*)lds); phase_rope_table(p); __syncthreads(); phase_convert(p, 0, (float*)lds); break;
    case PH_PRENORM: phase_prenorm(p, l); break;
    case PH_GEMM1:   phase8_gemm1(p, l, (LAS unsigned char*)lds); break;
    case PH_MIX1:    phase_attn(p, l, lds); __syncthreads(); phase_lru_tiles(p, l, 0, lds); __syncthreads(); phase_ret_kv(p, l, lds); break;
    case PH_MIX2:
        if (GDIM() == 256) {
            if (BIDX() < 192) phase8_merge(p, l, 2, (LAS unsigned char*)lds);
            else { phase_lru_carry(p, l, BIDX() - 192, 64); phase_ret_scan(p, l, BIDX() - 192, 64); }
        } else { phase_lru_carry(p, l, BIDX(), GDIM()); phase_ret_scan(p, l, BIDX(), GDIM()); }
        if (l == 1) phase_convert(p, 1, (float*)lds, 2);
        break;
    case PH_MIX3:    phase_lru_tiles(p, l, 1, lds); __syncthreads(); phase_ret_out(p, l, lds); break;
    case PH_MERGE:   phase8_merge(p, l, 0, (LAS unsigned char*)lds); break;
    case PH_MERGE2:  phase8_merge(p, l, 1, (LAS unsigned char*)lds); break;
    case PH_OUT:     phase8_out(p, l, (LAS unsigned char*)lds); if (l == 0) phase_convert(p, 1, (float*)lds, 1, 192); break;
    }
}

#if !ONE_LAUNCH
__global__ void __launch_bounds__(512, 2) phase_kernel(Params p, int ph, int l) {
    extern __shared__ __attribute__((aligned(16))) unsigned char dsm[];
    run_phase(p, ph, l, dsm);
}
#else
#ifndef PROBE_MASK
#define PROBE_MASK 0
#endif
#define PROBE_MULT 8
__global__ void __launch_bounds__(512, 2) mega_kernel(Params p) {
    extern __shared__ __attribute__((aligned(16))) unsigned char dsm[];
    cg::grid_group grid = cg::this_grid();
    volatile LAS unsigned* st = (volatile LAS unsigned*)((LAS unsigned char*)dsm + g8::STAGE_BYTES);
    if (threadIdx.x < 4) st[threadIdx.x] = 0u;
    __syncthreads();
    const XcdBarrier xb = xcd_barrier_post((unsigned*)(KARGS()->ws + OFF_BAR), st);
#define GSYNC() xcd_barrier(xb)
#if PROBE_MASK
    long long t_acc = 0, t0 = 0;
#define PROBE_BEGIN(ph) if ((PROBE_MASK >> (ph)) & 1) t0 = wall_clock64();
#define PROBE_END(ph) if ((PROBE_MASK >> (ph)) & 1) t_acc += wall_clock64() - t0;
#else
#define PROBE_BEGIN(ph)
#define PROBE_END(ph)
#endif
    if (KARGS()->out == nullptr) grid.sync();
    PROBE_BEGIN(PH_INIT) run_phase(*KARGS(), PH_INIT, 0, dsm); GSYNC(); PROBE_END(PH_INIT)
    PROBE_BEGIN(PH_PRENORM) run_phase(*KARGS(), PH_PRENORM, 0, dsm); GSYNC(); PROBE_END(PH_PRENORM)
    for (int l = 0; l < 2; ++l) {
        for (int ph = PH_GEMM1; ph <= PH_OUT; ++ph) {
            PROBE_BEGIN(ph)
            run_phase(*KARGS(), ph, l, dsm);
            if (!(l == 1 && ph == PH_OUT)) GSYNC();
            PROBE_END(ph)
        }
    }
#if PROBE_MASK
    if (blockIdx.x == 0 && threadIdx.x == 0) {
        const long long tgt = wall_clock64() + (long long)PROBE_MULT * t_acc;
        while (wall_clock64() < tgt) __builtin_amdgcn_s_sleep(8);
    }
#endif
}
#endif

extern "C" void kernel_launch(void* const* d_in, const int* in_sizes, int n_in,
                              void* d_out, int out_size, void* d_ws, size_t ws_size,
                              hipStream_t stream) {
    constexpr size_t kDynLds = LDS_XOFF + 5120;
    static int grid_blocks = 0;
    if (grid_blocks == 0) {
        if (n_in != 26 || ws_size < WS_NEED || out_size != 25231360) {
            fprintf(stderr, "kernel_launch: unexpected n_in %d / ws_size %zu (need %zu) / out_size %d\n", n_in, ws_size, (size_t)WS_NEED, out_size);
            grid_blocks = -1; return;
        }
        int dev = 0, cus = 0, per_cu = 0;
        (void)hipGetDevice(&dev);
        (void)hipDeviceGetAttribute(&cus, hipDeviceAttributeMultiprocessorCount, dev);
#if ONE_LAUNCH
        const void* kfn = (const void*)mega_kernel;
#else
        const void* kfn = (const void*)phase_kernel;
#endif
        if (hipFuncSetAttribute(kfn, hipFuncAttributeMaxDynamicSharedMemorySize, (int)kDynLds) != hipSuccess) {
            fprintf(stderr, "kernel_launch: hipFuncSetAttribute failed\n"); grid_blocks = -1; return;
        }
        if (hipOccupancyMaxActiveBlocksPerMultiprocessor(&per_cu, kfn, 512, kDynLds) != hipSuccess || per_cu < 1) {
            fprintf(stderr, "kernel_launch: occupancy query says %d blocks per CU\n", per_cu); grid_blocks = -1; return;
        }
        grid_blocks = cus & ~7;
    }
    if (grid_blocks < 0) return;
    Params p{};
    const float** pp = (const float**)&p;
    for (int i = 0; i < 26; ++i) pp[i] = (const float*)d_in[i];
    p.out = (float*)d_out;
    p.ws = (unsigned char*)d_ws;
#if ONE_LAUNCH
    (void)hipMemsetAsync((unsigned char*)d_ws + OFF_BAR, 0, 16384 + 1024, stream);
    void* args[] = {&p};
    hipError_t e = hipLaunchCooperativeKernel((const void*)mega_kernel, dim3(grid_blocks), dim3(512), args, kDynLds, stream);
    if (e != hipSuccess) fprintf(stderr, "cooperative launch failed: %s (grid %d)\n", hipGetErrorString(e), grid_blocks);
#else
    phase_kernel<<<grid_blocks, 512, kDynLds, stream>>>(p, PH_INIT, 0);
    phase_kernel<<<grid_blocks, 512, kDynLds, stream>>>(p, PH_PRENORM, 0);
    for (int l = 0; l < 2; ++l)
        for (int ph = PH_GEMM1; ph <= PH_OUT; ++ph)
            phase_kernel<<<grid_blocks, 512, kDynLds, stream>>>(p, ph, l);
#endif
}
```

```cpp
#include <hip/hip_runtime.h>
#include <hip/hip_cooperative_groups.h>
#include <cstdio>
#include <cstdint>
namespace cg = cooperative_groups;

#ifndef ONE_LAUNCH
#define ONE_LAUNCH 1
#endif

typedef unsigned short bf16_t;
#define DEV __device__ __forceinline__

constexpr int D = 1024;
constexpr int NCTX = 4096;
constexpr int NLAT = 8192;
constexpr int M = NCTX + NLAT;
constexpr int NW = 7680;
constexpr int N_RQ = 0, N_RK = 512, N_RV = 1024, N_RG = 2048, N_LX = 3072, N_LG = 4096,
              N_AQ = 5120, N_AK = 6144, N_AV = 6400, N_AG = 6656;
constexpr int PW = 6656;
constexpr int C_RQ = 0, C_RK = 512, C_RG = 1024, C_LX = 2048, C_LG = 3072,
              C_AQ = 4096, C_AK = 5120, C_AV = 5376, C_AG = 5632;
constexpr float EPS = 1e-6f;

constexpr size_t O_YP = 0, O_YS = 4194304, O_NK = 12582912, O_NV = 14680064, O_NRET = 16777216, O_NLRU = 25165824;

constexpr size_t OFF_MOD  = 0;
constexpr size_t OFF_LRUW = 122880;
constexpr size_t OFF_WBR  = OFF_LRUW + 1048576;
constexpr size_t OFF_WOUT = OFF_WBR + 6291456;
constexpr size_t OFF_WMG  = OFF_WOUT + 2097152;
constexpr size_t OFF_H    = OFF_WMG + 6291456;
constexpr size_t OFF_P    = OFF_H + (size_t)M * 1024 * 2;
constexpr size_t OFF_RVT  = OFF_P + (size_t)M * PW * 2;
constexpr size_t OFF_W1T  = OFF_RVT + (size_t)1024 * M * 2;
constexpr size_t OFF_OFTMP = OFF_W1T;
constexpr size_t OFF_LRUC = 262266880;
constexpr size_t OFF_ROPE = OFF_LRUC + (size_t)2 * 192 * 2 * 1024 * 4;
constexpr size_t OFF_BAR  = OFF_ROPE + (size_t)2048 * 96 * 8;
constexpr size_t OFF_XC   = OFF_BAR + 16384;
constexpr size_t OFF_XP   = OFF_XC + 1024;
constexpr size_t WS_NEED  = OFF_XP + 983040;
constexpr int LDS_XOFF = 131072 + 64;
static_assert(OFF_OFTMP + (size_t)M * 1024 * 2 <= OFF_LRUC, "overlap");
static_assert(WS_NEED <= 268435456, "ws budget");

struct Params;
typedef const __attribute__((address_space(4))) Params CParams;
struct Params {
    const float *x_prompt, *x_sample, *cache_k, *cache_v, *state_ret, *state_lru, *c, *c_ctx,
                *w_ada, *b_ada, *norm_pre, *norm_post, *w_in, *ret_decay, *conv_w, *conv_b,
                *lru_wa, *lru_ba, *lru_wx, *lru_bx, *lru_lambda, *att_sink, *w_branch, *w_merge, *b_merge, *w_out;
    float* out;
    unsigned char* ws;
};

DEV int BIDX() { int b = (int)blockIdx.x; asm volatile("" : "+s"(b)); return b; }
DEV int GDIM() { int g = (int)gridDim.x; asm volatile("" : "+s"(g)); return g; }
DEV int TIDX() { int t = threadIdx.x; asm volatile("" : "+v"(t)); return t; }
DEV float bf2f(bf16_t v) { return __uint_as_float(((unsigned)v) << 16); }
typedef __bf16 bf16x2_t __attribute__((ext_vector_type(2)));
DEV bf16_t f2bf(float f) { return __builtin_bit_cast(unsigned short, (__bf16)f); }
DEV unsigned pk2(float lo, float hi) { bf16x2_t v; v[0] = (__bf16)lo; v[1] = (__bf16)hi; return __builtin_bit_cast(unsigned, v); }
DEV float sigmf(float z) { return __builtin_amdgcn_rcpf(1.f + __builtin_amdgcn_exp2f(-1.4426950408889634f * z)); }
DEV float siluf(float x) { return x * sigmf(x); }
DEV float softplusf(float x) { return fmaxf(x, 0.f) + log1pf(__expf(-fabsf(x))); }

DEV float* ws_mod(CParams& p) { return (float*)(p.ws + OFF_MOD); }
DEV bf16_t* ws_bf(CParams& p, size_t off) { return (bf16_t*)(p.ws + off); }

DEV const float* x_row(CParams& p, int l, int m) {
    const float* xp = p.x_prompt; const float* xs = p.x_sample; const float* po = p.out;
    if (l == 0) return m < NCTX ? xp + (size_t)m * D : xs + (size_t)(m - NCTX) * D;
    return po + (size_t)m * D;
}
DEV int cond_row(int m) { return m < NCTX ? 0 : 1 + ((m - NCTX) >> 11); }

DEV float wave_sum(float v) {
#pragma unroll
    for (int o = 1; o < 64; o <<= 1) v += __shfl_xor(v, o);
    return v;
}
DEV float xrow16_max(float x) {
    auto s = __builtin_amdgcn_permlane16_swap(__float_as_uint(x), __float_as_uint(x), false, false);
    x = fmaxf(__uint_as_float(s[0]), __uint_as_float(s[1]));
    auto t = __builtin_amdgcn_permlane32_swap(__float_as_uint(x), __float_as_uint(x), false, false);
    return fmaxf(__uint_as_float(t[0]), __uint_as_float(t[1]));
}
DEV float xrow16_sum(float x) {
    auto s = __builtin_amdgcn_permlane16_swap(__float_as_uint(x), __float_as_uint(x), false, false);
    x = __uint_as_float(s[0]) + __uint_as_float(s[1]);
    auto t = __builtin_amdgcn_permlane32_swap(__float_as_uint(x), __float_as_uint(x), false, false);
    return __uint_as_float(t[0]) + __uint_as_float(t[1]);
}
DEV void xrow16_gather(float x, float (&v)[4]) {
    auto s = __builtin_amdgcn_permlane16_swap(__float_as_uint(x), __float_as_uint(x), false, false);
    auto e = __builtin_amdgcn_permlane32_swap(s[0], s[0], false, false);
    auto o = __builtin_amdgcn_permlane32_swap(s[1], s[1], false, false);
    v[0] = __uint_as_float(e[0]); v[1] = __uint_as_float(o[0]); v[2] = __uint_as_float(e[1]); v[3] = __uint_as_float(o[1]);
}
DEV void phase_mod(CParams& p, float* lds) {
    float* mod = ws_mod(p);
    float* sl = lds;
    float* part = lds + 1024;
    unsigned* lastf = (unsigned*)(lds + 1024 + 8 * 5 * 256);
    const int tid = TIDX(), lane = tid & 63, w = tid >> 6;
    const float* cctx = p.c_ctx; const float* cb_ = p.c;
    unsigned* MPu = (unsigned*)(p.ws + OFF_XP);
    unsigned* cnt = (unsigned*)(p.ws + OFF_XC) + 192;
    for (int unit = BIDX(); unit < 192; unit += GDIM()) {
        const int ks = unit & 7, cbk = (unit >> 3) % 12, l = unit / 96;
        __syncthreads();
        for (int e = tid; e < 5 * 128; e += 512) { const int r = e >> 7, k = ks * 128 + (e & 127); sl[e] = siluf(r == 0 ? cctx[k] : cb_[(r - 1) * D + k]); }
        __syncthreads();
        const float* wp = p.w_ada + ((size_t)l * D + ks * 128 + w * 16) * 3072 + cbk * 256 + lane * 4;
        float4 acc[5];
#pragma unroll
        for (int r = 0; r < 5; ++r) acc[r] = make_float4(0.f, 0.f, 0.f, 0.f);
#pragma unroll
        for (int k = 0; k < 16; ++k) {
            const float4 wv = *(const float4*)(wp + (size_t)k * 3072);
#pragma unroll
            for (int r = 0; r < 5; ++r) { const float sv = sl[r * 128 + w * 16 + k]; acc[r].x += sv * wv.x; acc[r].y += sv * wv.y; acc[r].z += sv * wv.z; acc[r].w += sv * wv.w; }
        }
#pragma unroll
        for (int r = 0; r < 5; ++r) *(float4*)(part + (w * 5 + r) * 256 + lane * 4) = acc[r];
        __syncthreads();
        unsigned* mp = MPu + (size_t)((l * 12 + cbk) * 8 + ks) * 1280;
        for (int e = tid; e < 1280; e += 512) {
            float v = 0.f;
#pragma unroll
            for (int q = 0; q < 8; ++q) v += part[q * 1280 + e];
            __hip_atomic_store(mp + e, __float_as_uint(v), __ATOMIC_RELAXED, __HIP_MEMORY_SCOPE_AGENT);
        }
        asm volatile("s_waitcnt vmcnt(0)" ::: "memory");
        __syncthreads();
        if (tid == 0) {
            const unsigned old = __hip_atomic_fetch_add(cnt + l * 12 + cbk, 1u, __ATOMIC_RELAXED, __HIP_MEMORY_SCOPE_AGENT);
            if (old == 7u) { __builtin_amdgcn_fence(__ATOMIC_ACQUIRE, "agent"); asm volatile("s_waitcnt vmcnt(0)" ::: "memory"); }
            *lastf = old == 7u ? 1u : 0u;
        }
        __syncthreads();
        if (*lastf) {
            const unsigned* m0 = MPu + (size_t)((l * 12 + cbk) * 8) * 1280;
            for (int e = tid; e < 1280; e += 512) {
                const int r = e >> 8, j = cbk * 256 + (e & 255);
                float v = p.b_ada[l * 3072 + j];
#pragma unroll
                for (int q = 0; q < 8; ++q) v += __uint_as_float(__hip_atomic_load(m0 + q * 1280 + e, __ATOMIC_RELAXED, __HIP_MEMORY_SCOPE_AGENT));
                mod[(size_t)(l * 5 + r) * 3072 + j] = v;
            }
        }
    }
    __syncthreads();
}

DEV void phase_rope_table(CParams& p) {
    float2* tab = (float2*)(p.ws + OFF_ROPE);
    const int gt = BIDX() * blockDim.x + TIDX(), gs = GDIM() * blockDim.x;
    for (int idx = gt; idx < 2048 * 96; idx += gs) {
        const int t = idx / 96, e = idx % 96;
        int a, c; float nq;
        if (e < 64) { a = e >> 5; c = e & 31; nq = 32.f; } else { a = (e - 64) >> 4; c = (e - 64) & 15; nq = 16.f; }
        const float pos = (float)(a ? (t & 63) : (t >> 6));
        const float inv = powf(10000.f, -(float)c / nq);
        float sn, cs; sincosf(pos * inv, &sn, &cs);
        tab[idx] = make_float2(cs, sn);
    }
}

DEV int w1t_row(int n) {
    if (n < N_RV) return (n & ~48) | ((n & 16) << 1) | ((n & 32) >> 1);
    if (n < N_RG) return PW + (n - N_RV);
    return n - 1024;
}
struct ConvTile { const float* src; bf16_t* dst; int N, K, k0, n0; bool w1; };
DEV void conv_load(const ConvTile& t, float4 (&v)[2]) {
    const int tid = TIDX();
#pragma unroll
    for (int i = 0; i < 2; ++i) v[i] = *(const float4*)(t.src + (size_t)(t.k0 + (tid >> 4) + 32 * i) * t.N + t.n0 + (tid & 15) * 4);
}
DEV void conv_park(const float4 (&v)[2], float* tile) {
    const int tid = TIDX();
#pragma unroll
    for (int i = 0; i < 2; ++i) {
        float* d = tile + ((tid >> 4) + 32 * i) * 65 + (tid & 15) * 4;
        d[0] = v[i].x; d[1] = v[i].y; d[2] = v[i].z; d[3] = v[i].w;
    }
}
DEV void conv_store(const ConvTile& t, const float* tile) {
    const int tid = TIDX();
    const int n = tid >> 3, kc = tid & 7;
    const int dr = t.w1 ? w1t_row(t.n0 + n) : t.n0 + n;
    const float* s = tile + (kc * 8) * 65 + n;
    uint4 o;
    o.x = pk2(s[0], s[65]);       o.y = pk2(s[130], s[195]);
    o.z = pk2(s[260], s[325]);    o.w = pk2(s[390], s[455]);
    *(uint4*)(t.dst + (size_t)dr * t.K + t.k0 + kc * 8) = o;
}
DEV void conv_tile(CParams& p, int l, int r, int set, ConvTile& t) {
    constexpr int T_IN = 16 * 120, T_MG = 16 * 48, T_BR = 3 * 256;
    t.K = D; t.w1 = false;
    if (set == 0) {
        if (r < T_IN) { t.src = p.w_in + (size_t)l * D * NW; t.N = NW; t.dst = ws_bf(p, OFF_W1T); t.k0 = (r / 120) * 64; t.n0 = (r % 120) * 64; t.w1 = true; return; }
        r -= T_IN;
        const int mat = r / 4, q = r % 4;
        const int dir = mat >> 4, gate = (mat >> 3) & 1, blk = mat & 7;
        const float* wa_ = p.lru_wa; const float* wx_ = p.lru_wx;
        t.src = (gate ? wx_ : wa_) + (((size_t)l * 2 + dir) * 8 + blk) * 128 * 128; t.N = 128; t.K = 128;
        t.dst = ws_bf(p, OFF_LRUW) + (size_t)mat * 128 * 128; t.k0 = (q >> 1) * 64; t.n0 = (q & 1) * 64;
        return;
    }
    if (r < T_MG) { t.src = p.w_merge + (size_t)l * D * 3072; t.N = 3072; t.dst = ws_bf(p, OFF_WMG); t.k0 = (r / 48) * 64; t.n0 = (r % 48) * 64; return; }
    r -= T_MG;
    if (r < T_BR) { const int nb = r / 256, q = r % 256;
        t.src = p.w_branch + ((size_t)l * 3 + nb) * D * D; t.N = D; t.dst = ws_bf(p, OFF_WBR) + (size_t)nb * D * D; t.k0 = (q / 16) * 64; t.n0 = (q % 16) * 64; return; }
    r -= T_BR;
    t.src = p.w_out + (size_t)l * D * D; t.N = D; t.dst = ws_bf(p, OFF_WOUT); t.k0 = (r / 16) * 64; t.n0 = (r % 16) * 64;
}
DEV void phase_convert(CParams& p, int l, float* tile, int set, int vb, int nvb) {
    const int count = set == 0 ? 16 * 120 + 32 * 4 : 16 * 48 + 3 * 256 + 256;
    for (int it = vb; it < count; it += 4 * nvb) {
        ConvTile t[4]; float4 v[4][2];
#pragma unroll
        for (int j = 0; j < 4; ++j) {
            const bool on = it + j * nvb < count;
            conv_tile(p, l, on ? it + j * nvb : it, set, t[j]);
            if (on) conv_load(t[j], v[j]);
        }
#pragma unroll
        for (int j = 0; j < 4; ++j) if (it + j * nvb < count) conv_park(v[j], tile + j * 4224);
        __syncthreads();
#pragma unroll
        for (int j = 0; j < 4; ++j) if (it + j * nvb < count) conv_store(t[j], tile + j * 4224);
        __syncthreads();
    }
}

DEV void prenorm_row(CParams& p, int l, int m, const float4 (&v)[4], int lane) {
    float ss = 0.f;
#pragma unroll
    for (int j = 0; j < 4; ++j) ss += (v[j].x * v[j].x + v[j].y * v[j].y) + (v[j].z * v[j].z + v[j].w * v[j].w);
    ss = wave_sum(ss);
    const float rstd = rsqrtf(ss * (1.f / D) + EPS);
    const float* mod = ws_mod(p) + (size_t)(l * 5 + cond_row(m)) * 3072;
    bf16_t* h = ws_bf(p, OFF_H) + (size_t)m * D;
#pragma unroll
    for (int j = 0; j < 4; ++j) {
        const int i4 = lane + 64 * j;
        const float4 g = ((const float4*)(p.norm_pre + l * D))[i4];
        const float4 sh = ((const float4*)mod)[i4];
        const float4 sc = ((const float4*)(mod + 1024))[i4];
        ushort4 o;
        o.x = f2bf(v[j].x * rstd * g.x * (1.f + sc.x) + sh.x);
        o.y = f2bf(v[j].y * rstd * g.y * (1.f + sc.y) + sh.y);
        o.z = f2bf(v[j].z * rstd * g.z * (1.f + sc.z) + sh.z);
        o.w = f2bf(v[j].w * rstd * g.w * (1.f + sc.w) + sh.w);
        ((ushort4*)h)[i4] = o;
    }
}
DEV void phase_prenorm(CParams& p, int l) {
    const int tid = TIDX(), lane = tid & 63;
    for (int m = BIDX() * 8 + (tid >> 6); m < M; m += GDIM() * 8) {
        const float4* xr = (const float4*)x_row(p, l, m);
        float4 v[4];
#pragma unroll
        for (int j = 0; j < 4; ++j) v[j] = xr[lane + 64 * j];
        prenorm_row(p, l, m, v, lane);
    }
}

typedef short bf16x8 __attribute__((ext_vector_type(8)));
typedef float f32x4 __attribute__((ext_vector_type(4)));
typedef short v4i16_t __attribute__((ext_vector_type(4)));
#define LAS __attribute__((address_space(3)))
namespace g8 {
constexpr int BK = 64, HALF = 128, HTB = HALF * BK * 2, STAGE_BYTES = 8 * HTB;
DEV int lds_byte(int r, int c) { const int st = (r >> 4) * 2 + (c >> 5), rr = r & 15, cc = c & 31, ob = rr * 64 + cc * 2; return st * 1024 + (ob ^ (((ob >> 9) & 1) << 5)); }
DEV void stage_rc(int b, int& R, int& C) { const int st = b / 1024, sb = b % 1024, swz = sb ^ (((sb >> 9) & 1) << 5); R = (st >> 1) * 16 + swz / 64; C = (st & 1) * 32 + (swz % 64) / 2; }
struct Unit { const char* a; const char* b; int kind, pm, pn; unsigned lda; };

template <class Sched, class Epi>
DEV void gemm_phase(LAS unsigned char* lds, const unsigned ldb, const int nt, const Sched& S, const Epi& E) {
    const int tid = TIDX(), wid = __builtin_amdgcn_readfirstlane(tid >> 6), lane = tid & 63, wr = wid >> 2, wc = wid & 3, fr = lane & 15, fq = lane >> 4;
    unsigned rowA[2], colA[2], voffB[2];
#pragma unroll
    for (int i = 0; i < 2; ++i) { int R, C; stage_rc(tid * 16 + i * 8192, R, C); rowA[i] = (unsigned)R; colA[i] = (unsigned)C * 2u; voffB[i] = (unsigned)R * ldb + (unsigned)C * 2u; }
    const size_t kstep = (size_t)(BK * 2);
    const size_t hstepB = (size_t)HALF * ldb;
    const unsigned ldsw = (unsigned)wid * 1024u;
    const int aoff = lds_byte(wr * 64 + fr, fq * 8), boff = lds_byte(wc * 32 + fr, fq * 8);
#define G8_SA(b, h) (((b) * 2 + (h)) * HTB)
#define G8_SB(b, h) ((4 + (b) * 2 + (h)) * HTB)
#define G8_STAGE(bufoff, gbase, voff) do { _Pragma("unroll") for (int _i = 0; _i < 2; ++_i) \
        __builtin_amdgcn_global_load_lds((const unsigned*)((const char*)(gbase) + (voff)[_i]), (LAS unsigned*)(lds + (bufoff) + ldsw + _i * 8192), 16, 0, 0); } while (0)
#define G8_STAGEA(bufoff, gbase, ld) do { _Pragma("unroll") for (int _i = 0; _i < 2; ++_i) \
        __builtin_amdgcn_global_load_lds((const unsigned*)((const char*)(gbase) + (rowA[_i] * (ld) + colA[_i])), (LAS unsigned*)(lds + (bufoff) + ldsw + _i * 8192), 16, 0, 0); } while (0)
#define G8_LDA(dst, b, h) do { _Pragma("unroll") for (int m = 0; m < 4; ++m) _Pragma("unroll") for (int k = 0; k < 2; ++k) dst[m][k] = *(const LAS bf16x8*)(lds + G8_SA(b, h) + aoff + m * 2048 + k * 1024); } while (0)
#define G8_LDB(dst, b, h) do { _Pragma("unroll") for (int n = 0; n < 2; ++n) _Pragma("unroll") for (int k = 0; k < 2; ++k) dst[n][k] = *(const LAS bf16x8*)(lds + G8_SB(b, h) + boff + n * 2048 + k * 1024); } while (0)
#define G8_MMA(ai, bj, At, Bt) do { __builtin_amdgcn_s_setprio(1); _Pragma("unroll") for (int m = 0; m < 4; ++m) _Pragma("unroll") for (int n = 0; n < 2; ++n) _Pragma("unroll") for (int k = 0; k < 2; ++k) \
        acc[ai][bj][m][n] = __builtin_amdgcn_mfma_f32_16x16x32_bf16(Bt[n][k], At[m][k], acc[ai][bj][m][n], 0, 0, 0); __builtin_amdgcn_s_setprio(0); } while (0)
#define G8_WAIT_V(n) asm volatile("s_waitcnt vmcnt(" #n ")" ::: "memory")
#define G8_WAIT_L(n) asm volatile("s_waitcnt lgkmcnt(" #n ")" ::: "memory")
#define G8_BAR __builtin_amdgcn_s_barrier()
#define G8_SCHED __builtin_amdgcn_sched_barrier(0)
    Unit cur, nxt; int ui = 0;
    if (!S.next(0, cur)) return;
    f32x4 acc[2][2][4][2];
#pragma unroll
    for (int a = 0; a < 2; ++a)
#pragma unroll
        for (int b = 0; b < 2; ++b)
#pragma unroll
            for (int m = 0; m < 4; ++m)
#pragma unroll
                for (int n = 0; n < 2; ++n) acc[a][b][m][n] = (f32x4){0.f, 0.f, 0.f, 0.f};
    bf16x8 At[4][2], B0[2][2], B1[2][2];
    const char* cA = cur.a; const char* cB = cur.b;
    unsigned ldc = cur.lda;
    G8_STAGE(G8_SB(0, 0), cB, voffB); G8_STAGE(G8_SB(0, 1), cB + hstepB, voffB); G8_STAGEA(G8_SA(0, 0), cA, ldc); G8_STAGEA(G8_SA(0, 1), cA + (size_t)HALF * ldc, ldc);
    if (wr == 1) G8_BAR;
    G8_WAIT_V(2); G8_BAR;
    G8_STAGE(G8_SB(1, 0), cB + kstep, voffB); G8_STAGEA(G8_SA(1, 0), cA + kstep, ldc); G8_STAGE(G8_SB(1, 1), cB + hstepB + kstep, voffB);
    G8_WAIT_V(6); G8_BAR;
    for (;;) {
        const bool has_next = S.next(ui + 1, nxt);
        const char* nA = has_next ? nxt.a : cA; const char* nB = has_next ? nxt.b : cB;
        const unsigned ldn = has_next ? nxt.lda : ldc;
        for (int t = 0; t < nt; t += 2) {
            const bool last = (t == nt - 2);
            const char* a1 = cA + (size_t)(t + 1) * kstep;
            const char* a2 = last ? nA : cA + (size_t)(t + 2) * kstep; const char* b2 = last ? nB : cB + (size_t)(t + 2) * kstep;
            const char* a3 = a2 + kstep; const char* b3 = b2 + kstep;
            const unsigned ld2 = last ? ldn : ldc;
            const size_t h1 = (size_t)HALF * ldc, h2 = (size_t)HALF * ld2;
            G8_LDB(B0, 0, 0); G8_LDB(B1, 0, 1); G8_SCHED; G8_LDA(At, 0, 0); G8_STAGEA(G8_SA(1, 1), a1 + h1, ldc);
            G8_WAIT_V(8); G8_WAIT_L(0); G8_BAR; G8_MMA(0, 0, At, B0); G8_MMA(0, 1, At, B1); G8_BAR; G8_SCHED;
            G8_LDA(At, 0, 1); G8_STAGE(G8_SB(0, 0), b2, voffB); G8_STAGE(G8_SB(0, 1), b2 + hstepB, voffB); G8_STAGEA(G8_SA(0, 0), a2, ld2);
            G8_WAIT_V(8); G8_WAIT_L(0); G8_BAR; G8_MMA(1, 0, At, B0); G8_MMA(1, 1, At, B1); G8_BAR; G8_SCHED;
            G8_LDB(B0, 1, 0); G8_LDB(B1, 1, 1); G8_SCHED; G8_LDA(At, 1, 0); G8_STAGEA(G8_SA(0, 1), a2 + h2, ld2);
            G8_WAIT_V(8); G8_WAIT_L(0); G8_BAR; G8_MMA(0, 0, At, B0); G8_MMA(0, 1, At, B1); G8_BAR; G8_SCHED;
            G8_LDA(At, 1, 1); G8_STAGE(G8_SB(1, 0), b3, voffB); G8_STAGE(G8_SB(1, 1), b3 + hstepB, voffB); G8_STAGEA(G8_SA(1, 0), a3, ld2);
            G8_WAIT_V(8); G8_WAIT_L(0); G8_BAR; G8_MMA(1, 0, At, B0); G8_MMA(1, 1, At, B1); G8_BAR; G8_SCHED;
        }
        if (wr == 0) G8_BAR;
        E(acc, cur, wr, wc, fr, fq);
        if (!has_next) break;
#pragma unroll
        for (int a = 0; a < 2; ++a)
#pragma unroll
            for (int b = 0; b < 2; ++b)
#pragma unroll
                for (int m = 0; m < 4; ++m)
#pragma unroll
                    for (int n = 0; n < 2; ++n) acc[a][b][m][n] = (f32x4){0.f, 0.f, 0.f, 0.f};
        cur = nxt; cA = nA; cB = nB; ldc = ldn; ++ui;
        if (wr == 1) G8_BAR;
    }
    G8_WAIT_V(0);
    G8_BAR;
#undef G8_SA
#undef G8_SB
#undef G8_STAGE
#undef G8_STAGEA
#undef G8_LDA
#undef G8_LDB
#undef G8_MMA
#undef G8_WAIT_V
#undef G8_WAIT_L
#undef G8_BAR
#undef G8_SCHED
}

DEV void grid_unit(int wgid, int nM, int nN, int& pm, int& pn) {
    const int nwg = nM * nN, q = nwg / 8, r = nwg % 8, xcd = wgid % 8, off = wgid / 8;
    wgid = (xcd < r ? xcd * (q + 1) : r * (q + 1) + (xcd - r) * q) + off;
    const int nig = 4 * nN, gid = wgid / nig, fm = gid * 4, gsz = (nM - fm) < 4 ? (nM - fm) : 4;
    pm = fm + ((wgid % nig) % gsz); pn = (wgid % nig) / gsz;
}
DEV uint2 pk4(const f32x4 v) { return make_uint2(pk2(v[0], v[1]), pk2(v[2], v[3])); }
DEV float lo16(unsigned u) { return __uint_as_float(u << 16); }
DEV float hi16(unsigned u) { return __uint_as_float(u & 0xffff0000u); }
}

struct SchedG1 {
    const char* H; const char* W; int G, c;
    DEV bool next(int i, g8::Unit& u) const {
        int L = i * G + c;
        if (L >= 1440) return false;
        if (L < 1248) { g8::grid_unit(L, 48, 26, u.pm, u.pn); u.kind = 0; u.lda = 2048u; u.a = H + (size_t)u.pm * 256 * 2048; u.b = W + (size_t)u.pn * 256 * 2048; }
        else { g8::grid_unit(L - 1248, 4, 48, u.pm, u.pn); u.kind = 0; u.lda = 2048u; u.a = W + (size_t)(PW + u.pm * 256) * 2048; u.b = H + (size_t)u.pn * 256 * 2048; u.pn += 64; }
        return true;
    }
};
struct EpiG1 {
    unsigned char* ws; float* out; int l;
    DEV void operator()(const f32x4 (&acc)[2][2][4][2], const g8::Unit& u, int wr, int wc, int fr, int fq) const {
        using namespace g8;
        bf16_t* Pb = (bf16_t*)(ws + OFF_P);
        if (u.pn >= 64) {
            bf16_t* RVT = (bf16_t*)(ws + OFF_RVT);
#pragma unroll
            for (int ai = 0; ai < 2; ++ai)
#pragma unroll
                for (int bj = 0; bj < 2; ++bj)
#pragma unroll
                    for (int m = 0; m < 4; ++m)
#pragma unroll
                        for (int n = 0; n < 2; ++n) {
                            const int ch = u.pm * 256 + ai * 128 + wr * 64 + m * 16 + fr;
                            const int tok = (u.pn - 64) * 256 + bj * 128 + wc * 32 + n * 16 + fq * 4;
                            *(uint2*)(RVT + (size_t)ch * M + tok) = pk4(acc[ai][bj][m][n]);
                        }
            return;
        }
        const int pn = u.pn;
        const bool rope_ret = pn < 4, rope_att = pn >= 16 && pn <= 20;
        const bool lat = u.pm >= 16;
        if (rope_ret || rope_att) {
            const int te = rope_ret ? (wc >> 1) * 32 + (wc & 1) * 16 + fq * 4 : 64 + (wc & 1) * 16 + fq * 4;
            const float sc = pn < 2 ? 0.08838834764831845f : (pn >= 16 && pn < 20) ? 0.125f * 1.4426950408889634f : 1.f;
#pragma unroll
            for (int ai = 0; ai < 2; ++ai) {
                float4 c01[4], c23[4];
                if (lat) {
#pragma unroll
                    for (int m = 0; m < 4; ++m) {
                        const int t = (u.pm * 256 + ai * 128 + wr * 64 + m * 16 + fr - NCTX) & 2047;
                        const float4* tb = (const float4*)((const float2*)(ws + OFF_ROPE) + (size_t)t * 96 + te);
                        c01[m] = tb[0]; c23[m] = tb[1];
                    }
                }
#pragma unroll
                for (int m = 0; m < 4; ++m) {
                    const int row = u.pm * 256 + ai * 128 + wr * 64 + m * 16 + fr;
                    bf16_t* Pr = Pb + (size_t)row * PW;
#pragma unroll
                    for (int bj = 0; bj < 2; ++bj) {
                        f32x4 x1 = acc[ai][bj][m][0], x2 = acc[ai][bj][m][1];
                        const int lc1 = rope_ret ? pn * 256 + bj * 128 + (wc >> 1) * 64 + (wc & 1) * 16 + fq * 4 : pn * 256 + bj * 128 + wc * 32 + fq * 4;
                        const int lc2 = rope_ret ? lc1 + 32 : lc1 + 16;
                        if (!lat && pn == 20) {
                            float* ok = out + O_NK + ((size_t)((row >> 8) * 2 + l) * 256 + (row & 255)) * 256 + (lc1 - C_AK);
                            *(float4*)ok = make_float4(x1[0], x1[1], x1[2], x1[3]);
                            *(float4*)(ok + 16) = make_float4(x2[0], x2[1], x2[2], x2[3]);
                        }
                        if (lat) {
                            const float cs[4] = {c01[m].x, c01[m].z, c23[m].x, c23[m].z}, sn[4] = {c01[m].y, c01[m].w, c23[m].y, c23[m].w};
                            f32x4 o1, o2;
#pragma unroll
                            for (int j = 0; j < 4; ++j) { o1[j] = x1[j] * cs[j] - x2[j] * sn[j]; o2[j] = x2[j] * cs[j] + x1[j] * sn[j]; }
                            x1 = o1; x2 = o2;
                        }
                        x1 *= sc; x2 *= sc;
                        *(uint2*)(Pr + lc1) = pk4(x1);
                        *(uint2*)(Pr + lc2) = pk4(x2);
                    }
                }
            }
            return;
        }
#pragma unroll
        for (int ai = 0; ai < 2; ++ai)
#pragma unroll
            for (int m = 0; m < 4; ++m) {
                const int row = u.pm * 256 + ai * 128 + wr * 64 + m * 16 + fr;
                bf16_t* Pr = Pb + (size_t)row * PW;
#pragma unroll
                for (int bj = 0; bj < 2; ++bj)
#pragma unroll
                    for (int n = 0; n < 2; ++n) {
                        f32x4 v = acc[ai][bj][m][n];
                        const int col = pn * 256 + bj * 128 + wc * 32 + n * 16 + fq * 4;
                        if (pn == 21) {
                            if (!lat) *(float4*)(out + O_NV + ((size_t)((row >> 8) * 2 + l) * 256 + (row & 255)) * 256 + (col - C_AV)) = make_float4(v[0], v[1], v[2], v[3]);
                        } else if (!(pn >= 8 && pn < 12)) {
#pragma unroll
                            for (int j = 0; j < 4; ++j) v[j] = siluf(v[j]);
                        }
                        *(uint2*)(Pr + col) = pk4(v);
                    }
            }
    }
};
DEV void phase8_gemm1(CParams& p, int l, LAS unsigned char* lds) {
    SchedG1 S{(const char*)(p.ws + OFF_H), (const char*)(p.ws + OFF_W1T), GDIM(), BIDX()};
    EpiG1 E{p.ws, p.out, l};
    g8::gemm_phase(lds, 2048u, 16, S, E);
}

constexpr size_t OFF_G2 = OFF_RVT;
struct SchedMg {
    const char *H, *P, *WMG, *WBR; int G, c, part;
    DEV void fill(g8::Unit& u, int tile, int n, int isz) const {
        u.pm = tile >> 2; u.pn = tile & 3; u.kind = n * 2 + isz;
        if (isz) { const int acol = n == 0 ? C_RG : n == 1 ? C_LG : C_AQ;
                   u.lda = (unsigned)PW * 2u; u.a = P + (size_t)u.pm * 256 * PW * 2 + (size_t)acol * 2; u.b = WBR + ((size_t)n * 1024 + u.pn * 256) * 2048; }
        else { u.lda = 2048u; u.a = H + (size_t)u.pm * 256 * 2048; u.b = WMG + ((size_t)n * 1024 + u.pn * 256) * 2048; }
    }
    DEV bool next(int i, g8::Unit& u) const {
        if (G == 256) {
            const int xg = c & 7, j = c >> 3;
            if (part == 2) {
                if (c >= 192 || i >= 1) return false;
                fill(u, xg * 24 + j, 1, 0);
            } else if (part == 0) {
                if (c < 192) { if (i >= 3) return false; if (i == 0) fill(u, xg * 24 + j, 0, 0); else fill(u, xg * 24 + j, i - 1, 1); }
                else { if (i >= 3) return false; fill(u, xg * 24 + (j - 24) * 3 + i, 2, 0); }
            } else {
                if (c >= 192 || i >= 1) return false;
                fill(u, xg * 24 + j, 2, 1);
            }
            return true;
        }
        if (part != 0) return false;
        const int tile = c + (i / 6) * G, sI = i % 6;
        if (tile >= 192) return false;
        fill(u, tile, sI >> 1, sI & 1);
        return true;
    }
};
struct EpiMg {
    unsigned char* ws; const float* bias;
    DEV bf16_t* gslot(int n, int row) const {
        bf16_t* Pb = (bf16_t*)(ws + OFF_P);
        return n == 0 ? Pb + (size_t)row * PW + C_LX : n == 1 ? Pb + (size_t)row * PW + C_AG : (bf16_t*)(ws + OFF_G2) + (size_t)row * 1024;
    }
    DEV void operator()(const f32x4 (&acc)[2][2][4][2], const g8::Unit& u, int wr, int wc, int fr, int fq) const {
        using namespace g8;
        const int n = u.kind >> 1; const bool zpass = u.kind & 1;
        const int colb = u.pn * 256 + wc * 32 + fq * 4;
        if (!zpass) {
            float4 bz[2][2];
#pragma unroll
            for (int bj = 0; bj < 2; ++bj)
#pragma unroll
                for (int nn = 0; nn < 2; ++nn) bz[bj][nn] = *(const float4*)(bias + n * 1024 + colb + bj * 128 + nn * 16);
#pragma unroll
            for (int ai = 0; ai < 2; ++ai)
#pragma unroll
                for (int m = 0; m < 4; ++m) {
                    bf16_t* gs = gslot(n, u.pm * 256 + ai * 128 + wr * 64 + m * 16 + fr);
#pragma unroll
                    for (int bj = 0; bj < 2; ++bj)
#pragma unroll
                        for (int nn = 0; nn < 2; ++nn) {
                            f32x4 v = acc[ai][bj][m][nn];
                            v[0] = sigmf(v[0] + bz[bj][nn].x); v[1] = sigmf(v[1] + bz[bj][nn].y); v[2] = sigmf(v[2] + bz[bj][nn].z); v[3] = sigmf(v[3] + bz[bj][nn].w);
                            *(uint2*)(gs + colb + bj * 128 + nn * 16) = pk4(v);
                        }
                }
            return;
        }
#pragma unroll
        for (int ai = 0; ai < 2; ++ai) {
            uint2 gq[4][2][2], tq[4][2][2];
#pragma unroll
            for (int m = 0; m < 4; ++m) {
                const int row = u.pm * 256 + ai * 128 + wr * 64 + m * 16 + fr;
                const bf16_t* gs = gslot(n, row);
                const bf16_t* Tr = (const bf16_t*)(ws + OFF_P) + (size_t)row * PW;
#pragma unroll
                for (int bj = 0; bj < 2; ++bj)
#pragma unroll
                    for (int nn = 0; nn < 2; ++nn) {
                        gq[m][bj][nn] = *(const uint2*)(gs + colb + bj * 128 + nn * 16);
                        if (n > 0) tq[m][bj][nn] = *(const uint2*)(Tr + colb + bj * 128 + nn * 16);
                    }
            }
#pragma unroll
            for (int m = 0; m < 4; ++m) {
                const int row = u.pm * 256 + ai * 128 + wr * 64 + m * 16 + fr;
                bf16_t* Tr = (bf16_t*)(ws + OFF_P) + (size_t)row * PW;
#pragma unroll
                for (int bj = 0; bj < 2; ++bj)
#pragma unroll
                    for (int nn = 0; nn < 2; ++nn) {
                        f32x4 v = acc[ai][bj][m][nn];
                        const uint2 gv = gq[m][bj][nn];
                        v[0] *= lo16(gv.x); v[1] *= hi16(gv.x); v[2] *= lo16(gv.y); v[3] *= hi16(gv.y);
                        if (n > 0) { const uint2 tv = tq[m][bj][nn]; v[0] += lo16(tv.x); v[1] += hi16(tv.x); v[2] += lo16(tv.y); v[3] += hi16(tv.y); }
                        *(uint2*)(Tr + colb + bj * 128 + nn * 16) = pk4(v);
                    }
            }
        }
    }
};
DEV void phase8_merge(CParams& p, int l, int part, LAS unsigned char* lds) {
    SchedMg S{(const char*)(p.ws + OFF_H), (const char*)(p.ws + OFF_P), (const char*)(p.ws + OFF_WMG), (const char*)(p.ws + OFF_WBR), GDIM(), BIDX(), part};
    EpiMg E{p.ws, p.b_merge + (size_t)l * 3072};
    g8::gemm_phase(lds, 2048u, 16, S, E);
}

struct SchedOut {
    const char* A; const char* B; int G, c;
    DEV bool next(int i, g8::Unit& u) const {
        int tile = i * G + c;
        if (G == 256) { if (i > 0 || c >= 192) return false; tile = (c & 7) * 24 + (c >> 3); }
        if (tile >= 192) return false;
        u.pm = tile >> 2; u.pn = tile & 3; u.kind = 0; u.lda = (unsigned)PW * 2u;
        u.a = A + (size_t)u.pm * 256 * PW * 2; u.b = B + (size_t)u.pn * 256 * 2048;
        return true;
    }
};
DEV void row_exchange(unsigned char* ws, int slot, int pn, float* part, float* rs) {
    const int tid = TIDX();
    __syncthreads();
    unsigned* XPd = (unsigned*)(ws + OFF_XP) + (size_t)slot * 4 * 256;
    unsigned* cnt = (unsigned*)(ws + OFF_XC) + slot;
    if (tid < 256) {
        const float v = (part[tid] + part[256 + tid]) + (part[512 + tid] + part[768 + tid]);
        __hip_atomic_store(XPd + pn * 256 + tid, __float_as_uint(v), __ATOMIC_RELAXED, __HIP_MEMORY_SCOPE_AGENT);
    }
    asm volatile("s_waitcnt vmcnt(0)" ::: "memory");
    __syncthreads();
    if (tid == 0) {
        (void)__hip_atomic_fetch_add(cnt, 1u, __ATOMIC_RELAXED, __HIP_MEMORY_SCOPE_AGENT);
        unsigned sp = 0;
        while (__hip_atomic_load(cnt, __ATOMIC_RELAXED, __HIP_MEMORY_SCOPE_AGENT) < 4u) { __builtin_amdgcn_s_sleep(1); if (++sp > (1u << 20)) break; }
        __builtin_amdgcn_fence(__ATOMIC_ACQUIRE, "agent");
        asm volatile("s_waitcnt vmcnt(0)" ::: "memory");
    }
    __syncthreads();
    if (tid < 256) {
        float t = 0.f;
#pragma unroll
        for (int q = 0; q < 4; ++q) t += __uint_as_float(__hip_atomic_load(XPd + q * 256 + tid, __ATOMIC_RELAXED, __HIP_MEMORY_SCOPE_AGENT));
        rs[tid] = rsqrtf(t * (1.f / D) + EPS);
    }
    __syncthreads();
}
struct EpiOutPost {
    CParams* kp; int l; unsigned char* ldsx;
    DEV void row_ssq(const f32x4 (&v)[2][2][4][2], float* part, int wr, int wc, int fr, int fq) const {
#pragma unroll
        for (int ai = 0; ai < 2; ++ai)
#pragma unroll
            for (int m = 0; m < 4; ++m) {
                float ss = 0.f;
#pragma unroll
                for (int bj = 0; bj < 2; ++bj)
#pragma unroll
                    for (int n = 0; n < 2; ++n) { const f32x4 x = v[ai][bj][m][n]; ss += (x[0] * x[0] + x[1] * x[1]) + (x[2] * x[2] + x[3] * x[3]); }
                ss = xrow16_sum(ss);
                if (fq == 0) part[wc * 256 + ai * 128 + wr * 64 + m * 16 + fr] = ss;
            }
    }
    DEV void operator()(f32x4 (&acc)[2][2][4][2], const g8::Unit& u, int wr, int wc, int fr, int fq) const {
        CParams& p = *kp;
        unsigned char* ws = p.ws;
        float* part = (float*)ldsx; float* rs = part + 1024;
        const int colb = u.pn * 256 + wc * 32 + fq * 4;
        const int crow = u.pm < 16 ? 0 : 1 + ((u.pm - 16) >> 3);
        const float* mod = ws_mod(p) + (size_t)(l * 5 + crow) * 3072;
        row_ssq(acc, part, wr, wc, fr, fq);
        row_exchange(ws, (l * 2 + 0) * 48 + u.pm, u.pn, part, rs);
        {
            float4 gt[2][2], gp[2][2];
#pragma unroll
            for (int bj = 0; bj < 2; ++bj)
#pragma unroll
                for (int n = 0; n < 2; ++n) {
                    gt[bj][n] = *(const float4*)(mod + 2048 + colb + bj * 128 + n * 16);
                    gp[bj][n] = *(const float4*)(p.norm_post + l * D + colb + bj * 128 + n * 16);
                    gt[bj][n].x *= gp[bj][n].x; gt[bj][n].y *= gp[bj][n].y; gt[bj][n].z *= gp[bj][n].z; gt[bj][n].w *= gp[bj][n].w;
                }
#pragma unroll
            for (int ai = 0; ai < 2; ++ai)
#pragma unroll
                for (int mh = 0; mh < 2; ++mh) {
                    float4 xv[2][2][2];
#pragma unroll
                    for (int m2 = 0; m2 < 2; ++m2) {
                        const int row = u.pm * 256 + ai * 128 + wr * 64 + (mh * 2 + m2) * 16 + fr;
                        const float* xr = x_row(p, l, row);
#pragma unroll
                        for (int bj = 0; bj < 2; ++bj)
#pragma unroll
                            for (int n = 0; n < 2; ++n) xv[m2][bj][n] = *(const float4*)(xr + colb + bj * 128 + n * 16);
                    }
#pragma unroll
                    for (int m2 = 0; m2 < 2; ++m2) {
                        const int m = mh * 2 + m2;
                        const int rl = ai * 128 + wr * 64 + m * 16 + fr;
                        const float rstd = rs[rl];
                        float* yr = p.out + (size_t)(u.pm * 256 + rl) * D;
#pragma unroll
                        for (int bj = 0; bj < 2; ++bj)
#pragma unroll
                            for (int n = 0; n < 2; ++n) {
                                f32x4 y;
                                y[0] = xv[m2][bj][n].x + gt[bj][n].x * (acc[ai][bj][m][n][0] * rstd);
                                y[1] = xv[m2][bj][n].y + gt[bj][n].y * (acc[ai][bj][m][n][1] * rstd);
                                y[2] = xv[m2][bj][n].z + gt[bj][n].z * (acc[ai][bj][m][n][2] * rstd);
                                y[3] = xv[m2][bj][n].w + gt[bj][n].w * (acc[ai][bj][m][n][3] * rstd);
                                acc[ai][bj][m][n] = y;
                                *(float4*)(yr + colb + bj * 128 + n * 16) = make_float4(y[0], y[1], y[2], y[3]);
                            }
                    }
                }
        }
        if (l != 0) return;
        row_ssq(acc, part, wr, wc, fr, fq);
        row_exchange(ws, (l * 2 + 1) * 48 + u.pm, u.pn, part, rs);
        {
            const float* mod1 = ws_mod(p) + (size_t)(1 * 5 + crow) * 3072;
            float4 a_[2][2], b_[2][2];
#pragma unroll
            for (int bj = 0; bj < 2; ++bj)
#pragma unroll
                for (int n = 0; n < 2; ++n) {
                    const int cc = colb + bj * 128 + n * 16;
                    const float4 g = *(const float4*)(p.norm_pre + 1 * D + cc), sc = *(const float4*)(mod1 + 1024 + cc);
                    a_[bj][n] = make_float4(g.x * (1.f + sc.x), g.y * (1.f + sc.y), g.z * (1.f + sc.z), g.w * (1.f + sc.w));
                    b_[bj][n] = *(const float4*)(mod1 + cc);
                }
#pragma unroll
            for (int ai = 0; ai < 2; ++ai)
#pragma unroll
                for (int m = 0; m < 4; ++m) {
                    const int rl = ai * 128 + wr * 64 + m * 16 + fr;
                    const float rstd = rs[rl];
                    bf16_t* hr = ws_bf(p, OFF_H) + (size_t)(u.pm * 256 + rl) * D;
#pragma unroll
                    for (int bj = 0; bj < 2; ++bj)
#pragma unroll
                        for (int n = 0; n < 2; ++n) {
                            const f32x4 y = acc[ai][bj][m][n];
                            uint2 o;
                            o.x = pk2(y[0] * rstd * a_[bj][n].x + b_[bj][n].x, y[1] * rstd * a_[bj][n].y + b_[bj][n].y);
                            o.y = pk2(y[2] * rstd * a_[bj][n].z + b_[bj][n].z, y[3] * rstd * a_[bj][n].w + b_[bj][n].w);
                            *(uint2*)(hr + colb + bj * 128 + n * 16) = o;
                        }
                }
        }
    }
};
DEV void phase8_out(CParams& p, int l, LAS unsigned char* lds) {
    SchedOut S{(const char*)(p.ws + OFF_P), (const char*)(p.ws + OFF_WOUT), GDIM(), BIDX()};
    EpiOutPost E{&p, l, (unsigned char*)lds + LDS_XOFF};
    g8::gemm_phase(lds, 2048u, 16, S, E);
}

DEV uint4 pack8(const float4 a, const float4 b) {
    uint4 r;
    r.x = pk2(a.x, a.y); r.y = pk2(a.z, a.w);
    r.z = pk2(b.x, b.y); r.w = pk2(b.z, b.w);
    return r;
}
template <int NU>
DEV void attn_item(CParams& p, int l, bool lat, int b, int hk, int qs0, unsigned char* lds) {
    bf16_t* Pb = ws_bf(p, OFF_P);
    const int tid = TIDX(), lane = tid & 63, w = tid >> 6, g = lane >> 4, lc = lane & 15;
    const int row0 = lat ? NCTX + b * 2048 : b * 256, L = lat ? 2048 : 256;
    const int hq = hk * 4 + (w & 3);
    const int qw = qs0 + (w >> 2) * 32;
    bf16x8 qfr[NU][2][2];
    f32x4 O[NU][4][2];
    float mrun[NU][2], lrun[NU][2];
    const float sink = p.att_sink[l * 16 + hq] * 1.4426950408889634f;
#pragma unroll
    for (int u = 0; u < NU; ++u)
#pragma unroll
        for (int qf = 0; qf < 2; ++qf) {
#pragma unroll
            for (int ks = 0; ks < 2; ++ks)
                qfr[u][qf][ks] = *(const bf16x8*)(Pb + (size_t)(row0 + qw + u * 64 + qf * 16 + lc) * PW + C_AQ + hq * 64 + ks * 32 + g * 8);
            mrun[u][qf] = sink; lrun[u][qf] = g == 0 ? 1.f : 0.f;
#pragma unroll
            for (int df = 0; df < 4; ++df) O[u][df][qf] = (f32x4){0.f, 0.f, 0.f, 0.f};
        }
    const int nband = lat ? 4 + NU : 4;
    const int ntile = lat ? nband + 4 : 4;
    const int qsb = qs0 >> 6;
    const int t_lo = lat ? (qsb < 2 ? 2 - qsb : 0) : 0;
    const int t_hi = lat ? ((33 - qsb) < (nband - 1) ? (33 - qsb) : (nband - 1)) : 3;
    const int fsw = (lane >> 1) & 7;
    const int srow = tid >> 3, sc8 = tid & 7;
    float4 R[4];
    auto tile_load = [&](int t) __attribute__((always_inline)) {
        if (t < nband) {
            const int kp0 = lat ? qs0 + 64 * (t - 2) : 64 * t;
            const uint4 kv = *(const uint4*)(Pb + (size_t)(row0 + kp0 + srow) * PW + C_AK + hk * 64 + sc8 * 8);
            const uint4 vv = *(const uint4*)(Pb + (size_t)(row0 + kp0 + srow) * PW + C_AV + hk * 64 + sc8 * 8);
            R[0] = make_float4(__uint_as_float(kv.x), __uint_as_float(kv.y), __uint_as_float(kv.z), __uint_as_float(kv.w));
            R[2] = make_float4(__uint_as_float(vv.x), __uint_as_float(vv.y), __uint_as_float(vv.z), __uint_as_float(vv.w));
        } else {
            const int j0 = (t - nband) * 64;
            const float* ck = p.cache_k + (size_t)((b * 2 + l) * 256 + j0) * 256 + hk * 64;
            const float* cv = p.cache_v + (size_t)((b * 2 + l) * 256 + j0) * 256 + hk * 64;
            R[0] = *(const float4*)(ck + (size_t)srow * 256 + sc8 * 8); R[1] = *(const float4*)(ck + (size_t)srow * 256 + sc8 * 8 + 4);
            R[2] = *(const float4*)(cv + (size_t)srow * 256 + sc8 * 8); R[3] = *(const float4*)(cv + (size_t)srow * 256 + sc8 * 8 + 4);
        }
    };
    auto tile_store = [&](bool cache_t, unsigned char* KsB, unsigned char* VtB) __attribute__((always_inline)) {
        uint4 kq, vq;
        if (!cache_t) {
            kq = make_uint4(__float_as_uint(R[0].x), __float_as_uint(R[0].y), __float_as_uint(R[0].z), __float_as_uint(R[0].w));
            vq = make_uint4(__float_as_uint(R[2].x), __float_as_uint(R[2].y), __float_as_uint(R[2].z), __float_as_uint(R[2].w));
        } else { kq = pack8(R[0], R[1]); vq = pack8(R[2], R[3]); }
        *(uint4*)(KsB + srow * 128 + ((sc8 ^ ((srow >> 1) & 7)) << 4)) = kq;
        *(uint4*)(VtB + srow * 128 + ((sc8 ^ (((srow >> 1) & 3) << 1)) << 4)) = vq;
    };
    int t = t_lo;
    tile_load(t);
    __syncthreads();
    tile_store(t >= nband, lds, lds + 8192);
    int tn = (lat && t == t_hi) ? nband : t + 1;
    if (tn < ntile) tile_load(tn);
    int cur = 0;
    while (t < ntile) {
        const bool cache = t >= nband;
        const int kp0 = lat ? qs0 + 64 * (t - 2) : 64 * t;
        const unsigned char* Ks = lds + cur * 16384; const unsigned char* Vt = Ks + 8192;
        __syncthreads();
        int tnn = ntile;
        if (tn < ntile) {
            tile_store(tn >= nband, lds + (cur ^ 1) * 16384, lds + (cur ^ 1) * 16384 + 8192);
            tnn = (lat && tn == t_hi) ? nband : tn + 1;
            if (tnn < ntile) tile_load(tnn);
        }
#pragma unroll
        for (int u = 0; u < NU; ++u) {
            const int tu = t - u;
            if (lat && !cache && (tu < 0 || tu > 4)) continue;
            __builtin_amdgcn_s_setprio(1);
            f32x4 sc[4][2];
#pragma unroll
            for (int kf = 0; kf < 4; ++kf)
#pragma unroll
                for (int qf = 0; qf < 2; ++qf) sc[kf][qf] = (f32x4){0.f, 0.f, 0.f, 0.f};
#pragma unroll
            for (int ks = 0; ks < 2; ++ks) {
                bf16x8 ak[4];
#pragma unroll
                for (int kf = 0; kf < 4; ++kf) ak[kf] = *(const bf16x8*)(Ks + (kf * 16 + lc) * 128 + (((ks * 4 + g) ^ fsw) << 4));
#pragma unroll
                for (int kf = 0; kf < 4; ++kf)
#pragma unroll
                    for (int qf = 0; qf < 2; ++qf)
                        sc[kf][qf] = __builtin_amdgcn_mfma_f32_16x16x32_bf16(ak[kf], qfr[u][qf][ks], sc[kf][qf], 0, 0, 0);
            }
            __builtin_amdgcn_s_setprio(0);
            if (lat && !cache && (tu == 0 || tu == 4)) {
#pragma unroll
                for (int kf = 0; kf < 4; ++kf)
#pragma unroll
                    for (int qf = 0; qf < 2; ++qf)
#pragma unroll
                        for (int r = 0; r < 4; ++r) {
                            const int kpos = kp0 + kf * 16 + g * 4 + r, qpos = qw + u * 64 + qf * 16 + lc;
                            const int dd = qpos - kpos;
                            if (dd > 128 || dd < -128) sc[kf][qf][r] = -INFINITY;
                        }
            }
            bf16x8 pb[2][2];
#pragma unroll
            for (int qf = 0; qf < 2; ++qf) {
                float mx = -INFINITY;
#pragma unroll
                for (int kf = 0; kf < 4; ++kf)
#pragma unroll
                    for (int r = 0; r < 4; ++r) mx = fmaxf(mx, sc[kf][qf][r]);
                mx = xrow16_max(mx);
                const float mnew = fmaxf(mrun[u][qf], mx);
                const float alpha = __builtin_amdgcn_exp2f(mrun[u][qf] - mnew);
                mrun[u][qf] = mnew;
                float ps = 0.f;
#pragma unroll
                for (int kf = 0; kf < 4; ++kf)
#pragma unroll
                    for (int r = 0; r < 4; ++r) { const float e = __builtin_amdgcn_exp2f(sc[kf][qf][r] - mnew); sc[kf][qf][r] = e; ps += e; }
                lrun[u][qf] = lrun[u][qf] * alpha + ps;
#pragma unroll
                for (int df = 0; df < 4; ++df) O[u][df][qf] *= alpha;
#pragma unroll
                for (int s2 = 0; s2 < 2; ++s2) {
                    bf16x8 v;
#pragma unroll
                    for (int r = 0; r < 4; ++r) { v[r] = (short)f2bf(sc[2 * s2][qf][r]); v[4 + r] = (short)f2bf(sc[2 * s2 + 1][qf][r]); }
                    pb[s2][qf] = v;
                }
            }
            __builtin_amdgcn_s_setprio(1);
#pragma unroll
            for (int s2 = 0; s2 < 2; ++s2)
#pragma unroll
                for (int df = 0; df < 4; ++df) {
                    const int vrow = 32 * s2 + 4 * g + (lc >> 2);
                    const unsigned char* vr = Vt + vrow * 128 + (((2 * df + ((lc >> 1) & 1)) ^ (((vrow >> 1) & 3) << 1)) << 4) + 8 * (lc & 1);
                    const v4i16_t lo = __builtin_amdgcn_ds_read_tr16_b64_v4i16((LAS v4i16_t*)vr);
                    const v4i16_t hi = __builtin_amdgcn_ds_read_tr16_b64_v4i16((LAS v4i16_t*)(vr + 2048));
                    union { v4i16_t h[2]; bf16x8 v; } av; av.h[0] = lo; av.h[1] = hi;
#pragma unroll
                    for (int qf = 0; qf < 2; ++qf)
                        O[u][df][qf] = __builtin_amdgcn_mfma_f32_16x16x32_bf16(av.v, pb[s2][qf], O[u][df][qf], 0, 0, 0);
                }
            __builtin_amdgcn_s_setprio(0);
        }
        t = tn; tn = tnn; cur ^= 1;
    }
#pragma unroll
    for (int u = 0; u < NU; ++u)
#pragma unroll
        for (int qf = 0; qf < 2; ++qf) {
            const float lt = xrow16_sum(lrun[u][qf]);
            const float inv = 1.f / lt;
            const size_t m = (size_t)(row0 + qw + u * 64 + qf * 16 + lc);
#pragma unroll
            for (int df = 0; df < 4; ++df) {
                const int col = hq * 64 + df * 16 + g * 4;
                const uint2 gt = *(const uint2*)(Pb + m * PW + C_AG + col);
                uint2 o;
                o.x = pk2(O[u][df][qf][0] * inv * __uint_as_float(gt.x << 16), O[u][df][qf][1] * inv * __uint_as_float(gt.x & 0xffff0000u));
                o.y = pk2(O[u][df][qf][2] * inv * __uint_as_float(gt.y << 16), O[u][df][qf][3] * inv * __uint_as_float(gt.y & 0xffff0000u));
                *(uint2*)(Pb + m * PW + C_AQ + col) = o;
            }
        }
}
DEV void phase_attn(CParams& p, int l, unsigned char* lds) {
    if (GDIM() == 256) {
        const int xg = BIDX() & 7, j = BIDX() >> 3;
        { const int grp = xg * 2 + (j >> 4); attn_item<2>(p, l, true, grp >> 2, grp & 3, (j & 15) * 128, lds); }
        { const int grp = xg * 8 + (j >> 2); attn_item<1>(p, l, false, grp >> 2, grp & 3, (j & 3) * 64, lds); }
        return;
    }
    for (int item = BIDX(); item < 768; item += GDIM()) {
        if (item < 512) attn_item<1>(p, l, true, item >> 7, (item >> 5) & 3, (item & 31) * 64, lds);
        else { const int it = item - 512; attn_item<1>(p, l, false, it >> 4, (it >> 2) & 3, (it & 3) * 64, lds); }
    }
}

constexpr size_t OFF_RS = OFF_W1T;
static_assert(OFF_RS + (size_t)4 * 4 * 2 * 8 * 32768 * 2 <= OFF_LRUC, "RS overlap");
DEV float ret_logg(CParams& p, int l, int dir, int h) { return -softplusf(-p.ret_decay[(l * 2 + dir) * 4 + h]); }

DEV void ret_kv_tile(CParams& p, int l, int item, unsigned char* lds) {
    bf16_t* Pb = ws_bf(p, OFF_P); const bf16_t* RVT = ws_bf(p, OFF_RVT);
    const int tid = TIDX(), lane = tid & 63, w = __builtin_amdgcn_readfirstlane(tid >> 6), g = lane >> 4, lc = lane & 15;
    const bool lat = item < 128;
    int b, h, c;
    if (lat) { c = item & 7; h = (item >> 3) & 3; b = item >> 5; }
    else { const int it = item - 128; h = it & 3; b = it >> 2; c = 0; }
    const int row0 = lat ? NCTX + b * 2048 + c * 256 : b * 256;
    const bool doF = !lat || c < 7, doB = !lat || c > 0;
    const float lgf = ret_logg(p, l, 0, h), lgb = ret_logg(p, l, 1, h);
    const float rf = __expf(-lgf), rb = __expf(lgb);
    const int dvbase = w * 32;
    auto dma_k = [&](int st) __attribute__((always_inline)) {
        LAS unsigned char* base = (LAS unsigned char*)lds + (st & 1) * 16384;
#pragma unroll
        for (int i = 0; i < 2; ++i) {
            const int q = w * 2 + i, row = 4 * q + (lane >> 4), lch = (lane & 15) ^ (((row & 3) << 2) | ((row >> 2) & 3));
            __builtin_amdgcn_global_load_lds((const unsigned*)(Pb + (size_t)(row0 + st * 64 + row) * PW + C_RK + h * 128 + lch * 8), (LAS unsigned*)(base + q * 1024), 16, 0, 0);
        }
    };
    __syncthreads();
    dma_k(0);
    f32x4 accF[2][8], accB[2][8];
#pragma unroll
    for (int i = 0; i < 2; ++i)
#pragma unroll
        for (int j = 0; j < 8; ++j) { accF[i][j] = (f32x4){0.f, 0.f, 0.f, 0.f}; accB[i][j] = (f32x4){0.f, 0.f, 0.f, 0.f}; }
    const int tq = lc >> 2, tp = lc & 3;
#pragma unroll 1
    for (int st = 0; st < 4; ++st) {
        bf16x8 av[2][2];
#pragma unroll
        for (int ks = 0; ks < 2; ++ks)
#pragma unroll
            for (int mf = 0; mf < 2; ++mf)
                av[ks][mf] = *(const bf16x8*)(RVT + (size_t)(h * 256 + dvbase + mf * 16 + lc) * M + row0 + st * 64 + ks * 32 + g * 8);
        bf16x8 avF[2][2], avB[2][2];
#pragma unroll
        for (int ks = 0; ks < 2; ++ks) {
            const int ti0 = st * 64 + ks * 32 + g * 8;
            float wf = __expf(lgf * (float)(255 - ti0)), wb = __expf(lgb * (float)ti0);
#pragma unroll
            for (int j = 0; j < 8; ++j) {
#pragma unroll
                for (int mf = 0; mf < 2; ++mf) {
                    const float v = bf2f((bf16_t)av[ks][mf][j]);
                    avF[ks][mf][j] = (short)f2bf(v * wf); avB[ks][mf][j] = (short)f2bf(v * wb);
                }
                wf *= rf; wb *= rb;
            }
        }
        asm volatile("s_waitcnt vmcnt(0)" ::: "memory");
        __syncthreads();
        if (st + 1 < 4) dma_k(st + 1);
        const unsigned char* Kt = lds + (st & 1) * 16384;
#pragma unroll
        for (int ks = 0; ks < 2; ++ks)
#pragma unroll
            for (int nf = 0; nf < 8; ++nf) {
                const int r0 = 32 * ks + 8 * g + tq, r1 = r0 + 4;
                const unsigned char* a0 = Kt + r0 * 256 + (((2 * nf + (tp >> 1)) ^ (((r0 & 3) << 2) | ((r0 >> 2) & 3))) << 4) + 8 * (tp & 1);
                const unsigned char* a1 = Kt + r1 * 256 + (((2 * nf + (tp >> 1)) ^ (((r1 & 3) << 2) | ((r1 >> 2) & 3))) << 4) + 8 * (tp & 1);
                union { v4i16_t hlf[2]; bf16x8 v; } bk;
                bk.hlf[0] = __builtin_amdgcn_ds_read_tr16_b64_v4i16((LAS v4i16_t*)a0);
                bk.hlf[1] = __builtin_amdgcn_ds_read_tr16_b64_v4i16((LAS v4i16_t*)a1);
#pragma unroll
                for (int mf = 0; mf < 2; ++mf) {
                    accF[mf][nf] = __builtin_amdgcn_mfma_f32_16x16x32_bf16(avF[ks][mf], bk.v, accF[mf][nf], 0, 0, 0);
                    accB[mf][nf] = __builtin_amdgcn_mfma_f32_16x16x32_bf16(avB[ks][mf], bk.v, accB[mf][nf], 0, 0, 0);
                }
            }
    }
    if (lat) {
        bf16_t* dF = ws_bf(p, OFF_RS) + ((size_t)((b * 4 + h) * 2 + 0) * 8 + (c + 1)) * 32768;
        bf16_t* dB = ws_bf(p, OFF_RS) + ((size_t)((b * 4 + h) * 2 + 1) * 8 + (c - 1)) * 32768;
#pragma unroll
        for (int mf = 0; mf < 2; ++mf)
#pragma unroll
            for (int nf = 0; nf < 8; ++nf)
#pragma unroll
                for (int r = 0; r < 4; ++r) {
                    const size_t o = (size_t)(dvbase + mf * 16 + g * 4 + r) * 128 + nf * 16 + lc;
                    if (doF) dF[o] = f2bf(accF[mf][nf][r]);
                    if (doB) dB[o] = f2bf(accB[mf][nf][r]);
                }
    } else {
        float* dF = p.out + O_NRET + ((((size_t)b * 2 + l) * 2 + 0) * 4 + h) * 128 * 256;
        float* dB = p.out + O_NRET + ((((size_t)b * 2 + l) * 2 + 1) * 4 + h) * 128 * 256;
#pragma unroll
        for (int mf = 0; mf < 2; ++mf)
#pragma unroll
            for (int nf = 0; nf < 8; ++nf) {
                const size_t o = (size_t)(nf * 16 + lc) * 256 + dvbase + mf * 16 + g * 4;
                *(float4*)(dF + o) = make_float4(accF[mf][nf][0], accF[mf][nf][1], accF[mf][nf][2], accF[mf][nf][3]);
                *(float4*)(dB + o) = make_float4(accB[mf][nf][0], accB[mf][nf][1], accB[mf][nf][2], accB[mf][nf][3]);
            }
    }
}
DEV void phase_ret_kv(CParams& p, int l, unsigned char* lds) {
    for (int item = BIDX(); item < 192; item += GDIM()) ret_kv_tile(p, l, item, lds);
}

DEV void phase_ret_scan(CParams& p, int l, int vb, int nvb) {
    bf16_t* RS = ws_bf(p, OFF_RS);
    const int gt = vb * 512 + TIDX(), gs = nvb * 512;
    for (int idx = gt; idx < 4 * 4 * 2 * 4096; idx += gs) {
        const int dk0 = (idx & 15) * 8, dv = (idx >> 4) & 255, dir = (idx >> 12) & 1, h = (idx >> 13) & 3, b = idx >> 15;
        const float g256 = __expf(ret_logg(p, l, dir, h) * 256.f);
        const float* s0 = p.state_ret + (((((size_t)b * 2 + l) * 2 + dir) * 4 + h) * 128 + dk0) * 256 + dv;
        float st[8];
#pragma unroll
        for (int e = 0; e < 8; ++e) st[e] = s0[(size_t)e * 256];
        bf16_t* base = RS + (size_t)((b * 4 + h) * 2 + dir) * 8 * 32768 + dv * 128 + dk0;
        uint4 kv[7];
#pragma unroll
        for (int j = 0; j < 7; ++j) kv[j] = *(const uint4*)(base + (size_t)(dir == 0 ? j + 1 : 6 - j) * 32768);
        *(uint4*)(base + (size_t)(dir == 0 ? 0 : 7) * 32768) = make_uint4(pk2(st[0], st[1]), pk2(st[2], st[3]), pk2(st[4], st[5]), pk2(st[6], st[7]));
#pragma unroll
        for (int j = 0; j < 7; ++j) {
            st[0] = g256 * st[0] + g8::lo16(kv[j].x); st[1] = g256 * st[1] + g8::hi16(kv[j].x);
            st[2] = g256 * st[2] + g8::lo16(kv[j].y); st[3] = g256 * st[3] + g8::hi16(kv[j].y);
            st[4] = g256 * st[4] + g8::lo16(kv[j].z); st[5] = g256 * st[5] + g8::hi16(kv[j].z);
            st[6] = g256 * st[6] + g8::lo16(kv[j].w); st[7] = g256 * st[7] + g8::hi16(kv[j].w);
            *(uint4*)(base + (size_t)(dir == 0 ? j + 1 : 6 - j) * 32768) = make_uint4(pk2(st[0], st[1]), pk2(st[2], st[3]), pk2(st[4], st[5]), pk2(st[6], st[7]));
        }
    }
}

DEV void ret_out_tile(CParams& p, int l, int item, unsigned char* lds) {
    bf16_t* Pb = ws_bf(p, OFF_P); const bf16_t* RVT = ws_bf(p, OFF_RVT);
    const int tid = TIDX(), lane = tid & 63, w = __builtin_amdgcn_readfirstlane(tid >> 6), g = lane >> 4, lc = lane & 15;
    const bool lat = item < 256;
    int b, h, qb, rowc, qi0, c;
    if (lat) { qb = item & 15; h = (item >> 4) & 3; b = item >> 6; c = qb >> 1; rowc = NCTX + b * 2048 + c * 256; qi0 = (qb & 1) * 128; }
    else { const int it = item - 256; qb = it & 1; h = (it >> 1) & 3; b = it >> 3; c = 0; rowc = b * 256; qi0 = qb * 128; }
    const int qi = qi0 + w * 16 + lc;
    const size_t rowq = (size_t)(rowc + qi);
    const float lgf = ret_logg(p, l, 0, h), lgb = ret_logg(p, l, 1, h);
    const int nstep = lat ? 8 : 4;
    auto dma_step = [&](int sI) __attribute__((always_inline)) {
        LAS unsigned char* base = (LAS unsigned char*)lds + (sI & 1) * 49152;
        if (sI < 4) {
#pragma unroll
            for (int i = 0; i < 2; ++i) {
                const int q = w * 2 + i, row = 4 * q + (lane >> 4), lch = (lane & 15) ^ (row & 15);
                __builtin_amdgcn_global_load_lds((const unsigned*)(Pb + (size_t)(rowc + sI * 64 + row) * PW + C_RK + h * 128 + lch * 8), (LAS unsigned*)(base + q * 1024), 16, 0, 0);
            }
#pragma unroll
            for (int i = 0; i < 4; ++i) {
                const int q = w * 4 + i, row = 8 * q + (lane >> 3), lch = (lane & 7) ^ ((row >> 1) & 7);
                __builtin_amdgcn_global_load_lds((const unsigned*)(RVT + (size_t)(h * 256 + row) * M + rowc + sI * 64 + lch * 8), (LAS unsigned*)(base + 16384 + q * 1024), 16, 0, 0);
            }
        } else {
            const int dir = (sI - 4) >> 1, kh = (sI - 4) & 1;
            const bf16_t* Sg = ws_bf(p, OFF_RS) + ((size_t)((b * 4 + h) * 2 + dir) * 8 + c) * 32768;
#pragma unroll
            for (int i = 0; i < 4; ++i) {
                const int q = w * 4 + i, row = 8 * q + (lane >> 3), lch = (lane & 7) ^ ((row >> 1) & 7);
                __builtin_amdgcn_global_load_lds((const unsigned*)(Sg + (size_t)row * 128 + kh * 64 + lch * 8), (LAS unsigned*)(base + 16384 + q * 1024), 16, 0, 0);
            }
        }
    };
    dma_step(0);
    f32x4 acc[16];
#pragma unroll
    for (int df = 0; df < 16; ++df) acc[df] = (f32x4){0.f, 0.f, 0.f, 0.f};
    const int vsw = (lc >> 1) & 7;
    unsigned char* qsave = lds + 98304 + tid * 64;
    {
        bf16x8 qfr[4];
#pragma unroll
        for (int ks = 0; ks < 4; ++ks) { qfr[ks] = *(const bf16x8*)(Pb + rowq * PW + C_RQ + h * 128 + ks * 32 + g * 8); *(bf16x8*)(qsave + ks * 16) = qfr[ks]; }
#pragma unroll 1
        for (int sI = 0; sI < 4; ++sI) {
            asm volatile("s_waitcnt vmcnt(0)" ::: "memory");
            __syncthreads();
            if (sI + 1 < nstep) dma_step(sI + 1);
            const unsigned char* Ks = lds + (sI & 1) * 49152;
            const unsigned char* Vt = Ks + 16384;
            f32x4 sc[4];
#pragma unroll
            for (int kf = 0; kf < 4; ++kf) sc[kf] = (f32x4){0.f, 0.f, 0.f, 0.f};
#pragma unroll
            for (int kb = 0; kb < 2; ++kb) {
                bf16x8 ak[2][4];
#pragma unroll
                for (int k2 = 0; k2 < 2; ++k2)
#pragma unroll
                    for (int kf = 0; kf < 4; ++kf) ak[k2][kf] = *(const bf16x8*)(Ks + (kf * 16 + lc) * 256 + ((((kb * 2 + k2) * 4 + g) ^ lc) << 4));
                __builtin_amdgcn_sched_barrier(0);
#pragma unroll
                for (int k2 = 0; k2 < 2; ++k2)
#pragma unroll
                    for (int kf = 0; kf < 4; ++kf) sc[kf] = __builtin_amdgcn_mfma_f32_16x16x32_bf16(ak[k2][kf], qfr[kb * 2 + k2], sc[kf], 0, 0, 0);
                __builtin_amdgcn_sched_barrier(0);
            }
            bf16x8 pb[2];
#pragma unroll
            for (int kf = 0; kf < 4; ++kf)
#pragma unroll
                for (int r = 0; r < 4; ++r) {
                    const int dd = qi - (sI * 64 + kf * 16 + g * 4 + r);
                    float wgt = 0.f;
                    if (dd >= 0) wgt += __expf(lgf * (float)dd);
                    if (dd <= 0) wgt += __expf(lgb * (float)(-dd));
                    pb[kf >> 1][(kf & 1) * 4 + r] = (short)f2bf(sc[kf][r] * wgt);
                }
#pragma unroll
            for (int s2 = 0; s2 < 2; ++s2)
#pragma unroll
                for (int db = 0; db < 2; ++db) {
                    uint2 lo[8], hi[8];
#pragma unroll
                    for (int j = 0; j < 8; ++j) {
                        const unsigned char* vr = Vt + ((db * 8 + j) * 16 + lc) * 128 + 8 * (g & 1);
                        lo[j] = *(const uint2*)(vr + (((4 * s2 + (g >> 1)) ^ vsw) << 4));
                        hi[j] = *(const uint2*)(vr + (((4 * s2 + 2 + (g >> 1)) ^ vsw) << 4));
                    }
                    __builtin_amdgcn_sched_barrier(0);
#pragma unroll
                    for (int j = 0; j < 8; ++j) {
                        union { uint4 u; bf16x8 v; } av; av.u = make_uint4(lo[j].x, lo[j].y, hi[j].x, hi[j].y);
                        acc[db * 8 + j] = __builtin_amdgcn_mfma_f32_16x16x32_bf16(av.v, pb[s2], acc[db * 8 + j], 0, 0, 0);
                    }
                    __builtin_amdgcn_sched_barrier(0);
                }
        }
    }
    if (lat) {
#pragma unroll 1
        for (int dir = 0; dir < 2; ++dir) {
            const float qs = dir == 0 ? __expf(lgf * (float)(qi + 1)) : __expf(lgb * (float)(256 - qi));
            bf16x8 qx[4];
#pragma unroll
            for (int ks = 0; ks < 4; ++ks) {
                const bf16x8 qv = *(const bf16x8*)(qsave + ks * 16);
#pragma unroll
                for (int e = 0; e < 8; ++e) qx[ks][e] = (short)f2bf(qs * bf2f((bf16_t)qv[e]));
            }
#pragma unroll
            for (int kh = 0; kh < 2; ++kh) {
                const int sI = 4 + dir * 2 + kh;
                asm volatile("s_waitcnt vmcnt(0)" ::: "memory");
                __syncthreads();
                if (sI + 1 < nstep) dma_step(sI + 1);
                const unsigned char* Vt = lds + (sI & 1) * 49152 + 16384;
#pragma unroll
                for (int db = 0; db < 4; ++db) {
                    bf16x8 as0[4], as1[4];
#pragma unroll
                    for (int j = 0; j < 4; ++j) {
                        as0[j] = *(const bf16x8*)(Vt + ((db * 4 + j) * 16 + lc) * 128 + (((0 + g) ^ vsw) << 4));
                        as1[j] = *(const bf16x8*)(Vt + ((db * 4 + j) * 16 + lc) * 128 + (((4 + g) ^ vsw) << 4));
                    }
                    __builtin_amdgcn_sched_barrier(0);
#pragma unroll
                    for (int j = 0; j < 4; ++j) {
                        acc[db * 4 + j] = __builtin_amdgcn_mfma_f32_16x16x32_bf16(as0[j], qx[kh * 2 + 0], acc[db * 4 + j], 0, 0, 0);
                        acc[db * 4 + j] = __builtin_amdgcn_mfma_f32_16x16x32_bf16(as1[j], qx[kh * 2 + 1], acc[db * 4 + j], 0, 0, 0);
                    }
                    __builtin_amdgcn_sched_barrier(0);
                }
            }
        }
    }
    float s1 = 0.f;
#pragma unroll
    for (int df = 0; df < 16; ++df) s1 += (acc[df][0] + acc[df][1]) + (acc[df][2] + acc[df][3]);
    s1 = xrow16_sum(s1);
    const float mu = s1 * (1.f / 256.f);
    float s2 = 0.f;
#pragma unroll
    for (int df = 0; df < 16; ++df)
#pragma unroll
        for (int r = 0; r < 4; ++r) { const float xc = acc[df][r] - mu; s2 += xc * xc; }
    s2 = xrow16_sum(s2);
    const float rstd = rsqrtf(s2 * (1.f / 256.f) + EPS);
#pragma unroll
    for (int df = 0; df < 16; ++df) {
        bf16_t* gp = Pb + rowq * PW + C_RG + h * 256 + df * 16 + g * 4;
        const uint2 gv = *(const uint2*)gp;
        uint2 o;
        o.x = pk2((acc[df][0] - mu) * rstd * __uint_as_float(gv.x << 16), (acc[df][1] - mu) * rstd * __uint_as_float(gv.x & 0xffff0000u));
        o.y = pk2((acc[df][2] - mu) * rstd * __uint_as_float(gv.y << 16), (acc[df][3] - mu) * rstd * __uint_as_float(gv.y & 0xffff0000u));
        *(uint2*)gp = o;
    }
}
DEV void phase_ret_out(CParams& p, int l, unsigned char* lds) {
    if (GDIM() == 256) {
        const int xg = BIDX() & 7, j = BIDX() >> 3;
        ret_out_tile(p, l, ((j >> 1) * 8 + xg) * 2 + (j & 1), lds);
        if (j < 16) ret_out_tile(p, l, 256 + ((j >> 1) * 8 + xg) * 2 + (j & 1), lds);
        return;
    }
    for (int item = BIDX(); item < 384; item += GDIM()) ret_out_tile(p, l, item, lds);
}

template <bool REV>
DEV void lru_scan16(const float (&a)[4][4], const float (&u)[4][4], float cin, int g, int lc, float (&h)[4][4], float& cout, float& Aprod) {
    float carry = cin, Ap = 1.f;
#pragma unroll
    for (int ii = 0; ii < 4; ++ii) {
        const int i = REV ? 3 - ii : ii;
        float hl[4], cp[4];
        {
            float hh = 0.f, cc = 1.f;
#pragma unroll
            for (int rr = 0; rr < 4; ++rr) { const int r = REV ? 3 - rr : rr; hh = a[i][r] * hh + u[i][r]; cc *= a[i][r]; hl[r] = hh; cp[r] = cc; }
        }
        const float As = REV ? cp[0] : cp[3], Hs = REV ? hl[0] : hl[3];
        float Ag[4], Hg[4];
        xrow16_gather(As, Ag); xrow16_gather(Hs, Hg);
        float cur = carry, mine = carry;
#pragma unroll
        for (int sI = 0; sI < 4; ++sI) {
            const int gg = REV ? 3 - sI : sI;
            mine = (g == gg) ? cur : mine;
            cur = Ag[gg] * cur + Hg[gg];
            Ap *= Ag[gg];
        }
        carry = cur;
#pragma unroll
        for (int r = 0; r < 4; ++r) h[i][r] = hl[r] + cp[r] * mine;
    }
    cout = carry; Aprod = Ap;
}

template <bool REV>
DEV void lru_dir(const unsigned char* xa, const bf16x8 (&bA)[4], const bf16x8 (&bX)[4], float ba, float bx, float c2, float cin,
                 const float (&x)[4][4], int g, int lc, float (&h)[4][4], float& cout, float& Ap) {
    f32x4 accA[4], accX[4];
#pragma unroll
    for (int i = 0; i < 4; ++i) { accA[i] = (f32x4){0.f, 0.f, 0.f, 0.f}; accX[i] = (f32x4){0.f, 0.f, 0.f, 0.f}; }
#pragma unroll
    for (int ks = 0; ks < 4; ++ks)
#pragma unroll
        for (int i = 0; i < 4; ++i) {
            const bf16x8 af = *(const bf16x8*)(xa + (i * 16 + lc) * 256 + (((ks * 4 + g) ^ lc) << 4));
            accA[i] = __builtin_amdgcn_mfma_f32_16x16x32_bf16(af, bA[ks], accA[i], 0, 0, 0);
            accX[i] = __builtin_amdgcn_mfma_f32_16x16x32_bf16(af, bX[ks], accX[i], 0, 0, 0);
        }
    float a[4][4], u[4][4];
#pragma unroll
    for (int i = 0; i < 4; ++i)
#pragma unroll
        for (int r = 0; r < 4; ++r) {
            const float rg = sigmf(accA[i][r] + ba), ig = sigmf(accX[i][r] + bx);
            const float av = __builtin_amdgcn_exp2f(rg * c2);
            a[i][r] = av;
            u[i][r] = __builtin_amdgcn_sqrtf(fmaxf(1.f - av * av, 0.f)) * (ig * x[i][r]);
        }
    lru_scan16<REV>(a, u, cin, g, lc, h, cout, Ap);
}

DEV void phase_lru_tiles(CParams& p, int l, int mode, unsigned char* lds) {
    unsigned char* xa = lds; float* hs = (float*)(lds + 16384); float* cwl = (float*)(lds + 49152); unsigned char* rawb = lds + 53248;
    bf16_t* Pb = ws_bf(p, OFF_P);
    const int tid = TIDX(), lane = tid & 63, w = __builtin_amdgcn_readfirstlane(tid >> 6), g = lane >> 4, lc = lane & 15;
    const int blk = BIDX() & 7, gstep = GDIM() >> 3;
    const int cl = w * 16 + lc, ch = blk * 128 + cl;
    for (int e = tid; e < 5 * 128; e += 512) {
        const int j = e >> 7, c = e & 127;
        cwl[e] = j < 4 ? p.conv_w[(size_t)(l * 4 + j) * D + blk * 128 + c] : p.conv_b[(size_t)l * D + blk * 128 + c];
    }
    bf16x8 bAf[4], bXf[4], bAb[4], bXb[4];
    {
        const bf16_t* W = ws_bf(p, OFF_LRUW) + ((size_t)blk * 128 + cl) * 128 + g * 8;
#pragma unroll
        for (int ks = 0; ks < 4; ++ks) {
            bAf[ks] = *(const bf16x8*)(W + ks * 32);
            bXf[ks] = *(const bf16x8*)(W + (size_t)1 * 8 * 16384 + ks * 32);
            bAb[ks] = *(const bf16x8*)(W + (size_t)2 * 8 * 16384 + ks * 32);
            bXb[ks] = *(const bf16x8*)(W + (size_t)3 * 8 * 16384 + ks * 32);
        }
    }
    const float baF = p.lru_ba[(l * 2 + 0) * D + ch], bxF = p.lru_bx[(l * 2 + 0) * D + ch];
    const float baB = p.lru_ba[(l * 2 + 1) * D + ch], bxB = p.lru_bx[(l * 2 + 1) * D + ch];
    const float c2F = -8.f * 1.4426950408889634f * softplusf(-p.lru_lambda[(l * 2 + 0) * D + ch]);
    const float c2B = -8.f * 1.4426950408889634f * softplusf(-p.lru_lambda[(l * 2 + 1) * D + ch]);
    float* LA = (float*)(p.ws + OFF_LRUC);
    float* LH = LA + 192 * 2 * 1024;
    const int chunk = tid & 15, chb = blk * 128 + chunk * 8, trow = tid >> 4;
#define LRU_PREFETCH(gcn) do { const bf16_t* src_ = Pb + (long)((gcn) * 64 - 1 + (lane >> 4)) * (long)PW + C_LX + blk * 128 + (lane & 15) * 8; \
        _Pragma("unroll") for (int q_ = 0; q_ < 3; ++q_) { const int qq_ = w + 8 * q_; if (qq_ < 17) \
            __builtin_amdgcn_global_load_lds((const unsigned*)(src_ + (long)qq_ * 4 * PW), (LAS unsigned*)((LAS unsigned char*)rawb + qq_ * 1024), 16, 0, 0); } } while (0)
    int gc = BIDX() >> 3, gend = 192, gst = gstep;
    if (mode && GDIM() == 256) { const int j = BIDX() >> 3; gc = j < 16 ? j * 5 : 80 + (j - 16) * 7; gend = gc + (j < 16 ? 5 : 7); gst = 1; }
    if (gc < gend) LRU_PREFETCH(gc);
    for (; gc < gend; gc += gst) {
        const int m0 = gc * 64;
        const bool lat = m0 >= NCTX;
        const int L = lat ? 2048 : 256, t0 = lat ? ((m0 - NCTX) & 2047) : (m0 & 255);
        asm volatile("s_waitcnt vmcnt(0)" ::: "memory");
        __syncthreads();
#pragma unroll
        for (int i = 0; i < 2; ++i) {
            const int tt = trow + 32 * i;
            float acc[8];
#pragma unroll
            for (int e = 0; e < 8; ++e) acc[e] = cwl[4 * 128 + chunk * 8 + e];
#pragma unroll
            for (int j = 0; j < 4; ++j) {
                const int tp = t0 + tt + j - 1;
                if (tp >= 0 && tp < L) {
                    const uint4 v = *(const uint4*)(rawb + (tt + j) * 256 + chunk * 16);
                    const float* cw = cwl + j * 128 + chunk * 8;
                    acc[0] += cw[0] * __uint_as_float(v.x << 16); acc[1] += cw[1] * __uint_as_float(v.x & 0xffff0000u);
                    acc[2] += cw[2] * __uint_as_float(v.y << 16); acc[3] += cw[3] * __uint_as_float(v.y & 0xffff0000u);
                    acc[4] += cw[4] * __uint_as_float(v.z << 16); acc[5] += cw[5] * __uint_as_float(v.z & 0xffff0000u);
                    acc[6] += cw[6] * __uint_as_float(v.w << 16); acc[7] += cw[7] * __uint_as_float(v.w & 0xffff0000u);
                }
            }
            uint4 o;
            o.x = pk2(acc[0], acc[1]); o.y = pk2(acc[2], acc[3]);
            o.z = pk2(acc[4], acc[5]); o.w = pk2(acc[6], acc[7]);
            *(uint4*)(xa + tt * 256 + ((chunk ^ (tt & 15)) << 4)) = o;
        }
        __syncthreads();
        if (gc + gst < gend) LRU_PREFETCH(gc + gst);
        const size_t ci = ((size_t)gc * 2) * 1024 + ch;
        const float cinF = mode ? LH[ci] : 0.f, cinB = mode ? LH[ci + 1024] : 0.f;
        uint4 gv[2];
        if (mode) {
#pragma unroll
            for (int i = 0; i < 2; ++i) gv[i] = *(const uint4*)(Pb + (size_t)(m0 + trow + 32 * i) * PW + C_LG + chb);
        }
        {
            float x[4][4];
#pragma unroll
            for (int i = 0; i < 4; ++i)
#pragma unroll
                for (int r = 0; r < 4; ++r) {
                    const int tok = i * 16 + g * 4 + r;
                    x[i][r] = bf2f(*(const bf16_t*)(xa + tok * 256 + (((cl >> 3) ^ (tok & 15)) << 4) + (cl & 7) * 2));
                }
            float h[4][4], cout, Ap;
            lru_dir<false>(xa, bAf, bXf, baF, bxF, c2F, cinF, x, g, lc, h, cout, Ap);
            if (!mode) { if (g == 0) { LA[ci] = Ap; LH[ci] = cout; } }
            else {
#pragma unroll
                for (int i = 0; i < 4; ++i)
#pragma unroll
                    for (int r = 0; r < 4; ++r) hs[(i * 16 + g * 4 + r) * 128 + cl] = h[i][r];
                if (!lat && g == 0 && t0 == 192) p.out[O_NLRU + ((size_t)((m0 >> 8) * 2 + l) * 2 + 0) * 1024 + ch] = cout;
            }
            lru_dir<true>(xa, bAb, bXb, baB, bxB, c2B, cinB, x, g, lc, h, cout, Ap);
            if (!mode) { if (g == 0) { LA[ci + 1024] = Ap; LH[ci + 1024] = cout; } }
            else {
#pragma unroll
                for (int i = 0; i < 4; ++i)
#pragma unroll
                    for (int r = 0; r < 4; ++r) hs[(i * 16 + g * 4 + r) * 128 + cl] += h[i][r];
                if (!lat && g == 0 && t0 == 0) p.out[O_NLRU + ((size_t)((m0 >> 8) * 2 + l) * 2 + 1) * 1024 + ch] = cout;
            }
        }
        if (mode) {
            __syncthreads();
#pragma unroll
            for (int i = 0; i < 2; ++i) {
                const int tt = trow + 32 * i, c8 = chunk * 8;
                const float4 h0 = *(const float4*)(hs + tt * 128 + c8), h1 = *(const float4*)(hs + tt * 128 + c8 + 4);
                uint4 o;
                o.x = pk2(h0.x * __uint_as_float(gv[i].x << 16), h0.y * __uint_as_float(gv[i].x & 0xffff0000u));
                o.y = pk2(h0.z * __uint_as_float(gv[i].y << 16), h0.w * __uint_as_float(gv[i].y & 0xffff0000u));
                o.z = pk2(h1.x * __uint_as_float(gv[i].z << 16), h1.y * __uint_as_float(gv[i].z & 0xffff0000u));
                o.w = pk2(h1.z * __uint_as_float(gv[i].w << 16), h1.w * __uint_as_float(gv[i].w & 0xffff0000u));
                *(uint4*)(Pb + (size_t)(m0 + tt) * PW + C_LG + chb) = o;
            }
        }
    }
    asm volatile("s_waitcnt vmcnt(0)" ::: "memory");
    __syncthreads();
#undef LRU_PREFETCH
}

DEV void phase_lru_carry(CParams& p, int l, int vb, int nvb) {
    float* LA = (float*)(p.ws + OFF_LRUC);
    float* LH = LA + 192 * 2 * 1024;
    const int gt = vb * 512 + TIDX(), gs = nvb * 512;
    for (int idx = gt; idx < 20 * 2 * 1024; idx += gs) {
        const int ch = idx & 1023, dir = (idx >> 10) & 1, seq = idx >> 11;
        const bool lat = seq >= 16;
        const int nch = lat ? 32 : 4;
        const int gc0 = lat ? 64 + (seq - 16) * 32 : seq * 4;
        float carry = lat ? p.state_lru[((size_t)((seq - 16) * 2 + l) * 2 + dir) * 1024 + ch] : 0.f;
        for (int s0 = 0; s0 < nch; s0 += 4) {
            float A[4], Hh[4]; size_t ci[4];
#pragma unroll
            for (int k = 0; k < 4; ++k) {
                const int sI = s0 + k, cidx = dir == 0 ? sI : nch - 1 - sI;
                ci[k] = ((size_t)(gc0 + cidx) * 2 + dir) * 1024 + ch;
                A[k] = LA[ci[k]]; Hh[k] = LH[ci[k]];
            }
#pragma unroll
            for (int k = 0; k < 4; ++k) { LH[ci[k]] = carry; carry = A[k] * carry + Hh[k]; }
        }
    }
}

DEV CParams* KARGS() { CParams* kp = (CParams*)__builtin_amdgcn_kernarg_segment_ptr(); asm volatile("" : "+s"(kp)); return kp; }

#define XB_TMO      128
#define XB_XCNT(j)  (256  + 64 * (j))
#define XB_XSUB(j)  (1280 + 64 * (j))
#define XB_XGEN(j)  (2304 + 64 * (j))
#define XB_TOP      3328
#define XB_TOPGEN   3392
#define XCD_BAR_WORDS 3456
#define XB_SPIN_CAP (1u << 18)
DEV unsigned xb_ld(unsigned* p)              { return __hip_atomic_load(p, __ATOMIC_RELAXED, __HIP_MEMORY_SCOPE_AGENT); }
DEV unsigned xb_add(unsigned* p, unsigned v) { return __hip_atomic_fetch_add(p, v, __ATOMIC_RELAXED, __HIP_MEMORY_SCOPE_AGENT); }
DEV unsigned xb_xcc_id() { return (unsigned)__builtin_amdgcn_s_getreg((3 << 11) | 20) & 0xFu; }
#define XB_SPIN(cond, bar) do { unsigned _sp = 0; while (cond) { __builtin_amdgcn_s_sleep(1); \
    if ((++_sp & 255u) == 0u) { if (xb_ld(&(bar)[XB_TMO])) break; if (_sp > XB_SPIN_CAP) { atomicAdd(&(bar)[XB_TMO], 1u); break; } } } } while (0)
struct XcdBarrier { unsigned* bar; unsigned x; volatile LAS unsigned* st; };
DEV XcdBarrier xcd_barrier_post(unsigned* bar, volatile LAS unsigned* st) {
    XcdBarrier b; b.bar = bar; b.x = xb_xcc_id(); b.st = st;
    if (threadIdx.x == 0) (void)xb_add(&bar[XB_XCNT(b.x)], 1u);
    return b;
}
DEV void xcd_barrier_complete(unsigned* bar, unsigned x, unsigned& nloc, unsigned& nx) {
    const unsigned G = gridDim.x * gridDim.y * gridDim.z;
    unsigned sum, cnt, mine, sp = 0u;
    for (;;) {
        sum = 0u; cnt = 0u; mine = 0u;
#pragma unroll
        for (unsigned j = 0; j < 16; ++j) { const unsigned c = xb_ld(&bar[XB_XCNT(j)]); sum += c; cnt += (c > 0u) ? 1u : 0u; mine = (j == x) ? c : mine; }
        if (sum == G) break;
        __builtin_amdgcn_s_sleep(1);
        if ((++sp & 255u) == 0u) { if (xb_ld(&bar[XB_TMO])) break; if (sp > XB_SPIN_CAP) { atomicAdd(&bar[XB_TMO], 1u); break; } }
    }
    nloc = mine > 0u ? mine : 1u; nx = cnt > 0u ? cnt : 1u;
}
DEV void xcd_barrier(const XcdBarrier& b0) {
    asm volatile("s_waitcnt vmcnt(0)" ::: "memory");
    __syncthreads();
    if (threadIdx.x == 0) {
        XcdBarrier b; b.x = b0.x; b.st = b0.st;
        asm volatile("" : "+s"(b.x));
        unsigned* bar = (unsigned*)(KARGS()->ws + OFF_BAR);
        __builtin_amdgcn_s_waitcnt(0);
        unsigned nloc = b.st[0], nx = b.st[1];
        if (nloc == 0u) { xcd_barrier_complete(bar, b.x, nloc, nx); b.st[0] = nloc; b.st[1] = nx; }
        const unsigned old = xb_add(&bar[XB_XSUB(b.x)], 1u);
        const unsigned gen = old / nloc;
        if (old + 1u == (gen + 1u) * nloc) {
            __builtin_amdgcn_fence(__ATOMIC_RELEASE, "agent");
            asm volatile("s_waitcnt vmcnt(0)" ::: "memory");
            const unsigned og = xb_add(&bar[XB_TOP], 1u);
            const unsigned tg = og / nx;
            if (og + 1u == (tg + 1u) * nx) xb_add(&bar[XB_TOPGEN], 1u);
            else XB_SPIN(xb_ld(&bar[XB_TOPGEN]) == tg, bar);
            __builtin_amdgcn_fence(__ATOMIC_ACQUIRE, "agent");
            xb_add(&bar[XB_XGEN(b.x)], 1u);
            asm volatile("s_waitcnt vmcnt(0)" ::: "memory");
        } else {
            XB_SPIN(xb_ld(&bar[XB_XGEN(b.x)]) == gen, bar);
            __builtin_amdgcn_fence(__ATOMIC_ACQUIRE, "agent");
            asm volatile("s_waitcnt vmcnt(0)" ::: "memory");
        }
    }
    __syncthreads();
}

enum { PH_INIT = 0, PH_PRENORM, PH_GEMM1, PH_MIX1, PH_MIX2, PH_MIX3, PH_MERGE, PH_MERGE2, PH_OUT, PH_COUNT };

DEV void run_phase(CParams& p, int ph, int l, unsigned char* lds) {
    switch (ph) {
    case PH_INIT:    phase_mod(p, (float*)lds); phase_rope_table(p); __syncthreads(); phase_convert(p, 0, (float*)lds, 0, BIDX(), GDIM()); break;
    case PH_PRENORM: phase_prenorm(p, l); break;
    case PH_GEMM1:
        phase8_gemm1(p, l, (LAS unsigned char*)lds);
        if (GDIM() != 256) phase_convert(p, l, (float*)lds, 1, BIDX(), GDIM()); else if (BIDX() >= 160) phase_convert(p, l, (float*)lds, 1, BIDX() - 160, 96);
        break;
    case PH_MIX1:    phase_attn(p, l, lds); __syncthreads(); phase_lru_tiles(p, l, 0, lds); __syncthreads(); phase_ret_kv(p, l, lds); break;
    case PH_MIX2:
        if (GDIM() == 256) {
            if (BIDX() < 192) phase8_merge(p, l, 2, (LAS unsigned char*)lds);
            else { phase_lru_carry(p, l, BIDX() - 192, 64); phase_ret_scan(p, l, BIDX() - 192, 64); }
        } else { phase_lru_carry(p, l, BIDX(), GDIM()); phase_ret_scan(p, l, BIDX(), GDIM()); }
        break;
    case PH_MIX3:    phase_lru_tiles(p, l, 1, lds); __syncthreads(); phase_ret_out(p, l, lds); break;
    case PH_MERGE:   phase8_merge(p, l, 0, (LAS unsigned char*)lds); break;
    case PH_MERGE2:  phase8_merge(p, l, 1, (LAS unsigned char*)lds); break;
    case PH_OUT:
        phase8_out(p, l, (LAS unsigned char*)lds);
        if (l == 0) { if (GDIM() != 256) phase_convert(p, 1, (float*)lds, 0, BIDX(), GDIM()); else if (BIDX() >= 192) phase_convert(p, 1, (float*)lds, 0, BIDX() - 192, 64); }
        break;
    }
}

#if !ONE_LAUNCH
__global__ void __launch_bounds__(512, 2) phase_kernel(Params p, int ph, int l) {
    extern __shared__ __attribute__((aligned(16))) unsigned char dsm[];
    run_phase(p, ph, l, dsm);
}
#else
#ifndef PROBE_MASK
#define PROBE_MASK 0
#endif
#define PROBE_MULT 8
__global__ void __launch_bounds__(512, 2) mega_kernel(Params p) {
    extern __shared__ __attribute__((aligned(16))) unsigned char dsm[];
    cg::grid_group grid = cg::this_grid();
    volatile LAS unsigned* st = (volatile LAS unsigned*)((LAS unsigned char*)dsm + g8::STAGE_BYTES);
    if (threadIdx.x < 4) st[threadIdx.x] = 0u;
    __syncthreads();
    const XcdBarrier xb = xcd_barrier_post((unsigned*)(KARGS()->ws + OFF_BAR), st);
#define GSYNC() xcd_barrier(xb)
#if PROBE_MASK
    long long t_acc = 0, t0 = 0;
#define PROBE_BEGIN(ph) if ((PROBE_MASK >> (ph)) & 1) t0 = wall_clock64();
#define PROBE_END(ph) if ((PROBE_MASK >> (ph)) & 1) t_acc += wall_clock64() - t0;
#else
#define PROBE_BEGIN(ph)
#define PROBE_END(ph)
#endif
    if (KARGS()->out == nullptr) grid.sync();
    PROBE_BEGIN(PH_INIT) run_phase(*KARGS(), PH_INIT, 0, dsm); GSYNC(); PROBE_END(PH_INIT)
    PROBE_BEGIN(PH_PRENORM) run_phase(*KARGS(), PH_PRENORM, 0, dsm); GSYNC(); PROBE_END(PH_PRENORM)
    for (int l = 0; l < 2; ++l) {
        for (int ph = PH_GEMM1; ph <= PH_OUT; ++ph) {
            PROBE_BEGIN(ph)
            run_phase(*KARGS(), ph, l, dsm);
            if (!(l == 1 && ph == PH_OUT)) GSYNC();
            PROBE_END(ph)
        }
    }
#if PROBE_MASK
    if (blockIdx.x == 0 && threadIdx.x == 0) {
        const long long tgt = wall_clock64() + (long long)PROBE_MULT * t_acc;
        while (wall_clock64() < tgt) __builtin_amdgcn_s_sleep(8);
    }
#endif
}
#endif

extern "C" void kernel_launch(void* const* d_in, const int* in_sizes, int n_in,
                              void* d_out, int out_size, void* d_ws, size_t ws_size,
                              hipStream_t stream) {
    constexpr size_t kDynLds = LDS_XOFF + 5120;
    static int grid_blocks = 0;
    if (grid_blocks == 0) {
        if (n_in != 26 || ws_size < WS_NEED || out_size != 25231360) {
            fprintf(stderr, "kernel_launch: unexpected n_in %d / ws_size %zu (need %zu) / out_size %d\n", n_in, ws_size, (size_t)WS_NEED, out_size);
            grid_blocks = -1; return;
        }
        int dev = 0, cus = 0, per_cu = 0;
        (void)hipGetDevice(&dev);
        (void)hipDeviceGetAttribute(&cus, hipDeviceAttributeMultiprocessorCount, dev);
#if ONE_LAUNCH
        const void* kfn = (const void*)mega_kernel;
#else
        const void* kfn = (const void*)phase_kernel;
#endif
        if (hipFuncSetAttribute(kfn, hipFuncAttributeMaxDynamicSharedMemorySize, (int)kDynLds) != hipSuccess) {
            fprintf(stderr, "kernel_launch: hipFuncSetAttribute failed\n"); grid_blocks = -1; return;
        }
        if (hipOccupancyMaxActiveBlocksPerMultiprocessor(&per_cu, kfn, 512, kDynLds) != hipSuccess || per_cu < 1) {
            fprintf(stderr, "kernel_launch: occupancy query says %d blocks per CU\n", per_cu); grid_blocks = -1; return;
        }
        grid_blocks = cus & ~7;
    }
    if (grid_blocks < 0) return;
    Params p{};
    const float** pp = (const float**)&p;
    for (int i = 0; i < 26; ++i) pp[i] = (const float*)d_in[i];
    p.out = (float*)d_out;
    p.ws = (unsigned char*)d_ws;
#if ONE_LAUNCH
    (void)hipMemsetAsync((unsigned char*)d_ws + OFF_BAR, 0, 16384 + 1024, stream);
    void* args[] = {&p};
    hipError_t e = hipLaunchCooperativeKernel((const void*)mega_kernel, dim3(grid_blocks), dim3(512), args, kDynLds, stream);
    if (e != hipSuccess) fprintf(stderr, "cooperative launch failed: %s (grid %d)\n", hipGetErrorString(e), grid_blocks);
#else
    phase_kernel<<<grid_blocks, 512, kDynLds, stream>>>(p, PH_INIT, 0);
    phase_kernel<<<grid_blocks, 512, kDynLds, stream>>>(p, PH_PRENORM, 0);
    for (int l = 0; l < 2; ++l)
        for (int ph = PH_GEMM1; ph <= PH_OUT; ++ph)
            phase_kernel<<<grid_blocks, 512, kDynLds, stream>>>(p, ph, l);
#endif
}
```

```cpp
#include <hip/hip_runtime.h>
#include <hip/hip_cooperative_groups.h>
#include <cstdio>
#include <cstdint>
namespace cg = cooperative_groups;

#ifndef ONE_LAUNCH
#define ONE_LAUNCH 1
#endif

typedef unsigned short bf16_t;
#define DEV __device__ __forceinline__

constexpr int D = 1024;
constexpr int NCTX = 4096;
constexpr int NLAT = 8192;
constexpr int M = NCTX + NLAT;
constexpr int NW = 7680;
constexpr int N_RQ = 0, N_RK = 512, N_RV = 1024, N_RG = 2048, N_LX = 3072, N_LG = 4096,
              N_AQ = 5120, N_AK = 6144, N_AV = 6400, N_AG = 6656;
constexpr int PW = 6656;
constexpr int C_RQ = 0, C_RK = 512, C_RG = 1024, C_LX = 2048, C_LG = 3072,
              C_AQ = 4096, C_AK = 5120, C_AV = 5376, C_AG = 5632;
constexpr float EPS = 1e-6f;

constexpr size_t O_YP = 0, O_YS = 4194304, O_NK = 12582912, O_NV = 14680064, O_NRET = 16777216, O_NLRU = 25165824;

constexpr size_t OFF_MOD  = 0;
constexpr size_t OFF_LRUW = 122880;
constexpr size_t OFF_WBR  = OFF_LRUW + 1048576;
constexpr size_t OFF_WOUT = OFF_WBR + 6291456;
constexpr size_t OFF_WMG  = OFF_WOUT + 2097152;
constexpr size_t OFF_H    = OFF_WMG + 6291456;
constexpr size_t OFF_P    = OFF_H + (size_t)M * 1024 * 2;
constexpr size_t OFF_RVT  = OFF_P + (size_t)M * PW * 2;
constexpr size_t OFF_W1T  = OFF_RVT + (size_t)1024 * M * 2;
constexpr size_t OFF_OFTMP = OFF_W1T;
constexpr size_t OFF_LRUC = 262266880;
constexpr size_t OFF_ROPE = OFF_LRUC + (size_t)2 * 192 * 2 * 1024 * 4;
constexpr size_t OFF_BAR  = OFF_ROPE + (size_t)2048 * 96 * 8;
constexpr size_t OFF_XC   = OFF_BAR + 16384;
constexpr size_t OFF_XP   = OFF_XC + 1024;
constexpr size_t WS_NEED  = OFF_XP + 983040;
constexpr int LDS_XOFF = 131072 + 64;
static_assert(OFF_OFTMP + (size_t)M * 1024 * 2 <= OFF_LRUC, "overlap");
static_assert(WS_NEED <= 268435456, "ws budget");

struct Params;
typedef const __attribute__((address_space(4))) Params CParams;
struct Params {
    const float *x_prompt, *x_sample, *cache_k, *cache_v, *state_ret, *state_lru, *c, *c_ctx,
                *w_ada, *b_ada, *norm_pre, *norm_post, *w_in, *ret_decay, *conv_w, *conv_b,
                *lru_wa, *lru_ba, *lru_wx, *lru_bx, *lru_lambda, *att_sink, *w_branch, *w_merge, *b_merge, *w_out;
    float* out;
    unsigned char* ws;
};

DEV int BIDX() { int b = (int)blockIdx.x; asm volatile("" : "+s"(b)); return b; }
DEV int GDIM() { int g = (int)gridDim.x; asm volatile("" : "+s"(g)); return g; }
DEV int TIDX() { int t = threadIdx.x; asm volatile("" : "+v"(t)); return t; }
DEV float bf2f(bf16_t v) { return __uint_as_float(((unsigned)v) << 16); }
typedef __bf16 bf16x2_t __attribute__((ext_vector_type(2)));
DEV bf16_t f2bf(float f) { return __builtin_bit_cast(unsigned short, (__bf16)f); }
DEV unsigned pk2(float lo, float hi) { bf16x2_t v; v[0] = (__bf16)lo; v[1] = (__bf16)hi; return __builtin_bit_cast(unsigned, v); }
DEV float sigmf(float z) { return __builtin_amdgcn_rcpf(1.f + __builtin_amdgcn_exp2f(-1.4426950408889634f * z)); }
DEV float siluf(float x) { return x * sigmf(x); }
DEV float softplusf(float x) { return fmaxf(x, 0.f) + log1pf(__expf(-fabsf(x))); }

DEV float* ws_mod(CParams& p) { return (float*)(p.ws + OFF_MOD); }
DEV bf16_t* ws_bf(CParams& p, size_t off) { return (bf16_t*)(p.ws + off); }

DEV const float* x_row(CParams& p, int l, int m) {
    const float* xp = p.x_prompt; const float* xs = p.x_sample; const float* po = p.out;
    if (l == 0) return m < NCTX ? xp + (size_t)m * D : xs + (size_t)(m - NCTX) * D;
    return po + (size_t)m * D;
}
DEV int cond_row(int m) { return m < NCTX ? 0 : 1 + ((m - NCTX) >> 11); }

DEV float wave_sum(float v) {
#pragma unroll
    for (int o = 1; o < 64; o <<= 1) v += __shfl_xor(v, o);
    return v;
}
DEV float xrow16_max(float x) {
    auto s = __builtin_amdgcn_permlane16_swap(__float_as_uint(x), __float_as_uint(x), false, false);
    x = fmaxf(__uint_as_float(s[0]), __uint_as_float(s[1]));
    auto t = __builtin_amdgcn_permlane32_swap(__float_as_uint(x), __float_as_uint(x), false, false);
    return fmaxf(__uint_as_float(t[0]), __uint_as_float(t[1]));
}
DEV float xrow16_sum(float x) {
    auto s = __builtin_amdgcn_permlane16_swap(__float_as_uint(x), __float_as_uint(x), false, false);
    x = __uint_as_float(s[0]) + __uint_as_float(s[1]);
    auto t = __builtin_amdgcn_permlane32_swap(__float_as_uint(x), __float_as_uint(x), false, false);
    return __uint_as_float(t[0]) + __uint_as_float(t[1]);
}
DEV void xrow16_gather(float x, float (&v)[4]) {
    auto s = __builtin_amdgcn_permlane16_swap(__float_as_uint(x), __float_as_uint(x), false, false);
    auto e = __builtin_amdgcn_permlane32_swap(s[0], s[0], false, false);
    auto o = __builtin_amdgcn_permlane32_swap(s[1], s[1], false, false);
    v[0] = __uint_as_float(e[0]); v[1] = __uint_as_float(o[0]); v[2] = __uint_as_float(e[1]); v[3] = __uint_as_float(o[1]);
}
DEV void phase_mod(CParams& p, float* lds) {
    float* mod = ws_mod(p);
    float* sl = lds;
    float* part = lds + 1024;
    unsigned* lastf = (unsigned*)(lds + 1024 + 8 * 5 * 256);
    const int tid = TIDX(), lane = tid & 63, w = tid >> 6;
    const float* cctx = p.c_ctx; const float* cb_ = p.c;
    unsigned* MPu = (unsigned*)(p.ws + OFF_XP);
    unsigned* cnt = (unsigned*)(p.ws + OFF_XC) + 192;
    for (int unit = BIDX(); unit < 192; unit += GDIM()) {
        const int ks = unit & 7, cbk = (unit >> 3) % 12, l = unit / 96;
        __syncthreads();
        for (int e = tid; e < 5 * 128; e += 512) { const int r = e >> 7, k = ks * 128 + (e & 127); sl[e] = siluf(r == 0 ? cctx[k] : cb_[(r - 1) * D + k]); }
        __syncthreads();
        const float* wp = p.w_ada + ((size_t)l * D + ks * 128 + w * 16) * 3072 + cbk * 256 + lane * 4;
        float4 acc[5];
#pragma unroll
        for (int r = 0; r < 5; ++r) acc[r] = make_float4(0.f, 0.f, 0.f, 0.f);
#pragma unroll
        for (int k = 0; k < 16; ++k) {
            const float4 wv = *(const float4*)(wp + (size_t)k * 3072);
#pragma unroll
            for (int r = 0; r < 5; ++r) { const float sv = sl[r * 128 + w * 16 + k]; acc[r].x += sv * wv.x; acc[r].y += sv * wv.y; acc[r].z += sv * wv.z; acc[r].w += sv * wv.w; }
        }
#pragma unroll
        for (int r = 0; r < 5; ++r) *(float4*)(part + (w * 5 + r) * 256 + lane * 4) = acc[r];
        __syncthreads();
        unsigned* mp = MPu + (size_t)((l * 12 + cbk) * 8 + ks) * 1280;
        for (int e = tid; e < 1280; e += 512) {
            float v = 0.f;
#pragma unroll
            for (int q = 0; q < 8; ++q) v += part[q * 1280 + e];
            __hip_atomic_store(mp + e, __float_as_uint(v), __ATOMIC_RELAXED, __HIP_MEMORY_SCOPE_AGENT);
        }
        asm volatile("s_waitcnt vmcnt(0)" ::: "memory");
        __syncthreads();
        if (tid == 0) {
            const unsigned old = __hip_atomic_fetch_add(cnt + l * 12 + cbk, 1u, __ATOMIC_RELAXED, __HIP_MEMORY_SCOPE_AGENT);
            if (old == 7u) { __builtin_amdgcn_fence(__ATOMIC_ACQUIRE, "agent"); asm volatile("s_waitcnt vmcnt(0)" ::: "memory"); }
            *lastf = old == 7u ? 1u : 0u;
        }
        __syncthreads();
        if (*lastf) {
            const unsigned* m0 = MPu + (size_t)((l * 12 + cbk) * 8) * 1280;
            for (int e = tid; e < 1280; e += 512) {
                const int r = e >> 8, j = cbk * 256 + (e & 255);
                float v = p.b_ada[l * 3072 + j];
#pragma unroll
                for (int q = 0; q < 8; ++q) v += __uint_as_float(__hip_atomic_load(m0 + q * 1280 + e, __ATOMIC_RELAXED, __HIP_MEMORY_SCOPE_AGENT));
                mod[(size_t)(l * 5 + r) * 3072 + j] = v;
            }
        }
    }
    __syncthreads();
}

DEV void phase_rope_table(CParams& p) {
    float2* tab = (float2*)(p.ws + OFF_ROPE);
    const int gt = BIDX() * blockDim.x + TIDX(), gs = GDIM() * blockDim.x;
    for (int idx = gt; idx < 2048 * 96; idx += gs) {
        const int t = idx / 96, e = idx % 96;
        int a, c; float nq;
        if (e < 64) { a = e >> 5; c = e & 31; nq = 32.f; } else { a = (e - 64) >> 4; c = (e - 64) & 15; nq = 16.f; }
        const float pos = (float)(a ? (t & 63) : (t >> 6));
        const float inv = powf(10000.f, -(float)c / nq);
        float sn, cs; sincosf(pos * inv, &sn, &cs);
        tab[idx] = make_float2(cs, sn);
    }
}

DEV int w1t_row(int n) {
    if (n < N_RV) return (n & ~63) | (((n >> 4) & 1) << 5) | (((n >> 2) & 3) << 3) | (((n >> 5) & 1) << 2) | (n & 3);
    if (n < N_RG) return PW + (n - N_RV);
    const int c = n - 1024;
    if (n >= N_AQ && n < N_AV) return (c & ~31) | (((c >> 2) & 3) << 3) | (((c >> 4) & 1) << 2) | (c & 3);
    return c;
}
struct ConvTile { const float* src; bf16_t* dst; int N, K, k0, n0; bool w1; };
DEV void conv_load(const ConvTile& t, float4 (&v)[2]) {
    const int tid = TIDX();
#pragma unroll
    for (int i = 0; i < 2; ++i) v[i] = *(const float4*)(t.src + (size_t)(t.k0 + (tid >> 4) + 32 * i) * t.N + t.n0 + (tid & 15) * 4);
}
DEV void conv_park(const float4 (&v)[2], float* tile) {
    const int tid = TIDX();
#pragma unroll
    for (int i = 0; i < 2; ++i) {
        float* d = tile + ((tid >> 4) + 32 * i) * 65 + (tid & 15) * 4;
        d[0] = v[i].x; d[1] = v[i].y; d[2] = v[i].z; d[3] = v[i].w;
    }
}
DEV void conv_store(const ConvTile& t, const float* tile) {
    const int tid = TIDX();
    const int n = tid >> 3, kc = tid & 7;
    const int dr = t.w1 ? w1t_row(t.n0 + n) : t.n0 + n;
    const float* s = tile + (kc * 8) * 65 + n;
    uint4 o;
    o.x = pk2(s[0], s[65]);       o.y = pk2(s[130], s[195]);
    o.z = pk2(s[260], s[325]);    o.w = pk2(s[390], s[455]);
    *(uint4*)(t.dst + (size_t)dr * t.K + t.k0 + kc * 8) = o;
}
DEV void conv_tile(CParams& p, int l, int r, int set, ConvTile& t) {
    constexpr int T_IN = 16 * 120, T_MG = 16 * 48, T_BR = 3 * 256;
    t.K = D; t.w1 = false;
    if (set == 0) {
        if (r < T_IN) { t.src = p.w_in + (size_t)l * D * NW; t.N = NW; t.dst = ws_bf(p, OFF_W1T); t.k0 = (r / 120) * 64; t.n0 = (r % 120) * 64; t.w1 = true; return; }
        r -= T_IN;
        const int mat = r / 4, q = r % 4;
        const int dir = mat >> 4, gate = (mat >> 3) & 1, blk = mat & 7;
        const float* wa_ = p.lru_wa; const float* wx_ = p.lru_wx;
        t.src = (gate ? wx_ : wa_) + (((size_t)l * 2 + dir) * 8 + blk) * 128 * 128; t.N = 128; t.K = 128;
        t.dst = ws_bf(p, OFF_LRUW) + (size_t)mat * 128 * 128; t.k0 = (q >> 1) * 64; t.n0 = (q & 1) * 64;
        return;
    }
    if (r < T_MG) { t.src = p.w_merge + (size_t)l * D * 3072; t.N = 3072; t.dst = ws_bf(p, OFF_WMG); t.k0 = (r / 48) * 64; t.n0 = (r % 48) * 64; return; }
    r -= T_MG;
    if (r < T_BR) { const int nb = r / 256, q = r % 256;
        t.src = p.w_branch + ((size_t)l * 3 + nb) * D * D; t.N = D; t.dst = ws_bf(p, OFF_WBR) + (size_t)nb * D * D; t.k0 = (q / 16) * 64; t.n0 = (q % 16) * 64; return; }
    r -= T_BR;
    t.src = p.w_out + (size_t)l * D * D; t.N = D; t.dst = ws_bf(p, OFF_WOUT); t.k0 = (r / 16) * 64; t.n0 = (r % 16) * 64;
}
DEV void phase_convert(CParams& p, int l, float* tile, int set, int vb, int nvb) {
    const int count = set == 0 ? 16 * 120 + 32 * 4 : 16 * 48 + 3 * 256 + 256;
    for (int it = vb; it < count; it += 4 * nvb) {
        ConvTile t[4]; float4 v[4][2];
#pragma unroll
        for (int j = 0; j < 4; ++j) {
            const bool on = it + j * nvb < count;
            conv_tile(p, l, on ? it + j * nvb : it, set, t[j]);
            if (on) conv_load(t[j], v[j]);
        }
#pragma unroll
        for (int j = 0; j < 4; ++j) if (it + j * nvb < count) conv_park(v[j], tile + j * 4224);
        __syncthreads();
#pragma unroll
        for (int j = 0; j < 4; ++j) if (it + j * nvb < count) conv_store(t[j], tile + j * 4224);
        __syncthreads();
    }
}

DEV void prenorm_row(CParams& p, int l, int m, const float4 (&v)[4], int lane) {
    float ss = 0.f;
#pragma unroll
    for (int j = 0; j < 4; ++j) ss += (v[j].x * v[j].x + v[j].y * v[j].y) + (v[j].z * v[j].z + v[j].w * v[j].w);
    ss = wave_sum(ss);
    const float rstd = rsqrtf(ss * (1.f / D) + EPS);
    const float* mod = ws_mod(p) + (size_t)(l * 5 + cond_row(m)) * 3072;
    bf16_t* h = ws_bf(p, OFF_H) + (size_t)m * D;
#pragma unroll
    for (int j = 0; j < 4; ++j) {
        const int i4 = lane + 64 * j;
        const float4 g = ((const float4*)(p.norm_pre + l * D))[i4];
        const float4 sh = ((const float4*)mod)[i4];
        const float4 sc = ((const float4*)(mod + 1024))[i4];
        ushort4 o;
        o.x = f2bf(v[j].x * rstd * g.x * (1.f + sc.x) + sh.x);
        o.y = f2bf(v[j].y * rstd * g.y * (1.f + sc.y) + sh.y);
        o.z = f2bf(v[j].z * rstd * g.z * (1.f + sc.z) + sh.z);
        o.w = f2bf(v[j].w * rstd * g.w * (1.f + sc.w) + sh.w);
        ((ushort4*)h)[i4] = o;
    }
}
DEV void phase_prenorm(CParams& p, int l) {
    const int tid = TIDX(), lane = tid & 63;
    for (int m = BIDX() * 8 + (tid >> 6); m < M; m += GDIM() * 8) {
        const float4* xr = (const float4*)x_row(p, l, m);
        float4 v[4];
#pragma unroll
        for (int j = 0; j < 4; ++j) v[j] = xr[lane + 64 * j];
        prenorm_row(p, l, m, v, lane);
    }
}

typedef short bf16x8 __attribute__((ext_vector_type(8)));
typedef float f32x4 __attribute__((ext_vector_type(4)));
typedef short v4i16_t __attribute__((ext_vector_type(4)));
#define LAS __attribute__((address_space(3)))
namespace g8 {
constexpr int BK = 64, HALF = 128, HTB = HALF * BK * 2, STAGE_BYTES = 8 * HTB;
DEV int lds_byte(int r, int c) { const int st = (r >> 4) * 2 + (c >> 5), rr = r & 15, cc = c & 31, ob = rr * 64 + cc * 2; return st * 1024 + (ob ^ (((ob >> 9) & 1) << 5)); }
DEV void stage_rc(int b, int& R, int& C) { const int st = b / 1024, sb = b % 1024, swz = sb ^ (((sb >> 9) & 1) << 5); R = (st >> 1) * 16 + swz / 64; C = (st & 1) * 32 + (swz % 64) / 2; }
DEV int perm32(int rho) { const int n = rho >> 4, i = rho & 15; return 8 * (i >> 2) + 4 * n + (i & 3); }
struct Unit { const char* a; const char* b; int kind, pm, pn; unsigned lda; };

template <class Sched, class Epi>
DEV void gemm_phase(LAS unsigned char* lds, const unsigned ldb, const int nt, const Sched& S, const Epi& E) {
    const int tid = TIDX(), wid = __builtin_amdgcn_readfirstlane(tid >> 6), lane = tid & 63, wr = wid >> 2, wc = wid & 3, fr = lane & 15, fq = lane >> 4;
    unsigned rowA[2], colA[2], voffB[2];
#pragma unroll
    for (int i = 0; i < 2; ++i) { int R, C; stage_rc(tid * 16 + i * 8192, R, C); rowA[i] = (unsigned)R; colA[i] = (unsigned)C * 2u; voffB[i] = (unsigned)((R & ~31) | perm32(R & 31)) * ldb + (unsigned)C * 2u; }
    const size_t kstep = (size_t)(BK * 2);
    const size_t hstepB = (size_t)HALF * ldb;
    const unsigned ldsw = (unsigned)wid * 1024u;
    const int aoff = lds_byte(wr * 64 + fr, fq * 8), boff = lds_byte(wc * 32 + fr, fq * 8);
#define G8_SA(b, h) (((b) * 2 + (h)) * HTB)
#define G8_SB(b, h) ((4 + (b) * 2 + (h)) * HTB)
#define G8_STAGE(bufoff, gbase, voff) do { _Pragma("unroll") for (int _i = 0; _i < 2; ++_i) \
        __builtin_amdgcn_global_load_lds((const unsigned*)((const char*)(gbase) + (voff)[_i]), (LAS unsigned*)(lds + (bufoff) + ldsw + _i * 8192), 16, 0, 0); } while (0)
#define G8_STAGEA(bufoff, gbase, ld) do { _Pragma("unroll") for (int _i = 0; _i < 2; ++_i) \
        __builtin_amdgcn_global_load_lds((const unsigned*)((const char*)(gbase) + (rowA[_i] * (ld) + colA[_i])), (LAS unsigned*)(lds + (bufoff) + ldsw + _i * 8192), 16, 0, 0); } while (0)
#define G8_LDA(dst, b, h) do { _Pragma("unroll") for (int m = 0; m < 4; ++m) _Pragma("unroll") for (int k = 0; k < 2; ++k) dst[m][k] = *(const LAS bf16x8*)(lds + G8_SA(b, h) + aoff + m * 2048 + k * 1024); } while (0)
#define G8_LDB(dst, b, h) do { _Pragma("unroll") for (int n = 0; n < 2; ++n) _Pragma("unroll") for (int k = 0; k < 2; ++k) dst[n][k] = *(const LAS bf16x8*)(lds + G8_SB(b, h) + boff + n * 2048 + k * 1024); } while (0)
#define G8_MMA(ai, bj, At, Bt) do { __builtin_amdgcn_s_setprio(1); _Pragma("unroll") for (int m = 0; m < 4; ++m) _Pragma("unroll") for (int n = 0; n < 2; ++n) _Pragma("unroll") for (int k = 0; k < 2; ++k) \
        acc[ai][bj][m][n] = __builtin_amdgcn_mfma_f32_16x16x32_bf16(Bt[n][k], At[m][k], acc[ai][bj][m][n], 0, 0, 0); __builtin_amdgcn_s_setprio(0); } while (0)
#define G8_WAIT_V(n) asm volatile("s_waitcnt vmcnt(" #n ")" ::: "memory")
#define G8_WAIT_L(n) asm volatile("s_waitcnt lgkmcnt(" #n ")" ::: "memory")
#define G8_BAR __builtin_amdgcn_s_barrier()
#define G8_SCHED __builtin_amdgcn_sched_barrier(0)
    Unit cur, nxt; int ui = 0;
    if (!S.next(0, cur)) return;
    f32x4 acc[2][2][4][2];
#pragma unroll
    for (int a = 0; a < 2; ++a)
#pragma unroll
        for (int b = 0; b < 2; ++b)
#pragma unroll
            for (int m = 0; m < 4; ++m)
#pragma unroll
                for (int n = 0; n < 2; ++n) acc[a][b][m][n] = (f32x4){0.f, 0.f, 0.f, 0.f};
    bf16x8 At[4][2], B0[2][2], B1[2][2];
    const char* cA = cur.a; const char* cB = cur.b;
    unsigned ldc = cur.lda;
    G8_STAGE(G8_SB(0, 0), cB, voffB); G8_STAGE(G8_SB(0, 1), cB + hstepB, voffB); G8_STAGEA(G8_SA(0, 0), cA, ldc); G8_STAGEA(G8_SA(0, 1), cA + (size_t)HALF * ldc, ldc);
    if (wr == 1) G8_BAR;
    G8_WAIT_V(2); G8_BAR;
    G8_STAGE(G8_SB(1, 0), cB + kstep, voffB); G8_STAGEA(G8_SA(1, 0), cA + kstep, ldc); G8_STAGE(G8_SB(1, 1), cB + hstepB + kstep, voffB);
    G8_WAIT_V(6); G8_BAR;
    for (;;) {
        const bool has_next = S.next(ui + 1, nxt);
        const char* nA = has_next ? nxt.a : cA; const char* nB = has_next ? nxt.b : cB;
        const unsigned ldn = has_next ? nxt.lda : ldc;
        for (int t = 0; t < nt; t += 2) {
            const bool last = (t == nt - 2);
            const char* a1 = cA + (size_t)(t + 1) * kstep;
            const char* a2 = last ? nA : cA + (size_t)(t + 2) * kstep; const char* b2 = last ? nB : cB + (size_t)(t + 2) * kstep;
            const char* a3 = a2 + kstep; const char* b3 = b2 + kstep;
            const unsigned ld2 = last ? ldn : ldc;
            const size_t h1 = (size_t)HALF * ldc, h2 = (size_t)HALF * ld2;
            G8_LDB(B0, 0, 0); G8_LDB(B1, 0, 1); G8_SCHED; G8_LDA(At, 0, 0); G8_STAGEA(G8_SA(1, 1), a1 + h1, ldc);
            G8_WAIT_V(8); G8_WAIT_L(0); G8_BAR; G8_MMA(0, 0, At, B0); G8_MMA(0, 1, At, B1); G8_BAR; G8_SCHED;
            G8_LDA(At, 0, 1); G8_STAGE(G8_SB(0, 0), b2, voffB); G8_STAGE(G8_SB(0, 1), b2 + hstepB, voffB); G8_STAGEA(G8_SA(0, 0), a2, ld2);
            G8_WAIT_V(8); G8_WAIT_L(0); G8_BAR; G8_MMA(1, 0, At, B0); G8_MMA(1, 1, At, B1); G8_BAR; G8_SCHED;
            G8_LDB(B0, 1, 0); G8_LDB(B1, 1, 1); G8_SCHED; G8_LDA(At, 1, 0); G8_STAGEA(G8_SA(0, 1), a2 + h2, ld2);
            G8_WAIT_V(8); G8_WAIT_L(0); G8_BAR; G8_MMA(0, 0, At, B0); G8_MMA(0, 1, At, B1); G8_BAR; G8_SCHED;
            G8_LDA(At, 1, 1); G8_STAGE(G8_SB(1, 0), b3, voffB); G8_STAGE(G8_SB(1, 1), b3 + hstepB, voffB); G8_STAGEA(G8_SA(1, 0), a3, ld2);
            G8_WAIT_V(8); G8_WAIT_L(0); G8_BAR; G8_MMA(1, 0, At, B0); G8_MMA(1, 1, At, B1); G8_BAR; G8_SCHED;
        }
        if (wr == 0) G8_BAR;
        E(acc, cur, wr, wc, fr, fq);
        if (!has_next) break;
#pragma unroll
        for (int a = 0; a < 2; ++a)
#pragma unroll
            for (int b = 0; b < 2; ++b)
#pragma unroll
                for (int m = 0; m < 4; ++m)
#pragma unroll
                    for (int n = 0; n < 2; ++n) acc[a][b][m][n] = (f32x4){0.f, 0.f, 0.f, 0.f};
        cur = nxt; cA = nA; cB = nB; ldc = ldn; ++ui;
        if (wr == 1) G8_BAR;
    }
    G8_WAIT_V(0);
    G8_BAR;
#undef G8_SA
#undef G8_SB
#undef G8_STAGE
#undef G8_STAGEA
#undef G8_LDA
#undef G8_LDB
#undef G8_MMA
#undef G8_WAIT_V
#undef G8_WAIT_L
#undef G8_BAR
#undef G8_SCHED
}

DEV void grid_unit(int wgid, int nM, int nN, int& pm, int& pn) {
    const int nwg = nM * nN, q = nwg / 8, r = nwg % 8, xcd = wgid % 8, off = wgid / 8;
    wgid = (xcd < r ? xcd * (q + 1) : r * (q + 1) + (xcd - r) * q) + off;
    const int nig = 4 * nN, gid = wgid / nig, fm = gid * 4, gsz = (nM - fm) < 4 ? (nM - fm) : 4;
    pm = fm + ((wgid % nig) % gsz); pn = (wgid % nig) / gsz;
}
DEV uint2 pk4(const f32x4 v) { return make_uint2(pk2(v[0], v[1]), pk2(v[2], v[3])); }
DEV float lo16(unsigned u) { return __uint_as_float(u << 16); }
DEV float hi16(unsigned u) { return __uint_as_float(u & 0xffff0000u); }
}

struct SchedG1 {
    const char* H; const char* W; int G, c;
    DEV bool next(int i, g8::Unit& u) const {
        int L = i * G + c;
        if (L >= 1440) return false;
        if (L < 1248) { g8::grid_unit(L, 48, 26, u.pm, u.pn); u.kind = 0; u.lda = 2048u; u.a = H + (size_t)u.pm * 256 * 2048; u.b = W + (size_t)u.pn * 256 * 2048; }
        else { g8::grid_unit(L - 1248, 4, 48, u.pm, u.pn); u.kind = 0; u.lda = 2048u; u.a = W + (size_t)(PW + u.pm * 256) * 2048; u.b = H + (size_t)u.pn * 256 * 2048; u.pn += 64; }
        return true;
    }
};
struct EpiG1 {
    unsigned char* ws; float* out; int l;
    DEV void operator()(const f32x4 (&acc)[2][2][4][2], const g8::Unit& u, int wr, int wc, int fr, int fq) const {
        using namespace g8;
        bf16_t* Pb = (bf16_t*)(ws + OFF_P);
        if (u.pn >= 64) {
            bf16_t* RVT = (bf16_t*)(ws + OFF_RVT);
#pragma unroll
            for (int ai = 0; ai < 2; ++ai)
#pragma unroll
                for (int bj = 0; bj < 2; ++bj)
#pragma unroll
                    for (int m = 0; m < 4; ++m) {
                        const int ch = u.pm * 256 + ai * 128 + wr * 64 + m * 16 + fr;
                        const int tok = (u.pn - 64) * 256 + bj * 128 + wc * 32 + fq * 8;
                        const uint2 a = pk4(acc[ai][bj][m][0]), b = pk4(acc[ai][bj][m][1]);
                        *(uint4*)(RVT + (size_t)ch * M + tok) = make_uint4(a.x, a.y, b.x, b.y);
                    }
            return;
        }
        const int pn = u.pn;
        const bool rope_ret = pn < 4, rope_att = pn >= 16 && pn <= 20;
        const bool lat = u.pm >= 16;
        if (rope_ret || rope_att) {
            const int te = rope_ret ? (wc >> 1) * 32 + (wc & 1) * 16 + fq * 4 : 64 + (wc & 1) * 16 + fq * 4;
            const float sc = pn < 2 ? 0.08838834764831845f : (pn >= 16 && pn < 20) ? 0.125f * 1.4426950408889634f : 1.f;
#pragma unroll
            for (int ai = 0; ai < 2; ++ai) {
                float4 c01[4], c23[4];
                if (lat) {
#pragma unroll
                    for (int m = 0; m < 4; ++m) {
                        const int t = (u.pm * 256 + ai * 128 + wr * 64 + m * 16 + fr - NCTX) & 2047;
                        const float4* tb = (const float4*)((const float2*)(ws + OFF_ROPE) + (size_t)t * 96 + te);
                        c01[m] = tb[0]; c23[m] = tb[1];
                    }
                }
#pragma unroll
                for (int m = 0; m < 4; ++m) {
                    const int row = u.pm * 256 + ai * 128 + wr * 64 + m * 16 + fr;
                    bf16_t* Pr = Pb + (size_t)row * PW;
#pragma unroll
                    for (int bj = 0; bj < 2; ++bj) {
                        f32x4 x1 = acc[ai][bj][m][0], x2 = acc[ai][bj][m][1];
                        const int lc1 = rope_ret ? pn * 256 + bj * 128 + (wc >> 1) * 64 + (wc & 1) * 16 + fq * 4 : pn * 256 + bj * 128 + wc * 32 + fq * 4;
                        const int lc2 = rope_ret ? lc1 + 32 : lc1 + 16;
                        if (!lat && pn == 20) {
                            float* ok = out + O_NK + ((size_t)((row >> 8) * 2 + l) * 256 + (row & 255)) * 256 + (lc1 - C_AK);
                            *(float4*)ok = make_float4(x1[0], x1[1], x1[2], x1[3]);
                            *(float4*)(ok + 16) = make_float4(x2[0], x2[1], x2[2], x2[3]);
                        }
                        if (lat) {
                            const float cs[4] = {c01[m].x, c01[m].z, c23[m].x, c23[m].z}, sn[4] = {c01[m].y, c01[m].w, c23[m].y, c23[m].w};
                            f32x4 o1, o2;
#pragma unroll
                            for (int j = 0; j < 4; ++j) { o1[j] = x1[j] * cs[j] - x2[j] * sn[j]; o2[j] = x2[j] * cs[j] + x1[j] * sn[j]; }
                            x1 = o1; x2 = o2;
                        }
                        x1 *= sc; x2 *= sc;
                        const uint2 a = pk4(x1), b = pk4(x2);
                        auto sx = __builtin_amdgcn_permlane16_swap(a.x, b.x, false, false);
                        auto sy = __builtin_amdgcn_permlane16_swap(a.y, b.y, false, false);
                        *(uint4*)(Pr + ((fq & 1) ? lc2 - 4 : lc1)) = make_uint4(sx[0], sy[0], sx[1], sy[1]);
                    }
                }
            }
            return;
        }
#pragma unroll
        for (int ai = 0; ai < 2; ++ai)
#pragma unroll
            for (int m = 0; m < 4; ++m) {
                const int row = u.pm * 256 + ai * 128 + wr * 64 + m * 16 + fr;
                bf16_t* Pr = Pb + (size_t)row * PW;
#pragma unroll
                for (int bj = 0; bj < 2; ++bj) {
                    const int col = pn * 256 + bj * 128 + wc * 32 + fq * 8;
                    uint2 pk[2];
#pragma unroll
                    for (int n = 0; n < 2; ++n) {
                        f32x4 v = acc[ai][bj][m][n];
                        if (pn == 21) {
                            if (!lat) *(float4*)(out + O_NV + ((size_t)((row >> 8) * 2 + l) * 256 + (row & 255)) * 256 + (col + n * 4 - C_AV)) = make_float4(v[0], v[1], v[2], v[3]);
                        } else if (!(pn >= 8 && pn < 12)) {
#pragma unroll
                            for (int j = 0; j < 4; ++j) v[j] = siluf(v[j]);
                        }
                        pk[n] = pk4(v);
                    }
                    *(uint4*)(Pr + col) = make_uint4(pk[0].x, pk[0].y, pk[1].x, pk[1].y);
                }
            }
    }
};
DEV void phase8_gemm1(CParams& p, int l, LAS unsigned char* lds) {
    SchedG1 S{(const char*)(p.ws + OFF_H), (const char*)(p.ws + OFF_W1T), GDIM(), BIDX()};
    EpiG1 E{p.ws, p.out, l};
    g8::gemm_phase(lds, 2048u, 16, S, E);
}

constexpr size_t OFF_G2 = OFF_RVT;
struct SchedMg {
    const char *H, *P, *WMG, *WBR; int G, c, part;
    DEV void fill(g8::Unit& u, int tile, int n, int isz) const {
        u.pm = tile >> 2; u.pn = tile & 3; u.kind = n * 2 + isz;
        if (isz) { const int acol = n == 0 ? C_RG : n == 1 ? C_LG : C_AQ;
                   u.lda = (unsigned)PW * 2u; u.a = P + (size_t)u.pm * 256 * PW * 2 + (size_t)acol * 2; u.b = WBR + ((size_t)n * 1024 + u.pn * 256) * 2048; }
        else { u.lda = 2048u; u.a = H + (size_t)u.pm * 256 * 2048; u.b = WMG + ((size_t)n * 1024 + u.pn * 256) * 2048; }
    }
    DEV bool next(int i, g8::Unit& u) const {
        if (G == 256) {
            const int xg = c & 7, j = c >> 3;
            if (part == 2) {
                if (c >= 192 || i >= 1) return false;
                fill(u, xg * 24 + j, 1, 0);
            } else if (part == 0) {
                if (c < 192) { if (i >= 3) return false; if (i == 0) fill(u, xg * 24 + j, 0, 0); else fill(u, xg * 24 + j, i - 1, 1); }
                else { if (i >= 3) return false; fill(u, xg * 24 + (j - 24) * 3 + i, 2, 0); }
            } else {
                if (c >= 192 || i >= 1) return false;
                fill(u, xg * 24 + j, 2, 1);
            }
            return true;
        }
        if (part != 0) return false;
        const int tile = c + (i / 6) * G, sI = i % 6;
        if (tile >= 192) return false;
        fill(u, tile, sI >> 1, sI & 1);
        return true;
    }
};
struct EpiMg {
    unsigned char* ws; const float* bias;
    DEV bf16_t* gslot(int n, int row) const {
        bf16_t* Pb = (bf16_t*)(ws + OFF_P);
        return n == 0 ? Pb + (size_t)row * PW + C_LX : n == 1 ? Pb + (size_t)row * PW + C_AG : (bf16_t*)(ws + OFF_G2) + (size_t)row * 1024;
    }
    DEV void operator()(const f32x4 (&acc)[2][2][4][2], const g8::Unit& u, int wr, int wc, int fr, int fq) const {
        using namespace g8;
        const int n = u.kind >> 1; const bool zpass = u.kind & 1;
        const int colb = u.pn * 256 + wc * 32 + fq * 8;
        if (!zpass) {
            float4 bz[2][2];
#pragma unroll
            for (int bj = 0; bj < 2; ++bj)
#pragma unroll
                for (int nn = 0; nn < 2; ++nn) bz[bj][nn] = *(const float4*)(bias + n * 1024 + colb + bj * 128 + nn * 4);
#pragma unroll
            for (int ai = 0; ai < 2; ++ai)
#pragma unroll
                for (int m = 0; m < 4; ++m) {
                    bf16_t* gs = gslot(n, u.pm * 256 + ai * 128 + wr * 64 + m * 16 + fr);
#pragma unroll
                    for (int bj = 0; bj < 2; ++bj) {
                        uint2 pk[2];
#pragma unroll
                        for (int nn = 0; nn < 2; ++nn) {
                            f32x4 v = acc[ai][bj][m][nn];
                            v[0] = sigmf(v[0] + bz[bj][nn].x); v[1] = sigmf(v[1] + bz[bj][nn].y); v[2] = sigmf(v[2] + bz[bj][nn].z); v[3] = sigmf(v[3] + bz[bj][nn].w);
                            pk[nn] = pk4(v);
                        }
                        *(uint4*)(gs + colb + bj * 128) = make_uint4(pk[0].x, pk[0].y, pk[1].x, pk[1].y);
                    }
                }
            return;
        }
#pragma unroll
        for (int ai = 0; ai < 2; ++ai) {
            uint4 gq[4][2], tq[4][2];
#pragma unroll
            for (int m = 0; m < 4; ++m) {
                const int row = u.pm * 256 + ai * 128 + wr * 64 + m * 16 + fr;
                const bf16_t* gs = gslot(n, row);
                const bf16_t* Tr = (const bf16_t*)(ws + OFF_P) + (size_t)row * PW;
#pragma unroll
                for (int bj = 0; bj < 2; ++bj) {
                    gq[m][bj] = *(const uint4*)(gs + colb + bj * 128);
                    if (n > 0) tq[m][bj] = *(const uint4*)(Tr + colb + bj * 128);
                }
            }
#pragma unroll
            for (int m = 0; m < 4; ++m) {
                const int row = u.pm * 256 + ai * 128 + wr * 64 + m * 16 + fr;
                bf16_t* Tr = (bf16_t*)(ws + OFF_P) + (size_t)row * PW;
#pragma unroll
                for (int bj = 0; bj < 2; ++bj) {
                    f32x4 v0 = acc[ai][bj][m][0], v1 = acc[ai][bj][m][1];
                    const uint4 gv = gq[m][bj];
                    v0[0] *= lo16(gv.x); v0[1] *= hi16(gv.x); v0[2] *= lo16(gv.y); v0[3] *= hi16(gv.y);
                    v1[0] *= lo16(gv.z); v1[1] *= hi16(gv.z); v1[2] *= lo16(gv.w); v1[3] *= hi16(gv.w);
                    if (n > 0) {
                        const uint4 tv = tq[m][bj];
                        v0[0] += lo16(tv.x); v0[1] += hi16(tv.x); v0[2] += lo16(tv.y); v0[3] += hi16(tv.y);
                        v1[0] += lo16(tv.z); v1[1] += hi16(tv.z); v1[2] += lo16(tv.w); v1[3] += hi16(tv.w);
                    }
                    const uint2 p0 = pk4(v0), p1 = pk4(v1);
                    *(uint4*)(Tr + colb + bj * 128) = make_uint4(p0.x, p0.y, p1.x, p1.y);
                }
            }
        }
    }
};
DEV void phase8_merge(CParams& p, int l, int part, LAS unsigned char* lds) {
    SchedMg S{(const char*)(p.ws + OFF_H), (const char*)(p.ws + OFF_P), (const char*)(p.ws + OFF_WMG), (const char*)(p.ws + OFF_WBR), GDIM(), BIDX(), part};
    EpiMg E{p.ws, p.b_merge + (size_t)l * 3072};
    g8::gemm_phase(lds, 2048u, 16, S, E);
}

struct SchedOut {
    const char* A; const char* B; int G, c;
    DEV bool next(int i, g8::Unit& u) const {
        int tile = i * G + c;
        if (G == 256) { if (i > 0 || c >= 192) return false; tile = (c & 7) * 24 + (c >> 3); }
        if (tile >= 192) return false;
        u.pm = tile >> 2; u.pn = tile & 3; u.kind = 0; u.lda = (unsigned)PW * 2u;
        u.a = A + (size_t)u.pm * 256 * PW * 2; u.b = B + (size_t)u.pn * 256 * 2048;
        return true;
    }
};
DEV void row_exchange(unsigned char* ws, int slot, int pn, float* part, float* rs) {
    const int tid = TIDX();
    __syncthreads();
    unsigned* XPd = (unsigned*)(ws + OFF_XP) + (size_t)slot * 4 * 256;
    unsigned* cnt = (unsigned*)(ws + OFF_XC) + slot;
    if (tid < 256) {
        const float v = (part[tid] + part[256 + tid]) + (part[512 + tid] + part[768 + tid]);
        __hip_atomic_store(XPd + pn * 256 + tid, __float_as_uint(v), __ATOMIC_RELAXED, __HIP_MEMORY_SCOPE_AGENT);
    }
    asm volatile("s_waitcnt vmcnt(0)" ::: "memory");
    __syncthreads();
    if (tid == 0) {
        (void)__hip_atomic_fetch_add(cnt, 1u, __ATOMIC_RELAXED, __HIP_MEMORY_SCOPE_AGENT);
        unsigned sp = 0;
        while (__hip_atomic_load(cnt, __ATOMIC_RELAXED, __HIP_MEMORY_SCOPE_AGENT) < 4u) { __builtin_amdgcn_s_sleep(1); if (++sp > (1u << 20)) break; }
        __builtin_amdgcn_fence(__ATOMIC_ACQUIRE, "agent");
        asm volatile("s_waitcnt vmcnt(0)" ::: "memory");
    }
    __syncthreads();
    if (tid < 256) {
        float t = 0.f;
#pragma unroll
        for (int q = 0; q < 4; ++q) t += __uint_as_float(__hip_atomic_load(XPd + q * 256 + tid, __ATOMIC_RELAXED, __HIP_MEMORY_SCOPE_AGENT));
        rs[tid] = rsqrtf(t * (1.f / D) + EPS);
    }
    __syncthreads();
}
struct EpiOutPost {
    CParams* kp; int l; unsigned char* ldsx;
    DEV void row_ssq(const f32x4 (&v)[2][2][4][2], float* part, int wr, int wc, int fr, int fq) const {
#pragma unroll
        for (int ai = 0; ai < 2; ++ai)
#pragma unroll
            for (int m = 0; m < 4; ++m) {
                float ss = 0.f;
#pragma unroll
                for (int bj = 0; bj < 2; ++bj)
#pragma unroll
                    for (int n = 0; n < 2; ++n) { const f32x4 x = v[ai][bj][m][n]; ss += (x[0] * x[0] + x[1] * x[1]) + (x[2] * x[2] + x[3] * x[3]); }
                ss = xrow16_sum(ss);
                if (fq == 0) part[wc * 256 + ai * 128 + wr * 64 + m * 16 + fr] = ss;
            }
    }
    DEV void operator()(f32x4 (&acc)[2][2][4][2], const g8::Unit& u, int wr, int wc, int fr, int fq) const {
        CParams& p = *kp;
        unsigned char* ws = p.ws;
        float* part = (float*)ldsx; float* rs = part + 1024;
        const int colb = u.pn * 256 + wc * 32 + fq * 8;
        const int crow = u.pm < 16 ? 0 : 1 + ((u.pm - 16) >> 3);
        const float* mod = ws_mod(p) + (size_t)(l * 5 + crow) * 3072;
        row_ssq(acc, part, wr, wc, fr, fq);
        row_exchange(ws, (l * 2 + 0) * 48 + u.pm, u.pn, part, rs);
        {
            float4 gt[2][2], gp[2][2];
#pragma unroll
            for (int bj = 0; bj < 2; ++bj)
#pragma unroll
                for (int n = 0; n < 2; ++n) {
                    gt[bj][n] = *(const float4*)(mod + 2048 + colb + bj * 128 + n * 4);
                    gp[bj][n] = *(const float4*)(p.norm_post + l * D + colb + bj * 128 + n * 4);
                    gt[bj][n].x *= gp[bj][n].x; gt[bj][n].y *= gp[bj][n].y; gt[bj][n].z *= gp[bj][n].z; gt[bj][n].w *= gp[bj][n].w;
                }
#pragma unroll
            for (int ai = 0; ai < 2; ++ai)
#pragma unroll
                for (int mh = 0; mh < 2; ++mh) {
                    float4 xv[2][2][2];
#pragma unroll
                    for (int m2 = 0; m2 < 2; ++m2) {
                        const int row = u.pm * 256 + ai * 128 + wr * 64 + (mh * 2 + m2) * 16 + fr;
                        const float* xr = x_row(p, l, row);
#pragma unroll
                        for (int bj = 0; bj < 2; ++bj)
#pragma unroll
                            for (int n = 0; n < 2; ++n) xv[m2][bj][n] = *(const float4*)(xr + colb + bj * 128 + n * 4);
                    }
#pragma unroll
                    for (int m2 = 0; m2 < 2; ++m2) {
                        const int m = mh * 2 + m2;
                        const int rl = ai * 128 + wr * 64 + m * 16 + fr;
                        const float rstd = rs[rl];
                        float* yr = p.out + (size_t)(u.pm * 256 + rl) * D;
#pragma unroll
                        for (int bj = 0; bj < 2; ++bj)
#pragma unroll
                            for (int n = 0; n < 2; ++n) {
                                f32x4 y;
                                y[0] = xv[m2][bj][n].x + gt[bj][n].x * (acc[ai][bj][m][n][0] * rstd);
                                y[1] = xv[m2][bj][n].y + gt[bj][n].y * (acc[ai][bj][m][n][1] * rstd);
                                y[2] = xv[m2][bj][n].z + gt[bj][n].z * (acc[ai][bj][m][n][2] * rstd);
                                y[3] = xv[m2][bj][n].w + gt[bj][n].w * (acc[ai][bj][m][n][3] * rstd);
                                acc[ai][bj][m][n] = y;
                                *(float4*)(yr + colb + bj * 128 + n * 4) = make_float4(y[0], y[1], y[2], y[3]);
                            }
                    }
                }
        }
        if (l != 0) return;
        row_ssq(acc, part, wr, wc, fr, fq);
        row_exchange(ws, (l * 2 + 1) * 48 + u.pm, u.pn, part, rs);
        {
            const float* mod1 = ws_mod(p) + (size_t)(1 * 5 + crow) * 3072;
            float4 a_[2][2], b_[2][2];
#pragma unroll
            for (int bj = 0; bj < 2; ++bj)
#pragma unroll
                for (int n = 0; n < 2; ++n) {
                    const int cc = colb + bj * 128 + n * 4;
                    const float4 g = *(const float4*)(p.norm_pre + 1 * D + cc), sc = *(const float4*)(mod1 + 1024 + cc);
                    a_[bj][n] = make_float4(g.x * (1.f + sc.x), g.y * (1.f + sc.y), g.z * (1.f + sc.z), g.w * (1.f + sc.w));
                    b_[bj][n] = *(const float4*)(mod1 + cc);
                }
#pragma unroll
            for (int ai = 0; ai < 2; ++ai)
#pragma unroll
                for (int m = 0; m < 4; ++m) {
                    const int rl = ai * 128 + wr * 64 + m * 16 + fr;
                    const float rstd = rs[rl];
                    bf16_t* hr = ws_bf(p, OFF_H) + (size_t)(u.pm * 256 + rl) * D;
#pragma unroll
                    for (int bj = 0; bj < 2; ++bj) {
                        uint2 o[2];
#pragma unroll
                        for (int n = 0; n < 2; ++n) {
                            const f32x4 y = acc[ai][bj][m][n];
                            o[n].x = pk2(y[0] * rstd * a_[bj][n].x + b_[bj][n].x, y[1] * rstd * a_[bj][n].y + b_[bj][n].y);
                            o[n].y = pk2(y[2] * rstd * a_[bj][n].z + b_[bj][n].z, y[3] * rstd * a_[bj][n].w + b_[bj][n].w);
                        }
                        *(uint4*)(hr + colb + bj * 128) = make_uint4(o[0].x, o[0].y, o[1].x, o[1].y);
                    }
                }
        }
    }
};
DEV void phase8_out(CParams& p, int l, LAS unsigned char* lds) {
    SchedOut S{(const char*)(p.ws + OFF_P), (const char*)(p.ws + OFF_WOUT), GDIM(), BIDX()};
    EpiOutPost E{&p, l, (unsigned char*)lds + LDS_XOFF};
    g8::gemm_phase(lds, 2048u, 16, S, E);
}

DEV uint4 pack8(const float4 a, const float4 b) {
    uint4 r;
    r.x = pk2(a.x, a.y); r.y = pk2(a.z, a.w);
    r.z = pk2(b.x, b.y); r.w = pk2(b.z, b.w);
    return r;
}
template <int NU>
DEV void attn_item(CParams& p, int l, bool lat, int b, int hk, int qs0, unsigned char* lds) {
    bf16_t* Pb = ws_bf(p, OFF_P);
    const int tid = TIDX(), lane = tid & 63, w = tid >> 6, g = lane >> 4, lc = lane & 15;
    const int row0 = lat ? NCTX + b * 2048 : b * 256, L = lat ? 2048 : 256;
    const int hq = hk * 4 + (w & 3);
    const int qw = qs0 + (w >> 2) * 32;
    bf16x8 qfr[NU][2][2];
    f32x4 O[NU][4][2];
    float mrun[NU][2], lrun[NU][2];
    const float sink = p.att_sink[l * 16 + hq] * 1.4426950408889634f;
#pragma unroll
    for (int u = 0; u < NU; ++u)
#pragma unroll
        for (int qf = 0; qf < 2; ++qf) {
#pragma unroll
            for (int ks = 0; ks < 2; ++ks)
                qfr[u][qf][ks] = *(const bf16x8*)(Pb + (size_t)(row0 + qw + u * 64 + qf * 16 + lc) * PW + C_AQ + hq * 64 + ks * 32 + g * 8);
            mrun[u][qf] = sink; lrun[u][qf] = g == 0 ? 1.f : 0.f;
#pragma unroll
            for (int df = 0; df < 4; ++df) O[u][df][qf] = (f32x4){0.f, 0.f, 0.f, 0.f};
        }
    const int nband = lat ? 4 + NU : 4;
    const int ntile = lat ? nband + 4 : 4;
    const int qsb = qs0 >> 6;
    const int t_lo = lat ? (qsb < 2 ? 2 - qsb : 0) : 0;
    const int t_hi = lat ? ((33 - qsb) < (nband - 1) ? (33 - qsb) : (nband - 1)) : 3;
    const int fsw = (lane >> 1) & 7;
    const int srow = tid >> 3, sc8 = tid & 7;
    float4 R[4];
    auto tile_load = [&](int t) __attribute__((always_inline)) {
        if (t < nband) {
            const int kp0 = lat ? qs0 + 64 * (t - 2) : 64 * t;
            const uint4 kv = *(const uint4*)(Pb + (size_t)(row0 + kp0 + srow) * PW + C_AK + hk * 64 + sc8 * 8);
            const uint4 vv = *(const uint4*)(Pb + (size_t)(row0 + kp0 + srow) * PW + C_AV + hk * 64 + sc8 * 8);
            R[0] = make_float4(__uint_as_float(kv.x), __uint_as_float(kv.y), __uint_as_float(kv.z), __uint_as_float(kv.w));
            R[2] = make_float4(__uint_as_float(vv.x), __uint_as_float(vv.y), __uint_as_float(vv.z), __uint_as_float(vv.w));
        } else {
            const int j0 = (t - nband) * 64;
            const float* ck = p.cache_k + (size_t)((b * 2 + l) * 256 + j0) * 256 + hk * 64;
            const float* cv = p.cache_v + (size_t)((b * 2 + l) * 256 + j0) * 256 + hk * 64;
            R[0] = *(const float4*)(ck + (size_t)srow * 256 + sc8 * 8); R[1] = *(const float4*)(ck + (size_t)srow * 256 + sc8 * 8 + 4);
            R[2] = *(const float4*)(cv + (size_t)srow * 256 + sc8 * 8); R[3] = *(const float4*)(cv + (size_t)srow * 256 + sc8 * 8 + 4);
        }
    };
    auto tile_store = [&](bool cache_t, unsigned char* KsB, unsigned char* VtB) __attribute__((always_inline)) {
        uint4 kq, vq;
        if (!cache_t) {
            kq = make_uint4(__float_as_uint(R[0].x), __float_as_uint(R[0].y), __float_as_uint(R[0].z), __float_as_uint(R[0].w));
            vq = make_uint4(__float_as_uint(R[2].x), __float_as_uint(R[2].y), __float_as_uint(R[2].z), __float_as_uint(R[2].w));
        } else { kq = pack8(R[0], R[1]); vq = pack8(R[2], R[3]); }
        *(uint4*)(KsB + srow * 128 + ((sc8 ^ ((srow >> 1) & 7)) << 4)) = kq;
        *(uint4*)(VtB + srow * 128 + ((sc8 ^ (((srow >> 1) & 3) << 1)) << 4)) = vq;
    };
    int t = t_lo;
    tile_load(t);
    __syncthreads();
    tile_store(t >= nband, lds, lds + 8192);
    int tn = (lat && t == t_hi) ? nband : t + 1;
    if (tn < ntile) tile_load(tn);
    int cur = 0;
    while (t < ntile) {
        const bool cache = t >= nband;
        const int kp0 = lat ? qs0 + 64 * (t - 2) : 64 * t;
        const unsigned char* Ks = lds + cur * 16384; const unsigned char* Vt = Ks + 8192;
        __syncthreads();
        int tnn = ntile;
        if (tn < ntile) {
            tile_store(tn >= nband, lds + (cur ^ 1) * 16384, lds + (cur ^ 1) * 16384 + 8192);
            tnn = (lat && tn == t_hi) ? nband : tn + 1;
            if (tnn < ntile) tile_load(tnn);
        }
#pragma unroll
        for (int u = 0; u < NU; ++u) {
            const int tu = t - u;
            if (lat && !cache && (tu < 0 || tu > 4)) continue;
            __builtin_amdgcn_s_setprio(1);
            f32x4 sc[4][2];
#pragma unroll
            for (int kf = 0; kf < 4; ++kf)
#pragma unroll
                for (int qf = 0; qf < 2; ++qf) sc[kf][qf] = (f32x4){0.f, 0.f, 0.f, 0.f};
#pragma unroll
            for (int ks = 0; ks < 2; ++ks) {
                bf16x8 ak[4];
#pragma unroll
                for (int kf = 0; kf < 4; ++kf) ak[kf] = *(const bf16x8*)(Ks + (kf * 16 + lc) * 128 + (((ks * 4 + g) ^ fsw) << 4));
#pragma unroll
                for (int kf = 0; kf < 4; ++kf)
#pragma unroll
                    for (int qf = 0; qf < 2; ++qf)
                        sc[kf][qf] = __builtin_amdgcn_mfma_f32_16x16x32_bf16(ak[kf], qfr[u][qf][ks], sc[kf][qf], 0, 0, 0);
            }
            __builtin_amdgcn_s_setprio(0);
            if (lat && !cache && (tu == 0 || tu == 4)) {
#pragma unroll
                for (int kf = 0; kf < 4; ++kf)
#pragma unroll
                    for (int qf = 0; qf < 2; ++qf)
#pragma unroll
                        for (int r = 0; r < 4; ++r) {
                            const int kpos = kp0 + kf * 16 + g * 4 + r, qpos = qw + u * 64 + qf * 16 + lc;
                            const int dd = qpos - kpos;
                            if (dd > 128 || dd < -128) sc[kf][qf][r] = -INFINITY;
                        }
            }
            bf16x8 pb[2][2];
#pragma unroll
            for (int qf = 0; qf < 2; ++qf) {
                float mx = -INFINITY;
#pragma unroll
                for (int kf = 0; kf < 4; ++kf)
#pragma unroll
                    for (int r = 0; r < 4; ++r) mx = fmaxf(mx, sc[kf][qf][r]);
                mx = xrow16_max(mx);
                const float mnew = fmaxf(mrun[u][qf], mx);
                const float alpha = __builtin_amdgcn_exp2f(mrun[u][qf] - mnew);
                mrun[u][qf] = mnew;
                float ps = 0.f;
#pragma unroll
                for (int kf = 0; kf < 4; ++kf)
#pragma unroll
                    for (int r = 0; r < 4; ++r) { const float e = __builtin_amdgcn_exp2f(sc[kf][qf][r] - mnew); sc[kf][qf][r] = e; ps += e; }
                lrun[u][qf] = lrun[u][qf] * alpha + ps;
#pragma unroll
                for (int df = 0; df < 4; ++df) O[u][df][qf] *= alpha;
#pragma unroll
                for (int s2 = 0; s2 < 2; ++s2) {
                    bf16x8 v;
#pragma unroll
                    for (int r = 0; r < 4; ++r) { v[r] = (short)f2bf(sc[2 * s2][qf][r]); v[4 + r] = (short)f2bf(sc[2 * s2 + 1][qf][r]); }
                    pb[s2][qf] = v;
                }
            }
            __builtin_amdgcn_s_setprio(1);
#pragma unroll
            for (int s2 = 0; s2 < 2; ++s2)
#pragma unroll
                for (int df = 0; df < 4; ++df) {
                    const int vrow = 32 * s2 + 4 * g + (lc >> 2);
                    const unsigned char* vr = Vt + vrow * 128 + (((2 * df + ((lc >> 1) & 1)) ^ (((vrow >> 1) & 3) << 1)) << 4) + 8 * (lc & 1);
                    const v4i16_t lo = __builtin_amdgcn_ds_read_tr16_b64_v4i16((LAS v4i16_t*)vr);
                    const v4i16_t hi = __builtin_amdgcn_ds_read_tr16_b64_v4i16((LAS v4i16_t*)(vr + 2048));
                    union { v4i16_t h[2]; bf16x8 v; } av; av.h[0] = lo; av.h[1] = hi;
#pragma unroll
                    for (int qf = 0; qf < 2; ++qf)
                        O[u][df][qf] = __builtin_amdgcn_mfma_f32_16x16x32_bf16(av.v, pb[s2][qf], O[u][df][qf], 0, 0, 0);
                }
            __builtin_amdgcn_s_setprio(0);
        }
        t = tn; tn = tnn; cur ^= 1;
    }
#pragma unroll
    for (int u = 0; u < NU; ++u)
#pragma unroll
        for (int qf = 0; qf < 2; ++qf) {
            const float lt = xrow16_sum(lrun[u][qf]);
            const float inv = 1.f / lt;
            const size_t m = (size_t)(row0 + qw + u * 64 + qf * 16 + lc);
#pragma unroll
            for (int df = 0; df < 4; ++df) {
                const int col = hq * 64 + df * 16 + g * 4;
                const uint2 gt = *(const uint2*)(Pb + m * PW + C_AG + col);
                uint2 o;
                o.x = pk2(O[u][df][qf][0] * inv * __uint_as_float(gt.x << 16), O[u][df][qf][1] * inv * __uint_as_float(gt.x & 0xffff0000u));
                o.y = pk2(O[u][df][qf][2] * inv * __uint_as_float(gt.y << 16), O[u][df][qf][3] * inv * __uint_as_float(gt.y & 0xffff0000u));
                *(uint2*)(Pb + m * PW + C_AQ + col) = o;
            }
        }
}
DEV void phase_attn(CParams& p, int l, unsigned char* lds) {
    if (GDIM() == 256) {
        const int xg = BIDX() & 7, j = BIDX() >> 3;
        { const int grp = xg * 2 + (j >> 4); attn_item<2>(p, l, true, grp >> 2, grp & 3, (j & 15) * 128, lds); }
        { const int grp = xg * 8 + (j >> 2); attn_item<1>(p, l, false, grp >> 2, grp & 3, (j & 3) * 64, lds); }
        return;
    }
    for (int item = BIDX(); item < 768; item += GDIM()) {
        if (item < 512) attn_item<1>(p, l, true, item >> 7, (item >> 5) & 3, (item & 31) * 64, lds);
        else { const int it = item - 512; attn_item<1>(p, l, false, it >> 4, (it >> 2) & 3, (it & 3) * 64, lds); }
    }
}

constexpr size_t OFF_RS = OFF_W1T;
static_assert(OFF_RS + (size_t)4 * 4 * 2 * 8 * 32768 * 2 <= OFF_LRUC, "RS overlap");
DEV float ret_logg(CParams& p, int l, int dir, int h) { return -softplusf(-p.ret_decay[(l * 2 + dir) * 4 + h]); }

DEV void ret_kv_tile(CParams& p, int l, int item, unsigned char* lds) {
    bf16_t* Pb = ws_bf(p, OFF_P); const bf16_t* RVT = ws_bf(p, OFF_RVT);
    const int tid = TIDX(), lane = tid & 63, w = __builtin_amdgcn_readfirstlane(tid >> 6), g = lane >> 4, lc = lane & 15;
    const bool lat = item < 128;
    int b, h, c;
    if (lat) { c = item & 7; h = (item >> 3) & 3; b = item >> 5; }
    else { const int it = item - 128; h = it & 3; b = it >> 2; c = 0; }
    const int row0 = lat ? NCTX + b * 2048 + c * 256 : b * 256;
    const bool doF = !lat || c < 7, doB = !lat || c > 0;
    const float lgf = ret_logg(p, l, 0, h), lgb = ret_logg(p, l, 1, h);
    const float rf = __expf(-lgf), rb = __expf(lgb);
    const int dvbase = w * 32;
    auto dma_k = [&](int st) __attribute__((always_inline)) {
        LAS unsigned char* base = (LAS unsigned char*)lds + (st & 1) * 16384;
#pragma unroll
        for (int i = 0; i < 2; ++i) {
            const int q = w * 2 + i, row = 4 * q + (lane >> 4), lch = (lane & 15) ^ (((row & 3) << 2) | ((row >> 2) & 3));
            __builtin_amdgcn_global_load_lds((const unsigned*)(Pb + (size_t)(row0 + st * 64 + row) * PW + C_RK + h * 128 + lch * 8), (LAS unsigned*)(base + q * 1024), 16, 0, 0);
        }
    };
    __syncthreads();
    dma_k(0);
    f32x4 accF[2][8], accB[2][8];
#pragma unroll
    for (int i = 0; i < 2; ++i)
#pragma unroll
        for (int j = 0; j < 8; ++j) { accF[i][j] = (f32x4){0.f, 0.f, 0.f, 0.f}; accB[i][j] = (f32x4){0.f, 0.f, 0.f, 0.f}; }
    const int tq = lc >> 2, tp = lc & 3;
#pragma unroll 1
    for (int st = 0; st < 4; ++st) {
        bf16x8 av[2][2];
#pragma unroll
        for (int ks = 0; ks < 2; ++ks)
#pragma unroll
            for (int mf = 0; mf < 2; ++mf)
                av[ks][mf] = *(const bf16x8*)(RVT + (size_t)(h * 256 + dvbase + mf * 16 + lc) * M + row0 + st * 64 + ks * 32 + g * 8);
        bf16x8 avF[2][2], avB[2][2];
#pragma unroll
        for (int ks = 0; ks < 2; ++ks) {
            const int ti0 = st * 64 + ks * 32 + g * 8;
            float wf = __expf(lgf * (float)(255 - ti0)), wb = __expf(lgb * (float)ti0);
#pragma unroll
            for (int j = 0; j < 8; ++j) {
#pragma unroll
                for (int mf = 0; mf < 2; ++mf) {
                    const float v = bf2f((bf16_t)av[ks][mf][j]);
                    avF[ks][mf][j] = (short)f2bf(v * wf); avB[ks][mf][j] = (short)f2bf(v * wb);
                }
                wf *= rf; wb *= rb;
            }
        }
        asm volatile("s_waitcnt vmcnt(0)" ::: "memory");
        __syncthreads();
        if (st + 1 < 4) dma_k(st + 1);
        const unsigned char* Kt = lds + (st & 1) * 16384;
#pragma unroll
        for (int ks = 0; ks < 2; ++ks)
#pragma unroll
            for (int nf = 0; nf < 8; ++nf) {
                const int r0 = 32 * ks + 8 * g + tq, r1 = r0 + 4;
                const unsigned char* a0 = Kt + r0 * 256 + (((2 * nf + (tp >> 1)) ^ (((r0 & 3) << 2) | ((r0 >> 2) & 3))) << 4) + 8 * (tp & 1);
                const unsigned char* a1 = Kt + r1 * 256 + (((2 * nf + (tp >> 1)) ^ (((r1 & 3) << 2) | ((r1 >> 2) & 3))) << 4) + 8 * (tp & 1);
                union { v4i16_t hlf[2]; bf16x8 v; } bk;
                bk.hlf[0] = __builtin_amdgcn_ds_read_tr16_b64_v4i16((LAS v4i16_t*)a0);
                bk.hlf[1] = __builtin_amdgcn_ds_read_tr16_b64_v4i16((LAS v4i16_t*)a1);
#pragma unroll
                for (int mf = 0; mf < 2; ++mf) {
                    accF[mf][nf] = __builtin_amdgcn_mfma_f32_16x16x32_bf16(avF[ks][mf], bk.v, accF[mf][nf], 0, 0, 0);
                    accB[mf][nf] = __builtin_amdgcn_mfma_f32_16x16x32_bf16(avB[ks][mf], bk.v, accB[mf][nf], 0, 0, 0);
                }
            }
    }
    if (lat) {
        bf16_t* dF = ws_bf(p, OFF_RS) + ((size_t)((b * 4 + h) * 2 + 0) * 8 + (c + 1)) * 32768;
        bf16_t* dB = ws_bf(p, OFF_RS) + ((size_t)((b * 4 + h) * 2 + 1) * 8 + (c - 1)) * 32768;
#pragma unroll
        for (int mf = 0; mf < 2; ++mf)
#pragma unroll
            for (int nf = 0; nf < 8; ++nf)
#pragma unroll
                for (int r = 0; r < 4; ++r) {
                    const size_t o = (size_t)(dvbase + mf * 16 + g * 4 + r) * 128 + nf * 16 + lc;
                    if (doF) dF[o] = f2bf(accF[mf][nf][r]);
                    if (doB) dB[o] = f2bf(accB[mf][nf][r]);
                }
    } else {
        float* dF = p.out + O_NRET + ((((size_t)b * 2 + l) * 2 + 0) * 4 + h) * 128 * 256;
        float* dB = p.out + O_NRET + ((((size_t)b * 2 + l) * 2 + 1) * 4 + h) * 128 * 256;
#pragma unroll
        for (int mf = 0; mf < 2; ++mf)
#pragma unroll
            for (int nf = 0; nf < 8; ++nf) {
                const size_t o = (size_t)(nf * 16 + lc) * 256 + dvbase + mf * 16 + g * 4;
                *(float4*)(dF + o) = make_float4(accF[mf][nf][0], accF[mf][nf][1], accF[mf][nf][2], accF[mf][nf][3]);
                *(float4*)(dB + o) = make_float4(accB[mf][nf][0], accB[mf][nf][1], accB[mf][nf][2], accB[mf][nf][3]);
            }
    }
}
DEV void phase_ret_kv(CParams& p, int l, unsigned char* lds) {
    for (int item = BIDX(); item < 192; item += GDIM()) ret_kv_tile(p, l, item, lds);
}

DEV void phase_ret_scan(CParams& p, int l, int vb, int nvb) {
    bf16_t* RS = ws_bf(p, OFF_RS);
    const int gt = vb * 512 + TIDX(), gs = nvb * 512;
    for (int idx = gt; idx < 4 * 4 * 2 * 4096; idx += gs) {
        const int dk0 = (idx & 15) * 8, dv = (idx >> 4) & 255, dir = (idx >> 12) & 1, h = (idx >> 13) & 3, b = idx >> 15;
        const float g256 = __expf(ret_logg(p, l, dir, h) * 256.f);
        const float* s0 = p.state_ret + (((((size_t)b * 2 + l) * 2 + dir) * 4 + h) * 128 + dk0) * 256 + dv;
        float st[8];
#pragma unroll
        for (int e = 0; e < 8; ++e) st[e] = s0[(size_t)e * 256];
        bf16_t* base = RS + (size_t)((b * 4 + h) * 2 + dir) * 8 * 32768 + dv * 128 + dk0;
        uint4 kv[7];
#pragma unroll
        for (int j = 0; j < 7; ++j) kv[j] = *(const uint4*)(base + (size_t)(dir == 0 ? j + 1 : 6 - j) * 32768);
        *(uint4*)(base + (size_t)(dir == 0 ? 0 : 7) * 32768) = make_uint4(pk2(st[0], st[1]), pk2(st[2], st[3]), pk2(st[4], st[5]), pk2(st[6], st[7]));
#pragma unroll
        for (int j = 0; j < 7; ++j) {
            st[0] = g256 * st[0] + g8::lo16(kv[j].x); st[1] = g256 * st[1] + g8::hi16(kv[j].x);
            st[2] = g256 * st[2] + g8::lo16(kv[j].y); st[3] = g256 * st[3] + g8::hi16(kv[j].y);
            st[4] = g256 * st[4] + g8::lo16(kv[j].z); st[5] = g256 * st[5] + g8::hi16(kv[j].z);
            st[6] = g256 * st[6] + g8::lo16(kv[j].w); st[7] = g256 * st[7] + g8::hi16(kv[j].w);
            *(uint4*)(base + (size_t)(dir == 0 ? j + 1 : 6 - j) * 32768) = make_uint4(pk2(st[0], st[1]), pk2(st[2], st[3]), pk2(st[4], st[5]), pk2(st[6], st[7]));
        }
    }
}

DEV void ret_out_tile(CParams& p, int l, int item, unsigned char* lds) {
    bf16_t* Pb = ws_bf(p, OFF_P); const bf16_t* RVT = ws_bf(p, OFF_RVT);
    const int tid = TIDX(), lane = tid & 63, w = __builtin_amdgcn_readfirstlane(tid >> 6), g = lane >> 4, lc = lane & 15;
    const bool lat = item < 256;
    int b, h, qb, rowc, qi0, c;
    if (lat) { qb = item & 15; h = (item >> 4) & 3; b = item >> 6; c = qb >> 1; rowc = NCTX + b * 2048 + c * 256; qi0 = (qb & 1) * 128; }
    else { const int it = item - 256; qb = it & 1; h = (it >> 1) & 3; b = it >> 3; c = 0; rowc = b * 256; qi0 = qb * 128; }
    const int qi = qi0 + w * 16 + lc;
    const size_t rowq = (size_t)(rowc + qi);
    const float lgf = ret_logg(p, l, 0, h), lgb = ret_logg(p, l, 1, h);
    const int nstep = lat ? 8 : 4;
    auto dma_step = [&](int sI) __attribute__((always_inline)) {
        LAS unsigned char* base = (LAS unsigned char*)lds + (sI & 1) * 49152;
        if (sI < 4) {
#pragma unroll
            for (int i = 0; i < 2; ++i) {
                const int q = w * 2 + i, row = 4 * q + (lane >> 4), lch = (lane & 15) ^ (row & 15);
                __builtin_amdgcn_global_load_lds((const unsigned*)(Pb + (size_t)(rowc + sI * 64 + row) * PW + C_RK + h * 128 + lch * 8), (LAS unsigned*)(base + q * 1024), 16, 0, 0);
            }
#pragma unroll
            for (int i = 0; i < 4; ++i) {
                const int q = w * 4 + i, row = 8 * q + (lane >> 3), lch = (lane & 7) ^ ((row >> 1) & 7);
                __builtin_amdgcn_global_load_lds((const unsigned*)(RVT + (size_t)(h * 256 + row) * M + rowc + sI * 64 + lch * 8), (LAS unsigned*)(base + 16384 + q * 1024), 16, 0, 0);
            }
        } else {
            const int dir = (sI - 4) >> 1, kh = (sI - 4) & 1;
            const bf16_t* Sg = ws_bf(p, OFF_RS) + ((size_t)((b * 4 + h) * 2 + dir) * 8 + c) * 32768;
#pragma unroll
            for (int i = 0; i < 4; ++i) {
                const int q = w * 4 + i, row = 8 * q + (lane >> 3), lch = (lane & 7) ^ ((row >> 1) & 7);
                __builtin_amdgcn_global_load_lds((const unsigned*)(Sg + (size_t)row * 128 + kh * 64 + lch * 8), (LAS unsigned*)(base + 16384 + q * 1024), 16, 0, 0);
            }
        }
    };
    dma_step(0);
    f32x4 acc[16];
#pragma unroll
    for (int df = 0; df < 16; ++df) acc[df] = (f32x4){0.f, 0.f, 0.f, 0.f};
    const int vsw = (lc >> 1) & 7;
    unsigned char* qsave = lds + 98304 + tid * 64;
    {
        bf16x8 qfr[4];
#pragma unroll
        for (int ks = 0; ks < 4; ++ks) { qfr[ks] = *(const bf16x8*)(Pb + rowq * PW + C_RQ + h * 128 + ks * 32 + g * 8); *(bf16x8*)(qsave + ks * 16) = qfr[ks]; }
#pragma unroll 1
        for (int sI = 0; sI < 4; ++sI) {
            asm volatile("s_waitcnt vmcnt(0)" ::: "memory");
            __syncthreads();
            if (sI + 1 < nstep) dma_step(sI + 1);
            const unsigned char* Ks = lds + (sI & 1) * 49152;
            const unsigned char* Vt = Ks + 16384;
            f32x4 sc[4];
#pragma unroll
            for (int kf = 0; kf < 4; ++kf) sc[kf] = (f32x4){0.f, 0.f, 0.f, 0.f};
#pragma unroll
            for (int kb = 0; kb < 2; ++kb) {
                bf16x8 ak[2][4];
#pragma unroll
                for (int k2 = 0; k2 < 2; ++k2)
#pragma unroll
                    for (int kf = 0; kf < 4; ++kf) ak[k2][kf] = *(const bf16x8*)(Ks + (kf * 16 + lc) * 256 + ((((kb * 2 + k2) * 4 + g) ^ lc) << 4));
                __builtin_amdgcn_sched_barrier(0);
#pragma unroll
                for (int k2 = 0; k2 < 2; ++k2)
#pragma unroll
                    for (int kf = 0; kf < 4; ++kf) sc[kf] = __builtin_amdgcn_mfma_f32_16x16x32_bf16(ak[k2][kf], qfr[kb * 2 + k2], sc[kf], 0, 0, 0);
                __builtin_amdgcn_sched_barrier(0);
            }
            bf16x8 pb[2];
#pragma unroll
            for (int kf = 0; kf < 4; ++kf)
#pragma unroll
                for (int r = 0; r < 4; ++r) {
                    const int dd = qi - (sI * 64 + kf * 16 + g * 4 + r);
                    float wgt = 0.f;
                    if (dd >= 0) wgt += __expf(lgf * (float)dd);
                    if (dd <= 0) wgt += __expf(lgb * (float)(-dd));
                    pb[kf >> 1][(kf & 1) * 4 + r] = (short)f2bf(sc[kf][r] * wgt);
                }
#pragma unroll
            for (int s2 = 0; s2 < 2; ++s2)
#pragma unroll
                for (int db = 0; db < 2; ++db) {
                    uint2 lo[8], hi[8];
#pragma unroll
                    for (int j = 0; j < 8; ++j) {
                        const unsigned char* vr = Vt + ((db * 8 + j) * 16 + lc) * 128 + 8 * (g & 1);
                        lo[j] = *(const uint2*)(vr + (((4 * s2 + (g >> 1)) ^ vsw) << 4));
                        hi[j] = *(const uint2*)(vr + (((4 * s2 + 2 + (g >> 1)) ^ vsw) << 4));
                    }
                    __builtin_amdgcn_sched_barrier(0);
#pragma unroll
                    for (int j = 0; j < 8; ++j) {
                        union { uint4 u; bf16x8 v; } av; av.u = make_uint4(lo[j].x, lo[j].y, hi[j].x, hi[j].y);
                        acc[db * 8 + j] = __builtin_amdgcn_mfma_f32_16x16x32_bf16(av.v, pb[s2], acc[db * 8 + j], 0, 0, 0);
                    }
                    __builtin_amdgcn_sched_barrier(0);
                }
        }
    }
    if (lat) {
#pragma unroll 1
        for (int dir = 0; dir < 2; ++dir) {
            const float qs = dir == 0 ? __expf(lgf * (float)(qi + 1)) : __expf(lgb * (float)(256 - qi));
            bf16x8 qx[4];
#pragma unroll
            for (int ks = 0; ks < 4; ++ks) {
                const bf16x8 qv = *(const bf16x8*)(qsave + ks * 16);
#pragma unroll
                for (int e = 0; e < 8; ++e) qx[ks][e] = (short)f2bf(qs * bf2f((bf16_t)qv[e]));
            }
#pragma unroll
            for (int kh = 0; kh < 2; ++kh) {
                const int sI = 4 + dir * 2 + kh;
                asm volatile("s_waitcnt vmcnt(0)" ::: "memory");
                __syncthreads();
                if (sI + 1 < nstep) dma_step(sI + 1);
                const unsigned char* Vt = lds + (sI & 1) * 49152 + 16384;
#pragma unroll
                for (int db = 0; db < 4; ++db) {
                    bf16x8 as0[4], as1[4];
#pragma unroll
                    for (int j = 0; j < 4; ++j) {
                        as0[j] = *(const bf16x8*)(Vt + ((db * 4 + j) * 16 + lc) * 128 + (((0 + g) ^ vsw) << 4));
                        as1[j] = *(const bf16x8*)(Vt + ((db * 4 + j) * 16 + lc) * 128 + (((4 + g) ^ vsw) << 4));
                    }
                    __builtin_amdgcn_sched_barrier(0);
#pragma unroll
                    for (int j = 0; j < 4; ++j) {
                        acc[db * 4 + j] = __builtin_amdgcn_mfma_f32_16x16x32_bf16(as0[j], qx[kh * 2 + 0], acc[db * 4 + j], 0, 0, 0);
                        acc[db * 4 + j] = __builtin_amdgcn_mfma_f32_16x16x32_bf16(as1[j], qx[kh * 2 + 1], acc[db * 4 + j], 0, 0, 0);
                    }
                    __builtin_amdgcn_sched_barrier(0);
                }
            }
        }
    }
    float s1 = 0.f;
#pragma unroll
    for (int df = 0; df < 16; ++df) s1 += (acc[df][0] + acc[df][1]) + (acc[df][2] + acc[df][3]);
    s1 = xrow16_sum(s1);
    const float mu = s1 * (1.f / 256.f);
    float s2 = 0.f;
#pragma unroll
    for (int df = 0; df < 16; ++df)
#pragma unroll
        for (int r = 0; r < 4; ++r) { const float xc = acc[df][r] - mu; s2 += xc * xc; }
    s2 = xrow16_sum(s2);
    const float rstd = rsqrtf(s2 * (1.f / 256.f) + EPS);
#pragma unroll
    for (int df = 0; df < 16; ++df) {
        bf16_t* gp = Pb + rowq * PW + C_RG + h * 256 + df * 16 + g * 4;
        const uint2 gv = *(const uint2*)gp;
        uint2 o;
        o.x = pk2((acc[df][0] - mu) * rstd * __uint_as_float(gv.x << 16), (acc[df][1] - mu) * rstd * __uint_as_float(gv.x & 0xffff0000u));
        o.y = pk2((acc[df][2] - mu) * rstd * __uint_as_float(gv.y << 16), (acc[df][3] - mu) * rstd * __uint_as_float(gv.y & 0xffff0000u));
        *(uint2*)gp = o;
    }
}
DEV void phase_ret_out(CParams& p, int l, unsigned char* lds) {
    if (GDIM() == 256) {
        const int xg = BIDX() & 7, j = BIDX() >> 3;
        ret_out_tile(p, l, ((j >> 1) * 8 + xg) * 2 + (j & 1), lds);
        if (j < 16) ret_out_tile(p, l, 256 + ((j >> 1) * 8 + xg) * 2 + (j & 1), lds);
        return;
    }
    for (int item = BIDX(); item < 384; item += GDIM()) ret_out_tile(p, l, item, lds);
}

template <bool REV>
DEV void lru_scan16(const float (&a)[4][4], const float (&u)[4][4], float cin, int g, int lc, float (&h)[4][4], float& cout, float& Aprod) {
    float carry = cin, Ap = 1.f;
#pragma unroll
    for (int ii = 0; ii < 4; ++ii) {
        const int i = REV ? 3 - ii : ii;
        float hl[4], cp[4];
        {
            float hh = 0.f, cc = 1.f;
#pragma unroll
            for (int rr = 0; rr < 4; ++rr) { const int r = REV ? 3 - rr : rr; hh = a[i][r] * hh + u[i][r]; cc *= a[i][r]; hl[r] = hh; cp[r] = cc; }
        }
        const float As = REV ? cp[0] : cp[3], Hs = REV ? hl[0] : hl[3];
        float Ag[4], Hg[4];
        xrow16_gather(As, Ag); xrow16_gather(Hs, Hg);
        float cur = carry, mine = carry;
#pragma unroll
        for (int sI = 0; sI < 4; ++sI) {
            const int gg = REV ? 3 - sI : sI;
            mine = (g == gg) ? cur : mine;
            cur = Ag[gg] * cur + Hg[gg];
            Ap *= Ag[gg];
        }
        carry = cur;
#pragma unroll
        for (int r = 0; r < 4; ++r) h[i][r] = hl[r] + cp[r] * mine;
    }
    cout = carry; Aprod = Ap;
}

template <bool REV>
DEV void lru_dir(const unsigned char* xa, const bf16x8 (&bA)[4], const bf16x8 (&bX)[4], float ba, float bx, float c2, float cin,
                 const float (&x)[4][4], int g, int lc, float (&h)[4][4], float& cout, float& Ap) {
    f32x4 accA[4], accX[4];
#pragma unroll
    for (int i = 0; i < 4; ++i) { accA[i] = (f32x4){0.f, 0.f, 0.f, 0.f}; accX[i] = (f32x4){0.f, 0.f, 0.f, 0.f}; }
#pragma unroll
    for (int ks = 0; ks < 4; ++ks)
#pragma unroll
        for (int i = 0; i < 4; ++i) {
            const bf16x8 af = *(const bf16x8*)(xa + (i * 16 + lc) * 256 + (((ks * 4 + g) ^ lc) << 4));
            accA[i] = __builtin_amdgcn_mfma_f32_16x16x32_bf16(af, bA[ks], accA[i], 0, 0, 0);
            accX[i] = __builtin_amdgcn_mfma_f32_16x16x32_bf16(af, bX[ks], accX[i], 0, 0, 0);
        }
    float a[4][4], u[4][4];
#pragma unroll
    for (int i = 0; i < 4; ++i)
#pragma unroll
        for (int r = 0; r < 4; ++r) {
            const float rg = sigmf(accA[i][r] + ba), ig = sigmf(accX[i][r] + bx);
            const float av = __builtin_amdgcn_exp2f(rg * c2);
            a[i][r] = av;
            u[i][r] = __builtin_amdgcn_sqrtf(fmaxf(1.f - av * av, 0.f)) * (ig * x[i][r]);
        }
    lru_scan16<REV>(a, u, cin, g, lc, h, cout, Ap);
}

DEV void phase_lru_tiles(CParams& p, int l, int mode, unsigned char* lds) {
    unsigned char* xa = lds; float* hs = (float*)(lds + 16384); float* cwl = (float*)(lds + 49152); unsigned char* rawb = lds + 53248;
    bf16_t* Pb = ws_bf(p, OFF_P);
    const int tid = TIDX(), lane = tid & 63, w = __builtin_amdgcn_readfirstlane(tid >> 6), g = lane >> 4, lc = lane & 15;
    const int blk = BIDX() & 7, gstep = GDIM() >> 3;
    const int cl = w * 16 + lc, ch = blk * 128 + cl;
    for (int e = tid; e < 5 * 128; e += 512) {
        const int j = e >> 7, c = e & 127;
        cwl[e] = j < 4 ? p.conv_w[(size_t)(l * 4 + j) * D + blk * 128 + c] : p.conv_b[(size_t)l * D + blk * 128 + c];
    }
    bf16x8 bAf[4], bXf[4], bAb[4], bXb[4];
    {
        const bf16_t* W = ws_bf(p, OFF_LRUW) + ((size_t)blk * 128 + cl) * 128 + g * 8;
#pragma unroll
        for (int ks = 0; ks < 4; ++ks) {
            bAf[ks] = *(const bf16x8*)(W + ks * 32);
            bXf[ks] = *(const bf16x8*)(W + (size_t)1 * 8 * 16384 + ks * 32);
            bAb[ks] = *(const bf16x8*)(W + (size_t)2 * 8 * 16384 + ks * 32);
            bXb[ks] = *(const bf16x8*)(W + (size_t)3 * 8 * 16384 + ks * 32);
        }
    }
    const float baF = p.lru_ba[(l * 2 + 0) * D + ch], bxF = p.lru_bx[(l * 2 + 0) * D + ch];
    const float baB = p.lru_ba[(l * 2 + 1) * D + ch], bxB = p.lru_bx[(l * 2 + 1) * D + ch];
    const float c2F = -8.f * 1.4426950408889634f * softplusf(-p.lru_lambda[(l * 2 + 0) * D + ch]);
    const float c2B = -8.f * 1.4426950408889634f * softplusf(-p.lru_lambda[(l * 2 + 1) * D + ch]);
    float* LA = (float*)(p.ws + OFF_LRUC);
    float* LH = LA + 192 * 2 * 1024;
    const int chunk = tid & 15, chb = blk * 128 + chunk * 8, trow = tid >> 4;
#define LRU_PREFETCH(gcn) do { const bf16_t* src_ = Pb + (long)((gcn) * 64 - 1 + (lane >> 4)) * (long)PW + C_LX + blk * 128 + (lane & 15) * 8; \
        _Pragma("unroll") for (int q_ = 0; q_ < 3; ++q_) { const int qq_ = w + 8 * q_; if (qq_ < 17) \
            __builtin_amdgcn_global_load_lds((const unsigned*)(src_ + (long)qq_ * 4 * PW), (LAS unsigned*)((LAS unsigned char*)rawb + qq_ * 1024), 16, 0, 0); } } while (0)
    int gc = BIDX() >> 3, gend = 192, gst = gstep;
    if (mode && GDIM() == 256) { const int j = BIDX() >> 3; gc = j < 16 ? j * 5 : 80 + (j - 16) * 7; gend = gc + (j < 16 ? 5 : 7); gst = 1; }
    if (gc < gend) LRU_PREFETCH(gc);
    for (; gc < gend; gc += gst) {
        const int m0 = gc * 64;
        const bool lat = m0 >= NCTX;
        const int L = lat ? 2048 : 256, t0 = lat ? ((m0 - NCTX) & 2047) : (m0 & 255);
        asm volatile("s_waitcnt vmcnt(0)" ::: "memory");
        __syncthreads();
#pragma unroll
        for (int i = 0; i < 2; ++i) {
            const int tt = trow + 32 * i;
            float acc[8];
#pragma unroll
            for (int e = 0; e < 8; ++e) acc[e] = cwl[4 * 128 + chunk * 8 + e];
#pragma unroll
            for (int j = 0; j < 4; ++j) {
                const int tp = t0 + tt + j - 1;
                if (tp >= 0 && tp < L) {
                    const uint4 v = *(const uint4*)(rawb + (tt + j) * 256 + chunk * 16);
                    const float* cw = cwl + j * 128 + chunk * 8;
                    acc[0] += cw[0] * __uint_as_float(v.x << 16); acc[1] += cw[1] * __uint_as_float(v.x & 0xffff0000u);
                    acc[2] += cw[2] * __uint_as_float(v.y << 16); acc[3] += cw[3] * __uint_as_float(v.y & 0xffff0000u);
                    acc[4] += cw[4] * __uint_as_float(v.z << 16); acc[5] += cw[5] * __uint_as_float(v.z & 0xffff0000u);
                    acc[6] += cw[6] * __uint_as_float(v.w << 16); acc[7] += cw[7] * __uint_as_float(v.w & 0xffff0000u);
                }
            }
            uint4 o;
            o.x = pk2(acc[0], acc[1]); o.y = pk2(acc[2], acc[3]);
            o.z = pk2(acc[4], acc[5]); o.w = pk2(acc[6], acc[7]);
            *(uint4*)(xa + tt * 256 + ((chunk ^ (tt & 15)) << 4)) = o;
        }
        __syncthreads();
        if (gc + gst < gend) LRU_PREFETCH(gc + gst);
        const size_t ci = ((size_t)gc * 2) * 1024 + ch;
        const float cinF = mode ? LH[ci] : 0.f, cinB = mode ? LH[ci + 1024] : 0.f;
        uint4 gv[2];
        if (mode) {
#pragma unroll
            for (int i = 0; i < 2; ++i) gv[i] = *(const uint4*)(Pb + (size_t)(m0 + trow + 32 * i) * PW + C_LG + chb);
        }
        {
            float x[4][4];
#pragma unroll
            for (int i = 0; i < 4; ++i)
#pragma unroll
                for (int r = 0; r < 4; ++r) {
                    const int tok = i * 16 + g * 4 + r;
                    x[i][r] = bf2f(*(const bf16_t*)(xa + tok * 256 + (((cl >> 3) ^ (tok & 15)) << 4) + (cl & 7) * 2));
                }
            float h[4][4], cout, Ap;
            lru_dir<false>(xa, bAf, bXf, baF, bxF, c2F, cinF, x, g, lc, h, cout, Ap);
            if (!mode) { if (g == 0) { LA[ci] = Ap; LH[ci] = cout; } }
            else {
#pragma unroll
                for (int i = 0; i < 4; ++i)
#pragma unroll
                    for (int r = 0; r < 4; ++r) hs[(i * 16 + g * 4 + r) * 128 + cl] = h[i][r];
                if (!lat && g == 0 && t0 == 192) p.out[O_NLRU + ((size_t)((m0 >> 8) * 2 + l) * 2 + 0) * 1024 + ch] = cout;
            }
            lru_dir<true>(xa, bAb, bXb, baB, bxB, c2B, cinB, x, g, lc, h, cout, Ap);
            if (!mode) { if (g == 0) { LA[ci + 1024] = Ap; LH[ci + 1024] = cout; } }
            else {
#pragma unroll
                for (int i = 0; i < 4; ++i)
#pragma unroll
                    for (int r = 0; r < 4; ++r) hs[(i * 16 + g * 4 + r) * 128 + cl] += h[i][r];
                if (!lat && g == 0 && t0 == 0) p.out[O_NLRU + ((size_t)((m0 >> 8) * 2 + l) * 2 + 1) * 1024 + ch] = cout;
            }
        }
        if (mode) {
            __syncthreads();
#pragma unroll
            for (int i = 0; i < 2; ++i) {
                const int tt = trow + 32 * i, c8 = chunk * 8;
                const float4 h0 = *(const float4*)(hs + tt * 128 + c8), h1 = *(const float4*)(hs + tt * 128 + c8 + 4);
                uint4 o;
                o.x = pk2(h0.x * __uint_as_float(gv[i].x << 16), h0.y * __uint_as_float(gv[i].x & 0xffff0000u));
                o.y = pk2(h0.z * __uint_as_float(gv[i].y << 16), h0.w * __uint_as_float(gv[i].y & 0xffff0000u));
                o.z = pk2(h1.x * __uint_as_float(gv[i].z << 16), h1.y * __uint_as_float(gv[i].z & 0xffff0000u));
                o.w = pk2(h1.z * __uint_as_float(gv[i].w << 16), h1.w * __uint_as_float(gv[i].w & 0xffff0000u));
                *(uint4*)(Pb + (size_t)(m0 + tt) * PW + C_LG + chb) = o;
            }
        }
    }
    asm volatile("s_waitcnt vmcnt(0)" ::: "memory");
    __syncthreads();
#undef LRU_PREFETCH
}

DEV void phase_lru_carry(CParams& p, int l, int vb, int nvb) {
    float* LA = (float*)(p.ws + OFF_LRUC);
    float* LH = LA + 192 * 2 * 1024;
    const int gt = vb * 512 + TIDX(), gs = nvb * 512;
    for (int idx = gt; idx < 20 * 2 * 1024; idx += gs) {
        const int ch = idx & 1023, dir = (idx >> 10) & 1, seq = idx >> 11;
        const bool lat = seq >= 16;
        const int nch = lat ? 32 : 4;
        const int gc0 = lat ? 64 + (seq - 16) * 32 : seq * 4;
        float carry = lat ? p.state_lru[((size_t)((seq - 16) * 2 + l) * 2 + dir) * 1024 + ch] : 0.f;
        for (int s0 = 0; s0 < nch; s0 += 4) {
            float A[4], Hh[4]; size_t ci[4];
#pragma unroll
            for (int k = 0; k < 4; ++k) {
                const int sI = s0 + k, cidx = dir == 0 ? sI : nch - 1 - sI;
                ci[k] = ((size_t)(gc0 + cidx) * 2 + dir) * 1024 + ch;
                A[k] = LA[ci[k]]; Hh[k] = LH[ci[k]];
            }
#pragma unroll
            for (int k = 0; k < 4; ++k) { LH[ci[k]] = carry; carry = A[k] * carry + Hh[k]; }
        }
    }
}

DEV CParams* KARGS() { CParams* kp = (CParams*)__builtin_amdgcn_kernarg_segment_ptr(); asm volatile("" : "+s"(kp)); return kp; }

#define XB_TMO      128
#define XB_XCNT(j)  (256  + 64 * (j))
#define XB_XSUB(j)  (1280 + 64 * (j))
#define XB_XGEN(j)  (2304 + 64 * (j))
#define XB_TOP      3328
#define XB_TOPGEN   3392
#define XCD_BAR_WORDS 3456
#define XB_SPIN_CAP (1u << 18)
DEV unsigned xb_ld(unsigned* p)              { return __hip_atomic_load(p, __ATOMIC_RELAXED, __HIP_MEMORY_SCOPE_AGENT); }
DEV unsigned xb_add(unsigned* p, unsigned v) { return __hip_atomic_fetch_add(p, v, __ATOMIC_RELAXED, __HIP_MEMORY_SCOPE_AGENT); }
DEV unsigned xb_xcc_id() { return (unsigned)__builtin_amdgcn_s_getreg((3 << 11) | 20) & 0xFu; }
#define XB_SPIN(cond, bar) do { unsigned _sp = 0; while (cond) { __builtin_amdgcn_s_sleep(1); \
    if ((++_sp & 255u) == 0u) { if (xb_ld(&(bar)[XB_TMO])) break; if (_sp > XB_SPIN_CAP) { atomicAdd(&(bar)[XB_TMO], 1u); break; } } } } while (0)
struct XcdBarrier { unsigned* bar; unsigned x; volatile LAS unsigned* st; };
DEV XcdBarrier xcd_barrier_post(unsigned* bar, volatile LAS unsigned* st) {
    XcdBarrier b; b.bar = bar; b.x = xb_xcc_id(); b.st = st;
    if (threadIdx.x == 0) (void)xb_add(&bar[XB_XCNT(b.x)], 1u);
    return b;
}
DEV void xcd_barrier_complete(unsigned* bar, unsigned x, unsigned& nloc, unsigned& nx) {
    const unsigned G = gridDim.x * gridDim.y * gridDim.z;
    unsigned sum, cnt, mine, sp = 0u;
    for (;;) {
        sum = 0u; cnt = 0u; mine = 0u;
#pragma unroll
        for (unsigned j = 0; j < 16; ++j) { const unsigned c = xb_ld(&bar[XB_XCNT(j)]); sum += c; cnt += (c > 0u) ? 1u : 0u; mine = (j == x) ? c : mine; }
        if (sum == G) break;
        __builtin_amdgcn_s_sleep(1);
        if ((++sp & 255u) == 0u) { if (xb_ld(&bar[XB_TMO])) break; if (sp > XB_SPIN_CAP) { atomicAdd(&bar[XB_TMO], 1u); break; } }
    }
    nloc = mine > 0u ? mine : 1u; nx = cnt > 0u ? cnt : 1u;
}
DEV void xcd_barrier(const XcdBarrier& b0) {
    asm volatile("s_waitcnt vmcnt(0)" ::: "memory");
    __syncthreads();
    if (threadIdx.x == 0) {
        XcdBarrier b; b.x = b0.x; b.st = b0.st;
        asm volatile("" : "+s"(b.x));
        unsigned* bar = (unsigned*)(KARGS()->ws + OFF_BAR);
        __builtin_amdgcn_s_waitcnt(0);
        unsigned nloc = b.st[0], nx = b.st[1];
        if (nloc == 0u) { xcd_barrier_complete(bar, b.x, nloc, nx); b.st[0] = nloc; b.st[1] = nx; }
        const unsigned old = xb_add(&bar[XB_XSUB(b.x)], 1u);
        const unsigned gen = old / nloc;
        if (old + 1u == (gen + 1u) * nloc) {
            __builtin_amdgcn_fence(__ATOMIC_RELEASE, "agent");
            asm volatile("s_waitcnt vmcnt(0)" ::: "memory");
            const unsigned og = xb_add(&bar[XB_TOP], 1u);
            const unsigned tg = og / nx;
            if (og + 1u == (tg + 1u) * nx) xb_add(&bar[XB_TOPGEN], 1u);
            else XB_SPIN(xb_ld(&bar[XB_TOPGEN]) == tg, bar);
            __builtin_amdgcn_fence(__ATOMIC_ACQUIRE, "agent");
            xb_add(&bar[XB_XGEN(b.x)], 1u);
            asm volatile("s_waitcnt vmcnt(0)" ::: "memory");
        } else {
            XB_SPIN(xb_ld(&bar[XB_XGEN(b.x)]) == gen, bar);
            __builtin_amdgcn_fence(__ATOMIC_ACQUIRE, "agent");
            asm volatile("s_waitcnt vmcnt(0)" ::: "memory");
        }
    }
    __syncthreads();
}

enum { PH_INIT = 0, PH_PRENORM, PH_GEMM1, PH_MIX1, PH_MIX2, PH_MIX3, PH_MERGE, PH_MERGE2, PH_OUT, PH_COUNT };

DEV void run_phase(CParams& p, int ph, int l, unsigned char* lds) {
    switch (ph) {
    case PH_INIT:    phase_mod(p, (float*)lds); phase_rope_table(p); __syncthreads(); phase_convert(p, 0, (float*)lds, 0, BIDX(), GDIM()); break;
    case PH_PRENORM: phase_prenorm(p, l); break;
    case PH_GEMM1:
        phase8_gemm1(p, l, (LAS unsigned char*)lds);
        if (GDIM() != 256) phase_convert(p, l, (float*)lds, 1, BIDX(), GDIM()); else if (BIDX() >= 160) phase_convert(p, l, (float*)lds, 1, BIDX() - 160, 96);
        break;
    case PH_MIX1:    phase_attn(p, l, lds); __syncthreads(); phase_lru_tiles(p, l, 0, lds); __syncthreads(); phase_ret_kv(p, l, lds); break;
    case PH_MIX2:
        if (GDIM() == 256) {
            if (BIDX() < 192) phase8_merge(p, l, 2, (LAS unsigned char*)lds);
            else { phase_lru_carry(p, l, BIDX() - 192, 64); phase_ret_scan(p, l, BIDX() - 192, 64); }
        } else { phase_lru_carry(p, l, BIDX(), GDIM()); phase_ret_scan(p, l, BIDX(), GDIM()); }
        break;
    case PH_MIX3:    phase_lru_tiles(p, l, 1, lds); __syncthreads(); phase_ret_out(p, l, lds); break;
    case PH_MERGE:   phase8_merge(p, l, 0, (LAS unsigned char*)lds); break;
    case PH_MERGE2:  phase8_merge(p, l, 1, (LAS unsigned char*)lds); break;
    case PH_OUT:
        phase8_out(p, l, (LAS unsigned char*)lds);
        if (l == 0) { if (GDIM() != 256) phase_convert(p, 1, (float*)lds, 0, BIDX(), GDIM()); else if (BIDX() >= 192) phase_convert(p, 1, (float*)lds, 0, BIDX() - 192, 64); }
        break;
    }
}

#if !ONE_LAUNCH
__global__ void __launch_bounds__(512, 2) phase_kernel(Params p, int ph, int l) {
    extern __shared__ __attribute__((aligned(16))) unsigned char dsm[];
    run_phase(p, ph, l, dsm);
}
#else
#ifndef PROBE_MASK
#define PROBE_MASK 0
#endif
#define PROBE_MULT 8
__global__ void __launch_bounds__(512, 2) mega_kernel(Params p) {
    extern __shared__ __attribute__((aligned(16))) unsigned char dsm[];
    cg::grid_group grid = cg::this_grid();
    volatile LAS unsigned* st = (volatile LAS unsigned*)((LAS unsigned char*)dsm + g8::STAGE_BYTES);
    if (threadIdx.x < 4) st[threadIdx.x] = 0u;
    __syncthreads();
    const XcdBarrier xb = xcd_barrier_post((unsigned*)(KARGS()->ws + OFF_BAR), st);
#define GSYNC() xcd_barrier(xb)
#if PROBE_MASK
    long long t_acc = 0, t0 = 0;
#define PROBE_BEGIN(ph) if ((PROBE_MASK >> (ph)) & 1) t0 = wall_clock64();
#define PROBE_END(ph) if ((PROBE_MASK >> (ph)) & 1) t_acc += wall_clock64() - t0;
#else
#define PROBE_BEGIN(ph)
#define PROBE_END(ph)
#endif
    if (KARGS()->out == nullptr) grid.sync();
    PROBE_BEGIN(PH_INIT) run_phase(*KARGS(), PH_INIT, 0, dsm); GSYNC(); PROBE_END(PH_INIT)
    PROBE_BEGIN(PH_PRENORM) run_phase(*KARGS(), PH_PRENORM, 0, dsm); GSYNC(); PROBE_END(PH_PRENORM)
    for (int l = 0; l < 2; ++l) {
        for (int ph = PH_GEMM1; ph <= PH_OUT; ++ph) {
            PROBE_BEGIN(ph)
            run_phase(*KARGS(), ph, l, dsm);
            if (!(l == 1 && ph == PH_OUT)) GSYNC();
            PROBE_END(ph)
        }
    }
#if PROBE_MASK
    if (blockIdx.x == 0 && threadIdx.x == 0) {
        const long long tgt = wall_clock64() + (long long)PROBE_MULT * t_acc;
        while (wall_clock64() < tgt) __builtin_amdgcn_s_sleep(8);
    }
#endif
}
#endif

extern "C" void kernel_launch(void* const* d_in, const int* in_sizes, int n_in,
                              void* d_out, int out_size, void* d_ws, size_t ws_size,
                              hipStream_t stream) {
    constexpr size_t kDynLds = LDS_XOFF + 5120;
    static int grid_blocks = 0;
    if (grid_blocks == 0) {
        if (n_in != 26 || ws_size < WS_NEED || out_size != 25231360) {
            fprintf(stderr, "kernel_launch: unexpected n_in %d / ws_size %zu (need %zu) / out_size %d\n", n_in, ws_size, (size_t)WS_NEED, out_size);
            grid_blocks = -1; return;
        }
        int dev = 0, cus = 0, per_cu = 0;
        (void)hipGetDevice(&dev);
        (void)hipDeviceGetAttribute(&cus, hipDeviceAttributeMultiprocessorCount, dev);
#if ONE_LAUNCH
        const void* kfn = (const void*)mega_kernel;
#else
        const void* kfn = (const void*)phase_kernel;
#endif
        if (hipFuncSetAttribute(kfn, hipFuncAttributeMaxDynamicSharedMemorySize, (int)kDynLds) != hipSuccess) {
            fprintf(stderr, "kernel_launch: hipFuncSetAttribute failed\n"); grid_blocks = -1; return;
        }
        if (hipOccupancyMaxActiveBlocksPerMultiprocessor(&per_cu, kfn, 512, kDynLds) != hipSuccess || per_cu < 1) {
            fprintf(stderr, "kernel_launch: occupancy query says %d blocks per CU\n", per_cu); grid_blocks = -1; return;
        }
        grid_blocks = cus & ~7;
    }
    if (grid_blocks < 0) return;
    Params p{};
    const float** pp = (const float**)&p;
    for (int i = 0; i < 26; ++i) pp[i] = (const float*)d_in[i];
    p.out = (float*)d_out;
    p.ws = (unsigned char*)d_ws;
#if ONE_LAUNCH
    (void)hipMemsetAsync((unsigned char*)d_ws + OFF_BAR, 0, 16384 + 1024, stream);
    void* args[] = {&p};
    hipError_t e = hipLaunchCooperativeKernel((const void*)mega_kernel, dim3(grid_blocks), dim3(512), args, kDynLds, stream);
    if (e != hipSuccess) fprintf(stderr, "cooperative launch failed: %s (grid %d)\n", hipGetErrorString(e), grid_blocks);
#else
    phase_kernel<<<grid_blocks, 512, kDynLds, stream>>>(p, PH_INIT, 0);
    phase_kernel<<<grid_blocks, 512, kDynLds, stream>>>(p, PH_PRENORM, 0);
    for (int l = 0; l < 2; ++l)
        for (int ph = PH_GEMM1; ph <= PH_OUT; ++ph)
            phase_kernel<<<grid_blocks, 512, kDynLds, stream>>>(p, ph, l);
#endif
}
```

```cpp
#include <hip/hip_runtime.h>
#include <hip/hip_cooperative_groups.h>
#include <cstdio>
#include <cstdint>
namespace cg = cooperative_groups;

#ifndef ONE_LAUNCH
#define ONE_LAUNCH 1
#endif

typedef unsigned short bf16_t;
#define DEV __device__ __forceinline__

constexpr int D = 1024;
constexpr int NCTX = 4096;
constexpr int NLAT = 8192;
constexpr int M = NCTX + NLAT;
constexpr int NW = 7680;
constexpr int N_RQ = 0, N_RK = 512, N_RV = 1024, N_RG = 2048, N_LX = 3072, N_LG = 4096,
              N_AQ = 5120, N_AK = 6144, N_AV = 6400, N_AG = 6656;
constexpr int PW = 6656;
constexpr int C_RQ = 0, C_RK = 512, C_RG = 1024, C_LX = 2048, C_LG = 3072,
              C_AQ = 4096, C_AK = 5120, C_AV = 5376, C_AG = 5632;
constexpr float EPS = 1e-6f;

constexpr size_t O_YP = 0, O_YS = 4194304, O_NK = 12582912, O_NV = 14680064, O_NRET = 16777216, O_NLRU = 25165824;

constexpr size_t OFF_MOD  = 0;
constexpr size_t OFF_LRUW = 122880;
constexpr size_t OFF_WBR  = OFF_LRUW + 1048576;
constexpr size_t OFF_WOUT = OFF_WBR + 6291456;
constexpr size_t OFF_WMG  = OFF_WOUT + 2097152;
constexpr size_t OFF_H    = OFF_WMG + 6291456;
constexpr size_t OFF_P    = OFF_H + (size_t)M * 1024 * 2;
constexpr size_t OFF_RVT  = OFF_P + (size_t)M * PW * 2;
constexpr size_t OFF_W1T  = OFF_RVT + (size_t)1024 * M * 2;
constexpr size_t OFF_OFTMP = OFF_W1T;
constexpr size_t OFF_LRUC = 262266880;
constexpr size_t OFF_ROPE = OFF_LRUC + (size_t)2 * 192 * 2 * 1024 * 4;
constexpr size_t OFF_BAR  = OFF_ROPE + (size_t)2048 * 96 * 8;
constexpr size_t OFF_XC   = OFF_BAR + 16384;
constexpr size_t OFF_XP   = OFF_XC + 1024;
constexpr size_t WS_NEED  = OFF_XP + 983040;
constexpr int LDS_XOFF = 131072 + 64;
static_assert(OFF_OFTMP + (size_t)M * 1024 * 2 <= OFF_LRUC, "overlap");
static_assert(WS_NEED <= 268435456, "ws budget");

struct Params;
typedef const __attribute__((address_space(4))) Params CParams;
struct Params {
    const float *x_prompt, *x_sample, *cache_k, *cache_v, *state_ret, *state_lru, *c, *c_ctx,
                *w_ada, *b_ada, *norm_pre, *norm_post, *w_in, *ret_decay, *conv_w, *conv_b,
                *lru_wa, *lru_ba, *lru_wx, *lru_bx, *lru_lambda, *att_sink, *w_branch, *w_merge, *b_merge, *w_out;
    float* out;
    unsigned char* ws;
};

DEV int BIDX() { int b = (int)blockIdx.x; asm volatile("" : "+s"(b)); return b; }
DEV int GDIM() { int g = (int)gridDim.x; asm volatile("" : "+s"(g)); return g; }
DEV int TIDX() { int t = threadIdx.x; asm volatile("" : "+v"(t)); return t; }
DEV float bf2f(bf16_t v) { return __uint_as_float(((unsigned)v) << 16); }
typedef __bf16 bf16x2_t __attribute__((ext_vector_type(2)));
DEV bf16_t f2bf(float f) { return __builtin_bit_cast(unsigned short, (__bf16)f); }
DEV unsigned pk2(float lo, float hi) { bf16x2_t v; v[0] = (__bf16)lo; v[1] = (__bf16)hi; return __builtin_bit_cast(unsigned, v); }
DEV float sigmf(float z) { return __builtin_amdgcn_rcpf(1.f + __builtin_amdgcn_exp2f(-1.4426950408889634f * z)); }
DEV float siluf(float x) { return x * sigmf(x); }
DEV float softplusf(float x) { return fmaxf(x, 0.f) + log1pf(__expf(-fabsf(x))); }

DEV float* ws_mod(CParams& p) { return (float*)(p.ws + OFF_MOD); }
DEV bf16_t* ws_bf(CParams& p, size_t off) { return (bf16_t*)(p.ws + off); }

DEV const float* x_row(CParams& p, int l, int m) {
    const float* xp = p.x_prompt; const float* xs = p.x_sample; const float* po = p.out;
    if (l == 0) return m < NCTX ? xp + (size_t)m * D : xs + (size_t)(m - NCTX) * D;
    return po + (size_t)m * D;
}
DEV int cond_row(int m) { return m < NCTX ? 0 : 1 + ((m - NCTX) >> 11); }

DEV float wave_sum(float v) {
#pragma unroll
    for (int o = 1; o < 64; o <<= 1) v += __shfl_xor(v, o);
    return v;
}
DEV float xrow16_max(float x) {
    auto s = __builtin_amdgcn_permlane16_swap(__float_as_uint(x), __float_as_uint(x), false, false);
    x = fmaxf(__uint_as_float(s[0]), __uint_as_float(s[1]));
    auto t = __builtin_amdgcn_permlane32_swap(__float_as_uint(x), __float_as_uint(x), false, false);
    return fmaxf(__uint_as_float(t[0]), __uint_as_float(t[1]));
}
DEV float xrow16_sum(float x) {
    auto s = __builtin_amdgcn_permlane16_swap(__float_as_uint(x), __float_as_uint(x), false, false);
    x = __uint_as_float(s[0]) + __uint_as_float(s[1]);
    auto t = __builtin_amdgcn_permlane32_swap(__float_as_uint(x), __float_as_uint(x), false, false);
    return __uint_as_float(t[0]) + __uint_as_float(t[1]);
}
DEV void xrow16_gather(float x, float (&v)[4]) {
    auto s = __builtin_amdgcn_permlane16_swap(__float_as_uint(x), __float_as_uint(x), false, false);
    auto e = __builtin_amdgcn_permlane32_swap(s[0], s[0], false, false);
    auto o = __builtin_amdgcn_permlane32_swap(s[1], s[1], false, false);
    v[0] = __uint_as_float(e[0]); v[1] = __uint_as_float(o[0]); v[2] = __uint_as_float(e[1]); v[3] = __uint_as_float(o[1]);
}
DEV void phase_mod(CParams& p, float* lds) {
    float* mod = ws_mod(p);
    float* sl = lds;
    float* part = lds + 1024;
    unsigned* lastf = (unsigned*)(lds + 1024 + 8 * 5 * 256);
    const int tid = TIDX(), lane = tid & 63, w = tid >> 6;
    const float* cctx = p.c_ctx; const float* cb_ = p.c;
    unsigned* MPu = (unsigned*)(p.ws + OFF_XP);
    unsigned* cnt = (unsigned*)(p.ws + OFF_XC) + 192;
    for (int unit = BIDX(); unit < 192; unit += GDIM()) {
        const int ks = unit & 7, cbk = (unit >> 3) % 12, l = unit / 96;
        __syncthreads();
        for (int e = tid; e < 5 * 128; e += 512) { const int r = e >> 7, k = ks * 128 + (e & 127); sl[e] = siluf(r == 0 ? cctx[k] : cb_[(r - 1) * D + k]); }
        __syncthreads();
        const float* wp = p.w_ada + ((size_t)l * D + ks * 128 + w * 16) * 3072 + cbk * 256 + lane * 4;
        float4 acc[5];
#pragma unroll
        for (int r = 0; r < 5; ++r) acc[r] = make_float4(0.f, 0.f, 0.f, 0.f);
#pragma unroll
        for (int k = 0; k < 16; ++k) {
            const float4 wv = *(const float4*)(wp + (size_t)k * 3072);
#pragma unroll
            for (int r = 0; r < 5; ++r) { const float sv = sl[r * 128 + w * 16 + k]; acc[r].x += sv * wv.x; acc[r].y += sv * wv.y; acc[r].z += sv * wv.z; acc[r].w += sv * wv.w; }
        }
#pragma unroll
        for (int r = 0; r < 5; ++r) *(float4*)(part + (w * 5 + r) * 256 + lane * 4) = acc[r];
        __syncthreads();
        unsigned* mp = MPu + (size_t)((l * 12 + cbk) * 8 + ks) * 1280;
        for (int e = tid; e < 1280; e += 512) {
            float v = 0.f;
#pragma unroll
            for (int q = 0; q < 8; ++q) v += part[q * 1280 + e];
            __hip_atomic_store(mp + e, __float_as_uint(v), __ATOMIC_RELAXED, __HIP_MEMORY_SCOPE_AGENT);
        }
        asm volatile("s_waitcnt vmcnt(0)" ::: "memory");
        __syncthreads();
        if (tid == 0) {
            const unsigned old = __hip_atomic_fetch_add(cnt + l * 12 + cbk, 1u, __ATOMIC_RELAXED, __HIP_MEMORY_SCOPE_AGENT);
            if (old == 7u) { __builtin_amdgcn_fence(__ATOMIC_ACQUIRE, "agent"); asm volatile("s_waitcnt vmcnt(0)" ::: "memory"); }
            *lastf = old == 7u ? 1u : 0u;
        }
        __syncthreads();
        if (*lastf) {
            const unsigned* m0 = MPu + (size_t)((l * 12 + cbk) * 8) * 1280;
            for (int e = tid; e < 1280; e += 512) {
                const int r = e >> 8, j = cbk * 256 + (e & 255);
                float v = p.b_ada[l * 3072 + j];
#pragma unroll
                for (int q = 0; q < 8; ++q) v += __uint_as_float(__hip_atomic_load(m0 + q * 1280 + e, __ATOMIC_RELAXED, __HIP_MEMORY_SCOPE_AGENT));
                mod[(size_t)(l * 5 + r) * 3072 + j] = v;
            }
        }
    }
    __syncthreads();
}

DEV void phase_rope_table(CParams& p) {
    float2* tab = (float2*)(p.ws + OFF_ROPE);
    const int gt = BIDX() * blockDim.x + TIDX(), gs = GDIM() * blockDim.x;
    for (int idx = gt; idx < 2048 * 96; idx += gs) {
        const int t = idx / 96, e = idx % 96;
        int a, c; float nq;
        if (e < 64) { a = e >> 5; c = e & 31; nq = 32.f; } else { a = (e - 64) >> 4; c = (e - 64) & 15; nq = 16.f; }
        const float pos = (float)(a ? (t & 63) : (t >> 6));
        const float inv = powf(10000.f, -(float)c / nq);
        float sn, cs; sincosf(pos * inv, &sn, &cs);
        tab[idx] = make_float2(cs, sn);
    }
}

DEV int w1t_row(int n) {
    if (n < N_RV) return (n & ~63) | (((n >> 4) & 1) << 5) | (((n >> 2) & 3) << 3) | (((n >> 5) & 1) << 2) | (n & 3);
    if (n < N_RG) return PW + (n - N_RV);
    const int c = n - 1024;
    if (n >= N_AQ && n < N_AV) return (c & ~31) | (((c >> 2) & 3) << 3) | (((c >> 4) & 1) << 2) | (c & 3);
    return c;
}
struct ConvTile { const float* src; bf16_t* dst; int N, K, k0, n0; bool w1; };
DEV void conv_load(const ConvTile& t, float4 (&v)[2]) {
    const int tid = TIDX();
#pragma unroll
    for (int i = 0; i < 2; ++i) v[i] = *(const float4*)(t.src + (size_t)(t.k0 + (tid >> 4) + 32 * i) * t.N + t.n0 + (tid & 15) * 4);
}
DEV void conv_park(const float4 (&v)[2], float* tile) {
    const int tid = TIDX();
#pragma unroll
    for (int i = 0; i < 2; ++i) {
        float* d = tile + ((tid >> 4) + 32 * i) * 65 + (tid & 15) * 4;
        d[0] = v[i].x; d[1] = v[i].y; d[2] = v[i].z; d[3] = v[i].w;
    }
}
DEV void conv_store(const ConvTile& t, const float* tile) {
    const int tid = TIDX();
    const int n = tid >> 3, kc = tid & 7;
    const int dr = t.w1 ? w1t_row(t.n0 + n) : t.n0 + n;
    const float* s = tile + (kc * 8) * 65 + n;
    uint4 o;
    o.x = pk2(s[0], s[65]);       o.y = pk2(s[130], s[195]);
    o.z = pk2(s[260], s[325]);    o.w = pk2(s[390], s[455]);
    *(uint4*)(t.dst + (size_t)dr * t.K + t.k0 + kc * 8) = o;
}
DEV void conv_tile(CParams& p, int l, int r, int set, ConvTile& t) {
    constexpr int T_IN = 16 * 120, T_MG = 16 * 48, T_BR = 3 * 256;
    t.K = D; t.w1 = false;
    if (set == 0) {
        if (r < T_IN) { t.src = p.w_in + (size_t)l * D * NW; t.N = NW; t.dst = ws_bf(p, OFF_W1T); t.k0 = (r / 120) * 64; t.n0 = (r % 120) * 64; t.w1 = true; return; }
        r -= T_IN;
        const int mat = r / 4, q = r % 4;
        const int dir = mat >> 4, gate = (mat >> 3) & 1, blk = mat & 7;
        const float* wa_ = p.lru_wa; const float* wx_ = p.lru_wx;
        t.src = (gate ? wx_ : wa_) + (((size_t)l * 2 + dir) * 8 + blk) * 128 * 128; t.N = 128; t.K = 128;
        t.dst = ws_bf(p, OFF_LRUW) + (size_t)mat * 128 * 128; t.k0 = (q >> 1) * 64; t.n0 = (q & 1) * 64;
        return;
    }
    if (r < T_MG) { t.src = p.w_merge + (size_t)l * D * 3072; t.N = 3072; t.dst = ws_bf(p, OFF_WMG); t.k0 = (r / 48) * 64; t.n0 = (r % 48) * 64; return; }
    r -= T_MG;
    if (r < T_BR) { const int nb = r / 256, q = r % 256;
        t.src = p.w_branch + ((size_t)l * 3 + nb) * D * D; t.N = D; t.dst = ws_bf(p, OFF_WBR) + (size_t)nb * D * D; t.k0 = (q / 16) * 64; t.n0 = (q % 16) * 64; return; }
    r -= T_BR;
    t.src = p.w_out + (size_t)l * D * D; t.N = D; t.dst = ws_bf(p, OFF_WOUT); t.k0 = (r / 16) * 64; t.n0 = (r % 16) * 64;
}
DEV void phase_convert(CParams& p, int l, float* tile, int set, int vb, int nvb) {
    const int count = set == 0 ? 16 * 120 + 32 * 4 : 16 * 48 + 3 * 256 + 256;
    for (int it = vb; it < count; it += 4 * nvb) {
        ConvTile t[4]; float4 v[4][2];
#pragma unroll
        for (int j = 0; j < 4; ++j) {
            const bool on = it + j * nvb < count;
            conv_tile(p, l, on ? it + j * nvb : it, set, t[j]);
            if (on) conv_load(t[j], v[j]);
        }
#pragma unroll
        for (int j = 0; j < 4; ++j) if (it + j * nvb < count) conv_park(v[j], tile + j * 4224);
        __syncthreads();
#pragma unroll
        for (int j = 0; j < 4; ++j) if (it + j * nvb < count) conv_store(t[j], tile + j * 4224);
        __syncthreads();
    }
}

DEV void prenorm_row(CParams& p, int l, int m, const float4 (&v)[4], int lane) {
    float ss = 0.f;
#pragma unroll
    for (int j = 0; j < 4; ++j) ss += (v[j].x * v[j].x + v[j].y * v[j].y) + (v[j].z * v[j].z + v[j].w * v[j].w);
    ss = wave_sum(ss);
    const float rstd = rsqrtf(ss * (1.f / D) + EPS);
    const float* mod = ws_mod(p) + (size_t)(l * 5 + cond_row(m)) * 3072;
    bf16_t* h = ws_bf(p, OFF_H) + (size_t)m * D;
#pragma unroll
    for (int j = 0; j < 4; ++j) {
        const int i4 = lane + 64 * j;
        const float4 g = ((const float4*)(p.norm_pre + l * D))[i4];
        const float4 sh = ((const float4*)mod)[i4];
        const float4 sc = ((const float4*)(mod + 1024))[i4];
        ushort4 o;
        o.x = f2bf(v[j].x * rstd * g.x * (1.f + sc.x) + sh.x);
        o.y = f2bf(v[j].y * rstd * g.y * (1.f + sc.y) + sh.y);
        o.z = f2bf(v[j].z * rstd * g.z * (1.f + sc.z) + sh.z);
        o.w = f2bf(v[j].w * rstd * g.w * (1.f + sc.w) + sh.w);
        ((ushort4*)h)[i4] = o;
    }
}
DEV void phase_prenorm(CParams& p, int l) {
    const int tid = TIDX(), lane = tid & 63;
    for (int m = BIDX() * 8 + (tid >> 6); m < M; m += GDIM() * 8) {
        const float4* xr = (const float4*)x_row(p, l, m);
        float4 v[4];
#pragma unroll
        for (int j = 0; j < 4; ++j) v[j] = xr[lane + 64 * j];
        prenorm_row(p, l, m, v, lane);
    }
}

typedef short bf16x8 __attribute__((ext_vector_type(8)));
typedef float f32x4 __attribute__((ext_vector_type(4)));
DEV void pair8(const f32x4 a, const f32x4 b, float (&v)[8]) {
#pragma unroll
    for (int r = 0; r < 4; ++r) {
        auto s = __builtin_amdgcn_permlane16_swap(__float_as_uint(a[r]), __float_as_uint(b[r]), false, false);
        v[r] = __uint_as_float(s[0]); v[4 + r] = __uint_as_float(s[1]);
    }
}
typedef short v4i16_t __attribute__((ext_vector_type(4)));
#define LAS __attribute__((address_space(3)))
namespace g8 {
constexpr int BK = 64, HALF = 128, HTB = HALF * BK * 2, STAGE_BYTES = 8 * HTB;
DEV int lds_byte(int r, int c) { const int st = (r >> 4) * 2 + (c >> 5), rr = r & 15, cc = c & 31, ob = rr * 64 + cc * 2; return st * 1024 + (ob ^ (((ob >> 9) & 1) << 5)); }
DEV void stage_rc(int b, int& R, int& C) { const int st = b / 1024, sb = b % 1024, swz = sb ^ (((sb >> 9) & 1) << 5); R = (st >> 1) * 16 + swz / 64; C = (st & 1) * 32 + (swz % 64) / 2; }
DEV int perm32(int rho) { const int n = rho >> 4, i = rho & 15; return 8 * (i >> 2) + 4 * n + (i & 3); }
struct Unit { const char* a; const char* b; int kind, pm, pn; unsigned lda; };

template <class Sched, class Epi>
DEV void gemm_phase(LAS unsigned char* lds, const unsigned ldb, const int nt, const Sched& S, const Epi& E) {
    const int tid = TIDX(), wid = __builtin_amdgcn_readfirstlane(tid >> 6), lane = tid & 63, wr = wid >> 2, wc = wid & 3, fr = lane & 15, fq = lane >> 4;
    unsigned rowA[2], colA[2], voffB[2];
#pragma unroll
    for (int i = 0; i < 2; ++i) { int R, C; stage_rc(tid * 16 + i * 8192, R, C); rowA[i] = (unsigned)R; colA[i] = (unsigned)C * 2u; voffB[i] = (unsigned)((R & ~31) | perm32(R & 31)) * ldb + (unsigned)C * 2u; }
    const size_t kstep = (size_t)(BK * 2);
    const size_t hstepB = (size_t)HALF * ldb;
    const unsigned ldsw = (unsigned)wid * 1024u;
    const int aoff = lds_byte(wr * 64 + fr, fq * 8), boff = lds_byte(wc * 32 + fr, fq * 8);
#define G8_SA(b, h) (((b) * 2 + (h)) * HTB)
#define G8_SB(b, h) ((4 + (b) * 2 + (h)) * HTB)
#define G8_STAGE(bufoff, gbase, voff) do { _Pragma("unroll") for (int _i = 0; _i < 2; ++_i) \
        __builtin_amdgcn_global_load_lds((const unsigned*)((const char*)(gbase) + (voff)[_i]), (LAS unsigned*)(lds + (bufoff) + ldsw + _i * 8192), 16, 0, 0); } while (0)
#define G8_STAGEA(bufoff, gbase, ld) do { _Pragma("unroll") for (int _i = 0; _i < 2; ++_i) \
        __builtin_amdgcn_global_load_lds((const unsigned*)((const char*)(gbase) + (rowA[_i] * (ld) + colA[_i])), (LAS unsigned*)(lds + (bufoff) + ldsw + _i * 8192), 16, 0, 0); } while (0)
#define G8_LDA(dst, b, h) do { _Pragma("unroll") for (int m = 0; m < 4; ++m) _Pragma("unroll") for (int k = 0; k < 2; ++k) dst[m][k] = *(const LAS bf16x8*)(lds + G8_SA(b, h) + aoff + m * 2048 + k * 1024); } while (0)
#define G8_LDB(dst, b, h) do { _Pragma("unroll") for (int n = 0; n < 2; ++n) _Pragma("unroll") for (int k = 0; k < 2; ++k) dst[n][k] = *(const LAS bf16x8*)(lds + G8_SB(b, h) + boff + n * 2048 + k * 1024); } while (0)
#define G8_MMA(ai, bj, At, Bt) do { __builtin_amdgcn_s_setprio(1); _Pragma("unroll") for (int m = 0; m < 4; ++m) _Pragma("unroll") for (int n = 0; n < 2; ++n) _Pragma("unroll") for (int k = 0; k < 2; ++k) \
        acc[ai][bj][m][n] = __builtin_amdgcn_mfma_f32_16x16x32_bf16(Bt[n][k], At[m][k], acc[ai][bj][m][n], 0, 0, 0); __builtin_amdgcn_s_setprio(0); } while (0)
#define G8_WAIT_V(n) asm volatile("s_waitcnt vmcnt(" #n ")" ::: "memory")
#define G8_WAIT_L(n) asm volatile("s_waitcnt lgkmcnt(" #n ")" ::: "memory")
#define G8_BAR __builtin_amdgcn_s_barrier()
#define G8_SCHED __builtin_amdgcn_sched_barrier(0)
    Unit cur, nxt; int ui = 0;
    if (!S.next(0, cur)) return;
    f32x4 acc[2][2][4][2];
#pragma unroll
    for (int a = 0; a < 2; ++a)
#pragma unroll
        for (int b = 0; b < 2; ++b)
#pragma unroll
            for (int m = 0; m < 4; ++m)
#pragma unroll
                for (int n = 0; n < 2; ++n) acc[a][b][m][n] = (f32x4){0.f, 0.f, 0.f, 0.f};
    bf16x8 At[4][2], B0[2][2], B1[2][2];
    const char* cA = cur.a; const char* cB = cur.b;
    unsigned ldc = cur.lda;
    G8_STAGE(G8_SB(0, 0), cB, voffB); G8_STAGE(G8_SB(0, 1), cB + hstepB, voffB); G8_STAGEA(G8_SA(0, 0), cA, ldc); G8_STAGEA(G8_SA(0, 1), cA + (size_t)HALF * ldc, ldc);
    if (wr == 1) G8_BAR;
    G8_WAIT_V(2); G8_BAR;
    G8_STAGE(G8_SB(1, 0), cB + kstep, voffB); G8_STAGEA(G8_SA(1, 0), cA + kstep, ldc); G8_STAGE(G8_SB(1, 1), cB + hstepB + kstep, voffB);
    G8_WAIT_V(6); G8_BAR;
    for (;;) {
        const bool has_next = S.next(ui + 1, nxt);
        const char* nA = has_next ? nxt.a : cA; const char* nB = has_next ? nxt.b : cB;
        const unsigned ldn = has_next ? nxt.lda : ldc;
        for (int t = 0; t < nt; t += 2) {
            const bool last = (t == nt - 2);
            const char* a1 = cA + (size_t)(t + 1) * kstep;
            const char* a2 = last ? nA : cA + (size_t)(t + 2) * kstep; const char* b2 = last ? nB : cB + (size_t)(t + 2) * kstep;
            const char* a3 = a2 + kstep; const char* b3 = b2 + kstep;
            const unsigned ld2 = last ? ldn : ldc;
            const size_t h1 = (size_t)HALF * ldc, h2 = (size_t)HALF * ld2;
            G8_LDB(B0, 0, 0); G8_LDB(B1, 0, 1); G8_SCHED; G8_LDA(At, 0, 0); G8_STAGEA(G8_SA(1, 1), a1 + h1, ldc);
            G8_WAIT_V(8); G8_WAIT_L(0); G8_BAR; G8_MMA(0, 0, At, B0); G8_MMA(0, 1, At, B1); G8_BAR; G8_SCHED;
            G8_LDA(At, 0, 1); G8_STAGE(G8_SB(0, 0), b2, voffB); G8_STAGE(G8_SB(0, 1), b2 + hstepB, voffB); G8_STAGEA(G8_SA(0, 0), a2, ld2);
            G8_WAIT_V(8); G8_WAIT_L(0); G8_BAR; G8_MMA(1, 0, At, B0); G8_MMA(1, 1, At, B1); G8_BAR; G8_SCHED;
            G8_LDB(B0, 1, 0); G8_LDB(B1, 1, 1); G8_SCHED; G8_LDA(At, 1, 0); G8_STAGEA(G8_SA(0, 1), a2 + h2, ld2);
            G8_WAIT_V(8); G8_WAIT_L(0); G8_BAR; G8_MMA(0, 0, At, B0); G8_MMA(0, 1, At, B1); G8_BAR; G8_SCHED;
            G8_LDA(At, 1, 1); G8_STAGE(G8_SB(1, 0), b3, voffB); G8_STAGE(G8_SB(1, 1), b3 + hstepB, voffB); G8_STAGEA(G8_SA(1, 0), a3, ld2);
            G8_WAIT_V(8); G8_WAIT_L(0); G8_BAR; G8_MMA(1, 0, At, B0); G8_MMA(1, 1, At, B1); G8_BAR; G8_SCHED;
        }
        if (wr == 0) G8_BAR;
        E(acc, cur, wr, wc, fr, fq);
        if (!has_next) break;
#pragma unroll
        for (int a = 0; a < 2; ++a)
#pragma unroll
            for (int b = 0; b < 2; ++b)
#pragma unroll
                for (int m = 0; m < 4; ++m)
#pragma unroll
                    for (int n = 0; n < 2; ++n) acc[a][b][m][n] = (f32x4){0.f, 0.f, 0.f, 0.f};
        cur = nxt; cA = nA; cB = nB; ldc = ldn; ++ui;
        if (wr == 1) G8_BAR;
    }
    G8_WAIT_V(0);
    G8_BAR;
#undef G8_SA
#undef G8_SB
#undef G8_STAGE
#undef G8_STAGEA
#undef G8_LDA
#undef G8_LDB
#undef G8_MMA
#undef G8_WAIT_V
#undef G8_WAIT_L
#undef G8_BAR
#undef G8_SCHED
}

DEV void grid_unit(int wgid, int nM, int nN, int& pm, int& pn) {
    const int nwg = nM * nN, q = nwg / 8, r = nwg % 8, xcd = wgid % 8, off = wgid / 8;
    wgid = (xcd < r ? xcd * (q + 1) : r * (q + 1) + (xcd - r) * q) + off;
    const int nig = 4 * nN, gid = wgid / nig, fm = gid * 4, gsz = (nM - fm) < 4 ? (nM - fm) : 4;
    pm = fm + ((wgid % nig) % gsz); pn = (wgid % nig) / gsz;
}
DEV uint2 pk4(const f32x4 v) { return make_uint2(pk2(v[0], v[1]), pk2(v[2], v[3])); }
DEV float lo16(unsigned u) { return __uint_as_float(u << 16); }
DEV float hi16(unsigned u) { return __uint_as_float(u & 0xffff0000u); }
}

struct SchedG1 {
    const char* H; const char* W; int G, c;
    DEV bool next(int i, g8::Unit& u) const {
        int L = i * G + c;
        if (L >= 1440) return false;
        if (L < 1248) { g8::grid_unit(L, 48, 26, u.pm, u.pn); u.kind = 0; u.lda = 2048u; u.a = H + (size_t)u.pm * 256 * 2048; u.b = W + (size_t)u.pn * 256 * 2048; }
        else { g8::grid_unit(L - 1248, 4, 48, u.pm, u.pn); u.kind = 0; u.lda = 2048u; u.a = W + (size_t)(PW + u.pm * 256) * 2048; u.b = H + (size_t)u.pn * 256 * 2048; u.pn += 64; }
        return true;
    }
};
struct EpiG1 {
    unsigned char* ws; float* out; int l;
    DEV void operator()(const f32x4 (&acc)[2][2][4][2], const g8::Unit& u, int wr, int wc, int fr, int fq) const {
        using namespace g8;
        bf16_t* Pb = (bf16_t*)(ws + OFF_P);
        if (u.pn >= 64) {
            bf16_t* RVT = (bf16_t*)(ws + OFF_RVT);
#pragma unroll
            for (int ai = 0; ai < 2; ++ai)
#pragma unroll
                for (int bj = 0; bj < 2; ++bj)
#pragma unroll
                    for (int m = 0; m < 4; ++m) {
                        const int ch = u.pm * 256 + ai * 128 + wr * 64 + m * 16 + fr;
                        const int tok = (u.pn - 64) * 256 + bj * 128 + wc * 32 + fq * 8;
                        const uint2 a = pk4(acc[ai][bj][m][0]), b = pk4(acc[ai][bj][m][1]);
                        *(uint4*)(RVT + (size_t)ch * M + tok) = make_uint4(a.x, a.y, b.x, b.y);
                    }
            return;
        }
        const int pn = u.pn;
        const bool rope_ret = pn < 4, rope_att = pn >= 16 && pn <= 20;
        const bool lat = u.pm >= 16;
        if (rope_ret || rope_att) {
            const int te = rope_ret ? (wc >> 1) * 32 + (wc & 1) * 16 + fq * 4 : 64 + (wc & 1) * 16 + fq * 4;
            const float sc = pn < 2 ? 0.08838834764831845f : (pn >= 16 && pn < 20) ? 0.125f * 1.4426950408889634f : 1.f;
#pragma unroll
            for (int ai = 0; ai < 2; ++ai) {
                float4 c01[4], c23[4];
                if (lat) {
#pragma unroll
                    for (int m = 0; m < 4; ++m) {
                        const int t = (u.pm * 256 + ai * 128 + wr * 64 + m * 16 + fr - NCTX) & 2047;
                        const float4* tb = (const float4*)((const float2*)(ws + OFF_ROPE) + (size_t)t * 96 + te);
                        c01[m] = tb[0]; c23[m] = tb[1];
                    }
                }
#pragma unroll
                for (int m = 0; m < 4; ++m) {
                    const int row = u.pm * 256 + ai * 128 + wr * 64 + m * 16 + fr;
                    bf16_t* Pr = Pb + (size_t)row * PW;
#pragma unroll
                    for (int bj = 0; bj < 2; ++bj) {
                        f32x4 x1 = acc[ai][bj][m][0], x2 = acc[ai][bj][m][1];
                        const int lc1 = rope_ret ? pn * 256 + bj * 128 + (wc >> 1) * 64 + (wc & 1) * 16 + fq * 4 : pn * 256 + bj * 128 + wc * 32 + fq * 4;
                        const int lc2 = rope_ret ? lc1 + 32 : lc1 + 16;
                        if (!lat && pn == 20) {
                            float* ok = out + O_NK + ((size_t)((row >> 8) * 2 + l) * 256 + (row & 255)) * 256 + (lc1 - C_AK);
                            *(float4*)ok = make_float4(x1[0], x1[1], x1[2], x1[3]);
                            *(float4*)(ok + 16) = make_float4(x2[0], x2[1], x2[2], x2[3]);
                        }
                        if (lat) {
                            const float cs[4] = {c01[m].x, c01[m].z, c23[m].x, c23[m].z}, sn[4] = {c01[m].y, c01[m].w, c23[m].y, c23[m].w};
                            f32x4 o1, o2;
#pragma unroll
                            for (int j = 0; j < 4; ++j) { o1[j] = x1[j] * cs[j] - x2[j] * sn[j]; o2[j] = x2[j] * cs[j] + x1[j] * sn[j]; }
                            x1 = o1; x2 = o2;
                        }
                        x1 *= sc; x2 *= sc;
                        const uint2 a = pk4(x1), b = pk4(x2);
                        auto sx = __builtin_amdgcn_permlane16_swap(a.x, b.x, false, false);
                        auto sy = __builtin_amdgcn_permlane16_swap(a.y, b.y, false, false);
                        *(uint4*)(Pr + ((fq & 1) ? lc2 - 4 : lc1)) = make_uint4(sx[0], sy[0], sx[1], sy[1]);
                    }
                }
            }
            return;
        }
#pragma unroll
        for (int ai = 0; ai < 2; ++ai)
#pragma unroll
            for (int m = 0; m < 4; ++m) {
                const int row = u.pm * 256 + ai * 128 + wr * 64 + m * 16 + fr;
                bf16_t* Pr = Pb + (size_t)row * PW;
#pragma unroll
                for (int bj = 0; bj < 2; ++bj) {
                    const int col = pn * 256 + bj * 128 + wc * 32 + fq * 8;
                    uint2 pk[2];
#pragma unroll
                    for (int n = 0; n < 2; ++n) {
                        f32x4 v = acc[ai][bj][m][n];
                        if (pn == 21) {
                            if (!lat) *(float4*)(out + O_NV + ((size_t)((row >> 8) * 2 + l) * 256 + (row & 255)) * 256 + (col + n * 4 - C_AV)) = make_float4(v[0], v[1], v[2], v[3]);
                        } else if (!(pn >= 8 && pn < 12)) {
#pragma unroll
                            for (int j = 0; j < 4; ++j) v[j] = siluf(v[j]);
                        }
                        pk[n] = pk4(v);
                    }
                    *(uint4*)(Pr + col) = make_uint4(pk[0].x, pk[0].y, pk[1].x, pk[1].y);
                }
            }
    }
};
DEV void phase8_gemm1(CParams& p, int l, LAS unsigned char* lds) {
    SchedG1 S{(const char*)(p.ws + OFF_H), (const char*)(p.ws + OFF_W1T), GDIM(), BIDX()};
    EpiG1 E{p.ws, p.out, l};
    g8::gemm_phase(lds, 2048u, 16, S, E);
}

constexpr size_t OFF_G2 = OFF_RVT;
struct SchedMg {
    const char *H, *P, *WMG, *WBR; int G, c, part;
    DEV void fill(g8::Unit& u, int tile, int n, int isz) const {
        u.pm = tile >> 2; u.pn = tile & 3; u.kind = n * 2 + isz;
        if (isz) { const int acol = n == 0 ? C_RG : n == 1 ? C_LG : C_AQ;
                   u.lda = (unsigned)PW * 2u; u.a = P + (size_t)u.pm * 256 * PW * 2 + (size_t)acol * 2; u.b = WBR + ((size_t)n * 1024 + u.pn * 256) * 2048; }
        else { u.lda = 2048u; u.a = H + (size_t)u.pm * 256 * 2048; u.b = WMG + ((size_t)n * 1024 + u.pn * 256) * 2048; }
    }
    DEV bool next(int i, g8::Unit& u) const {
        if (G == 256) {
            const int xg = c & 7, j = c >> 3;
            if (part == 2) {
                if (c >= 192 || i >= 1) return false;
                fill(u, xg * 24 + j, 1, 0);
            } else if (part == 0) {
                if (c < 192) { if (i >= 3) return false; if (i == 0) fill(u, xg * 24 + j, 0, 0); else fill(u, xg * 24 + j, i - 1, 1); }
                else { if (i >= 3) return false; fill(u, xg * 24 + (j - 24) * 3 + i, 2, 0); }
            } else {
                if (c >= 192 || i >= 1) return false;
                fill(u, xg * 24 + j, 2, 1);
            }
            return true;
        }
        if (part != 0) return false;
        const int tile = c + (i / 6) * G, sI = i % 6;
        if (tile >= 192) return false;
        fill(u, tile, sI >> 1, sI & 1);
        return true;
    }
};
struct EpiMg {
    unsigned char* ws; const float* bias;
    DEV bf16_t* gslot(int n, int row) const {
        bf16_t* Pb = (bf16_t*)(ws + OFF_P);
        return n == 0 ? Pb + (size_t)row * PW + C_LX : n == 1 ? Pb + (size_t)row * PW + C_AG : (bf16_t*)(ws + OFF_G2) + (size_t)row * 1024;
    }
    DEV void operator()(const f32x4 (&acc)[2][2][4][2], const g8::Unit& u, int wr, int wc, int fr, int fq) const {
        using namespace g8;
        const int n = u.kind >> 1; const bool zpass = u.kind & 1;
        const int colb = u.pn * 256 + wc * 32 + fq * 8;
        if (!zpass) {
            float4 bz[2][2];
#pragma unroll
            for (int bj = 0; bj < 2; ++bj)
#pragma unroll
                for (int nn = 0; nn < 2; ++nn) bz[bj][nn] = *(const float4*)(bias + n * 1024 + colb + bj * 128 + nn * 4);
#pragma unroll
            for (int ai = 0; ai < 2; ++ai)
#pragma unroll
                for (int m = 0; m < 4; ++m) {
                    bf16_t* gs = gslot(n, u.pm * 256 + ai * 128 + wr * 64 + m * 16 + fr);
#pragma unroll
                    for (int bj = 0; bj < 2; ++bj) {
                        uint2 pk[2];
#pragma unroll
                        for (int nn = 0; nn < 2; ++nn) {
                            f32x4 v = acc[ai][bj][m][nn];
                            v[0] = sigmf(v[0] + bz[bj][nn].x); v[1] = sigmf(v[1] + bz[bj][nn].y); v[2] = sigmf(v[2] + bz[bj][nn].z); v[3] = sigmf(v[3] + bz[bj][nn].w);
                            pk[nn] = pk4(v);
                        }
                        *(uint4*)(gs + colb + bj * 128) = make_uint4(pk[0].x, pk[0].y, pk[1].x, pk[1].y);
                    }
                }
            return;
        }
#pragma unroll
        for (int ai = 0; ai < 2; ++ai) {
            uint4 gq[4][2], tq[4][2];
#pragma unroll
            for (int m = 0; m < 4; ++m) {
                const int row = u.pm * 256 + ai * 128 + wr * 64 + m * 16 + fr;
                const bf16_t* gs = gslot(n, row);
                const bf16_t* Tr = (const bf16_t*)(ws + OFF_P) + (size_t)row * PW;
#pragma unroll
                for (int bj = 0; bj < 2; ++bj) {
                    gq[m][bj] = *(const uint4*)(gs + colb + bj * 128);
                    if (n > 0) tq[m][bj] = *(const uint4*)(Tr + colb + bj * 128);
                }
            }
#pragma unroll
            for (int m = 0; m < 4; ++m) {
                const int row = u.pm * 256 + ai * 128 + wr * 64 + m * 16 + fr;
                bf16_t* Tr = (bf16_t*)(ws + OFF_P) + (size_t)row * PW;
#pragma unroll
                for (int bj = 0; bj < 2; ++bj) {
                    f32x4 v0 = acc[ai][bj][m][0], v1 = acc[ai][bj][m][1];
                    const uint4 gv = gq[m][bj];
                    v0[0] *= lo16(gv.x); v0[1] *= hi16(gv.x); v0[2] *= lo16(gv.y); v0[3] *= hi16(gv.y);
                    v1[0] *= lo16(gv.z); v1[1] *= hi16(gv.z); v1[2] *= lo16(gv.w); v1[3] *= hi16(gv.w);
                    if (n > 0) {
                        const uint4 tv = tq[m][bj];
                        v0[0] += lo16(tv.x); v0[1] += hi16(tv.x); v0[2] += lo16(tv.y); v0[3] += hi16(tv.y);
                        v1[0] += lo16(tv.z); v1[1] += hi16(tv.z); v1[2] += lo16(tv.w); v1[3] += hi16(tv.w);
                    }
                    const uint2 p0 = pk4(v0), p1 = pk4(v1);
                    *(uint4*)(Tr + colb + bj * 128) = make_uint4(p0.x, p0.y, p1.x, p1.y);
                }
            }
        }
    }
};
DEV void phase8_merge(CParams& p, int l, int part, LAS unsigned char* lds) {
    SchedMg S{(const char*)(p.ws + OFF_H), (const char*)(p.ws + OFF_P), (const char*)(p.ws + OFF_WMG), (const char*)(p.ws + OFF_WBR), GDIM(), BIDX(), part};
    EpiMg E{p.ws, p.b_merge + (size_t)l * 3072};
    g8::gemm_phase(lds, 2048u, 16, S, E);
}

struct SchedOut {
    const char* A; const char* B; int G, c;
    DEV bool next(int i, g8::Unit& u) const {
        int tile = i * G + c;
        if (G == 256) { if (i > 0 || c >= 192) return false; tile = (c & 7) * 24 + (c >> 3); }
        if (tile >= 192) return false;
        u.pm = tile >> 2; u.pn = tile & 3; u.kind = 0; u.lda = (unsigned)PW * 2u;
        u.a = A + (size_t)u.pm * 256 * PW * 2; u.b = B + (size_t)u.pn * 256 * 2048;
        return true;
    }
};
DEV void row_exchange(unsigned char* ws, int slot, int pn, float* part, float* rs) {
    const int tid = TIDX();
    __syncthreads();
    unsigned* XPd = (unsigned*)(ws + OFF_XP) + (size_t)slot * 4 * 256;
    unsigned* cnt = (unsigned*)(ws + OFF_XC) + slot;
    if (tid < 256) {
        const float v = (part[tid] + part[256 + tid]) + (part[512 + tid] + part[768 + tid]);
        __hip_atomic_store(XPd + pn * 256 + tid, __float_as_uint(v), __ATOMIC_RELAXED, __HIP_MEMORY_SCOPE_AGENT);
    }
    asm volatile("s_waitcnt vmcnt(0)" ::: "memory");
    __syncthreads();
    if (tid == 0) {
        (void)__hip_atomic_fetch_add(cnt, 1u, __ATOMIC_RELAXED, __HIP_MEMORY_SCOPE_AGENT);
        unsigned sp = 0;
        while (__hip_atomic_load(cnt, __ATOMIC_RELAXED, __HIP_MEMORY_SCOPE_AGENT) < 4u) { __builtin_amdgcn_s_sleep(1); if (++sp > (1u << 20)) break; }
        __builtin_amdgcn_fence(__ATOMIC_ACQUIRE, "agent");
        asm volatile("s_waitcnt vmcnt(0)" ::: "memory");
    }
    __syncthreads();
    if (tid < 256) {
        float t = 0.f;
#pragma unroll
        for (int q = 0; q < 4; ++q) t += __uint_as_float(__hip_atomic_load(XPd + q * 256 + tid, __ATOMIC_RELAXED, __HIP_MEMORY_SCOPE_AGENT));
        rs[tid] = rsqrtf(t * (1.f / D) + EPS);
    }
    __syncthreads();
}
struct EpiOutPost {
    CParams* kp; int l; unsigned char* ldsx;
    DEV void row_ssq(const f32x4 (&v)[2][2][4][2], float* part, int wr, int wc, int fr, int fq) const {
#pragma unroll
        for (int ai = 0; ai < 2; ++ai)
#pragma unroll
            for (int m = 0; m < 4; ++m) {
                float ss = 0.f;
#pragma unroll
                for (int bj = 0; bj < 2; ++bj)
#pragma unroll
                    for (int n = 0; n < 2; ++n) { const f32x4 x = v[ai][bj][m][n]; ss += (x[0] * x[0] + x[1] * x[1]) + (x[2] * x[2] + x[3] * x[3]); }
                ss = xrow16_sum(ss);
                if (fq == 0) part[wc * 256 + ai * 128 + wr * 64 + m * 16 + fr] = ss;
            }
    }
    DEV void operator()(f32x4 (&acc)[2][2][4][2], const g8::Unit& u, int wr, int wc, int fr, int fq) const {
        CParams& p = *kp;
        unsigned char* ws = p.ws;
        float* part = (float*)ldsx; float* rs = part + 1024;
        const int colb = u.pn * 256 + wc * 32 + fq * 8;
        const int crow = u.pm < 16 ? 0 : 1 + ((u.pm - 16) >> 3);
        const float* mod = ws_mod(p) + (size_t)(l * 5 + crow) * 3072;
        row_ssq(acc, part, wr, wc, fr, fq);
        row_exchange(ws, (l * 2 + 0) * 48 + u.pm, u.pn, part, rs);
        {
            float4 gt[2][2], gp[2][2];
#pragma unroll
            for (int bj = 0; bj < 2; ++bj)
#pragma unroll
                for (int n = 0; n < 2; ++n) {
                    gt[bj][n] = *(const float4*)(mod + 2048 + colb + bj * 128 + n * 4);
                    gp[bj][n] = *(const float4*)(p.norm_post + l * D + colb + bj * 128 + n * 4);
                    gt[bj][n].x *= gp[bj][n].x; gt[bj][n].y *= gp[bj][n].y; gt[bj][n].z *= gp[bj][n].z; gt[bj][n].w *= gp[bj][n].w;
                }
#pragma unroll
            for (int ai = 0; ai < 2; ++ai)
#pragma unroll
                for (int mh = 0; mh < 2; ++mh) {
                    float4 xv[2][2][2];
#pragma unroll
                    for (int m2 = 0; m2 < 2; ++m2) {
                        const int row = u.pm * 256 + ai * 128 + wr * 64 + (mh * 2 + m2) * 16 + fr;
                        const float* xr = x_row(p, l, row);
#pragma unroll
                        for (int bj = 0; bj < 2; ++bj)
#pragma unroll
                            for (int n = 0; n < 2; ++n) xv[m2][bj][n] = *(const float4*)(xr + colb + bj * 128 + n * 4);
                    }
#pragma unroll
                    for (int m2 = 0; m2 < 2; ++m2) {
                        const int m = mh * 2 + m2;
                        const int rl = ai * 128 + wr * 64 + m * 16 + fr;
                        const float rstd = rs[rl];
                        float* yr = p.out + (size_t)(u.pm * 256 + rl) * D;
#pragma unroll
                        for (int bj = 0; bj < 2; ++bj)
#pragma unroll
                            for (int n = 0; n < 2; ++n) {
                                f32x4 y;
                                y[0] = xv[m2][bj][n].x + gt[bj][n].x * (acc[ai][bj][m][n][0] * rstd);
                                y[1] = xv[m2][bj][n].y + gt[bj][n].y * (acc[ai][bj][m][n][1] * rstd);
                                y[2] = xv[m2][bj][n].z + gt[bj][n].z * (acc[ai][bj][m][n][2] * rstd);
                                y[3] = xv[m2][bj][n].w + gt[bj][n].w * (acc[ai][bj][m][n][3] * rstd);
                                acc[ai][bj][m][n] = y;
                                *(float4*)(yr + colb + bj * 128 + n * 4) = make_float4(y[0], y[1], y[2], y[3]);
                            }
                    }
                }
        }
        if (l != 0) return;
        row_ssq(acc, part, wr, wc, fr, fq);
        row_exchange(ws, (l * 2 + 1) * 48 + u.pm, u.pn, part, rs);
        {
            const float* mod1 = ws_mod(p) + (size_t)(1 * 5 + crow) * 3072;
            float4 a_[2][2], b_[2][2];
#pragma unroll
            for (int bj = 0; bj < 2; ++bj)
#pragma unroll
                for (int n = 0; n < 2; ++n) {
                    const int cc = colb + bj * 128 + n * 4;
                    const float4 g = *(const float4*)(p.norm_pre + 1 * D + cc), sc = *(const float4*)(mod1 + 1024 + cc);
                    a_[bj][n] = make_float4(g.x * (1.f + sc.x), g.y * (1.f + sc.y), g.z * (1.f + sc.z), g.w * (1.f + sc.w));
                    b_[bj][n] = *(const float4*)(mod1 + cc);
                }
#pragma unroll
            for (int ai = 0; ai < 2; ++ai)
#pragma unroll
                for (int m = 0; m < 4; ++m) {
                    const int rl = ai * 128 + wr * 64 + m * 16 + fr;
                    const float rstd = rs[rl];
                    bf16_t* hr = ws_bf(p, OFF_H) + (size_t)(u.pm * 256 + rl) * D;
#pragma unroll
                    for (int bj = 0; bj < 2; ++bj) {
                        uint2 o[2];
#pragma unroll
                        for (int n = 0; n < 2; ++n) {
                            const f32x4 y = acc[ai][bj][m][n];
                            o[n].x = pk2(y[0] * rstd * a_[bj][n].x + b_[bj][n].x, y[1] * rstd * a_[bj][n].y + b_[bj][n].y);
                            o[n].y = pk2(y[2] * rstd * a_[bj][n].z + b_[bj][n].z, y[3] * rstd * a_[bj][n].w + b_[bj][n].w);
                        }
                        *(uint4*)(hr + colb + bj * 128) = make_uint4(o[0].x, o[0].y, o[1].x, o[1].y);
                    }
                }
        }
    }
};
DEV void phase8_out(CParams& p, int l, LAS unsigned char* lds) {
    SchedOut S{(const char*)(p.ws + OFF_P), (const char*)(p.ws + OFF_WOUT), GDIM(), BIDX()};
    EpiOutPost E{&p, l, (unsigned char*)lds + LDS_XOFF};
    g8::gemm_phase(lds, 2048u, 16, S, E);
}

DEV uint4 pack8(const float4 a, const float4 b) {
    uint4 r;
    r.x = pk2(a.x, a.y); r.y = pk2(a.z, a.w);
    r.z = pk2(b.x, b.y); r.w = pk2(b.z, b.w);
    return r;
}
template <int NU>
DEV void attn_item(CParams& p, int l, bool lat, int b, int hk, int qs0, unsigned char* lds) {
    bf16_t* Pb = ws_bf(p, OFF_P);
    const int tid = TIDX(), lane = tid & 63, w = tid >> 6, g = lane >> 4, lc = lane & 15;
    const int row0 = lat ? NCTX + b * 2048 : b * 256, L = lat ? 2048 : 256;
    const int hq = hk * 4 + (w & 3);
    const int qw = qs0 + (w >> 2) * 32;
    bf16x8 qfr[NU][2][2];
    f32x4 O[NU][4][2];
    float mrun[NU][2], lrun[NU][2];
    const float sink = p.att_sink[l * 16 + hq] * 1.4426950408889634f;
#pragma unroll
    for (int u = 0; u < NU; ++u)
#pragma unroll
        for (int qf = 0; qf < 2; ++qf) {
#pragma unroll
            for (int ks = 0; ks < 2; ++ks)
                qfr[u][qf][ks] = *(const bf16x8*)(Pb + (size_t)(row0 + qw + u * 64 + qf * 16 + lc) * PW + C_AQ + hq * 64 + ks * 32 + g * 8);
            mrun[u][qf] = sink; lrun[u][qf] = g == 0 ? 1.f : 0.f;
#pragma unroll
            for (int df = 0; df < 4; ++df) O[u][df][qf] = (f32x4){0.f, 0.f, 0.f, 0.f};
        }
    const int nband = lat ? 4 + NU : 4;
    const int ntile = lat ? nband + 4 : 4;
    const int qsb = qs0 >> 6;
    const int t_lo = lat ? (qsb < 2 ? 2 - qsb : 0) : 0;
    const int t_hi = lat ? ((33 - qsb) < (nband - 1) ? (33 - qsb) : (nband - 1)) : 3;
    const int fsw = (lane >> 1) & 7;
    const int srow = tid >> 3, sc8 = tid & 7;
    float4 R[4];
    auto tile_load = [&](int t) __attribute__((always_inline)) {
        if (t < nband) {
            const int kp0 = lat ? qs0 + 64 * (t - 2) : 64 * t;
            const uint4 kv = *(const uint4*)(Pb + (size_t)(row0 + kp0 + srow) * PW + C_AK + hk * 64 + sc8 * 8);
            const uint4 vv = *(const uint4*)(Pb + (size_t)(row0 + kp0 + srow) * PW + C_AV + hk * 64 + sc8 * 8);
            R[0] = make_float4(__uint_as_float(kv.x), __uint_as_float(kv.y), __uint_as_float(kv.z), __uint_as_float(kv.w));
            R[2] = make_float4(__uint_as_float(vv.x), __uint_as_float(vv.y), __uint_as_float(vv.z), __uint_as_float(vv.w));
        } else {
            const int j0 = (t - nband) * 64;
            const float* ck = p.cache_k + (size_t)((b * 2 + l) * 256 + j0) * 256 + hk * 64;
            const float* cv = p.cache_v + (size_t)((b * 2 + l) * 256 + j0) * 256 + hk * 64;
            R[0] = *(const float4*)(ck + (size_t)srow * 256 + sc8 * 8); R[1] = *(const float4*)(ck + (size_t)srow * 256 + sc8 * 8 + 4);
            R[2] = *(const float4*)(cv + (size_t)srow * 256 + sc8 * 8); R[3] = *(const float4*)(cv + (size_t)srow * 256 + sc8 * 8 + 4);
        }
    };
    auto tile_store = [&](bool cache_t, unsigned char* KsB, unsigned char* VtB) __attribute__((always_inline)) {
        uint4 kq, vq;
        if (!cache_t) {
            kq = make_uint4(__float_as_uint(R[0].x), __float_as_uint(R[0].y), __float_as_uint(R[0].z), __float_as_uint(R[0].w));
            vq = make_uint4(__float_as_uint(R[2].x), __float_as_uint(R[2].y), __float_as_uint(R[2].z), __float_as_uint(R[2].w));
        } else { kq = pack8(R[0], R[1]); vq = pack8(R[2], R[3]); }
        *(uint4*)(KsB + srow * 128 + ((sc8 ^ ((srow >> 1) & 7)) << 4)) = kq;
        *(uint4*)(VtB + srow * 128 + ((sc8 ^ (((srow >> 1) & 3) << 1)) << 4)) = vq;
    };
    int t = t_lo;
    tile_load(t);
    __syncthreads();
    tile_store(t >= nband, lds, lds + 8192);
    int tn = (lat && t == t_hi) ? nband : t + 1;
    if (tn < ntile) tile_load(tn);
    int cur = 0;
    while (t < ntile) {
        const bool cache = t >= nband;
        const int kp0 = lat ? qs0 + 64 * (t - 2) : 64 * t;
        const unsigned char* Ks = lds + cur * 16384; const unsigned char* Vt = Ks + 8192;
        __syncthreads();
        int tnn = ntile;
        if (tn < ntile) {
            tile_store(tn >= nband, lds + (cur ^ 1) * 16384, lds + (cur ^ 1) * 16384 + 8192);
            tnn = (lat && tn == t_hi) ? nband : tn + 1;
            if (tnn < ntile) tile_load(tnn);
        }
#pragma unroll
        for (int u = 0; u < NU; ++u) {
            const int tu = t - u;
            if (lat && !cache && (tu < 0 || tu > 4)) continue;
            __builtin_amdgcn_s_setprio(1);
            f32x4 sc[4][2];
#pragma unroll
            for (int kf = 0; kf < 4; ++kf)
#pragma unroll
                for (int qf = 0; qf < 2; ++qf) sc[kf][qf] = (f32x4){0.f, 0.f, 0.f, 0.f};
#pragma unroll
            for (int ks = 0; ks < 2; ++ks) {
                bf16x8 ak[4];
#pragma unroll
                for (int kf = 0; kf < 4; ++kf) ak[kf] = *(const bf16x8*)(Ks + (kf * 16 + lc) * 128 + (((ks * 4 + g) ^ fsw) << 4));
#pragma unroll
                for (int kf = 0; kf < 4; ++kf)
#pragma unroll
                    for (int qf = 0; qf < 2; ++qf)
                        sc[kf][qf] = __builtin_amdgcn_mfma_f32_16x16x32_bf16(ak[kf], qfr[u][qf][ks], sc[kf][qf], 0, 0, 0);
            }
            __builtin_amdgcn_s_setprio(0);
            if (lat && !cache && (tu == 0 || tu == 4)) {
#pragma unroll
                for (int kf = 0; kf < 4; ++kf)
#pragma unroll
                    for (int qf = 0; qf < 2; ++qf)
#pragma unroll
                        for (int r = 0; r < 4; ++r) {
                            const int kpos = kp0 + kf * 16 + g * 4 + r, qpos = qw + u * 64 + qf * 16 + lc;
                            const int dd = qpos - kpos;
                            if (dd > 128 || dd < -128) sc[kf][qf][r] = -INFINITY;
                        }
            }
            bf16x8 pb[2][2];
#pragma unroll
            for (int qf = 0; qf < 2; ++qf) {
                float mx = -INFINITY;
#pragma unroll
                for (int kf = 0; kf < 4; ++kf)
#pragma unroll
                    for (int r = 0; r < 4; ++r) mx = fmaxf(mx, sc[kf][qf][r]);
                mx = xrow16_max(mx);
                const float mnew = fmaxf(mrun[u][qf], mx);
                const float alpha = __builtin_amdgcn_exp2f(mrun[u][qf] - mnew);
                mrun[u][qf] = mnew;
                float ps = 0.f;
#pragma unroll
                for (int kf = 0; kf < 4; ++kf)
#pragma unroll
                    for (int r = 0; r < 4; ++r) { const float e = __builtin_amdgcn_exp2f(sc[kf][qf][r] - mnew); sc[kf][qf][r] = e; ps += e; }
                lrun[u][qf] = lrun[u][qf] * alpha + ps;
#pragma unroll
                for (int df = 0; df < 4; ++df) O[u][df][qf] *= alpha;
#pragma unroll
                for (int s2 = 0; s2 < 2; ++s2) {
                    bf16x8 v;
#pragma unroll
                    for (int r = 0; r < 4; ++r) { v[r] = (short)f2bf(sc[2 * s2][qf][r]); v[4 + r] = (short)f2bf(sc[2 * s2 + 1][qf][r]); }
                    pb[s2][qf] = v;
                }
            }
            __builtin_amdgcn_s_setprio(1);
#pragma unroll
            for (int s2 = 0; s2 < 2; ++s2)
#pragma unroll
                for (int df = 0; df < 4; ++df) {
                    const int vrow = 32 * s2 + 4 * g + (lc >> 2);
                    const unsigned char* vr = Vt + vrow * 128 + (((2 * df + ((lc >> 1) & 1)) ^ (((vrow >> 1) & 3) << 1)) << 4) + 8 * (lc & 1);
                    const v4i16_t lo = __builtin_amdgcn_ds_read_tr16_b64_v4i16((LAS v4i16_t*)vr);
                    const v4i16_t hi = __builtin_amdgcn_ds_read_tr16_b64_v4i16((LAS v4i16_t*)(vr + 2048));
                    union { v4i16_t h[2]; bf16x8 v; } av; av.h[0] = lo; av.h[1] = hi;
#pragma unroll
                    for (int qf = 0; qf < 2; ++qf)
                        O[u][df][qf] = __builtin_amdgcn_mfma_f32_16x16x32_bf16(av.v, pb[s2][qf], O[u][df][qf], 0, 0, 0);
                }
            __builtin_amdgcn_s_setprio(0);
        }
        t = tn; tn = tnn; cur ^= 1;
    }
#pragma unroll
    for (int u = 0; u < NU; ++u)
#pragma unroll
        for (int qf = 0; qf < 2; ++qf) {
            const float lt = xrow16_sum(lrun[u][qf]);
            const float inv = 1.f / lt;
            const size_t m = (size_t)(row0 + qw + u * 64 + qf * 16 + lc);
#pragma unroll
            for (int dp = 0; dp < 2; ++dp) {
                float v[8];
                pair8(O[u][dp * 2][qf], O[u][dp * 2 + 1][qf], v);
                const int col = hq * 64 + ((g & 1) ? (dp * 2 + 1) * 16 + (g - 1) * 4 : dp * 32 + g * 4);
                const uint4 gt = *(const uint4*)(Pb + m * PW + C_AG + col);
                uint4 o;
                o.x = pk2(v[0] * inv * __uint_as_float(gt.x << 16), v[1] * inv * __uint_as_float(gt.x & 0xffff0000u));
                o.y = pk2(v[2] * inv * __uint_as_float(gt.y << 16), v[3] * inv * __uint_as_float(gt.y & 0xffff0000u));
                o.z = pk2(v[4] * inv * __uint_as_float(gt.z << 16), v[5] * inv * __uint_as_float(gt.z & 0xffff0000u));
                o.w = pk2(v[6] * inv * __uint_as_float(gt.w << 16), v[7] * inv * __uint_as_float(gt.w & 0xffff0000u));
                *(uint4*)(Pb + m * PW + C_AQ + col) = o;
            }
        }
}
DEV void phase_attn(CParams& p, int l, unsigned char* lds) {
    if (GDIM() == 256) {
        const int xg = BIDX() & 7, j = BIDX() >> 3;
        { const int grp = xg * 2 + (j >> 4); attn_item<2>(p, l, true, grp >> 2, grp & 3, (j & 15) * 128, lds); }
        { const int grp = xg * 8 + (j >> 2); attn_item<1>(p, l, false, grp >> 2, grp & 3, (j & 3) * 64, lds); }
        return;
    }
    for (int item = BIDX(); item < 768; item += GDIM()) {
        if (item < 512) attn_item<1>(p, l, true, item >> 7, (item >> 5) & 3, (item & 31) * 64, lds);
        else { const int it = item - 512; attn_item<1>(p, l, false, it >> 4, (it >> 2) & 3, (it & 3) * 64, lds); }
    }
}

constexpr size_t OFF_RS = OFF_W1T;
static_assert(OFF_RS + (size_t)4 * 4 * 2 * 8 * 32768 * 2 <= OFF_LRUC, "RS overlap");
DEV float ret_logg(CParams& p, int l, int dir, int h) { return -softplusf(-p.ret_decay[(l * 2 + dir) * 4 + h]); }

DEV void ret_kv_tile(CParams& p, int l, int item, unsigned char* lds) {
    bf16_t* Pb = ws_bf(p, OFF_P); const bf16_t* RVT = ws_bf(p, OFF_RVT);
    const int tid = TIDX(), lane = tid & 63, w = __builtin_amdgcn_readfirstlane(tid >> 6), g = lane >> 4, lc = lane & 15;
    const bool lat = item < 128;
    int b, h, c;
    if (lat) { c = item & 7; h = (item >> 3) & 3; b = item >> 5; }
    else { const int it = item - 128; h = it & 3; b = it >> 2; c = 0; }
    const int row0 = lat ? NCTX + b * 2048 + c * 256 : b * 256;
    const bool doF = !lat || c < 7, doB = !lat || c > 0;
    const float lgf = ret_logg(p, l, 0, h), lgb = ret_logg(p, l, 1, h);
    const float rf = __expf(-lgf), rb = __expf(lgb);
    const int dvbase = w * 32;
    auto dma_k = [&](int st) __attribute__((always_inline)) {
        LAS unsigned char* base = (LAS unsigned char*)lds + (st & 1) * 16384;
#pragma unroll
        for (int i = 0; i < 2; ++i) {
            const int q = w * 2 + i, row = 4 * q + (lane >> 4), lch = (lane & 15) ^ (((row & 3) << 2) | ((row >> 2) & 3));
            __builtin_amdgcn_global_load_lds((const unsigned*)(Pb + (size_t)(row0 + st * 64 + row) * PW + C_RK + h * 128 + lch * 8), (LAS unsigned*)(base + q * 1024), 16, 0, 0);
        }
    };
    __syncthreads();
    dma_k(0);
    f32x4 accF[2][8], accB[2][8];
#pragma unroll
    for (int i = 0; i < 2; ++i)
#pragma unroll
        for (int j = 0; j < 8; ++j) { accF[i][j] = (f32x4){0.f, 0.f, 0.f, 0.f}; accB[i][j] = (f32x4){0.f, 0.f, 0.f, 0.f}; }
    const int tq = lc >> 2, tp = lc & 3;
#pragma unroll 1
    for (int st = 0; st < 4; ++st) {
        bf16x8 av[2][2];
#pragma unroll
        for (int ks = 0; ks < 2; ++ks)
#pragma unroll
            for (int mf = 0; mf < 2; ++mf)
                av[ks][mf] = *(const bf16x8*)(RVT + (size_t)(h * 256 + dvbase + mf * 16 + lc) * M + row0 + st * 64 + ks * 32 + g * 8);
        bf16x8 avF[2][2], avB[2][2];
#pragma unroll
        for (int ks = 0; ks < 2; ++ks) {
            const int ti0 = st * 64 + ks * 32 + g * 8;
            float wf = __expf(lgf * (float)(255 - ti0)), wb = __expf(lgb * (float)ti0);
#pragma unroll
            for (int j = 0; j < 8; ++j) {
#pragma unroll
                for (int mf = 0; mf < 2; ++mf) {
                    const float v = bf2f((bf16_t)av[ks][mf][j]);
                    avF[ks][mf][j] = (short)f2bf(v * wf); avB[ks][mf][j] = (short)f2bf(v * wb);
                }
                wf *= rf; wb *= rb;
            }
        }
        asm volatile("s_waitcnt vmcnt(0)" ::: "memory");
        __syncthreads();
        if (st + 1 < 4) dma_k(st + 1);
        const unsigned char* Kt = lds + (st & 1) * 16384;
#pragma unroll
        for (int ks = 0; ks < 2; ++ks)
#pragma unroll
            for (int nf = 0; nf < 8; ++nf) {
                const int r0 = 32 * ks + 8 * g + tq, r1 = r0 + 4;
                const unsigned char* a0 = Kt + r0 * 256 + (((2 * nf + (tp >> 1)) ^ (((r0 & 3) << 2) | ((r0 >> 2) & 3))) << 4) + 8 * (tp & 1);
                const unsigned char* a1 = Kt + r1 * 256 + (((2 * nf + (tp >> 1)) ^ (((r1 & 3) << 2) | ((r1 >> 2) & 3))) << 4) + 8 * (tp & 1);
                union { v4i16_t hlf[2]; bf16x8 v; } bk;
                bk.hlf[0] = __builtin_amdgcn_ds_read_tr16_b64_v4i16((LAS v4i16_t*)a0);
                bk.hlf[1] = __builtin_amdgcn_ds_read_tr16_b64_v4i16((LAS v4i16_t*)a1);
#pragma unroll
                for (int mf = 0; mf < 2; ++mf) {
                    accF[mf][nf] = __builtin_amdgcn_mfma_f32_16x16x32_bf16(avF[ks][mf], bk.v, accF[mf][nf], 0, 0, 0);
                    accB[mf][nf] = __builtin_amdgcn_mfma_f32_16x16x32_bf16(avB[ks][mf], bk.v, accB[mf][nf], 0, 0, 0);
                }
            }
    }
    if (lat) {
        bf16_t* dF = ws_bf(p, OFF_RS) + ((size_t)((b * 4 + h) * 2 + 0) * 8 + (c + 1)) * 32768;
        bf16_t* dB = ws_bf(p, OFF_RS) + ((size_t)((b * 4 + h) * 2 + 1) * 8 + (c - 1)) * 32768;
#pragma unroll
        for (int mf = 0; mf < 2; ++mf)
#pragma unroll
            for (int nf = 0; nf < 8; ++nf)
#pragma unroll
                for (int r = 0; r < 4; ++r) {
                    const size_t o = (size_t)(dvbase + mf * 16 + g * 4 + r) * 128 + nf * 16 + lc;
                    if (doF) dF[o] = f2bf(accF[mf][nf][r]);
                    if (doB) dB[o] = f2bf(accB[mf][nf][r]);
                }
    } else {
        float* dF = p.out + O_NRET + ((((size_t)b * 2 + l) * 2 + 0) * 4 + h) * 128 * 256;
        float* dB = p.out + O_NRET + ((((size_t)b * 2 + l) * 2 + 1) * 4 + h) * 128 * 256;
#pragma unroll
        for (int mf = 0; mf < 2; ++mf)
#pragma unroll
            for (int nf = 0; nf < 8; ++nf) {
                const size_t o = (size_t)(nf * 16 + lc) * 256 + dvbase + mf * 16 + g * 4;
                *(float4*)(dF + o) = make_float4(accF[mf][nf][0], accF[mf][nf][1], accF[mf][nf][2], accF[mf][nf][3]);
                *(float4*)(dB + o) = make_float4(accB[mf][nf][0], accB[mf][nf][1], accB[mf][nf][2], accB[mf][nf][3]);
            }
    }
}
DEV void phase_ret_kv(CParams& p, int l, unsigned char* lds) {
    for (int item = BIDX(); item < 192; item += GDIM()) ret_kv_tile(p, l, item, lds);
}

DEV void phase_ret_scan(CParams& p, int l, int vb, int nvb) {
    bf16_t* RS = ws_bf(p, OFF_RS);
    const int gt = vb * 512 + TIDX(), gs = nvb * 512;
    for (int idx = gt; idx < 4 * 4 * 2 * 4096; idx += gs) {
        const int dk0 = (idx & 15) * 8, dv = (idx >> 4) & 255, dir = (idx >> 12) & 1, h = (idx >> 13) & 3, b = idx >> 15;
        const float g256 = __expf(ret_logg(p, l, dir, h) * 256.f);
        const float* s0 = p.state_ret + (((((size_t)b * 2 + l) * 2 + dir) * 4 + h) * 128 + dk0) * 256 + dv;
        float st[8];
#pragma unroll
        for (int e = 0; e < 8; ++e) st[e] = s0[(size_t)e * 256];
        bf16_t* base = RS + (size_t)((b * 4 + h) * 2 + dir) * 8 * 32768 + dv * 128 + dk0;
        uint4 kv[7];
#pragma unroll
        for (int j = 0; j < 7; ++j) kv[j] = *(const uint4*)(base + (size_t)(dir == 0 ? j + 1 : 6 - j) * 32768);
        *(uint4*)(base + (size_t)(dir == 0 ? 0 : 7) * 32768) = make_uint4(pk2(st[0], st[1]), pk2(st[2], st[3]), pk2(st[4], st[5]), pk2(st[6], st[7]));
#pragma unroll
        for (int j = 0; j < 7; ++j) {
            st[0] = g256 * st[0] + g8::lo16(kv[j].x); st[1] = g256 * st[1] + g8::hi16(kv[j].x);
            st[2] = g256 * st[2] + g8::lo16(kv[j].y); st[3] = g256 * st[3] + g8::hi16(kv[j].y);
            st[4] = g256 * st[4] + g8::lo16(kv[j].z); st[5] = g256 * st[5] + g8::hi16(kv[j].z);
            st[6] = g256 * st[6] + g8::lo16(kv[j].w); st[7] = g256 * st[7] + g8::hi16(kv[j].w);
            *(uint4*)(base + (size_t)(dir == 0 ? j + 1 : 6 - j) * 32768) = make_uint4(pk2(st[0], st[1]), pk2(st[2], st[3]), pk2(st[4], st[5]), pk2(st[6], st[7]));
        }
    }
}

DEV void ret_out_tile(CParams& p, int l, int item, unsigned char* lds) {
    bf16_t* Pb = ws_bf(p, OFF_P); const bf16_t* RVT = ws_bf(p, OFF_RVT);
    const int tid = TIDX(), lane = tid & 63, w = __builtin_amdgcn_readfirstlane(tid >> 6), g = lane >> 4, lc = lane & 15;
    const bool lat = item < 256;
    int b, h, qb, rowc, qi0, c;
    if (lat) { qb = item & 15; h = (item >> 4) & 3; b = item >> 6; c = qb >> 1; rowc = NCTX + b * 2048 + c * 256; qi0 = (qb & 1) * 128; }
    else { const int it = item - 256; qb = it & 1; h = (it >> 1) & 3; b = it >> 3; c = 0; rowc = b * 256; qi0 = qb * 128; }
    const int qi = qi0 + w * 16 + lc;
    const size_t rowq = (size_t)(rowc + qi);
    const float lgf = ret_logg(p, l, 0, h), lgb = ret_logg(p, l, 1, h);
    const int nstep = lat ? 8 : 4;
    auto dma_step = [&](int sI) __attribute__((always_inline)) {
        LAS unsigned char* base = (LAS unsigned char*)lds + (sI & 1) * 49152;
        if (sI < 4) {
#pragma unroll
            for (int i = 0; i < 2; ++i) {
                const int q = w * 2 + i, row = 4 * q + (lane >> 4), lch = (lane & 15) ^ (row & 15);
                __builtin_amdgcn_global_load_lds((const unsigned*)(Pb + (size_t)(rowc + sI * 64 + row) * PW + C_RK + h * 128 + lch * 8), (LAS unsigned*)(base + q * 1024), 16, 0, 0);
            }
#pragma unroll
            for (int i = 0; i < 4; ++i) {
                const int q = w * 4 + i, row = 8 * q + (lane >> 3), lch = (lane & 7) ^ ((row >> 1) & 7);
                __builtin_amdgcn_global_load_lds((const unsigned*)(RVT + (size_t)(h * 256 + row) * M + rowc + sI * 64 + lch * 8), (LAS unsigned*)(base + 16384 + q * 1024), 16, 0, 0);
            }
        } else {
            const int dir = (sI - 4) >> 1, kh = (sI - 4) & 1;
            const bf16_t* Sg = ws_bf(p, OFF_RS) + ((size_t)((b * 4 + h) * 2 + dir) * 8 + c) * 32768;
#pragma unroll
            for (int i = 0; i < 4; ++i) {
                const int q = w * 4 + i, row = 8 * q + (lane >> 3), lch = (lane & 7) ^ ((row >> 1) & 7);
                __builtin_amdgcn_global_load_lds((const unsigned*)(Sg + (size_t)row * 128 + kh * 64 + lch * 8), (LAS unsigned*)(base + 16384 + q * 1024), 16, 0, 0);
            }
        }
    };
    dma_step(0);
    f32x4 acc[16];
#pragma unroll
    for (int df = 0; df < 16; ++df) acc[df] = (f32x4){0.f, 0.f, 0.f, 0.f};
    const int vsw = (lc >> 1) & 7;
    unsigned char* qsave = lds + 98304 + tid * 64;
    {
        bf16x8 qfr[4];
#pragma unroll
        for (int ks = 0; ks < 4; ++ks) { qfr[ks] = *(const bf16x8*)(Pb + rowq * PW + C_RQ + h * 128 + ks * 32 + g * 8); *(bf16x8*)(qsave + ks * 16) = qfr[ks]; }
#pragma unroll 1
        for (int sI = 0; sI < 4; ++sI) {
            asm volatile("s_waitcnt vmcnt(0)" ::: "memory");
            __syncthreads();
            if (sI + 1 < nstep) dma_step(sI + 1);
            const unsigned char* Ks = lds + (sI & 1) * 49152;
            const unsigned char* Vt = Ks + 16384;
            f32x4 sc[4];
#pragma unroll
            for (int kf = 0; kf < 4; ++kf) sc[kf] = (f32x4){0.f, 0.f, 0.f, 0.f};
#pragma unroll
            for (int kb = 0; kb < 2; ++kb) {
                bf16x8 ak[2][4];
#pragma unroll
                for (int k2 = 0; k2 < 2; ++k2)
#pragma unroll
                    for (int kf = 0; kf < 4; ++kf) ak[k2][kf] = *(const bf16x8*)(Ks + (kf * 16 + lc) * 256 + ((((kb * 2 + k2) * 4 + g) ^ lc) << 4));
                __builtin_amdgcn_sched_barrier(0);
#pragma unroll
                for (int k2 = 0; k2 < 2; ++k2)
#pragma unroll
                    for (int kf = 0; kf < 4; ++kf) sc[kf] = __builtin_amdgcn_mfma_f32_16x16x32_bf16(ak[k2][kf], qfr[kb * 2 + k2], sc[kf], 0, 0, 0);
                __builtin_amdgcn_sched_barrier(0);
            }
            bf16x8 pb[2];
#pragma unroll
            for (int kf = 0; kf < 4; ++kf)
#pragma unroll
                for (int r = 0; r < 4; ++r) {
                    const int dd = qi - (sI * 64 + kf * 16 + g * 4 + r);
                    float wgt = 0.f;
                    if (dd >= 0) wgt += __expf(lgf * (float)dd);
                    if (dd <= 0) wgt += __expf(lgb * (float)(-dd));
                    pb[kf >> 1][(kf & 1) * 4 + r] = (short)f2bf(sc[kf][r] * wgt);
                }
#pragma unroll
            for (int s2 = 0; s2 < 2; ++s2)
#pragma unroll
                for (int db = 0; db < 2; ++db) {
                    uint2 lo[8], hi[8];
#pragma unroll
                    for (int j = 0; j < 8; ++j) {
                        const unsigned char* vr = Vt + ((db * 8 + j) * 16 + lc) * 128 + 8 * (g & 1);
                        lo[j] = *(const uint2*)(vr + (((4 * s2 + (g >> 1)) ^ vsw) << 4));
                        hi[j] = *(const uint2*)(vr + (((4 * s2 + 2 + (g >> 1)) ^ vsw) << 4));
                    }
                    __builtin_amdgcn_sched_barrier(0);
#pragma unroll
                    for (int j = 0; j < 8; ++j) {
                        union { uint4 u; bf16x8 v; } av; av.u = make_uint4(lo[j].x, lo[j].y, hi[j].x, hi[j].y);
                        acc[db * 8 + j] = __builtin_amdgcn_mfma_f32_16x16x32_bf16(av.v, pb[s2], acc[db * 8 + j], 0, 0, 0);
                    }
                    __builtin_amdgcn_sched_barrier(0);
                }
        }
    }
    if (lat) {
#pragma unroll 1
        for (int dir = 0; dir < 2; ++dir) {
            const float qs = dir == 0 ? __expf(lgf * (float)(qi + 1)) : __expf(lgb * (float)(256 - qi));
            bf16x8 qx[4];
#pragma unroll
            for (int ks = 0; ks < 4; ++ks) {
                const bf16x8 qv = *(const bf16x8*)(qsave + ks * 16);
#pragma unroll
                for (int e = 0; e < 8; ++e) qx[ks][e] = (short)f2bf(qs * bf2f((bf16_t)qv[e]));
            }
#pragma unroll
            for (int kh = 0; kh < 2; ++kh) {
                const int sI = 4 + dir * 2 + kh;
                asm volatile("s_waitcnt vmcnt(0)" ::: "memory");
                __syncthreads();
                if (sI + 1 < nstep) dma_step(sI + 1);
                const unsigned char* Vt = lds + (sI & 1) * 49152 + 16384;
#pragma unroll
                for (int db = 0; db < 4; ++db) {
                    bf16x8 as0[4], as1[4];
#pragma unroll
                    for (int j = 0; j < 4; ++j) {
                        as0[j] = *(const bf16x8*)(Vt + ((db * 4 + j) * 16 + lc) * 128 + (((0 + g) ^ vsw) << 4));
                        as1[j] = *(const bf16x8*)(Vt + ((db * 4 + j) * 16 + lc) * 128 + (((4 + g) ^ vsw) << 4));
                    }
                    __builtin_amdgcn_sched_barrier(0);
#pragma unroll
                    for (int j = 0; j < 4; ++j) {
                        acc[db * 4 + j] = __builtin_amdgcn_mfma_f32_16x16x32_bf16(as0[j], qx[kh * 2 + 0], acc[db * 4 + j], 0, 0, 0);
                        acc[db * 4 + j] = __builtin_amdgcn_mfma_f32_16x16x32_bf16(as1[j], qx[kh * 2 + 1], acc[db * 4 + j], 0, 0, 0);
                    }
                    __builtin_amdgcn_sched_barrier(0);
                }
            }
        }
    }
    float s1 = 0.f;
#pragma unroll
    for (int df = 0; df < 16; ++df) s1 += (acc[df][0] + acc[df][1]) + (acc[df][2] + acc[df][3]);
    s1 = xrow16_sum(s1);
    const float mu = s1 * (1.f / 256.f);
    float s2 = 0.f;
#pragma unroll
    for (int df = 0; df < 16; ++df)
#pragma unroll
        for (int r = 0; r < 4; ++r) { const float xc = acc[df][r] - mu; s2 += xc * xc; }
    s2 = xrow16_sum(s2);
    const float rstd = rsqrtf(s2 * (1.f / 256.f) + EPS);
#pragma unroll
    for (int dp = 0; dp < 8; ++dp) {
        float v[8];
        pair8(acc[dp * 2], acc[dp * 2 + 1], v);
        bf16_t* gp = Pb + rowq * PW + C_RG + h * 256 + ((g & 1) ? (dp * 2 + 1) * 16 + (g - 1) * 4 : dp * 32 + g * 4);
        const uint4 gv = *(const uint4*)gp;
        uint4 o;
        o.x = pk2((v[0] - mu) * rstd * __uint_as_float(gv.x << 16), (v[1] - mu) * rstd * __uint_as_float(gv.x & 0xffff0000u));
        o.y = pk2((v[2] - mu) * rstd * __uint_as_float(gv.y << 16), (v[3] - mu) * rstd * __uint_as_float(gv.y & 0xffff0000u));
        o.z = pk2((v[4] - mu) * rstd * __uint_as_float(gv.z << 16), (v[5] - mu) * rstd * __uint_as_float(gv.z & 0xffff0000u));
        o.w = pk2((v[6] - mu) * rstd * __uint_as_float(gv.w << 16), (v[7] - mu) * rstd * __uint_as_float(gv.w & 0xffff0000u));
        *(uint4*)gp = o;
    }
}
DEV void phase_ret_out(CParams& p, int l, unsigned char* lds) {
    if (GDIM() == 256) {
        const int xg = BIDX() & 7, j = BIDX() >> 3;
        ret_out_tile(p, l, ((j >> 1) * 8 + xg) * 2 + (j & 1), lds);
        if (j < 16) ret_out_tile(p, l, 256 + ((j >> 1) * 8 + xg) * 2 + (j & 1), lds);
        return;
    }
    for (int item = BIDX(); item < 384; item += GDIM()) ret_out_tile(p, l, item, lds);
}

template <bool REV>
DEV void lru_scan16(const float (&a)[4][4], const float (&u)[4][4], float cin, int g, int lc, float (&h)[4][4], float& cout, float& Aprod) {
    float carry = cin, Ap = 1.f;
#pragma unroll
    for (int ii = 0; ii < 4; ++ii) {
        const int i = REV ? 3 - ii : ii;
        float hl[4], cp[4];
        {
            float hh = 0.f, cc = 1.f;
#pragma unroll
            for (int rr = 0; rr < 4; ++rr) { const int r = REV ? 3 - rr : rr; hh = a[i][r] * hh + u[i][r]; cc *= a[i][r]; hl[r] = hh; cp[r] = cc; }
        }
        const float As = REV ? cp[0] : cp[3], Hs = REV ? hl[0] : hl[3];
        float Ag[4], Hg[4];
        xrow16_gather(As, Ag); xrow16_gather(Hs, Hg);
        float cur = carry, mine = carry;
#pragma unroll
        for (int sI = 0; sI < 4; ++sI) {
            const int gg = REV ? 3 - sI : sI;
            mine = (g == gg) ? cur : mine;
            cur = Ag[gg] * cur + Hg[gg];
            Ap *= Ag[gg];
        }
        carry = cur;
#pragma unroll
        for (int r = 0; r < 4; ++r) h[i][r] = hl[r] + cp[r] * mine;
    }
    cout = carry; Aprod = Ap;
}

template <bool REV>
DEV void lru_dir(const unsigned char* xa, const bf16x8 (&bA)[4], const bf16x8 (&bX)[4], float ba, float bx, float c2, float cin,
                 const float (&x)[4][4], int g, int lc, float (&h)[4][4], float& cout, float& Ap) {
    f32x4 accA[4], accX[4];
#pragma unroll
    for (int i = 0; i < 4; ++i) { accA[i] = (f32x4){0.f, 0.f, 0.f, 0.f}; accX[i] = (f32x4){0.f, 0.f, 0.f, 0.f}; }
#pragma unroll
    for (int ks = 0; ks < 4; ++ks)
#pragma unroll
        for (int i = 0; i < 4; ++i) {
            const bf16x8 af = *(const bf16x8*)(xa + (i * 16 + lc) * 256 + (((ks * 4 + g) ^ lc) << 4));
            accA[i] = __builtin_amdgcn_mfma_f32_16x16x32_bf16(af, bA[ks], accA[i], 0, 0, 0);
            accX[i] = __builtin_amdgcn_mfma_f32_16x16x32_bf16(af, bX[ks], accX[i], 0, 0, 0);
        }
    float a[4][4], u[4][4];
#pragma unroll
    for (int i = 0; i < 4; ++i)
#pragma unroll
        for (int r = 0; r < 4; ++r) {
            const float rg = sigmf(accA[i][r] + ba), ig = sigmf(accX[i][r] + bx);
            const float av = __builtin_amdgcn_exp2f(rg * c2);
            a[i][r] = av;
            u[i][r] = __builtin_amdgcn_sqrtf(fmaxf(1.f - av * av, 0.f)) * (ig * x[i][r]);
        }
    lru_scan16<REV>(a, u, cin, g, lc, h, cout, Ap);
}

DEV void phase_lru_tiles(CParams& p, int l, int mode, unsigned char* lds) {
    unsigned char* xa = lds; float* hs = (float*)(lds + 16384); float* cwl = (float*)(lds + 49152); unsigned char* rawb = lds + 53248;
    bf16_t* Pb = ws_bf(p, OFF_P);
    const int tid = TIDX(), lane = tid & 63, w = __builtin_amdgcn_readfirstlane(tid >> 6), g = lane >> 4, lc = lane & 15;
    const int blk = BIDX() & 7, gstep = GDIM() >> 3;
    const int cl = w * 16 + lc, ch = blk * 128 + cl;
    for (int e = tid; e < 5 * 128; e += 512) {
        const int j = e >> 7, c = e & 127;
        cwl[e] = j < 4 ? p.conv_w[(size_t)(l * 4 + j) * D + blk * 128 + c] : p.conv_b[(size_t)l * D + blk * 128 + c];
    }
    bf16x8 bAf[4], bXf[4], bAb[4], bXb[4];
    {
        const bf16_t* W = ws_bf(p, OFF_LRUW) + ((size_t)blk * 128 + cl) * 128 + g * 8;
#pragma unroll
        for (int ks = 0; ks < 4; ++ks) {
            bAf[ks] = *(const bf16x8*)(W + ks * 32);
            bXf[ks] = *(const bf16x8*)(W + (size_t)1 * 8 * 16384 + ks * 32);
            bAb[ks] = *(const bf16x8*)(W + (size_t)2 * 8 * 16384 + ks * 32);
            bXb[ks] = *(const bf16x8*)(W + (size_t)3 * 8 * 16384 + ks * 32);
        }
    }
    const float baF = p.lru_ba[(l * 2 + 0) * D + ch], bxF = p.lru_bx[(l * 2 + 0) * D + ch];
    const float baB = p.lru_ba[(l * 2 + 1) * D + ch], bxB = p.lru_bx[(l * 2 + 1) * D + ch];
    const float c2F = -8.f * 1.4426950408889634f * softplusf(-p.lru_lambda[(l * 2 + 0) * D + ch]);
    const float c2B = -8.f * 1.4426950408889634f * softplusf(-p.lru_lambda[(l * 2 + 1) * D + ch]);
    float* LA = (float*)(p.ws + OFF_LRUC);
    float* LH = LA + 192 * 2 * 1024;
    const int chunk = tid & 15, chb = blk * 128 + chunk * 8, trow = tid >> 4;
#define LRU_PREFETCH(gcn) do { const bf16_t* src_ = Pb + (long)((gcn) * 64 - 1 + (lane >> 4)) * (long)PW + C_LX + blk * 128 + (lane & 15) * 8; \
        _Pragma("unroll") for (int q_ = 0; q_ < 3; ++q_) { const int qq_ = w + 8 * q_; if (qq_ < 17) \
            __builtin_amdgcn_global_load_lds((const unsigned*)(src_ + (long)qq_ * 4 * PW), (LAS unsigned*)((LAS unsigned char*)rawb + qq_ * 1024), 16, 0, 0); } } while (0)
    int gc = BIDX() >> 3, gend = 192, gst = gstep;
    if (mode && GDIM() == 256) { const int j = BIDX() >> 3; gc = j < 16 ? j * 5 : 80 + (j - 16) * 7; gend = gc + (j < 16 ? 5 : 7); gst = 1; }
    if (gc < gend) LRU_PREFETCH(gc);
    for (; gc < gend; gc += gst) {
        const int m0 = gc * 64;
        const bool lat = m0 >= NCTX;
        const int L = lat ? 2048 : 256, t0 = lat ? ((m0 - NCTX) & 2047) : (m0 & 255);
        asm volatile("s_waitcnt vmcnt(0)" ::: "memory");
        __syncthreads();
#pragma unroll
        for (int i = 0; i < 2; ++i) {
            const int tt = trow + 32 * i;
            float acc[8];
#pragma unroll
            for (int e = 0; e < 8; ++e) acc[e] = cwl[4 * 128 + chunk * 8 + e];
#pragma unroll
            for (int j = 0; j < 4; ++j) {
                const int tp = t0 + tt + j - 1;
                if (tp >= 0 && tp < L) {
                    const uint4 v = *(const uint4*)(rawb + (tt + j) * 256 + chunk * 16);
                    const float* cw = cwl + j * 128 + chunk * 8;
                    acc[0] += cw[0] * __uint_as_float(v.x << 16); acc[1] += cw[1] * __uint_as_float(v.x & 0xffff0000u);
                    acc[2] += cw[2] * __uint_as_float(v.y << 16); acc[3] += cw[3] * __uint_as_float(v.y & 0xffff0000u);
                    acc[4] += cw[4] * __uint_as_float(v.z << 16); acc[5] += cw[5] * __uint_as_float(v.z & 0xffff0000u);
                    acc[6] += cw[6] * __uint_as_float(v.w << 16); acc[7] += cw[7] * __uint_as_float(v.w & 0xffff0000u);
                }
            }
            uint4 o;
            o.x = pk2(acc[0], acc[1]); o.y = pk2(acc[2], acc[3]);
            o.z = pk2(acc[4], acc[5]); o.w = pk2(acc[6], acc[7]);
            *(uint4*)(xa + tt * 256 + ((chunk ^ (tt & 15)) << 4)) = o;
        }
        __syncthreads();
        if (gc + gst < gend) LRU_PREFETCH(gc + gst);
        const size_t ci = ((size_t)gc * 2) * 1024 + ch;
        const float cinF = mode ? LH[ci] : 0.f, cinB = mode ? LH[ci + 1024] : 0.f;
        uint4 gv[2];
        if (mode) {
#pragma unroll
            for (int i = 0; i < 2; ++i) gv[i] = *(const uint4*)(Pb + (size_t)(m0 + trow + 32 * i) * PW + C_LG + chb);
        }
        {
            float x[4][4];
#pragma unroll
            for (int i = 0; i < 4; ++i)
#pragma unroll
                for (int r = 0; r < 4; ++r) {
                    const int tok = i * 16 + g * 4 + r;
                    x[i][r] = bf2f(*(const bf16_t*)(xa + tok * 256 + (((cl >> 3) ^ (tok & 15)) << 4) + (cl & 7) * 2));
                }
            float h[4][4], cout, Ap;
            lru_dir<false>(xa, bAf, bXf, baF, bxF, c2F, cinF, x, g, lc, h, cout, Ap);
            if (!mode) { if (g == 0) { LA[ci] = Ap; LH[ci] = cout; } }
            else {
#pragma unroll
                for (int i = 0; i < 4; ++i)
#pragma unroll
                    for (int r = 0; r < 4; ++r) hs[(i * 16 + g * 4 + r) * 128 + cl] = h[i][r];
                if (!lat && g == 0 && t0 == 192) p.out[O_NLRU + ((size_t)((m0 >> 8) * 2 + l) * 2 + 0) * 1024 + ch] = cout;
            }
            lru_dir<true>(xa, bAb, bXb, baB, bxB, c2B, cinB, x, g, lc, h, cout, Ap);
            if (!mode) { if (g == 0) { LA[ci + 1024] = Ap; LH[ci + 1024] = cout; } }
            else {
#pragma unroll
                for (int i = 0; i < 4; ++i)
#pragma unroll
                    for (int r = 0; r < 4; ++r) hs[(i * 16 + g * 4 + r) * 128 + cl] += h[i][r];
                if (!lat && g == 0 && t0 == 0) p.out[O_NLRU + ((size_t)((m0 >> 8) * 2 + l) * 2 + 1) * 1024 + ch] = cout;
            }
        }
        if (mode) {
            __syncthreads();
#pragma unroll
            for (int i = 0; i < 2; ++i) {
                const int tt = trow + 32 * i, c8 = chunk * 8;
                const float4 h0 = *(const float4*)(hs + tt * 128 + c8), h1 = *(const float4*)(hs + tt * 128 + c8 + 4);
                uint4 o;
                o.x = pk2(h0.x * __uint_as_float(gv[i].x << 16), h0.y * __uint_as_float(gv[i].x & 0xffff0000u));
                o.y = pk2(h0.z * __uint_as_float(gv[i].y << 16), h0.w * __uint_as_float(gv[i].y & 0xffff0000u));
                o.z = pk2(h1.x * __uint_as_float(gv[i].z << 16), h1.y * __uint_as_float(gv[i].z & 0xffff0000u));
                o.w = pk2(h1.z * __uint_as_float(gv[i].w << 16), h1.w * __uint_as_float(gv[i].w & 0xffff0000u));
                *(uint4*)(Pb + (size_t)(m0 + tt) * PW + C_LG + chb) = o;
            }
        }
    }
    asm volatile("s_waitcnt vmcnt(0)" ::: "memory");
    __syncthreads();
#undef LRU_PREFETCH
}

DEV void phase_lru_carry(CParams& p, int l, int vb, int nvb) {
    float* LA = (float*)(p.ws + OFF_LRUC);
    float* LH = LA + 192 * 2 * 1024;
    const int gt = vb * 512 + TIDX(), gs = nvb * 512;
    for (int idx = gt; idx < 20 * 2 * 1024; idx += gs) {
        const int ch = idx & 1023, dir = (idx >> 10) & 1, seq = idx >> 11;
        const bool lat = seq >= 16;
        const int nch = lat ? 32 : 4;
        const int gc0 = lat ? 64 + (seq - 16) * 32 : seq * 4;
        float carry = lat ? p.state_lru[((size_t)((seq - 16) * 2 + l) * 2 + dir) * 1024 + ch] : 0.f;
        for (int s0 = 0; s0 < nch; s0 += 4) {
            float A[4], Hh[4]; size_t ci[4];
#pragma unroll
            for (int k = 0; k < 4; ++k) {
                const int sI = s0 + k, cidx = dir == 0 ? sI : nch - 1 - sI;
                ci[k] = ((size_t)(gc0 + cidx) * 2 + dir) * 1024 + ch;
                A[k] = LA[ci[k]]; Hh[k] = LH[ci[k]];
            }
#pragma unroll
            for (int k = 0; k < 4; ++k) { LH[ci[k]] = carry; carry = A[k] * carry + Hh[k]; }
        }
    }
}

DEV CParams* KARGS() { CParams* kp = (CParams*)__builtin_amdgcn_kernarg_segment_ptr(); asm volatile("" : "+s"(kp)); return kp; }

#define XB_TMO      128
#define XB_XCNT(j)  (256  + 64 * (j))
#define XB_XSUB(j)  (1280 + 64 * (j))
#define XB_XGEN(j)  (2304 + 64 * (j))
#define XB_TOP      3328
#define XB_TOPGEN   3392
#define XCD_BAR_WORDS 3456
#define XB_SPIN_CAP (1u << 18)
DEV unsigned xb_ld(unsigned* p)              { return __hip_atomic_load(p, __ATOMIC_RELAXED, __HIP_MEMORY_SCOPE_AGENT); }
DEV unsigned xb_add(unsigned* p, unsigned v) { return __hip_atomic_fetch_add(p, v, __ATOMIC_RELAXED, __HIP_MEMORY_SCOPE_AGENT); }
DEV unsigned xb_xcc_id() { return (unsigned)__builtin_amdgcn_s_getreg((3 << 11) | 20) & 0xFu; }
#define XB_SPIN(cond, bar) do { unsigned _sp = 0; while (cond) { __builtin_amdgcn_s_sleep(1); \
    if ((++_sp & 255u) == 0u) { if (xb_ld(&(bar)[XB_TMO])) break; if (_sp > XB_SPIN_CAP) { atomicAdd(&(bar)[XB_TMO], 1u); break; } } } } while (0)
struct XcdBarrier { unsigned* bar; unsigned x; volatile LAS unsigned* st; };
DEV XcdBarrier xcd_barrier_post(unsigned* bar, volatile LAS unsigned* st) {
    XcdBarrier b; b.bar = bar; b.x = xb_xcc_id(); b.st = st;
    if (threadIdx.x == 0) (void)xb_add(&bar[XB_XCNT(b.x)], 1u);
    return b;
}
DEV void xcd_barrier_complete(unsigned* bar, unsigned x, unsigned& nloc, unsigned& nx) {
    const unsigned G = gridDim.x * gridDim.y * gridDim.z;
    unsigned sum, cnt, mine, sp = 0u;
    for (;;) {
        sum = 0u; cnt = 0u; mine = 0u;
#pragma unroll
        for (unsigned j = 0; j < 16; ++j) { const unsigned c = xb_ld(&bar[XB_XCNT(j)]); sum += c; cnt += (c > 0u) ? 1u : 0u; mine = (j == x) ? c : mine; }
        if (sum == G) break;
        __builtin_amdgcn_s_sleep(1);
        if ((++sp & 255u) == 0u) { if (xb_ld(&bar[XB_TMO])) break; if (sp > XB_SPIN_CAP) { atomicAdd(&bar[XB_TMO], 1u); break; } }
    }
    nloc = mine > 0u ? mine : 1u; nx = cnt > 0u ? cnt : 1u;
}
DEV void xcd_barrier(const XcdBarrier& b0) {
    asm volatile("s_waitcnt vmcnt(0)" ::: "memory");
    __syncthreads();
    if (threadIdx.x == 0) {
        XcdBarrier b; b.x = b0.x; b.st = b0.st;
        asm volatile("" : "+s"(b.x));
        unsigned* bar = (unsigned*)(KARGS()->ws + OFF_BAR);
        __builtin_amdgcn_s_waitcnt(0);
        unsigned nloc = b.st[0], nx = b.st[1];
        if (nloc == 0u) { xcd_barrier_complete(bar, b.x, nloc, nx); b.st[0] = nloc; b.st[1] = nx; }
        const unsigned old = xb_add(&bar[XB_XSUB(b.x)], 1u);
        const unsigned gen = old / nloc;
        if (old + 1u == (gen + 1u) * nloc) {
            __builtin_amdgcn_fence(__ATOMIC_RELEASE, "agent");
            asm volatile("s_waitcnt vmcnt(0)" ::: "memory");
            const unsigned og = xb_add(&bar[XB_TOP], 1u);
            const unsigned tg = og / nx;
            if (og + 1u == (tg + 1u) * nx) xb_add(&bar[XB_TOPGEN], 1u);
            else XB_SPIN(xb_ld(&bar[XB_TOPGEN]) == tg, bar);
            __builtin_amdgcn_fence(__ATOMIC_ACQUIRE, "agent");
            xb_add(&bar[XB_XGEN(b.x)], 1u);
            asm volatile("s_waitcnt vmcnt(0)" ::: "memory");
        } else {
            XB_SPIN(xb_ld(&bar[XB_XGEN(b.x)]) == gen, bar);
            __builtin_amdgcn_fence(__ATOMIC_ACQUIRE, "agent");
            asm volatile("s_waitcnt vmcnt(0)" ::: "memory");
        }
    }
    __syncthreads();
}

enum { PH_INIT = 0, PH_PRENORM, PH_GEMM1, PH_MIX1, PH_MIX2, PH_MIX3, PH_MERGE, PH_MERGE2, PH_OUT, PH_COUNT };

DEV void run_phase(CParams& p, int ph, int l, unsigned char* lds) {
    switch (ph) {
    case PH_INIT:    phase_mod(p, (float*)lds); phase_rope_table(p); __syncthreads(); phase_convert(p, 0, (float*)lds, 0, BIDX(), GDIM()); break;
    case PH_PRENORM: phase_prenorm(p, l); break;
    case PH_GEMM1:
        phase8_gemm1(p, l, (LAS unsigned char*)lds);
        if (GDIM() != 256) phase_convert(p, l, (float*)lds, 1, BIDX(), GDIM()); else if (BIDX() >= 160) phase_convert(p, l, (float*)lds, 1, BIDX() - 160, 96);
        break;
    case PH_MIX1:    phase_attn(p, l, lds); __syncthreads(); phase_lru_tiles(p, l, 0, lds); __syncthreads(); phase_ret_kv(p, l, lds); break;
    case PH_MIX2:
        if (GDIM() == 256) {
            if (BIDX() < 192) phase8_merge(p, l, 2, (LAS unsigned char*)lds);
            else { phase_lru_carry(p, l, BIDX() - 192, 64); phase_ret_scan(p, l, BIDX() - 192, 64); }
        } else { phase_lru_carry(p, l, BIDX(), GDIM()); phase_ret_scan(p, l, BIDX(), GDIM()); }
        break;
    case PH_MIX3:    phase_lru_tiles(p, l, 1, lds); __syncthreads(); phase_ret_out(p, l, lds); break;
    case PH_MERGE:   phase8_merge(p, l, 0, (LAS unsigned char*)lds); break;
    case PH_MERGE2:  phase8_merge(p, l, 1, (LAS unsigned char*)lds); break;
    case PH_OUT:
        phase8_out(p, l, (LAS unsigned char*)lds);
        if (l == 0) { if (GDIM() != 256) phase_convert(p, 1, (float*)lds, 0, BIDX(), GDIM()); else if (BIDX() >= 192) phase_convert(p, 1, (float*)lds, 0, BIDX() - 192, 64); }
        break;
    }
}

#if !ONE_LAUNCH
__global__ void __launch_bounds__(512, 2) phase_kernel(Params p, int ph, int l) {
    extern __shared__ __attribute__((aligned(16))) unsigned char dsm[];
    run_phase(p, ph, l, dsm);
}
#else
#ifndef PROBE_MASK
#define PROBE_MASK 0
#endif
#define PROBE_MULT 8
__global__ void __launch_bounds__(512, 2) mega_kernel(Params p) {
    extern __shared__ __attribute__((aligned(16))) unsigned char dsm[];
    cg::grid_group grid = cg::this_grid();
    volatile LAS unsigned* st = (volatile LAS unsigned*)((LAS unsigned char*)dsm + g8::STAGE_BYTES);
    if (threadIdx.x < 4) st[threadIdx.x] = 0u;
    __syncthreads();
    const XcdBarrier xb = xcd_barrier_post((unsigned*)(KARGS()->ws + OFF_BAR), st);
#define GSYNC() xcd_barrier(xb)
#if PROBE_MASK
    long long t_acc = 0, t0 = 0;
#define PROBE_BEGIN(ph) if ((PROBE_MASK >> (ph)) & 1) t0 = wall_clock64();
#define PROBE_END(ph) if ((PROBE_MASK >> (ph)) & 1) t_acc += wall_clock64() - t0;
#else
#define PROBE_BEGIN(ph)
#define PROBE_END(ph)
#endif
    if (KARGS()->out == nullptr) grid.sync();
    PROBE_BEGIN(PH_INIT) run_phase(*KARGS(), PH_INIT, 0, dsm); GSYNC(); PROBE_END(PH_INIT)
    PROBE_BEGIN(PH_PRENORM) run_phase(*KARGS(), PH_PRENORM, 0, dsm); GSYNC(); PROBE_END(PH_PRENORM)
    for (int l = 0; l < 2; ++l) {
        for (int ph = PH_GEMM1; ph <= PH_OUT; ++ph) {
            PROBE_BEGIN(ph)
            run_phase(*KARGS(), ph, l, dsm);
            if (!(l == 1 && ph == PH_OUT)) GSYNC();
            PROBE_END(ph)
        }
    }
#if PROBE_MASK
    if (blockIdx.x == 0 && threadIdx.x == 0) {
        const long long tgt = wall_clock64() + (long long)PROBE_MULT * t_acc;
        while (wall_clock64() < tgt) __builtin_amdgcn_s_sleep(8);
    }
#endif
}
#endif

extern "C" void kernel_launch(void* const* d_in, const int* in_sizes, int n_in,
                              void* d_out, int out_size, void* d_ws, size_t ws_size,
                              hipStream_t stream) {
    constexpr size_t kDynLds = LDS_XOFF + 5120;
    static int grid_blocks = 0;
    if (grid_blocks == 0) {
        if (n_in != 26 || ws_size < WS_NEED || out_size != 25231360) {
            fprintf(stderr, "kernel_launch: unexpected n_in %d / ws_size %zu (need %zu) / out_size %d\n", n_in, ws_size, (size_t)WS_NEED, out_size);
            grid_blocks = -1; return;
        }
        int dev = 0, cus = 0, per_cu = 0;
        (void)hipGetDevice(&dev);
        (void)hipDeviceGetAttribute(&cus, hipDeviceAttributeMultiprocessorCount, dev);
#if ONE_LAUNCH
        const void* kfn = (const void*)mega_kernel;
#else
        const void* kfn = (const void*)phase_kernel;
#endif
        if (hipFuncSetAttribute(kfn, hipFuncAttributeMaxDynamicSharedMemorySize, (int)kDynLds) != hipSuccess) {
            fprintf(stderr, "kernel_launch: hipFuncSetAttribute failed\n"); grid_blocks = -1; return;
        }
        if (hipOccupancyMaxActiveBlocksPerMultiprocessor(&per_cu, kfn, 512, kDynLds) != hipSuccess || per_cu < 1) {
            fprintf(stderr, "kernel_launch: occupancy query says %d blocks per CU\n", per_cu); grid_blocks = -1; return;
        }
        grid_blocks = cus & ~7;
    }
    if (grid_blocks < 0) return;
    Params p{};
    const float** pp = (const float**)&p;
    for (int i = 0; i < 26; ++i) pp[i] = (const float*)d_in[i];
    p.out = (float*)d_out;
    p.ws = (unsigned char*)d_ws;
#if ONE_LAUNCH
    (void)hipMemsetAsync((unsigned char*)d_ws + OFF_BAR, 0, 16384 + 1024, stream);
    void* args[] = {&p};
    hipError_t e = hipLaunchCooperativeKernel((const void*)mega_kernel, dim3(grid_blocks), dim3(512), args, kDynLds, stream);
    if (e != hipSuccess) fprintf(stderr, "cooperative launch failed: %s (grid %d)\n", hipGetErrorString(e), grid_blocks);
#else
    phase_kernel<<<grid_blocks, 512, kDynLds, stream>>>(p, PH_INIT, 0);
    phase_kernel<<<grid_blocks, 512, kDynLds, stream>>>(p, PH_PRENORM, 0);
    for (int l = 0; l < 2; ++l)
        for (int ph = PH_GEMM1; ph <= PH_OUT; ++ph)
            phase_kernel<<<grid_blocks, 512, kDynLds, stream>>>(p, ph, l);
#endif
}
```
